# Optimizing an MI355X kernel written in HIP

```python
import math
import jax, jax.numpy as jnp
from jax import lax
import numpy as np

D_MODEL = 1024
BATCH = 8
SEQ = 8192
DEPTH = 1

MEM_LEN = 256
CONV_CH = D_MODEL // 4
CONV_K = 3
DIFF_HEADS = 4
DIFF_QK_DIM = D_MODEL // 16
DIFF_V_DIM = 2 * DIFF_QK_DIM
MEM_HEADS = 4
MEM_HEAD_DIM = D_MODEL // 16
DIFF_QK_TOTAL = DIFF_HEADS * 2 * DIFF_QK_DIM
DIFF_V_TOTAL = DIFF_HEADS * DIFF_V_DIM
MEM_TOTAL = MEM_HEADS * MEM_HEAD_DIM
IN_WIDTH = 3 * CONV_CH + 2 * DIFF_QK_TOTAL + DIFF_V_TOTAL + MEM_TOTAL
MIX_WIDTH = CONV_CH + DIFF_V_TOTAL + MEM_TOTAL
IN_SPLITS = (CONV_CH, 2 * CONV_CH, 3 * CONV_CH,
             3 * CONV_CH + DIFF_QK_TOTAL,
             3 * CONV_CH + 2 * DIFF_QK_TOTAL,
             3 * CONV_CH + 2 * DIFF_QK_TOTAL + DIFF_V_TOTAL)
N_BUCKETS = 32
MAX_DISTANCE = 128
Q_BLOCK = 128
N_EXPERTS = 32
TOP_K = 4
D_EXPERT = D_MODEL
SWIGLU_ALPHA = 1.702
SWIGLU_LIMIT = 7.0
EXPERT_BLOCK = 128
EPS = 1e-5
NEG = -1e30

kernel_name = "hymba_conv_diffattn_mem_moe_block"


def rmsnorm(x, g):
    xf = x.astype(jnp.float32)
    y = xf * lax.rsqrt(jnp.mean(xf * xf, axis=-1, keepdims=True) + EPS)
    return (y * g.astype(jnp.float32)).astype(x.dtype)


def causal_short_conv(u, w):
    rhs = w[:, None, :].astype(u.dtype)
    return lax.conv_general_dilated(
        u, rhs, window_strides=(1,), padding=[(CONV_K - 1, 0)],
        dimension_numbers=("NWC", "WIO", "NWC"), feature_group_count=u.shape[-1])


def t5_bucket(n):
    max_exact = N_BUCKETS // 2
    nf = jnp.maximum(n, 1).astype(jnp.float32)
    large = max_exact + (jnp.log(nf / max_exact) / math.log(MAX_DISTANCE / max_exact)
                         * (N_BUCKETS - max_exact)).astype(jnp.int32)
    large = jnp.minimum(large, N_BUCKETS - 1)
    return jnp.where(n < max_exact, n, large)


def diff_attention(q, k, v, lam, rel_bias):
    S = q.shape[1]
    scale = DIFF_QK_DIM ** -0.5
    outs = []
    for i in range(S // Q_BLOCK):
        q0 = i * Q_BLOCK
        kv_len = q0 + Q_BLOCK
        qb = q[:, q0:kv_len]
        kb = k[:, :kv_len]
        vb = v[:, :kv_len]
        s = jnp.einsum("bqhcd,bkhcd->bhcqk", qb, kb).astype(jnp.float32) * scale
        q_pos = q0 + jnp.arange(Q_BLOCK, dtype=jnp.int32)
        k_pos = jnp.arange(kv_len, dtype=jnp.int32)
        dist = q_pos[:, None] - k_pos[None, :]
        bias = jnp.transpose(rel_bias[t5_bucket(jnp.maximum(dist, 0))], (2, 0, 1)).astype(jnp.float32)
        s = jnp.where((dist >= 0)[None, None, None], s + bias[None, :, None], NEG)
        p = jax.nn.softmax(s, axis=-1)
        p_diff = p[:, :, 0] - lam * p[:, :, 1]
        outs.append(jnp.einsum("bhqk,bkhd->bqhd", p_diff.astype(vb.dtype), vb))
    return jnp.concatenate(outs, axis=1)


def memory_attention(qm, mem_h, w_mem_kv):
    B, M, _ = mem_h.shape
    kv = mem_h @ w_mem_kv
    km, vm = jnp.split(kv, 2, axis=-1)
    km = km.reshape(B, M, MEM_HEADS, MEM_HEAD_DIM)
    vm = vm.reshape(B, M, MEM_HEADS, MEM_HEAD_DIM)
    s = jnp.einsum("bshd,bmhd->bhsm", qm, km).astype(jnp.float32) * (MEM_HEAD_DIM ** -0.5)
    p = jax.nn.softmax(s, axis=-1)
    return jnp.einsum("bhsm,bmhd->bshd", p.astype(vm.dtype), vm)


def moe_ffn(h, router_w, router_b, w_gate_up, b_gate_up, w_down, b_down):
    T, D = h.shape
    logits = (h @ router_w).astype(jnp.float32) + router_b.astype(jnp.float32)
    top_logit, top_idx = lax.top_k(logits, TOP_K)
    gates = jax.nn.softmax(top_logit, axis=-1)
    n_slots = T * TOP_K
    flat_e = top_idx.reshape(-1).astype(jnp.int32)
    flat_tok = jnp.repeat(jnp.arange(T, dtype=jnp.int32), TOP_K)
    flat_g = gates.reshape(-1)
    order = jnp.argsort(flat_e)
    sorted_e = flat_e[order]
    counts = jnp.bincount(flat_e, length=N_EXPERTS).astype(jnp.int32)
    padded = (counts + EXPERT_BLOCK - 1) // EXPERT_BLOCK * EXPERT_BLOCK
    start = jnp.cumsum(counts) - counts
    pad_end = jnp.cumsum(padded)
    pad_start = pad_end - padded
    dest = pad_start[sorted_e] + jnp.arange(n_slots, dtype=jnp.int32) - start[sorted_e]
    n_blocks = -(-n_slots // EXPERT_BLOCK) + N_EXPERTS
    n_pad = n_blocks * EXPERT_BLOCK
    tok_buf = jnp.full((n_pad,), T, jnp.int32).at[dest].set(flat_tok[order])
    gate_buf = jnp.zeros((n_pad,), jnp.float32).at[dest].set(flat_g[order])
    block_e = jnp.searchsorted(pad_end, jnp.arange(n_blocks, dtype=jnp.int32) * EXPERT_BLOCK, side="right")
    block_e = jnp.minimum(block_e, N_EXPERTS - 1).astype(jnp.int32)
    h_pad = jnp.concatenate([h, jnp.zeros((1, D), h.dtype)], axis=0)

    def expert_block(args):
        tok, g, e = args
        xb = h_pad[tok]
        gu = xb @ w_gate_up[e] + b_gate_up[e]
        gate, up = jnp.split(gu, 2, axis=-1)
        gate = jnp.minimum(gate, SWIGLU_LIMIT)
        up = jnp.clip(up, -SWIGLU_LIMIT, SWIGLU_LIMIT)
        act = (up + 1.0) * (gate * jax.nn.sigmoid(SWIGLU_ALPHA * gate))
        y = act @ w_down[e] + b_down[e]
        return y * g[:, None].astype(y.dtype)

    yb = lax.map(expert_block, (tok_buf.reshape(n_blocks, EXPERT_BLOCK),
                                gate_buf.reshape(n_blocks, EXPERT_BLOCK), block_e))
    out = jax.ops.segment_sum(yb.reshape(n_pad, D), tok_buf, num_segments=T + 1)
    return out[:T]


def setup_inputs(seed: int = 0) -> dict:
    key = jax.random.key(seed)
    ks = jax.random.split(key, 20)
    f32 = jnp.float32
    L, D = DEPTH, D_MODEL
    nrm = lambda k, shape, s: jax.random.normal(k, shape, f32) * s
    gain = lambda k, shape: 1.0 + 0.01 * jax.random.normal(k, shape, f32)
    return {
        "x": jax.random.normal(ks[0], (BATCH, SEQ, D), f32),
        "mem": jax.random.normal(ks[1], (BATCH, MEM_LEN, D), f32),
        "rel_bias": nrm(ks[2], (N_BUCKETS, DIFF_HEADS), 0.5),
        "attn_norm_g": gain(ks[3], (L, D)),
        "w_mix_in": nrm(ks[4], (L, D, IN_WIDTH), D ** -0.5),
        "conv_w": nrm(ks[5], (L, CONV_K, CONV_CH), CONV_K ** -0.5),
        "lambda_qk": nrm(ks[6], (L, 4, DIFF_QK_DIM), 0.1),
        "diff_subln_g": gain(ks[7], (L, DIFF_V_DIM)),
        "mem_norm_g": gain(ks[8], (L, D)),
        "w_mem_kv": nrm(ks[9], (L, D, 2 * MEM_TOTAL), D ** -0.5),
        "w_mix_out": nrm(ks[10], (L, MIX_WIDTH, D), MIX_WIDTH ** -0.5),
        "ffn_norm_g": gain(ks[11], (L, D)),
        "router_w": nrm(ks[12], (L, D, N_EXPERTS), D ** -0.5),
        "router_b": nrm(ks[13], (L, N_EXPERTS), 0.01),
        "w_gate_up": nrm(ks[14], (L, N_EXPERTS, D, 2 * D_EXPERT), D ** -0.5),
        "b_gate_up": nrm(ks[15], (L, N_EXPERTS, 2 * D_EXPERT), 0.01),
        "w_down": nrm(ks[16], (L, N_EXPERTS, D_EXPERT, D), D_EXPERT ** -0.5),
        "b_down": nrm(ks[17], (L, N_EXPERTS, D), 0.01),
        "final_norm_g": gain(ks[18], (D,)),
    }


def reference(x, mem, rel_bias, attn_norm_g, w_mix_in, conv_w, lambda_qk, diff_subln_g,
              mem_norm_g, w_mem_kv, w_mix_out, ffn_norm_g, router_w, router_b,
              w_gate_up, b_gate_up, w_down, b_down, final_norm_g):
    B, S, D = x.shape
    for l in range(DEPTH):
        lam_init = 0.8 - 0.6 * math.exp(-0.3 * l)
        h = rmsnorm(x, attn_norm_g[l])
        proj = h @ w_mix_in[l]
        u, g_b, g_c, q, k, v, qm = jnp.split(proj, IN_SPLITS, axis=-1)
        y_conv = g_b * causal_short_conv(g_c * u, conv_w[l])
        lq = lambda_qk[l].astype(jnp.float32)
        lam = jnp.exp(jnp.sum(lq[0] * lq[1])) - jnp.exp(jnp.sum(lq[2] * lq[3])) + lam_init
        q = q.reshape(B, S, DIFF_HEADS, 2, DIFF_QK_DIM)
        k = k.reshape(B, S, DIFF_HEADS, 2, DIFF_QK_DIM)
        v = v.reshape(B, S, DIFF_HEADS, DIFF_V_DIM)
        o = diff_attention(q, k, v, lam, rel_bias)
        o = rmsnorm(o, diff_subln_g[l]) * (1.0 - lam_init)
        y_diff = o.reshape(B, S, DIFF_V_TOTAL).astype(x.dtype)
        mem_h = rmsnorm(mem, mem_norm_g[l])
        y_mem = memory_attention(qm.reshape(B, S, MEM_HEADS, MEM_HEAD_DIM), mem_h, w_mem_kv[l])
        y_mem = y_mem.reshape(B, S, MEM_TOTAL)
        mix = jnp.concatenate([y_conv, y_diff, y_mem], axis=-1)
        x = x + mix @ w_mix_out[l]
        h = rmsnorm(x, ffn_norm_g[l]).reshape(B * S, D)
        x = x + moe_ffn(h, router_w[l], router_b[l], w_gate_up[l], b_gate_up[l],
                        w_down[l], b_down[l]).reshape(B, S, D)
    return rmsnorm(x, final_norm_g)
```

```cpp
#include <hip/hip_runtime.h>
#include <hip/hip_bf16.h>
#include <cstdio>
#include <cstdint>

#ifndef MK_N_LAUNCHES
#define MK_N_LAUNCHES 1
#endif

constexpr int BATCH = 8, SEQ = 8192, DM = 1024, T = BATCH * SEQ, INW = 2560, MEML = 256, NEXP = 32, TOPK = 4, DEXP = 1024;
constexpr int COL_U = 0, COL_GB = 256, COL_GC = 512, COL_Q = 768, COL_K = 1280, COL_V = 1792, COL_QM = 2304;
constexpr float EPS = 1e-5f;
constexpr float C2 = 0.125f * 1.4426950408889634f;
constexpr float LOG2E = 1.4426950408889634f;
constexpr int NRB_MAX = 1056;
constexpr int NRB_A = 512;
constexpr int POS_A = NRB_A * 256;

#define GAS __attribute__((address_space(1)))
#define LAS __attribute__((address_space(3)))
typedef unsigned short bf16_t;
typedef short bf16x8 __attribute__((ext_vector_type(8)));
typedef short s16x4 __attribute__((ext_vector_type(4)));
typedef float f32x4 __attribute__((ext_vector_type(4)));
typedef float f32x16 __attribute__((ext_vector_type(16)));
typedef unsigned u32x4 __attribute__((ext_vector_type(4)));
typedef unsigned u32x2 __attribute__((ext_vector_type(2)));
typedef float f32x2_t __attribute__((ext_vector_type(2)));
typedef __bf16 bf16x2_t __attribute__((ext_vector_type(2)));
typedef GAS unsigned gu32;
#define RLX_AGENT __ATOMIC_RELAXED, __HIP_MEMORY_SCOPE_AGENT
#define LDS_WAIT() asm volatile("s_waitcnt lgkmcnt(0)" ::: "memory")
#define VM_WAIT() asm volatile("s_waitcnt vmcnt(0)" ::: "memory")
#define SBAR() __builtin_amdgcn_sched_barrier(0)

__device__ __forceinline__ unsigned pk2(float lo, float hi) { f32x2_t v = {lo, hi}; bf16x2_t b = __builtin_convertvector(v, bf16x2_t); return __builtin_bit_cast(unsigned, b); }
__device__ __forceinline__ float bflo(unsigned u) { return __uint_as_float(u << 16); }
__device__ __forceinline__ float bfhi(unsigned u) { return __uint_as_float(u & 0xffff0000u); }
__device__ __forceinline__ bf16x8 pack8(f32x4 a, f32x4 b) { u32x4 w = {pk2(a[0], a[1]), pk2(a[2], a[3]), pk2(b[0], b[1]), pk2(b[2], b[3])}; return __builtin_bit_cast(bf16x8, w); }
__device__ __forceinline__ int crow(int r, int hi) { return (r & 3) + 8 * (r >> 2) + 4 * hi; }
__device__ __forceinline__ float wave_sum(float v) {
#pragma unroll
    for (int o = 1; o < 64; o <<= 1) v += __shfl_xor(v, o);
    return v;
}

namespace pg8 {
constexpr int BM = 256, BK = 64, HALF = 128, HTB = HALF * BK * 2  , STAGE_BYTES = 8 * HTB, NXCD = 8, WGM = 8;
__host__ __device__ __forceinline__ int lds_byte(int r, int c) { const int st = (r >> 4) * 2 + (c >> 5), rr = r & 15, cc = c & 31, ob = rr * 64 + cc * 2; return st * 1024 + (ob ^ (((ob >> 9) & 1) << 5)); }
__host__ __device__ __forceinline__ void stage_rc(int b, int& R, int& C) { const int st = b / 1024, sb = b % 1024, swz = sb ^ (((sb >> 9) & 1) << 5); R = (st >> 1) * 16 + swz / 64; C = (st & 1) * 32 + (swz % 64) / 2; }
__host__ __device__ __forceinline__ int perm32(int rho) { const int n = rho >> 4, i = rho & 15; return 8 * (i >> 2) + 4 * n + (i & 3); }

struct Unit { int pm, pn, e; };
struct Gemm { const bf16_t* A; const bf16_t* Bt; int K; long bstride; const int* rowmap; };

struct StaticOrder {
    int nM, nN, nwg, G, c;
    __device__ void init(int M, int N, int G_, int c_) { nM = M / BM; nN = N / BM; nwg = nM * nN; G = G_; c = c_; }
    __device__ bool next(int i, Unit& u) const {
        const long L = (long)i * G + c; if (L >= nwg) return false;
        int wgid = (int)L; { const int q = nwg / NXCD, r = nwg % NXCD, xcd = wgid % NXCD, off = wgid / NXCD; wgid = (xcd < r ? xcd * (q + 1) : r * (q + 1) + (xcd - r) * q) + off; }
        const int nig = WGM * nN, gid = wgid / nig, fm = gid * WGM, gsz = (nM - fm) < WGM ? (nM - fm) : WGM;
        u.pm = fm + ((wgid % nig) % gsz); u.pn = (wgid % nig) / gsz; u.e = 0; return true;
    }
};
struct GroupOrder {
    int nrb, rb0, npn, G, c; const int* rb_e;
    __device__ bool next(int i, Unit& u) const {
        int rbl, pn;
        if ((G & 7) == 0 && ((G >> 3) % npn) == 0) { const int x = c & 7, j = c >> 3, rpx = (G >> 3) / npn; rbl = i * (G / npn) + x * rpx + j / npn; pn = j % npn; }
        else { const long L = (long)i * G + c; rbl = (int)(L / npn); pn = (int)(L % npn); }
        if (rbl >= nrb) return false;
        u.pm = rb0 + rbl; u.pn = pn; u.e = rb_e[u.pm]; return true;
    }
};

template <class Epi, class Sched, bool ALIGN_EPI>
__device__ __forceinline__ void gemm_phase(LAS unsigned char* lds, const Gemm g, const Sched& S, const Epi& E) {
    const int tid = threadIdx.x, wid = __builtin_amdgcn_readfirstlane(tid >> 6), lane = tid & 63, wr = wid >> 2, wc = wid & 3, fr = lane & 15, fq = lane >> 4;
    const int K = g.K, nt = K / BK;
    int Rr[2], Cc[2]; unsigned voffB[2];
#pragma unroll
    for (int i = 0; i < 2; ++i) { int R, C; stage_rc(tid * 16 + i * 8192, R, C); const int Rb = Epi::PERM ? ((R & ~31) + perm32(R & 31)) : R;
        Rr[i] = R; Cc[i] = C; voffB[i] = (unsigned)(Rb * K + C) * 2u; }
    const size_t kstep = (size_t)(BK * 2);
    const size_t hstep = (size_t)HALF * K * 2;
    const size_t tstep = 2 * hstep;
    const unsigned ldsw = (unsigned)wid * 1024u;
    const int aoff = lds_byte(wr * 64 + fr, fq * 8), boff = lds_byte(wc * 32 + fr, fq * 8);
#define PG8_SA(b, h) (((b) * 2 + (h)) * HTB)
#define PG8_SB(b, h) ((4 + (b) * 2 + (h)) * HTB)
#define PG8_STAGE(bufoff, gbase, voff) do { _Pragma("unroll") for (int _i = 0; _i < 2; ++_i) \
        __builtin_amdgcn_global_load_lds((const unsigned*)((const char*)(gbase) + (voff)[_i]), (LAS unsigned*)(lds + (bufoff) + ldsw + _i * 8192), 16, 0, 0); } while (0)
#define PG8_STAGE_A(bufoff, kptr, offs, h) do { _Pragma("unroll") for (int _i = 0; _i < 2; ++_i) \
        __builtin_amdgcn_global_load_lds((const unsigned*)((const char*)(kptr) + (offs)[h][_i]), (LAS unsigned*)(lds + (bufoff) + ldsw + _i * 8192), 16, 0, 0); } while (0)
#define PG8_AOFF(dst, u) do { _Pragma("unroll") for (int _h = 0; _h < 2; ++_h) _Pragma("unroll") for (int _i = 0; _i < 2; ++_i) { const int _row = (u).pm * BM + _h * HALF + Rr[_i]; \
        const int _src = g.rowmap ? g.rowmap[_row] : _row; dst[_h][_i] = (unsigned)(_src * K + Cc[_i]) * 2u; } } while (0)
#define PG8_LDA(dst, b, h) do { _Pragma("unroll") for (int m = 0; m < 4; ++m) _Pragma("unroll") for (int k = 0; k < 2; ++k) dst[m][k] = *(const LAS bf16x8*)(lds + PG8_SA(b, h) + aoff + m * 2048 + k * 1024); } while (0)
#define PG8_LDB(dst, b, h) do { _Pragma("unroll") for (int n = 0; n < 2; ++n) _Pragma("unroll") for (int k = 0; k < 2; ++k) dst[n][k] = *(const LAS bf16x8*)(lds + PG8_SB(b, h) + boff + n * 2048 + k * 1024); } while (0)
#define PG8_MMA(ai, bj, At, Bt) do { __builtin_amdgcn_s_setprio(1); _Pragma("unroll") for (int m = 0; m < 4; ++m) _Pragma("unroll") for (int n = 0; n < 2; ++n) _Pragma("unroll") for (int k = 0; k < 2; ++k) \
        acc[ai][bj][m][n] = __builtin_amdgcn_mfma_f32_16x16x32_bf16(Bt[n][k], At[m][k], acc[ai][bj][m][n], 0, 0, 0); __builtin_amdgcn_s_setprio(0); } while (0)
#define PG8_WAIT_V(n) asm volatile("s_waitcnt vmcnt(" #n ")" ::: "memory")
#define PG8_WAIT_L(n) asm volatile("s_waitcnt lgkmcnt(" #n ")" ::: "memory")
#define PG8_BAR __builtin_amdgcn_s_barrier()
#define PG8_SCHED __builtin_amdgcn_sched_barrier(0)
    Unit cur, nxt; int ui = 0;
    if (!S.next(0, cur)) return;
    f32x4 acc[2][2][4][2];
#pragma unroll
    for (int a = 0; a < 2; ++a)
#pragma unroll
        for (int b = 0; b < 2; ++b)
#pragma unroll
            for (int m = 0; m < 4; ++m)
#pragma unroll
                for (int n = 0; n < 2; ++n) acc[a][b][m][n] = (f32x4){0.f, 0.f, 0.f, 0.f};
    bf16x8 At[4][2], B0[2][2], B1[2][2];
    unsigned aoc[2][2], aon[2][2];
    PG8_AOFF(aoc, cur);
    const char* Ab = (const char*)g.A;
    const char* cB = (const char*)g.Bt + ((size_t)cur.e * (size_t)g.bstride) * 2 + (size_t)cur.pn * tstep;
    PG8_STAGE(PG8_SB(0, 0), cB, voffB); PG8_STAGE(PG8_SB(0, 1), cB + hstep, voffB); PG8_STAGE_A(PG8_SA(0, 0), Ab, aoc, 0); PG8_STAGE_A(PG8_SA(0, 1), Ab, aoc, 1);
    if (wr == 1) PG8_BAR;
    PG8_WAIT_V(2); PG8_BAR;
    PG8_STAGE(PG8_SB(1, 0), cB + kstep, voffB); PG8_STAGE_A(PG8_SA(1, 0), Ab + kstep, aoc, 0); PG8_STAGE(PG8_SB(1, 1), cB + hstep + kstep, voffB);
    PG8_WAIT_V(6); PG8_BAR;
    for (;;) {
        const bool has_next = S.next(ui + 1, nxt);
        if (has_next) { PG8_AOFF(aon, nxt); }
        else {
#pragma unroll
            for (int h = 0; h < 2; ++h)
#pragma unroll
                for (int i = 0; i < 2; ++i) aon[h][i] = aoc[h][i];
        }
        const char* nB = has_next ? (const char*)g.Bt + ((size_t)nxt.e * (size_t)g.bstride) * 2 + (size_t)nxt.pn * tstep : cB;
        for (int t = 0; t < nt; t += 2) {
            const bool last = (t == nt - 2);
            const char* a1 = Ab + (size_t)(t + 1) * kstep;
            const char* a2 = last ? Ab : Ab + (size_t)(t + 2) * kstep; const char* b2 = last ? nB : cB + (size_t)(t + 2) * kstep;
            const char* a3 = a2 + kstep; const char* b3 = b2 + kstep;
            unsigned o2[2][2];
#pragma unroll
            for (int h = 0; h < 2; ++h)
#pragma unroll
                for (int i = 0; i < 2; ++i) o2[h][i] = last ? aon[h][i] : aoc[h][i];
            PG8_LDB(B0, 0, 0); PG8_LDB(B1, 0, 1); PG8_SCHED; PG8_LDA(At, 0, 0); PG8_STAGE_A(PG8_SA(1, 1), a1, aoc, 1);
            PG8_WAIT_V(8); PG8_WAIT_L(0); PG8_BAR; PG8_MMA(0, 0, At, B0); PG8_MMA(0, 1, At, B1); PG8_BAR; PG8_SCHED;
            PG8_LDA(At, 0, 1); PG8_STAGE(PG8_SB(0, 0), b2, voffB); PG8_STAGE(PG8_SB(0, 1), b2 + hstep, voffB); PG8_STAGE_A(PG8_SA(0, 0), a2, o2, 0);
            PG8_WAIT_V(8); PG8_WAIT_L(0); PG8_BAR; PG8_MMA(1, 0, At, B0); PG8_MMA(1, 1, At, B1); PG8_BAR; PG8_SCHED;
            PG8_LDB(B0, 1, 0); PG8_LDB(B1, 1, 1); PG8_SCHED; PG8_LDA(At, 1, 0); PG8_STAGE_A(PG8_SA(0, 1), a2, o2, 1);
            PG8_WAIT_V(8); PG8_WAIT_L(0); PG8_BAR; PG8_MMA(0, 0, At, B0); PG8_MMA(0, 1, At, B1); PG8_BAR; PG8_SCHED;
            PG8_LDA(At, 1, 1); PG8_STAGE(PG8_SB(1, 0), b3, voffB); PG8_STAGE(PG8_SB(1, 1), b3 + hstep, voffB); PG8_STAGE_A(PG8_SA(1, 0), a3, o2, 0);
            PG8_WAIT_V(8); PG8_WAIT_L(0); PG8_BAR; PG8_MMA(1, 0, At, B0); PG8_MMA(1, 1, At, B1); PG8_BAR; PG8_SCHED;
        }
        if constexpr (ALIGN_EPI) { if (wr == 0) PG8_BAR; }
        E(acc, cur, wr, wc, fr, fq);
        if (!has_next) break;
#pragma unroll
        for (int a = 0; a < 2; ++a)
#pragma unroll
            for (int b = 0; b < 2; ++b)
#pragma unroll
                for (int m = 0; m < 4; ++m)
#pragma unroll
                    for (int n = 0; n < 2; ++n) acc[a][b][m][n] = (f32x4){0.f, 0.f, 0.f, 0.f};
        cur = nxt; cB = nB; ++ui;
#pragma unroll
        for (int h = 0; h < 2; ++h)
#pragma unroll
            for (int i = 0; i < 2; ++i) aoc[h][i] = aon[h][i];
        if constexpr (ALIGN_EPI) { if (wr == 1) PG8_BAR; }
    }
    PG8_WAIT_V(0);
    if constexpr (!ALIGN_EPI) { if (wr == 0) PG8_BAR; }
    PG8_BAR;
#undef PG8_SA
#undef PG8_SB
#undef PG8_STAGE
#undef PG8_STAGE_A
#undef PG8_AOFF
#undef PG8_LDA
#undef PG8_LDB
#undef PG8_MMA
#undef PG8_WAIT_V
#undef PG8_WAIT_L
#undef PG8_BAR
#undef PG8_SCHED
}

struct EpiProj {
    static constexpr bool PERM = true;
    bf16_t* O;
    __device__ __forceinline__ void operator()(const f32x4 (&acc)[2][2][4][2], const Unit& u, int wr, int wc, int fr, int fq) const {
        const int row0 = u.pm * BM + wr * 64 + fr, col0 = u.pn * BM + wc * 32 + 8 * fq;
        const float sc = (u.pn == 3 || u.pn == 4 || u.pn == 9) ? C2 : 1.f;
#pragma unroll
        for (int ai = 0; ai < 2; ++ai)
#pragma unroll
            for (int m = 0; m < 4; ++m) { bf16_t* rowp = O + (size_t)(row0 + ai * HALF + m * 16) * INW + col0;
#pragma unroll
                for (int bj = 0; bj < 2; ++bj) { const f32x4 v0 = acc[ai][bj][m][0] * sc, v1 = acc[ai][bj][m][1] * sc;
                    u32x4 w; w.x = pk2(v0[0], v0[1]); w.y = pk2(v0[2], v0[3]); w.z = pk2(v1[0], v1[1]); w.w = pk2(v1[2], v1[3]);
                    *(u32x4*)(rowp + bj * HALF) = w; } }
    }
};
struct EpiX1 {
    static constexpr bool PERM = true;
    const float* X; bf16_t* O;
    __device__ __forceinline__ void operator()(const f32x4 (&acc)[2][2][4][2], const Unit& u, int wr, int wc, int fr, int fq) const {
        const int row0 = u.pm * BM + wr * 64 + fr, col0 = u.pn * BM + wc * 32 + 8 * fq;
#pragma unroll
        for (int ai = 0; ai < 2; ++ai)
#pragma unroll
            for (int m = 0; m < 4; ++m) { const size_t off = (size_t)(row0 + ai * HALF + m * 16) * DM + col0;
#pragma unroll
                for (int bj = 0; bj < 2; ++bj) { const f32x4 x0 = *(const f32x4*)(X + off + bj * HALF), x1 = *(const f32x4*)(X + off + bj * HALF + 4);
                    const f32x4 v0 = acc[ai][bj][m][0] + x0, v1 = acc[ai][bj][m][1] + x1;
                    u32x4 w; w.x = pk2(v0[0], v0[1]); w.y = pk2(v0[2], v0[3]); w.z = pk2(v1[0], v1[1]); w.w = pk2(v1[2], v1[3]);
                    *(u32x4*)(O + off + bj * HALF) = w; } }
    }
};
struct EpiGU {
    static constexpr bool PERM = true;
    bf16_t* ACT; const float* bias; const float* rstd;
    __device__ __forceinline__ void operator()(const f32x4 (&acc)[2][2][4][2], const Unit& u, int wr, int wc, int fr, int fq) const {
        const int row0 = u.pm * BM + wr * 64 + fr, j0 = u.pn * HALF + wc * 32 + 8 * fq;
        const float* bp = bias + (size_t)u.e * 2048 + j0;
        const f32x4 bg0 = *(const f32x4*)(bp), bg1 = *(const f32x4*)(bp + 4), bu0 = *(const f32x4*)(bp + 1024), bu1 = *(const f32x4*)(bp + 1028);
#pragma unroll
        for (int ai = 0; ai < 2; ++ai)
#pragma unroll
            for (int m = 0; m < 4; ++m) { const int row = row0 + ai * HALF + m * 16; const float rs = rstd[row];
                f32x4 g0 = acc[ai][0][m][0] * rs + bg0, g1 = acc[ai][0][m][1] * rs + bg1, u0 = acc[ai][1][m][0] * rs + bu0, u1 = acc[ai][1][m][1] * rs + bu1;
                float o[8];
#pragma unroll
                for (int i = 0; i < 4; ++i) {
                    { const float gg = fminf(g0[i], 7.f), uu = fminf(fmaxf(u0[i], -7.f), 7.f); const float sg = __builtin_amdgcn_rcpf(1.f + __builtin_amdgcn_exp2f(-1.702f * LOG2E * gg)); o[i] = (uu + 1.f) * gg * sg; }
                    { const float gg = fminf(g1[i], 7.f), uu = fminf(fmaxf(u1[i], -7.f), 7.f); const float sg = __builtin_amdgcn_rcpf(1.f + __builtin_amdgcn_exp2f(-1.702f * LOG2E * gg)); o[4 + i] = (uu + 1.f) * gg * sg; }
                }
                u32x4 w; w.x = pk2(o[0], o[1]); w.y = pk2(o[2], o[3]); w.z = pk2(o[4], o[5]); w.w = pk2(o[6], o[7]);
                *(u32x4*)(ACT + (size_t)row * DEXP + j0) = w; }
    }
};
struct EpiDown {
    static constexpr bool PERM = true;
    bf16_t* Y; const float* bias; const float* gate;
    __device__ __forceinline__ void operator()(const f32x4 (&acc)[2][2][4][2], const Unit& u, int wr, int wc, int fr, int fq) const {
        const int row0 = u.pm * BM + wr * 64 + fr, col0 = u.pn * BM + wc * 32 + 8 * fq;
        const float* bp = bias + (size_t)u.e * DM + col0;
        f32x4 bv[2][2];
#pragma unroll
        for (int bj = 0; bj < 2; ++bj) { bv[bj][0] = *(const f32x4*)(bp + bj * HALF); bv[bj][1] = *(const f32x4*)(bp + bj * HALF + 4); }
#pragma unroll
        for (int ai = 0; ai < 2; ++ai)
#pragma unroll
            for (int m = 0; m < 4; ++m) { const int row = row0 + ai * HALF + m * 16; const float gs = gate[row];
#pragma unroll
                for (int bj = 0; bj < 2; ++bj) { const f32x4 v0 = (acc[ai][bj][m][0] + bv[bj][0]) * gs, v1 = (acc[ai][bj][m][1] + bv[bj][1]) * gs;
                    u32x4 w; w.x = pk2(v0[0], v0[1]); w.y = pk2(v0[2], v0[3]); w.z = pk2(v1[0], v1[1]); w.w = pk2(v1[2], v1[3]);
                    *(u32x4*)(Y + (size_t)row * DM + col0 + bj * HALF) = w; } }
    }
};
}

namespace dattn {
constexpr int NW = 8, QBLK = 32, KVBLK = 64, QB = 256, PITCH = INW;
constexpr int SHM_V = KVBLK * 128 * 2, SHM_K = KVBLK * 64 * 2;
constexpr int OFF_V = 0, OFF_K = 2 * SHM_V, OFF_WS = OFF_K + 2 * SHM_K, OFF_STASH = OFF_WS + NW * 64 * 4, OFF_TB = OFF_STASH + NW * 8192, LDS_BYTES = OFF_TB + 4 * 128 * 4;
constexpr float THR = 8.f;
__device__ __forceinline__ int v_st(int k, int c) { const int kk = (k & ~0xC) | ((k & 4) << 1) | ((k & 8) >> 1); return ((kk >> 3) * 4 + (c >> 5)) * 512 + ((kk & 7) * 32 + (c & 31)) * 2; }
__device__ __forceinline__ int v_rd_base(int lane) { return ((lane & 3) << 3) | (((lane >> 2) & 3) << 6) | (((lane >> 4) & 1) << 5) | (((lane >> 5) & 1) << 8); }
constexpr int v_rd_off(int d0, int ks, int half) { return d0 * 512 + ks * 4096 + half * 2048; }

struct Ref { const bf16_t* Q; const bf16_t* K; const bf16_t* V; bf16_t* O; int P0, comp, h; };
struct Seam { bf16x8 qr[4]; bf16x8 st_v0, st_v1, st_k; };

__device__ __forceinline__ bf16x8 ld8(const bf16_t* p) { return *reinterpret_cast<const bf16x8*>(p); }

__device__ __forceinline__ void bias_mask(f32x16& p0, f32x16& p1, int sdq  , const LAS float* tb) {
    const float NEG = -__builtin_inff();
    int lane_ = (int)__builtin_amdgcn_mbcnt_hi(~0u, __builtin_amdgcn_mbcnt_lo(~0u, 0u));
    int dq = sdq + (lane_ & 31) - 4 * (lane_ >> 5);
    asm volatile("" : "+v"(dq));
#pragma unroll
    for (int r = 0; r < 16; ++r) {
        const int c = (r & 3) + 8 * (r >> 2);
        const int d0 = dq - c, d1 = dq - c - 32;
        const int i0 = d0 < 0 ? 0 : (d0 > 127 ? 127 : d0), i1 = d1 < 0 ? 0 : (d1 > 127 ? 127 : d1);
        const float b0 = tb[i0], b1 = tb[i1];
        p0[r] = d0 < 0 ? NEG : p0[r] + b0;
        p1[r] = d1 < 0 ? NEG : p1[r] + b1;
    }
}
__device__ __forceinline__ void partialSM(f32x16& p0, f32x16& p1, float& m_reg, float& alpha) {
    float pmax = p0[0];
#pragma unroll
    for (int r = 1; r < 16; ++r) pmax = fmaxf(pmax, p0[r]);
#pragma unroll
    for (int r = 0; r < 16; ++r) pmax = fmaxf(pmax, p1[r]);
    { auto rr = __builtin_amdgcn_permlane32_swap(__float_as_uint(pmax), __float_as_uint(pmax), false, false);
      pmax = fmaxf(__uint_as_float(rr[0]), __uint_as_float(rr[1])); }
    float mn;
    if (__builtin_expect(__all((pmax - m_reg) <= THR), 1)) { mn = m_reg; alpha = 1.f; }
    else { mn = fmaxf(m_reg, pmax); alpha = __builtin_amdgcn_exp2f(m_reg - mn); m_reg = mn; }
#pragma unroll
    for (int r = 0; r < 16; ++r) p0[r] = p0[r] - mn;
#pragma unroll
    for (int r = 0; r < 16; ++r) p1[r] = p1[r] - mn;
#pragma unroll
    for (int r = 0; r < 16; ++r) p0[r] = __builtin_amdgcn_exp2f(p0[r]);
}
__device__ __forceinline__ void finishSM(f32x16& p0, f32x16& p1, float alpha, float& l_reg, bf16x8& pa0, bf16x8& pa1, bf16x8& pa2, bf16x8& pa3) {
#pragma unroll
    for (int r = 0; r < 16; ++r) p1[r] = __builtin_amdgcn_exp2f(p1[r]);
    float ps = 0;
#pragma unroll
    for (int r = 0; r < 16; ++r) ps += p0[r];
#pragma unroll
    for (int r = 0; r < 16; ++r) ps += p1[r];
    { auto rr = __builtin_amdgcn_permlane32_swap(__float_as_uint(ps), __float_as_uint(ps), false, false);
      ps = __uint_as_float(rr[0]) + __uint_as_float(rr[1]); }
    l_reg = l_reg * alpha + ps;
#define PK4(P, B_, OUT) do { unsigned a0 = pk2(P[B_+0], P[B_+1]), a1 = pk2(P[B_+2], P[B_+3]);                          \
        unsigned b0 = pk2(P[B_+4], P[B_+5]), b1 = pk2(P[B_+6], P[B_+7]);                                             \
        auto r0 = __builtin_amdgcn_permlane32_swap(a0, b0, false, false); auto r1 = __builtin_amdgcn_permlane32_swap(a1, b1, false, false); \
        u32x4 w = {r0[0], r1[0], r0[1], r1[1]}; OUT = __builtin_bit_cast(bf16x8, w); } while (0)
    PK4(p0, 0, pa0); PK4(p0, 8, pa1); PK4(p1, 0, pa2); PK4(p1, 8, pa3);
#undef PK4
}
template <int KB>
__device__ __forceinline__ void qkt(f32x16& p0, f32x16& p1, const LAS unsigned char* K_lds, int r32, int hi, const bf16x8* qr) {
    p0 = f32x16{}; p1 = f32x16{};
    const int s = (r32 >> 1) & 7;
#pragma unroll
    for (int d0 = 0; d0 < 4; ++d0) {
        const LAS unsigned char* a = K_lds + KB * SHM_K + r32 * 128 + (((2 * d0 + hi) ^ s) << 4);
        const bf16x8 b0 = *(const LAS bf16x8*)(a);
        const bf16x8 b1 = *(const LAS bf16x8*)(a + 32 * 128);
        p0 = __builtin_amdgcn_mfma_f32_32x32x16_bf16(b0, qr[d0], p0, 0, 0, 0);
        p1 = __builtin_amdgcn_mfma_f32_32x32x16_bf16(b1, qr[d0], p1, 0, 0, 0); }
}
template <int VB>
__device__ __forceinline__ void pv_tile(f32x16* o, int vb0, bf16x8 pa0, bf16x8 pa1, bf16x8 pa2, bf16x8 pa3) {
#define TRRD(dst, off) asm volatile("ds_read_b64_tr_b16 %0, %1 offset:%2" : "=&v"(dst) : "v"(vb0), "i"(off) : "memory")
#define PV_D0(d0) do { s16x4 l0, l1, l2, l3, h0, h1, h2, h3; constexpr int b_ = VB * SHM_V + v_rd_off(d0, 0, 0); \
        TRRD(l0, b_); TRRD(h0, b_ + 2048); TRRD(l1, b_ + 4096); TRRD(h1, b_ + 6144); TRRD(l2, b_ + 8192); TRRD(h2, b_ + 10240); TRRD(l3, b_ + 12288); TRRD(h3, b_ + 14336); \
        asm volatile("s_waitcnt lgkmcnt(0)" ::: "memory"); SBAR();   \
        o[d0] = __builtin_amdgcn_mfma_f32_32x32x16_bf16(pa0, (bf16x8){l0[0], l0[1], l0[2], l0[3], h0[0], h0[1], h0[2], h0[3]}, o[d0], 0, 0, 0);   \
        o[d0] = __builtin_amdgcn_mfma_f32_32x32x16_bf16(pa1, (bf16x8){l1[0], l1[1], l1[2], l1[3], h1[0], h1[1], h1[2], h1[3]}, o[d0], 0, 0, 0);   \
        o[d0] = __builtin_amdgcn_mfma_f32_32x32x16_bf16(pa2, (bf16x8){l2[0], l2[1], l2[2], l2[3], h2[0], h2[1], h2[2], h2[3]}, o[d0], 0, 0, 0);   \
        o[d0] = __builtin_amdgcn_mfma_f32_32x32x16_bf16(pa3, (bf16x8){l3[0], l3[1], l3[2], l3[3], h3[0], h3[1], h3[2], h3[3]}, o[d0], 0, 0, 0); } while (0)
    PV_D0(0); PV_D0(1); PV_D0(2); PV_D0(3);
#undef PV_D0
#undef TRRD
}

#define DA_VMW() asm volatile("s_waitcnt vmcnt(0)" ::: "memory")
#define DA_SLOAD(Kp, Vp, k0) do { S.st_v0 = ld8((Vp) + (size_t)((k0) + sr) * PITCH + sc); S.st_v1 = ld8((Vp) + (size_t)((k0) + 32 + sr) * PITCH + sc); \
                                  S.st_k = ld8((Kp) + (size_t)((k0) + kr) * PITCH + kc * 8); } while (0)
#define DA_SWRITE_K(bf) do { *(LAS bf16x8*)(K_lds + (bf) * SHM_K + kws) = S.st_k; } while (0)
#define DA_SWRITE_V(bf) do { *(LAS bf16x8*)(V_lds + (bf) * SHM_V + vst0) = S.st_v0; *(LAS bf16x8*)(V_lds + (bf) * SHM_V + vst1) = S.st_v1; } while (0)

__device__ __forceinline__ void prime(const Ref& cur, LAS unsigned char* lds, Seam& S) {
    const int tid = threadIdx.x, wid = __builtin_amdgcn_readfirstlane(tid >> 6), lane = tid & 63, r32 = lane & 31, hi = lane >> 5;
    const int sr = tid >> 4, sc = (tid & 15) * 8, kr = tid >> 3, kc = tid & 7, kws = kr * 128 + ((kc ^ ((kr >> 1) & 7)) << 4);
    LAS unsigned char* K_lds = lds + OFF_K;
#pragma unroll
    for (int d0 = 0; d0 < 4; ++d0) S.qr[d0] = ld8(cur.Q + (size_t)(wid * QBLK + r32) * PITCH + d0 * 16 + hi * 8);
    DA_SLOAD(cur.K, cur.V, 0); DA_VMW(); DA_SWRITE_K(0);
    __syncthreads();
}
__device__ __forceinline__ void block(const Ref& cur, const Ref& nxt, LAS unsigned char* lds, Seam& S, float lam, const float* gsub) {
    const int tid = threadIdx.x, wid = __builtin_amdgcn_readfirstlane(tid >> 6), lane = tid & 63, r32 = lane & 31, hi = lane >> 5;
    const int NT = (cur.P0 + QB) / KVBLK;
    const int qlo = cur.P0 + wid * QBLK;
    LAS unsigned char* V_lds = lds + OFF_V; LAS unsigned char* K_lds = lds + OFF_K;
    LAS float* ws = (LAS float*)(lds + OFF_WS) + wid * 64; LAS float* li_l = ws; LAS float* al_l = ws + 32;
    const LAS float* tbh = (const LAS float*)(lds + OFF_TB) + cur.h * 128;
    float m_reg = -1e30f, l_reg = 0; f32x16 o[4] = {};
    const int sr = tid >> 4, sc = (tid & 15) * 8, vst0 = v_st(sr, sc), vst1 = v_st(32 + sr, sc);
    const int kr = tid >> 3, kc = tid & 7, kws = kr * 128 + ((kc ^ ((kr >> 1) & 7)) << 4);
    const int vb0 = (int)(unsigned)(uintptr_t)V_lds + v_rd_base(lane);
    const bf16_t* Kh = cur.K; const bf16_t* Vh = cur.V;
#define RESC(a) do { if (__any((a) < 1.f)) { if (hi == 0) al_l[r32] = (a); asm volatile("s_waitcnt lgkmcnt(0)" ::: "memory");              \
                     _Pragma("unroll") for (int d_ = 0; d_ < 4; ++d_) _Pragma("unroll") for (int r = 0; r < 16; ++r) o[d_][r] *= al_l[crow(r, hi)]; } } while (0)
#define KBASE(t) ((t) * KVBLK)
#define NEAR(P0_, P1_, t) do { const int kb_ = KBASE(t); if (kb_ >= qlo - 175) bias_mask(P0_, P1_, qlo - kb_, tbh); } while (0)
    f32x16 pA0, pA1, pB0, pB1; float alA, alB; bf16x8 pa0, pa1, pa2, pa3;
    DA_SWRITE_V(0); SBAR();
    DA_SLOAD(Kh, Vh, KBASE(1));
    SBAR(); qkt<0>(pA0, pA1, K_lds, r32, hi, S.qr);
    NEAR(pA0, pA1, 0); partialSM(pA0, pA1, m_reg, alA);
    DA_VMW(); DA_SWRITE_V(1); DA_SWRITE_K(1);
    __syncthreads();
#define HALF_STEP(PX0, PX1, alX, PY0, PY1, alY, t, KB, VB, SB) do {                                                      \
        SBAR(); qkt<KB>(PX0, PX1, K_lds, r32, hi, S.qr);                                                                   \
        finishSM(PY0, PY1, alY, l_reg, pa0, pa1, pa2, pa3); SBAR();                                                           \
        if ((t) + 1 < NT) { DA_SLOAD(Kh, Vh, KBASE((t) + 1)); SBAR(); }                                                        \
        pv_tile<VB>(o, vb0, pa0, pa1, pa2, pa3); NEAR(PX0, PX1, (t)); partialSM(PX0, PX1, m_reg, alX);                      \
        __syncthreads();                                                                                                      \
        if ((t) + 1 < NT) { DA_VMW(); DA_SWRITE_V(SB); DA_SWRITE_K(SB); }                                                     \
        RESC(alX); __syncthreads(); } while (0)
    for (int t = 1; t + 1 < NT; t += 2) {
        HALF_STEP(pB0, pB1, alB, pA0, pA1, alA, t, 1, 0, 0);
        HALF_STEP(pA0, pA1, alA, pB0, pB1, alB, t + 1, 0, 1, 1);
    }
    SBAR(); qkt<1>(pB0, pB1, K_lds, r32, hi, S.qr); SBAR();
    DA_SLOAD(nxt.K, nxt.V, 0); SBAR();
#pragma unroll
    for (int d0 = 0; d0 < 4; ++d0) S.qr[d0] = ld8(nxt.Q + (size_t)(wid * QBLK + r32) * PITCH + d0 * 16 + hi * 8);
    SBAR();
    finishSM(pA0, pA1, alA, l_reg, pa0, pa1, pa2, pa3); SBAR();
    pv_tile<0>(o, vb0, pa0, pa1, pa2, pa3);
    NEAR(pB0, pB1, NT - 1); partialSM(pB0, pB1, m_reg, alB); __syncthreads(); RESC(alB);
    finishSM(pB0, pB1, alB, l_reg, pa0, pa1, pa2, pa3); SBAR(); pv_tile<1>(o, vb0, pa0, pa1, pa2, pa3);
    SBAR(); asm volatile("s_waitcnt vmcnt(4)" ::: "memory"); DA_SWRITE_K(0); SBAR();
    int lane_e = (int)__builtin_amdgcn_mbcnt_hi(~0u, __builtin_amdgcn_mbcnt_lo(~0u, 0u)); asm volatile("" : "+v"(lane_e));
    const int r32e = lane_e & 31, hie = lane_e >> 5;
    if (hi == 0) li_l[r32] = l_reg; asm volatile("s_waitcnt lgkmcnt(0)" ::: "memory");
    float rli[16];
#pragma unroll
    for (int r = 0; r < 16; ++r) rli[r] = __builtin_amdgcn_rcpf(li_l[crow(r, hi)]);
    LAS unsigned* st = (LAS unsigned*)(lds + OFF_STASH + wid * 8192) + lane_e;
    if (cur.comp == 0) {
#pragma unroll
        for (int r = 0; r < 16; ++r) { st[(2 * r) * 64] = pk2(o[0][r] * rli[r], o[1][r] * rli[r]); st[(2 * r + 1) * 64] = pk2(o[2][r] * rli[r], o[3][r] * rli[r]); }
    } else {
        float ss[16];
#pragma unroll
        for (int r = 0; r < 16; ++r) { const unsigned u0 = st[(2 * r) * 64], u1 = st[(2 * r + 1) * 64];
            const float s2 = lam * rli[r];
            o[0][r] = bflo(u0) - s2 * o[0][r]; o[1][r] = bfhi(u0) - s2 * o[1][r]; o[2][r] = bflo(u1) - s2 * o[2][r]; o[3][r] = bfhi(u1) - s2 * o[3][r];
            ss[r] = (o[0][r] * o[0][r] + o[1][r] * o[1][r]) + (o[2][r] * o[2][r] + o[3][r] * o[3][r]); }
#pragma unroll
        for (int r = 0; r < 16; ++r) {
#pragma unroll
            for (int x = 1; x < 32; x <<= 1) ss[r] += __shfl_xor(ss[r], x);
            ss[r] = rsqrtf(ss[r] * (1.f / 128.f) + EPS) * 0.8f; }
        float gg[4];
#pragma unroll
        for (int d0 = 0; d0 < 4; ++d0) gg[d0] = gsub[d0 * 32 + r32e];
        bf16_t* Ow = cur.O + (size_t)(wid * QBLK) * DM;
#pragma unroll
        for (int r = 0; r < 16; ++r) { const int orow = crow(r, hie);
#pragma unroll
            for (int d0 = 0; d0 < 4; ++d0) { const float v = o[d0][r] * ss[r] * gg[d0]; const float vn = __shfl_xor(v, 1);
                if ((r32e & 1) == 0) *(unsigned*)(Ow + (size_t)orow * DM + d0 * 32 + r32e) = pk2(v, vn); } }
    }
    __syncthreads();
#undef RESC
#undef KBASE
#undef NEAR
#undef HALF_STEP
}
#undef DA_VMW
#undef DA_SLOAD
#undef DA_SWRITE_K
#undef DA_SWRITE_V
}

constexpr int NWAVES = 8;
constexpr int N_LAUNCHES = MK_N_LAUNCHES;
constexpr int N_PHASES = 10;
static_assert(N_LAUNCHES == 1 || N_LAUNCHES == N_PHASES, "MK_N_LAUNCHES is 1 or 10");

constexpr size_t MiB = 1u << 20;
constexpr size_t WS_CTL = 0, CTL_ZERO_BYTES = 1 * MiB;
constexpr size_t WS_ETK = 1 * MiB, WS_GTK = 2 * MiB, WS_RSTDT = 3 * MiB, WS_SLOTTK = 4 * MiB, WS_TOKSLOT = 5 * MiB, WS_GATESLOT = 7 * MiB, WS_RSTDSLOT = 9 * MiB, WS_RBE = 11 * MiB;
constexpr size_t WS_WRHI = 12 * MiB, WS_WRLO = 12 * MiB + 65536, WS_KMB = 13 * MiB, WS_VMT = 14 * MiB;
constexpr size_t WS_WIN = 16 * MiB, WS_WOUT = 21 * MiB, WS_X1B = 24 * MiB;
constexpr size_t WS_BIG = 152 * MiB;
constexpr size_t WS_H = WS_BIG, WS_PROJ = WS_BIG + 128 * MiB, WS_MIX = WS_BIG + 448 * MiB;
constexpr size_t WS_ACTA = WS_BIG, WS_ACTB = WS_BIG + 272 * MiB, WS_YA = WS_BIG + 544 * MiB, WS_YB = WS_BIG;
constexpr size_t WS_END = WS_BIG + 800 * MiB;
static_assert(WS_END <= 1024 * MiB, "d_ws map");
constexpr size_t OUT_WGU = 0, OUT_WD = 128 * MiB;
constexpr int CW_BAR = 4096, CW_COUNT = 1024, CW_CURSOR = 2048;
constexpr int RING_BYTES = 131072, LDSCTL_OFF = RING_BYTES, MISC_OFF = LDSCTL_OFF + 320, LDS_BYTES = 147456;
static_assert(dattn::LDS_BYTES <= RING_BYTES, "attention scratch");

#define XB_TMO      128
#define XB_XCNT(j)  (256  + 64 * (j))
#define XB_XSUB(j)  (1280 + 64 * (j))
#define XB_XGEN(j)  (2304 + 64 * (j))
#define XB_TOP      3328
#define XB_TOPGEN   3392
#define XCD_BAR_WORDS 3456
#define XB_SPIN_CAP (1u << 18)
__device__ __forceinline__ unsigned xb_ld(unsigned* p)              { return __hip_atomic_load(p, __ATOMIC_RELAXED, __HIP_MEMORY_SCOPE_AGENT); }
__device__ __forceinline__ unsigned xb_add(unsigned* p, unsigned v) { return __hip_atomic_fetch_add(p, v, __ATOMIC_RELAXED, __HIP_MEMORY_SCOPE_AGENT); }
__device__ __forceinline__ unsigned xb_xcc_id() { return (unsigned)__builtin_amdgcn_s_getreg((3 << 11) | 20) & 0xFu; }
#define XB_SPIN(cond, bar) do { unsigned _sp = 0; while (cond) { __builtin_amdgcn_s_sleep(1); \
    if ((++_sp & 255u) == 0u) { if (xb_ld(&(bar)[XB_TMO])) break; if (_sp > XB_SPIN_CAP) { atomicAdd(&(bar)[XB_TMO], 1u); break; } } } } while (0)
struct XcdBarrier { unsigned* bar; unsigned x; volatile LAS unsigned* st; };
__device__ __forceinline__ XcdBarrier xcd_barrier_post(unsigned* bar, volatile LAS unsigned* st) {
    XcdBarrier b; b.bar = bar; b.x = xb_xcc_id(); b.st = st;
    if (threadIdx.x == 0) (void)xb_add(&bar[XB_XCNT(b.x)], 1u);
    return b;
}
__device__ __forceinline__ void xcd_barrier_complete(unsigned* bar, unsigned x, unsigned& nloc, unsigned& nx) {
    const unsigned G = gridDim.x * gridDim.y * gridDim.z;
    unsigned sum, cnt, mine, sp = 0u;
    for (;;) {
        sum = 0u; cnt = 0u; mine = 0u;
#pragma unroll
        for (unsigned j = 0; j < 16; ++j) { const unsigned c = xb_ld(&bar[XB_XCNT(j)]); sum += c; cnt += (c > 0u) ? 1u : 0u; mine = (j == x) ? c : mine; }
        if (sum == G) break;
        __builtin_amdgcn_s_sleep(1);
        if ((++sp & 255u) == 0u) { if (xb_ld(&bar[XB_TMO])) break; if (sp > XB_SPIN_CAP) { atomicAdd(&bar[XB_TMO], 1u); break; } }
    }
    nloc = mine > 0u ? mine : 1u; nx = cnt > 0u ? cnt : 1u;
}
__device__ __forceinline__ void xcd_barrier(const XcdBarrier& b) {
    asm volatile("s_waitcnt vmcnt(0)" ::: "memory");
    __syncthreads();
    if (threadIdx.x == 0) {
        unsigned* bar = b.bar;
        __builtin_amdgcn_s_waitcnt(0);
        unsigned nloc = b.st[0], nx = b.st[1];
        if (nloc == 0u) { xcd_barrier_complete(bar, b.x, nloc, nx); b.st[0] = nloc; b.st[1] = nx; }
        const unsigned old = xb_add(&bar[XB_XSUB(b.x)], 1u);
        const unsigned gen = old / nloc;
        if (old + 1u == (gen + 1u) * nloc) {
            __builtin_amdgcn_fence(__ATOMIC_RELEASE, "agent");
            asm volatile("s_waitcnt vmcnt(0)" ::: "memory");
            const unsigned og = xb_add(&bar[XB_TOP], 1u);
            const unsigned tg = og / nx;
            if (og + 1u == (tg + 1u) * nx) xb_add(&bar[XB_TOPGEN], 1u);
            else XB_SPIN(xb_ld(&bar[XB_TOPGEN]) == tg, bar);
            __builtin_amdgcn_fence(__ATOMIC_ACQUIRE, "agent");
            xb_add(&bar[XB_XGEN(b.x)], 1u);
            asm volatile("s_waitcnt vmcnt(0)" ::: "memory");
        } else {
            XB_SPIN(xb_ld(&bar[XB_XGEN(b.x)]) == gen, bar);
            __builtin_amdgcn_fence(__ATOMIC_ACQUIRE, "agent");
            asm volatile("s_waitcnt vmcnt(0)" ::: "memory");
        }
    }
    __syncthreads();
}

struct Frame {
    LAS unsigned char* lds;
    volatile LAS unsigned* MISC;
    unsigned* ctl;
    int tid, lane, wave, vcu, G;
    float* out;
    unsigned char* ws;
};
struct Args { const float* in[19]; float* out; unsigned char* ws; int ph_lo, ph_hi; };
typedef const __attribute__((address_space(4))) Args* KArgs;
__device__ __forceinline__ KArgs kargs() { KArgs p = (KArgs)__builtin_amdgcn_kernarg_segment_ptr(); asm volatile("" : "+s"(p)); return p; }
enum { I_X = 0, I_MEM, I_RELB, I_ATTNG, I_WIN, I_CONVW, I_LAMQK, I_SUBG, I_MEMG, I_WMEMKV, I_WOUT, I_FFNG, I_RW, I_RB, I_WGU, I_BGU, I_WDN, I_BDN, I_FING };

__device__ __forceinline__ void p0_transpose_item(const float* W, int K, int N, bf16_t* WT, int k0, int n0, int drow0, const float* kgain, LAS float* scr, int lane) {
#pragma unroll 8
    for (int i = 0; i < 32; ++i) { const int kk = 2 * i + (lane >> 5); float v = W[(size_t)(k0 + kk) * N + n0 + (lane & 31)]; if (kgain) v *= kgain[k0 + kk]; scr[kk * 33 + (lane & 31)] = v; }
    LDS_WAIT(); asm volatile("" ::: "memory");
    const int c = lane & 7;
#pragma unroll
    for (int j = 0; j < 4; ++j) { const int n = (lane >> 3) + 8 * j; const LAS float* s = scr + (8 * c) * 33 + n;
        u32x4 o; o.x = pk2(s[0 * 33], s[1 * 33]); o.y = pk2(s[2 * 33], s[3 * 33]); o.z = pk2(s[4 * 33], s[5 * 33]); o.w = pk2(s[6 * 33], s[7 * 33]);
        *(u32x4*)(WT + (size_t)(drow0 + n) * K + k0 + 8 * c) = o; }
    LDS_WAIT(); asm volatile("" ::: "memory");
}
__device__ __forceinline__ void rms_row_to_bf16(const float* xrow, const float* g, bf16_t* orow, int lane) {
    const f32x4* xr = (const f32x4*)xrow + lane; const f32x4* gr = (const f32x4*)g + lane;
    f32x4 v[4]; float s = 0.f;
#pragma unroll
    for (int j = 0; j < 4; ++j) { v[j] = xr[64 * j]; s += (v[j].x * v[j].x + v[j].y * v[j].y) + (v[j].z * v[j].z + v[j].w * v[j].w); }
    const float rstd = rsqrtf(wave_sum(s) * (1.f / DM) + EPS);
    unsigned long long* o8 = (unsigned long long*)orow + lane;
#pragma unroll
    for (int j = 0; j < 4; ++j) { const f32x4 gg = gr[64 * j];
        o8[64 * j] = (unsigned long long)pk2(v[j].x * rstd * gg.x, v[j].y * rstd * gg.y) | ((unsigned long long)pk2(v[j].z * rstd * gg.z, v[j].w * rstd * gg.w) << 32); }
}
__device__ __forceinline__ void p0_kvm_tile(Frame& F, int tile, const float* mem, const float* mem_g, const float* w_memkv) {
    const int mt = tile >> 3, ntile = tile & 7, row0 = 64 * mt, col0 = 64 * ntile;
    const int mb = F.wave >> 1, nb0 = (F.wave & 1) * 2, ar = F.lane & 15, kq = F.lane >> 4;
    const float* arow = mem + (size_t)(row0 + mb * 16 + ar) * DM;
    f32x4 acc[2]; acc[0] = (f32x4){0.f, 0.f, 0.f, 0.f}; acc[1] = acc[0];
    float ss = 0.f;
    for (int k0 = 0; k0 < DM; k0 += 32) {
        const int kk = k0 + 8 * kq;
        const f32x4 a0 = *(const f32x4*)(arow + kk), a1 = *(const f32x4*)(arow + kk + 4), g0 = *(const f32x4*)(mem_g + kk), g1 = *(const f32x4*)(mem_g + kk + 4);
        ss += (a0.x * a0.x + a0.y * a0.y) + (a0.z * a0.z + a0.w * a0.w) + (a1.x * a1.x + a1.y * a1.y) + (a1.z * a1.z + a1.w * a1.w);
        const bf16x8 af = pack8(a0 * g0, a1 * g1);
#pragma unroll
        for (int nbi = 0; nbi < 2; ++nbi) { const float* wp = w_memkv + (size_t)kk * 512 + col0 + (nb0 + nbi) * 16 + ar;
            f32x4 b0, b1; b0.x = wp[0]; b0.y = wp[512]; b0.z = wp[1024]; b0.w = wp[1536]; b1.x = wp[2048]; b1.y = wp[2560]; b1.z = wp[3072]; b1.w = wp[3584];
            acc[nbi] = __builtin_amdgcn_mfma_f32_16x16x32_bf16(af, pack8(b0, b1), acc[nbi], 0, 0, 0); }
    }
    ss += __shfl_xor(ss, 16); ss += __shfl_xor(ss, 32);
    const float rstd = rsqrtf(ss * (1.f / DM) + EPS);
    float rs[4];
#pragma unroll
    for (int j = 0; j < 4; ++j) rs[j] = __shfl(rstd, kq * 4 + j);
    bf16_t* kmb = (bf16_t*)(F.ws + WS_KMB); bf16_t* vmt = (bf16_t*)(F.ws + WS_VMT);
#pragma unroll
    for (int nbi = 0; nbi < 2; ++nbi) {
        const int gc = col0 + (nb0 + nbi) * 16 + ar, gr0 = row0 + mb * 16 + kq * 4;
        if (ntile < 4) {
#pragma unroll
            for (int j = 0; j < 4; ++j) kmb[(size_t)(gr0 + j) * 256 + gc] = (bf16_t)(pk2(acc[nbi][j] * rs[j], 0.f) & 0xffffu);
        } else {
            const int d = gc - 256, hm = d >> 6, dd = d & 63, b = gr0 >> 8, m = gr0 & 255;
            u32x2 w; w.x = pk2(acc[nbi][0] * rs[0], acc[nbi][1] * rs[1]); w.y = pk2(acc[nbi][2] * rs[2], acc[nbi][3] * rs[3]);
            *(u32x2*)(vmt + ((size_t)((b * 4 + hm) * 64 + dd)) * 256 + m) = w;
        }
    }
}
__device__ __forceinline__ void p0_prologue(Frame& F) {
    KArgs A = kargs();
    { const float* mem = A->in[I_MEM]; const float* mem_g = A->in[I_MEMG]; const float* w_memkv = A->in[I_WMEMKV];
      for (int tile = blockIdx.x; tile < 256; tile += F.G) p0_kvm_tile(F, tile, mem, mem_g, w_memkv); }
    const float* w_in = A->in[I_WIN]; const float* w_out = A->in[I_WOUT]; const float* w_gu = A->in[I_WGU]; const float* w_dn = A->in[I_WDN]; const float* ffn_g = A->in[I_FFNG];
    LAS float* scr = (LAS float*)(F.lds + F.wave * 16384);
    const int gw = F.vcu * NWAVES + F.wave, NGW = F.G * NWAVES;
    bf16_t* Win_t = (bf16_t*)(F.ws + WS_WIN); bf16_t* Wout_t = (bf16_t*)(F.ws + WS_WOUT);
    bf16_t* Wgu_t = (bf16_t*)((unsigned char*)F.out + OUT_WGU); bf16_t* Wd_t = (bf16_t*)((unsigned char*)F.out + OUT_WD);
    constexpr int I_IN = 16 * 80, I_OUT = 16 * 32, I_GU1 = 16 * 64, I_D1 = 16 * 32;
    constexpr int I_GU = NEXP * I_GU1, I_D = NEXP * I_D1, NITEMS = I_IN + I_OUT + I_GU + I_D;
    for (int it = gw; it < NITEMS; it += NGW) {
        int r = it;
        if (r < I_IN) { const int kb = r / 80, nb = r % 80; p0_transpose_item(w_in, DM, INW, Win_t, 64 * kb, 32 * nb, 32 * nb, nullptr, scr, F.lane); continue; } r -= I_IN;
        if (r < I_OUT) { const int kb = r / 32, nb = r % 32; p0_transpose_item(w_out, DM, DM, Wout_t, 64 * kb, 32 * nb, 32 * nb, nullptr, scr, F.lane); continue; } r -= I_OUT;
        if (r < I_GU) { const int e = r / I_GU1, q = r % I_GU1, kb = q / 64, nb = q % 64, n0 = 32 * nb;
            const int jj = n0 & 1023, drow0 = (jj >> 7) * 256 + (n0 >= 1024 ? 128 : 0) + (jj & 127);
            p0_transpose_item(w_gu + (size_t)e * DM * 2048, DM, 2048, Wgu_t + (size_t)e * 2048 * DM, 64 * kb, n0, drow0, ffn_g, scr, F.lane); continue; } r -= I_GU;
        { const int e = r / I_D1, q = r % I_D1, kb = q / 32, nb = q % 32;
            p0_transpose_item(w_dn + (size_t)e * DEXP * DM, DEXP, DM, Wd_t + (size_t)e * DM * DEXP, 64 * kb, 32 * nb, 32 * nb, nullptr, scr, F.lane); }
    }
    bf16_t* H = (bf16_t*)(F.ws + WS_H);
    { const float* x = A->in[I_X]; const float* attn_g = A->in[I_ATTNG];
      for (int m = gw; m < T; m += NGW) rms_row_to_bf16(x + (size_t)m * DM, attn_g, H + (size_t)m * DM, F.lane); }
    const float* router_w = A->in[I_RW];
    bf16_t* wrh = (bf16_t*)(F.ws + WS_WRHI); bf16_t* wrl = (bf16_t*)(F.ws + WS_WRLO);
    for (int i = (F.vcu * NWAVES + F.wave) * 64 + F.lane; i < NEXP * DM; i += NGW * 64) { const int e = i >> 10, k = i & 1023;
        const float v = ffn_g[k] * router_w[(size_t)k * NEXP + e]; const unsigned hb = pk2(v, 0.f) & 0xffffu; const float hf = __uint_as_float(hb << 16);
        wrh[i] = (bf16_t)hb; wrl[i] = (bf16_t)(pk2(v - hf, 0.f) & 0xffffu); }
}

__device__ __forceinline__ void p2_conv_block(Frame& F, int blk, int tid_, const float* conv_w) {
    const bf16_t* proj = (const bf16_t*)(F.ws + WS_PROJ); bf16_t* mix = (bf16_t*)(F.ws + WS_MIX);
    const int cg = tid_ & 31, tc = tid_ >> 5;
    const int c0 = cg * 8, t0 = blk * 256 + tc * 16, s0 = t0 & (SEQ - 1);
    float w0[8], w1[8], w2[8];
#pragma unroll
    for (int i = 0; i < 8; ++i) { w0[i] = conv_w[c0 + i]; w1[i] = conv_w[256 + c0 + i]; w2[i] = conv_w[512 + c0 + i]; }
    float p2[8], p1[8];
#pragma unroll
    for (int i = 0; i < 8; ++i) { p2[i] = 0.f; p1[i] = 0.f; }
    if (s0 >= 2) {
        const u32x4 ua = *(const u32x4*)(proj + (size_t)(t0 - 2) * INW + COL_U + c0), ca = *(const u32x4*)(proj + (size_t)(t0 - 2) * INW + COL_GC + c0);
        const u32x4 ub = *(const u32x4*)(proj + (size_t)(t0 - 1) * INW + COL_U + c0), cb = *(const u32x4*)(proj + (size_t)(t0 - 1) * INW + COL_GC + c0);
#pragma unroll
        for (int i = 0; i < 4; ++i) { p2[2 * i] = bflo(ua[i]) * bflo(ca[i]); p2[2 * i + 1] = bfhi(ua[i]) * bfhi(ca[i]); p1[2 * i] = bflo(ub[i]) * bflo(cb[i]); p1[2 * i + 1] = bfhi(ub[i]) * bfhi(cb[i]); }
    }
    for (int tt = 0; tt < 16; ++tt) {
        const size_t ro = (size_t)(t0 + tt) * INW;
        const u32x4 uu = *(const u32x4*)(proj + ro + COL_U + c0), cc = *(const u32x4*)(proj + ro + COL_GC + c0), bb = *(const u32x4*)(proj + ro + COL_GB + c0);
        float cur[8], y[8];
#pragma unroll
        for (int i = 0; i < 4; ++i) { cur[2 * i] = bflo(uu[i]) * bflo(cc[i]); cur[2 * i + 1] = bfhi(uu[i]) * bfhi(cc[i]); }
#pragma unroll
        for (int i = 0; i < 4; ++i) { y[2 * i] = bflo(bb[i]) * (w0[2 * i] * p2[2 * i] + w1[2 * i] * p1[2 * i] + w2[2 * i] * cur[2 * i]);
                                       y[2 * i + 1] = bfhi(bb[i]) * (w0[2 * i + 1] * p2[2 * i + 1] + w1[2 * i + 1] * p1[2 * i + 1] + w2[2 * i + 1] * cur[2 * i + 1]); }
        u32x4 o; o.x = pk2(y[0], y[1]); o.y = pk2(y[2], y[3]); o.z = pk2(y[4], y[5]); o.w = pk2(y[6], y[7]);
        *(u32x4*)(mix + (size_t)(t0 + tt) * DM + c0) = o;
#pragma unroll
        for (int i = 0; i < 8; ++i) { p2[i] = p1[i]; p1[i] = cur[i]; }
    }
}
__device__ __forceinline__ void p2_mem_block(Frame& F, int blk, int lane_) {
    const bf16_t* proj = (const bf16_t*)(F.ws + WS_PROJ); bf16_t* mix = (bf16_t*)(F.ws + WS_MIX);
    const bf16_t* kmb = (const bf16_t*)(F.ws + WS_KMB); const bf16_t* vmt = (const bf16_t*)(F.ws + WS_VMT);
    const int r32 = lane_ & 31, hi = lane_ >> 5, b = blk >> 5, tw = blk * 256 + F.wave * 32;
    for (int hm = 0; hm < 4; ++hm) {
        bf16x8 qr[4];
#pragma unroll
        for (int d0 = 0; d0 < 4; ++d0) qr[d0] = *(const bf16x8*)(proj + (size_t)(tw + r32) * INW + COL_QM + hm * 64 + d0 * 16 + hi * 8);
        float mx = -__builtin_inff();
#pragma unroll 1
        for (int kb = 0; kb < 8; ++kb) { f32x16 p = f32x16{};
#pragma unroll
            for (int d0 = 0; d0 < 4; ++d0) { const bf16x8 kf = *(const bf16x8*)(kmb + (size_t)(b * 256 + kb * 32 + r32) * 256 + hm * 64 + d0 * 16 + hi * 8);
                p = __builtin_amdgcn_mfma_f32_32x32x16_bf16(kf, qr[d0], p, 0, 0, 0); }
#pragma unroll
            for (int r = 0; r < 16; ++r) mx = fmaxf(mx, p[r]); }
        mx = fmaxf(mx, __shfl_xor(mx, 32));
        float sum = 0.f;
        f32x16 o[2]; o[0] = f32x16{}; o[1] = f32x16{};
#pragma unroll 1
        for (int kb = 0; kb < 8; ++kb) { f32x16 p = f32x16{};
#pragma unroll
            for (int d0 = 0; d0 < 4; ++d0) { const bf16x8 kf = *(const bf16x8*)(kmb + (size_t)(b * 256 + kb * 32 + r32) * 256 + hm * 64 + d0 * 16 + hi * 8);
                p = __builtin_amdgcn_mfma_f32_32x32x16_bf16(kf, qr[d0], p, 0, 0, 0); }
#pragma unroll
            for (int r = 0; r < 16; ++r) { p[r] = __builtin_amdgcn_exp2f(p[r] - mx); sum += p[r]; }
            bf16x8 pa0, pa1;
#define PK4(P, B_, OUT) do { unsigned a0 = pk2(P[B_+0], P[B_+1]), a1 = pk2(P[B_+2], P[B_+3]); unsigned b0 = pk2(P[B_+4], P[B_+5]), b1 = pk2(P[B_+6], P[B_+7]); \
        auto r0 = __builtin_amdgcn_permlane32_swap(a0, b0, false, false); auto r1 = __builtin_amdgcn_permlane32_swap(a1, b1, false, false); \
        u32x4 w = {r0[0], r1[0], r0[1], r1[1]}; OUT = __builtin_bit_cast(bf16x8, w); } while (0)
            PK4(p, 0, pa0); PK4(p, 8, pa1);
#undef PK4
#pragma unroll
            for (int d0 = 0; d0 < 2; ++d0) { const bf16_t* vp = vmt + ((size_t)((b * 4 + hm) * 64 + d0 * 32 + r32)) * 256 + kb * 32 + hi * 8;
                o[d0] = __builtin_amdgcn_mfma_f32_32x32x16_bf16(pa0, *(const bf16x8*)(vp), o[d0], 0, 0, 0);
                o[d0] = __builtin_amdgcn_mfma_f32_32x32x16_bf16(pa1, *(const bf16x8*)(vp + 16), o[d0], 0, 0, 0); }
        }
        sum += __shfl_xor(sum, 32);
        const float linv = __builtin_amdgcn_rcpf(sum);
#pragma unroll
        for (int r = 0; r < 16; ++r) { const int orow = crow(r, hi); const float li = __shfl(linv, orow);
#pragma unroll
            for (int d0 = 0; d0 < 2; ++d0) { const float v = o[d0][r] * li; const float vn = __shfl_xor(v, 1);
                if ((r32 & 1) == 0) *(unsigned*)(mix + (size_t)(tw + orow) * DM + 768 + hm * 64 + d0 * 32 + r32) = pk2(v, vn); } }
    }
}
__device__ __forceinline__ dattn::Ref da_ref(Frame& F, int n) {
    const int pid = F.vcu + (n >> 2) * F.G, sub = n & 3, blk = sub >> 1, comp = sub & 1, bh = pid >> 4, s = pid & 15, qb = blk ? 31 - s : s, b = bh >> 2, h = bh & 3;
    const bf16_t* proj = (const bf16_t*)(F.ws + WS_PROJ); bf16_t* mix = (bf16_t*)(F.ws + WS_MIX);
    dattn::Ref r;
    r.Q = proj + (size_t)(b * SEQ + qb * 256) * INW + COL_Q + h * 128 + comp * 64;
    r.K = proj + (size_t)(b * SEQ) * INW + COL_K + h * 128 + comp * 64;
    r.V = proj + (size_t)(b * SEQ) * INW + COL_V + h * 128;
    r.O = mix + (size_t)(b * SEQ + qb * 256) * DM + 256 + h * 128;
    r.P0 = qb * 256; r.comp = comp; r.h = h;
    return r;
}
__device__ __forceinline__ void p2_mixers(Frame& F) {
    KArgs A = kargs();
    const float* rel_bias = A->in[I_RELB]; const float* lam_qk = A->in[I_LAMQK]; const float* subln_g = A->in[I_SUBG];
    if (F.tid < 512) { const int h = F.tid >> 7, n = F.tid & 127; int bk;
        if (n < 16) bk = n; else { bk = 16; const int thr[15] = {19, 21, 24, 27, 31, 35, 40, 46, 52, 59, 67, 77, 87, 99, 113};
#pragma unroll
            for (int i = 0; i < 15; ++i) bk += (n >= thr[i]) ? 1 : 0; }
        ((LAS float*)(F.lds + dattn::OFF_TB))[h * 128 + n] = (rel_bias[bk * 4 + h] - rel_bias[31 * 4 + h]) * LOG2E; }
    float d1 = 0.f, d2 = 0.f;
    for (int i = 0; i < 64; ++i) { d1 += lam_qk[i] * lam_qk[64 + i]; d2 += lam_qk[128 + i] * lam_qk[192 + i]; }
    const float lam = __expf(d1) - __expf(d2) + 0.2f;
    __syncthreads();
    const int npairs = F.vcu < 512 ? (512 - F.vcu + F.G - 1) / F.G : 0, total = 4 * npairs;
    if (total > 0) {
        dattn::Seam S; dattn::Ref cur = da_ref(F, 0);
        dattn::prime(cur, F.lds, S);
        for (int n = 0; n < total; ++n) {
            const dattn::Ref nxt = (n + 1 < total) ? da_ref(F, n + 1) : cur;
            dattn::block(cur, nxt, F.lds, S, lam, subln_g);
            cur = nxt;
        }
    }
    int lane2 = (int)__builtin_amdgcn_mbcnt_hi(~0u, __builtin_amdgcn_mbcnt_lo(~0u, 0u)); asm volatile("" : "+v"(lane2));
    const int tid2 = F.wave * 64 + lane2;
    const float* conv_w = kargs()->in[I_CONVW];
    for (int blk = blockIdx.x; blk < T / 256; blk += F.G) { p2_conv_block(F, blk, tid2, conv_w); p2_mem_block(F, blk, lane2); }
}

__device__ __forceinline__ void p4_router(Frame& F) {
    const float* router_b = kargs()->in[I_RB];
    const bf16_t* x1b = (const bf16_t*)(F.ws + WS_X1B); const bf16_t* wrh = (const bf16_t*)(F.ws + WS_WRHI); const bf16_t* wrl = (const bf16_t*)(F.ws + WS_WRLO);
    int* e_tk = (int*)(F.ws + WS_ETK); float* g_tk = (float*)(F.ws + WS_GTK); float* rstd_t = (float*)(F.ws + WS_RSTDT);
    LAS float* lg = (LAS float*)F.lds + F.wave * (32 * 33); LAS unsigned* hist = (LAS unsigned*)(F.lds + 8 * 32 * 33 * 4);
    const int r32 = F.lane & 31, hi = F.lane >> 5;
    for (int blk = blockIdx.x; blk < T / 256; blk += F.G) {
        if (F.tid < 32) hist[F.tid] = 0u;
        __syncthreads();
        const int t0 = blk * 256 + F.wave * 32;
        const bf16_t* xr = x1b + (size_t)(t0 + r32) * DM + hi * 8; const bf16_t* wh = wrh + (size_t)r32 * DM + hi * 8; const bf16_t* wl = wrl + (size_t)r32 * DM + hi * 8;
        f32x16 acc = f32x16{}; float ss = 0.f;
#pragma unroll 4
        for (int k0 = 0; k0 < DM; k0 += 16) {
            const u32x4 xw = *(const u32x4*)(xr + k0); const bf16x8 ah = *(const bf16x8*)(wh + k0), al = *(const bf16x8*)(wl + k0);
#pragma unroll
            for (int i = 0; i < 4; ++i) { const float a = bflo(xw[i]), b = bfhi(xw[i]); ss += a * a + b * b; }
            const bf16x8 xb = __builtin_bit_cast(bf16x8, xw);
            acc = __builtin_amdgcn_mfma_f32_32x32x16_bf16(ah, xb, acc, 0, 0, 0);
            acc = __builtin_amdgcn_mfma_f32_32x32x16_bf16(al, xb, acc, 0, 0, 0);
        }
        ss += __shfl_xor(ss, 32);
        const float rstd = rsqrtf(ss * (1.f / DM) + EPS);
#pragma unroll
        for (int r = 0; r < 16; ++r) { const int e = crow(r, hi); lg[r32 * 33 + e] = acc[r] * rstd + router_b[e]; }
        LDS_WAIT(); asm volatile("" ::: "memory");
        if (F.lane < 32) {
            LAS float* row = lg + F.lane * 33; float tv[4]; int ti[4];
#pragma unroll
            for (int p = 0; p < 4; ++p) { float best = -__builtin_inff(); int bi = 0;
                for (int e = 0; e < NEXP; ++e) { const float v = row[e]; if (v > best) { best = v; bi = e; } }
                tv[p] = best; ti[p] = bi; row[bi] = -__builtin_inff(); LDS_WAIT(); asm volatile("" ::: "memory"); }
            const float w1 = __expf(tv[1] - tv[0]), w2 = __expf(tv[2] - tv[0]), w3 = __expf(tv[3] - tv[0]); const float inv = 1.f / (1.f + w1 + w2 + w3);
            const int t = t0 + F.lane;
            *(int4*)(e_tk + (size_t)t * 4) = make_int4(ti[0], ti[1], ti[2], ti[3]);
            *(float4*)(g_tk + (size_t)t * 4) = make_float4(inv, w1 * inv, w2 * inv, w3 * inv);
            rstd_t[t] = rstd;
#pragma unroll
            for (int p = 0; p < 4; ++p) __hip_atomic_fetch_add(&hist[ti[p]], 1u, __ATOMIC_RELAXED, __HIP_MEMORY_SCOPE_WORKGROUP);
        }
        __syncthreads();
        if (F.tid < 32) __hip_atomic_fetch_add(F.ctl + CW_COUNT + F.tid, hist[F.tid], RLX_AGENT);
        __syncthreads();
    }
}
__device__ __forceinline__ void p5_place(Frame& F) {
    const int* e_tk = (const int*)(F.ws + WS_ETK); const float* g_tk = (const float*)(F.ws + WS_GTK); const float* rstd_t = (const float*)(F.ws + WS_RSTDT);
    int* slot_tk = (int*)(F.ws + WS_SLOTTK); int* tok_slot = (int*)(F.ws + WS_TOKSLOT); float* gate_slot = (float*)(F.ws + WS_GATESLOT); float* rstd_slot = (float*)(F.ws + WS_RSTDSLOT);
    int* rb_e = (int*)(F.ws + WS_RBE);
    LAS int* L = (LAS int*)F.lds;
    if (F.tid < 32) { const int c = (int)__hip_atomic_load(F.ctl + CW_COUNT + F.tid, RLX_AGENT); L[F.tid] = c; L[32 + F.tid] = (c + 255) & ~255; }
    __syncthreads();
    if (F.tid < 32) { int s = 0; for (int e = 0; e < F.tid; ++e) s += L[32 + e]; L[64 + F.tid] = s; }
    __syncthreads();
    for (int blk = blockIdx.x; blk < T / 256; blk += F.G) {
        if (F.tid < 32) { L[96 + F.tid] = 0; L[128 + F.tid] = 0; }
        __syncthreads();
        int ee[2];
#pragma unroll
        for (int j = 0; j < 2; ++j) { const int i = F.tid + 512 * j; ee[j] = e_tk[(size_t)blk * 1024 + i]; __hip_atomic_fetch_add(&L[96 + ee[j]], 1, __ATOMIC_RELAXED, __HIP_MEMORY_SCOPE_WORKGROUP); }
        __syncthreads();
        if (F.tid < 32) L[160 + F.tid] = L[64 + F.tid] + (int)__hip_atomic_fetch_add(F.ctl + CW_CURSOR + F.tid, (unsigned)L[96 + F.tid], RLX_AGENT);
        __syncthreads();
#pragma unroll
        for (int j = 0; j < 2; ++j) { const int i = F.tid + 512 * j; const int r = __hip_atomic_fetch_add(&L[128 + ee[j]], 1, __ATOMIC_RELAXED, __HIP_MEMORY_SCOPE_WORKGROUP); const int pos = L[160 + ee[j]] + r;
            const int t = blk * 256 + (i >> 2);
            tok_slot[pos] = t; gate_slot[pos] = g_tk[(size_t)blk * 1024 + i]; rstd_slot[pos] = rstd_t[t]; slot_tk[(size_t)blk * 1024 + i] = pos; }
        __syncthreads();
    }
    for (int e = blockIdx.x; e < NEXP; e += F.G)
        for (int i = L[e] + F.tid; i < L[32 + e]; i += NWAVES * 64) { const int pos = L[64 + e] + i; tok_slot[pos] = 0; gate_slot[pos] = 0.f; rstd_slot[pos] = 0.f; }
    if (blockIdx.x == 0) {
        const int nrb = (L[64 + 31] + L[32 + 31]) >> 8;
        for (int rb = F.tid; rb < NRB_MAX; rb += NWAVES * 64) { int e = 31; for (int q = 0; q < 32; ++q) { if (rb * 256 >= L[64 + q] && rb * 256 < L[64 + q] + L[32 + q]) e = q; } rb_e[rb] = e; }
        if (F.tid == 0) rb_e[NRB_MAX] = nrb;
    }
}
__device__ __forceinline__ void p9_final(Frame& F) {
    const bf16_t* x1b = (const bf16_t*)(F.ws + WS_X1B); const int* slot_tk = (const int*)(F.ws + WS_SLOTTK);
    const bf16_t* YA = (const bf16_t*)(F.ws + WS_YA); const bf16_t* YB = (const bf16_t*)(F.ws + WS_YB);
    const int gw = F.vcu * NWAVES + F.wave, NGW = F.G * NWAVES;
    const float* final_g = kargs()->in[I_FING];
    for (int t = gw; t < T; t += NGW) {
        const int4 sl = *(const int4*)(slot_tk + (size_t)t * 4);
        const int s4[4] = {sl.x, sl.y, sl.z, sl.w};
        float v[2][8]; float ss = 0.f;
#pragma unroll
        for (int j = 0; j < 2; ++j) { const int c = 8 * F.lane + 512 * j;
            const u32x4 a = *(const u32x4*)(x1b + (size_t)t * DM + c);
#pragma unroll
            for (int i = 0; i < 4; ++i) { v[j][2 * i] = bflo(a[i]); v[j][2 * i + 1] = bfhi(a[i]); }
#pragma unroll
            for (int k = 0; k < 4; ++k) { const int s = s4[k]; const bf16_t* yp = (s < POS_A ? YA + (size_t)s * DM : YB + (size_t)(s - POS_A) * DM) + c;
                const u32x4 y = *(const u32x4*)yp;
#pragma unroll
                for (int i = 0; i < 4; ++i) { v[j][2 * i] += bflo(y[i]); v[j][2 * i + 1] += bfhi(y[i]); } }
#pragma unroll
            for (int i = 0; i < 8; ++i) ss += v[j][i] * v[j][i]; }
        const float rstd = rsqrtf(wave_sum(ss) * (1.f / DM) + EPS);
#pragma unroll
        for (int j = 0; j < 2; ++j) { const int c = 8 * F.lane + 512 * j;
            const f32x4 g0 = *(const f32x4*)(final_g + c), g1 = *(const f32x4*)(final_g + c + 4);
            f32x4 o0, o1; o0.x = v[j][0] * rstd * g0.x; o0.y = v[j][1] * rstd * g0.y; o0.z = v[j][2] * rstd * g0.z; o0.w = v[j][3] * rstd * g0.w;
            o1.x = v[j][4] * rstd * g1.x; o1.y = v[j][5] * rstd * g1.y; o1.z = v[j][6] * rstd * g1.z; o1.w = v[j][7] * rstd * g1.w;
            *(f32x4*)(F.out + (size_t)t * DM + c) = o0; *(f32x4*)(F.out + (size_t)t * DM + c + 4) = o1; }
    }
}

__global__ void __launch_bounds__(NWAVES * 64, 2) hymba_fwd(Args args) {
    extern __shared__ __attribute__((aligned(16))) unsigned char lds[];
    Frame F;
    F.lds = (LAS unsigned char*)lds;
    F.MISC = (volatile LAS unsigned*)(F.lds + MISC_OFF);
    F.tid = threadIdx.x; F.lane = F.tid & 63; F.wave = __builtin_amdgcn_readfirstlane(F.tid >> 6);
    F.G = gridDim.x; { const int bx = blockIdx.x; F.vcu = (F.G % 8 == 0) ? (bx % 8) * (F.G / 8) + bx / 8 : bx; }
    F.ws = args.ws; F.ctl = (unsigned*)(args.ws + WS_CTL); F.out = args.out;
    for (int u = F.tid; u < (LDS_BYTES - LDSCTL_OFF) / 4; u += NWAVES * 64) ((LAS unsigned*)(F.lds + LDSCTL_OFF))[u] = 0u;
    __syncthreads();
    XcdBarrier bar; bar.bar = F.ctl + CW_BAR; bar.x = 0; bar.st = nullptr;
    if (N_LAUNCHES == 1) bar = xcd_barrier_post(F.ctl + CW_BAR, F.MISC + 8);
#define GRID_BAR() do { if (N_LAUNCHES == 1) xcd_barrier(bar); } while (0)
    const int lo = args.ph_lo, hi = args.ph_hi;
#ifndef PH_MASK
#define PH_MASK 0x3ff
#endif
#define IN(k) (((PH_MASK >> (k)) & 1) && lo <= (k) && (k) < hi)
#define BOTH(k) (IN(k) && IN((k) + 1))
    bf16_t* const H = (bf16_t*)(F.ws + WS_H); bf16_t* const PROJ = (bf16_t*)(F.ws + WS_PROJ); bf16_t* const MIX = (bf16_t*)(F.ws + WS_MIX); bf16_t* const X1B = (bf16_t*)(F.ws + WS_X1B);
    bf16_t* const Win_t = (bf16_t*)(F.ws + WS_WIN); bf16_t* const Wout_t = (bf16_t*)(F.ws + WS_WOUT);
    bf16_t* const Wgu_t = (bf16_t*)((unsigned char*)F.out + OUT_WGU); bf16_t* const Wd_t = (bf16_t*)((unsigned char*)F.out + OUT_WD);
    bf16_t* const ACTp = (bf16_t*)(F.ws + WS_ACTA);
    bf16_t* const ACTq = (bf16_t*)(F.ws + WS_ACTB) - (size_t)POS_A * DEXP;
    bf16_t* const YAp = (bf16_t*)(F.ws + WS_YA); bf16_t* const YBq = (bf16_t*)(F.ws + WS_YB) - (size_t)POS_A * DM;
    const int* const tok_slot = (const int*)(F.ws + WS_TOKSLOT); const float* const gate_slot = (const float*)(F.ws + WS_GATESLOT); const float* const rstd_slot = (const float*)(F.ws + WS_RSTDSLOT);
    const int* const rb_e = (const int*)(F.ws + WS_RBE);

    if (IN(0)) { p0_prologue(F); if (BOTH(0)) GRID_BAR(); }
    if (IN(1)) {
        pg8::Gemm g{H, Win_t, DM, 0, nullptr}; pg8::StaticOrder S; S.init(T, INW, F.G, (int)blockIdx.x);
        pg8::EpiProj E{PROJ};
        pg8::gemm_phase<pg8::EpiProj, pg8::StaticOrder, true>(F.lds, g, S, E);
        if (BOTH(1)) GRID_BAR();
    }
    if (IN(2)) { p2_mixers(F); if (BOTH(2)) GRID_BAR(); }
    if (IN(3)) {
        pg8::Gemm g{MIX, Wout_t, DM, 0, nullptr}; pg8::StaticOrder S; S.init(T, DM, F.G, (int)blockIdx.x);
        pg8::EpiX1 E{kargs()->in[I_X], X1B};
        pg8::gemm_phase<pg8::EpiX1, pg8::StaticOrder, true>(F.lds, g, S, E);
        if (BOTH(3)) GRID_BAR();
    }
    if (IN(4)) { p4_router(F); if (BOTH(4)) GRID_BAR(); }
    if (IN(5)) { p5_place(F); if (BOTH(5)) GRID_BAR(); }
    if (IN(6)) {
        pg8::Gemm g{X1B, Wgu_t, DM, (long)2048 * DM, tok_slot}; pg8::GroupOrder S{NRB_A, 0, 8, F.G, (int)blockIdx.x, rb_e};
        pg8::EpiGU E{ACTp, kargs()->in[I_BGU], rstd_slot};
        pg8::gemm_phase<pg8::EpiGU, pg8::GroupOrder, true>(F.lds, g, S, E);
        if (BOTH(6)) GRID_BAR();
    }
    if (IN(7)) {
        const int nrb = rb_e[NRB_MAX];
        { pg8::Gemm g{ACTp, Wd_t, DEXP, (long)DM * DEXP, nullptr}; pg8::GroupOrder S{NRB_A, 0, 4, F.G, (int)blockIdx.x, rb_e};
          pg8::EpiDown E{YAp, kargs()->in[I_BDN], gate_slot};
          pg8::gemm_phase<pg8::EpiDown, pg8::GroupOrder, true>(F.lds, g, S, E); }
        { pg8::Gemm g{X1B, Wgu_t, DM, (long)2048 * DM, tok_slot}; pg8::GroupOrder S{nrb - NRB_A, NRB_A, 8, F.G, (int)blockIdx.x, rb_e};
          pg8::EpiGU E{ACTq, kargs()->in[I_BGU], rstd_slot};
          pg8::gemm_phase<pg8::EpiGU, pg8::GroupOrder, true>(F.lds, g, S, E); }
        if (BOTH(7)) GRID_BAR();
    }
    if (IN(8)) {
        const int nrb = rb_e[NRB_MAX];
        pg8::Gemm g{ACTq, Wd_t, DEXP, (long)DM * DEXP, nullptr}; pg8::GroupOrder S{nrb - NRB_A, NRB_A, 4, F.G, (int)blockIdx.x, rb_e};
        pg8::EpiDown E{YBq, kargs()->in[I_BDN], gate_slot};
        pg8::gemm_phase<pg8::EpiDown, pg8::GroupOrder, true>(F.lds, g, S, E);
        if (BOTH(8)) GRID_BAR();
    }
    if (IN(9)) { p9_final(F); }
#undef IN
#undef BOTH
#undef GRID_BAR
}

extern "C" void kernel_launch(void* const* d_in, const int* in_sizes, int n_in, void* d_out, int out_size, void* d_ws, size_t ws_size, hipStream_t stream) {
    static int grid = 0;
    if (grid == 0) {
        if (n_in != 19 || out_size != T * DM || ws_size < WS_END) { fprintf(stderr, "kernel_launch: unexpected shapes (n_in %d out %d ws %zu)\n", n_in, out_size, ws_size); grid = -1; return; }
        int dev = 0, cus = 0;
        if (hipGetDevice(&dev) != hipSuccess || hipDeviceGetAttribute(&cus, hipDeviceAttributeMultiprocessorCount, dev) != hipSuccess) { grid = -1; return; }
        if (hipFuncSetAttribute((const void*)hymba_fwd, hipFuncAttributeMaxDynamicSharedMemorySize, LDS_BYTES) != hipSuccess) { fprintf(stderr, "kernel_launch: hipFuncSetAttribute failed\n"); grid = -1; return; }
        int per_cu = 0;
        if (hipOccupancyMaxActiveBlocksPerMultiprocessor(&per_cu, (const void*)hymba_fwd, NWAVES * 64, LDS_BYTES) != hipSuccess || per_cu < 1) fprintf(stderr, "kernel_launch: occupancy query reports %d\n", per_cu);
        (void)hipGetLastError();
        grid = cus;
    }
    if (grid < 0) return;
    if (hipMemsetAsync((char*)d_ws + WS_CTL, 0, CTL_ZERO_BYTES, stream) != hipSuccess) return;
    Args a{};
    for (int i = 0; i < 19; ++i) a.in[i] = (const float*)d_in[i];
    a.out = (float*)d_out; a.ws = (unsigned char*)d_ws;
    for (int li = 0; li < N_LAUNCHES; ++li) {
        a.ph_lo = (N_LAUNCHES == 1) ? 0 : li; a.ph_hi = (N_LAUNCHES == 1) ? N_PHASES : li + 1;
        hipLaunchKernelGGL(hymba_fwd, dim3(grid), dim3(NWAVES * 64), LDS_BYTES, stream, a);
    }
}
```

```cpp
#include <hip/hip_runtime.h>
#include <hip/hip_bf16.h>
#include <cstdio>
#include <cstdint>

#ifndef PROBE_REP
#define PROBE_REP 0
#endif
#ifndef MK_N_LAUNCHES
#define MK_N_LAUNCHES 1
#endif

constexpr int BATCH = 8, SEQ = 8192, DM = 1024, T = BATCH * SEQ, INW = 2560, MEML = 256, NEXP = 32, TOPK = 4, DEXP = 1024;
constexpr int COL_U = 0, COL_GB = 256, COL_GC = 512, COL_Q = 768, COL_K = 1280, COL_V = 1792, COL_QM = 2304;
constexpr float EPS = 1e-5f;
constexpr float C2 = 0.125f * 1.4426950408889634f;
constexpr float LOG2E = 1.4426950408889634f;
constexpr int NRB_MAX = 1056;

#define GAS __attribute__((address_space(1)))
#define LAS __attribute__((address_space(3)))
typedef unsigned short bf16_t;
typedef short bf16x8 __attribute__((ext_vector_type(8)));
typedef short s16x4 __attribute__((ext_vector_type(4)));
typedef float f32x4 __attribute__((ext_vector_type(4)));
typedef float f32x16 __attribute__((ext_vector_type(16)));
typedef unsigned u32x4 __attribute__((ext_vector_type(4)));
typedef unsigned u32x2 __attribute__((ext_vector_type(2)));
typedef float f32x2_t __attribute__((ext_vector_type(2)));
typedef __bf16 bf16x2_t __attribute__((ext_vector_type(2)));
typedef GAS unsigned gu32;
#define RLX_AGENT __ATOMIC_RELAXED, __HIP_MEMORY_SCOPE_AGENT
#define LDS_WAIT() asm volatile("s_waitcnt lgkmcnt(0)" ::: "memory")
#define VM_WAIT() asm volatile("s_waitcnt vmcnt(0)" ::: "memory")
#define SBAR() __builtin_amdgcn_sched_barrier(0)

__device__ __forceinline__ unsigned pk2(float lo, float hi) { f32x2_t v = {lo, hi}; bf16x2_t b = __builtin_convertvector(v, bf16x2_t); return __builtin_bit_cast(unsigned, b); }
__device__ __forceinline__ float bflo(unsigned u) { return __uint_as_float(u << 16); }
__device__ __forceinline__ float bfhi(unsigned u) { return __uint_as_float(u & 0xffff0000u); }
__device__ __forceinline__ bf16x8 pack8(f32x4 a, f32x4 b) { u32x4 w = {pk2(a[0], a[1]), pk2(a[2], a[3]), pk2(b[0], b[1]), pk2(b[2], b[3])}; return __builtin_bit_cast(bf16x8, w); }
__device__ __forceinline__ int crow(int r, int hi) { return (r & 3) + 8 * (r >> 2) + 4 * hi; }
__device__ __forceinline__ float wave_sum(float v) {
#pragma unroll
    for (int o = 1; o < 64; o <<= 1) v += __shfl_xor(v, o);
    return v;
}

namespace pg8 {
constexpr int BM = 256, BK = 64, HALF = 128, HTB = HALF * BK * 2  , STAGE_BYTES = 8 * HTB, NXCD = 8, WGM = 8;
__host__ __device__ __forceinline__ int lds_byte(int r, int c) { const int st = (r >> 4) * 2 + (c >> 5), rr = r & 15, cc = c & 31, ob = rr * 64 + cc * 2; return st * 1024 + (ob ^ (((ob >> 9) & 1) << 5)); }
__host__ __device__ __forceinline__ void stage_rc(int b, int& R, int& C) { const int st = b / 1024, sb = b % 1024, swz = sb ^ (((sb >> 9) & 1) << 5); R = (st >> 1) * 16 + swz / 64; C = (st & 1) * 32 + (swz % 64) / 2; }
__host__ __device__ __forceinline__ int perm32(int rho) { const int n = rho >> 4, i = rho & 15; return 8 * (i >> 2) + 4 * n + (i & 3); }

struct Unit { int pm, pn, e; };
struct Gemm { const bf16_t* A; const bf16_t* Bt; int K; long bstride; const int* rowmap; };

struct StaticOrder {
    int nM, nN, nwg, G, c;
    __device__ void init(int M, int N, int G_, int c_) { nM = M / BM; nN = N / BM; nwg = nM * nN; G = G_; c = c_; }
    __device__ bool next(int i, Unit& u) const {
        const long L = (long)i * G + c; if (L >= nwg) return false;
        int wgid = (int)L; { const int q = nwg / NXCD, r = nwg % NXCD, xcd = wgid % NXCD, off = wgid / NXCD; wgid = (xcd < r ? xcd * (q + 1) : r * (q + 1) + (xcd - r) * q) + off; }
        const int nig = WGM * nN, gid = wgid / nig, fm = gid * WGM, gsz = (nM - fm) < WGM ? (nM - fm) : WGM;
        u.pm = fm + ((wgid % nig) % gsz); u.pn = (wgid % nig) / gsz; u.e = 0; return true;
    }
};
struct GroupOrder {
    int nrb, rb0, npn, G, c; const int* rb_e;
    __device__ bool next(int i, Unit& u) const {
        int rbl, pn;
        if ((G & 7) == 0 && ((G >> 3) % npn) == 0) { const int x = c & 7, j = c >> 3, rpx = (G >> 3) / npn; rbl = i * (G / npn) + x * rpx + j / npn; pn = j % npn; }
        else { const long L = (long)i * G + c; rbl = (int)(L / npn); pn = (int)(L % npn); }
        if (rbl >= nrb) return false;
        u.pm = rb0 + rbl; u.pn = pn; u.e = rb_e[u.pm]; return true;
    }
};

typedef int v4i_t __attribute__((ext_vector_type(4)));
typedef int v8i_t __attribute__((ext_vector_type(8)));
template <class Epi, class Sched, bool ALIGN_EPI, bool FP8 = false, int SCW = 0x7f7f7f7f, int SCA = 0x7f7f7f7f>
__device__ __forceinline__ void gemm_phase(LAS unsigned char* lds, const Gemm g, const Sched& S, const Epi& E) {
    const int tid = threadIdx.x, wid = __builtin_amdgcn_readfirstlane(tid >> 6), lane = tid & 63, wr = wid >> 2, wc = wid & 3, fr = lane & 15, fq = lane >> 4;
    const int K = g.K; int nt = K / BK; asm volatile("" : "+s"(nt));
    int Rr[2], Cc[2]; unsigned voffB[2];
#pragma unroll
    for (int i = 0; i < 2; ++i) { int R, C; stage_rc(tid * 16 + i * 8192, R, C); const int Rb = Epi::PERM ? ((R & ~31) + perm32(R & 31)) : R;
        Rr[i] = R; Cc[i] = C; voffB[i] = (unsigned)(Rb * K + C) * 2u; }
    const size_t kstep = (size_t)(BK * 2);
    const size_t hstep = (size_t)HALF * K * 2;
    const size_t tstep = 2 * hstep;
    const unsigned ldsw = (unsigned)wid * 1024u;
    const int aoff = lds_byte(wr * 64 + fr, fq * 8), boff = lds_byte(wc * 32 + fr, fq * 8);
#define PG8_SA(b, h) (((b) * 2 + (h)) * HTB)
#define PG8_SB(b, h) ((4 + (b) * 2 + (h)) * HTB)
#define PG8_STAGE(bufoff, gbase, voff) do { _Pragma("unroll") for (int _i = 0; _i < 2; ++_i) \
        __builtin_amdgcn_global_load_lds((const unsigned*)((const char*)(gbase) + (voff)[_i]), (LAS unsigned*)(lds + (bufoff) + ldsw + _i * 8192), 16, 0, 0); } while (0)
#define PG8_STAGE_A(bufoff, kptr, offs, h) do { _Pragma("unroll") for (int _i = 0; _i < 2; ++_i) \
        __builtin_amdgcn_global_load_lds((const unsigned*)((const char*)(kptr) + (offs)[h][_i]), (LAS unsigned*)(lds + (bufoff) + ldsw + _i * 8192), 16, 0, 0); } while (0)
#define PG8_AOFF(dst, u) do { _Pragma("unroll") for (int _h = 0; _h < 2; ++_h) _Pragma("unroll") for (int _i = 0; _i < 2; ++_i) { const int _row = (u).pm * BM + _h * HALF + Rr[_i]; \
        const int _src = g.rowmap ? g.rowmap[_row] : _row; dst[_h][_i] = (unsigned)(_src * K + Cc[_i]) * 2u; } } while (0)
#define PG8_LDA(dst, b, h) do { _Pragma("unroll") for (int m = 0; m < 4; ++m) _Pragma("unroll") for (int k = 0; k < 2; ++k) dst[m][k] = *(const LAS bf16x8*)(lds + PG8_SA(b, h) + aoff + m * 2048 + k * 1024); } while (0)
#define PG8_LDB(dst, b, h) do { _Pragma("unroll") for (int n = 0; n < 2; ++n) _Pragma("unroll") for (int k = 0; k < 2; ++k) dst[n][k] = *(const LAS bf16x8*)(lds + PG8_SB(b, h) + boff + n * 2048 + k * 1024); } while (0)
#define PG8_CAT(x, y) __builtin_shufflevector(__builtin_bit_cast(v4i_t, x), __builtin_bit_cast(v4i_t, y), 0, 1, 2, 3, 4, 5, 6, 7)
#define PG8_MMA(ai, bj, At, Bt) do { __builtin_amdgcn_s_setprio(1); _Pragma("unroll") for (int m = 0; m < 4; ++m) _Pragma("unroll") for (int n = 0; n < 2; ++n) { \
        if constexpr (FP8) { acc[ai][bj][m][n] = __builtin_amdgcn_mfma_scale_f32_16x16x128_f8f6f4(PG8_CAT(Bt[n][0], Bt[n][1]), PG8_CAT(At[m][0], At[m][1]), acc[ai][bj][m][n], 0, 0, 0, SCW, 0, SCA); } \
        else { _Pragma("unroll") for (int k = 0; k < 2; ++k) acc[ai][bj][m][n] = __builtin_amdgcn_mfma_f32_16x16x32_bf16(Bt[n][k], At[m][k], acc[ai][bj][m][n], 0, 0, 0); } } \
        __builtin_amdgcn_s_setprio(0); } while (0)
#define PG8_WAIT_V(n) asm volatile("s_waitcnt vmcnt(" #n ")" ::: "memory")
#define PG8_WAIT_L(n) asm volatile("s_waitcnt lgkmcnt(" #n ")" ::: "memory")
#define PG8_BAR __builtin_amdgcn_s_barrier()
#define PG8_SCHED __builtin_amdgcn_sched_barrier(0)
    Unit cur, nxt; int ui = 0;
    if (!S.next(0, cur)) return;
    f32x4 acc[2][2][4][2];
#pragma unroll
    for (int a = 0; a < 2; ++a)
#pragma unroll
        for (int b = 0; b < 2; ++b)
#pragma unroll
            for (int m = 0; m < 4; ++m)
#pragma unroll
                for (int n = 0; n < 2; ++n) acc[a][b][m][n] = (f32x4){0.f, 0.f, 0.f, 0.f};
    bf16x8 At[4][2], B0[2][2], B1[2][2];
    unsigned aoc[2][2], aon[2][2];
    PG8_AOFF(aoc, cur);
    const char* Ab = (const char*)g.A;
    const char* cB = (const char*)g.Bt + ((size_t)cur.e * (size_t)g.bstride) * 2 + (size_t)cur.pn * tstep;
    PG8_STAGE(PG8_SB(0, 0), cB, voffB); PG8_STAGE(PG8_SB(0, 1), cB + hstep, voffB); PG8_STAGE_A(PG8_SA(0, 0), Ab, aoc, 0); PG8_STAGE_A(PG8_SA(0, 1), Ab, aoc, 1);
    if (wr == 1) PG8_BAR;
    PG8_WAIT_V(2); PG8_BAR;
    PG8_STAGE(PG8_SB(1, 0), cB + kstep, voffB); PG8_STAGE_A(PG8_SA(1, 0), Ab + kstep, aoc, 0); PG8_STAGE(PG8_SB(1, 1), cB + hstep + kstep, voffB);
    PG8_WAIT_V(6); PG8_BAR;
    for (;;) {
        const bool has_next = S.next(ui + 1, nxt);
        if (has_next) { PG8_AOFF(aon, nxt); }
        else {
#pragma unroll
            for (int h = 0; h < 2; ++h)
#pragma unroll
                for (int i = 0; i < 2; ++i) aon[h][i] = aoc[h][i];
        }
        const char* nB = has_next ? (const char*)g.Bt + ((size_t)nxt.e * (size_t)g.bstride) * 2 + (size_t)nxt.pn * tstep : cB;
#pragma nounroll
        for (int t = 0; t < nt; t += 2) {
            const bool last = (t == nt - 2);
            const char* a1 = Ab + (size_t)(t + 1) * kstep;
            const char* a2 = last ? Ab : Ab + (size_t)(t + 2) * kstep; const char* b2 = last ? nB : cB + (size_t)(t + 2) * kstep;
            const char* a3 = a2 + kstep; const char* b3 = b2 + kstep;
            PG8_LDB(B0, 0, 0); PG8_LDB(B1, 0, 1); PG8_SCHED; PG8_LDA(At, 0, 0); PG8_STAGE_A(PG8_SA(1, 1), a1, aoc, 1);
            if (last) {
#pragma unroll
                for (int h = 0; h < 2; ++h)
#pragma unroll
                    for (int i = 0; i < 2; ++i) aoc[h][i] = aon[h][i]; }
            PG8_WAIT_V(8); PG8_WAIT_L(0); PG8_BAR; PG8_MMA(0, 0, At, B0); PG8_MMA(0, 1, At, B1); PG8_BAR; PG8_SCHED;
            PG8_LDA(At, 0, 1); PG8_STAGE(PG8_SB(0, 0), b2, voffB); PG8_STAGE(PG8_SB(0, 1), b2 + hstep, voffB); PG8_STAGE_A(PG8_SA(0, 0), a2, aoc, 0);
            PG8_WAIT_V(8); PG8_WAIT_L(0); PG8_BAR; PG8_MMA(1, 0, At, B0); PG8_MMA(1, 1, At, B1); PG8_BAR; PG8_SCHED;
            PG8_LDB(B0, 1, 0); PG8_LDB(B1, 1, 1); PG8_SCHED; PG8_LDA(At, 1, 0); PG8_STAGE_A(PG8_SA(0, 1), a2, aoc, 1);
            PG8_WAIT_V(8); PG8_WAIT_L(0); PG8_BAR; PG8_MMA(0, 0, At, B0); PG8_MMA(0, 1, At, B1); PG8_BAR; PG8_SCHED;
            PG8_LDA(At, 1, 1); PG8_STAGE(PG8_SB(1, 0), b3, voffB); PG8_STAGE(PG8_SB(1, 1), b3 + hstep, voffB); PG8_STAGE_A(PG8_SA(1, 0), a3, aoc, 0);
            PG8_WAIT_V(8); PG8_WAIT_L(0); PG8_BAR; PG8_MMA(1, 0, At, B0); PG8_MMA(1, 1, At, B1); PG8_BAR; PG8_SCHED;
        }
        if constexpr (ALIGN_EPI) { if (wr == 0) PG8_BAR; }
        E(acc, cur, wr, wc, fr, fq);
        if (!has_next) break;
#pragma unroll
        for (int a = 0; a < 2; ++a)
#pragma unroll
            for (int b = 0; b < 2; ++b)
#pragma unroll
                for (int m = 0; m < 4; ++m)
#pragma unroll
                    for (int n = 0; n < 2; ++n) acc[a][b][m][n] = (f32x4){0.f, 0.f, 0.f, 0.f};
        cur = nxt; cB = nB; ++ui;
        if constexpr (ALIGN_EPI) { if (wr == 1) PG8_BAR; }
    }
    PG8_WAIT_V(0);
    if constexpr (!ALIGN_EPI) { if (wr == 0) PG8_BAR; }
    PG8_BAR;
#undef PG8_SA
#undef PG8_SB
#undef PG8_STAGE
#undef PG8_STAGE_A
#undef PG8_AOFF
#undef PG8_LDA
#undef PG8_LDB
#undef PG8_MMA
#undef PG8_CAT
#undef PG8_WAIT_V
#undef PG8_WAIT_L
#undef PG8_BAR
#undef PG8_SCHED
}

struct EpiProj {
    static constexpr bool PERM = true;
    bf16_t* O;
    __device__ __forceinline__ void operator()(const f32x4 (&acc)[2][2][4][2], const Unit& u, int wr, int wc, int fr, int fq) const {
        const int row0 = u.pm * BM + wr * 64 + fr, col0 = u.pn * BM + wc * 32 + 8 * fq;
        const float sc = (u.pn == 3 || u.pn == 4 || u.pn == 9) ? C2 : 1.f;
#pragma unroll
        for (int ai = 0; ai < 2; ++ai)
#pragma unroll
            for (int m = 0; m < 4; ++m) { bf16_t* rowp = O + (size_t)(row0 + ai * HALF + m * 16) * INW + col0;
#pragma unroll
                for (int bj = 0; bj < 2; ++bj) { const f32x4 v0 = acc[ai][bj][m][0] * sc, v1 = acc[ai][bj][m][1] * sc;
                    u32x4 w; w.x = pk2(v0[0], v0[1]); w.y = pk2(v0[2], v0[3]); w.z = pk2(v1[0], v1[1]); w.w = pk2(v1[2], v1[3]);
                    *(u32x4*)(rowp + bj * HALF) = w; } }
    }
};
__device__ __forceinline__ unsigned pk4_fp8(float a, float b, float c, float d) { int w = 0; w = __builtin_amdgcn_cvt_pk_fp8_f32(a, b, w, false); w = __builtin_amdgcn_cvt_pk_fp8_f32(c, d, w, true); return (unsigned)w; }
struct EpiX1 {
    static constexpr bool PERM = true;
    const float* X; bf16_t* O; unsigned char* Q8;
    __device__ __forceinline__ void operator()(const f32x4 (&acc)[2][2][4][2], const Unit& u, int wr, int wc, int fr, int fq) const {
        const int row0 = u.pm * BM + wr * 64 + fr, col0 = u.pn * BM + wc * 32 + 8 * fq;
#pragma unroll
        for (int ai = 0; ai < 2; ++ai)
#pragma unroll
            for (int m = 0; m < 4; ++m) { const size_t off = (size_t)(row0 + ai * HALF + m * 16) * DM + col0;
#pragma unroll
                for (int bj = 0; bj < 2; ++bj) { const f32x4 x0 = *(const f32x4*)(X + off + bj * HALF), x1 = *(const f32x4*)(X + off + bj * HALF + 4);
                    const f32x4 v0 = acc[ai][bj][m][0] + x0, v1 = acc[ai][bj][m][1] + x1;
                    u32x4 w; w.x = pk2(v0[0], v0[1]); w.y = pk2(v0[2], v0[3]); w.z = pk2(v1[0], v1[1]); w.w = pk2(v1[2], v1[3]);
                    *(u32x4*)(O + off + bj * HALF) = w;
                    u32x2 q; q.x = pk4_fp8(v0[0], v0[1], v0[2], v0[3]); q.y = pk4_fp8(v1[0], v1[1], v1[2], v1[3]);
                    *(u32x2*)(Q8 + off + bj * HALF) = q; } }
    }
};
struct EpiGU {
    static constexpr bool PERM = true;
    unsigned char* ACT; const float* bias; const float* rstd;
    __device__ __forceinline__ void operator()(const f32x4 (&acc)[2][2][4][2], const Unit& u, int wr, int wc, int fr, int fq) const {
        const int row0 = u.pm * BM + wr * 64 + fr, j0 = u.pn * HALF + wc * 32 + 8 * fq;
        const float* bp = bias + (size_t)u.e * 2048 + j0;
        const f32x4 bg0 = *(const f32x4*)(bp), bg1 = *(const f32x4*)(bp + 4), bu0 = *(const f32x4*)(bp + 1024), bu1 = *(const f32x4*)(bp + 1028);
#pragma unroll
        for (int ai = 0; ai < 2; ++ai)
#pragma unroll
            for (int m = 0; m < 4; ++m) { const int row = row0 + ai * HALF + m * 16; const float rs = rstd[row];
                f32x4 g0 = acc[ai][0][m][0] * rs + bg0, g1 = acc[ai][0][m][1] * rs + bg1, u0 = acc[ai][1][m][0] * rs + bu0, u1 = acc[ai][1][m][1] * rs + bu1;
                float o[8];
#pragma unroll
                for (int i = 0; i < 4; ++i) {
                    { const float gg = fminf(g0[i], 7.f), uu = fminf(fmaxf(u0[i], -7.f), 7.f); const float sg = __builtin_amdgcn_rcpf(1.f + __builtin_amdgcn_exp2f(-1.702f * LOG2E * gg)); o[i] = (uu + 1.f) * gg * sg; }
                    { const float gg = fminf(g1[i], 7.f), uu = fminf(fmaxf(u1[i], -7.f), 7.f); const float sg = __builtin_amdgcn_rcpf(1.f + __builtin_amdgcn_exp2f(-1.702f * LOG2E * gg)); o[4 + i] = (uu + 1.f) * gg * sg; }
                }
                u32x2 w; w.x = pk4_fp8(4.f * o[0], 4.f * o[1], 4.f * o[2], 4.f * o[3]); w.y = pk4_fp8(4.f * o[4], 4.f * o[5], 4.f * o[6], 4.f * o[7]);
                *(u32x2*)(ACT + (size_t)row * DEXP + j0) = w; }
    }
};
struct EpiDown {
    static constexpr bool PERM = true;
    bf16_t* Y; const float* bias; const float* gate;
    __device__ __forceinline__ void operator()(const f32x4 (&acc)[2][2][4][2], const Unit& u, int wr, int wc, int fr, int fq) const {
        const int row0 = u.pm * BM + wr * 64 + fr, col0 = u.pn * BM + wc * 32 + 8 * fq;
        const float* bp = bias + (size_t)u.e * DM + col0;
        f32x4 bv[2][2];
#pragma unroll
        for (int bj = 0; bj < 2; ++bj) { bv[bj][0] = *(const f32x4*)(bp + bj * HALF); bv[bj][1] = *(const f32x4*)(bp + bj * HALF + 4); }
#pragma unroll
        for (int ai = 0; ai < 2; ++ai)
#pragma unroll
            for (int m = 0; m < 4; ++m) { const int row = row0 + ai * HALF + m * 16; const float gs = gate[row];
#pragma unroll
                for (int bj = 0; bj < 2; ++bj) { const f32x4 v0 = (acc[ai][bj][m][0] + bv[bj][0]) * gs, v1 = (acc[ai][bj][m][1] + bv[bj][1]) * gs;
                    u32x4 w; w.x = pk2(v0[0], v0[1]); w.y = pk2(v0[2], v0[3]); w.z = pk2(v1[0], v1[1]); w.w = pk2(v1[2], v1[3]);
                    *(u32x4*)(Y + (size_t)row * DM + col0 + bj * HALF) = w; } }
    }
};
}

namespace dattn {
constexpr int NW = 8, QBLK = 32, KVBLK = 64, QB = 256, PITCH = INW;
constexpr int SHM_V = KVBLK * 128 * 2, SHM_K = KVBLK * 64 * 2;
constexpr int OFF_V = 0, OFF_K = 2 * SHM_V, OFF_WS = OFF_K + 2 * SHM_K, OFF_STASH = OFF_WS + NW * 64 * 4, OFF_TB = OFF_STASH + NW * 8192, LDS_BYTES = OFF_TB + 4 * 128 * 4;
constexpr float THR = 8.f;
__device__ __forceinline__ int v_st(int k, int c) { const int kk = (k & ~0xC) | ((k & 4) << 1) | ((k & 8) >> 1); return ((kk >> 3) * 4 + (c >> 5)) * 512 + ((kk & 7) * 32 + (c & 31)) * 2; }
__device__ __forceinline__ int v_rd_base(int lane) { return ((lane & 3) << 3) | (((lane >> 2) & 3) << 6) | (((lane >> 4) & 1) << 5) | (((lane >> 5) & 1) << 8); }
constexpr int v_rd_off(int d0, int ks, int half) { return d0 * 512 + ks * 4096 + half * 2048; }

struct Ref { unsigned qoff, koff, voff; bf16_t* O; int P0, comp, h; };
typedef __amdgpu_buffer_rsrc_t rsrc_t;
__device__ __forceinline__ bf16x8 bld8(rsrc_t r, unsigned voff, unsigned soff) { return __builtin_bit_cast(bf16x8, __builtin_amdgcn_raw_buffer_load_b128(r, (int)voff, (int)soff, 0)); }
struct Seam { bf16x8 qr[4]; bf16x8 st_v0, st_v1, st_k; };

__device__ __forceinline__ bf16x8 ld8(const bf16_t* p) { return *reinterpret_cast<const bf16x8*>(p); }

__device__ __forceinline__ void bias_mask(f32x16& p0, f32x16& p1, int sdq  , const LAS float* tb) {
    const float NEG = -__builtin_inff();
    int lane_ = (int)__builtin_amdgcn_mbcnt_hi(~0u, __builtin_amdgcn_mbcnt_lo(~0u, 0u));
    int dq = sdq + (lane_ & 31) - 4 * (lane_ >> 5);
    asm volatile("" : "+v"(dq));
#pragma unroll
    for (int r = 0; r < 16; ++r) {
        const int c = (r & 3) + 8 * (r >> 2);
        const int d0 = dq - c, d1 = dq - c - 32;
        const int i0 = d0 < 0 ? 0 : (d0 > 127 ? 127 : d0), i1 = d1 < 0 ? 0 : (d1 > 127 ? 127 : d1);
        const float b0 = tb[i0], b1 = tb[i1];
        p0[r] = d0 < 0 ? NEG : p0[r] + b0;
        p1[r] = d1 < 0 ? NEG : p1[r] + b1;
    }
}
__device__ __forceinline__ void partialSM(f32x16& p0, f32x16& p1, float& m_reg, float& alpha) {
    float pmax = p0[0];
#pragma unroll
    for (int r = 1; r < 16; ++r) pmax = fmaxf(pmax, p0[r]);
#pragma unroll
    for (int r = 0; r < 16; ++r) pmax = fmaxf(pmax, p1[r]);
    { auto rr = __builtin_amdgcn_permlane32_swap(__float_as_uint(pmax), __float_as_uint(pmax), false, false);
      pmax = fmaxf(__uint_as_float(rr[0]), __uint_as_float(rr[1])); }
    float mn;
    if (__builtin_expect(__all((pmax - m_reg) <= THR), 1)) { mn = m_reg; alpha = 1.f; }
    else { mn = fmaxf(m_reg, pmax); alpha = __builtin_amdgcn_exp2f(m_reg - mn); m_reg = mn; }
#pragma unroll
    for (int r = 0; r < 16; ++r) p0[r] = p0[r] - mn;
#pragma unroll
    for (int r = 0; r < 16; ++r) p1[r] = p1[r] - mn;
#pragma unroll
    for (int r = 0; r < 16; ++r) p0[r] = __builtin_amdgcn_exp2f(p0[r]);
}
__device__ __forceinline__ void finishSM(f32x16& p0, f32x16& p1, float alpha, float& l_reg, bf16x8& pa0, bf16x8& pa1, bf16x8& pa2, bf16x8& pa3) {
#pragma unroll
    for (int r = 0; r < 16; ++r) p1[r] = __builtin_amdgcn_exp2f(p1[r]);
    float ps = 0;
#pragma unroll
    for (int r = 0; r < 16; ++r) ps += p0[r];
#pragma unroll
    for (int r = 0; r < 16; ++r) ps += p1[r];
    { auto rr = __builtin_amdgcn_permlane32_swap(__float_as_uint(ps), __float_as_uint(ps), false, false);
      ps = __uint_as_float(rr[0]) + __uint_as_float(rr[1]); }
    l_reg = l_reg * alpha + ps;
#define PK4(P, B_, OUT) do { unsigned a0 = pk2(P[B_+0], P[B_+1]), a1 = pk2(P[B_+2], P[B_+3]);                          \
        unsigned b0 = pk2(P[B_+4], P[B_+5]), b1 = pk2(P[B_+6], P[B_+7]);                                             \
        auto r0 = __builtin_amdgcn_permlane32_swap(a0, b0, false, false); auto r1 = __builtin_amdgcn_permlane32_swap(a1, b1, false, false); \
        u32x4 w = {r0[0], r1[0], r0[1], r1[1]}; OUT = __builtin_bit_cast(bf16x8, w); } while (0)
    PK4(p0, 0, pa0); PK4(p0, 8, pa1); PK4(p1, 0, pa2); PK4(p1, 8, pa3);
#undef PK4
}
template <int KB>
__device__ __forceinline__ void qkt(f32x16& p0, f32x16& p1, const LAS unsigned char* K_lds, int r32, int hi, const bf16x8* qr) {
    p0 = f32x16{}; p1 = f32x16{};
    const int s = (r32 >> 1) & 7;
#pragma unroll
    for (int d0 = 0; d0 < 4; ++d0) {
        const LAS unsigned char* a = K_lds + KB * SHM_K + r32 * 128 + (((2 * d0 + hi) ^ s) << 4);
        const bf16x8 b0 = *(const LAS bf16x8*)(a);
        const bf16x8 b1 = *(const LAS bf16x8*)(a + 32 * 128);
        p0 = __builtin_amdgcn_mfma_f32_32x32x16_bf16(b0, qr[d0], p0, 0, 0, 0);
        p1 = __builtin_amdgcn_mfma_f32_32x32x16_bf16(b1, qr[d0], p1, 0, 0, 0); }
}
template <int VB>
__device__ __forceinline__ void pv_tile(f32x16* o, int vb0, bf16x8 pa0, bf16x8 pa1, bf16x8 pa2, bf16x8 pa3) {
#define TRRD(dst, off) asm volatile("ds_read_b64_tr_b16 %0, %1 offset:%2" : "=&v"(dst) : "v"(vb0), "i"(off) : "memory")
#define PV_D0(d0) do { s16x4 l0, l1, l2, l3, h0, h1, h2, h3; constexpr int b_ = VB * SHM_V + v_rd_off(d0, 0, 0); \
        TRRD(l0, b_); TRRD(h0, b_ + 2048); TRRD(l1, b_ + 4096); TRRD(h1, b_ + 6144); TRRD(l2, b_ + 8192); TRRD(h2, b_ + 10240); TRRD(l3, b_ + 12288); TRRD(h3, b_ + 14336); \
        asm volatile("s_waitcnt lgkmcnt(0)" ::: "memory"); SBAR();   \
        o[d0] = __builtin_amdgcn_mfma_f32_32x32x16_bf16(pa0, (bf16x8){l0[0], l0[1], l0[2], l0[3], h0[0], h0[1], h0[2], h0[3]}, o[d0], 0, 0, 0);   \
        o[d0] = __builtin_amdgcn_mfma_f32_32x32x16_bf16(pa1, (bf16x8){l1[0], l1[1], l1[2], l1[3], h1[0], h1[1], h1[2], h1[3]}, o[d0], 0, 0, 0);   \
        o[d0] = __builtin_amdgcn_mfma_f32_32x32x16_bf16(pa2, (bf16x8){l2[0], l2[1], l2[2], l2[3], h2[0], h2[1], h2[2], h2[3]}, o[d0], 0, 0, 0);   \
        o[d0] = __builtin_amdgcn_mfma_f32_32x32x16_bf16(pa3, (bf16x8){l3[0], l3[1], l3[2], l3[3], h3[0], h3[1], h3[2], h3[3]}, o[d0], 0, 0, 0); } while (0)
    PV_D0(0); PV_D0(1); PV_D0(2); PV_D0(3);
#undef PV_D0
#undef TRRD
}

#define DA_VMW() asm volatile("s_waitcnt vmcnt(0)" ::: "memory")
#define DA_SLOAD(koff_, voff_, k0) do { const unsigned tb_ = (unsigned)(k0) * (PITCH * 2); S.st_v0 = bld8(R, lv, (voff_) + tb_); S.st_v1 = bld8(R, lv, (voff_) + tb_ + 32 * PITCH * 2); \
                                  S.st_k = bld8(R, lk, (koff_) + tb_); } while (0)
#define DA_SWRITE_K(bf) do { *(LAS bf16x8*)(K_lds + (bf) * SHM_K + kws) = S.st_k; } while (0)
#define DA_SWRITE_V(bf) do { *(LAS bf16x8*)(V_lds + (bf) * SHM_V + vst0) = S.st_v0; *(LAS bf16x8*)(V_lds + (bf) * SHM_V + vst1) = S.st_v1; } while (0)

__device__ __forceinline__ void prime(const Ref& cur, LAS unsigned char* lds, Seam& S, rsrc_t R) {
    const int tid = threadIdx.x, wid = __builtin_amdgcn_readfirstlane(tid >> 6), lane = tid & 63, r32 = lane & 31, hi = lane >> 5;
    const int sr = tid >> 4, sc = (tid & 15) * 8, kr = tid >> 3, kc = tid & 7, kws = kr * 128 + ((kc ^ ((kr >> 1) & 7)) << 4);
    const unsigned lv = (unsigned)(sr * PITCH + sc) * 2u, lk = (unsigned)(kr * PITCH + kc * 8) * 2u, lq = (unsigned)((wid * QBLK + r32) * PITCH + hi * 8) * 2u;
    LAS unsigned char* K_lds = lds + OFF_K;
#pragma unroll
    for (int d0 = 0; d0 < 4; ++d0) S.qr[d0] = bld8(R, lq + d0 * 32, cur.qoff);
    DA_SLOAD(cur.koff, cur.voff, 0); DA_VMW(); DA_SWRITE_K(0);
    __syncthreads();
}
__device__ __forceinline__ void block(const Ref& cur, const Ref& nxt, LAS unsigned char* lds, Seam& S, float lam, const float* gsub, rsrc_t R) {
    const int tid = threadIdx.x, wid = __builtin_amdgcn_readfirstlane(tid >> 6), lane = tid & 63, r32 = lane & 31, hi = lane >> 5;
    const int NT = (cur.P0 + QB) / KVBLK;
    const int qlo = cur.P0 + wid * QBLK;
    LAS unsigned char* V_lds = lds + OFF_V; LAS unsigned char* K_lds = lds + OFF_K;
    LAS float* ws = (LAS float*)(lds + OFF_WS) + wid * 64; LAS float* li_l = ws; LAS float* al_l = ws + 32;
    const LAS float* tbh = (const LAS float*)(lds + OFF_TB) + cur.h * 128;
    float m_reg = -1e30f, l_reg = 0; f32x16 o[4] = {};
    const int sr = tid >> 4, sc = (tid & 15) * 8, vst0 = v_st(sr, sc), vst1 = v_st(32 + sr, sc);
    const int kr = tid >> 3, kc = tid & 7, kws = kr * 128 + ((kc ^ ((kr >> 1) & 7)) << 4);
    const int vb0 = (int)(unsigned)(uintptr_t)V_lds + v_rd_base(lane);
    const unsigned lv = (unsigned)(sr * PITCH + sc) * 2u, lk = (unsigned)(kr * PITCH + kc * 8) * 2u;
    const unsigned Kh = cur.koff, Vh = cur.voff;
#define RESC(a) do { if (__any((a) < 1.f)) { if (hi == 0) al_l[r32] = (a); asm volatile("s_waitcnt lgkmcnt(0)" ::: "memory");              \
                     _Pragma("unroll") for (int d_ = 0; d_ < 4; ++d_) _Pragma("unroll") for (int r = 0; r < 16; ++r) o[d_][r] *= al_l[crow(r, hi)]; } } while (0)
#define KBASE(t) ((t) * KVBLK)
#define NEAR(P0_, P1_, t) do { const int kb_ = KBASE(t); if (kb_ >= qlo - 175) bias_mask(P0_, P1_, qlo - kb_, tbh); } while (0)
    f32x16 pA0, pA1, pB0, pB1; float alA, alB; bf16x8 pa0, pa1, pa2, pa3;
    DA_SWRITE_V(0); SBAR();
    DA_SLOAD(Kh, Vh, KBASE(1));
    SBAR(); qkt<0>(pA0, pA1, K_lds, r32, hi, S.qr);
    NEAR(pA0, pA1, 0); partialSM(pA0, pA1, m_reg, alA);
    DA_VMW(); DA_SWRITE_V(1); DA_SWRITE_K(1);
    __syncthreads();
#define HALF_STEP(PX0, PX1, alX, PY0, PY1, alY, t, KB, VB, SB) do {                                                      \
        SBAR(); qkt<KB>(PX0, PX1, K_lds, r32, hi, S.qr);                                                                   \
        finishSM(PY0, PY1, alY, l_reg, pa0, pa1, pa2, pa3); SBAR();                                                           \
        if ((t) + 1 < NT) { DA_SLOAD(Kh, Vh, KBASE((t) + 1)); SBAR(); }                                                        \
        pv_tile<VB>(o, vb0, pa0, pa1, pa2, pa3); NEAR(PX0, PX1, (t)); partialSM(PX0, PX1, m_reg, alX);                      \
        __syncthreads();                                                                                                      \
        if ((t) + 1 < NT) { DA_VMW(); DA_SWRITE_V(SB); DA_SWRITE_K(SB); }                                                     \
        RESC(alX); __syncthreads(); } while (0)
    for (int t = 1; t + 1 < NT; t += 2) {
        HALF_STEP(pB0, pB1, alB, pA0, pA1, alA, t, 1, 0, 0);
        HALF_STEP(pA0, pA1, alA, pB0, pB1, alB, t + 1, 0, 1, 1);
    }
    SBAR(); qkt<1>(pB0, pB1, K_lds, r32, hi, S.qr); SBAR();
    DA_SLOAD(nxt.koff, nxt.voff, 0); SBAR();
    { const unsigned lq = (unsigned)((wid * QBLK + r32) * PITCH + hi * 8) * 2u;
#pragma unroll
      for (int d0 = 0; d0 < 4; ++d0) S.qr[d0] = bld8(R, lq + d0 * 32, nxt.qoff); }
    SBAR();
    finishSM(pA0, pA1, alA, l_reg, pa0, pa1, pa2, pa3); SBAR();
    pv_tile<0>(o, vb0, pa0, pa1, pa2, pa3);
    NEAR(pB0, pB1, NT - 1); partialSM(pB0, pB1, m_reg, alB); __syncthreads(); RESC(alB);
    finishSM(pB0, pB1, alB, l_reg, pa0, pa1, pa2, pa3); SBAR(); pv_tile<1>(o, vb0, pa0, pa1, pa2, pa3);
    SBAR(); asm volatile("s_waitcnt vmcnt(4)" ::: "memory"); DA_SWRITE_K(0); SBAR();
    int lane_e = (int)__builtin_amdgcn_mbcnt_hi(~0u, __builtin_amdgcn_mbcnt_lo(~0u, 0u)); asm volatile("" : "+v"(lane_e));
    const int r32e = lane_e & 31, hie = lane_e >> 5;
    if (hi == 0) li_l[r32] = l_reg; asm volatile("s_waitcnt lgkmcnt(0)" ::: "memory");
    float rli[16];
#pragma unroll
    for (int r = 0; r < 16; ++r) rli[r] = __builtin_amdgcn_rcpf(li_l[crow(r, hi)]);
    LAS unsigned* st = (LAS unsigned*)(lds + OFF_STASH + wid * 8192) + lane_e;
    if (cur.comp == 0) {
#pragma unroll
        for (int r = 0; r < 16; ++r) { st[(2 * r) * 64] = pk2(o[0][r] * rli[r], o[1][r] * rli[r]); st[(2 * r + 1) * 64] = pk2(o[2][r] * rli[r], o[3][r] * rli[r]); }
    } else {
        float ss[16];
#pragma unroll
        for (int r = 0; r < 16; ++r) { const unsigned u0 = st[(2 * r) * 64], u1 = st[(2 * r + 1) * 64];
            const float s2 = lam * rli[r];
            o[0][r] = bflo(u0) - s2 * o[0][r]; o[1][r] = bfhi(u0) - s2 * o[1][r]; o[2][r] = bflo(u1) - s2 * o[2][r]; o[3][r] = bfhi(u1) - s2 * o[3][r];
            ss[r] = (o[0][r] * o[0][r] + o[1][r] * o[1][r]) + (o[2][r] * o[2][r] + o[3][r] * o[3][r]); }
#pragma unroll
        for (int r = 0; r < 16; ++r) {
#pragma unroll
            for (int x = 1; x < 32; x <<= 1) ss[r] += __shfl_xor(ss[r], x);
            ss[r] = rsqrtf(ss[r] * (1.f / 128.f) + EPS) * 0.8f; }
        float gg[4];
#pragma unroll
        for (int d0 = 0; d0 < 4; ++d0) gg[d0] = gsub[d0 * 32 + r32e];
        bf16_t* Ow = cur.O + (size_t)(wid * QBLK) * DM;
#pragma unroll
        for (int r = 0; r < 16; ++r) { const int orow = crow(r, hie);
#pragma unroll
            for (int d0 = 0; d0 < 4; ++d0) { const float v = o[d0][r] * ss[r] * gg[d0]; const float vn = __shfl_xor(v, 1);
                if ((r32e & 1) == 0) *(unsigned*)(Ow + (size_t)orow * DM + d0 * 32 + r32e) = pk2(v, vn); } }
    }
    __syncthreads();
#undef RESC
#undef KBASE
#undef NEAR
#undef HALF_STEP
}
#undef DA_VMW
#undef DA_SLOAD
#undef DA_SWRITE_K
#undef DA_SWRITE_V
}

constexpr int NWAVES = 8;
constexpr int N_LAUNCHES = MK_N_LAUNCHES;
constexpr int N_PHASES = 9;
static_assert(N_LAUNCHES == 1 || N_LAUNCHES == N_PHASES, "MK_N_LAUNCHES is 1 or 9");

constexpr size_t MiB = 1u << 20;
constexpr size_t WS_CTL = 0, CTL_ZERO_BYTES = 1 * MiB;
constexpr size_t WS_ETK = 1 * MiB, WS_GTK = 2 * MiB, WS_RSTDT = 3 * MiB, WS_SLOTTK = 4 * MiB, WS_TOKSLOT = 5 * MiB, WS_GATESLOT = 7 * MiB, WS_RSTDSLOT = 9 * MiB, WS_RBE = 11 * MiB;
constexpr size_t WS_WRHI = 12 * MiB, WS_WRLO = 12 * MiB + 65536, WS_KMB = 13 * MiB, WS_VMT = 14 * MiB;
constexpr size_t WS_WIN = 16 * MiB, WS_WOUT = 21 * MiB, WS_X1B = 24 * MiB, WS_X1Q = 152 * MiB;
constexpr size_t WS_BIG = 216 * MiB;
constexpr size_t WS_H = WS_BIG, WS_PROJ = WS_BIG + 128 * MiB, WS_MIX = WS_BIG + 448 * MiB;
constexpr size_t WS_ACTQ = WS_BIG, WS_Y = WS_BIG + 264 * MiB;
constexpr size_t WS_END = WS_BIG + 792 * MiB;
static_assert(WS_END <= 1024 * MiB, "d_ws map");
constexpr size_t OUT_WGU = 0, OUT_WD = 64 * MiB;
constexpr int CW_BAR = 4096, CW_COUNT = 1024, CW_CURSOR = 2048;
constexpr int RING_BYTES = 131072, LDSCTL_OFF = RING_BYTES, MISC_OFF = LDSCTL_OFF + 320, LDS_BYTES = 147456;
static_assert(dattn::LDS_BYTES <= RING_BYTES, "attention scratch");

#define XB_TMO      128
#define XB_XCNT(j)  (256  + 64 * (j))
#define XB_XSUB(j)  (1280 + 64 * (j))
#define XB_XGEN(j)  (2304 + 64 * (j))
#define XB_TOP      3328
#define XB_TOPGEN   3392
#define XCD_BAR_WORDS 3456
#define XB_SPIN_CAP (1u << 18)
__device__ __forceinline__ unsigned xb_ld(unsigned* p)              { return __hip_atomic_load(p, __ATOMIC_RELAXED, __HIP_MEMORY_SCOPE_AGENT); }
__device__ __forceinline__ unsigned xb_add(unsigned* p, unsigned v) { return __hip_atomic_fetch_add(p, v, __ATOMIC_RELAXED, __HIP_MEMORY_SCOPE_AGENT); }
__device__ __forceinline__ unsigned xb_xcc_id() { return (unsigned)__builtin_amdgcn_s_getreg((3 << 11) | 20) & 0xFu; }
#define XB_SPIN(cond, bar) do { unsigned _sp = 0; while (cond) { __builtin_amdgcn_s_sleep(1); \
    if ((++_sp & 255u) == 0u) { if (xb_ld(&(bar)[XB_TMO])) break; if (_sp > XB_SPIN_CAP) { atomicAdd(&(bar)[XB_TMO], 1u); break; } } } } while (0)
struct XcdBarrier { unsigned* bar; unsigned x; volatile LAS unsigned* st; };
__device__ __forceinline__ XcdBarrier xcd_barrier_post(unsigned* bar, volatile LAS unsigned* st) {
    XcdBarrier b; b.bar = bar; b.x = xb_xcc_id(); b.st = st;
    if (threadIdx.x == 0) (void)xb_add(&bar[XB_XCNT(b.x)], 1u);
    return b;
}
__device__ __forceinline__ void xcd_barrier_complete(unsigned* bar, unsigned x, unsigned& nloc, unsigned& nx) {
    const unsigned G = gridDim.x * gridDim.y * gridDim.z;
    unsigned sum, cnt, mine, sp = 0u;
    for (;;) {
        sum = 0u; cnt = 0u; mine = 0u;
#pragma unroll
        for (unsigned j = 0; j < 16; ++j) { const unsigned c = xb_ld(&bar[XB_XCNT(j)]); sum += c; cnt += (c > 0u) ? 1u : 0u; mine = (j == x) ? c : mine; }
        if (sum == G) break;
        __builtin_amdgcn_s_sleep(1);
        if ((++sp & 255u) == 0u) { if (xb_ld(&bar[XB_TMO])) break; if (sp > XB_SPIN_CAP) { atomicAdd(&bar[XB_TMO], 1u); break; } }
    }
    nloc = mine > 0u ? mine : 1u; nx = cnt > 0u ? cnt : 1u;
}
__device__ __forceinline__ void xcd_barrier(const XcdBarrier& b) {
    asm volatile("s_waitcnt vmcnt(0)" ::: "memory");
    __syncthreads();
    if (threadIdx.x == 0) {
        unsigned* bar = b.bar;
        __builtin_amdgcn_s_waitcnt(0);
        unsigned nloc = b.st[0], nx = b.st[1];
        if (nloc == 0u) { xcd_barrier_complete(bar, b.x, nloc, nx); b.st[0] = nloc; b.st[1] = nx; }
        const unsigned old = xb_add(&bar[XB_XSUB(b.x)], 1u);
        const unsigned gen = old / nloc;
        if (old + 1u == (gen + 1u) * nloc) {
            __builtin_amdgcn_fence(__ATOMIC_RELEASE, "agent");
            asm volatile("s_waitcnt vmcnt(0)" ::: "memory");
            const unsigned og = xb_add(&bar[XB_TOP], 1u);
            const unsigned tg = og / nx;
            if (og + 1u == (tg + 1u) * nx) xb_add(&bar[XB_TOPGEN], 1u);
            else XB_SPIN(xb_ld(&bar[XB_TOPGEN]) == tg, bar);
            __builtin_amdgcn_fence(__ATOMIC_ACQUIRE, "agent");
            xb_add(&bar[XB_XGEN(b.x)], 1u);
            asm volatile("s_waitcnt vmcnt(0)" ::: "memory");
        } else {
            XB_SPIN(xb_ld(&bar[XB_XGEN(b.x)]) == gen, bar);
            __builtin_amdgcn_fence(__ATOMIC_ACQUIRE, "agent");
            asm volatile("s_waitcnt vmcnt(0)" ::: "memory");
        }
    }
    __syncthreads();
}

struct Frame {
    LAS unsigned char* lds;
    volatile LAS unsigned* MISC;
    unsigned* ctl;
    int tid, lane, wave, vcu, G;
    float* out;
    unsigned char* ws;
};
struct Args { const float* in[19]; float* out; unsigned char* ws; int ph_lo, ph_hi; };
typedef const __attribute__((address_space(4))) Args* KArgs;
__device__ __forceinline__ KArgs kargs() { KArgs p = (KArgs)__builtin_amdgcn_kernarg_segment_ptr(); asm volatile("" : "+s"(p)); return p; }
enum { I_X = 0, I_MEM, I_RELB, I_ATTNG, I_WIN, I_CONVW, I_LAMQK, I_SUBG, I_MEMG, I_WMEMKV, I_WOUT, I_FFNG, I_RW, I_RB, I_WGU, I_BGU, I_WDN, I_BDN, I_FING };

__device__ __forceinline__ void p0_transpose_item(const float* W, int K, int N, bf16_t* WT, int k0, int n0, int drow0, const float* kgain, LAS float* scr, int lane) {
#pragma unroll 8
    for (int i = 0; i < 32; ++i) { const int kk = 2 * i + (lane >> 5); float v = W[(size_t)(k0 + kk) * N + n0 + (lane & 31)]; if (kgain) v *= kgain[k0 + kk]; scr[kk * 33 + (lane & 31)] = v; }
    LDS_WAIT(); asm volatile("" ::: "memory");
    const int c = lane & 7;
#pragma unroll
    for (int j = 0; j < 4; ++j) { const int n = (lane >> 3) + 8 * j; const LAS float* s = scr + (8 * c) * 33 + n;
        u32x4 o; o.x = pk2(s[0 * 33], s[1 * 33]); o.y = pk2(s[2 * 33], s[3 * 33]); o.z = pk2(s[4 * 33], s[5 * 33]); o.w = pk2(s[6 * 33], s[7 * 33]);
        *(u32x4*)(WT + (size_t)(drow0 + n) * K + k0 + 8 * c) = o; }
    LDS_WAIT(); asm volatile("" ::: "memory");
}
__device__ __forceinline__ void rms_row_to_bf16(const float* xrow, const float* g, bf16_t* orow, int lane) {
    const f32x4* xr = (const f32x4*)xrow + lane; const f32x4* gr = (const f32x4*)g + lane;
    f32x4 v[4]; float s = 0.f;
#pragma unroll
    for (int j = 0; j < 4; ++j) { v[j] = xr[64 * j]; s += (v[j].x * v[j].x + v[j].y * v[j].y) + (v[j].z * v[j].z + v[j].w * v[j].w); }
    const float rstd = rsqrtf(wave_sum(s) * (1.f / DM) + EPS);
    unsigned long long* o8 = (unsigned long long*)orow + lane;
#pragma unroll
    for (int j = 0; j < 4; ++j) { const f32x4 gg = gr[64 * j];
        o8[64 * j] = (unsigned long long)pk2(v[j].x * rstd * gg.x, v[j].y * rstd * gg.y) | ((unsigned long long)pk2(v[j].z * rstd * gg.z, v[j].w * rstd * gg.w) << 32); }
}
__device__ __forceinline__ void p0_kvm_tile(Frame& F, int tile, const float* mem, const float* mem_g, const float* w_memkv) {
    const int mt = tile >> 3, ntile = tile & 7, row0 = 64 * mt, col0 = 64 * ntile;
    const int mb = F.wave >> 1, nb0 = (F.wave & 1) * 2, ar = F.lane & 15, kq = F.lane >> 4;
    const float* arow = mem + (size_t)(row0 + mb * 16 + ar) * DM;
    f32x4 acc[2]; acc[0] = (f32x4){0.f, 0.f, 0.f, 0.f}; acc[1] = acc[0];
    float ss = 0.f;
    for (int k0 = 0; k0 < DM; k0 += 32) {
        const int kk = k0 + 8 * kq;
        const f32x4 a0 = *(const f32x4*)(arow + kk), a1 = *(const f32x4*)(arow + kk + 4), g0 = *(const f32x4*)(mem_g + kk), g1 = *(const f32x4*)(mem_g + kk + 4);
        ss += (a0.x * a0.x + a0.y * a0.y) + (a0.z * a0.z + a0.w * a0.w) + (a1.x * a1.x + a1.y * a1.y) + (a1.z * a1.z + a1.w * a1.w);
        const bf16x8 af = pack8(a0 * g0, a1 * g1);
#pragma unroll
        for (int nbi = 0; nbi < 2; ++nbi) { const float* wp = w_memkv + (size_t)kk * 512 + col0 + (nb0 + nbi) * 16 + ar;
            f32x4 b0, b1; b0.x = wp[0]; b0.y = wp[512]; b0.z = wp[1024]; b0.w = wp[1536]; b1.x = wp[2048]; b1.y = wp[2560]; b1.z = wp[3072]; b1.w = wp[3584];
            acc[nbi] = __builtin_amdgcn_mfma_f32_16x16x32_bf16(af, pack8(b0, b1), acc[nbi], 0, 0, 0); }
    }
    ss += __shfl_xor(ss, 16); ss += __shfl_xor(ss, 32);
    const float rstd = rsqrtf(ss * (1.f / DM) + EPS);
    float rs[4];
#pragma unroll
    for (int j = 0; j < 4; ++j) rs[j] = __shfl(rstd, kq * 4 + j);
    bf16_t* kmb = (bf16_t*)(F.ws + WS_KMB); bf16_t* vmt = (bf16_t*)(F.ws + WS_VMT);
#pragma unroll
    for (int nbi = 0; nbi < 2; ++nbi) {
        const int gc = col0 + (nb0 + nbi) * 16 + ar, gr0 = row0 + mb * 16 + kq * 4;
        if (ntile < 4) {
#pragma unroll
            for (int j = 0; j < 4; ++j) kmb[(size_t)(gr0 + j) * 256 + gc] = (bf16_t)(pk2(acc[nbi][j] * rs[j], 0.f) & 0xffffu);
        } else {
            const int d = gc - 256, hm = d >> 6, dd = d & 63, b = gr0 >> 8, m = gr0 & 255;
            u32x2 w; w.x = pk2(acc[nbi][0] * rs[0], acc[nbi][1] * rs[1]); w.y = pk2(acc[nbi][2] * rs[2], acc[nbi][3] * rs[3]);
            *(u32x2*)(vmt + ((size_t)((b * 4 + hm) * 64 + dd)) * 256 + m) = w;
        }
    }
}
__device__ __forceinline__ void p0_transpose_item_fp8(const float* W, int K, int N, unsigned char* WT, int k0, int n0, int drow0, const float* kgain, float scale, LAS float* scr, int lane) {
#pragma unroll 8
    for (int i = 0; i < 32; ++i) { const int kk = 2 * i + (lane >> 5); float v = W[(size_t)(k0 + kk) * N + n0 + (lane & 31)] * scale; if (kgain) v *= kgain[k0 + kk]; scr[kk * 33 + (lane & 31)] = v; }
    LDS_WAIT(); asm volatile("" ::: "memory");
    const int c = lane & 7;
#pragma unroll
    for (int j = 0; j < 4; ++j) { const int n = (lane >> 3) + 8 * j; const LAS float* s = scr + (8 * c) * 33 + n;
        u32x2 o; o.x = pg8::pk4_fp8(s[0 * 33], s[1 * 33], s[2 * 33], s[3 * 33]); o.y = pg8::pk4_fp8(s[4 * 33], s[5 * 33], s[6 * 33], s[7 * 33]);
        *(u32x2*)(WT + (size_t)(drow0 + n) * K + k0 + 8 * c) = o; }
    LDS_WAIT(); asm volatile("" ::: "memory");
}
__device__ __forceinline__ void p0_prologue(Frame& F) {
    KArgs A = kargs();
    { const float* mem = A->in[I_MEM]; const float* mem_g = A->in[I_MEMG]; const float* w_memkv = A->in[I_WMEMKV];
      for (int tile = blockIdx.x; tile < 256; tile += F.G) p0_kvm_tile(F, tile, mem, mem_g, w_memkv); }
    const float* w_in = A->in[I_WIN]; const float* w_out = A->in[I_WOUT]; const float* w_gu = A->in[I_WGU]; const float* w_dn = A->in[I_WDN]; const float* ffn_g = A->in[I_FFNG];
    LAS float* scr = (LAS float*)(F.lds + F.wave * 16384);
    const int gw = F.vcu * NWAVES + F.wave, NGW = F.G * NWAVES;
    bf16_t* Win_t = (bf16_t*)(F.ws + WS_WIN); bf16_t* Wout_t = (bf16_t*)(F.ws + WS_WOUT);
    unsigned char* Wgu_q = (unsigned char*)F.out + OUT_WGU; unsigned char* Wd_q = (unsigned char*)F.out + OUT_WD;
    constexpr int I_IN = 16 * 80, I_OUT = 16 * 32, I_GU1 = 16 * 64, I_D1 = 16 * 32;
    constexpr int I_GU = NEXP * I_GU1, I_D = NEXP * I_D1, NITEMS = I_IN + I_OUT + I_GU + I_D;
    for (int it = gw; it < NITEMS; it += NGW) {
        int r = it;
        if (r < I_IN) { const int kb = r / 80, nb = r % 80; p0_transpose_item(w_in, DM, INW, Win_t, 64 * kb, 32 * nb, 32 * nb, nullptr, scr, F.lane); continue; } r -= I_IN;
        if (r < I_OUT) { const int kb = r / 32, nb = r % 32; p0_transpose_item(w_out, DM, DM, Wout_t, 64 * kb, 32 * nb, 32 * nb, nullptr, scr, F.lane); continue; } r -= I_OUT;
        if (r < I_GU) { const int e = r / I_GU1, q = r % I_GU1, kb = q / 64, nb = q % 64, n0 = 32 * nb;
            const int jj = n0 & 1023, drow0 = (jj >> 7) * 256 + (n0 >= 1024 ? 128 : 0) + (jj & 127);
            p0_transpose_item_fp8(w_gu + (size_t)e * DM * 2048, DM, 2048, Wgu_q + (size_t)e * 2048 * DM, 64 * kb, n0, drow0, ffn_g, 64.f, scr, F.lane); continue; } r -= I_GU;
        { const int e = r / I_D1, q = r % I_D1, kb = q / 32, nb = q % 32;
            p0_transpose_item_fp8(w_dn + (size_t)e * DEXP * DM, DEXP, DM, Wd_q + (size_t)e * DM * DEXP, 64 * kb, 32 * nb, 32 * nb, nullptr, 64.f, scr, F.lane); }
    }
    bf16_t* H = (bf16_t*)(F.ws + WS_H);
    { const float* x = A->in[I_X]; const float* attn_g = A->in[I_ATTNG];
      for (int m = gw; m < T; m += NGW) rms_row_to_bf16(x + (size_t)m * DM, attn_g, H + (size_t)m * DM, F.lane); }
    const float* router_w = A->in[I_RW];
    bf16_t* wrh = (bf16_t*)(F.ws + WS_WRHI); bf16_t* wrl = (bf16_t*)(F.ws + WS_WRLO);
    for (int i = (F.vcu * NWAVES + F.wave) * 64 + F.lane; i < NEXP * DM; i += NGW * 64) { const int e = i >> 10, k = i & 1023;
        const float v = ffn_g[k] * router_w[(size_t)k * NEXP + e]; const unsigned hb = pk2(v, 0.f) & 0xffffu; const float hf = __uint_as_float(hb << 16);
        wrh[i] = (bf16_t)hb; wrl[i] = (bf16_t)(pk2(v - hf, 0.f) & 0xffffu); }
}

__device__ __forceinline__ void p2_conv_block(Frame& F, int blk, int tid_, const float* conv_w) {
    const bf16_t* proj = (const bf16_t*)(F.ws + WS_PROJ); bf16_t* mix = (bf16_t*)(F.ws + WS_MIX);
    const int cg = tid_ & 31, tc = tid_ >> 5;
    const int c0 = cg * 8, t0 = blk * 256 + tc * 16, s0 = t0 & (SEQ - 1);
    float w0[8], w1[8], w2[8];
#pragma unroll
    for (int i = 0; i < 8; ++i) { w0[i] = conv_w[c0 + i]; w1[i] = conv_w[256 + c0 + i]; w2[i] = conv_w[512 + c0 + i]; }
    float p2[8], p1[8];
#pragma unroll
    for (int i = 0; i < 8; ++i) { p2[i] = 0.f; p1[i] = 0.f; }
    if (s0 >= 2) {
        const u32x4 ua = *(const u32x4*)(proj + (size_t)(t0 - 2) * INW + COL_U + c0), ca = *(const u32x4*)(proj + (size_t)(t0 - 2) * INW + COL_GC + c0);
        const u32x4 ub = *(const u32x4*)(proj + (size_t)(t0 - 1) * INW + COL_U + c0), cb = *(const u32x4*)(proj + (size_t)(t0 - 1) * INW + COL_GC + c0);
#pragma unroll
        for (int i = 0; i < 4; ++i) { p2[2 * i] = bflo(ua[i]) * bflo(ca[i]); p2[2 * i + 1] = bfhi(ua[i]) * bfhi(ca[i]); p1[2 * i] = bflo(ub[i]) * bflo(cb[i]); p1[2 * i + 1] = bfhi(ub[i]) * bfhi(cb[i]); }
    }
    for (int tt = 0; tt < 16; ++tt) {
        const size_t ro = (size_t)(t0 + tt) * INW;
        const u32x4 uu = *(const u32x4*)(proj + ro + COL_U + c0), cc = *(const u32x4*)(proj + ro + COL_GC + c0), bb = *(const u32x4*)(proj + ro + COL_GB + c0);
        float cur[8], y[8];
#pragma unroll
        for (int i = 0; i < 4; ++i) { cur[2 * i] = bflo(uu[i]) * bflo(cc[i]); cur[2 * i + 1] = bfhi(uu[i]) * bfhi(cc[i]); }
#pragma unroll
        for (int i = 0; i < 4; ++i) { y[2 * i] = bflo(bb[i]) * (w0[2 * i] * p2[2 * i] + w1[2 * i] * p1[2 * i] + w2[2 * i] * cur[2 * i]);
                                       y[2 * i + 1] = bfhi(bb[i]) * (w0[2 * i + 1] * p2[2 * i + 1] + w1[2 * i + 1] * p1[2 * i + 1] + w2[2 * i + 1] * cur[2 * i + 1]); }
        u32x4 o; o.x = pk2(y[0], y[1]); o.y = pk2(y[2], y[3]); o.z = pk2(y[4], y[5]); o.w = pk2(y[6], y[7]);
        *(u32x4*)(mix + (size_t)(t0 + tt) * DM + c0) = o;
#pragma unroll
        for (int i = 0; i < 8; ++i) { p2[i] = p1[i]; p1[i] = cur[i]; }
    }
}
__device__ __forceinline__ void p2_mem_block(Frame& F, int blk, int lane_) {
    const bf16_t* proj = (const bf16_t*)(F.ws + WS_PROJ); bf16_t* mix = (bf16_t*)(F.ws + WS_MIX);
    const bf16_t* kmb = (const bf16_t*)(F.ws + WS_KMB); const bf16_t* vmt = (const bf16_t*)(F.ws + WS_VMT);
    const int r32 = lane_ & 31, hi = lane_ >> 5, b = blk >> 5, tw = blk * 256 + F.wave * 32;
    for (int hm = 0; hm < 4; ++hm) {
        bf16x8 qr[4];
#pragma unroll
        for (int d0 = 0; d0 < 4; ++d0) qr[d0] = *(const bf16x8*)(proj + (size_t)(tw + r32) * INW + COL_QM + hm * 64 + d0 * 16 + hi * 8);
        float mx = -__builtin_inff();
#pragma unroll 1
        for (int kb = 0; kb < 8; ++kb) { f32x16 p = f32x16{};
#pragma unroll
            for (int d0 = 0; d0 < 4; ++d0) { const bf16x8 kf = *(const bf16x8*)(kmb + (size_t)(b * 256 + kb * 32 + r32) * 256 + hm * 64 + d0 * 16 + hi * 8);
                p = __builtin_amdgcn_mfma_f32_32x32x16_bf16(kf, qr[d0], p, 0, 0, 0); }
#pragma unroll
            for (int r = 0; r < 16; ++r) mx = fmaxf(mx, p[r]); }
        mx = fmaxf(mx, __shfl_xor(mx, 32));
        float sum = 0.f;
        f32x16 o[2]; o[0] = f32x16{}; o[1] = f32x16{};
#pragma unroll 1
        for (int kb = 0; kb < 8; ++kb) { f32x16 p = f32x16{};
#pragma unroll
            for (int d0 = 0; d0 < 4; ++d0) { const bf16x8 kf = *(const bf16x8*)(kmb + (size_t)(b * 256 + kb * 32 + r32) * 256 + hm * 64 + d0 * 16 + hi * 8);
                p = __builtin_amdgcn_mfma_f32_32x32x16_bf16(kf, qr[d0], p, 0, 0, 0); }
#pragma unroll
            for (int r = 0; r < 16; ++r) { p[r] = __builtin_amdgcn_exp2f(p[r] - mx); sum += p[r]; }
            bf16x8 pa0, pa1;
#define PK4(P, B_, OUT) do { unsigned a0 = pk2(P[B_+0], P[B_+1]), a1 = pk2(P[B_+2], P[B_+3]); unsigned b0 = pk2(P[B_+4], P[B_+5]), b1 = pk2(P[B_+6], P[B_+7]); \
        auto r0 = __builtin_amdgcn_permlane32_swap(a0, b0, false, false); auto r1 = __builtin_amdgcn_permlane32_swap(a1, b1, false, false); \
        u32x4 w = {r0[0], r1[0], r0[1], r1[1]}; OUT = __builtin_bit_cast(bf16x8, w); } while (0)
            PK4(p, 0, pa0); PK4(p, 8, pa1);
#undef PK4
#pragma unroll
            for (int d0 = 0; d0 < 2; ++d0) { const bf16_t* vp = vmt + ((size_t)((b * 4 + hm) * 64 + d0 * 32 + r32)) * 256 + kb * 32 + hi * 8;
                o[d0] = __builtin_amdgcn_mfma_f32_32x32x16_bf16(pa0, *(const bf16x8*)(vp), o[d0], 0, 0, 0);
                o[d0] = __builtin_amdgcn_mfma_f32_32x32x16_bf16(pa1, *(const bf16x8*)(vp + 16), o[d0], 0, 0, 0); }
        }
        sum += __shfl_xor(sum, 32);
        const float linv = __builtin_amdgcn_rcpf(sum);
#pragma unroll
        for (int r = 0; r < 16; ++r) { const int orow = crow(r, hi); const float li = __shfl(linv, orow);
#pragma unroll
            for (int d0 = 0; d0 < 2; ++d0) { const float v = o[d0][r] * li; const float vn = __shfl_xor(v, 1);
                if ((r32 & 1) == 0) *(unsigned*)(mix + (size_t)(tw + orow) * DM + 768 + hm * 64 + d0 * 32 + r32) = pk2(v, vn); } }
    }
}
__device__ __forceinline__ dattn::Ref da_ref(Frame& F, int n) {
    const int pid = F.vcu + (n >> 2) * F.G, sub = n & 3, blk = sub >> 1, comp = sub & 1, bh = pid >> 4, s = pid & 15, qb = blk ? 31 - s : s, b = bh >> 2, h = bh & 3;
    bf16_t* mix = (bf16_t*)(F.ws + WS_MIX);
    dattn::Ref r;
    r.qoff = (unsigned)(((size_t)(b * SEQ + qb * 256) * INW + COL_Q + h * 128 + comp * 64) * 2);
    r.koff = (unsigned)(((size_t)(b * SEQ) * INW + COL_K + h * 128 + comp * 64) * 2);
    r.voff = (unsigned)(((size_t)(b * SEQ) * INW + COL_V + h * 128) * 2);
    r.O = mix + (size_t)(b * SEQ + qb * 256) * DM + 256 + h * 128;
    r.P0 = qb * 256; r.comp = comp; r.h = h;
    return r;
}
__device__ __forceinline__ void p2_mixers(Frame& F) {
    KArgs A = kargs();
    const float* rel_bias = A->in[I_RELB]; const float* lam_qk = A->in[I_LAMQK]; const float* subln_g = A->in[I_SUBG];
    if (F.tid < 512) { const int h = F.tid >> 7, n = F.tid & 127; int bk;
        if (n < 16) bk = n; else { bk = 16; const int thr[15] = {19, 21, 24, 27, 31, 35, 40, 46, 52, 59, 67, 77, 87, 99, 113};
#pragma unroll
            for (int i = 0; i < 15; ++i) bk += (n >= thr[i]) ? 1 : 0; }
        ((LAS float*)(F.lds + dattn::OFF_TB))[h * 128 + n] = (rel_bias[bk * 4 + h] - rel_bias[31 * 4 + h]) * LOG2E; }
    float d1 = 0.f, d2 = 0.f;
    for (int i = 0; i < 64; ++i) { d1 += lam_qk[i] * lam_qk[64 + i]; d2 += lam_qk[128 + i] * lam_qk[192 + i]; }
    const float lam = __expf(d1) - __expf(d2) + 0.2f;
    __syncthreads();
    const int npairs = F.vcu < 512 ? (512 - F.vcu + F.G - 1) / F.G : 0, total1 = 4 * npairs, total = ((PROBE_REP >> 2) & 1) ? 2 * total1 : total1;
    if (total > 0) {
        dattn::Seam S; dattn::Ref cur = da_ref(F, 0);
        const dattn::rsrc_t R = __builtin_amdgcn_make_buffer_rsrc((void*)(F.ws + WS_PROJ), 0, (int)((size_t)T * INW * 2), 0x00020000);
        dattn::prime(cur, F.lds, S, R);
        for (int n = 0; n < total; ++n) {
            const dattn::Ref nxt = (n + 1 < total) ? da_ref(F, (n + 1) % total1) : cur;
            dattn::block(cur, nxt, F.lds, S, lam, subln_g, R);
            cur = nxt;
        }
    }
    int lane2 = (int)__builtin_amdgcn_mbcnt_hi(~0u, __builtin_amdgcn_mbcnt_lo(~0u, 0u)); asm volatile("" : "+v"(lane2));
    const int tid2 = F.wave * 64 + lane2;
    const float* conv_w = kargs()->in[I_CONVW];
    for (int blk = blockIdx.x; blk < T / 256; blk += F.G) { p2_conv_block(F, blk, tid2, conv_w); p2_mem_block(F, blk, lane2); }
}

__device__ __forceinline__ void p4_router(Frame& F) {
    const float* router_b = kargs()->in[I_RB];
    const bf16_t* x1b = (const bf16_t*)(F.ws + WS_X1B); const bf16_t* wrh = (const bf16_t*)(F.ws + WS_WRHI); const bf16_t* wrl = (const bf16_t*)(F.ws + WS_WRLO);
    int* e_tk = (int*)(F.ws + WS_ETK); float* g_tk = (float*)(F.ws + WS_GTK); float* rstd_t = (float*)(F.ws + WS_RSTDT);
    LAS float* lg = (LAS float*)F.lds + F.wave * (32 * 33); LAS unsigned* hist = (LAS unsigned*)(F.lds + 8 * 32 * 33 * 4);
    const int r32 = F.lane & 31, hi = F.lane >> 5;
    for (int blk = blockIdx.x; blk < T / 256; blk += F.G) {
        if (F.tid < 32) hist[F.tid] = 0u;
        __syncthreads();
        const int t0 = blk * 256 + F.wave * 32;
        const bf16_t* xr = x1b + (size_t)(t0 + r32) * DM + hi * 8; const bf16_t* wh = wrh + (size_t)r32 * DM + hi * 8; const bf16_t* wl = wrl + (size_t)r32 * DM + hi * 8;
        f32x16 acc = f32x16{}; float ss = 0.f;
#pragma unroll 4
        for (int k0 = 0; k0 < DM; k0 += 16) {
            const u32x4 xw = *(const u32x4*)(xr + k0); const bf16x8 ah = *(const bf16x8*)(wh + k0), al = *(const bf16x8*)(wl + k0);
#pragma unroll
            for (int i = 0; i < 4; ++i) { const float a = bflo(xw[i]), b = bfhi(xw[i]); ss += a * a + b * b; }
            const bf16x8 xb = __builtin_bit_cast(bf16x8, xw);
            acc = __builtin_amdgcn_mfma_f32_32x32x16_bf16(ah, xb, acc, 0, 0, 0);
            acc = __builtin_amdgcn_mfma_f32_32x32x16_bf16(al, xb, acc, 0, 0, 0);
        }
        ss += __shfl_xor(ss, 32);
        const float rstd = rsqrtf(ss * (1.f / DM) + EPS);
#pragma unroll
        for (int r = 0; r < 16; ++r) { const int e = crow(r, hi); lg[r32 * 33 + e] = acc[r] * rstd + router_b[e]; }
        LDS_WAIT(); asm volatile("" ::: "memory");
        if (F.lane < 32) {
            LAS float* row = lg + F.lane * 33; float tv[4]; int ti[4];
#pragma unroll
            for (int p = 0; p < 4; ++p) { float best = -__builtin_inff(); int bi = 0;
                for (int e = 0; e < NEXP; ++e) { const float v = row[e]; if (v > best) { best = v; bi = e; } }
                tv[p] = best; ti[p] = bi; row[bi] = -__builtin_inff(); LDS_WAIT(); asm volatile("" ::: "memory"); }
            const float w1 = __expf(tv[1] - tv[0]), w2 = __expf(tv[2] - tv[0]), w3 = __expf(tv[3] - tv[0]); const float inv = 1.f / (1.f + w1 + w2 + w3);
            const int t = t0 + F.lane;
            *(int4*)(e_tk + (size_t)t * 4) = make_int4(ti[0], ti[1], ti[2], ti[3]);
            *(float4*)(g_tk + (size_t)t * 4) = make_float4(inv, w1 * inv, w2 * inv, w3 * inv);
            rstd_t[t] = rstd;
#pragma unroll
            for (int p = 0; p < 4; ++p) __hip_atomic_fetch_add(&hist[ti[p]], 1u, __ATOMIC_RELAXED, __HIP_MEMORY_SCOPE_WORKGROUP);
        }
        __syncthreads();
        if (F.tid < 32) __hip_atomic_fetch_add(F.ctl + CW_COUNT + F.tid, hist[F.tid], RLX_AGENT);
        __syncthreads();
    }
}
__device__ __forceinline__ void p5_place(Frame& F) {
    const int* e_tk = (const int*)(F.ws + WS_ETK); const float* g_tk = (const float*)(F.ws + WS_GTK); const float* rstd_t = (const float*)(F.ws + WS_RSTDT);
    int* slot_tk = (int*)(F.ws + WS_SLOTTK); int* tok_slot = (int*)(F.ws + WS_TOKSLOT); float* gate_slot = (float*)(F.ws + WS_GATESLOT); float* rstd_slot = (float*)(F.ws + WS_RSTDSLOT);
    int* rb_e = (int*)(F.ws + WS_RBE);
    LAS int* L = (LAS int*)F.lds;
    if (F.tid < 32) { const int c = (int)__hip_atomic_load(F.ctl + CW_COUNT + F.tid, RLX_AGENT); L[F.tid] = c; L[32 + F.tid] = (c + 255) & ~255; }
    __syncthreads();
    if (F.tid < 32) { int s = 0; for (int e = 0; e < F.tid; ++e) s += L[32 + e]; L[64 + F.tid] = s; }
    __syncthreads();
    for (int blk = blockIdx.x; blk < T / 256; blk += F.G) {
        if (F.tid < 32) { L[96 + F.tid] = 0; L[128 + F.tid] = 0; }
        __syncthreads();
        int ee[2];
#pragma unroll
        for (int j = 0; j < 2; ++j) { const int i = F.tid + 512 * j; ee[j] = e_tk[(size_t)blk * 1024 + i]; __hip_atomic_fetch_add(&L[96 + ee[j]], 1, __ATOMIC_RELAXED, __HIP_MEMORY_SCOPE_WORKGROUP); }
        __syncthreads();
        if (F.tid < 32) L[160 + F.tid] = L[64 + F.tid] + (int)__hip_atomic_fetch_add(F.ctl + CW_CURSOR + F.tid, (unsigned)L[96 + F.tid], RLX_AGENT);
        __syncthreads();
#pragma unroll
        for (int j = 0; j < 2; ++j) { const int i = F.tid + 512 * j; const int r = __hip_atomic_fetch_add(&L[128 + ee[j]], 1, __ATOMIC_RELAXED, __HIP_MEMORY_SCOPE_WORKGROUP); const int pos = L[160 + ee[j]] + r;
            const int t = blk * 256 + (i >> 2);
            tok_slot[pos] = t; gate_slot[pos] = g_tk[(size_t)blk * 1024 + i]; rstd_slot[pos] = rstd_t[t]; slot_tk[(size_t)blk * 1024 + i] = pos; }
        __syncthreads();
    }
    for (int e = blockIdx.x; e < NEXP; e += F.G)
        for (int i = L[e] + F.tid; i < L[32 + e]; i += NWAVES * 64) { const int pos = L[64 + e] + i; tok_slot[pos] = 0; gate_slot[pos] = 0.f; rstd_slot[pos] = 0.f; }
    if (blockIdx.x == 0) {
        const int nrb = (L[64 + 31] + L[32 + 31]) >> 8;
        for (int rb = F.tid; rb < NRB_MAX; rb += NWAVES * 64) { int e = 31; for (int q = 0; q < 32; ++q) { if (rb * 256 >= L[64 + q] && rb * 256 < L[64 + q] + L[32 + q]) e = q; } rb_e[rb] = e; }
        if (F.tid == 0) rb_e[NRB_MAX] = nrb;
    }
}
__device__ __forceinline__ void p9_final(Frame& F) {
    const bf16_t* x1b = (const bf16_t*)(F.ws + WS_X1B); const int* slot_tk = (const int*)(F.ws + WS_SLOTTK);
    const bf16_t* Y = (const bf16_t*)(F.ws + WS_Y);
    const int gw = F.vcu * NWAVES + F.wave, NGW = F.G * NWAVES;
    const float* final_g = kargs()->in[I_FING];
    for (int t = gw; t < T; t += NGW) {
        const int4 sl = *(const int4*)(slot_tk + (size_t)t * 4);
        const int s4[4] = {sl.x, sl.y, sl.z, sl.w};
        float v[2][8]; float ss = 0.f;
#pragma unroll
        for (int j = 0; j < 2; ++j) { const int c = 8 * F.lane + 512 * j;
            const u32x4 a = *(const u32x4*)(x1b + (size_t)t * DM + c);
#pragma unroll
            for (int i = 0; i < 4; ++i) { v[j][2 * i] = bflo(a[i]); v[j][2 * i + 1] = bfhi(a[i]); }
#pragma unroll
            for (int k = 0; k < 4; ++k) { const int s = s4[k]; const bf16_t* yp = Y + (size_t)s * DM + c;
                const u32x4 y = *(const u32x4*)yp;
#pragma unroll
                for (int i = 0; i < 4; ++i) { v[j][2 * i] += bflo(y[i]); v[j][2 * i + 1] += bfhi(y[i]); } }
#pragma unroll
            for (int i = 0; i < 8; ++i) ss += v[j][i] * v[j][i]; }
        const float rstd = rsqrtf(wave_sum(ss) * (1.f / DM) + EPS);
#pragma unroll
        for (int j = 0; j < 2; ++j) { const int c = 8 * F.lane + 512 * j;
            const f32x4 g0 = *(const f32x4*)(final_g + c), g1 = *(const f32x4*)(final_g + c + 4);
            f32x4 o0, o1; o0.x = v[j][0] * rstd * g0.x; o0.y = v[j][1] * rstd * g0.y; o0.z = v[j][2] * rstd * g0.z; o0.w = v[j][3] * rstd * g0.w;
            o1.x = v[j][4] * rstd * g1.x; o1.y = v[j][5] * rstd * g1.y; o1.z = v[j][6] * rstd * g1.z; o1.w = v[j][7] * rstd * g1.w;
            *(f32x4*)(F.out + (size_t)t * DM + c) = o0; *(f32x4*)(F.out + (size_t)t * DM + c + 4) = o1; }
    }
}

__global__ void __launch_bounds__(NWAVES * 64, 2) hymba_fwd(Args args) {
    extern __shared__ __attribute__((aligned(16))) unsigned char lds[];
    Frame F;
    F.lds = (LAS unsigned char*)lds;
    F.MISC = (volatile LAS unsigned*)(F.lds + MISC_OFF);
    F.tid = threadIdx.x; F.lane = F.tid & 63; F.wave = __builtin_amdgcn_readfirstlane(F.tid >> 6);
    F.G = gridDim.x; { const int bx = blockIdx.x; F.vcu = (F.G % 8 == 0) ? (bx % 8) * (F.G / 8) + bx / 8 : bx; }
    F.ws = args.ws; F.ctl = (unsigned*)(args.ws + WS_CTL); F.out = args.out;
    for (int u = F.tid; u < (LDS_BYTES - LDSCTL_OFF) / 4; u += NWAVES * 64) ((LAS unsigned*)(F.lds + LDSCTL_OFF))[u] = 0u;
    __syncthreads();
    XcdBarrier bar; bar.bar = F.ctl + CW_BAR; bar.x = 0; bar.st = nullptr;
    if (N_LAUNCHES == 1) bar = xcd_barrier_post(F.ctl + CW_BAR, F.MISC + 8);
#define GRID_BAR() do { if (N_LAUNCHES == 1) xcd_barrier(bar); } while (0)
    const int lo = args.ph_lo, hi = args.ph_hi;
#ifndef PH_MASK
#define PH_MASK 0x1ff
#endif
#define IN(k) (((PH_MASK >> (k)) & 1) && lo <= (k) && (k) < hi)
#define BOTH(k) (IN(k) && IN((k) + 1))
    bf16_t* const H = (bf16_t*)(F.ws + WS_H); bf16_t* const PROJ = (bf16_t*)(F.ws + WS_PROJ); bf16_t* const MIX = (bf16_t*)(F.ws + WS_MIX); bf16_t* const X1B = (bf16_t*)(F.ws + WS_X1B);
    bf16_t* const Win_t = (bf16_t*)(F.ws + WS_WIN); bf16_t* const Wout_t = (bf16_t*)(F.ws + WS_WOUT);
    const unsigned char* const Wgu_q = (const unsigned char*)F.out + OUT_WGU; const unsigned char* const Wd_q = (const unsigned char*)F.out + OUT_WD;
    unsigned char* const X1Q = F.ws + WS_X1Q; unsigned char* const ACTQ = F.ws + WS_ACTQ; bf16_t* const Yp = (bf16_t*)(F.ws + WS_Y);
    const int* const tok_slot = (const int*)(F.ws + WS_TOKSLOT); const float* const gate_slot = (const float*)(F.ws + WS_GATESLOT); const float* const rstd_slot = (const float*)(F.ws + WS_RSTDSLOT);
    const int* const rb_e = (const int*)(F.ws + WS_RBE);

#define REP(k) for (int rep_ = 0; rep_ < (((PROBE_REP >> (k)) & 1) ? 2 : 1); ++rep_)
    if (IN(0)) { REP(0) p0_prologue(F); if (BOTH(0)) GRID_BAR(); }
    if (IN(1)) {
        REP(1) {
        pg8::Gemm g{H, Win_t, DM, 0, nullptr}; pg8::StaticOrder S; S.init(T, INW, F.G, (int)blockIdx.x);
        pg8::EpiProj E{PROJ};
        pg8::gemm_phase<pg8::EpiProj, pg8::StaticOrder, true>(F.lds, g, S, E); }
        if (BOTH(1)) GRID_BAR();
    }
    if (IN(2)) { p2_mixers(F); if (BOTH(2)) GRID_BAR(); }
    if (IN(3)) {
        pg8::Gemm g{MIX, Wout_t, DM, 0, nullptr}; pg8::StaticOrder S; S.init(T, DM, F.G, (int)blockIdx.x);
        pg8::EpiX1 E{kargs()->in[I_X], X1B, X1Q};
        pg8::gemm_phase<pg8::EpiX1, pg8::StaticOrder, true>(F.lds, g, S, E);
        if (BOTH(3)) GRID_BAR();
    }
    if (IN(4)) { p4_router(F); if (BOTH(4)) GRID_BAR(); }
    if (IN(5)) { p5_place(F); if (BOTH(5)) GRID_BAR(); }
    if (IN(6)) {
        const int nrb = rb_e[NRB_MAX];
        REP(6) {
        pg8::Gemm g{(const bf16_t*)X1Q, (const bf16_t*)Wgu_q, DM / 2, (long)2048 * DM / 2, tok_slot}; pg8::GroupOrder S{nrb, 0, 8, F.G, (int)blockIdx.x, rb_e};
        pg8::EpiGU E{ACTQ, kargs()->in[I_BGU], rstd_slot};
        pg8::gemm_phase<pg8::EpiGU, pg8::GroupOrder, true, true, 0x79797979, 0x7f7f7f7f>(F.lds, g, S, E); }
        if (BOTH(6)) GRID_BAR();
    }
    if (IN(7)) {
        const int nrb = rb_e[NRB_MAX];
        pg8::Gemm g{(const bf16_t*)ACTQ, (const bf16_t*)Wd_q, DEXP / 2, (long)DM * DEXP / 2, nullptr}; pg8::GroupOrder S{nrb, 0, 4, F.G, (int)blockIdx.x, rb_e};
        pg8::EpiDown E{Yp, kargs()->in[I_BDN], gate_slot};
        pg8::gemm_phase<pg8::EpiDown, pg8::GroupOrder, true, true, 0x79797979, 0x7d7d7d7d>(F.lds, g, S, E);
        if (BOTH(7)) GRID_BAR();
    }
    if (IN(8)) { REP(8) p9_final(F); }
#undef IN
#undef BOTH
#undef GRID_BAR
}

extern "C" void kernel_launch(void* const* d_in, const int* in_sizes, int n_in, void* d_out, int out_size, void* d_ws, size_t ws_size, hipStream_t stream) {
    static int grid = 0;
    if (grid == 0) {
        if (n_in != 19 || out_size != T * DM || ws_size < WS_END) { fprintf(stderr, "kernel_launch: unexpected shapes (n_in %d out %d ws %zu)\n", n_in, out_size, ws_size); grid = -1; return; }
        int dev = 0, cus = 0;
        if (hipGetDevice(&dev) != hipSuccess || hipDeviceGetAttribute(&cus, hipDeviceAttributeMultiprocessorCount, dev) != hipSuccess) { grid = -1; return; }
        if (hipFuncSetAttribute((const void*)hymba_fwd, hipFuncAttributeMaxDynamicSharedMemorySize, LDS_BYTES) != hipSuccess) { fprintf(stderr, "kernel_launch: hipFuncSetAttribute failed\n"); grid = -1; return; }
        int per_cu = 0;
        if (hipOccupancyMaxActiveBlocksPerMultiprocessor(&per_cu, (const void*)hymba_fwd, NWAVES * 64, LDS_BYTES) != hipSuccess || per_cu < 1) fprintf(stderr, "kernel_launch: occupancy query reports %d\n", per_cu);
        (void)hipGetLastError();
        grid = cus;
    }
    if (grid < 0) return;
    if (hipMemsetAsync((char*)d_ws + WS_CTL, 0, CTL_ZERO_BYTES, stream) != hipSuccess) return;
    Args a{};
    for (int i = 0; i < 19; ++i) a.in[i] = (const float*)d_in[i];
    a.out = (float*)d_out; a.ws = (unsigned char*)d_ws;
    for (int li = 0; li < N_LAUNCHES; ++li) {
        a.ph_lo = (N_LAUNCHES == 1) ? 0 : li; a.ph_hi = (N_LAUNCHES == 1) ? N_PHASES : li + 1;
        hipLaunchKernelGGL(hymba_fwd, dim3(grid), dim3(NWAVES * 64), LDS_BYTES, stream, a);
    }
}
```

```cpp
#include <hip/hip_runtime.h>
#include <hip/hip_bf16.h>
#include <cstdio>
#include <cstdint>

#ifndef PROBE_REP
#define PROBE_REP 0
#endif
#ifndef MK_N_LAUNCHES
#define MK_N_LAUNCHES 1
#endif

constexpr int BATCH = 8, SEQ = 8192, DM = 1024, T = BATCH * SEQ, INW = 2560, MEML = 256, NEXP = 32, TOPK = 4, DEXP = 1024;
constexpr int COL_U = 0, COL_GB = 256, COL_GC = 512, COL_Q = 768, COL_K = 1280, COL_V = 1792, COL_QM = 2304;
constexpr float EPS = 1e-5f;
constexpr float C2 = 0.125f * 1.4426950408889634f;
constexpr float LOG2E = 1.4426950408889634f;
constexpr int NRB_MAX = 1056;

#define GAS __attribute__((address_space(1)))
#define LAS __attribute__((address_space(3)))
typedef unsigned short bf16_t;
typedef short bf16x8 __attribute__((ext_vector_type(8)));
typedef short s16x4 __attribute__((ext_vector_type(4)));
typedef float f32x4 __attribute__((ext_vector_type(4)));
typedef float f32x16 __attribute__((ext_vector_type(16)));
typedef unsigned u32x4 __attribute__((ext_vector_type(4)));
typedef unsigned u32x2 __attribute__((ext_vector_type(2)));
typedef float f32x2_t __attribute__((ext_vector_type(2)));
typedef __bf16 bf16x2_t __attribute__((ext_vector_type(2)));
typedef GAS unsigned gu32;
#define RLX_AGENT __ATOMIC_RELAXED, __HIP_MEMORY_SCOPE_AGENT
#define LDS_WAIT() asm volatile("s_waitcnt lgkmcnt(0)" ::: "memory")
#define VM_WAIT() asm volatile("s_waitcnt vmcnt(0)" ::: "memory")
#define SBAR() __builtin_amdgcn_sched_barrier(0)

__device__ __forceinline__ unsigned pk2(float lo, float hi) { f32x2_t v = {lo, hi}; bf16x2_t b = __builtin_convertvector(v, bf16x2_t); return __builtin_bit_cast(unsigned, b); }
__device__ __forceinline__ float bflo(unsigned u) { return __uint_as_float(u << 16); }
__device__ __forceinline__ float bfhi(unsigned u) { return __uint_as_float(u & 0xffff0000u); }
__device__ __forceinline__ bf16x8 pack8(f32x4 a, f32x4 b) { u32x4 w = {pk2(a[0], a[1]), pk2(a[2], a[3]), pk2(b[0], b[1]), pk2(b[2], b[3])}; return __builtin_bit_cast(bf16x8, w); }
__device__ __forceinline__ int crow(int r, int hi) { return (r & 3) + 8 * (r >> 2) + 4 * hi; }
__device__ __forceinline__ float wave_sum(float v) {
#pragma unroll
    for (int o = 1; o < 64; o <<= 1) v += __shfl_xor(v, o);
    return v;
}

namespace pg8 {
constexpr int BM = 256, BK = 64, HALF = 128, HTB = HALF * BK * 2  , STAGE_BYTES = 8 * HTB, NXCD = 8, WGM = 8;
__host__ __device__ __forceinline__ int lds_byte(int r, int c) { const int st = (r >> 4) * 2 + (c >> 5), rr = r & 15, cc = c & 31, ob = rr * 64 + cc * 2; return st * 1024 + (ob ^ (((ob >> 9) & 1) << 5)); }
__host__ __device__ __forceinline__ void stage_rc(int b, int& R, int& C) { const int st = b / 1024, sb = b % 1024, swz = sb ^ (((sb >> 9) & 1) << 5); R = (st >> 1) * 16 + swz / 64; C = (st & 1) * 32 + (swz % 64) / 2; }
__host__ __device__ __forceinline__ int perm32(int rho) { const int n = rho >> 4, i = rho & 15; return 8 * (i >> 2) + 4 * n + (i & 3); }

struct Unit { int pm, pn, e; };
struct Gemm { const bf16_t* A; const bf16_t* Bt; int K; long bstride; const int* rowmap; };

struct StaticOrder {
    int nM, nN, nwg, G, c;
    __device__ void init(int M, int N, int G_, int c_) { nM = M / BM; nN = N / BM; nwg = nM * nN; G = G_; c = c_; }
    __device__ bool next(int i, Unit& u) const {
        const long L = (long)i * G + c; if (L >= nwg) return false;
        int wgid = (int)L; { const int q = nwg / NXCD, r = nwg % NXCD, xcd = wgid % NXCD, off = wgid / NXCD; wgid = (xcd < r ? xcd * (q + 1) : r * (q + 1) + (xcd - r) * q) + off; }
        const int nig = WGM * nN, gid = wgid / nig, fm = gid * WGM, gsz = (nM - fm) < WGM ? (nM - fm) : WGM;
        u.pm = fm + ((wgid % nig) % gsz); u.pn = (wgid % nig) / gsz; u.e = 0; return true;
    }
};
struct GroupOrder {
    int nrb, rb0, npn, G, c; const int* rb_e;
    __device__ bool next(int i, Unit& u) const {
        int rbl, pn;
        if ((G & 7) == 0 && ((G >> 3) % npn) == 0) { const int x = c & 7, j = c >> 3, rpx = (G >> 3) / npn; rbl = i * (G / npn) + x * rpx + j / npn; pn = j % npn; }
        else { const long L = (long)i * G + c; rbl = (int)(L / npn); pn = (int)(L % npn); }
        if (rbl >= nrb) return false;
        u.pm = rb0 + rbl; u.pn = pn; u.e = rb_e[u.pm]; return true;
    }
};

typedef int v4i_t __attribute__((ext_vector_type(4)));
typedef int v8i_t __attribute__((ext_vector_type(8)));
template <class Epi, class Sched, bool ALIGN_EPI, bool FP8 = false, int SCW = 0x7f7f7f7f, int SCA = 0x7f7f7f7f>
__device__ __forceinline__ void gemm_phase(LAS unsigned char* lds, const Gemm g, const Sched& S, const Epi& E) {
    const int tid = threadIdx.x, wid = __builtin_amdgcn_readfirstlane(tid >> 6), lane = tid & 63, wr = wid >> 2, wc = wid & 3, fr = lane & 15, fq = lane >> 4;
    const int K = g.K; int nt = K / BK; asm volatile("" : "+s"(nt));
    int Rr[2], Cc[2]; unsigned voffB[2];
#pragma unroll
    for (int i = 0; i < 2; ++i) { int R, C; stage_rc(tid * 16 + i * 8192, R, C); const int Rb = Epi::PERM ? ((R & ~31) + perm32(R & 31)) : R;
        Rr[i] = R; Cc[i] = C; voffB[i] = (unsigned)(Rb * K + C) * 2u; }
    const size_t kstep = (size_t)(BK * 2);
    const size_t hstep = (size_t)HALF * K * 2;
    const size_t tstep = 2 * hstep;
    const unsigned ldsw = (unsigned)wid * 1024u;
    const int aoff = lds_byte(wr * 64 + fr, fq * 8), boff = lds_byte(wc * 32 + fr, fq * 8);
#define PG8_SA(b, h) (((b) * 2 + (h)) * HTB)
#define PG8_SB(b, h) ((4 + (b) * 2 + (h)) * HTB)
#define PG8_STAGE(bufoff, gbase, voff) do { _Pragma("unroll") for (int _i = 0; _i < 2; ++_i) \
        __builtin_amdgcn_global_load_lds((const unsigned*)((const char*)(gbase) + (voff)[_i]), (LAS unsigned*)(lds + (bufoff) + ldsw + _i * 8192), 16, 0, 0); } while (0)
#define PG8_STAGE_A(bufoff, kptr, offs, h) do { _Pragma("unroll") for (int _i = 0; _i < 2; ++_i) \
        __builtin_amdgcn_global_load_lds((const unsigned*)((const char*)(kptr) + (offs)[h][_i]), (LAS unsigned*)(lds + (bufoff) + ldsw + _i * 8192), 16, 0, 0); } while (0)
#define PG8_AOFF(dst, u) do { _Pragma("unroll") for (int _h = 0; _h < 2; ++_h) _Pragma("unroll") for (int _i = 0; _i < 2; ++_i) { const int _row = (u).pm * BM + _h * HALF + Rr[_i]; \
        const int _src = g.rowmap ? g.rowmap[_row] : _row; dst[_h][_i] = (unsigned)(_src * K + Cc[_i]) * 2u; } } while (0)
#define PG8_LDA(dst, b, h) do { _Pragma("unroll") for (int m = 0; m < 4; ++m) _Pragma("unroll") for (int k = 0; k < 2; ++k) dst[m][k] = *(const LAS bf16x8*)(lds + PG8_SA(b, h) + aoff + m * 2048 + k * 1024); } while (0)
#define PG8_LDB(dst, b, h) do { _Pragma("unroll") for (int n = 0; n < 2; ++n) _Pragma("unroll") for (int k = 0; k < 2; ++k) dst[n][k] = *(const LAS bf16x8*)(lds + PG8_SB(b, h) + boff + n * 2048 + k * 1024); } while (0)
#define PG8_CAT(x, y) __builtin_shufflevector(__builtin_bit_cast(v4i_t, x), __builtin_bit_cast(v4i_t, y), 0, 1, 2, 3, 4, 5, 6, 7)
#define PG8_MMA(ai, bj, At, Bt) do { __builtin_amdgcn_s_setprio(1); _Pragma("unroll") for (int m = 0; m < 4; ++m) _Pragma("unroll") for (int n = 0; n < 2; ++n) { \
        if constexpr (FP8) { acc[ai][bj][m][n] = __builtin_amdgcn_mfma_scale_f32_16x16x128_f8f6f4(PG8_CAT(Bt[n][0], Bt[n][1]), PG8_CAT(At[m][0], At[m][1]), acc[ai][bj][m][n], 0, 0, 0, SCW, 0, SCA); } \
        else { _Pragma("unroll") for (int k = 0; k < 2; ++k) acc[ai][bj][m][n] = __builtin_amdgcn_mfma_f32_16x16x32_bf16(Bt[n][k], At[m][k], acc[ai][bj][m][n], 0, 0, 0); } } \
        __builtin_amdgcn_s_setprio(0); } while (0)
#define PG8_WAIT_V(n) asm volatile("s_waitcnt vmcnt(" #n ")" ::: "memory")
#define PG8_WAIT_L(n) asm volatile("s_waitcnt lgkmcnt(" #n ")" ::: "memory")
#define PG8_BAR __builtin_amdgcn_s_barrier()
#define PG8_SCHED __builtin_amdgcn_sched_barrier(0)
    Unit cur, nxt; int ui = 0;
    if (!S.next(0, cur)) return;
    f32x4 acc[2][2][4][2];
#pragma unroll
    for (int a = 0; a < 2; ++a)
#pragma unroll
        for (int b = 0; b < 2; ++b)
#pragma unroll
            for (int m = 0; m < 4; ++m)
#pragma unroll
                for (int n = 0; n < 2; ++n) acc[a][b][m][n] = (f32x4){0.f, 0.f, 0.f, 0.f};
    bf16x8 At[4][2], B0[2][2], B1[2][2];
    unsigned aoc[2][2], aon[2][2];
    PG8_AOFF(aoc, cur);
    const char* Ab = (const char*)g.A;
    const char* cB = (const char*)g.Bt + ((size_t)cur.e * (size_t)g.bstride) * 2 + (size_t)cur.pn * tstep;
    PG8_STAGE(PG8_SB(0, 0), cB, voffB); PG8_STAGE(PG8_SB(0, 1), cB + hstep, voffB); PG8_STAGE_A(PG8_SA(0, 0), Ab, aoc, 0); PG8_STAGE_A(PG8_SA(0, 1), Ab, aoc, 1);
    if (wr == 1) PG8_BAR;
    PG8_WAIT_V(2); PG8_BAR;
    PG8_STAGE(PG8_SB(1, 0), cB + kstep, voffB); PG8_STAGE_A(PG8_SA(1, 0), Ab + kstep, aoc, 0); PG8_STAGE(PG8_SB(1, 1), cB + hstep + kstep, voffB);
    PG8_WAIT_V(6); PG8_BAR;
    for (;;) {
        const bool has_next = S.next(ui + 1, nxt);
        if (has_next) { PG8_AOFF(aon, nxt); }
        else {
#pragma unroll
            for (int h = 0; h < 2; ++h)
#pragma unroll
                for (int i = 0; i < 2; ++i) aon[h][i] = aoc[h][i];
        }
        const char* nB = has_next ? (const char*)g.Bt + ((size_t)nxt.e * (size_t)g.bstride) * 2 + (size_t)nxt.pn * tstep : cB;
#pragma nounroll
        for (int t = 0; t < nt; t += 2) {
            const bool last = (t == nt - 2);
            const char* a1 = Ab + (size_t)(t + 1) * kstep;
            const char* a2 = last ? Ab : Ab + (size_t)(t + 2) * kstep; const char* b2 = last ? nB : cB + (size_t)(t + 2) * kstep;
            const char* a3 = a2 + kstep; const char* b3 = b2 + kstep;
            PG8_LDB(B0, 0, 0); PG8_LDB(B1, 0, 1); PG8_SCHED; PG8_LDA(At, 0, 0); PG8_STAGE_A(PG8_SA(1, 1), a1, aoc, 1);
            if (last) {
#pragma unroll
                for (int h = 0; h < 2; ++h)
#pragma unroll
                    for (int i = 0; i < 2; ++i) aoc[h][i] = aon[h][i]; }
            PG8_WAIT_V(8); PG8_WAIT_L(0); PG8_BAR; PG8_MMA(0, 0, At, B0); PG8_MMA(0, 1, At, B1); PG8_BAR; PG8_SCHED;
            PG8_LDA(At, 0, 1); PG8_STAGE(PG8_SB(0, 0), b2, voffB); PG8_STAGE(PG8_SB(0, 1), b2 + hstep, voffB); PG8_STAGE_A(PG8_SA(0, 0), a2, aoc, 0);
            PG8_WAIT_V(8); PG8_WAIT_L(0); PG8_BAR; PG8_MMA(1, 0, At, B0); PG8_MMA(1, 1, At, B1); PG8_BAR; PG8_SCHED;
            PG8_LDB(B0, 1, 0); PG8_LDB(B1, 1, 1); PG8_SCHED; PG8_LDA(At, 1, 0); PG8_STAGE_A(PG8_SA(0, 1), a2, aoc, 1);
            PG8_WAIT_V(8); PG8_WAIT_L(0); PG8_BAR; PG8_MMA(0, 0, At, B0); PG8_MMA(0, 1, At, B1); PG8_BAR; PG8_SCHED;
            PG8_LDA(At, 1, 1); PG8_STAGE(PG8_SB(1, 0), b3, voffB); PG8_STAGE(PG8_SB(1, 1), b3 + hstep, voffB); PG8_STAGE_A(PG8_SA(1, 0), a3, aoc, 0);
            PG8_WAIT_V(8); PG8_WAIT_L(0); PG8_BAR; PG8_MMA(1, 0, At, B0); PG8_MMA(1, 1, At, B1); PG8_BAR; PG8_SCHED;
        }
        if constexpr (ALIGN_EPI) { if (wr == 0) PG8_BAR; }
        E(acc, cur, wr, wc, fr, fq);
        if (!has_next) break;
#pragma unroll
        for (int a = 0; a < 2; ++a)
#pragma unroll
            for (int b = 0; b < 2; ++b)
#pragma unroll
                for (int m = 0; m < 4; ++m)
#pragma unroll
                    for (int n = 0; n < 2; ++n) acc[a][b][m][n] = (f32x4){0.f, 0.f, 0.f, 0.f};
        cur = nxt; cB = nB; ++ui;
        if constexpr (ALIGN_EPI) { if (wr == 1) PG8_BAR; }
    }
    PG8_WAIT_V(0);
    if constexpr (!ALIGN_EPI) { if (wr == 0) PG8_BAR; }
    PG8_BAR;
#undef PG8_SA
#undef PG8_SB
#undef PG8_STAGE
#undef PG8_STAGE_A
#undef PG8_AOFF
#undef PG8_LDA
#undef PG8_LDB
#undef PG8_MMA
#undef PG8_CAT
#undef PG8_WAIT_V
#undef PG8_WAIT_L
#undef PG8_BAR
#undef PG8_SCHED
}

struct EpiProj {
    static constexpr bool PERM = true;
    bf16_t* O;
    __device__ __forceinline__ void operator()(const f32x4 (&acc)[2][2][4][2], const Unit& u, int wr, int wc, int fr, int fq) const {
        const int row0 = u.pm * BM + wr * 64 + fr, col0 = u.pn * BM + wc * 32 + 8 * fq;
        const float sc = (u.pn == 3 || u.pn == 4 || u.pn == 9) ? C2 : 1.f;
#pragma unroll
        for (int ai = 0; ai < 2; ++ai)
#pragma unroll
            for (int m = 0; m < 4; ++m) { bf16_t* rowp = O + (size_t)(row0 + ai * HALF + m * 16) * INW + col0;
#pragma unroll
                for (int bj = 0; bj < 2; ++bj) { const f32x4 v0 = acc[ai][bj][m][0] * sc, v1 = acc[ai][bj][m][1] * sc;
                    u32x4 w; w.x = pk2(v0[0], v0[1]); w.y = pk2(v0[2], v0[3]); w.z = pk2(v1[0], v1[1]); w.w = pk2(v1[2], v1[3]);
                    *(u32x4*)(rowp + bj * HALF) = w; } }
    }
};
__device__ __forceinline__ unsigned pk4_fp8(float a, float b, float c, float d) { int w = 0; w = __builtin_amdgcn_cvt_pk_fp8_f32(a, b, w, false); w = __builtin_amdgcn_cvt_pk_fp8_f32(c, d, w, true); return (unsigned)w; }
struct EpiX1 {
    static constexpr bool PERM = true;
    const float* X; bf16_t* O; unsigned char* Q8;
    __device__ __forceinline__ void operator()(const f32x4 (&acc)[2][2][4][2], const Unit& u, int wr, int wc, int fr, int fq) const {
        const int row0 = u.pm * BM + wr * 64 + fr, col0 = u.pn * BM + wc * 32 + 8 * fq;
#pragma unroll
        for (int ai = 0; ai < 2; ++ai)
#pragma unroll
            for (int m = 0; m < 4; ++m) { const size_t off = (size_t)(row0 + ai * HALF + m * 16) * DM + col0;
#pragma unroll
                for (int bj = 0; bj < 2; ++bj) { const f32x4 x0 = *(const f32x4*)(X + off + bj * HALF), x1 = *(const f32x4*)(X + off + bj * HALF + 4);
                    const f32x4 v0 = acc[ai][bj][m][0] + x0, v1 = acc[ai][bj][m][1] + x1;
                    u32x4 w; w.x = pk2(v0[0], v0[1]); w.y = pk2(v0[2], v0[3]); w.z = pk2(v1[0], v1[1]); w.w = pk2(v1[2], v1[3]);
                    *(u32x4*)(O + off + bj * HALF) = w;
                    u32x2 q; q.x = pk4_fp8(v0[0], v0[1], v0[2], v0[3]); q.y = pk4_fp8(v1[0], v1[1], v1[2], v1[3]);
                    *(u32x2*)(Q8 + off + bj * HALF) = q; } }
    }
};
struct EpiGU {
    static constexpr bool PERM = true;
    unsigned char* ACT; const float* bias; const float* rstd;
    __device__ __forceinline__ void operator()(const f32x4 (&acc)[2][2][4][2], const Unit& u, int wr, int wc, int fr, int fq) const {
        const int row0 = u.pm * BM + wr * 64 + fr, j0 = u.pn * HALF + wc * 32 + 8 * fq;
        const float* bp = bias + (size_t)u.e * 2048 + j0;
        const f32x4 bg0 = *(const f32x4*)(bp), bg1 = *(const f32x4*)(bp + 4), bu0 = *(const f32x4*)(bp + 1024), bu1 = *(const f32x4*)(bp + 1028);
#pragma unroll
        for (int ai = 0; ai < 2; ++ai)
#pragma unroll
            for (int m = 0; m < 4; ++m) { const int row = row0 + ai * HALF + m * 16; const float rs = rstd[row];
                f32x4 g0 = acc[ai][0][m][0] * rs + bg0, g1 = acc[ai][0][m][1] * rs + bg1, u0 = acc[ai][1][m][0] * rs + bu0, u1 = acc[ai][1][m][1] * rs + bu1;
                float o[8];
#pragma unroll
                for (int i = 0; i < 4; ++i) {
                    { const float gg = fminf(g0[i], 7.f), uu = fminf(fmaxf(u0[i], -7.f), 7.f); const float sg = __builtin_amdgcn_rcpf(1.f + __builtin_amdgcn_exp2f(-1.702f * LOG2E * gg)); o[i] = (uu + 1.f) * gg * sg; }
                    { const float gg = fminf(g1[i], 7.f), uu = fminf(fmaxf(u1[i], -7.f), 7.f); const float sg = __builtin_amdgcn_rcpf(1.f + __builtin_amdgcn_exp2f(-1.702f * LOG2E * gg)); o[4 + i] = (uu + 1.f) * gg * sg; }
                }
                u32x2 w; w.x = pk4_fp8(4.f * o[0], 4.f * o[1], 4.f * o[2], 4.f * o[3]); w.y = pk4_fp8(4.f * o[4], 4.f * o[5], 4.f * o[6], 4.f * o[7]);
                *(u32x2*)(ACT + (size_t)row * DEXP + j0) = w; }
    }
};
struct EpiDown {
    static constexpr bool PERM = true;
    bf16_t* Y; const float* bias; const float* gate;
    __device__ __forceinline__ void operator()(const f32x4 (&acc)[2][2][4][2], const Unit& u, int wr, int wc, int fr, int fq) const {
        const int row0 = u.pm * BM + wr * 64 + fr, col0 = u.pn * BM + wc * 32 + 8 * fq;
        const float* bp = bias + (size_t)u.e * DM + col0;
        f32x4 bv[2][2];
#pragma unroll
        for (int bj = 0; bj < 2; ++bj) { bv[bj][0] = *(const f32x4*)(bp + bj * HALF); bv[bj][1] = *(const f32x4*)(bp + bj * HALF + 4); }
#pragma unroll
        for (int ai = 0; ai < 2; ++ai)
#pragma unroll
            for (int m = 0; m < 4; ++m) { const int row = row0 + ai * HALF + m * 16; const float gs = gate[row];
#pragma unroll
                for (int bj = 0; bj < 2; ++bj) { const f32x4 v0 = (acc[ai][bj][m][0] + bv[bj][0]) * gs, v1 = (acc[ai][bj][m][1] + bv[bj][1]) * gs;
                    u32x4 w; w.x = pk2(v0[0], v0[1]); w.y = pk2(v0[2], v0[3]); w.z = pk2(v1[0], v1[1]); w.w = pk2(v1[2], v1[3]);
                    *(u32x4*)(Y + (size_t)row * DM + col0 + bj * HALF) = w; } }
    }
};
}

namespace dattn {
constexpr int NW = 8, QBLK = 32, KVBLK = 64, QB = 256, PITCH = INW;
constexpr int SHM_V = KVBLK * 128 * 2, SHM_K = KVBLK * 64 * 2;
constexpr int OFF_V = 0, OFF_K = 2 * SHM_V, OFF_WS = OFF_K + 2 * SHM_K, OFF_STASH = OFF_WS + NW * 64 * 4, OFF_TB = OFF_STASH + NW * 8192, LDS_BYTES = OFF_TB + 4 * 128 * 4;
constexpr float THR = 8.f;
__device__ __forceinline__ int v_st(int k, int c) { const int kk = k;     return ((kk >> 3) * 4 + (c >> 5)) * 512 + ((kk & 7) * 32 + (c & 31)) * 2; }
__device__ __forceinline__ int v_rd_base(int lane) { return ((lane & 3) << 3) | (((lane >> 2) & 3) << 6) | (((lane >> 4) & 1) << 5) | (((lane >> 5) & 1) << 8); }
constexpr int v_rd_off(int d0, int ks, int half) { return d0 * 512 + ks * 4096 + half * 2048; }

struct Ref { unsigned qoff, koff, voff; bf16_t* O; int P0, comp, h; };
typedef __amdgpu_buffer_rsrc_t rsrc_t;
__device__ __forceinline__ bf16x8 bld8(rsrc_t r, unsigned voff, unsigned soff) { return __builtin_bit_cast(bf16x8, __builtin_amdgcn_raw_buffer_load_b128(r, (int)voff, (int)soff, 0)); }
struct Seam { bf16x8 qr[4]; bf16x8 st_v0, st_v1, st_k; };

__device__ __forceinline__ bf16x8 ld8(const bf16_t* p) { return *reinterpret_cast<const bf16x8*>(p); }

__device__ __forceinline__ void bias_mask(f32x16& p0, f32x16& p1, int sdq  , const LAS float* tb) {
    const float NEG = -__builtin_inff();
    int lane_ = (int)__builtin_amdgcn_mbcnt_hi(~0u, __builtin_amdgcn_mbcnt_lo(~0u, 0u));
    int dq = sdq + (lane_ & 31) - 4 * (lane_ >> 5);
    asm volatile("" : "+v"(dq));
#pragma unroll
    for (int r = 0; r < 16; ++r) {
        const int c = (r & 3) + 8 * (r >> 2);
        const int d0 = dq - c, d1 = dq - c - 32;
        const int i0 = d0 < 0 ? 0 : (d0 > 127 ? 127 : d0), i1 = d1 < 0 ? 0 : (d1 > 127 ? 127 : d1);
        const float b0 = tb[i0], b1 = tb[i1];
        p0[r] = d0 < 0 ? NEG : p0[r] + b0;
        p1[r] = d1 < 0 ? NEG : p1[r] + b1;
    }
}
__device__ __forceinline__ void partialSM(f32x16& p0, f32x16& p1, float& m_reg, float& alpha) {
    float pmax = p0[0];
#pragma unroll
    for (int r = 1; r < 16; ++r) pmax = fmaxf(pmax, p0[r]);
#pragma unroll
    for (int r = 0; r < 16; ++r) pmax = fmaxf(pmax, p1[r]);
    { auto rr = __builtin_amdgcn_permlane32_swap(__float_as_uint(pmax), __float_as_uint(pmax), false, false);
      pmax = fmaxf(__uint_as_float(rr[0]), __uint_as_float(rr[1])); }
    float mn;
    if (__builtin_expect(__all((pmax - m_reg) <= THR), 1)) { mn = m_reg; alpha = 1.f; }
    else { mn = fmaxf(m_reg, pmax); alpha = __builtin_amdgcn_exp2f(m_reg - mn); m_reg = mn; }
#pragma unroll
    for (int r = 0; r < 16; ++r) p0[r] = p0[r] - mn;
#pragma unroll
    for (int r = 0; r < 16; ++r) p1[r] = p1[r] - mn;
#pragma unroll
    for (int r = 0; r < 16; ++r) p0[r] = __builtin_amdgcn_exp2f(p0[r]);
}
__device__ __forceinline__ void finishSM(f32x16& p0, f32x16& p1, float alpha, float& l_reg, bf16x8& pa0, bf16x8& pa1, bf16x8& pa2, bf16x8& pa3) {
#pragma unroll
    for (int r = 0; r < 16; ++r) p1[r] = __builtin_amdgcn_exp2f(p1[r]);
    float ps = 0;
#pragma unroll
    for (int r = 0; r < 16; ++r) ps += p0[r];
#pragma unroll
    for (int r = 0; r < 16; ++r) ps += p1[r];
    { auto rr = __builtin_amdgcn_permlane32_swap(__float_as_uint(ps), __float_as_uint(ps), false, false);
      ps = __uint_as_float(rr[0]) + __uint_as_float(rr[1]); }
    l_reg = l_reg * alpha + ps;
#define PK4(P, B_, OUT) do { unsigned a0 = pk2(P[B_+0], P[B_+1]), a1 = pk2(P[B_+2], P[B_+3]);                          \
        unsigned b0 = pk2(P[B_+4], P[B_+5]), b1 = pk2(P[B_+6], P[B_+7]);                                             \
        auto r0 = __builtin_amdgcn_permlane32_swap(a0, b0, false, false); auto r1 = __builtin_amdgcn_permlane32_swap(a1, b1, false, false); \
        u32x4 w = {r0[0], r1[0], r0[1], r1[1]}; OUT = __builtin_bit_cast(bf16x8, w); } while (0)
    PK4(p0, 0, pa0); PK4(p0, 8, pa1); PK4(p1, 0, pa2); PK4(p1, 8, pa3);
#undef PK4
}
template <int KB>
__device__ __forceinline__ void qkt(f32x16& p0, f32x16& p1, const LAS unsigned char* K_lds, int r32, int hi, const bf16x8* qr) {
    p0 = f32x16{}; p1 = f32x16{};
    const int s = (r32 >> 1) & 7;
#pragma unroll
    for (int d0 = 0; d0 < 4; ++d0) {
        const LAS unsigned char* a = K_lds + KB * SHM_K + r32 * 128 + (((2 * d0 + hi) ^ s) << 4);
        const bf16x8 b0 = *(const LAS bf16x8*)(a);
        const bf16x8 b1 = *(const LAS bf16x8*)(a + 32 * 128);
        p0 = __builtin_amdgcn_mfma_f32_32x32x16_bf16(b0, qr[d0], p0, 0, 0, 0);
        p1 = __builtin_amdgcn_mfma_f32_32x32x16_bf16(b1, qr[d0], p1, 0, 0, 0); }
}
template <int VB>
__device__ __forceinline__ void pv_tile(f32x16* o, int vb0, bf16x8 pa0, bf16x8 pa1, bf16x8 pa2, bf16x8 pa3) {
#define TRRD(dst, off) asm volatile("ds_read_b64_tr_b16 %0, %1 offset:%2" : "=&v"(dst) : "v"(vb0), "i"(off) : "memory")
#define PV_D0(d0) do { s16x4 l0, l1, l2, l3, h0, h1, h2, h3; constexpr int b_ = VB * SHM_V + v_rd_off(d0, 0, 0); \
        TRRD(l0, b_); TRRD(h0, b_ + 2048); TRRD(l1, b_ + 4096); TRRD(h1, b_ + 6144); TRRD(l2, b_ + 8192); TRRD(h2, b_ + 10240); TRRD(l3, b_ + 12288); TRRD(h3, b_ + 14336); \
        asm volatile("s_waitcnt lgkmcnt(0)" ::: "memory"); SBAR();   \
        o[d0] = __builtin_amdgcn_mfma_f32_32x32x16_bf16(pa0, (bf16x8){l0[0], l0[1], l0[2], l0[3], h0[0], h0[1], h0[2], h0[3]}, o[d0], 0, 0, 0);   \
        o[d0] = __builtin_amdgcn_mfma_f32_32x32x16_bf16(pa1, (bf16x8){l1[0], l1[1], l1[2], l1[3], h1[0], h1[1], h1[2], h1[3]}, o[d0], 0, 0, 0);   \
        o[d0] = __builtin_amdgcn_mfma_f32_32x32x16_bf16(pa2, (bf16x8){l2[0], l2[1], l2[2], l2[3], h2[0], h2[1], h2[2], h2[3]}, o[d0], 0, 0, 0);   \
        o[d0] = __builtin_amdgcn_mfma_f32_32x32x16_bf16(pa3, (bf16x8){l3[0], l3[1], l3[2], l3[3], h3[0], h3[1], h3[2], h3[3]}, o[d0], 0, 0, 0); } while (0)
    PV_D0(0); PV_D0(1); PV_D0(2); PV_D0(3);
#undef PV_D0
#undef TRRD
}

#define DA_VMW() asm volatile("s_waitcnt vmcnt(0)" ::: "memory")
#define DA_SLOAD(koff_, voff_, k0) do { const unsigned tb_ = (unsigned)(k0) * (PITCH * 2); S.st_v0 = bld8(R, lv, (voff_) + tb_); S.st_v1 = bld8(R, lv, (voff_) + tb_ + 32 * PITCH * 2); \
                                  S.st_k = bld8(R, lk, (koff_) + tb_); } while (0)
#define DA_SWRITE_K(bf) do { *(LAS bf16x8*)(K_lds + (bf) * SHM_K + kws) = S.st_k; } while (0)
#define DA_SWRITE_V(bf) do { *(LAS bf16x8*)(V_lds + (bf) * SHM_V + vst0) = S.st_v0; *(LAS bf16x8*)(V_lds + (bf) * SHM_V + vst1) = S.st_v1; } while (0)

__device__ __forceinline__ void prime(const Ref& cur, LAS unsigned char* lds, Seam& S, rsrc_t R) {
    const int tid = threadIdx.x, wid = __builtin_amdgcn_readfirstlane(tid >> 6), lane = tid & 63, r32 = lane & 31, hi = lane >> 5;
    const int sr = tid >> 4, sc = (tid & 15) * 8, kr = tid >> 3, kc = tid & 7, kws = kr * 128 + ((kc ^ ((kr >> 1) & 7)) << 4);
    const unsigned lv = (unsigned)(sr * PITCH + sc) * 2u, lk = (unsigned)(kr * PITCH + kc * 8) * 2u, lq = (unsigned)((wid * QBLK + r32) * PITCH + hi * 8) * 2u;
    LAS unsigned char* K_lds = lds + OFF_K;
#pragma unroll
    for (int d0 = 0; d0 < 4; ++d0) S.qr[d0] = bld8(R, lq + d0 * 32, cur.qoff);
    DA_SLOAD(cur.koff, cur.voff, 0); DA_VMW(); DA_SWRITE_K(0);
    __syncthreads();
}
__device__ __forceinline__ void block(const Ref& cur, const Ref& nxt, LAS unsigned char* lds, Seam& S, float lam, const float* gsub, rsrc_t R) {
    const int tid = threadIdx.x, wid = __builtin_amdgcn_readfirstlane(tid >> 6), lane = tid & 63, r32 = lane & 31, hi = lane >> 5;
    const int NT = (cur.P0 + QB) / KVBLK;
    const int qlo = cur.P0 + wid * QBLK;
    LAS unsigned char* V_lds = lds + OFF_V; LAS unsigned char* K_lds = lds + OFF_K;
    LAS float* ws = (LAS float*)(lds + OFF_WS) + wid * 64; LAS float* li_l = ws; LAS float* al_l = ws + 32;
    const LAS float* tbh = (const LAS float*)(lds + OFF_TB) + cur.h * 128;
    float mhat = 0.f, l_reg = 0.f; f32x16 o[4] = {}; f32x16 negm = f32x16{};
    bool resc = false;
    const int sr = tid >> 4, sc = (tid & 15) * 8, vst0 = v_st(sr, sc), vst1 = v_st(32 + sr, sc);
    const int kr = tid >> 3, kc = tid & 7, kws = kr * 128 + ((kc ^ ((kr >> 1) & 7)) << 4);
    const int vb0 = (int)(unsigned)(uintptr_t)V_lds + v_rd_base(lane);
    const unsigned lv = (unsigned)(sr * PITCH + sc) * 2u, lk = (unsigned)(kr * PITCH + kc * 8) * 2u;
    const unsigned Kh = cur.koff, Vh = cur.voff;
    const int ksw = (r32 >> 1) & 7;
    const LAS unsigned char* kbase = K_lds + r32 * 128;
#define KBASE(t) ((t) * KVBLK)
#define NEAR(P0_, P1_, t) do { const int kb_ = KBASE(t); if (kb_ >= qlo - 175) bias_mask(P0_, P1_, qlo - kb_, tbh); } while (0)
#define RESC() do { if (resc) { asm volatile("s_waitcnt lgkmcnt(0)" ::: "memory");              \
                     _Pragma("unroll") for (int d_ = 0; d_ < 4; ++d_) _Pragma("unroll") for (int r = 0; r < 16; ++r) o[d_][r] *= al_l[crow(r, hi)]; } } while (0)
#define PIN(x) asm volatile("" : "+v"(x))
#define EX(v) __builtin_amdgcn_exp2f(v)
#define MX3(a, b, c) __builtin_fmaxf(__builtin_fmaxf((a), (b)), (c))
#define DECIDE(C0, C1, FIRST) do { \
        float a_ = MX3(C0[0], C0[1], C1[0]), b_ = MX3(C0[2], C0[3], C1[1]); a_ = MX3(a_, C1[2], C1[3]); \
        _Pragma("unroll") for (int r = 4; r < 16; r += 4) { a_ = MX3(a_, C0[r], C0[r + 1]); b_ = MX3(b_, C0[r + 2], C0[r + 3]); a_ = MX3(a_, C1[r], C1[r + 1]); b_ = MX3(b_, C1[r + 2], C1[r + 3]); } \
        float rm_ = __builtin_fmaxf(a_, b_); { auto rr_ = __builtin_amdgcn_permlane32_swap(__float_as_uint(rm_), __float_as_uint(rm_), false, false); rm_ = __builtin_fmaxf(__uint_as_float(rr_[0]), __uint_as_float(rr_[1])); } \
        resc = false; \
        if ((FIRST) || __builtin_expect(__any(rm_ > THR), 0)) { const float dl_ = (FIRST) ? rm_ : __builtin_fmaxf(rm_, 0.f); mhat += dl_; \
            _Pragma("unroll") for (int r = 0; r < 16; ++r) { C0[r] -= dl_; C1[r] -= dl_; } \
            _Pragma("unroll") for (int r = 0; r < 16; ++r) negm[r] = -mhat; \
            asm volatile("" : "+v"(negm)); \
            if (!(FIRST)) { const float f_ = EX(-dl_); l_reg *= f_; if (hi == 0) al_l[r32] = f_; resc = true; } } } while (0)
#define KF(d0, hf) (*(const LAS bf16x8*)(kbase + (KB_) * SHM_K + (((2 * (d0) + hi) ^ ksw) << 4) + (hf) * 4096))
#define GAPA(MF, P, B, W) do { MF; sacc += P[B]; sacc += P[B + 1]; sacc += P[B + 2]; sacc += P[B + 3]; PIN(sacc); W[((B) >> 1) & 3] = pk2(P[B], P[B + 1]); W[(((B) >> 1) & 3) + 1] = pk2(P[B + 2], P[B + 3]); PIN(W); SBAR(); } while (0)
#define PHASE_A(C0, C1, P0, P1, KBv) do { constexpr int KB_ = KBv; \
        const bf16x8 k00 = KF(0, 0), k01 = KF(0, 1), k10 = KF(1, 0), k11 = KF(1, 1), k20 = KF(2, 0), k21 = KF(2, 1), k30 = KF(3, 0), k31 = KF(3, 1); \
        float sacc = 0.f; SBAR(); \
        GAPA(C0 = __builtin_amdgcn_mfma_f32_32x32x16_bf16(k00, S.qr[0], negm, 0, 0, 0), P0, 0, pw0); \
        GAPA(C1 = __builtin_amdgcn_mfma_f32_32x32x16_bf16(k01, S.qr[0], negm, 0, 0, 0), P0, 4, pw0); \
        GAPA(C0 = __builtin_amdgcn_mfma_f32_32x32x16_bf16(k10, S.qr[1], C0, 0, 0, 0), P0, 8, pw1); \
        GAPA(C1 = __builtin_amdgcn_mfma_f32_32x32x16_bf16(k11, S.qr[1], C1, 0, 0, 0), P0, 12, pw1); \
        GAPA(C0 = __builtin_amdgcn_mfma_f32_32x32x16_bf16(k20, S.qr[2], C0, 0, 0, 0), P1, 0, pw2); \
        GAPA(C1 = __builtin_amdgcn_mfma_f32_32x32x16_bf16(k21, S.qr[2], C1, 0, 0, 0), P1, 4, pw2); \
        GAPA(C0 = __builtin_amdgcn_mfma_f32_32x32x16_bf16(k30, S.qr[3], C0, 0, 0, 0), P1, 8, pw3); \
        GAPA(C1 = __builtin_amdgcn_mfma_f32_32x32x16_bf16(k31, S.qr[3], C1, 0, 0, 0), P1, 12, pw3); \
        l_reg += sacc; } while (0)
#define TRRD(dst, off) asm volatile("ds_read_b64_tr_b16 %0, %1 offset:%2" : "=&v"(dst) : "v"(vb0), "i"(off) : "memory")
#define VRD8(L0, H0, L1, H1, L2, H2, L3, H3, VBv, d0) do { constexpr int b_ = (VBv) * SHM_V + v_rd_off(d0, 0, 0); \
        TRRD(L0, b_); TRRD(H0, b_ + 2048); TRRD(L1, b_ + 4096); TRRD(H1, b_ + 6144); TRRD(L2, b_ + 8192); TRRD(H2, b_ + 10240); TRRD(L3, b_ + 12288); TRRD(H3, b_ + 14336); } while (0)
#define VF(L, H) (bf16x8){L[0], L[1], L[2], L[3], H[0], H[1], H[2], H[3]}
#define PAF(k) __builtin_bit_cast(bf16x8, pw##k)
#define GAPB(MF, X, B) do { MF; X[B] = EX(X[B]); X[(B) + 1] = EX(X[(B) + 1]); PIN(X); SBAR(); } while (0)
#define PV4(d0, L0, H0, L1, H1, L2, H2, L3, H3, X, B) do { \
        GAPB(o[d0] = __builtin_amdgcn_mfma_f32_32x32x16_bf16(PAF(0), VF(L0, H0), o[d0], 0, 0, 0), X, (B)); \
        GAPB(o[d0] = __builtin_amdgcn_mfma_f32_32x32x16_bf16(PAF(1), VF(L1, H1), o[d0], 0, 0, 0), X, (B) + 2); \
        GAPB(o[d0] = __builtin_amdgcn_mfma_f32_32x32x16_bf16(PAF(2), VF(L2, H2), o[d0], 0, 0, 0), X, (B) + 4); \
        GAPB(o[d0] = __builtin_amdgcn_mfma_f32_32x32x16_bf16(PAF(3), VF(L3, H3), o[d0], 0, 0, 0), X, (B) + 6); } while (0)
#define LWAIT(n) do { asm volatile("s_waitcnt lgkmcnt(" #n ")" ::: "memory"); SBAR(); } while (0)
#define PHASE_B(C0, C1, VBv) do { s16x4 a0, a1, a2, a3, a4, a5, a6, a7, b0, b1, b2, b3, b4, b5, b6, b7; \
        asm volatile("s_waitcnt lgkmcnt(0)" ::: "memory"); SBAR(); \
        VRD8(a0, a1, a2, a3, a4, a5, a6, a7, VBv, 0); VRD8(b0, b1, b2, b3, b4, b5, b6, b7, VBv, 1); LWAIT(8); \
        PV4(0, a0, a1, a2, a3, a4, a5, a6, a7, C0, 0); \
        VRD8(a0, a1, a2, a3, a4, a5, a6, a7, VBv, 2); LWAIT(8); \
        PV4(1, b0, b1, b2, b3, b4, b5, b6, b7, C0, 8); \
        VRD8(b0, b1, b2, b3, b4, b5, b6, b7, VBv, 3); LWAIT(8); \
        PV4(2, a0, a1, a2, a3, a4, a5, a6, a7, C1, 0); \
        LWAIT(0); \
        PV4(3, b0, b1, b2, b3, b4, b5, b6, b7, C1, 8); } while (0)
    f32x16 pA0, pA1, pB0, pB1; u32x4 pw0, pw1, pw2, pw3;
    DA_SWRITE_V(0); SBAR();
    DA_SLOAD(Kh, Vh, KBASE(1));
    SBAR();
    { constexpr int KB_ = 0;
      const bf16x8 k00 = KF(0, 0), k01 = KF(0, 1), k10 = KF(1, 0), k11 = KF(1, 1), k20 = KF(2, 0), k21 = KF(2, 1), k30 = KF(3, 0), k31 = KF(3, 1);
      pA0 = __builtin_amdgcn_mfma_f32_32x32x16_bf16(k00, S.qr[0], negm, 0, 0, 0); pA1 = __builtin_amdgcn_mfma_f32_32x32x16_bf16(k01, S.qr[0], negm, 0, 0, 0);
      pA0 = __builtin_amdgcn_mfma_f32_32x32x16_bf16(k10, S.qr[1], pA0, 0, 0, 0); pA1 = __builtin_amdgcn_mfma_f32_32x32x16_bf16(k11, S.qr[1], pA1, 0, 0, 0);
      pA0 = __builtin_amdgcn_mfma_f32_32x32x16_bf16(k20, S.qr[2], pA0, 0, 0, 0); pA1 = __builtin_amdgcn_mfma_f32_32x32x16_bf16(k21, S.qr[2], pA1, 0, 0, 0);
      pA0 = __builtin_amdgcn_mfma_f32_32x32x16_bf16(k30, S.qr[3], pA0, 0, 0, 0); pA1 = __builtin_amdgcn_mfma_f32_32x32x16_bf16(k31, S.qr[3], pA1, 0, 0, 0); }
    NEAR(pA0, pA1, 0); DECIDE(pA0, pA1, true);
#pragma unroll
    for (int r = 0; r < 16; ++r) { pA0[r] = EX(pA0[r]); pA1[r] = EX(pA1[r]); }
    DA_VMW(); DA_SWRITE_V(1); DA_SWRITE_K(1);
    __syncthreads();
#define STEP(C0, C1, P0, P1, t, KBv, VBv, SBv) do { SBAR(); \
        PHASE_A(C0, C1, P0, P1, KBv); \
        if ((t) + 1 < NT) { DA_SLOAD(Kh, Vh, KBASE((t) + 1)); } SBAR(); \
        NEAR(C0, C1, (t)); DECIDE(C0, C1, false); SBAR(); \
        PHASE_B(C0, C1, VBv); \
        __syncthreads(); \
        if ((t) + 1 < NT) { DA_VMW(); DA_SWRITE_V(SBv); DA_SWRITE_K(SBv); } \
        RESC(); __syncthreads(); } while (0)
    int t = 1;
    for (; t + 2 < NT; t += 2) {
        STEP(pB0, pB1, pA0, pA1, t, 1, 0, 0);
        STEP(pA0, pA1, pB0, pB1, t + 1, 0, 1, 1);
    }
    SBAR(); PHASE_A(pB0, pB1, pA0, pA1, 1);
    DA_SLOAD(nxt.koff, nxt.voff, 0); SBAR();
    { const unsigned lq = (unsigned)((wid * QBLK + r32) * PITCH + hi * 8) * 2u;
#pragma unroll
      for (int d0 = 0; d0 < 4; ++d0) S.qr[d0] = bld8(R, lq + d0 * 32, nxt.qoff); }
    SBAR();
    NEAR(pB0, pB1, NT - 1); DECIDE(pB0, pB1, false); SBAR();
    PHASE_B(pB0, pB1, 0);
    RESC();
    { float sacc = 0.f;
#pragma unroll
      for (int r = 0; r < 16; ++r) { sacc += pB0[r]; sacc += pB1[r]; }
      l_reg += sacc;
      pw0 = (u32x4){pk2(pB0[0], pB0[1]), pk2(pB0[2], pB0[3]), pk2(pB0[4], pB0[5]), pk2(pB0[6], pB0[7])}; pw1 = (u32x4){pk2(pB0[8], pB0[9]), pk2(pB0[10], pB0[11]), pk2(pB0[12], pB0[13]), pk2(pB0[14], pB0[15])};
      pw2 = (u32x4){pk2(pB1[0], pB1[1]), pk2(pB1[2], pB1[3]), pk2(pB1[4], pB1[5]), pk2(pB1[6], pB1[7])}; pw3 = (u32x4){pk2(pB1[8], pB1[9]), pk2(pB1[10], pB1[11]), pk2(pB1[12], pB1[13]), pk2(pB1[14], pB1[15])};
      SBAR(); pv_tile<1>(o, vb0, PAF(0), PAF(1), PAF(2), PAF(3)); }
    SBAR(); asm volatile("s_waitcnt vmcnt(4)" ::: "memory"); DA_SWRITE_K(0); SBAR();
    { auto rr = __builtin_amdgcn_permlane32_swap(__float_as_uint(l_reg), __float_as_uint(l_reg), false, false); l_reg = __uint_as_float(rr[0]) + __uint_as_float(rr[1]); }
    int lane_e = (int)__builtin_amdgcn_mbcnt_hi(~0u, __builtin_amdgcn_mbcnt_lo(~0u, 0u)); asm volatile("" : "+v"(lane_e));
    const int r32e = lane_e & 31, hie = lane_e >> 5;
    if (hi == 0) li_l[r32] = l_reg; asm volatile("s_waitcnt lgkmcnt(0)" ::: "memory");
    float rli[16];
#pragma unroll
    for (int r = 0; r < 16; ++r) rli[r] = __builtin_amdgcn_rcpf(li_l[crow(r, hi)]);
    LAS unsigned* st = (LAS unsigned*)(lds + OFF_STASH + wid * 8192) + lane_e;
    if (cur.comp == 0) {
#pragma unroll
        for (int r = 0; r < 16; ++r) { st[(2 * r) * 64] = pk2(o[0][r] * rli[r], o[1][r] * rli[r]); st[(2 * r + 1) * 64] = pk2(o[2][r] * rli[r], o[3][r] * rli[r]); }
    } else {
        float ss[16];
#pragma unroll
        for (int r = 0; r < 16; ++r) { const unsigned u0 = st[(2 * r) * 64], u1 = st[(2 * r + 1) * 64];
            const float s2 = lam * rli[r];
            o[0][r] = bflo(u0) - s2 * o[0][r]; o[1][r] = bfhi(u0) - s2 * o[1][r]; o[2][r] = bflo(u1) - s2 * o[2][r]; o[3][r] = bfhi(u1) - s2 * o[3][r];
            ss[r] = (o[0][r] * o[0][r] + o[1][r] * o[1][r]) + (o[2][r] * o[2][r] + o[3][r] * o[3][r]); }
#pragma unroll
        for (int r = 0; r < 16; ++r) {
#pragma unroll
            for (int x = 1; x < 32; x <<= 1) ss[r] += __shfl_xor(ss[r], x);
            ss[r] = rsqrtf(ss[r] * (1.f / 128.f) + EPS) * 0.8f; }
        float gg[4];
#pragma unroll
        for (int d0 = 0; d0 < 4; ++d0) gg[d0] = gsub[d0 * 32 + r32e];
        bf16_t* Ow = cur.O + (size_t)(wid * QBLK) * DM;
#pragma unroll
        for (int r = 0; r < 16; ++r) { const int orow = crow(r, hie);
#pragma unroll
            for (int d0 = 0; d0 < 4; ++d0) { const float v = o[d0][r] * ss[r] * gg[d0]; const float vn = __shfl_xor(v, 1);
                if ((r32e & 1) == 0) *(unsigned*)(Ow + (size_t)orow * DM + d0 * 32 + r32e) = pk2(v, vn); } }
    }
    __syncthreads();
#undef RESC
#undef KBASE
#undef NEAR
#undef PIN
#undef EX
#undef MX3
#undef DECIDE
#undef KF
#undef GAPA
#undef PHASE_A
#undef TRRD
#undef VRD8
#undef VF
#undef PAF
#undef GAPB
#undef PV4
#undef LWAIT
#undef PHASE_B
#undef STEP
}
#undef DA_VMW
#undef DA_SLOAD
#undef DA_SWRITE_K
#undef DA_SWRITE_V
}

constexpr int NWAVES = 8;
constexpr int N_LAUNCHES = MK_N_LAUNCHES;
constexpr int N_PHASES = 9;
static_assert(N_LAUNCHES == 1 || N_LAUNCHES == N_PHASES, "MK_N_LAUNCHES is 1 or 9");

constexpr size_t MiB = 1u << 20;
constexpr size_t WS_CTL = 0, CTL_ZERO_BYTES = 1 * MiB;
constexpr size_t WS_ETK = 1 * MiB, WS_GTK = 2 * MiB, WS_RSTDT = 3 * MiB, WS_SLOTTK = 4 * MiB, WS_TOKSLOT = 5 * MiB, WS_GATESLOT = 7 * MiB, WS_RSTDSLOT = 9 * MiB, WS_RBE = 11 * MiB;
constexpr size_t WS_WRHI = 12 * MiB, WS_WRLO = 12 * MiB + 65536, WS_KMB = 13 * MiB, WS_VMT = 14 * MiB;
constexpr size_t WS_WIN = 16 * MiB, WS_WOUT = 21 * MiB, WS_X1B = 24 * MiB, WS_X1Q = 152 * MiB;
constexpr size_t WS_BIG = 216 * MiB;
constexpr size_t WS_H = WS_BIG, WS_PROJ = WS_BIG + 128 * MiB, WS_MIX = WS_BIG + 448 * MiB;
constexpr size_t WS_ACTQ = WS_BIG, WS_Y = WS_BIG + 264 * MiB;
constexpr size_t WS_END = WS_BIG + 792 * MiB;
static_assert(WS_END <= 1024 * MiB, "d_ws map");
constexpr size_t OUT_WGU = 0, OUT_WD = 64 * MiB;
constexpr int CW_BAR = 4096, CW_COUNT = 1024, CW_CURSOR = 2048;
constexpr int RING_BYTES = 131072, LDSCTL_OFF = RING_BYTES, MISC_OFF = LDSCTL_OFF + 320, LDS_BYTES = 147456;
static_assert(dattn::LDS_BYTES <= RING_BYTES, "attention scratch");

#define XB_TMO      128
#define XB_XCNT(j)  (256  + 64 * (j))
#define XB_XSUB(j)  (1280 + 64 * (j))
#define XB_XGEN(j)  (2304 + 64 * (j))
#define XB_TOP      3328
#define XB_TOPGEN   3392
#define XCD_BAR_WORDS 3456
#define XB_SPIN_CAP (1u << 18)
__device__ __forceinline__ unsigned xb_ld(unsigned* p)              { return __hip_atomic_load(p, __ATOMIC_RELAXED, __HIP_MEMORY_SCOPE_AGENT); }
__device__ __forceinline__ unsigned xb_add(unsigned* p, unsigned v) { return __hip_atomic_fetch_add(p, v, __ATOMIC_RELAXED, __HIP_MEMORY_SCOPE_AGENT); }
__device__ __forceinline__ unsigned xb_xcc_id() { return (unsigned)__builtin_amdgcn_s_getreg((3 << 11) | 20) & 0xFu; }
#define XB_SPIN(cond, bar) do { unsigned _sp = 0; while (cond) { __builtin_amdgcn_s_sleep(1); \
    if ((++_sp & 255u) == 0u) { if (xb_ld(&(bar)[XB_TMO])) break; if (_sp > XB_SPIN_CAP) { atomicAdd(&(bar)[XB_TMO], 1u); break; } } } } while (0)
struct XcdBarrier { unsigned* bar; unsigned x; volatile LAS unsigned* st; };
__device__ __forceinline__ XcdBarrier xcd_barrier_post(unsigned* bar, volatile LAS unsigned* st) {
    XcdBarrier b; b.bar = bar; b.x = xb_xcc_id(); b.st = st;
    if (threadIdx.x == 0) (void)xb_add(&bar[XB_XCNT(b.x)], 1u);
    return b;
}
__device__ __forceinline__ void xcd_barrier_complete(unsigned* bar, unsigned x, unsigned& nloc, unsigned& nx) {
    const unsigned G = gridDim.x * gridDim.y * gridDim.z;
    unsigned sum, cnt, mine, sp = 0u;
    for (;;) {
        sum = 0u; cnt = 0u; mine = 0u;
#pragma unroll
        for (unsigned j = 0; j < 16; ++j) { const unsigned c = xb_ld(&bar[XB_XCNT(j)]); sum += c; cnt += (c > 0u) ? 1u : 0u; mine = (j == x) ? c : mine; }
        if (sum == G) break;
        __builtin_amdgcn_s_sleep(1);
        if ((++sp & 255u) == 0u) { if (xb_ld(&bar[XB_TMO])) break; if (sp > XB_SPIN_CAP) { atomicAdd(&bar[XB_TMO], 1u); break; } }
    }
    nloc = mine > 0u ? mine : 1u; nx = cnt > 0u ? cnt : 1u;
}
__device__ __forceinline__ void xcd_barrier(const XcdBarrier& b) {
    asm volatile("s_waitcnt vmcnt(0)" ::: "memory");
    __syncthreads();
    if (threadIdx.x == 0) {
        unsigned* bar = b.bar;
        __builtin_amdgcn_s_waitcnt(0);
        unsigned nloc = b.st[0], nx = b.st[1];
        if (nloc == 0u) { xcd_barrier_complete(bar, b.x, nloc, nx); b.st[0] = nloc; b.st[1] = nx; }
        const unsigned old = xb_add(&bar[XB_XSUB(b.x)], 1u);
        const unsigned gen = old / nloc;
        if (old + 1u == (gen + 1u) * nloc) {
            __builtin_amdgcn_fence(__ATOMIC_RELEASE, "agent");
            asm volatile("s_waitcnt vmcnt(0)" ::: "memory");
            const unsigned og = xb_add(&bar[XB_TOP], 1u);
            const unsigned tg = og / nx;
            if (og + 1u == (tg + 1u) * nx) xb_add(&bar[XB_TOPGEN], 1u);
            else XB_SPIN(xb_ld(&bar[XB_TOPGEN]) == tg, bar);
            __builtin_amdgcn_fence(__ATOMIC_ACQUIRE, "agent");
            xb_add(&bar[XB_XGEN(b.x)], 1u);
            asm volatile("s_waitcnt vmcnt(0)" ::: "memory");
        } else {
            XB_SPIN(xb_ld(&bar[XB_XGEN(b.x)]) == gen, bar);
            __builtin_amdgcn_fence(__ATOMIC_ACQUIRE, "agent");
            asm volatile("s_waitcnt vmcnt(0)" ::: "memory");
        }
    }
    __syncthreads();
}

struct Frame {
    LAS unsigned char* lds;
    volatile LAS unsigned* MISC;
    unsigned* ctl;
    int tid, lane, wave, vcu, G;
    float* out;
    unsigned char* ws;
};
struct Args { const float* in[19]; float* out; unsigned char* ws; int ph_lo, ph_hi; };
typedef const __attribute__((address_space(4))) Args* KArgs;
__device__ __forceinline__ KArgs kargs() { KArgs p = (KArgs)__builtin_amdgcn_kernarg_segment_ptr(); asm volatile("" : "+s"(p)); return p; }
enum { I_X = 0, I_MEM, I_RELB, I_ATTNG, I_WIN, I_CONVW, I_LAMQK, I_SUBG, I_MEMG, I_WMEMKV, I_WOUT, I_FFNG, I_RW, I_RB, I_WGU, I_BGU, I_WDN, I_BDN, I_FING };

__device__ __forceinline__ void p0_transpose_item(const float* W, int K, int N, bf16_t* WT, int k0, int n0, int drow0, const float* kgain, LAS float* scr, int lane) {
#pragma unroll 8
    for (int i = 0; i < 32; ++i) { const int kk = 2 * i + (lane >> 5); float v = W[(size_t)(k0 + kk) * N + n0 + (lane & 31)]; if (kgain) v *= kgain[k0 + kk]; scr[kk * 33 + (lane & 31)] = v; }
    LDS_WAIT(); asm volatile("" ::: "memory");
    const int c = lane & 7;
#pragma unroll
    for (int j = 0; j < 4; ++j) { const int n = (lane >> 3) + 8 * j; const LAS float* s = scr + (8 * c) * 33 + n;
        u32x4 o; o.x = pk2(s[0 * 33], s[1 * 33]); o.y = pk2(s[2 * 33], s[3 * 33]); o.z = pk2(s[4 * 33], s[5 * 33]); o.w = pk2(s[6 * 33], s[7 * 33]);
        *(u32x4*)(WT + (size_t)(drow0 + n) * K + k0 + 8 * c) = o; }
    LDS_WAIT(); asm volatile("" ::: "memory");
}
__device__ __forceinline__ void rms_row_to_bf16(const float* xrow, const float* g, bf16_t* orow, int lane) {
    const f32x4* xr = (const f32x4*)xrow + lane; const f32x4* gr = (const f32x4*)g + lane;
    f32x4 v[4]; float s = 0.f;
#pragma unroll
    for (int j = 0; j < 4; ++j) { v[j] = xr[64 * j]; s += (v[j].x * v[j].x + v[j].y * v[j].y) + (v[j].z * v[j].z + v[j].w * v[j].w); }
    const float rstd = rsqrtf(wave_sum(s) * (1.f / DM) + EPS);
    unsigned long long* o8 = (unsigned long long*)orow + lane;
#pragma unroll
    for (int j = 0; j < 4; ++j) { const f32x4 gg = gr[64 * j];
        o8[64 * j] = (unsigned long long)pk2(v[j].x * rstd * gg.x, v[j].y * rstd * gg.y) | ((unsigned long long)pk2(v[j].z * rstd * gg.z, v[j].w * rstd * gg.w) << 32); }
}
__device__ __forceinline__ void p0_kvm_tile(Frame& F, int tile, const float* mem, const float* mem_g, const float* w_memkv) {
    const int mt = tile >> 3, ntile = tile & 7, row0 = 64 * mt, col0 = 64 * ntile;
    const int mb = F.wave >> 1, nb0 = (F.wave & 1) * 2, ar = F.lane & 15, kq = F.lane >> 4;
    const float* arow = mem + (size_t)(row0 + mb * 16 + ar) * DM;
    f32x4 acc[2]; acc[0] = (f32x4){0.f, 0.f, 0.f, 0.f}; acc[1] = acc[0];
    float ss = 0.f;
    for (int k0 = 0; k0 < DM; k0 += 32) {
        const int kk = k0 + 8 * kq;
        const f32x4 a0 = *(const f32x4*)(arow + kk), a1 = *(const f32x4*)(arow + kk + 4), g0 = *(const f32x4*)(mem_g + kk), g1 = *(const f32x4*)(mem_g + kk + 4);
        ss += (a0.x * a0.x + a0.y * a0.y) + (a0.z * a0.z + a0.w * a0.w) + (a1.x * a1.x + a1.y * a1.y) + (a1.z * a1.z + a1.w * a1.w);
        const bf16x8 af = pack8(a0 * g0, a1 * g1);
#pragma unroll
        for (int nbi = 0; nbi < 2; ++nbi) { const float* wp = w_memkv + (size_t)kk * 512 + col0 + (nb0 + nbi) * 16 + ar;
            f32x4 b0, b1; b0.x = wp[0]; b0.y = wp[512]; b0.z = wp[1024]; b0.w = wp[1536]; b1.x = wp[2048]; b1.y = wp[2560]; b1.z = wp[3072]; b1.w = wp[3584];
            acc[nbi] = __builtin_amdgcn_mfma_f32_16x16x32_bf16(af, pack8(b0, b1), acc[nbi], 0, 0, 0); }
    }
    ss += __shfl_xor(ss, 16); ss += __shfl_xor(ss, 32);
    const float rstd = rsqrtf(ss * (1.f / DM) + EPS);
    float rs[4];
#pragma unroll
    for (int j = 0; j < 4; ++j) rs[j] = __shfl(rstd, kq * 4 + j);
    bf16_t* kmb = (bf16_t*)(F.ws + WS_KMB); bf16_t* vmt = (bf16_t*)(F.ws + WS_VMT);
#pragma unroll
    for (int nbi = 0; nbi < 2; ++nbi) {
        const int gc = col0 + (nb0 + nbi) * 16 + ar, gr0 = row0 + mb * 16 + kq * 4;
        if (ntile < 4) {
#pragma unroll
            for (int j = 0; j < 4; ++j) kmb[(size_t)(gr0 + j) * 256 + gc] = (bf16_t)(pk2(acc[nbi][j] * rs[j], 0.f) & 0xffffu);
        } else {
            const int d = gc - 256, hm = d >> 6, dd = d & 63, b = gr0 >> 8, m = gr0 & 255;
            u32x2 w; w.x = pk2(acc[nbi][0] * rs[0], acc[nbi][1] * rs[1]); w.y = pk2(acc[nbi][2] * rs[2], acc[nbi][3] * rs[3]);
            *(u32x2*)(vmt + ((size_t)((b * 4 + hm) * 64 + dd)) * 256 + m) = w;
        }
    }
}
__device__ __forceinline__ void p0_transpose_item_fp8(const float* W, int K, int N, unsigned char* WT, int k0, int n0, int drow0, const float* kgain, float scale, LAS float* scr, int lane) {
#pragma unroll 8
    for (int i = 0; i < 32; ++i) { const int kk = 2 * i + (lane >> 5); float v = W[(size_t)(k0 + kk) * N + n0 + (lane & 31)] * scale; if (kgain) v *= kgain[k0 + kk]; scr[kk * 33 + (lane & 31)] = v; }
    LDS_WAIT(); asm volatile("" ::: "memory");
    const int c = lane & 7;
#pragma unroll
    for (int j = 0; j < 4; ++j) { const int n = (lane >> 3) + 8 * j; const LAS float* s = scr + (8 * c) * 33 + n;
        u32x2 o; o.x = pg8::pk4_fp8(s[0 * 33], s[1 * 33], s[2 * 33], s[3 * 33]); o.y = pg8::pk4_fp8(s[4 * 33], s[5 * 33], s[6 * 33], s[7 * 33]);
        *(u32x2*)(WT + (size_t)(drow0 + n) * K + k0 + 8 * c) = o; }
    LDS_WAIT(); asm volatile("" ::: "memory");
}
__device__ __forceinline__ void p0_prologue(Frame& F) {
    KArgs A = kargs();
    { const float* mem = A->in[I_MEM]; const float* mem_g = A->in[I_MEMG]; const float* w_memkv = A->in[I_WMEMKV];
      for (int tile = blockIdx.x; tile < 256; tile += F.G) p0_kvm_tile(F, tile, mem, mem_g, w_memkv); }
    const float* w_in = A->in[I_WIN]; const float* w_out = A->in[I_WOUT]; const float* w_gu = A->in[I_WGU]; const float* w_dn = A->in[I_WDN]; const float* ffn_g = A->in[I_FFNG];
    LAS float* scr = (LAS float*)(F.lds + F.wave * 16384);
    const int gw = F.vcu * NWAVES + F.wave, NGW = F.G * NWAVES;
    bf16_t* Win_t = (bf16_t*)(F.ws + WS_WIN); bf16_t* Wout_t = (bf16_t*)(F.ws + WS_WOUT);
    unsigned char* Wgu_q = (unsigned char*)F.out + OUT_WGU; unsigned char* Wd_q = (unsigned char*)F.out + OUT_WD;
    constexpr int I_IN = 16 * 80, I_OUT = 16 * 32, I_GU1 = 16 * 64, I_D1 = 16 * 32;
    constexpr int I_GU = NEXP * I_GU1, I_D = NEXP * I_D1, NITEMS = I_IN + I_OUT + I_GU + I_D;
    for (int it = gw; it < NITEMS; it += NGW) {
        int r = it;
        if (r < I_IN) { const int kb = r / 80, nb = r % 80; p0_transpose_item(w_in, DM, INW, Win_t, 64 * kb, 32 * nb, 32 * nb, nullptr, scr, F.lane); continue; } r -= I_IN;
        if (r < I_OUT) { const int kb = r / 32, nb = r % 32; p0_transpose_item(w_out, DM, DM, Wout_t, 64 * kb, 32 * nb, 32 * nb, nullptr, scr, F.lane); continue; } r -= I_OUT;
        if (r < I_GU) { const int e = r / I_GU1, q = r % I_GU1, kb = q / 64, nb = q % 64, n0 = 32 * nb;
            const int jj = n0 & 1023, drow0 = (jj >> 7) * 256 + (n0 >= 1024 ? 128 : 0) + (jj & 127);
            p0_transpose_item_fp8(w_gu + (size_t)e * DM * 2048, DM, 2048, Wgu_q + (size_t)e * 2048 * DM, 64 * kb, n0, drow0, ffn_g, 64.f, scr, F.lane); continue; } r -= I_GU;
        { const int e = r / I_D1, q = r % I_D1, kb = q / 32, nb = q % 32;
            p0_transpose_item_fp8(w_dn + (size_t)e * DEXP * DM, DEXP, DM, Wd_q + (size_t)e * DM * DEXP, 64 * kb, 32 * nb, 32 * nb, nullptr, 64.f, scr, F.lane); }
    }
    bf16_t* H = (bf16_t*)(F.ws + WS_H);
    { const float* x = A->in[I_X]; const float* attn_g = A->in[I_ATTNG];
      for (int m = gw; m < T; m += NGW) rms_row_to_bf16(x + (size_t)m * DM, attn_g, H + (size_t)m * DM, F.lane); }
    const float* router_w = A->in[I_RW];
    bf16_t* wrh = (bf16_t*)(F.ws + WS_WRHI); bf16_t* wrl = (bf16_t*)(F.ws + WS_WRLO);
    for (int i = (F.vcu * NWAVES + F.wave) * 64 + F.lane; i < NEXP * DM; i += NGW * 64) { const int e = i >> 10, k = i & 1023;
        const float v = ffn_g[k] * router_w[(size_t)k * NEXP + e]; const unsigned hb = pk2(v, 0.f) & 0xffffu; const float hf = __uint_as_float(hb << 16);
        wrh[i] = (bf16_t)hb; wrl[i] = (bf16_t)(pk2(v - hf, 0.f) & 0xffffu); }
}

__device__ __forceinline__ void p2_conv_block(Frame& F, int blk, int tid_, const float* conv_w) {
    const bf16_t* proj = (const bf16_t*)(F.ws + WS_PROJ); bf16_t* mix = (bf16_t*)(F.ws + WS_MIX);
    const int cg = tid_ & 31, tc = tid_ >> 5;
    const int c0 = cg * 8, t0 = blk * 256 + tc * 16, s0 = t0 & (SEQ - 1);
    float w0[8], w1[8], w2[8];
#pragma unroll
    for (int i = 0; i < 8; ++i) { w0[i] = conv_w[c0 + i]; w1[i] = conv_w[256 + c0 + i]; w2[i] = conv_w[512 + c0 + i]; }
    float p2[8], p1[8];
#pragma unroll
    for (int i = 0; i < 8; ++i) { p2[i] = 0.f; p1[i] = 0.f; }
    if (s0 >= 2) {
        const u32x4 ua = *(const u32x4*)(proj + (size_t)(t0 - 2) * INW + COL_U + c0), ca = *(const u32x4*)(proj + (size_t)(t0 - 2) * INW + COL_GC + c0);
        const u32x4 ub = *(const u32x4*)(proj + (size_t)(t0 - 1) * INW + COL_U + c0), cb = *(const u32x4*)(proj + (size_t)(t0 - 1) * INW + COL_GC + c0);
#pragma unroll
        for (int i = 0; i < 4; ++i) { p2[2 * i] = bflo(ua[i]) * bflo(ca[i]); p2[2 * i + 1] = bfhi(ua[i]) * bfhi(ca[i]); p1[2 * i] = bflo(ub[i]) * bflo(cb[i]); p1[2 * i + 1] = bfhi(ub[i]) * bfhi(cb[i]); }
    }
    for (int tt = 0; tt < 16; ++tt) {
        const size_t ro = (size_t)(t0 + tt) * INW;
        const u32x4 uu = *(const u32x4*)(proj + ro + COL_U + c0), cc = *(const u32x4*)(proj + ro + COL_GC + c0), bb = *(const u32x4*)(proj + ro + COL_GB + c0);
        float cur[8], y[8];
#pragma unroll
        for (int i = 0; i < 4; ++i) { cur[2 * i] = bflo(uu[i]) * bflo(cc[i]); cur[2 * i + 1] = bfhi(uu[i]) * bfhi(cc[i]); }
#pragma unroll
        for (int i = 0; i < 4; ++i) { y[2 * i] = bflo(bb[i]) * (w0[2 * i] * p2[2 * i] + w1[2 * i] * p1[2 * i] + w2[2 * i] * cur[2 * i]);
                                       y[2 * i + 1] = bfhi(bb[i]) * (w0[2 * i + 1] * p2[2 * i + 1] + w1[2 * i + 1] * p1[2 * i + 1] + w2[2 * i + 1] * cur[2 * i + 1]); }
        u32x4 o; o.x = pk2(y[0], y[1]); o.y = pk2(y[2], y[3]); o.z = pk2(y[4], y[5]); o.w = pk2(y[6], y[7]);
        *(u32x4*)(mix + (size_t)(t0 + tt) * DM + c0) = o;
#pragma unroll
        for (int i = 0; i < 8; ++i) { p2[i] = p1[i]; p1[i] = cur[i]; }
    }
}
__device__ __forceinline__ void p2_mem_block(Frame& F, int blk, int lane_) {
    const bf16_t* proj = (const bf16_t*)(F.ws + WS_PROJ); bf16_t* mix = (bf16_t*)(F.ws + WS_MIX);
    const bf16_t* kmb = (const bf16_t*)(F.ws + WS_KMB); const bf16_t* vmt = (const bf16_t*)(F.ws + WS_VMT);
    const int r32 = lane_ & 31, hi = lane_ >> 5, b = blk >> 5, tw = blk * 256 + F.wave * 32;
    for (int hm = 0; hm < 4; ++hm) {
        bf16x8 qr[4];
#pragma unroll
        for (int d0 = 0; d0 < 4; ++d0) qr[d0] = *(const bf16x8*)(proj + (size_t)(tw + r32) * INW + COL_QM + hm * 64 + d0 * 16 + hi * 8);
        float mx = -__builtin_inff();
#pragma unroll 1
        for (int kb = 0; kb < 8; ++kb) { f32x16 p = f32x16{};
#pragma unroll
            for (int d0 = 0; d0 < 4; ++d0) { const bf16x8 kf = *(const bf16x8*)(kmb + (size_t)(b * 256 + kb * 32 + r32) * 256 + hm * 64 + d0 * 16 + hi * 8);
                p = __builtin_amdgcn_mfma_f32_32x32x16_bf16(kf, qr[d0], p, 0, 0, 0); }
#pragma unroll
            for (int r = 0; r < 16; ++r) mx = fmaxf(mx, p[r]); }
        mx = fmaxf(mx, __shfl_xor(mx, 32));
        float sum = 0.f;
        f32x16 o[2]; o[0] = f32x16{}; o[1] = f32x16{};
#pragma unroll 1
        for (int kb = 0; kb < 8; ++kb) { f32x16 p = f32x16{};
#pragma unroll
            for (int d0 = 0; d0 < 4; ++d0) { const bf16x8 kf = *(const bf16x8*)(kmb + (size_t)(b * 256 + kb * 32 + r32) * 256 + hm * 64 + d0 * 16 + hi * 8);
                p = __builtin_amdgcn_mfma_f32_32x32x16_bf16(kf, qr[d0], p, 0, 0, 0); }
#pragma unroll
            for (int r = 0; r < 16; ++r) { p[r] = __builtin_amdgcn_exp2f(p[r] - mx); sum += p[r]; }
            bf16x8 pa0, pa1;
#define PK4(P, B_, OUT) do { unsigned a0 = pk2(P[B_+0], P[B_+1]), a1 = pk2(P[B_+2], P[B_+3]); unsigned b0 = pk2(P[B_+4], P[B_+5]), b1 = pk2(P[B_+6], P[B_+7]); \
        auto r0 = __builtin_amdgcn_permlane32_swap(a0, b0, false, false); auto r1 = __builtin_amdgcn_permlane32_swap(a1, b1, false, false); \
        u32x4 w = {r0[0], r1[0], r0[1], r1[1]}; OUT = __builtin_bit_cast(bf16x8, w); } while (0)
            PK4(p, 0, pa0); PK4(p, 8, pa1);
#undef PK4
#pragma unroll
            for (int d0 = 0; d0 < 2; ++d0) { const bf16_t* vp = vmt + ((size_t)((b * 4 + hm) * 64 + d0 * 32 + r32)) * 256 + kb * 32 + hi * 8;
                o[d0] = __builtin_amdgcn_mfma_f32_32x32x16_bf16(pa0, *(const bf16x8*)(vp), o[d0], 0, 0, 0);
                o[d0] = __builtin_amdgcn_mfma_f32_32x32x16_bf16(pa1, *(const bf16x8*)(vp + 16), o[d0], 0, 0, 0); }
        }
        sum += __shfl_xor(sum, 32);
        const float linv = __builtin_amdgcn_rcpf(sum);
#pragma unroll
        for (int r = 0; r < 16; ++r) { const int orow = crow(r, hi); const float li = __shfl(linv, orow);
#pragma unroll
            for (int d0 = 0; d0 < 2; ++d0) { const float v = o[d0][r] * li; const float vn = __shfl_xor(v, 1);
                if ((r32 & 1) == 0) *(unsigned*)(mix + (size_t)(tw + orow) * DM + 768 + hm * 64 + d0 * 32 + r32) = pk2(v, vn); } }
    }
}
__device__ __forceinline__ dattn::Ref da_ref(Frame& F, int n) {
    const int pid = F.vcu + (n >> 2) * F.G, sub = n & 3, blk = sub >> 1, comp = sub & 1, bh = pid >> 4, s = pid & 15, qb = blk ? 31 - s : s, b = bh >> 2, h = bh & 3;
    bf16_t* mix = (bf16_t*)(F.ws + WS_MIX);
    dattn::Ref r;
    r.qoff = (unsigned)(((size_t)(b * SEQ + qb * 256) * INW + COL_Q + h * 128 + comp * 64) * 2);
    r.koff = (unsigned)(((size_t)(b * SEQ) * INW + COL_K + h * 128 + comp * 64) * 2);
    r.voff = (unsigned)(((size_t)(b * SEQ) * INW + COL_V + h * 128) * 2);
    r.O = mix + (size_t)(b * SEQ + qb * 256) * DM + 256 + h * 128;
    r.P0 = qb * 256; r.comp = comp; r.h = h;
    return r;
}
__device__ __forceinline__ void p2_mixers(Frame& F) {
    KArgs A = kargs();
    const float* rel_bias = A->in[I_RELB]; const float* lam_qk = A->in[I_LAMQK]; const float* subln_g = A->in[I_SUBG];
    if (F.tid < 512) { const int h = F.tid >> 7, n = F.tid & 127; int bk;
        if (n < 16) bk = n; else { bk = 16; const int thr[15] = {19, 21, 24, 27, 31, 35, 40, 46, 52, 59, 67, 77, 87, 99, 113};
#pragma unroll
            for (int i = 0; i < 15; ++i) bk += (n >= thr[i]) ? 1 : 0; }
        ((LAS float*)(F.lds + dattn::OFF_TB))[h * 128 + n] = (rel_bias[bk * 4 + h] - rel_bias[31 * 4 + h]) * LOG2E; }
    float d1 = 0.f, d2 = 0.f;
    for (int i = 0; i < 64; ++i) { d1 += lam_qk[i] * lam_qk[64 + i]; d2 += lam_qk[128 + i] * lam_qk[192 + i]; }
    const float lam = __expf(d1) - __expf(d2) + 0.2f;
    __syncthreads();
    const int npairs = F.vcu < 512 ? (512 - F.vcu + F.G - 1) / F.G : 0, total1 = 4 * npairs, total = ((PROBE_REP >> 2) & 1) ? 2 * total1 : total1;
    if (total > 0) {
        dattn::Seam S; dattn::Ref cur = da_ref(F, 0);
        const dattn::rsrc_t R = __builtin_amdgcn_make_buffer_rsrc((void*)(F.ws + WS_PROJ), 0, (int)((size_t)T * INW * 2), 0x00020000);
        dattn::prime(cur, F.lds, S, R);
        for (int n = 0; n < total; ++n) {
            const dattn::Ref nxt = (n + 1 < total) ? da_ref(F, (n + 1) % total1) : cur;
            dattn::block(cur, nxt, F.lds, S, lam, subln_g, R);
            cur = nxt;
        }
    }
    int lane2 = (int)__builtin_amdgcn_mbcnt_hi(~0u, __builtin_amdgcn_mbcnt_lo(~0u, 0u)); asm volatile("" : "+v"(lane2));
    const int tid2 = F.wave * 64 + lane2;
    const float* conv_w = kargs()->in[I_CONVW];
    for (int blk = blockIdx.x; blk < T / 256; blk += F.G) { p2_conv_block(F, blk, tid2, conv_w); p2_mem_block(F, blk, lane2); }
}

__device__ __forceinline__ void p4_router(Frame& F) {
    const float* router_b = kargs()->in[I_RB];
    const bf16_t* x1b = (const bf16_t*)(F.ws + WS_X1B); const bf16_t* wrh = (const bf16_t*)(F.ws + WS_WRHI); const bf16_t* wrl = (const bf16_t*)(F.ws + WS_WRLO);
    int* e_tk = (int*)(F.ws + WS_ETK); float* g_tk = (float*)(F.ws + WS_GTK); float* rstd_t = (float*)(F.ws + WS_RSTDT);
    LAS float* lg = (LAS float*)F.lds + F.wave * (32 * 33); LAS unsigned* hist = (LAS unsigned*)(F.lds + 8 * 32 * 33 * 4);
    const int r32 = F.lane & 31, hi = F.lane >> 5;
    for (int blk = blockIdx.x; blk < T / 256; blk += F.G) {
        if (F.tid < 32) hist[F.tid] = 0u;
        __syncthreads();
        const int t0 = blk * 256 + F.wave * 32;
        const bf16_t* xr = x1b + (size_t)(t0 + r32) * DM + hi * 8; const bf16_t* wh = wrh + (size_t)r32 * DM + hi * 8; const bf16_t* wl = wrl + (size_t)r32 * DM + hi * 8;
        f32x16 acc = f32x16{}; float ss = 0.f;
#pragma unroll 4
        for (int k0 = 0; k0 < DM; k0 += 16) {
            const u32x4 xw = *(const u32x4*)(xr + k0); const bf16x8 ah = *(const bf16x8*)(wh + k0), al = *(const bf16x8*)(wl + k0);
#pragma unroll
            for (int i = 0; i < 4; ++i) { const float a = bflo(xw[i]), b = bfhi(xw[i]); ss += a * a + b * b; }
            const bf16x8 xb = __builtin_bit_cast(bf16x8, xw);
            acc = __builtin_amdgcn_mfma_f32_32x32x16_bf16(ah, xb, acc, 0, 0, 0);
            acc = __builtin_amdgcn_mfma_f32_32x32x16_bf16(al, xb, acc, 0, 0, 0);
        }
        ss += __shfl_xor(ss, 32);
        const float rstd = rsqrtf(ss * (1.f / DM) + EPS);
#pragma unroll
        for (int r = 0; r < 16; ++r) { const int e = crow(r, hi); lg[r32 * 33 + e] = acc[r] * rstd + router_b[e]; }
        LDS_WAIT(); asm volatile("" ::: "memory");
        if (F.lane < 32) {
            LAS float* row = lg + F.lane * 33; float tv[4]; int ti[4];
#pragma unroll
            for (int p = 0; p < 4; ++p) { float best = -__builtin_inff(); int bi = 0;
                for (int e = 0; e < NEXP; ++e) { const float v = row[e]; if (v > best) { best = v; bi = e; } }
                tv[p] = best; ti[p] = bi; row[bi] = -__builtin_inff(); LDS_WAIT(); asm volatile("" ::: "memory"); }
            const float w1 = __expf(tv[1] - tv[0]), w2 = __expf(tv[2] - tv[0]), w3 = __expf(tv[3] - tv[0]); const float inv = 1.f / (1.f + w1 + w2 + w3);
            const int t = t0 + F.lane;
            *(int4*)(e_tk + (size_t)t * 4) = make_int4(ti[0], ti[1], ti[2], ti[3]);
            *(float4*)(g_tk + (size_t)t * 4) = make_float4(inv, w1 * inv, w2 * inv, w3 * inv);
            rstd_t[t] = rstd;
#pragma unroll
            for (int p = 0; p < 4; ++p) __hip_atomic_fetch_add(&hist[ti[p]], 1u, __ATOMIC_RELAXED, __HIP_MEMORY_SCOPE_WORKGROUP);
        }
        __syncthreads();
        if (F.tid < 32) __hip_atomic_fetch_add(F.ctl + CW_COUNT + F.tid, hist[F.tid], RLX_AGENT);
        __syncthreads();
    }
}
__device__ __forceinline__ void p5_place(Frame& F) {
    const int* e_tk = (const int*)(F.ws + WS_ETK); const float* g_tk = (const float*)(F.ws + WS_GTK); const float* rstd_t = (const float*)(F.ws + WS_RSTDT);
    int* slot_tk = (int*)(F.ws + WS_SLOTTK); int* tok_slot = (int*)(F.ws + WS_TOKSLOT); float* gate_slot = (float*)(F.ws + WS_GATESLOT); float* rstd_slot = (float*)(F.ws + WS_RSTDSLOT);
    int* rb_e = (int*)(F.ws + WS_RBE);
    LAS int* L = (LAS int*)F.lds;
    if (F.tid < 32) { const int c = (int)__hip_atomic_load(F.ctl + CW_COUNT + F.tid, RLX_AGENT); L[F.tid] = c; L[32 + F.tid] = (c + 255) & ~255; }
    __syncthreads();
    if (F.tid < 32) { int s = 0; for (int e = 0; e < F.tid; ++e) s += L[32 + e]; L[64 + F.tid] = s; }
    __syncthreads();
    for (int blk = blockIdx.x; blk < T / 256; blk += F.G) {
        if (F.tid < 32) { L[96 + F.tid] = 0; L[128 + F.tid] = 0; }
        __syncthreads();
        int ee[2];
#pragma unroll
        for (int j = 0; j < 2; ++j) { const int i = F.tid + 512 * j; ee[j] = e_tk[(size_t)blk * 1024 + i]; __hip_atomic_fetch_add(&L[96 + ee[j]], 1, __ATOMIC_RELAXED, __HIP_MEMORY_SCOPE_WORKGROUP); }
        __syncthreads();
        if (F.tid < 32) L[160 + F.tid] = L[64 + F.tid] + (int)__hip_atomic_fetch_add(F.ctl + CW_CURSOR + F.tid, (unsigned)L[96 + F.tid], RLX_AGENT);
        __syncthreads();
#pragma unroll
        for (int j = 0; j < 2; ++j) { const int i = F.tid + 512 * j; const int r = __hip_atomic_fetch_add(&L[128 + ee[j]], 1, __ATOMIC_RELAXED, __HIP_MEMORY_SCOPE_WORKGROUP); const int pos = L[160 + ee[j]] + r;
            const int t = blk * 256 + (i >> 2);
            tok_slot[pos] = t; gate_slot[pos] = g_tk[(size_t)blk * 1024 + i]; rstd_slot[pos] = rstd_t[t]; slot_tk[(size_t)blk * 1024 + i] = pos; }
        __syncthreads();
    }
    for (int e = blockIdx.x; e < NEXP; e += F.G)
        for (int i = L[e] + F.tid; i < L[32 + e]; i += NWAVES * 64) { const int pos = L[64 + e] + i; tok_slot[pos] = 0; gate_slot[pos] = 0.f; rstd_slot[pos] = 0.f; }
    if (blockIdx.x == 0) {
        const int nrb = (L[64 + 31] + L[32 + 31]) >> 8;
        for (int rb = F.tid; rb < NRB_MAX; rb += NWAVES * 64) { int e = 31; for (int q = 0; q < 32; ++q) { if (rb * 256 >= L[64 + q] && rb * 256 < L[64 + q] + L[32 + q]) e = q; } rb_e[rb] = e; }
        if (F.tid == 0) rb_e[NRB_MAX] = nrb;
    }
}
__device__ __forceinline__ void p9_final(Frame& F) {
    const bf16_t* x1b = (const bf16_t*)(F.ws + WS_X1B); const int* slot_tk = (const int*)(F.ws + WS_SLOTTK);
    const bf16_t* Y = (const bf16_t*)(F.ws + WS_Y);
    const int gw = F.vcu * NWAVES + F.wave, NGW = F.G * NWAVES;
    const float* final_g = kargs()->in[I_FING];
    for (int t = gw; t < T; t += NGW) {
        const int4 sl = *(const int4*)(slot_tk + (size_t)t * 4);
        const int s4[4] = {sl.x, sl.y, sl.z, sl.w};
        float v[2][8]; float ss = 0.f;
#pragma unroll
        for (int j = 0; j < 2; ++j) { const int c = 8 * F.lane + 512 * j;
            const u32x4 a = *(const u32x4*)(x1b + (size_t)t * DM + c);
#pragma unroll
            for (int i = 0; i < 4; ++i) { v[j][2 * i] = bflo(a[i]); v[j][2 * i + 1] = bfhi(a[i]); }
#pragma unroll
            for (int k = 0; k < 4; ++k) { const int s = s4[k]; const bf16_t* yp = Y + (size_t)s * DM + c;
                const u32x4 y = *(const u32x4*)yp;
#pragma unroll
                for (int i = 0; i < 4; ++i) { v[j][2 * i] += bflo(y[i]); v[j][2 * i + 1] += bfhi(y[i]); } }
#pragma unroll
            for (int i = 0; i < 8; ++i) ss += v[j][i] * v[j][i]; }
        const float rstd = rsqrtf(wave_sum(ss) * (1.f / DM) + EPS);
#pragma unroll
        for (int j = 0; j < 2; ++j) { const int c = 8 * F.lane + 512 * j;
            const f32x4 g0 = *(const f32x4*)(final_g + c), g1 = *(const f32x4*)(final_g + c + 4);
            f32x4 o0, o1; o0.x = v[j][0] * rstd * g0.x; o0.y = v[j][1] * rstd * g0.y; o0.z = v[j][2] * rstd * g0.z; o0.w = v[j][3] * rstd * g0.w;
            o1.x = v[j][4] * rstd * g1.x; o1.y = v[j][5] * rstd * g1.y; o1.z = v[j][6] * rstd * g1.z; o1.w = v[j][7] * rstd * g1.w;
            *(f32x4*)(F.out + (size_t)t * DM + c) = o0; *(f32x4*)(F.out + (size_t)t * DM + c + 4) = o1; }
    }
}

__global__ void __launch_bounds__(NWAVES * 64, 2) hymba_fwd(Args args) {
    extern __shared__ __attribute__((aligned(16))) unsigned char lds[];
    Frame F;
    F.lds = (LAS unsigned char*)lds;
    F.MISC = (volatile LAS unsigned*)(F.lds + MISC_OFF);
    F.tid = threadIdx.x; F.lane = F.tid & 63; F.wave = __builtin_amdgcn_readfirstlane(F.tid >> 6);
    F.G = gridDim.x; { const int bx = blockIdx.x; F.vcu = (F.G % 8 == 0) ? (bx % 8) * (F.G / 8) + bx / 8 : bx; }
    F.ws = args.ws; F.ctl = (unsigned*)(args.ws + WS_CTL); F.out = args.out;
    for (int u = F.tid; u < (LDS_BYTES - LDSCTL_OFF) / 4; u += NWAVES * 64) ((LAS unsigned*)(F.lds + LDSCTL_OFF))[u] = 0u;
    __syncthreads();
    XcdBarrier bar; bar.bar = F.ctl + CW_BAR; bar.x = 0; bar.st = nullptr;
    if (N_LAUNCHES == 1) bar = xcd_barrier_post(F.ctl + CW_BAR, F.MISC + 8);
#define GRID_BAR() do { if (N_LAUNCHES == 1) xcd_barrier(bar); } while (0)
    const int lo = args.ph_lo, hi = args.ph_hi;
#ifndef PH_MASK
#define PH_MASK 0x1ff
#endif
#define IN(k) (((PH_MASK >> (k)) & 1) && lo <= (k) && (k) < hi)
#define BOTH(k) (IN(k) && IN((k) + 1))
    bf16_t* const H = (bf16_t*)(F.ws + WS_H); bf16_t* const PROJ = (bf16_t*)(F.ws + WS_PROJ); bf16_t* const MIX = (bf16_t*)(F.ws + WS_MIX); bf16_t* const X1B = (bf16_t*)(F.ws + WS_X1B);
    bf16_t* const Win_t = (bf16_t*)(F.ws + WS_WIN); bf16_t* const Wout_t = (bf16_t*)(F.ws + WS_WOUT);
    const unsigned char* const Wgu_q = (const unsigned char*)F.out + OUT_WGU; const unsigned char* const Wd_q = (const unsigned char*)F.out + OUT_WD;
    unsigned char* const X1Q = F.ws + WS_X1Q; unsigned char* const ACTQ = F.ws + WS_ACTQ; bf16_t* const Yp = (bf16_t*)(F.ws + WS_Y);
    const int* const tok_slot = (const int*)(F.ws + WS_TOKSLOT); const float* const gate_slot = (const float*)(F.ws + WS_GATESLOT); const float* const rstd_slot = (const float*)(F.ws + WS_RSTDSLOT);
    const int* const rb_e = (const int*)(F.ws + WS_RBE);

#define REP(k) for (int rep_ = 0; rep_ < (((PROBE_REP >> (k)) & 1) ? 2 : 1); ++rep_)
    if (IN(0)) { REP(0) p0_prologue(F); if (BOTH(0)) GRID_BAR(); }
    if (IN(1)) {
        REP(1) {
        pg8::Gemm g{H, Win_t, DM, 0, nullptr}; pg8::StaticOrder S; S.init(T, INW, F.G, (int)blockIdx.x);
        pg8::EpiProj E{PROJ};
        pg8::gemm_phase<pg8::EpiProj, pg8::StaticOrder, true>(F.lds, g, S, E); }
        if (BOTH(1)) GRID_BAR();
    }
    if (IN(2)) { p2_mixers(F); if (BOTH(2)) GRID_BAR(); }
    if (IN(3)) {
        pg8::Gemm g{MIX, Wout_t, DM, 0, nullptr}; pg8::StaticOrder S; S.init(T, DM, F.G, (int)blockIdx.x);
        pg8::EpiX1 E{kargs()->in[I_X], X1B, X1Q};
        pg8::gemm_phase<pg8::EpiX1, pg8::StaticOrder, true>(F.lds, g, S, E);
        if (BOTH(3)) GRID_BAR();
    }
    if (IN(4)) { p4_router(F); if (BOTH(4)) GRID_BAR(); }
    if (IN(5)) { p5_place(F); if (BOTH(5)) GRID_BAR(); }
    if (IN(6)) {
        const int nrb = rb_e[NRB_MAX];
        REP(6) {
        pg8::Gemm g{(const bf16_t*)X1Q, (const bf16_t*)Wgu_q, DM / 2, (long)2048 * DM / 2, tok_slot}; pg8::GroupOrder S{nrb, 0, 8, F.G, (int)blockIdx.x, rb_e};
        pg8::EpiGU E{ACTQ, kargs()->in[I_BGU], rstd_slot};
        pg8::gemm_phase<pg8::EpiGU, pg8::GroupOrder, true, true, 0x79797979, 0x7f7f7f7f>(F.lds, g, S, E); }
        if (BOTH(6)) GRID_BAR();
    }
    if (IN(7)) {
        const int nrb = rb_e[NRB_MAX];
        pg8::Gemm g{(const bf16_t*)ACTQ, (const bf16_t*)Wd_q, DEXP / 2, (long)DM * DEXP / 2, nullptr}; pg8::GroupOrder S{nrb, 0, 4, F.G, (int)blockIdx.x, rb_e};
        pg8::EpiDown E{Yp, kargs()->in[I_BDN], gate_slot};
        pg8::gemm_phase<pg8::EpiDown, pg8::GroupOrder, true, true, 0x79797979, 0x7d7d7d7d>(F.lds, g, S, E);
        if (BOTH(7)) GRID_BAR();
    }
    if (IN(8)) { REP(8) p9_final(F); }
#undef IN
#undef BOTH
#undef GRID_BAR
}

extern "C" void kernel_launch(void* const* d_in, const int* in_sizes, int n_in, void* d_out, int out_size, void* d_ws, size_t ws_size, hipStream_t stream) {
    static int grid = 0;
    if (grid == 0) {
        if (n_in != 19 || out_size != T * DM || ws_size < WS_END) { fprintf(stderr, "kernel_launch: unexpected shapes (n_in %d out %d ws %zu)\n", n_in, out_size, ws_size); grid = -1; return; }
        int dev = 0, cus = 0;
        if (hipGetDevice(&dev) != hipSuccess || hipDeviceGetAttribute(&cus, hipDeviceAttributeMultiprocessorCount, dev) != hipSuccess) { grid = -1; return; }
        if (hipFuncSetAttribute((const void*)hymba_fwd, hipFuncAttributeMaxDynamicSharedMemorySize, LDS_BYTES) != hipSuccess) { fprintf(stderr, "kernel_launch: hipFuncSetAttribute failed\n"); grid = -1; return; }
        int per_cu = 0;
        if (hipOccupancyMaxActiveBlocksPerMultiprocessor(&per_cu, (const void*)hymba_fwd, NWAVES * 64, LDS_BYTES) != hipSuccess || per_cu < 1) fprintf(stderr, "kernel_launch: occupancy query reports %d\n", per_cu);
        (void)hipGetLastError();
        grid = cus;
    }
    if (grid < 0) return;
    if (hipMemsetAsync((char*)d_ws + WS_CTL, 0, CTL_ZERO_BYTES, stream) != hipSuccess) return;
    Args a{};
    for (int i = 0; i < 19; ++i) a.in[i] = (const float*)d_in[i];
    a.out = (float*)d_out; a.ws = (unsigned char*)d_ws;
    for (int li = 0; li < N_LAUNCHES; ++li) {
        a.ph_lo = (N_LAUNCHES == 1) ? 0 : li; a.ph_hi = (N_LAUNCHES == 1) ? N_PHASES : li + 1;
        hipLaunchKernelGGL(hymba_fwd, dim3(grid), dim3(NWAVES * 64), LDS_BYTES, stream, a);
    }
}
```

```cpp
#include <hip/hip_runtime.h>
#include <hip/hip_bf16.h>
#include <cstdio>
#include <cstdint>

#ifndef PROBE_REP
#define PROBE_REP 0
#endif
#ifndef PROBE_EPI
#define PROBE_EPI 0
#endif
#ifndef MK_N_LAUNCHES
#define MK_N_LAUNCHES 1
#endif

constexpr int BATCH = 8, SEQ = 8192, DM = 1024, T = BATCH * SEQ, INW = 2560, MEML = 256, NEXP = 32, TOPK = 4, DEXP = 1024;
constexpr int COL_U = 0, COL_GB = 256, COL_GC = 512, COL_Q = 768, COL_K = 1280, COL_V = 1792, COL_QM = 2304;
constexpr float EPS = 1e-5f;
constexpr float C2 = 0.125f * 1.4426950408889634f;
constexpr float LOG2E = 1.4426950408889634f;
constexpr int NRB_MAX = 1056;

#define GAS __attribute__((address_space(1)))
#define LAS __attribute__((address_space(3)))
typedef unsigned short bf16_t;
typedef short bf16x8 __attribute__((ext_vector_type(8)));
typedef short s16x4 __attribute__((ext_vector_type(4)));
typedef float f32x4 __attribute__((ext_vector_type(4)));
typedef float f32x16 __attribute__((ext_vector_type(16)));
typedef unsigned u32x4 __attribute__((ext_vector_type(4)));
typedef unsigned u32x2 __attribute__((ext_vector_type(2)));
typedef float f32x2_t __attribute__((ext_vector_type(2)));
typedef __bf16 bf16x2_t __attribute__((ext_vector_type(2)));
typedef GAS unsigned gu32;
#define RLX_AGENT __ATOMIC_RELAXED, __HIP_MEMORY_SCOPE_AGENT
#define LDS_WAIT() asm volatile("s_waitcnt lgkmcnt(0)" ::: "memory")
#define VM_WAIT() asm volatile("s_waitcnt vmcnt(0)" ::: "memory")
#define SBAR() __builtin_amdgcn_sched_barrier(0)

__device__ __forceinline__ unsigned pk2(float lo, float hi) { f32x2_t v = {lo, hi}; bf16x2_t b = __builtin_convertvector(v, bf16x2_t); return __builtin_bit_cast(unsigned, b); }
__device__ __forceinline__ float bflo(unsigned u) { return __uint_as_float(u << 16); }
__device__ __forceinline__ float bfhi(unsigned u) { return __uint_as_float(u & 0xffff0000u); }
__device__ __forceinline__ bf16x8 pack8(f32x4 a, f32x4 b) { u32x4 w = {pk2(a[0], a[1]), pk2(a[2], a[3]), pk2(b[0], b[1]), pk2(b[2], b[3])}; return __builtin_bit_cast(bf16x8, w); }
__device__ __forceinline__ int crow(int r, int hi) { return (r & 3) + 8 * (r >> 2) + 4 * hi; }
__device__ __forceinline__ float wave_sum(float v) {
#pragma unroll
    for (int o = 1; o < 64; o <<= 1) v += __shfl_xor(v, o);
    return v;
}

namespace pg8 {
constexpr int BM = 256, BK = 64, HALF = 128, HTB = HALF * BK * 2  , STAGE_BYTES = 8 * HTB, NXCD = 8, WGM = 8;
__host__ __device__ __forceinline__ int lds_byte(int r, int c) { const int st = (r >> 4) * 2 + (c >> 5), rr = r & 15, cc = c & 31, ob = rr * 64 + cc * 2; return st * 1024 + (ob ^ (((ob >> 9) & 1) << 5)); }
__host__ __device__ __forceinline__ void stage_rc(int b, int& R, int& C) { const int st = b / 1024, sb = b % 1024, swz = sb ^ (((sb >> 9) & 1) << 5); R = (st >> 1) * 16 + swz / 64; C = (st & 1) * 32 + (swz % 64) / 2; }
__host__ __device__ __forceinline__ int perm32(int rho) { const int n = rho >> 4, i = rho & 15; return 8 * (i >> 2) + 4 * n + (i & 3); }

struct Unit { int pm, pn, e; };
struct Gemm { const bf16_t* A; const bf16_t* Bt; int K; long bstride; const int* rowmap; };

struct StaticOrder {
    int nM, nN, nwg, G, c;
    __device__ void init(int M, int N, int G_, int c_) { nM = M / BM; nN = N / BM; nwg = nM * nN; G = G_; c = c_; }
    __device__ bool next(int i, Unit& u) const {
        const long L = (long)i * G + c; if (L >= nwg) return false;
        int wgid = (int)L; { const int q = nwg / NXCD, r = nwg % NXCD, xcd = wgid % NXCD, off = wgid / NXCD; wgid = (xcd < r ? xcd * (q + 1) : r * (q + 1) + (xcd - r) * q) + off; }
        const int nig = WGM * nN, gid = wgid / nig, fm = gid * WGM, gsz = (nM - fm) < WGM ? (nM - fm) : WGM;
        u.pm = fm + ((wgid % nig) % gsz); u.pn = (wgid % nig) / gsz; u.e = 0; return true;
    }
};
struct GroupOrder {
    int nrb, rb0, npn, G, c; const int* rb_e;
    __device__ bool next(int i, Unit& u) const {
        int rbl, pn;
        if ((G & 7) == 0 && ((G >> 3) % npn) == 0) { const int x = c & 7, j = c >> 3, rpx = (G >> 3) / npn; rbl = i * (G / npn) + x * rpx + j / npn; pn = j % npn; }
        else { const long L = (long)i * G + c; rbl = (int)(L / npn); pn = (int)(L % npn); }
        if (rbl >= nrb) return false;
        u.pm = rb0 + rbl; u.pn = pn; u.e = rb_e[u.pm]; return true;
    }
};

typedef int v4i_t __attribute__((ext_vector_type(4)));
typedef int v8i_t __attribute__((ext_vector_type(8)));
template <class Epi, class Sched, bool ALIGN_EPI, bool FP8 = false, int SCW = 0x7f7f7f7f, int SCA = 0x7f7f7f7f>
__device__ __forceinline__ void gemm_phase(LAS unsigned char* lds, const Gemm g, const Sched& S, const Epi& E) {
    const int tid = threadIdx.x, wid = __builtin_amdgcn_readfirstlane(tid >> 6), lane = tid & 63, wr = wid >> 2, wc = wid & 3, fr = lane & 15, fq = lane >> 4;
    const int K = g.K; int nt = K / BK; asm volatile("" : "+s"(nt));
    int Rr[2], Cc[2]; unsigned voffB[2];
#pragma unroll
    for (int i = 0; i < 2; ++i) { int R, C; stage_rc(tid * 16 + i * 8192, R, C); const int Rb = Epi::PERM ? ((R & ~31) + perm32(R & 31)) : R;
        Rr[i] = R; Cc[i] = C; voffB[i] = (unsigned)(Rb * K + C) * 2u; }
    const size_t kstep = (size_t)(BK * 2);
    const size_t hstep = (size_t)HALF * K * 2;
    const size_t tstep = 2 * hstep;
    const unsigned ldsw = (unsigned)wid * 1024u;
    const int aoff = lds_byte(wr * 64 + fr, fq * 8), boff = lds_byte(wc * 32 + fr, fq * 8);
#define PG8_SA(b, h) (((b) * 2 + (h)) * HTB)
#define PG8_SB(b, h) ((4 + (b) * 2 + (h)) * HTB)
#define PG8_STAGE(bufoff, gbase, voff) do { _Pragma("unroll") for (int _i = 0; _i < 2; ++_i) \
        __builtin_amdgcn_global_load_lds((const unsigned*)((const char*)(gbase) + (voff)[_i]), (LAS unsigned*)(lds + (bufoff) + ldsw + _i * 8192), 16, 0, 0); } while (0)
#define PG8_STAGE_A(bufoff, kptr, offs, h) do { _Pragma("unroll") for (int _i = 0; _i < 2; ++_i) \
        __builtin_amdgcn_global_load_lds((const unsigned*)((const char*)(kptr) + (offs)[h][_i]), (LAS unsigned*)(lds + (bufoff) + ldsw + _i * 8192), 16, 0, 0); } while (0)
#define PG8_AOFF(dst, u) do { _Pragma("unroll") for (int _h = 0; _h < 2; ++_h) _Pragma("unroll") for (int _i = 0; _i < 2; ++_i) { const int _row = (u).pm * BM + _h * HALF + Rr[_i]; \
        const int _src = g.rowmap ? g.rowmap[_row] : _row; dst[_h][_i] = (unsigned)(_src * K + Cc[_i]) * 2u; } } while (0)
#define PG8_LDA(dst, b, h) do { _Pragma("unroll") for (int m = 0; m < 4; ++m) _Pragma("unroll") for (int k = 0; k < 2; ++k) dst[m][k] = *(const LAS bf16x8*)(lds + PG8_SA(b, h) + aoff + m * 2048 + k * 1024); } while (0)
#define PG8_LDB(dst, b, h) do { _Pragma("unroll") for (int n = 0; n < 2; ++n) _Pragma("unroll") for (int k = 0; k < 2; ++k) dst[n][k] = *(const LAS bf16x8*)(lds + PG8_SB(b, h) + boff + n * 2048 + k * 1024); } while (0)
#define PG8_CAT(x, y) __builtin_shufflevector(__builtin_bit_cast(v4i_t, x), __builtin_bit_cast(v4i_t, y), 0, 1, 2, 3, 4, 5, 6, 7)
#define PG8_MMA(ai, bj, At, Bt) do { __builtin_amdgcn_s_setprio(1); _Pragma("unroll") for (int m = 0; m < 4; ++m) _Pragma("unroll") for (int n = 0; n < 2; ++n) { \
        if constexpr (FP8) { acc[ai][bj][m][n] = __builtin_amdgcn_mfma_scale_f32_16x16x128_f8f6f4(PG8_CAT(Bt[n][0], Bt[n][1]), PG8_CAT(At[m][0], At[m][1]), acc[ai][bj][m][n], 0, 0, 0, SCW, 0, SCA); } \
        else { _Pragma("unroll") for (int k = 0; k < 2; ++k) acc[ai][bj][m][n] = __builtin_amdgcn_mfma_f32_16x16x32_bf16(Bt[n][k], At[m][k], acc[ai][bj][m][n], 0, 0, 0); } } \
        __builtin_amdgcn_s_setprio(0); } while (0)
#define PG8_WAIT_V(n) asm volatile("s_waitcnt vmcnt(" #n ")" ::: "memory")
#define PG8_WAIT_L(n) asm volatile("s_waitcnt lgkmcnt(" #n ")" ::: "memory")
#define PG8_BAR __builtin_amdgcn_s_barrier()
#define PG8_SCHED __builtin_amdgcn_sched_barrier(0)
    Unit cur, nxt; int ui = 0;
    if (!S.next(0, cur)) return;
    f32x4 acc[2][2][4][2];
#pragma unroll
    for (int a = 0; a < 2; ++a)
#pragma unroll
        for (int b = 0; b < 2; ++b)
#pragma unroll
            for (int m = 0; m < 4; ++m)
#pragma unroll
                for (int n = 0; n < 2; ++n) acc[a][b][m][n] = (f32x4){0.f, 0.f, 0.f, 0.f};
    bf16x8 At[4][2], B0[2][2], B1[2][2];
    unsigned aoc[2][2], aon[2][2];
    PG8_AOFF(aoc, cur);
    const char* Ab = (const char*)g.A;
    const char* cB = (const char*)g.Bt + ((size_t)cur.e * (size_t)g.bstride) * 2 + (size_t)cur.pn * tstep;
    PG8_STAGE(PG8_SB(0, 0), cB, voffB); PG8_STAGE(PG8_SB(0, 1), cB + hstep, voffB); PG8_STAGE_A(PG8_SA(0, 0), Ab, aoc, 0); PG8_STAGE_A(PG8_SA(0, 1), Ab, aoc, 1);
    if (wr == 1) PG8_BAR;
    PG8_WAIT_V(2); PG8_BAR;
    PG8_STAGE(PG8_SB(1, 0), cB + kstep, voffB); PG8_STAGE_A(PG8_SA(1, 0), Ab + kstep, aoc, 0); PG8_STAGE(PG8_SB(1, 1), cB + hstep + kstep, voffB);
    PG8_WAIT_V(6); PG8_BAR;
    for (;;) {
        const bool has_next = S.next(ui + 1, nxt);
        if (has_next) { PG8_AOFF(aon, nxt); }
        else {
#pragma unroll
            for (int h = 0; h < 2; ++h)
#pragma unroll
                for (int i = 0; i < 2; ++i) aon[h][i] = aoc[h][i];
        }
        const char* nB = has_next ? (const char*)g.Bt + ((size_t)nxt.e * (size_t)g.bstride) * 2 + (size_t)nxt.pn * tstep : cB;
#pragma nounroll
        for (int t = 0; t < nt; t += 2) {
            const bool last = (t == nt - 2);
            const char* a1 = Ab + (size_t)(t + 1) * kstep;
            const char* a2 = last ? Ab : Ab + (size_t)(t + 2) * kstep; const char* b2 = last ? nB : cB + (size_t)(t + 2) * kstep;
            const char* a3 = a2 + kstep; const char* b3 = b2 + kstep;
            PG8_LDB(B0, 0, 0); PG8_LDB(B1, 0, 1); PG8_SCHED; PG8_LDA(At, 0, 0); PG8_STAGE_A(PG8_SA(1, 1), a1, aoc, 1);
            if (last) {
#pragma unroll
                for (int h = 0; h < 2; ++h)
#pragma unroll
                    for (int i = 0; i < 2; ++i) aoc[h][i] = aon[h][i]; }
            PG8_WAIT_V(8); PG8_WAIT_L(0); PG8_BAR; PG8_MMA(0, 0, At, B0); PG8_MMA(0, 1, At, B1); PG8_BAR; PG8_SCHED;
            PG8_LDA(At, 0, 1); PG8_STAGE(PG8_SB(0, 0), b2, voffB); PG8_STAGE(PG8_SB(0, 1), b2 + hstep, voffB); PG8_STAGE_A(PG8_SA(0, 0), a2, aoc, 0);
            PG8_WAIT_V(8); PG8_WAIT_L(0); PG8_BAR; PG8_MMA(1, 0, At, B0); PG8_MMA(1, 1, At, B1); PG8_BAR; PG8_SCHED;
            PG8_LDB(B0, 1, 0); PG8_LDB(B1, 1, 1); PG8_SCHED; PG8_LDA(At, 1, 0); PG8_STAGE_A(PG8_SA(0, 1), a2, aoc, 1);
            PG8_WAIT_V(8); PG8_WAIT_L(0); PG8_BAR; PG8_MMA(0, 0, At, B0); PG8_MMA(0, 1, At, B1); PG8_BAR; PG8_SCHED;
            PG8_LDA(At, 1, 1); PG8_STAGE(PG8_SB(1, 0), b3, voffB); PG8_STAGE(PG8_SB(1, 1), b3 + hstep, voffB); PG8_STAGE_A(PG8_SA(1, 0), a3, aoc, 0);
            PG8_WAIT_V(8); PG8_WAIT_L(0); PG8_BAR; PG8_MMA(1, 0, At, B0); PG8_MMA(1, 1, At, B1); PG8_BAR; PG8_SCHED;
        }
        if constexpr (ALIGN_EPI) { if (wr == 0) PG8_BAR; }
        E(acc, cur, wr, wc, fr, fq);
        if constexpr (FP8 && PROBE_EPI != 0) { asm volatile("" ::: "memory"); E(acc, cur, wr, wc, fr, fq); }
        if (!has_next) break;
#pragma unroll
        for (int a = 0; a < 2; ++a)
#pragma unroll
            for (int b = 0; b < 2; ++b)
#pragma unroll
                for (int m = 0; m < 4; ++m)
#pragma unroll
                    for (int n = 0; n < 2; ++n) acc[a][b][m][n] = (f32x4){0.f, 0.f, 0.f, 0.f};
        cur = nxt; cB = nB; ++ui;
        if constexpr (ALIGN_EPI) { if (wr == 1) PG8_BAR; }
    }
    PG8_WAIT_V(0);
    if constexpr (!ALIGN_EPI) { if (wr == 0) PG8_BAR; }
    PG8_BAR;
#undef PG8_SA
#undef PG8_SB
#undef PG8_STAGE
#undef PG8_STAGE_A
#undef PG8_AOFF
#undef PG8_LDA
#undef PG8_LDB
#undef PG8_MMA
#undef PG8_CAT
#undef PG8_WAIT_V
#undef PG8_WAIT_L
#undef PG8_BAR
#undef PG8_SCHED
}

struct EpiProj {
    static constexpr bool PERM = true;
    bf16_t* O;
    __device__ __forceinline__ void operator()(const f32x4 (&acc)[2][2][4][2], const Unit& u, int wr, int wc, int fr, int fq) const {
        const int row0 = u.pm * BM + wr * 64 + fr, col0 = u.pn * BM + wc * 32 + 8 * fq;
        const float sc = (u.pn == 3 || u.pn == 4 || u.pn == 9) ? C2 : 1.f;
#pragma unroll
        for (int ai = 0; ai < 2; ++ai)
#pragma unroll
            for (int m = 0; m < 4; ++m) { bf16_t* rowp = O + (size_t)(row0 + ai * HALF + m * 16) * INW + col0;
#pragma unroll
                for (int bj = 0; bj < 2; ++bj) { const f32x4 v0 = acc[ai][bj][m][0] * sc, v1 = acc[ai][bj][m][1] * sc;
                    u32x4 w; w.x = pk2(v0[0], v0[1]); w.y = pk2(v0[2], v0[3]); w.z = pk2(v1[0], v1[1]); w.w = pk2(v1[2], v1[3]);
                    *(u32x4*)(rowp + bj * HALF) = w; } }
    }
};
__device__ __forceinline__ unsigned pk4_fp8(float a, float b, float c, float d) { int w = 0; w = __builtin_amdgcn_cvt_pk_fp8_f32(a, b, w, false); w = __builtin_amdgcn_cvt_pk_fp8_f32(c, d, w, true); return (unsigned)w; }
struct EpiX1 {
    static constexpr bool PERM = true;
    const float* X; bf16_t* O; unsigned char* Q8;
    __device__ __forceinline__ void operator()(const f32x4 (&acc)[2][2][4][2], const Unit& u, int wr, int wc, int fr, int fq) const {
        const int row0 = u.pm * BM + wr * 64 + fr, col0 = u.pn * BM + wc * 32 + 8 * fq;
#pragma unroll
        for (int ai = 0; ai < 2; ++ai)
#pragma unroll
            for (int m = 0; m < 4; ++m) { const size_t off = (size_t)(row0 + ai * HALF + m * 16) * DM + col0;
#pragma unroll
                for (int bj = 0; bj < 2; ++bj) { const f32x4 x0 = *(const f32x4*)(X + off + bj * HALF), x1 = *(const f32x4*)(X + off + bj * HALF + 4);
                    const f32x4 v0 = acc[ai][bj][m][0] + x0, v1 = acc[ai][bj][m][1] + x1;
                    u32x4 w; w.x = pk2(v0[0], v0[1]); w.y = pk2(v0[2], v0[3]); w.z = pk2(v1[0], v1[1]); w.w = pk2(v1[2], v1[3]);
                    *(u32x4*)(O + off + bj * HALF) = w;
                    u32x2 q; q.x = pk4_fp8(v0[0], v0[1], v0[2], v0[3]); q.y = pk4_fp8(v1[0], v1[1], v1[2], v1[3]);
                    *(u32x2*)(Q8 + off + bj * HALF) = q; } }
    }
};
struct EpiGU {
    static constexpr bool PERM = true;
    unsigned char* ACT; const float* bias; const float* rstd;
    __device__ __forceinline__ void operator()(const f32x4 (&acc)[2][2][4][2], const Unit& u, int wr, int wc, int fr, int fq) const {
        const int row0 = u.pm * BM + wr * 64 + fr, j0 = u.pn * HALF + wc * 32 + 8 * fq;
        const float* bp = bias + (size_t)u.e * 2048 + j0;
        const f32x4 bg0 = *(const f32x4*)(bp), bg1 = *(const f32x4*)(bp + 4), bu0 = *(const f32x4*)(bp + 1024), bu1 = *(const f32x4*)(bp + 1028);
#pragma unroll
        for (int ai = 0; ai < 2; ++ai)
#pragma unroll
            for (int m = 0; m < 4; ++m) { const int row = row0 + ai * HALF + m * 16; const float rs = rstd[row];
                f32x4 g0 = acc[ai][0][m][0] * rs + bg0, g1 = acc[ai][0][m][1] * rs + bg1, u0 = acc[ai][1][m][0] * rs + bu0, u1 = acc[ai][1][m][1] * rs + bu1;
                float o[8];
#pragma unroll
                for (int i = 0; i < 4; ++i) {
                    { const float gg = fminf(g0[i], 7.f), uu = __builtin_amdgcn_fmed3f(u0[i], -7.f, 7.f); const float s4 = gg * __builtin_amdgcn_rcpf(fmaf(__builtin_amdgcn_exp2f(-1.702f * LOG2E * gg), 0.25f, 0.25f)); o[i] = fmaf(uu, s4, s4); }
                    { const float gg = fminf(g1[i], 7.f), uu = __builtin_amdgcn_fmed3f(u1[i], -7.f, 7.f); const float s4 = gg * __builtin_amdgcn_rcpf(fmaf(__builtin_amdgcn_exp2f(-1.702f * LOG2E * gg), 0.25f, 0.25f)); o[4 + i] = fmaf(uu, s4, s4); }
                }
                u32x2 w; w.x = pk4_fp8(o[0], o[1], o[2], o[3]); w.y = pk4_fp8(o[4], o[5], o[6], o[7]);
                *(u32x2*)(ACT + (size_t)row * DEXP + j0) = w; }
    }
};
struct EpiDown {
    static constexpr bool PERM = true;
    bf16_t* Y; const float* bias; const float* gate;
    __device__ __forceinline__ void operator()(const f32x4 (&acc)[2][2][4][2], const Unit& u, int wr, int wc, int fr, int fq) const {
        const int row0 = u.pm * BM + wr * 64 + fr, col0 = u.pn * BM + wc * 32 + 8 * fq;
        const float* bp = bias + (size_t)u.e * DM + col0;
        f32x4 bv[2][2];
#pragma unroll
        for (int bj = 0; bj < 2; ++bj) { bv[bj][0] = *(const f32x4*)(bp + bj * HALF); bv[bj][1] = *(const f32x4*)(bp + bj * HALF + 4); }
#pragma unroll
        for (int ai = 0; ai < 2; ++ai)
#pragma unroll
            for (int m = 0; m < 4; ++m) { const int row = row0 + ai * HALF + m * 16; const float gs = gate[row];
#pragma unroll
                for (int bj = 0; bj < 2; ++bj) { const f32x4 v0 = (acc[ai][bj][m][0] + bv[bj][0]) * gs, v1 = (acc[ai][bj][m][1] + bv[bj][1]) * gs;
                    u32x4 w; w.x = pk2(v0[0], v0[1]); w.y = pk2(v0[2], v0[3]); w.z = pk2(v1[0], v1[1]); w.w = pk2(v1[2], v1[3]);
                    *(u32x4*)(Y + (size_t)row * DM + col0 + bj * HALF) = w; } }
    }
};
}

namespace dattn {
constexpr int NW = 8, QBLK = 32, KVBLK = 64, QB = 256, PITCH = INW;
constexpr int SHM_V = KVBLK * 128 * 2, SHM_K = KVBLK * 64 * 2;
constexpr int OFF_V = 0, OFF_K = 2 * SHM_V, OFF_WS = OFF_K + 2 * SHM_K, OFF_STASH = OFF_WS + NW * 64 * 4, OFF_TB = OFF_STASH + NW * 8192, LDS_BYTES = OFF_TB + 4 * 128 * 4;
constexpr float THR = 8.f;
__device__ __forceinline__ int v_st(int k, int c) { const int kk = k;     return ((kk >> 3) * 4 + (c >> 5)) * 512 + ((kk & 7) * 32 + (c & 31)) * 2; }
__device__ __forceinline__ int v_rd_base(int lane) { return ((lane & 3) << 3) | (((lane >> 2) & 3) << 6) | (((lane >> 4) & 1) << 5) | (((lane >> 5) & 1) << 8); }
constexpr int v_rd_off(int d0, int ks, int half) { return d0 * 512 + ks * 4096 + half * 2048; }

struct Ref { unsigned qoff, koff, voff; bf16_t* O; int P0, comp, h; };
typedef __amdgpu_buffer_rsrc_t rsrc_t;
__device__ __forceinline__ bf16x8 bld8(rsrc_t r, unsigned voff, unsigned soff) { return __builtin_bit_cast(bf16x8, __builtin_amdgcn_raw_buffer_load_b128(r, (int)voff, (int)soff, 0)); }
struct Seam { bf16x8 qr[4]; bf16x8 st_v0, st_v1, st_k; };

__device__ __forceinline__ bf16x8 ld8(const bf16_t* p) { return *reinterpret_cast<const bf16x8*>(p); }

__device__ __forceinline__ void bias_mask(f32x16& p0, f32x16& p1, int sdq  , const LAS float* tb) {
    const float NEG = -__builtin_inff();
    int lane_ = (int)__builtin_amdgcn_mbcnt_hi(~0u, __builtin_amdgcn_mbcnt_lo(~0u, 0u));
    int dq = sdq + (lane_ & 31) - 4 * (lane_ >> 5);
    asm volatile("" : "+v"(dq));
#pragma unroll
    for (int r = 0; r < 16; ++r) {
        const int c = (r & 3) + 8 * (r >> 2);
        const int d0 = dq - c, d1 = dq - c - 32;
        const int i0 = d0 < 0 ? 0 : (d0 > 127 ? 127 : d0), i1 = d1 < 0 ? 0 : (d1 > 127 ? 127 : d1);
        const float b0 = tb[i0], b1 = tb[i1];
        p0[r] = d0 < 0 ? NEG : p0[r] + b0;
        p1[r] = d1 < 0 ? NEG : p1[r] + b1;
    }
}
__device__ __forceinline__ void partialSM(f32x16& p0, f32x16& p1, float& m_reg, float& alpha) {
    float pmax = p0[0];
#pragma unroll
    for (int r = 1; r < 16; ++r) pmax = fmaxf(pmax, p0[r]);
#pragma unroll
    for (int r = 0; r < 16; ++r) pmax = fmaxf(pmax, p1[r]);
    { auto rr = __builtin_amdgcn_permlane32_swap(__float_as_uint(pmax), __float_as_uint(pmax), false, false);
      pmax = fmaxf(__uint_as_float(rr[0]), __uint_as_float(rr[1])); }
    float mn;
    if (__builtin_expect(__all((pmax - m_reg) <= THR), 1)) { mn = m_reg; alpha = 1.f; }
    else { mn = fmaxf(m_reg, pmax); alpha = __builtin_amdgcn_exp2f(m_reg - mn); m_reg = mn; }
#pragma unroll
    for (int r = 0; r < 16; ++r) p0[r] = p0[r] - mn;
#pragma unroll
    for (int r = 0; r < 16; ++r) p1[r] = p1[r] - mn;
#pragma unroll
    for (int r = 0; r < 16; ++r) p0[r] = __builtin_amdgcn_exp2f(p0[r]);
}
__device__ __forceinline__ void finishSM(f32x16& p0, f32x16& p1, float alpha, float& l_reg, bf16x8& pa0, bf16x8& pa1, bf16x8& pa2, bf16x8& pa3) {
#pragma unroll
    for (int r = 0; r < 16; ++r) p1[r] = __builtin_amdgcn_exp2f(p1[r]);
    float ps = 0;
#pragma unroll
    for (int r = 0; r < 16; ++r) ps += p0[r];
#pragma unroll
    for (int r = 0; r < 16; ++r) ps += p1[r];
    { auto rr = __builtin_amdgcn_permlane32_swap(__float_as_uint(ps), __float_as_uint(ps), false, false);
      ps = __uint_as_float(rr[0]) + __uint_as_float(rr[1]); }
    l_reg = l_reg * alpha + ps;
#define PK4(P, B_, OUT) do { unsigned a0 = pk2(P[B_+0], P[B_+1]), a1 = pk2(P[B_+2], P[B_+3]);                          \
        unsigned b0 = pk2(P[B_+4], P[B_+5]), b1 = pk2(P[B_+6], P[B_+7]);                                             \
        auto r0 = __builtin_amdgcn_permlane32_swap(a0, b0, false, false); auto r1 = __builtin_amdgcn_permlane32_swap(a1, b1, false, false); \
        u32x4 w = {r0[0], r1[0], r0[1], r1[1]}; OUT = __builtin_bit_cast(bf16x8, w); } while (0)
    PK4(p0, 0, pa0); PK4(p0, 8, pa1); PK4(p1, 0, pa2); PK4(p1, 8, pa3);
#undef PK4
}
template <int KB>
__device__ __forceinline__ void qkt(f32x16& p0, f32x16& p1, const LAS unsigned char* K_lds, int r32, int hi, const bf16x8* qr) {
    p0 = f32x16{}; p1 = f32x16{};
    const int s = (r32 >> 1) & 7;
#pragma unroll
    for (int d0 = 0; d0 < 4; ++d0) {
        const LAS unsigned char* a = K_lds + KB * SHM_K + r32 * 128 + (((2 * d0 + hi) ^ s) << 4);
        const bf16x8 b0 = *(const LAS bf16x8*)(a);
        const bf16x8 b1 = *(const LAS bf16x8*)(a + 32 * 128);
        p0 = __builtin_amdgcn_mfma_f32_32x32x16_bf16(b0, qr[d0], p0, 0, 0, 0);
        p1 = __builtin_amdgcn_mfma_f32_32x32x16_bf16(b1, qr[d0], p1, 0, 0, 0); }
}
template <int VB>
__device__ __forceinline__ void pv_tile(f32x16* o, int vb0, bf16x8 pa0, bf16x8 pa1, bf16x8 pa2, bf16x8 pa3) {
#define TRRD(dst, off) asm volatile("ds_read_b64_tr_b16 %0, %1 offset:%2" : "=&v"(dst) : "v"(vb0), "i"(off) : "memory")
#define PV_D0(d0) do { s16x4 l0, l1, l2, l3, h0, h1, h2, h3; constexpr int b_ = VB * SHM_V + v_rd_off(d0, 0, 0); \
        TRRD(l0, b_); TRRD(h0, b_ + 2048); TRRD(l1, b_ + 4096); TRRD(h1, b_ + 6144); TRRD(l2, b_ + 8192); TRRD(h2, b_ + 10240); TRRD(l3, b_ + 12288); TRRD(h3, b_ + 14336); \
        asm volatile("s_waitcnt lgkmcnt(0)" ::: "memory"); SBAR();   \
        o[d0] = __builtin_amdgcn_mfma_f32_32x32x16_bf16(pa0, (bf16x8){l0[0], l0[1], l0[2], l0[3], h0[0], h0[1], h0[2], h0[3]}, o[d0], 0, 0, 0);   \
        o[d0] = __builtin_amdgcn_mfma_f32_32x32x16_bf16(pa1, (bf16x8){l1[0], l1[1], l1[2], l1[3], h1[0], h1[1], h1[2], h1[3]}, o[d0], 0, 0, 0);   \
        o[d0] = __builtin_amdgcn_mfma_f32_32x32x16_bf16(pa2, (bf16x8){l2[0], l2[1], l2[2], l2[3], h2[0], h2[1], h2[2], h2[3]}, o[d0], 0, 0, 0);   \
        o[d0] = __builtin_amdgcn_mfma_f32_32x32x16_bf16(pa3, (bf16x8){l3[0], l3[1], l3[2], l3[3], h3[0], h3[1], h3[2], h3[3]}, o[d0], 0, 0, 0); } while (0)
    PV_D0(0); PV_D0(1); PV_D0(2); PV_D0(3);
#undef PV_D0
#undef TRRD
}

#define DA_VMW() asm volatile("s_waitcnt vmcnt(0)" ::: "memory")
#define DA_SLOAD(koff_, voff_, k0) do { const unsigned tb_ = (unsigned)(k0) * (PITCH * 2); S.st_v0 = bld8(R, lv, (voff_) + tb_); S.st_v1 = bld8(R, lv, (voff_) + tb_ + 32 * PITCH * 2); \
                                  S.st_k = bld8(R, lk, (koff_) + tb_); } while (0)
#define DA_SWRITE_K(bf) do { *(LAS bf16x8*)(K_lds + (bf) * SHM_K + kws) = S.st_k; } while (0)
#define DA_SWRITE_V(bf) do { *(LAS bf16x8*)(V_lds + (bf) * SHM_V + vst0) = S.st_v0; *(LAS bf16x8*)(V_lds + (bf) * SHM_V + vst1) = S.st_v1; } while (0)

__device__ __forceinline__ void prime(const Ref& cur, LAS unsigned char* lds, Seam& S, rsrc_t R) {
    const int tid = threadIdx.x, wid = __builtin_amdgcn_readfirstlane(tid >> 6), lane = tid & 63, r32 = lane & 31, hi = lane >> 5;
    const int sr = tid >> 4, sc = (tid & 15) * 8, kr = tid >> 3, kc = tid & 7, kws = kr * 128 + ((kc ^ ((kr >> 1) & 7)) << 4);
    const unsigned lv = (unsigned)(sr * PITCH + sc) * 2u, lk = (unsigned)(kr * PITCH + kc * 8) * 2u, lq = (unsigned)((wid * QBLK + r32) * PITCH + hi * 8) * 2u;
    LAS unsigned char* K_lds = lds + OFF_K;
#pragma unroll
    for (int d0 = 0; d0 < 4; ++d0) S.qr[d0] = bld8(R, lq + d0 * 32, cur.qoff);
    DA_SLOAD(cur.koff, cur.voff, 0); DA_VMW(); DA_SWRITE_K(0);
    __syncthreads();
}
__device__ __forceinline__ void block(const Ref& cur, const Ref& nxt, LAS unsigned char* lds, Seam& S, float lam, const float* gsub, rsrc_t R) {
    const int tid = threadIdx.x, wid = __builtin_amdgcn_readfirstlane(tid >> 6), lane = tid & 63, r32 = lane & 31, hi = lane >> 5;
    const int NT = (cur.P0 + QB) / KVBLK;
    const int qlo = cur.P0 + wid * QBLK;
    LAS unsigned char* V_lds = lds + OFF_V; LAS unsigned char* K_lds = lds + OFF_K;
    LAS float* ws = (LAS float*)(lds + OFF_WS) + wid * 64; LAS float* li_l = ws; LAS float* al_l = ws + 32;
    const LAS float* tbh = (const LAS float*)(lds + OFF_TB) + cur.h * 128;
    float mhat = 0.f, l_reg = 0.f; f32x16 o[4] = {}; f32x16 negm = f32x16{};
    bool resc = false;
    const int sr = tid >> 4, sc = (tid & 15) * 8, vst0 = v_st(sr, sc), vst1 = v_st(32 + sr, sc);
    const int kr = tid >> 3, kc = tid & 7, kws = kr * 128 + ((kc ^ ((kr >> 1) & 7)) << 4);
    const int vb0 = (int)(unsigned)(uintptr_t)V_lds + v_rd_base(lane);
    const unsigned lv = (unsigned)(sr * PITCH + sc) * 2u, lk = (unsigned)(kr * PITCH + kc * 8) * 2u;
    const unsigned Kh = cur.koff, Vh = cur.voff;
    const int ksw = (r32 >> 1) & 7;
    const LAS unsigned char* kbase = K_lds + r32 * 128;
#define KBASE(t) ((t) * KVBLK)
#define NEAR(P0_, P1_, t) do { const int kb_ = KBASE(t); if (kb_ >= qlo - 175) bias_mask(P0_, P1_, qlo - kb_, tbh); } while (0)
#define RESC() do { if (resc) { asm volatile("s_waitcnt lgkmcnt(0)" ::: "memory");              \
                     _Pragma("unroll") for (int d_ = 0; d_ < 4; ++d_) _Pragma("unroll") for (int r = 0; r < 16; ++r) o[d_][r] *= al_l[crow(r, hi)]; } } while (0)
#define PIN(x) asm volatile("" : "+v"(x))
#define EX(v) __builtin_amdgcn_exp2f(v)
#define MX3(a, b, c) __builtin_fmaxf(__builtin_fmaxf((a), (b)), (c))
#define DECIDE(C0, C1, FIRST) do { \
        float a_ = MX3(C0[0], C0[1], C1[0]), b_ = MX3(C0[2], C0[3], C1[1]); a_ = MX3(a_, C1[2], C1[3]); \
        _Pragma("unroll") for (int r = 4; r < 16; r += 4) { a_ = MX3(a_, C0[r], C0[r + 1]); b_ = MX3(b_, C0[r + 2], C0[r + 3]); a_ = MX3(a_, C1[r], C1[r + 1]); b_ = MX3(b_, C1[r + 2], C1[r + 3]); } \
        float rm_ = __builtin_fmaxf(a_, b_); { auto rr_ = __builtin_amdgcn_permlane32_swap(__float_as_uint(rm_), __float_as_uint(rm_), false, false); rm_ = __builtin_fmaxf(__uint_as_float(rr_[0]), __uint_as_float(rr_[1])); } \
        resc = false; \
        if ((FIRST) || __builtin_expect(__any(rm_ > THR), 0)) { const float dl_ = (FIRST) ? rm_ : __builtin_fmaxf(rm_, 0.f); mhat += dl_; \
            _Pragma("unroll") for (int r = 0; r < 16; ++r) { C0[r] -= dl_; C1[r] -= dl_; } \
            _Pragma("unroll") for (int r = 0; r < 16; ++r) negm[r] = -mhat; \
            asm volatile("" : "+v"(negm)); \
            if (!(FIRST)) { const float f_ = EX(-dl_); l_reg *= f_; if (hi == 0) al_l[r32] = f_; resc = true; } } } while (0)
#define KF(d0, hf) (*(const LAS bf16x8*)(kbase + (KB_) * SHM_K + (((2 * (d0) + hi) ^ ksw) << 4) + (hf) * 4096))
#define GAPA(MF, P, B, W) do { MF; sacc += P[B]; sacc += P[B + 1]; sacc += P[B + 2]; sacc += P[B + 3]; PIN(sacc); W[((B) >> 1) & 3] = pk2(P[B], P[B + 1]); W[(((B) >> 1) & 3) + 1] = pk2(P[B + 2], P[B + 3]); PIN(W); SBAR(); } while (0)
#define PHASE_A(C0, C1, P0, P1, KBv) do { constexpr int KB_ = KBv; \
        const bf16x8 k00 = KF(0, 0), k01 = KF(0, 1), k10 = KF(1, 0), k11 = KF(1, 1), k20 = KF(2, 0), k21 = KF(2, 1), k30 = KF(3, 0), k31 = KF(3, 1); \
        float sacc = 0.f; SBAR(); \
        GAPA(C0 = __builtin_amdgcn_mfma_f32_32x32x16_bf16(k00, S.qr[0], negm, 0, 0, 0), P0, 0, pw0); \
        GAPA(C1 = __builtin_amdgcn_mfma_f32_32x32x16_bf16(k01, S.qr[0], negm, 0, 0, 0), P0, 4, pw0); \
        GAPA(C0 = __builtin_amdgcn_mfma_f32_32x32x16_bf16(k10, S.qr[1], C0, 0, 0, 0), P0, 8, pw1); \
        GAPA(C1 = __builtin_amdgcn_mfma_f32_32x32x16_bf16(k11, S.qr[1], C1, 0, 0, 0), P0, 12, pw1); \
        GAPA(C0 = __builtin_amdgcn_mfma_f32_32x32x16_bf16(k20, S.qr[2], C0, 0, 0, 0), P1, 0, pw2); \
        GAPA(C1 = __builtin_amdgcn_mfma_f32_32x32x16_bf16(k21, S.qr[2], C1, 0, 0, 0), P1, 4, pw2); \
        GAPA(C0 = __builtin_amdgcn_mfma_f32_32x32x16_bf16(k30, S.qr[3], C0, 0, 0, 0), P1, 8, pw3); \
        GAPA(C1 = __builtin_amdgcn_mfma_f32_32x32x16_bf16(k31, S.qr[3], C1, 0, 0, 0), P1, 12, pw3); \
        l_reg += sacc; } while (0)
#define TRRD(dst, off) asm volatile("ds_read_b64_tr_b16 %0, %1 offset:%2" : "=&v"(dst) : "v"(vb0), "i"(off) : "memory")
#define VRD8(L0, H0, L1, H1, L2, H2, L3, H3, VBv, d0) do { constexpr int b_ = (VBv) * SHM_V + v_rd_off(d0, 0, 0); \
        TRRD(L0, b_); TRRD(H0, b_ + 2048); TRRD(L1, b_ + 4096); TRRD(H1, b_ + 6144); TRRD(L2, b_ + 8192); TRRD(H2, b_ + 10240); TRRD(L3, b_ + 12288); TRRD(H3, b_ + 14336); } while (0)
#define VF(L, H) (bf16x8){L[0], L[1], L[2], L[3], H[0], H[1], H[2], H[3]}
#define PAF(k) __builtin_bit_cast(bf16x8, pw##k)
#define GAPB(MF, X, B) do { MF; X[B] = EX(X[B]); X[(B) + 1] = EX(X[(B) + 1]); PIN(X); SBAR(); } while (0)
#define PV4(d0, L0, H0, L1, H1, L2, H2, L3, H3, X, B) do { \
        GAPB(o[d0] = __builtin_amdgcn_mfma_f32_32x32x16_bf16(PAF(0), VF(L0, H0), o[d0], 0, 0, 0), X, (B)); \
        GAPB(o[d0] = __builtin_amdgcn_mfma_f32_32x32x16_bf16(PAF(1), VF(L1, H1), o[d0], 0, 0, 0), X, (B) + 2); \
        GAPB(o[d0] = __builtin_amdgcn_mfma_f32_32x32x16_bf16(PAF(2), VF(L2, H2), o[d0], 0, 0, 0), X, (B) + 4); \
        GAPB(o[d0] = __builtin_amdgcn_mfma_f32_32x32x16_bf16(PAF(3), VF(L3, H3), o[d0], 0, 0, 0), X, (B) + 6); } while (0)
#define LWAIT(n) do { asm volatile("s_waitcnt lgkmcnt(" #n ")" ::: "memory"); SBAR(); } while (0)
#define PHASE_B(C0, C1, VBv) do { s16x4 a0, a1, a2, a3, a4, a5, a6, a7, b0, b1, b2, b3, b4, b5, b6, b7; \
        asm volatile("s_waitcnt lgkmcnt(0)" ::: "memory"); SBAR(); \
        VRD8(a0, a1, a2, a3, a4, a5, a6, a7, VBv, 0); VRD8(b0, b1, b2, b3, b4, b5, b6, b7, VBv, 1); LWAIT(8); \
        PV4(0, a0, a1, a2, a3, a4, a5, a6, a7, C0, 0); \
        VRD8(a0, a1, a2, a3, a4, a5, a6, a7, VBv, 2); LWAIT(8); \
        PV4(1, b0, b1, b2, b3, b4, b5, b6, b7, C0, 8); \
        VRD8(b0, b1, b2, b3, b4, b5, b6, b7, VBv, 3); LWAIT(8); \
        PV4(2, a0, a1, a2, a3, a4, a5, a6, a7, C1, 0); \
        LWAIT(0); \
        PV4(3, b0, b1, b2, b3, b4, b5, b6, b7, C1, 8); } while (0)
    f32x16 pA0, pA1, pB0, pB1; u32x4 pw0, pw1, pw2, pw3;
    DA_SWRITE_V(0); SBAR();
    DA_SLOAD(Kh, Vh, KBASE(1));
    SBAR();
    { constexpr int KB_ = 0;
      const bf16x8 k00 = KF(0, 0), k01 = KF(0, 1), k10 = KF(1, 0), k11 = KF(1, 1), k20 = KF(2, 0), k21 = KF(2, 1), k30 = KF(3, 0), k31 = KF(3, 1);
      pA0 = __builtin_amdgcn_mfma_f32_32x32x16_bf16(k00, S.qr[0], negm, 0, 0, 0); pA1 = __builtin_amdgcn_mfma_f32_32x32x16_bf16(k01, S.qr[0], negm, 0, 0, 0);
      pA0 = __builtin_amdgcn_mfma_f32_32x32x16_bf16(k10, S.qr[1], pA0, 0, 0, 0); pA1 = __builtin_amdgcn_mfma_f32_32x32x16_bf16(k11, S.qr[1], pA1, 0, 0, 0);
      pA0 = __builtin_amdgcn_mfma_f32_32x32x16_bf16(k20, S.qr[2], pA0, 0, 0, 0); pA1 = __builtin_amdgcn_mfma_f32_32x32x16_bf16(k21, S.qr[2], pA1, 0, 0, 0);
      pA0 = __builtin_amdgcn_mfma_f32_32x32x16_bf16(k30, S.qr[3], pA0, 0, 0, 0); pA1 = __builtin_amdgcn_mfma_f32_32x32x16_bf16(k31, S.qr[3], pA1, 0, 0, 0); }
    NEAR(pA0, pA1, 0); DECIDE(pA0, pA1, true);
#pragma unroll
    for (int r = 0; r < 16; ++r) { pA0[r] = EX(pA0[r]); pA1[r] = EX(pA1[r]); }
    DA_VMW(); DA_SWRITE_V(1); DA_SWRITE_K(1);
    __syncthreads();
#define STEP(C0, C1, P0, P1, t, KBv, VBv, SBv) do { SBAR(); \
        PHASE_A(C0, C1, P0, P1, KBv); \
        if ((t) + 1 < NT) { DA_SLOAD(Kh, Vh, KBASE((t) + 1)); } SBAR(); \
        NEAR(C0, C1, (t)); DECIDE(C0, C1, false); SBAR(); \
        PHASE_B(C0, C1, VBv); \
        __syncthreads(); \
        if ((t) + 1 < NT) { DA_VMW(); DA_SWRITE_V(SBv); DA_SWRITE_K(SBv); } \
        RESC(); __syncthreads(); } while (0)
    int t = 1;
    for (; t + 2 < NT; t += 2) {
        STEP(pB0, pB1, pA0, pA1, t, 1, 0, 0);
        STEP(pA0, pA1, pB0, pB1, t + 1, 0, 1, 1);
    }
    SBAR(); PHASE_A(pB0, pB1, pA0, pA1, 1);
    DA_SLOAD(nxt.koff, nxt.voff, 0); SBAR();
    { const unsigned lq = (unsigned)((wid * QBLK + r32) * PITCH + hi * 8) * 2u;
#pragma unroll
      for (int d0 = 0; d0 < 4; ++d0) S.qr[d0] = bld8(R, lq + d0 * 32, nxt.qoff); }
    SBAR();
    NEAR(pB0, pB1, NT - 1); DECIDE(pB0, pB1, false); SBAR();
    PHASE_B(pB0, pB1, 0);
    RESC();
    { float sacc = 0.f;
#pragma unroll
      for (int r = 0; r < 16; ++r) { sacc += pB0[r]; sacc += pB1[r]; }
      l_reg += sacc;
      pw0 = (u32x4){pk2(pB0[0], pB0[1]), pk2(pB0[2], pB0[3]), pk2(pB0[4], pB0[5]), pk2(pB0[6], pB0[7])}; pw1 = (u32x4){pk2(pB0[8], pB0[9]), pk2(pB0[10], pB0[11]), pk2(pB0[12], pB0[13]), pk2(pB0[14], pB0[15])};
      pw2 = (u32x4){pk2(pB1[0], pB1[1]), pk2(pB1[2], pB1[3]), pk2(pB1[4], pB1[5]), pk2(pB1[6], pB1[7])}; pw3 = (u32x4){pk2(pB1[8], pB1[9]), pk2(pB1[10], pB1[11]), pk2(pB1[12], pB1[13]), pk2(pB1[14], pB1[15])};
      SBAR(); pv_tile<1>(o, vb0, PAF(0), PAF(1), PAF(2), PAF(3)); }
    SBAR(); asm volatile("s_waitcnt vmcnt(4)" ::: "memory"); DA_SWRITE_K(0); SBAR();
    { auto rr = __builtin_amdgcn_permlane32_swap(__float_as_uint(l_reg), __float_as_uint(l_reg), false, false); l_reg = __uint_as_float(rr[0]) + __uint_as_float(rr[1]); }
    int lane_e = (int)__builtin_amdgcn_mbcnt_hi(~0u, __builtin_amdgcn_mbcnt_lo(~0u, 0u)); asm volatile("" : "+v"(lane_e));
    const int r32e = lane_e & 31, hie = lane_e >> 5;
    if (hi == 0) li_l[r32] = l_reg; asm volatile("s_waitcnt lgkmcnt(0)" ::: "memory");
    float rli[16];
#pragma unroll
    for (int r = 0; r < 16; ++r) rli[r] = __builtin_amdgcn_rcpf(li_l[crow(r, hi)]);
    LAS unsigned* st = (LAS unsigned*)(lds + OFF_STASH + wid * 8192) + lane_e;
    if (cur.comp == 0) {
#pragma unroll
        for (int r = 0; r < 16; ++r) { st[(2 * r) * 64] = pk2(o[0][r] * rli[r], o[1][r] * rli[r]); st[(2 * r + 1) * 64] = pk2(o[2][r] * rli[r], o[3][r] * rli[r]); }
    } else {
        float ss[16];
#pragma unroll
        for (int r = 0; r < 16; ++r) { const unsigned u0 = st[(2 * r) * 64], u1 = st[(2 * r + 1) * 64];
            const float s2 = lam * rli[r];
            o[0][r] = bflo(u0) - s2 * o[0][r]; o[1][r] = bfhi(u0) - s2 * o[1][r]; o[2][r] = bflo(u1) - s2 * o[2][r]; o[3][r] = bfhi(u1) - s2 * o[3][r];
            ss[r] = (o[0][r] * o[0][r] + o[1][r] * o[1][r]) + (o[2][r] * o[2][r] + o[3][r] * o[3][r]); }
#pragma unroll
        for (int r = 0; r < 16; ++r) {
#pragma unroll
            for (int x = 1; x < 32; x <<= 1) ss[r] += __shfl_xor(ss[r], x);
            ss[r] = rsqrtf(ss[r] * (1.f / 128.f) + EPS) * 0.8f; }
        float gg[4];
#pragma unroll
        for (int d0 = 0; d0 < 4; ++d0) gg[d0] = gsub[d0 * 32 + r32e];
        bf16_t* Ow = cur.O + (size_t)(wid * QBLK) * DM;
#pragma unroll
        for (int r = 0; r < 16; ++r) { const int orow = crow(r, hie);
#pragma unroll
            for (int d0 = 0; d0 < 4; ++d0) { const float v = o[d0][r] * ss[r] * gg[d0]; const float vn = __shfl_xor(v, 1);
                if ((r32e & 1) == 0) *(unsigned*)(Ow + (size_t)orow * DM + d0 * 32 + r32e) = pk2(v, vn); } }
    }
    __syncthreads();
#undef RESC
#undef KBASE
#undef NEAR
#undef PIN
#undef EX
#undef MX3
#undef DECIDE
#undef KF
#undef GAPA
#undef PHASE_A
#undef TRRD
#undef VRD8
#undef VF
#undef PAF
#undef GAPB
#undef PV4
#undef LWAIT
#undef PHASE_B
#undef STEP
}
#undef DA_VMW
#undef DA_SLOAD
#undef DA_SWRITE_K
#undef DA_SWRITE_V
}

constexpr int NWAVES = 8;
constexpr int N_LAUNCHES = MK_N_LAUNCHES;
constexpr int N_PHASES = 9;
static_assert(N_LAUNCHES == 1 || N_LAUNCHES == N_PHASES, "MK_N_LAUNCHES is 1 or 9");

constexpr size_t MiB = 1u << 20;
constexpr size_t WS_CTL = 0, CTL_ZERO_BYTES = 1 * MiB;
constexpr size_t WS_ETK = 1 * MiB, WS_GTK = 2 * MiB, WS_RSTDT = 3 * MiB, WS_SLOTTK = 4 * MiB, WS_TOKSLOT = 5 * MiB, WS_GATESLOT = 7 * MiB, WS_RSTDSLOT = 9 * MiB, WS_RBE = 11 * MiB;
constexpr size_t WS_WRHI = 12 * MiB, WS_WRLO = 12 * MiB + 65536, WS_KMB = 13 * MiB, WS_VMT = 14 * MiB;
constexpr size_t WS_WIN = 16 * MiB, WS_WOUT = 21 * MiB, WS_X1B = 24 * MiB, WS_X1Q = 152 * MiB;
constexpr size_t WS_BIG = 216 * MiB;
constexpr size_t WS_H = WS_BIG, WS_PROJ = WS_BIG + 128 * MiB, WS_MIX = WS_BIG + 448 * MiB;
constexpr size_t WS_ACTQ = WS_BIG, WS_Y = WS_BIG + 264 * MiB;
constexpr size_t WS_END = WS_BIG + 792 * MiB;
static_assert(WS_END <= 1024 * MiB, "d_ws map");
constexpr size_t OUT_WGU = 0, OUT_WD = 64 * MiB;
constexpr int CW_BAR = 4096, CW_COUNT = 1024, CW_CURSOR = 2048;
constexpr int RING_BYTES = 131072, LDSCTL_OFF = RING_BYTES, MISC_OFF = LDSCTL_OFF + 320, LDS_BYTES = 147456;
static_assert(dattn::LDS_BYTES <= RING_BYTES, "attention scratch");

#define XB_TMO      128
#define XB_XCNT(j)  (256  + 64 * (j))
#define XB_XSUB(j)  (1280 + 64 * (j))
#define XB_XGEN(j)  (2304 + 64 * (j))
#define XB_TOP      3328
#define XB_TOPGEN   3392
#define XCD_BAR_WORDS 3456
#define XB_SPIN_CAP (1u << 18)
__device__ __forceinline__ unsigned xb_ld(unsigned* p)              { return __hip_atomic_load(p, __ATOMIC_RELAXED, __HIP_MEMORY_SCOPE_AGENT); }
__device__ __forceinline__ unsigned xb_add(unsigned* p, unsigned v) { return __hip_atomic_fetch_add(p, v, __ATOMIC_RELAXED, __HIP_MEMORY_SCOPE_AGENT); }
__device__ __forceinline__ unsigned xb_xcc_id() { return (unsigned)__builtin_amdgcn_s_getreg((3 << 11) | 20) & 0xFu; }
#define XB_SPIN(cond, bar) do { unsigned _sp = 0; while (cond) { __builtin_amdgcn_s_sleep(1); \
    if ((++_sp & 255u) == 0u) { if (xb_ld(&(bar)[XB_TMO])) break; if (_sp > XB_SPIN_CAP) { atomicAdd(&(bar)[XB_TMO], 1u); break; } } } } while (0)
struct XcdBarrier { unsigned* bar; unsigned x; volatile LAS unsigned* st; };
__device__ __forceinline__ XcdBarrier xcd_barrier_post(unsigned* bar, volatile LAS unsigned* st) {
    XcdBarrier b; b.bar = bar; b.x = xb_xcc_id(); b.st = st;
    if (threadIdx.x == 0) (void)xb_add(&bar[XB_XCNT(b.x)], 1u);
    return b;
}
__device__ __forceinline__ void xcd_barrier_complete(unsigned* bar, unsigned x, unsigned& nloc, unsigned& nx) {
    const unsigned G = gridDim.x * gridDim.y * gridDim.z;
    unsigned sum, cnt, mine, sp = 0u;
    for (;;) {
        sum = 0u; cnt = 0u; mine = 0u;
#pragma unroll
        for (unsigned j = 0; j < 16; ++j) { const unsigned c = xb_ld(&bar[XB_XCNT(j)]); sum += c; cnt += (c > 0u) ? 1u : 0u; mine = (j == x) ? c : mine; }
        if (sum == G) break;
        __builtin_amdgcn_s_sleep(1);
        if ((++sp & 255u) == 0u) { if (xb_ld(&bar[XB_TMO])) break; if (sp > XB_SPIN_CAP) { atomicAdd(&bar[XB_TMO], 1u); break; } }
    }
    nloc = mine > 0u ? mine : 1u; nx = cnt > 0u ? cnt : 1u;
}
__device__ __forceinline__ void xcd_barrier(const XcdBarrier& b) {
    asm volatile("s_waitcnt vmcnt(0)" ::: "memory");
    __syncthreads();
    if (threadIdx.x == 0) {
        unsigned* bar = b.bar;
        __builtin_amdgcn_s_waitcnt(0);
        unsigned nloc = b.st[0], nx = b.st[1];
        if (nloc == 0u) { xcd_barrier_complete(bar, b.x, nloc, nx); b.st[0] = nloc; b.st[1] = nx; }
        const unsigned old = xb_add(&bar[XB_XSUB(b.x)], 1u);
        const unsigned gen = old / nloc;
        if (old + 1u == (gen + 1u) * nloc) {
            __builtin_amdgcn_fence(__ATOMIC_RELEASE, "agent");
            asm volatile("s_waitcnt vmcnt(0)" ::: "memory");
            const unsigned og = xb_add(&bar[XB_TOP], 1u);
            const unsigned tg = og / nx;
            if (og + 1u == (tg + 1u) * nx) xb_add(&bar[XB_TOPGEN], 1u);
            else XB_SPIN(xb_ld(&bar[XB_TOPGEN]) == tg, bar);
            __builtin_amdgcn_fence(__ATOMIC_ACQUIRE, "agent");
            xb_add(&bar[XB_XGEN(b.x)], 1u);
            asm volatile("s_waitcnt vmcnt(0)" ::: "memory");
        } else {
            XB_SPIN(xb_ld(&bar[XB_XGEN(b.x)]) == gen, bar);
            __builtin_amdgcn_fence(__ATOMIC_ACQUIRE, "agent");
            asm volatile("s_waitcnt vmcnt(0)" ::: "memory");
        }
    }
    __syncthreads();
}

struct Frame {
    LAS unsigned char* lds;
    volatile LAS unsigned* MISC;
    unsigned* ctl;
    int tid, lane, wave, vcu, G;
    float* out;
    unsigned char* ws;
};
struct Args { const float* in[19]; float* out; unsigned char* ws; int ph_lo, ph_hi; };
typedef const __attribute__((address_space(4))) Args* KArgs;
__device__ __forceinline__ KArgs kargs() { KArgs p = (KArgs)__builtin_amdgcn_kernarg_segment_ptr(); asm volatile("" : "+s"(p)); return p; }
enum { I_X = 0, I_MEM, I_RELB, I_ATTNG, I_WIN, I_CONVW, I_LAMQK, I_SUBG, I_MEMG, I_WMEMKV, I_WOUT, I_FFNG, I_RW, I_RB, I_WGU, I_BGU, I_WDN, I_BDN, I_FING };

__device__ __forceinline__ void p0_transpose_item(const float* W, int K, int N, bf16_t* WT, int k0, int n0, int drow0, const float* kgain, LAS float* scr, int lane) {
#pragma unroll 16
    for (int i = 0; i < 32; ++i) { const int kk = 2 * i + (lane >> 5); float v = W[(size_t)(k0 + kk) * N + n0 + (lane & 31)]; if (kgain) v *= kgain[k0 + kk]; scr[kk * 33 + (lane & 31)] = v; }
    LDS_WAIT(); asm volatile("" ::: "memory");
    const int c = lane & 7;
#pragma unroll
    for (int j = 0; j < 4; ++j) { const int n = (lane >> 3) + 8 * j; const LAS float* s = scr + (8 * c) * 33 + n;
        u32x4 o; o.x = pk2(s[0 * 33], s[1 * 33]); o.y = pk2(s[2 * 33], s[3 * 33]); o.z = pk2(s[4 * 33], s[5 * 33]); o.w = pk2(s[6 * 33], s[7 * 33]);
        *(u32x4*)(WT + (size_t)(drow0 + n) * K + k0 + 8 * c) = o; }
    LDS_WAIT(); asm volatile("" ::: "memory");
}
__device__ __forceinline__ void rms_row2_to_bf16(const float* xa, const float* xb, const float* g, bf16_t* oa, bf16_t* ob, int lane) {
    const f32x4* ra = (const f32x4*)xa + lane; const f32x4* rb = (const f32x4*)xb + lane; const f32x4* gr = (const f32x4*)g + lane;
    f32x4 va[4], vb[4]; float sa = 0.f, sb = 0.f;
#pragma unroll
    for (int j = 0; j < 4; ++j) { va[j] = ra[64 * j]; vb[j] = rb[64 * j]; }
#pragma unroll
    for (int j = 0; j < 4; ++j) { sa += (va[j].x * va[j].x + va[j].y * va[j].y) + (va[j].z * va[j].z + va[j].w * va[j].w); sb += (vb[j].x * vb[j].x + vb[j].y * vb[j].y) + (vb[j].z * vb[j].z + vb[j].w * vb[j].w); }
    const float rsa = rsqrtf(wave_sum(sa) * (1.f / DM) + EPS), rsb = rsqrtf(wave_sum(sb) * (1.f / DM) + EPS);
    unsigned long long* pa = (unsigned long long*)oa + lane; unsigned long long* pb = (unsigned long long*)ob + lane;
#pragma unroll
    for (int j = 0; j < 4; ++j) { const f32x4 gg = gr[64 * j];
        pa[64 * j] = (unsigned long long)pk2(va[j].x * rsa * gg.x, va[j].y * rsa * gg.y) | ((unsigned long long)pk2(va[j].z * rsa * gg.z, va[j].w * rsa * gg.w) << 32);
        pb[64 * j] = (unsigned long long)pk2(vb[j].x * rsb * gg.x, vb[j].y * rsb * gg.y) | ((unsigned long long)pk2(vb[j].z * rsb * gg.z, vb[j].w * rsb * gg.w) << 32); }
}
__device__ __forceinline__ void p0_kvm_tile(Frame& F, int tile, const float* mem, const float* mem_g, const float* w_memkv) {
    const int mt = tile >> 3, ntile = tile & 7, row0 = 64 * mt, col0 = 64 * ntile;
    const int mb = F.wave >> 1, nb0 = (F.wave & 1) * 2, ar = F.lane & 15, kq = F.lane >> 4;
    const float* arow = mem + (size_t)(row0 + mb * 16 + ar) * DM;
    f32x4 acc[2]; acc[0] = (f32x4){0.f, 0.f, 0.f, 0.f}; acc[1] = acc[0];
    float ss = 0.f;
#pragma unroll 4
    for (int k0 = 0; k0 < DM; k0 += 32) {
        const int kk = k0 + 8 * kq;
        const f32x4 a0 = *(const f32x4*)(arow + kk), a1 = *(const f32x4*)(arow + kk + 4), g0 = *(const f32x4*)(mem_g + kk), g1 = *(const f32x4*)(mem_g + kk + 4);
        ss += (a0.x * a0.x + a0.y * a0.y) + (a0.z * a0.z + a0.w * a0.w) + (a1.x * a1.x + a1.y * a1.y) + (a1.z * a1.z + a1.w * a1.w);
        const bf16x8 af = pack8(a0 * g0, a1 * g1);
#pragma unroll
        for (int nbi = 0; nbi < 2; ++nbi) { const float* wp = w_memkv + (size_t)kk * 512 + col0 + (nb0 + nbi) * 16 + ar;
            f32x4 b0, b1; b0.x = wp[0]; b0.y = wp[512]; b0.z = wp[1024]; b0.w = wp[1536]; b1.x = wp[2048]; b1.y = wp[2560]; b1.z = wp[3072]; b1.w = wp[3584];
            acc[nbi] = __builtin_amdgcn_mfma_f32_16x16x32_bf16(af, pack8(b0, b1), acc[nbi], 0, 0, 0); }
    }
    ss += __shfl_xor(ss, 16); ss += __shfl_xor(ss, 32);
    const float rstd = rsqrtf(ss * (1.f / DM) + EPS);
    float rs[4];
#pragma unroll
    for (int j = 0; j < 4; ++j) rs[j] = __shfl(rstd, kq * 4 + j);
    bf16_t* kmb = (bf16_t*)(F.ws + WS_KMB); bf16_t* vmt = (bf16_t*)(F.ws + WS_VMT);
#pragma unroll
    for (int nbi = 0; nbi < 2; ++nbi) {
        const int gc = col0 + (nb0 + nbi) * 16 + ar, gr0 = row0 + mb * 16 + kq * 4;
        if (ntile < 4) {
#pragma unroll
            for (int j = 0; j < 4; ++j) kmb[(size_t)(gr0 + j) * 256 + gc] = (bf16_t)(pk2(acc[nbi][j] * rs[j], 0.f) & 0xffffu);
        } else {
            const int d = gc - 256, hm = d >> 6, dd = d & 63, b = gr0 >> 8, m = gr0 & 255;
            u32x2 w; w.x = pk2(acc[nbi][0] * rs[0], acc[nbi][1] * rs[1]); w.y = pk2(acc[nbi][2] * rs[2], acc[nbi][3] * rs[3]);
            *(u32x2*)(vmt + ((size_t)((b * 4 + hm) * 64 + dd)) * 256 + m) = w;
        }
    }
}
__device__ __forceinline__ void p0_transpose_item_fp8(const float* W, int K, int N, unsigned char* WT, int k0, int n0, int drow0, const float* kgain, float scale, LAS float* scr, int lane) {
#pragma unroll 16
    for (int i = 0; i < 32; ++i) { const int kk = 2 * i + (lane >> 5); float v = W[(size_t)(k0 + kk) * N + n0 + (lane & 31)] * scale; if (kgain) v *= kgain[k0 + kk]; scr[kk * 33 + (lane & 31)] = v; }
    LDS_WAIT(); asm volatile("" ::: "memory");
    const int c = lane & 7;
#pragma unroll
    for (int j = 0; j < 4; ++j) { const int n = (lane >> 3) + 8 * j; const LAS float* s = scr + (8 * c) * 33 + n;
        u32x2 o; o.x = pg8::pk4_fp8(s[0 * 33], s[1 * 33], s[2 * 33], s[3 * 33]); o.y = pg8::pk4_fp8(s[4 * 33], s[5 * 33], s[6 * 33], s[7 * 33]);
        *(u32x2*)(WT + (size_t)(drow0 + n) * K + k0 + 8 * c) = o; }
    LDS_WAIT(); asm volatile("" ::: "memory");
}
__device__ __forceinline__ void p0_prologue(Frame& F) {
    KArgs A = kargs();
    { const float* mem = A->in[I_MEM]; const float* mem_g = A->in[I_MEMG]; const float* w_memkv = A->in[I_WMEMKV];
      for (int tile = blockIdx.x; tile < 256; tile += F.G) p0_kvm_tile(F, tile, mem, mem_g, w_memkv); }
    const float* w_in = A->in[I_WIN]; const float* w_out = A->in[I_WOUT]; const float* w_gu = A->in[I_WGU]; const float* w_dn = A->in[I_WDN]; const float* ffn_g = A->in[I_FFNG];
    LAS float* scr = (LAS float*)(F.lds + F.wave * 16384);
    const int gw = F.vcu * NWAVES + F.wave, NGW = F.G * NWAVES;
    bf16_t* Win_t = (bf16_t*)(F.ws + WS_WIN); bf16_t* Wout_t = (bf16_t*)(F.ws + WS_WOUT);
    unsigned char* Wgu_q = (unsigned char*)F.out + OUT_WGU; unsigned char* Wd_q = (unsigned char*)F.out + OUT_WD;
    constexpr int I_IN = 16 * 80, I_OUT = 16 * 32, I_GU1 = 16 * 64, I_D1 = 16 * 32;
    constexpr int I_GU = NEXP * I_GU1, I_D = NEXP * I_D1, NITEMS = I_IN + I_OUT + I_GU + I_D;
    for (int it = gw; it < NITEMS; it += NGW) {
        int r = it;
        if (r < I_IN) { const int kb = r / 80, nb = r % 80; p0_transpose_item(w_in, DM, INW, Win_t, 64 * kb, 32 * nb, 32 * nb, nullptr, scr, F.lane); continue; } r -= I_IN;
        if (r < I_OUT) { const int kb = r / 32, nb = r % 32; p0_transpose_item(w_out, DM, DM, Wout_t, 64 * kb, 32 * nb, 32 * nb, nullptr, scr, F.lane); continue; } r -= I_OUT;
        if (r < I_GU) { const int e = r / I_GU1, q = r % I_GU1, kb = q / 64, nb = q % 64, n0 = 32 * nb;
            const int jj = n0 & 1023, drow0 = (jj >> 7) * 256 + (n0 >= 1024 ? 128 : 0) + (jj & 127);
            p0_transpose_item_fp8(w_gu + (size_t)e * DM * 2048, DM, 2048, Wgu_q + (size_t)e * 2048 * DM, 64 * kb, n0, drow0, ffn_g, 64.f, scr, F.lane); continue; } r -= I_GU;
        { const int e = r / I_D1, q = r % I_D1, kb = q / 32, nb = q % 32;
            p0_transpose_item_fp8(w_dn + (size_t)e * DEXP * DM, DEXP, DM, Wd_q + (size_t)e * DM * DEXP, 64 * kb, 32 * nb, 32 * nb, nullptr, 64.f, scr, F.lane); }
    }
    bf16_t* H = (bf16_t*)(F.ws + WS_H);
    { const float* x = A->in[I_X]; const float* attn_g = A->in[I_ATTNG];
      for (int m = gw; m < T; m += 2 * NGW) { const int m2 = (m + NGW < T) ? m + NGW : m;
          rms_row2_to_bf16(x + (size_t)m * DM, x + (size_t)m2 * DM, attn_g, H + (size_t)m * DM, H + (size_t)m2 * DM, F.lane); } }
    const float* router_w = A->in[I_RW];
    bf16_t* wrh = (bf16_t*)(F.ws + WS_WRHI); bf16_t* wrl = (bf16_t*)(F.ws + WS_WRLO);
    for (int i = (F.vcu * NWAVES + F.wave) * 64 + F.lane; i < NEXP * DM; i += NGW * 64) { const int e = i >> 10, k = i & 1023;
        const float v = ffn_g[k] * router_w[(size_t)k * NEXP + e]; const unsigned hb = pk2(v, 0.f) & 0xffffu; const float hf = __uint_as_float(hb << 16);
        wrh[i] = (bf16_t)hb; wrl[i] = (bf16_t)(pk2(v - hf, 0.f) & 0xffffu); }
}

__device__ __forceinline__ void p2_conv_block(Frame& F, int blk, int tid_, const float* conv_w) {
    const bf16_t* proj = (const bf16_t*)(F.ws + WS_PROJ); bf16_t* mix = (bf16_t*)(F.ws + WS_MIX);
    const int cg = tid_ & 31, tc = tid_ >> 5;
    const int c0 = cg * 8, t0 = blk * 256 + tc * 16, s0 = t0 & (SEQ - 1);
    float w0[8], w1[8], w2[8];
#pragma unroll
    for (int i = 0; i < 8; ++i) { w0[i] = conv_w[c0 + i]; w1[i] = conv_w[256 + c0 + i]; w2[i] = conv_w[512 + c0 + i]; }
    float p2[8], p1[8];
#pragma unroll
    for (int i = 0; i < 8; ++i) { p2[i] = 0.f; p1[i] = 0.f; }
    if (s0 >= 2) {
        const u32x4 ua = *(const u32x4*)(proj + (size_t)(t0 - 2) * INW + COL_U + c0), ca = *(const u32x4*)(proj + (size_t)(t0 - 2) * INW + COL_GC + c0);
        const u32x4 ub = *(const u32x4*)(proj + (size_t)(t0 - 1) * INW + COL_U + c0), cb = *(const u32x4*)(proj + (size_t)(t0 - 1) * INW + COL_GC + c0);
#pragma unroll
        for (int i = 0; i < 4; ++i) { p2[2 * i] = bflo(ua[i]) * bflo(ca[i]); p2[2 * i + 1] = bfhi(ua[i]) * bfhi(ca[i]); p1[2 * i] = bflo(ub[i]) * bflo(cb[i]); p1[2 * i + 1] = bfhi(ub[i]) * bfhi(cb[i]); }
    }
    for (int tt = 0; tt < 16; ++tt) {
        const size_t ro = (size_t)(t0 + tt) * INW;
        const u32x4 uu = *(const u32x4*)(proj + ro + COL_U + c0), cc = *(const u32x4*)(proj + ro + COL_GC + c0), bb = *(const u32x4*)(proj + ro + COL_GB + c0);
        float cur[8], y[8];
#pragma unroll
        for (int i = 0; i < 4; ++i) { cur[2 * i] = bflo(uu[i]) * bflo(cc[i]); cur[2 * i + 1] = bfhi(uu[i]) * bfhi(cc[i]); }
#pragma unroll
        for (int i = 0; i < 4; ++i) { y[2 * i] = bflo(bb[i]) * (w0[2 * i] * p2[2 * i] + w1[2 * i] * p1[2 * i] + w2[2 * i] * cur[2 * i]);
                                       y[2 * i + 1] = bfhi(bb[i]) * (w0[2 * i + 1] * p2[2 * i + 1] + w1[2 * i + 1] * p1[2 * i + 1] + w2[2 * i + 1] * cur[2 * i + 1]); }
        u32x4 o; o.x = pk2(y[0], y[1]); o.y = pk2(y[2], y[3]); o.z = pk2(y[4], y[5]); o.w = pk2(y[6], y[7]);
        *(u32x4*)(mix + (size_t)(t0 + tt) * DM + c0) = o;
#pragma unroll
        for (int i = 0; i < 8; ++i) { p2[i] = p1[i]; p1[i] = cur[i]; }
    }
}
__device__ __forceinline__ void p2_mem_block(Frame& F, int blk, int lane_) {
    const bf16_t* proj = (const bf16_t*)(F.ws + WS_PROJ); bf16_t* mix = (bf16_t*)(F.ws + WS_MIX);
    const bf16_t* kmb = (const bf16_t*)(F.ws + WS_KMB); const bf16_t* vmt = (const bf16_t*)(F.ws + WS_VMT);
    const int r32 = lane_ & 31, hi = lane_ >> 5, b = blk >> 5, tw = blk * 256 + F.wave * 32;
    for (int hm = 0; hm < 4; ++hm) {
        bf16x8 qr[4];
#pragma unroll
        for (int d0 = 0; d0 < 4; ++d0) qr[d0] = *(const bf16x8*)(proj + (size_t)(tw + r32) * INW + COL_QM + hm * 64 + d0 * 16 + hi * 8);
        float mx = -__builtin_inff();
#pragma unroll 1
        for (int kb = 0; kb < 8; ++kb) { f32x16 p = f32x16{};
#pragma unroll
            for (int d0 = 0; d0 < 4; ++d0) { const bf16x8 kf = *(const bf16x8*)(kmb + (size_t)(b * 256 + kb * 32 + r32) * 256 + hm * 64 + d0 * 16 + hi * 8);
                p = __builtin_amdgcn_mfma_f32_32x32x16_bf16(kf, qr[d0], p, 0, 0, 0); }
#pragma unroll
            for (int r = 0; r < 16; ++r) mx = fmaxf(mx, p[r]); }
        mx = fmaxf(mx, __shfl_xor(mx, 32));
        float sum = 0.f;
        f32x16 o[2]; o[0] = f32x16{}; o[1] = f32x16{};
#pragma unroll 1
        for (int kb = 0; kb < 8; ++kb) { f32x16 p = f32x16{};
#pragma unroll
            for (int d0 = 0; d0 < 4; ++d0) { const bf16x8 kf = *(const bf16x8*)(kmb + (size_t)(b * 256 + kb * 32 + r32) * 256 + hm * 64 + d0 * 16 + hi * 8);
                p = __builtin_amdgcn_mfma_f32_32x32x16_bf16(kf, qr[d0], p, 0, 0, 0); }
#pragma unroll
            for (int r = 0; r < 16; ++r) { p[r] = __builtin_amdgcn_exp2f(p[r] - mx); sum += p[r]; }
            bf16x8 pa0, pa1;
#define PK4(P, B_, OUT) do { unsigned a0 = pk2(P[B_+0], P[B_+1]), a1 = pk2(P[B_+2], P[B_+3]); unsigned b0 = pk2(P[B_+4], P[B_+5]), b1 = pk2(P[B_+6], P[B_+7]); \
        auto r0 = __builtin_amdgcn_permlane32_swap(a0, b0, false, false); auto r1 = __builtin_amdgcn_permlane32_swap(a1, b1, false, false); \
        u32x4 w = {r0[0], r1[0], r0[1], r1[1]}; OUT = __builtin_bit_cast(bf16x8, w); } while (0)
            PK4(p, 0, pa0); PK4(p, 8, pa1);
#undef PK4
#pragma unroll
            for (int d0 = 0; d0 < 2; ++d0) { const bf16_t* vp = vmt + ((size_t)((b * 4 + hm) * 64 + d0 * 32 + r32)) * 256 + kb * 32 + hi * 8;
                o[d0] = __builtin_amdgcn_mfma_f32_32x32x16_bf16(pa0, *(const bf16x8*)(vp), o[d0], 0, 0, 0);
                o[d0] = __builtin_amdgcn_mfma_f32_32x32x16_bf16(pa1, *(const bf16x8*)(vp + 16), o[d0], 0, 0, 0); }
        }
        sum += __shfl_xor(sum, 32);
        const float linv = __builtin_amdgcn_rcpf(sum);
#pragma unroll
        for (int r = 0; r < 16; ++r) { const int orow = crow(r, hi); const float li = __shfl(linv, orow);
#pragma unroll
            for (int d0 = 0; d0 < 2; ++d0) { const float v = o[d0][r] * li; const float vn = __shfl_xor(v, 1);
                if ((r32 & 1) == 0) *(unsigned*)(mix + (size_t)(tw + orow) * DM + 768 + hm * 64 + d0 * 32 + r32) = pk2(v, vn); } }
    }
}
__device__ __forceinline__ dattn::Ref da_ref(Frame& F, int n) {
    const int pid = F.vcu + (n >> 2) * F.G, sub = n & 3, blk = sub >> 1, comp = sub & 1, bh = pid >> 4, s = pid & 15, qb = blk ? 31 - s : s, b = bh >> 2, h = bh & 3;
    bf16_t* mix = (bf16_t*)(F.ws + WS_MIX);
    dattn::Ref r;
    r.qoff = (unsigned)(((size_t)(b * SEQ + qb * 256) * INW + COL_Q + h * 128 + comp * 64) * 2);
    r.koff = (unsigned)(((size_t)(b * SEQ) * INW + COL_K + h * 128 + comp * 64) * 2);
    r.voff = (unsigned)(((size_t)(b * SEQ) * INW + COL_V + h * 128) * 2);
    r.O = mix + (size_t)(b * SEQ + qb * 256) * DM + 256 + h * 128;
    r.P0 = qb * 256; r.comp = comp; r.h = h;
    return r;
}
__device__ __forceinline__ void p2_mixers(Frame& F) {
    KArgs A = kargs();
    const float* rel_bias = A->in[I_RELB]; const float* lam_qk = A->in[I_LAMQK]; const float* subln_g = A->in[I_SUBG];
    if (F.tid < 512) { const int h = F.tid >> 7, n = F.tid & 127; int bk;
        if (n < 16) bk = n; else { bk = 16; const int thr[15] = {19, 21, 24, 27, 31, 35, 40, 46, 52, 59, 67, 77, 87, 99, 113};
#pragma unroll
            for (int i = 0; i < 15; ++i) bk += (n >= thr[i]) ? 1 : 0; }
        ((LAS float*)(F.lds + dattn::OFF_TB))[h * 128 + n] = (rel_bias[bk * 4 + h] - rel_bias[31 * 4 + h]) * LOG2E; }
    float d1 = 0.f, d2 = 0.f;
    for (int i = 0; i < 64; ++i) { d1 += lam_qk[i] * lam_qk[64 + i]; d2 += lam_qk[128 + i] * lam_qk[192 + i]; }
    const float lam = __expf(d1) - __expf(d2) + 0.2f;
    __syncthreads();
    const int npairs = F.vcu < 512 ? (512 - F.vcu + F.G - 1) / F.G : 0, total1 = 4 * npairs, total = ((PROBE_REP >> 2) & 1) ? 2 * total1 : total1;
    if (total > 0) {
        dattn::Seam S; dattn::Ref cur = da_ref(F, 0);
        const dattn::rsrc_t R = __builtin_amdgcn_make_buffer_rsrc((void*)(F.ws + WS_PROJ), 0, (int)((size_t)T * INW * 2), 0x00020000);
        dattn::prime(cur, F.lds, S, R);
        for (int n = 0; n < total; ++n) {
            const dattn::Ref nxt = (n + 1 < total) ? da_ref(F, (n + 1) % total1) : cur;
            dattn::block(cur, nxt, F.lds, S, lam, subln_g, R);
            cur = nxt;
        }
    }
    int lane2 = (int)__builtin_amdgcn_mbcnt_hi(~0u, __builtin_amdgcn_mbcnt_lo(~0u, 0u)); asm volatile("" : "+v"(lane2));
    const int tid2 = F.wave * 64 + lane2;
    const float* conv_w = kargs()->in[I_CONVW];
    for (int blk = blockIdx.x; blk < T / 256; blk += F.G) { p2_conv_block(F, blk, tid2, conv_w); p2_mem_block(F, blk, lane2); }
}

__device__ __forceinline__ void p4_router(Frame& F) {
    const float* router_b = kargs()->in[I_RB];
    const bf16_t* x1b = (const bf16_t*)(F.ws + WS_X1B); const bf16_t* wrh = (const bf16_t*)(F.ws + WS_WRHI); const bf16_t* wrl = (const bf16_t*)(F.ws + WS_WRLO);
    int* e_tk = (int*)(F.ws + WS_ETK); float* g_tk = (float*)(F.ws + WS_GTK); float* rstd_t = (float*)(F.ws + WS_RSTDT);
    LAS float* lg = (LAS float*)F.lds + F.wave * (32 * 33); LAS unsigned* hist = (LAS unsigned*)(F.lds + 8 * 32 * 33 * 4);
    const int r32 = F.lane & 31, hi = F.lane >> 5;
    for (int blk = blockIdx.x; blk < T / 256; blk += F.G) {
        if (F.tid < 32) hist[F.tid] = 0u;
        __syncthreads();
        const int t0 = blk * 256 + F.wave * 32;
        const bf16_t* xr = x1b + (size_t)(t0 + r32) * DM + hi * 8; const bf16_t* wh = wrh + (size_t)r32 * DM + hi * 8; const bf16_t* wl = wrl + (size_t)r32 * DM + hi * 8;
        f32x16 acc = f32x16{}; float ss = 0.f;
#pragma unroll 4
        for (int k0 = 0; k0 < DM; k0 += 16) {
            const u32x4 xw = *(const u32x4*)(xr + k0); const bf16x8 ah = *(const bf16x8*)(wh + k0), al = *(const bf16x8*)(wl + k0);
#pragma unroll
            for (int i = 0; i < 4; ++i) { const float a = bflo(xw[i]), b = bfhi(xw[i]); ss += a * a + b * b; }
            const bf16x8 xb = __builtin_bit_cast(bf16x8, xw);
            acc = __builtin_amdgcn_mfma_f32_32x32x16_bf16(ah, xb, acc, 0, 0, 0);
            acc = __builtin_amdgcn_mfma_f32_32x32x16_bf16(al, xb, acc, 0, 0, 0);
        }
        ss += __shfl_xor(ss, 32);
        const float rstd = rsqrtf(ss * (1.f / DM) + EPS);
#pragma unroll
        for (int r = 0; r < 16; ++r) { const int e = crow(r, hi); lg[r32 * 33 + e] = acc[r] * rstd + router_b[e]; }
        LDS_WAIT(); asm volatile("" ::: "memory");
        if (F.lane < 32) {
            LAS float* row = lg + F.lane * 33; float tv[4]; int ti[4];
#pragma unroll
            for (int p = 0; p < 4; ++p) { float best = -__builtin_inff(); int bi = 0;
                for (int e = 0; e < NEXP; ++e) { const float v = row[e]; if (v > best) { best = v; bi = e; } }
                tv[p] = best; ti[p] = bi; row[bi] = -__builtin_inff(); LDS_WAIT(); asm volatile("" ::: "memory"); }
            const float w1 = __expf(tv[1] - tv[0]), w2 = __expf(tv[2] - tv[0]), w3 = __expf(tv[3] - tv[0]); const float inv = 1.f / (1.f + w1 + w2 + w3);
            const int t = t0 + F.lane;
            *(int4*)(e_tk + (size_t)t * 4) = make_int4(ti[0], ti[1], ti[2], ti[3]);
            *(float4*)(g_tk + (size_t)t * 4) = make_float4(inv, w1 * inv, w2 * inv, w3 * inv);
            rstd_t[t] = rstd;
#pragma unroll
            for (int p = 0; p < 4; ++p) __hip_atomic_fetch_add(&hist[ti[p]], 1u, __ATOMIC_RELAXED, __HIP_MEMORY_SCOPE_WORKGROUP);
        }
        __syncthreads();
        if (F.tid < 32) __hip_atomic_fetch_add(F.ctl + CW_COUNT + F.tid, hist[F.tid], RLX_AGENT);
        __syncthreads();
    }
}
__device__ __forceinline__ void p5_place(Frame& F) {
    const int* e_tk = (const int*)(F.ws + WS_ETK); const float* g_tk = (const float*)(F.ws + WS_GTK); const float* rstd_t = (const float*)(F.ws + WS_RSTDT);
    int* slot_tk = (int*)(F.ws + WS_SLOTTK); int* tok_slot = (int*)(F.ws + WS_TOKSLOT); float* gate_slot = (float*)(F.ws + WS_GATESLOT); float* rstd_slot = (float*)(F.ws + WS_RSTDSLOT);
    int* rb_e = (int*)(F.ws + WS_RBE);
    LAS int* L = (LAS int*)F.lds;
    if (F.tid < 32) { const int c = (int)__hip_atomic_load(F.ctl + CW_COUNT + F.tid, RLX_AGENT); L[F.tid] = c; L[32 + F.tid] = (c + 255) & ~255; }
    __syncthreads();
    if (F.tid < 32) { int s = 0; for (int e = 0; e < F.tid; ++e) s += L[32 + e]; L[64 + F.tid] = s; }
    __syncthreads();
    for (int blk = blockIdx.x; blk < T / 256; blk += F.G) {
        if (F.tid < 32) { L[96 + F.tid] = 0; L[128 + F.tid] = 0; }
        __syncthreads();
        int ee[2];
#pragma unroll
        for (int j = 0; j < 2; ++j) { const int i = F.tid + 512 * j; ee[j] = e_tk[(size_t)blk * 1024 + i]; __hip_atomic_fetch_add(&L[96 + ee[j]], 1, __ATOMIC_RELAXED, __HIP_MEMORY_SCOPE_WORKGROUP); }
        __syncthreads();
        if (F.tid < 32) L[160 + F.tid] = L[64 + F.tid] + (int)__hip_atomic_fetch_add(F.ctl + CW_CURSOR + F.tid, (unsigned)L[96 + F.tid], RLX_AGENT);
        __syncthreads();
#pragma unroll
        for (int j = 0; j < 2; ++j) { const int i = F.tid + 512 * j; const int r = __hip_atomic_fetch_add(&L[128 + ee[j]], 1, __ATOMIC_RELAXED, __HIP_MEMORY_SCOPE_WORKGROUP); const int pos = L[160 + ee[j]] + r;
            const int t = blk * 256 + (i >> 2);
            tok_slot[pos] = t; gate_slot[pos] = g_tk[(size_t)blk * 1024 + i]; rstd_slot[pos] = rstd_t[t]; slot_tk[(size_t)blk * 1024 + i] = pos; }
        __syncthreads();
    }
    for (int e = blockIdx.x; e < NEXP; e += F.G)
        for (int i = L[e] + F.tid; i < L[32 + e]; i += NWAVES * 64) { const int pos = L[64 + e] + i; tok_slot[pos] = 0; gate_slot[pos] = 0.f; rstd_slot[pos] = 0.f; }
    if (blockIdx.x == 0) {
        const int nrb = (L[64 + 31] + L[32 + 31]) >> 8;
        for (int rb = F.tid; rb < NRB_MAX; rb += NWAVES * 64) { int e = 31; for (int q = 0; q < 32; ++q) { if (rb * 256 >= L[64 + q] && rb * 256 < L[64 + q] + L[32 + q]) e = q; } rb_e[rb] = e; }
        if (F.tid == 0) rb_e[NRB_MAX] = nrb;
    }
}
__device__ __forceinline__ void p9_final(Frame& F) {
    const bf16_t* x1b = (const bf16_t*)(F.ws + WS_X1B); const int* slot_tk = (const int*)(F.ws + WS_SLOTTK);
    const bf16_t* Y = (const bf16_t*)(F.ws + WS_Y);
    const int gw = F.vcu * NWAVES + F.wave, NGW = F.G * NWAVES;
    const float* final_g = kargs()->in[I_FING];
    for (int t = gw; t < T; t += NGW) {
        const int4 sl = *(const int4*)(slot_tk + (size_t)t * 4);
        const int s4[4] = {sl.x, sl.y, sl.z, sl.w};
        float v[2][8]; float ss = 0.f;
#pragma unroll
        for (int j = 0; j < 2; ++j) { const int c = 8 * F.lane + 512 * j;
            const u32x4 a = *(const u32x4*)(x1b + (size_t)t * DM + c);
#pragma unroll
            for (int i = 0; i < 4; ++i) { v[j][2 * i] = bflo(a[i]); v[j][2 * i + 1] = bfhi(a[i]); }
#pragma unroll
            for (int k = 0; k < 4; ++k) { const int s = s4[k]; const bf16_t* yp = Y + (size_t)s * DM + c;
                const u32x4 y = *(const u32x4*)yp;
#pragma unroll
                for (int i = 0; i < 4; ++i) { v[j][2 * i] += bflo(y[i]); v[j][2 * i + 1] += bfhi(y[i]); } }
#pragma unroll
            for (int i = 0; i < 8; ++i) ss += v[j][i] * v[j][i]; }
        const float rstd = rsqrtf(wave_sum(ss) * (1.f / DM) + EPS);
#pragma unroll
        for (int j = 0; j < 2; ++j) { const int c = 8 * F.lane + 512 * j;
            const f32x4 g0 = *(const f32x4*)(final_g + c), g1 = *(const f32x4*)(final_g + c + 4);
            f32x4 o0, o1; o0.x = v[j][0] * rstd * g0.x; o0.y = v[j][1] * rstd * g0.y; o0.z = v[j][2] * rstd * g0.z; o0.w = v[j][3] * rstd * g0.w;
            o1.x = v[j][4] * rstd * g1.x; o1.y = v[j][5] * rstd * g1.y; o1.z = v[j][6] * rstd * g1.z; o1.w = v[j][7] * rstd * g1.w;
            *(f32x4*)(F.out + (size_t)t * DM + c) = o0; *(f32x4*)(F.out + (size_t)t * DM + c + 4) = o1; }
    }
}

__global__ void __launch_bounds__(NWAVES * 64, 2) hymba_fwd(Args args) {
    extern __shared__ __attribute__((aligned(16))) unsigned char lds[];
    Frame F;
    F.lds = (LAS unsigned char*)lds;
    F.MISC = (volatile LAS unsigned*)(F.lds + MISC_OFF);
    F.tid = threadIdx.x; F.lane = F.tid & 63; F.wave = __builtin_amdgcn_readfirstlane(F.tid >> 6);
    F.G = gridDim.x; { const int bx = blockIdx.x; F.vcu = (F.G % 8 == 0) ? (bx % 8) * (F.G / 8) + bx / 8 : bx; }
    F.ws = args.ws; F.ctl = (unsigned*)(args.ws + WS_CTL); F.out = args.out;
    for (int u = F.tid; u < (LDS_BYTES - LDSCTL_OFF) / 4; u += NWAVES * 64) ((LAS unsigned*)(F.lds + LDSCTL_OFF))[u] = 0u;
    __syncthreads();
    XcdBarrier bar; bar.bar = F.ctl + CW_BAR; bar.x = 0; bar.st = nullptr;
    if (N_LAUNCHES == 1) bar = xcd_barrier_post(F.ctl + CW_BAR, F.MISC + 8);
#define GRID_BAR() do { if (N_LAUNCHES == 1) xcd_barrier(bar); } while (0)
    const int lo = args.ph_lo, hi = args.ph_hi;
#ifndef PH_MASK
#define PH_MASK 0x1ff
#endif
#define IN(k) (((PH_MASK >> (k)) & 1) && lo <= (k) && (k) < hi)
#define BOTH(k) (IN(k) && IN((k) + 1))
    bf16_t* const H = (bf16_t*)(F.ws + WS_H); bf16_t* const PROJ = (bf16_t*)(F.ws + WS_PROJ); bf16_t* const MIX = (bf16_t*)(F.ws + WS_MIX); bf16_t* const X1B = (bf16_t*)(F.ws + WS_X1B);
    bf16_t* const Win_t = (bf16_t*)(F.ws + WS_WIN); bf16_t* const Wout_t = (bf16_t*)(F.ws + WS_WOUT);
    const unsigned char* const Wgu_q = (const unsigned char*)F.out + OUT_WGU; const unsigned char* const Wd_q = (const unsigned char*)F.out + OUT_WD;
    unsigned char* const X1Q = F.ws + WS_X1Q; unsigned char* const ACTQ = F.ws + WS_ACTQ; bf16_t* const Yp = (bf16_t*)(F.ws + WS_Y);
    const int* const tok_slot = (const int*)(F.ws + WS_TOKSLOT); const float* const gate_slot = (const float*)(F.ws + WS_GATESLOT); const float* const rstd_slot = (const float*)(F.ws + WS_RSTDSLOT);
    const int* const rb_e = (const int*)(F.ws + WS_RBE);

#define REP(k) for (int rep_ = 0; rep_ < (((PROBE_REP >> (k)) & 1) ? 2 : 1); ++rep_)
    if (IN(0)) { REP(0) p0_prologue(F); if (BOTH(0)) GRID_BAR(); }
    if (IN(1)) {
        REP(1) {
        pg8::Gemm g{H, Win_t, DM, 0, nullptr}; pg8::StaticOrder S; S.init(T, INW, F.G, (int)blockIdx.x);
        pg8::EpiProj E{PROJ};
        pg8::gemm_phase<pg8::EpiProj, pg8::StaticOrder, true>(F.lds, g, S, E); }
        if (BOTH(1)) GRID_BAR();
    }
    if (IN(2)) { p2_mixers(F); if (BOTH(2)) GRID_BAR(); }
    if (IN(3)) {
        pg8::Gemm g{MIX, Wout_t, DM, 0, nullptr}; pg8::StaticOrder S; S.init(T, DM, F.G, (int)blockIdx.x);
        pg8::EpiX1 E{kargs()->in[I_X], X1B, X1Q};
        pg8::gemm_phase<pg8::EpiX1, pg8::StaticOrder, true>(F.lds, g, S, E);
        if (BOTH(3)) GRID_BAR();
    }
    if (IN(4)) { p4_router(F); if (BOTH(4)) GRID_BAR(); }
    if (IN(5)) { p5_place(F); if (BOTH(5)) GRID_BAR(); }
    if (IN(6)) {
        const int nrb = rb_e[NRB_MAX];
        REP(6) {
        pg8::Gemm g{(const bf16_t*)X1Q, (const bf16_t*)Wgu_q, DM / 2, (long)2048 * DM / 2, tok_slot}; pg8::GroupOrder S{nrb, 0, 8, F.G, (int)blockIdx.x, rb_e};
        pg8::EpiGU E{ACTQ, kargs()->in[I_BGU], rstd_slot};
        pg8::gemm_phase<pg8::EpiGU, pg8::GroupOrder, true, true, 0x79797979, 0x7f7f7f7f>(F.lds, g, S, E); }
        if (BOTH(6)) GRID_BAR();
    }
    if (IN(7)) {
        const int nrb = rb_e[NRB_MAX];
        REP(7) {
        pg8::Gemm g{(const bf16_t*)ACTQ, (const bf16_t*)Wd_q, DEXP / 2, (long)DM * DEXP / 2, nullptr}; pg8::GroupOrder S{nrb, 0, 4, F.G, (int)blockIdx.x, rb_e};
        pg8::EpiDown E{Yp, kargs()->in[I_BDN], gate_slot};
        pg8::gemm_phase<pg8::EpiDown, pg8::GroupOrder, true, true, 0x79797979, 0x7d7d7d7d>(F.lds, g, S, E); }
        if (BOTH(7)) GRID_BAR();
    }
    if (IN(8)) { REP(8) p9_final(F); }
#undef IN
#undef BOTH
#undef GRID_BAR
}

extern "C" void kernel_launch(void* const* d_in, const int* in_sizes, int n_in, void* d_out, int out_size, void* d_ws, size_t ws_size, hipStream_t stream) {
    static int grid = 0;
    if (grid == 0) {
        if (n_in != 19 || out_size != T * DM || ws_size < WS_END) { fprintf(stderr, "kernel_launch: unexpected shapes (n_in %d out %d ws %zu)\n", n_in, out_size, ws_size); grid = -1; return; }
        int dev = 0, cus = 0;
        if (hipGetDevice(&dev) != hipSuccess || hipDeviceGetAttribute(&cus, hipDeviceAttributeMultiprocessorCount, dev) != hipSuccess) { grid = -1; return; }
        if (hipFuncSetAttribute((const void*)hymba_fwd, hipFuncAttributeMaxDynamicSharedMemorySize, LDS_BYTES) != hipSuccess) { fprintf(stderr, "kernel_launch: hipFuncSetAttribute failed\n"); grid = -1; return; }
        int per_cu = 0;
        if (hipOccupancyMaxActiveBlocksPerMultiprocessor(&per_cu, (const void*)hymba_fwd, NWAVES * 64, LDS_BYTES) != hipSuccess || per_cu < 1) fprintf(stderr, "kernel_launch: occupancy query reports %d\n", per_cu);
        (void)hipGetLastError();
        grid = cus;
    }
    if (grid < 0) return;
    if (hipMemsetAsync((char*)d_ws + WS_CTL, 0, CTL_ZERO_BYTES, stream) != hipSuccess) return;
    Args a{};
    for (int i = 0; i < 19; ++i) a.in[i] = (const float*)d_in[i];
    a.out = (float*)d_out; a.ws = (unsigned char*)d_ws;
    for (int li = 0; li < N_LAUNCHES; ++li) {
        a.ph_lo = (N_LAUNCHES == 1) ? 0 : li; a.ph_hi = (N_LAUNCHES == 1) ? N_PHASES : li + 1;
        hipLaunchKernelGGL(hymba_fwd, dim3(grid), dim3(NWAVES * 64), LDS_BYTES, stream, a);
    }
}
```

```cpp
#include <hip/hip_runtime.h>
#include <hip/hip_bf16.h>
#include <cstdio>
#include <cstdint>

#ifndef PROBE_REP
#define PROBE_REP 0
#endif
#ifndef PROBE_CLK
#define PROBE_CLK 0
#endif
#ifndef PROBE_KREP
#define PROBE_KREP 1
#endif
#ifndef PROBE_EPI
#define PROBE_EPI 0
#endif
#ifndef MK_N_LAUNCHES
#define MK_N_LAUNCHES 1
#endif

constexpr int BATCH = 8, SEQ = 8192, DM = 1024, T = BATCH * SEQ, INW = 2560, MEML = 256, NEXP = 32, TOPK = 4, DEXP = 1024;
constexpr int COL_U = 0, COL_GB = 256, COL_GC = 512, COL_Q = 768, COL_K = 1280, COL_V = 1792, COL_QM = 2304;
constexpr float EPS = 1e-5f;
constexpr float C2 = 0.125f * 1.4426950408889634f;
constexpr float LOG2E = 1.4426950408889634f;
constexpr int NRB_MAX = 1056;

#define GAS __attribute__((address_space(1)))
#define LAS __attribute__((address_space(3)))
typedef unsigned short bf16_t;
typedef short bf16x8 __attribute__((ext_vector_type(8)));
typedef short s16x4 __attribute__((ext_vector_type(4)));
typedef float f32x4 __attribute__((ext_vector_type(4)));
typedef float f32x16 __attribute__((ext_vector_type(16)));
typedef unsigned u32x4 __attribute__((ext_vector_type(4)));
typedef unsigned u32x2 __attribute__((ext_vector_type(2)));
typedef float f32x2_t __attribute__((ext_vector_type(2)));
typedef __bf16 bf16x2_t __attribute__((ext_vector_type(2)));
typedef GAS unsigned gu32;
#define RLX_AGENT __ATOMIC_RELAXED, __HIP_MEMORY_SCOPE_AGENT
#define LDS_WAIT() asm volatile("s_waitcnt lgkmcnt(0)" ::: "memory")
#define VM_WAIT() asm volatile("s_waitcnt vmcnt(0)" ::: "memory")
#define SBAR() __builtin_amdgcn_sched_barrier(0)

__device__ __forceinline__ unsigned pk2(float lo, float hi) { f32x2_t v = {lo, hi}; bf16x2_t b = __builtin_convertvector(v, bf16x2_t); return __builtin_bit_cast(unsigned, b); }
__device__ __forceinline__ float bflo(unsigned u) { return __uint_as_float(u << 16); }
__device__ __forceinline__ float bfhi(unsigned u) { return __uint_as_float(u & 0xffff0000u); }
__device__ __forceinline__ bf16x8 pack8(f32x4 a, f32x4 b) { u32x4 w = {pk2(a[0], a[1]), pk2(a[2], a[3]), pk2(b[0], b[1]), pk2(b[2], b[3])}; return __builtin_bit_cast(bf16x8, w); }
__device__ __forceinline__ int crow(int r, int hi) { return (r & 3) + 8 * (r >> 2) + 4 * hi; }
__device__ __forceinline__ float wave_sum(float v) {
#pragma unroll
    for (int o = 1; o < 64; o <<= 1) v += __shfl_xor(v, o);
    return v;
}

namespace pg8 {
constexpr int BM = 256, BK = 64, HALF = 128, HTB = HALF * BK * 2  , STAGE_BYTES = 8 * HTB, NXCD = 8, WGM = 8;
__host__ __device__ __forceinline__ int lds_byte(int r, int c) { const int st = (r >> 4) * 2 + (c >> 5), rr = r & 15, cc = c & 31, ob = rr * 64 + cc * 2; return st * 1024 + (ob ^ (((ob >> 9) & 1) << 5)); }
__host__ __device__ __forceinline__ void stage_rc(int b, int& R, int& C) { const int st = b / 1024, sb = b % 1024, swz = sb ^ (((sb >> 9) & 1) << 5); R = (st >> 1) * 16 + swz / 64; C = (st & 1) * 32 + (swz % 64) / 2; }
__host__ __device__ __forceinline__ int perm32(int rho) { const int n = rho >> 4, i = rho & 15; return 8 * (i >> 2) + 4 * n + (i & 3); }

struct Unit { int pm, pn, e; };
struct Gemm { const bf16_t* A; const bf16_t* Bt; int K; long bstride; const int* rowmap; };

struct StaticOrder {
    int nM, nN, nwg, G, c;
    __device__ void init(int M, int N, int G_, int c_) { nM = M / BM; nN = N / BM; nwg = nM * nN; G = G_; c = c_; }
    __device__ bool next(int i, Unit& u) const {
        const long L = (long)i * G + c; if (L >= nwg) return false;
        int wgid = (int)L; { const int q = nwg / NXCD, r = nwg % NXCD, xcd = wgid % NXCD, off = wgid / NXCD; wgid = (xcd < r ? xcd * (q + 1) : r * (q + 1) + (xcd - r) * q) + off; }
        const int nig = WGM * nN, gid = wgid / nig, fm = gid * WGM, gsz = (nM - fm) < WGM ? (nM - fm) : WGM;
        u.pm = fm + ((wgid % nig) % gsz); u.pn = (wgid % nig) / gsz; u.e = 0; return true;
    }
};
struct GroupOrder {
    int nrb, rb0, npn, G, c; const int* rb_e;
    __device__ bool next(int i, Unit& u) const {
        int rbl, pn;
        if ((G & 7) == 0 && ((G >> 3) % npn) == 0) { const int x = c & 7, j = c >> 3, rpx = (G >> 3) / npn; rbl = i * (G / npn) + x * rpx + j / npn; pn = j % npn; }
        else { const long L = (long)i * G + c; rbl = (int)(L / npn); pn = (int)(L % npn); }
        if (rbl >= nrb) return false;
        u.pm = rb0 + rbl; u.pn = pn; u.e = rb_e[u.pm]; return true;
    }
};

typedef int v4i_t __attribute__((ext_vector_type(4)));
typedef int v8i_t __attribute__((ext_vector_type(8)));
template <class Epi, class Sched, bool ALIGN_EPI, bool FP8 = false, int SCW = 0x7f7f7f7f, int SCA = 0x7f7f7f7f, int KREP = 1>
__device__ __forceinline__ void gemm_phase(LAS unsigned char* lds, const Gemm g, const Sched& S, const Epi& E) {
    const int tid = threadIdx.x, wid = __builtin_amdgcn_readfirstlane(tid >> 6), lane = tid & 63, wr = wid >> 2, wc = wid & 3, fr = lane & 15, fq = lane >> 4;
    const int K = g.K; int nt = K / BK; asm volatile("" : "+s"(nt));
    int Rr[2], Cc[2]; unsigned voffB[2];
#pragma unroll
    for (int i = 0; i < 2; ++i) { int R, C; stage_rc(tid * 16 + i * 8192, R, C); const int Rb = Epi::PERM ? ((R & ~31) + perm32(R & 31)) : R;
        Rr[i] = R; Cc[i] = C; voffB[i] = (unsigned)(Rb * K + C) * 2u; }
    const size_t kstep = (size_t)(BK * 2);
    const size_t hstep = (size_t)HALF * K * 2;
    const size_t tstep = 2 * hstep;
    const unsigned ldsw = (unsigned)wid * 1024u;
    const int aoff = lds_byte(wr * 64 + fr, fq * 8), boff = lds_byte(wc * 32 + fr, fq * 8);
#define PG8_SA(b, h) (((b) * 2 + (h)) * HTB)
#define PG8_SB(b, h) ((4 + (b) * 2 + (h)) * HTB)
#define PG8_STAGE(bufoff, gbase, voff) do { _Pragma("unroll") for (int _i = 0; _i < 2; ++_i) \
        __builtin_amdgcn_global_load_lds((const unsigned*)((const char*)(gbase) + (voff)[_i]), (LAS unsigned*)(lds + (bufoff) + ldsw + _i * 8192), 16, 0, 0); } while (0)
#define PG8_STAGE_A(bufoff, kptr, offs, h) do { _Pragma("unroll") for (int _i = 0; _i < 2; ++_i) \
        __builtin_amdgcn_global_load_lds((const unsigned*)((const char*)(kptr) + (offs)[h][_i]), (LAS unsigned*)(lds + (bufoff) + ldsw + _i * 8192), 16, 0, 0); } while (0)
#define PG8_AOFF(dst, u) do { _Pragma("unroll") for (int _h = 0; _h < 2; ++_h) _Pragma("unroll") for (int _i = 0; _i < 2; ++_i) { const int _row = (u).pm * BM + _h * HALF + Rr[_i]; \
        const int _src = g.rowmap ? g.rowmap[_row] : _row; dst[_h][_i] = (unsigned)(_src * K + Cc[_i]) * 2u; } } while (0)
#define PG8_LDA(dst, b, h) do { _Pragma("unroll") for (int m = 0; m < 4; ++m) _Pragma("unroll") for (int k = 0; k < 2; ++k) dst[m][k] = *(const LAS bf16x8*)(lds + PG8_SA(b, h) + aoff + m * 2048 + k * 1024); } while (0)
#define PG8_LDB(dst, b, h) do { _Pragma("unroll") for (int n = 0; n < 2; ++n) _Pragma("unroll") for (int k = 0; k < 2; ++k) dst[n][k] = *(const LAS bf16x8*)(lds + PG8_SB(b, h) + boff + n * 2048 + k * 1024); } while (0)
#define PG8_CAT(x, y) __builtin_shufflevector(__builtin_bit_cast(v4i_t, x), __builtin_bit_cast(v4i_t, y), 0, 1, 2, 3, 4, 5, 6, 7)
#define PG8_MMA(ai, bj, At, Bt) do { __builtin_amdgcn_s_setprio(1); _Pragma("unroll") for (int m = 0; m < 4; ++m) _Pragma("unroll") for (int n = 0; n < 2; ++n) { \
        if constexpr (FP8) { acc[ai][bj][m][n] = __builtin_amdgcn_mfma_scale_f32_16x16x128_f8f6f4(PG8_CAT(Bt[n][0], Bt[n][1]), PG8_CAT(At[m][0], At[m][1]), acc[ai][bj][m][n], 0, 0, 0, SCW, 0, SCA); } \
        else { _Pragma("unroll") for (int k = 0; k < 2; ++k) acc[ai][bj][m][n] = __builtin_amdgcn_mfma_f32_16x16x32_bf16(Bt[n][k], At[m][k], acc[ai][bj][m][n], 0, 0, 0); } } \
        __builtin_amdgcn_s_setprio(0); } while (0)
#define PG8_WAIT_V(n) asm volatile("s_waitcnt vmcnt(" #n ")" ::: "memory")
#define PG8_WAIT_L(n) asm volatile("s_waitcnt lgkmcnt(" #n ")" ::: "memory")
#define PG8_BAR __builtin_amdgcn_s_barrier()
#define PG8_SCHED __builtin_amdgcn_sched_barrier(0)
    Unit cur, nxt; int ui = 0;
    if (!S.next(0, cur)) return;
    f32x4 acc[2][2][4][2];
#pragma unroll
    for (int a = 0; a < 2; ++a)
#pragma unroll
        for (int b = 0; b < 2; ++b)
#pragma unroll
            for (int m = 0; m < 4; ++m)
#pragma unroll
                for (int n = 0; n < 2; ++n) acc[a][b][m][n] = (f32x4){0.f, 0.f, 0.f, 0.f};
    bf16x8 At[4][2], B0[2][2], B1[2][2];
    unsigned aoc[2][2], aon[2][2];
    PG8_AOFF(aoc, cur);
    const char* Ab = (const char*)g.A;
    const char* cB = (const char*)g.Bt + ((size_t)cur.e * (size_t)g.bstride) * 2 + (size_t)cur.pn * tstep;
    PG8_STAGE(PG8_SB(0, 0), cB, voffB); PG8_STAGE(PG8_SB(0, 1), cB + hstep, voffB); PG8_STAGE_A(PG8_SA(0, 0), Ab, aoc, 0); PG8_STAGE_A(PG8_SA(0, 1), Ab, aoc, 1);
    if (wr == 1) PG8_BAR;
    PG8_WAIT_V(2); PG8_BAR;
    PG8_STAGE(PG8_SB(1, 0), cB + kstep, voffB); PG8_STAGE_A(PG8_SA(1, 0), Ab + kstep, aoc, 0); PG8_STAGE(PG8_SB(1, 1), cB + hstep + kstep, voffB);
    PG8_WAIT_V(6); PG8_BAR;
    for (;;) {
        const bool has_next = S.next(ui + 1, nxt);
        if (has_next) { PG8_AOFF(aon, nxt); }
        else {
#pragma unroll
            for (int h = 0; h < 2; ++h)
#pragma unroll
                for (int i = 0; i < 2; ++i) aon[h][i] = aoc[h][i];
        }
        const char* nB = has_next ? (const char*)g.Bt + ((size_t)nxt.e * (size_t)g.bstride) * 2 + (size_t)nxt.pn * tstep : cB;
#pragma nounroll
        for (int t = 0; t < nt * KREP; t += 2) {
            const bool last = (t == nt * KREP - 2);
            const char* a1 = Ab + (size_t)((t + 1) & (nt - 1)) * kstep;
            const char* a2 = last ? Ab : Ab + (size_t)((t + 2) & (nt - 1)) * kstep; const char* b2 = last ? nB : cB + (size_t)((t + 2) & (nt - 1)) * kstep;
            const char* a3 = a2 + kstep; const char* b3 = b2 + kstep;
            PG8_LDB(B0, 0, 0); PG8_LDB(B1, 0, 1); PG8_SCHED; PG8_LDA(At, 0, 0); PG8_STAGE_A(PG8_SA(1, 1), a1, aoc, 1);
            if (last) {
#pragma unroll
                for (int h = 0; h < 2; ++h)
#pragma unroll
                    for (int i = 0; i < 2; ++i) aoc[h][i] = aon[h][i]; }
            PG8_WAIT_V(8); PG8_WAIT_L(0); PG8_BAR; PG8_MMA(0, 0, At, B0); PG8_MMA(0, 1, At, B1); PG8_BAR; PG8_SCHED;
            PG8_LDA(At, 0, 1); PG8_STAGE(PG8_SB(0, 0), b2, voffB); PG8_STAGE(PG8_SB(0, 1), b2 + hstep, voffB); PG8_STAGE_A(PG8_SA(0, 0), a2, aoc, 0);
            PG8_WAIT_V(8); PG8_WAIT_L(0); PG8_BAR; PG8_MMA(1, 0, At, B0); PG8_MMA(1, 1, At, B1); PG8_BAR; PG8_SCHED;
            PG8_LDB(B0, 1, 0); PG8_LDB(B1, 1, 1); PG8_SCHED; PG8_LDA(At, 1, 0); PG8_STAGE_A(PG8_SA(0, 1), a2, aoc, 1);
            PG8_WAIT_V(8); PG8_WAIT_L(0); PG8_BAR; PG8_MMA(0, 0, At, B0); PG8_MMA(0, 1, At, B1); PG8_BAR; PG8_SCHED;
            PG8_LDA(At, 1, 1); PG8_STAGE(PG8_SB(1, 0), b3, voffB); PG8_STAGE(PG8_SB(1, 1), b3 + hstep, voffB); PG8_STAGE_A(PG8_SA(1, 0), a3, aoc, 0);
            PG8_WAIT_V(8); PG8_WAIT_L(0); PG8_BAR; PG8_MMA(1, 0, At, B0); PG8_MMA(1, 1, At, B1); PG8_BAR; PG8_SCHED;
        }
        if constexpr (ALIGN_EPI) { if (wr == 0) PG8_BAR; }
        E(acc, cur, wr, wc, fr, fq);
        if constexpr (FP8 && PROBE_EPI != 0) { asm volatile("" ::: "memory"); E(acc, cur, wr, wc, fr, fq); }
        if (!has_next) break;
#pragma unroll
        for (int a = 0; a < 2; ++a)
#pragma unroll
            for (int b = 0; b < 2; ++b)
#pragma unroll
                for (int m = 0; m < 4; ++m)
#pragma unroll
                    for (int n = 0; n < 2; ++n) acc[a][b][m][n] = (f32x4){0.f, 0.f, 0.f, 0.f};
        cur = nxt; cB = nB; ++ui;
        if constexpr (ALIGN_EPI) { if (wr == 1) PG8_BAR; }
    }
    PG8_WAIT_V(0);
    if constexpr (!ALIGN_EPI) { if (wr == 0) PG8_BAR; }
    PG8_BAR;
#undef PG8_SA
#undef PG8_SB
#undef PG8_STAGE
#undef PG8_STAGE_A
#undef PG8_AOFF
#undef PG8_LDA
#undef PG8_LDB
#undef PG8_MMA
#undef PG8_CAT
#undef PG8_WAIT_V
#undef PG8_WAIT_L
#undef PG8_BAR
#undef PG8_SCHED
}

struct EpiProj {
    static constexpr bool PERM = true;
    bf16_t* O;
    __device__ __forceinline__ void operator()(const f32x4 (&acc)[2][2][4][2], const Unit& u, int wr, int wc, int fr, int fq) const {
        const int row0 = u.pm * BM + wr * 64 + fr, col0 = u.pn * BM + wc * 32 + 8 * fq;
        const float sc = (u.pn == 3 || u.pn == 4 || u.pn == 9) ? C2 : 1.f;
#pragma unroll
        for (int ai = 0; ai < 2; ++ai)
#pragma unroll
            for (int m = 0; m < 4; ++m) { bf16_t* rowp = O + (size_t)(row0 + ai * HALF + m * 16) * INW + col0;
#pragma unroll
                for (int bj = 0; bj < 2; ++bj) { const f32x4 v0 = acc[ai][bj][m][0] * sc, v1 = acc[ai][bj][m][1] * sc;
                    u32x4 w; w.x = pk2(v0[0], v0[1]); w.y = pk2(v0[2], v0[3]); w.z = pk2(v1[0], v1[1]); w.w = pk2(v1[2], v1[3]);
                    *(u32x4*)(rowp + bj * HALF) = w; } }
    }
};
__device__ __forceinline__ unsigned pk4_fp8(float a, float b, float c, float d) { int w = 0; w = __builtin_amdgcn_cvt_pk_fp8_f32(a, b, w, false); w = __builtin_amdgcn_cvt_pk_fp8_f32(c, d, w, true); return (unsigned)w; }
struct EpiX1 {
    static constexpr bool PERM = true;
    const float* X; bf16_t* O; unsigned char* Q8;
    __device__ __forceinline__ void operator()(const f32x4 (&acc)[2][2][4][2], const Unit& u, int wr, int wc, int fr, int fq) const {
        const int row0 = u.pm * BM + wr * 64 + fr, col0 = u.pn * BM + wc * 32 + 8 * fq;
#pragma unroll
        for (int ai = 0; ai < 2; ++ai)
#pragma unroll
            for (int m = 0; m < 4; ++m) { const size_t off = (size_t)(row0 + ai * HALF + m * 16) * DM + col0;
#pragma unroll
                for (int bj = 0; bj < 2; ++bj) { const f32x4 x0 = *(const f32x4*)(X + off + bj * HALF), x1 = *(const f32x4*)(X + off + bj * HALF + 4);
                    const f32x4 v0 = acc[ai][bj][m][0] + x0, v1 = acc[ai][bj][m][1] + x1;
                    u32x4 w; w.x = pk2(v0[0], v0[1]); w.y = pk2(v0[2], v0[3]); w.z = pk2(v1[0], v1[1]); w.w = pk2(v1[2], v1[3]);
                    *(u32x4*)(O + off + bj * HALF) = w;
                    u32x2 q; q.x = pk4_fp8(v0[0], v0[1], v0[2], v0[3]); q.y = pk4_fp8(v1[0], v1[1], v1[2], v1[3]);
                    *(u32x2*)(Q8 + off + bj * HALF) = q; } }
    }
};
struct EpiGU {
    static constexpr bool PERM = true;
    unsigned char* ACT; const float* bias; const float* rstd;
    __device__ __forceinline__ void operator()(const f32x4 (&acc)[2][2][4][2], const Unit& u, int wr, int wc, int fr, int fq) const {
        const int row0 = u.pm * BM + wr * 64 + fr, j0 = u.pn * HALF + wc * 32 + 8 * fq;
        const float* bp = bias + (size_t)u.e * 2048 + j0;
        const f32x4 bg0 = *(const f32x4*)(bp), bg1 = *(const f32x4*)(bp + 4), bu0 = *(const f32x4*)(bp + 1024), bu1 = *(const f32x4*)(bp + 1028);
#pragma unroll
        for (int ai = 0; ai < 2; ++ai)
#pragma unroll
            for (int m = 0; m < 4; ++m) { const int row = row0 + ai * HALF + m * 16; const float rs = rstd[row];
                f32x4 g0 = acc[ai][0][m][0] * rs + bg0, g1 = acc[ai][0][m][1] * rs + bg1, u0 = acc[ai][1][m][0] * rs + bu0, u1 = acc[ai][1][m][1] * rs + bu1;
                float o[8];
#pragma unroll
                for (int i = 0; i < 4; ++i) {
                    { const float gg = fminf(g0[i], 7.f), uu = __builtin_amdgcn_fmed3f(u0[i], -7.f, 7.f); const float s4 = gg * __builtin_amdgcn_rcpf(fmaf(__builtin_amdgcn_exp2f(-1.702f * LOG2E * gg), 0.25f, 0.25f)); o[i] = fmaf(uu, s4, s4); }
                    { const float gg = fminf(g1[i], 7.f), uu = __builtin_amdgcn_fmed3f(u1[i], -7.f, 7.f); const float s4 = gg * __builtin_amdgcn_rcpf(fmaf(__builtin_amdgcn_exp2f(-1.702f * LOG2E * gg), 0.25f, 0.25f)); o[4 + i] = fmaf(uu, s4, s4); }
                }
                u32x2 w; w.x = pk4_fp8(o[0], o[1], o[2], o[3]); w.y = pk4_fp8(o[4], o[5], o[6], o[7]);
                *(u32x2*)(ACT + (size_t)row * DEXP + j0) = w; }
    }
};
struct EpiDown {
    static constexpr bool PERM = true;
    bf16_t* Y; const float* bias; const float* gate;
    __device__ __forceinline__ void operator()(const f32x4 (&acc)[2][2][4][2], const Unit& u, int wr, int wc, int fr, int fq) const {
        const int row0 = u.pm * BM + wr * 64 + fr, col0 = u.pn * BM + wc * 32 + 8 * fq;
        const float* bp = bias + (size_t)u.e * DM + col0;
        f32x4 bv[2][2];
#pragma unroll
        for (int bj = 0; bj < 2; ++bj) { bv[bj][0] = *(const f32x4*)(bp + bj * HALF); bv[bj][1] = *(const f32x4*)(bp + bj * HALF + 4); }
#pragma unroll
        for (int ai = 0; ai < 2; ++ai)
#pragma unroll
            for (int m = 0; m < 4; ++m) { const int row = row0 + ai * HALF + m * 16; const float gs = gate[row];
#pragma unroll
                for (int bj = 0; bj < 2; ++bj) { const f32x4 v0 = (acc[ai][bj][m][0] + bv[bj][0]) * gs, v1 = (acc[ai][bj][m][1] + bv[bj][1]) * gs;
                    u32x4 w; w.x = pk2(v0[0], v0[1]); w.y = pk2(v0[2], v0[3]); w.z = pk2(v1[0], v1[1]); w.w = pk2(v1[2], v1[3]);
                    *(u32x4*)(Y + (size_t)row * DM + col0 + bj * HALF) = w; } }
    }
};
}

namespace dattn {
constexpr int NW = 8, QBLK = 32, KVBLK = 64, QB = 256, PITCH = INW;
constexpr int SHM_V = KVBLK * 128 * 2, SHM_K = KVBLK * 64 * 2;
constexpr int NVS = 4, NKS = 3;
constexpr int OFF_V = 0, OFF_K = NVS * SHM_V, OFF_WS = OFF_K + NKS * SHM_K, OFF_STASH = OFF_WS + NW * 64 * 4, OFF_TB = OFF_STASH + NW * 8192, LDS_BYTES = OFF_TB + 4 * 128 * 4;
constexpr float THR = 8.f;
__device__ __forceinline__ int v_st(int k, int c) { const int kk = k;     return ((kk >> 3) * 4 + (c >> 5)) * 512 + ((kk & 7) * 32 + (c & 31)) * 2; }
__device__ __forceinline__ int v_rd_base(int lane) { return ((lane & 3) << 3) | (((lane >> 2) & 3) << 6) | (((lane >> 4) & 1) << 5) | (((lane >> 5) & 1) << 8); }
constexpr int v_rd_off(int d0, int ks, int half) { return d0 * 512 + ks * 4096 + half * 2048; }

struct Ref { unsigned qoff, koff, voff; bf16_t* O; int P0, comp, h; };
typedef __amdgpu_buffer_rsrc_t rsrc_t;
__device__ __forceinline__ bf16x8 bld8(rsrc_t r, unsigned voff, unsigned soff) { return __builtin_bit_cast(bf16x8, __builtin_amdgcn_raw_buffer_load_b128(r, (int)voff, (int)soff, 0)); }
struct Seam { bf16x8 qr[4]; int ks, vs; };

__device__ __forceinline__ bf16x8 ld8(const bf16_t* p) { return *reinterpret_cast<const bf16x8*>(p); }

__device__ __forceinline__ void bias_mask(f32x16& p0, f32x16& p1, int sdq  , const LAS float* tb) {
    const float NEG = -__builtin_inff();
    int lane_ = (int)__builtin_amdgcn_mbcnt_hi(~0u, __builtin_amdgcn_mbcnt_lo(~0u, 0u));
    int dq = sdq + (lane_ & 31) - 4 * (lane_ >> 5);
    asm volatile("" : "+v"(dq));
#pragma unroll
    for (int r = 0; r < 16; ++r) {
        const int c = (r & 3) + 8 * (r >> 2);
        const int d0 = dq - c, d1 = dq - c - 32;
        const int i0 = d0 < 0 ? 0 : (d0 > 127 ? 127 : d0), i1 = d1 < 0 ? 0 : (d1 > 127 ? 127 : d1);
        const float b0 = tb[i0], b1 = tb[i1];
        p0[r] = d0 < 0 ? NEG : p0[r] + b0;
        p1[r] = d1 < 0 ? NEG : p1[r] + b1;
    }
}
__device__ __forceinline__ void partialSM(f32x16& p0, f32x16& p1, float& m_reg, float& alpha) {
    float pmax = p0[0];
#pragma unroll
    for (int r = 1; r < 16; ++r) pmax = fmaxf(pmax, p0[r]);
#pragma unroll
    for (int r = 0; r < 16; ++r) pmax = fmaxf(pmax, p1[r]);
    { auto rr = __builtin_amdgcn_permlane32_swap(__float_as_uint(pmax), __float_as_uint(pmax), false, false);
      pmax = fmaxf(__uint_as_float(rr[0]), __uint_as_float(rr[1])); }
    float mn;
    if (__builtin_expect(__all((pmax - m_reg) <= THR), 1)) { mn = m_reg; alpha = 1.f; }
    else { mn = fmaxf(m_reg, pmax); alpha = __builtin_amdgcn_exp2f(m_reg - mn); m_reg = mn; }
#pragma unroll
    for (int r = 0; r < 16; ++r) p0[r] = p0[r] - mn;
#pragma unroll
    for (int r = 0; r < 16; ++r) p1[r] = p1[r] - mn;
#pragma unroll
    for (int r = 0; r < 16; ++r) p0[r] = __builtin_amdgcn_exp2f(p0[r]);
}
__device__ __forceinline__ void finishSM(f32x16& p0, f32x16& p1, float alpha, float& l_reg, bf16x8& pa0, bf16x8& pa1, bf16x8& pa2, bf16x8& pa3) {
#pragma unroll
    for (int r = 0; r < 16; ++r) p1[r] = __builtin_amdgcn_exp2f(p1[r]);
    float ps = 0;
#pragma unroll
    for (int r = 0; r < 16; ++r) ps += p0[r];
#pragma unroll
    for (int r = 0; r < 16; ++r) ps += p1[r];
    { auto rr = __builtin_amdgcn_permlane32_swap(__float_as_uint(ps), __float_as_uint(ps), false, false);
      ps = __uint_as_float(rr[0]) + __uint_as_float(rr[1]); }
    l_reg = l_reg * alpha + ps;
#define PK4(P, B_, OUT) do { unsigned a0 = pk2(P[B_+0], P[B_+1]), a1 = pk2(P[B_+2], P[B_+3]);                          \
        unsigned b0 = pk2(P[B_+4], P[B_+5]), b1 = pk2(P[B_+6], P[B_+7]);                                             \
        auto r0 = __builtin_amdgcn_permlane32_swap(a0, b0, false, false); auto r1 = __builtin_amdgcn_permlane32_swap(a1, b1, false, false); \
        u32x4 w = {r0[0], r1[0], r0[1], r1[1]}; OUT = __builtin_bit_cast(bf16x8, w); } while (0)
    PK4(p0, 0, pa0); PK4(p0, 8, pa1); PK4(p1, 0, pa2); PK4(p1, 8, pa3);
#undef PK4
}
template <int KB>
__device__ __forceinline__ void qkt(f32x16& p0, f32x16& p1, const LAS unsigned char* K_lds, int r32, int hi, const bf16x8* qr) {
    p0 = f32x16{}; p1 = f32x16{};
    const int s = (r32 >> 1) & 7;
#pragma unroll
    for (int d0 = 0; d0 < 4; ++d0) {
        const LAS unsigned char* a = K_lds + KB * SHM_K + r32 * 128 + (((2 * d0 + hi) ^ s) << 4);
        const bf16x8 b0 = *(const LAS bf16x8*)(a);
        const bf16x8 b1 = *(const LAS bf16x8*)(a + 32 * 128);
        p0 = __builtin_amdgcn_mfma_f32_32x32x16_bf16(b0, qr[d0], p0, 0, 0, 0);
        p1 = __builtin_amdgcn_mfma_f32_32x32x16_bf16(b1, qr[d0], p1, 0, 0, 0); }
}
__device__ __forceinline__ void pv_tile(f32x16* o, int vb0, bf16x8 pa0, bf16x8 pa1, bf16x8 pa2, bf16x8 pa3) {
#define TRRD(dst, off) asm volatile("ds_read_b64_tr_b16 %0, %1 offset:%2" : "=&v"(dst) : "v"(vb0), "i"(off) : "memory")
#define PV_D0(d0) do { s16x4 l0, l1, l2, l3, h0, h1, h2, h3; constexpr int b_ = v_rd_off(d0, 0, 0); \
        TRRD(l0, b_); TRRD(h0, b_ + 2048); TRRD(l1, b_ + 4096); TRRD(h1, b_ + 6144); TRRD(l2, b_ + 8192); TRRD(h2, b_ + 10240); TRRD(l3, b_ + 12288); TRRD(h3, b_ + 14336); \
        asm volatile("s_waitcnt lgkmcnt(0)" ::: "memory"); SBAR();   \
        o[d0] = __builtin_amdgcn_mfma_f32_32x32x16_bf16(pa0, (bf16x8){l0[0], l0[1], l0[2], l0[3], h0[0], h0[1], h0[2], h0[3]}, o[d0], 0, 0, 0);   \
        o[d0] = __builtin_amdgcn_mfma_f32_32x32x16_bf16(pa1, (bf16x8){l1[0], l1[1], l1[2], l1[3], h1[0], h1[1], h1[2], h1[3]}, o[d0], 0, 0, 0);   \
        o[d0] = __builtin_amdgcn_mfma_f32_32x32x16_bf16(pa2, (bf16x8){l2[0], l2[1], l2[2], l2[3], h2[0], h2[1], h2[2], h2[3]}, o[d0], 0, 0, 0);   \
        o[d0] = __builtin_amdgcn_mfma_f32_32x32x16_bf16(pa3, (bf16x8){l3[0], l3[1], l3[2], l3[3], h3[0], h3[1], h3[2], h3[3]}, o[d0], 0, 0, 0); } while (0)
    PV_D0(0); PV_D0(1); PV_D0(2); PV_D0(3);
#undef PV_D0
#undef TRRD
}

#define DA_DMA16(gp, ldsp) __builtin_amdgcn_global_load_lds((const unsigned*)(gp), (LAS unsigned*)(ldsp), 16, 0, 0)
#define DA_STAGE(koff_, voff_, k0, ksoff, vsoff) do { const size_t tb_ = (size_t)(k0) * (PITCH * 2); \
        DA_DMA16(projb + (koff_) + tb_ + lk, K_lds + (ksoff) + wid * 1024); \
        DA_DMA16(projb + (voff_) + tb_ + lv, V_lds + (vsoff) + wid * 2048); \
        DA_DMA16(projb + (voff_) + tb_ + lv + 128, V_lds + (vsoff) + wid * 2048 + 1024); } while (0)
#define DA_LANE_OFFS() const int krow_ = 8 * wid + (lane >> 3); \
        const unsigned lk = (unsigned)(krow_ * PITCH) * 2u + (unsigned)(((lane & 7) ^ ((krow_ >> 1) & 7)) << 4); \
        const unsigned lv = (unsigned)((8 * wid + ((lane & 31) >> 2)) * PITCH) * 2u + (unsigned)(((lane >> 5) * 32 + (lane & 3) * 8) * 2)

__device__ __forceinline__ void prime(const Ref& cur, LAS unsigned char* lds, Seam& S, rsrc_t R, const char* projb) {
    const int tid = threadIdx.x, wid = __builtin_amdgcn_readfirstlane(tid >> 6), lane = tid & 63, r32 = lane & 31, hi = lane >> 5;
    DA_LANE_OFFS();
    const unsigned lq = (unsigned)((wid * QBLK + r32) * PITCH + hi * 8) * 2u;
    LAS unsigned char* K_lds = lds + OFF_K; LAS unsigned char* V_lds = lds + OFF_V;
#pragma unroll
    for (int d0 = 0; d0 < 4; ++d0) S.qr[d0] = bld8(R, lq + d0 * 32, cur.qoff);
    S.ks = 0; S.vs = 0;
    DA_STAGE(cur.koff, cur.voff, 0, 0, 0); DA_STAGE(cur.koff, cur.voff, KVBLK, SHM_K, SHM_V);
    __syncthreads();
}
__device__ __forceinline__ void block(const Ref& cur, const Ref& nxt, LAS unsigned char* lds, Seam& S, float lam, const float* gsub, rsrc_t R, const char* projb) {
    const int tid = threadIdx.x, wid = __builtin_amdgcn_readfirstlane(tid >> 6), lane = tid & 63, r32 = lane & 31, hi = lane >> 5;
    const int NT = (cur.P0 + QB) / KVBLK;
    const int qlo = cur.P0 + wid * QBLK;
    LAS unsigned char* V_lds = lds + OFF_V; LAS unsigned char* K_lds = lds + OFF_K;
    LAS float* ws = (LAS float*)(lds + OFF_WS) + wid * 64; LAS float* li_l = ws; LAS float* al_l = ws + 32;
    const LAS float* tbh = (const LAS float*)(lds + OFF_TB) + cur.h * 128;
    float mhat = 0.f, l_reg = 0.f; f32x16 o[4] = {}; f32x16 negm = f32x16{};
    bool resc = false;
    const int vb0 = (int)(unsigned)(uintptr_t)V_lds + v_rd_base(lane);
    DA_LANE_OFFS();
    const unsigned Kh = cur.koff, Vh = cur.voff;
#define KNEXT(x) (((x) == (NKS - 1) * SHM_K) ? 0 : (x) + SHM_K)
#define VNEXT(x) (((x) == (NVS - 1) * SHM_V) ? 0 : (x) + SHM_V)
    int k0 = S.ks, k1 = KNEXT(k0), k2 = KNEXT(k1);
    int v1 = S.vs, v2 = VNEXT(v1), v3 = VNEXT(v2), v0 = VNEXT(v3);
#define ROT() do { const int kn_ = k0; k0 = k1; k1 = k2; k2 = kn_; const int vn_ = v0; v0 = v1; v1 = v2; v2 = v3; v3 = vn_; } while (0)
#define STREAM(j) do { const bool in_ = (j) < NT; const unsigned ko_ = in_ ? Kh : nxt.koff, vo_ = in_ ? Vh : nxt.voff; const int tj_ = in_ ? (j) : (j) - NT; DA_STAGE(ko_, vo_, KBASE(tj_), k2, v3); } while (0)
#define STEP_BAR() asm volatile("s_waitcnt vmcnt(3) lgkmcnt(0)\n\ts_barrier" ::: "memory")
    const int ksw = (r32 >> 1) & 7;
    const LAS unsigned char* kbase = K_lds + r32 * 128;
#define KBASE(t) ((t) * KVBLK)
#define NEAR(P0_, P1_, t) do { const int kb_ = KBASE(t); if (kb_ >= qlo - 175) bias_mask(P0_, P1_, qlo - kb_, tbh); } while (0)
#define RESC() do { if (resc) { asm volatile("s_waitcnt lgkmcnt(0)" ::: "memory");              \
                     _Pragma("unroll") for (int d_ = 0; d_ < 4; ++d_) _Pragma("unroll") for (int r = 0; r < 16; ++r) o[d_][r] *= al_l[crow(r, hi)]; } } while (0)
#define PIN(x) asm volatile("" : "+v"(x))
#define EX(v) __builtin_amdgcn_exp2f(v)
#define MX3(a, b, c) __builtin_fmaxf(__builtin_fmaxf((a), (b)), (c))
#define DECIDE(C0, C1, FIRST) do { \
        float a_ = MX3(C0[0], C0[1], C1[0]), b_ = MX3(C0[2], C0[3], C1[1]); a_ = MX3(a_, C1[2], C1[3]); \
        _Pragma("unroll") for (int r = 4; r < 16; r += 4) { a_ = MX3(a_, C0[r], C0[r + 1]); b_ = MX3(b_, C0[r + 2], C0[r + 3]); a_ = MX3(a_, C1[r], C1[r + 1]); b_ = MX3(b_, C1[r + 2], C1[r + 3]); } \
        float rm_ = __builtin_fmaxf(a_, b_); { auto rr_ = __builtin_amdgcn_permlane32_swap(__float_as_uint(rm_), __float_as_uint(rm_), false, false); rm_ = __builtin_fmaxf(__uint_as_float(rr_[0]), __uint_as_float(rr_[1])); } \
        resc = false; \
        if ((FIRST) || __builtin_expect(__any(rm_ > THR), 0)) { const float dl_ = (FIRST) ? rm_ : __builtin_fmaxf(rm_, 0.f); mhat += dl_; \
            _Pragma("unroll") for (int r = 0; r < 16; ++r) { C0[r] -= dl_; C1[r] -= dl_; } \
            _Pragma("unroll") for (int r = 0; r < 16; ++r) negm[r] = -mhat; \
            asm volatile("" : "+v"(negm)); \
            if (!(FIRST)) { const float f_ = EX(-dl_); l_reg *= f_; if (hi == 0) al_l[r32] = f_; resc = true; } } } while (0)
#define KF(d0, hf) (*(const LAS bf16x8*)(kbase + k0 + (((2 * (d0) + hi) ^ ksw) << 4) + (hf) * 4096))
#define GAPA(MF, P, B, W) do { MF; sacc += P[B]; sacc += P[B + 1]; sacc += P[B + 2]; sacc += P[B + 3]; PIN(sacc); W[((B) >> 1) & 3] = pk2(P[B], P[B + 1]); W[(((B) >> 1) & 3) + 1] = pk2(P[B + 2], P[B + 3]); PIN(W); SBAR(); } while (0)
#define PHASE_A(C0, C1, P0, P1) do { \
        const bf16x8 k00 = KF(0, 0), k01 = KF(0, 1), k10 = KF(1, 0), k11 = KF(1, 1), k20 = KF(2, 0), k21 = KF(2, 1), k30 = KF(3, 0), k31 = KF(3, 1); \
        float sacc = 0.f; SBAR(); \
        GAPA(C0 = __builtin_amdgcn_mfma_f32_32x32x16_bf16(k00, S.qr[0], negm, 0, 0, 0), P0, 0, pw0); \
        GAPA(C1 = __builtin_amdgcn_mfma_f32_32x32x16_bf16(k01, S.qr[0], negm, 0, 0, 0), P0, 4, pw0); \
        GAPA(C0 = __builtin_amdgcn_mfma_f32_32x32x16_bf16(k10, S.qr[1], C0, 0, 0, 0), P0, 8, pw1); \
        GAPA(C1 = __builtin_amdgcn_mfma_f32_32x32x16_bf16(k11, S.qr[1], C1, 0, 0, 0), P0, 12, pw1); \
        GAPA(C0 = __builtin_amdgcn_mfma_f32_32x32x16_bf16(k20, S.qr[2], C0, 0, 0, 0), P1, 0, pw2); \
        GAPA(C1 = __builtin_amdgcn_mfma_f32_32x32x16_bf16(k21, S.qr[2], C1, 0, 0, 0), P1, 4, pw2); \
        GAPA(C0 = __builtin_amdgcn_mfma_f32_32x32x16_bf16(k30, S.qr[3], C0, 0, 0, 0), P1, 8, pw3); \
        GAPA(C1 = __builtin_amdgcn_mfma_f32_32x32x16_bf16(k31, S.qr[3], C1, 0, 0, 0), P1, 12, pw3); \
        l_reg += sacc; } while (0)
#define TRRD(dst, off) asm volatile("ds_read_b64_tr_b16 %0, %1 offset:%2" : "=&v"(dst) : "v"(vbr), "i"(off) : "memory")
#define VRD8(L0, H0, L1, H1, L2, H2, L3, H3, VBv, d0) do { constexpr int b_ = v_rd_off(d0, 0, 0); \
        TRRD(L0, b_); TRRD(H0, b_ + 2048); TRRD(L1, b_ + 4096); TRRD(H1, b_ + 6144); TRRD(L2, b_ + 8192); TRRD(H2, b_ + 10240); TRRD(L3, b_ + 12288); TRRD(H3, b_ + 14336); } while (0)
#define VF(L, H) (bf16x8){L[0], L[1], L[2], L[3], H[0], H[1], H[2], H[3]}
#define PAF(k) __builtin_bit_cast(bf16x8, pw##k)
#define GAPB(MF, X, B) do { MF; X[B] = EX(X[B]); X[(B) + 1] = EX(X[(B) + 1]); PIN(X); SBAR(); } while (0)
#define PV4(d0, L0, H0, L1, H1, L2, H2, L3, H3, X, B) do { \
        GAPB(o[d0] = __builtin_amdgcn_mfma_f32_32x32x16_bf16(PAF(0), VF(L0, H0), o[d0], 0, 0, 0), X, (B)); \
        GAPB(o[d0] = __builtin_amdgcn_mfma_f32_32x32x16_bf16(PAF(1), VF(L1, H1), o[d0], 0, 0, 0), X, (B) + 2); \
        GAPB(o[d0] = __builtin_amdgcn_mfma_f32_32x32x16_bf16(PAF(2), VF(L2, H2), o[d0], 0, 0, 0), X, (B) + 4); \
        GAPB(o[d0] = __builtin_amdgcn_mfma_f32_32x32x16_bf16(PAF(3), VF(L3, H3), o[d0], 0, 0, 0), X, (B) + 6); } while (0)
#define LWAIT(n) do { asm volatile("s_waitcnt lgkmcnt(" #n ")" ::: "memory"); SBAR(); } while (0)
#define PHASE_B(C0, C1, VBv) do { s16x4 a0, a1, a2, a3, a4, a5, a6, a7, b0, b1, b2, b3, b4, b5, b6, b7; const int vbr = vb0 + (VBv); \
        asm volatile("s_waitcnt lgkmcnt(0)" ::: "memory"); SBAR(); \
        VRD8(a0, a1, a2, a3, a4, a5, a6, a7, VBv, 0); VRD8(b0, b1, b2, b3, b4, b5, b6, b7, VBv, 1); LWAIT(8); \
        PV4(0, a0, a1, a2, a3, a4, a5, a6, a7, C0, 0); \
        VRD8(a0, a1, a2, a3, a4, a5, a6, a7, VBv, 2); LWAIT(8); \
        PV4(1, b0, b1, b2, b3, b4, b5, b6, b7, C0, 8); \
        VRD8(b0, b1, b2, b3, b4, b5, b6, b7, VBv, 3); LWAIT(8); \
        PV4(2, a0, a1, a2, a3, a4, a5, a6, a7, C1, 0); \
        LWAIT(0); \
        PV4(3, b0, b1, b2, b3, b4, b5, b6, b7, C1, 8); } while (0)
    f32x16 pA0, pA1, pB0, pB1; u32x4 pw0, pw1, pw2, pw3;
    STREAM(2);
    SBAR();
    {
      const bf16x8 k00 = KF(0, 0), k01 = KF(0, 1), k10 = KF(1, 0), k11 = KF(1, 1), k20 = KF(2, 0), k21 = KF(2, 1), k30 = KF(3, 0), k31 = KF(3, 1);
      pA0 = __builtin_amdgcn_mfma_f32_32x32x16_bf16(k00, S.qr[0], negm, 0, 0, 0); pA1 = __builtin_amdgcn_mfma_f32_32x32x16_bf16(k01, S.qr[0], negm, 0, 0, 0);
      pA0 = __builtin_amdgcn_mfma_f32_32x32x16_bf16(k10, S.qr[1], pA0, 0, 0, 0); pA1 = __builtin_amdgcn_mfma_f32_32x32x16_bf16(k11, S.qr[1], pA1, 0, 0, 0);
      pA0 = __builtin_amdgcn_mfma_f32_32x32x16_bf16(k20, S.qr[2], pA0, 0, 0, 0); pA1 = __builtin_amdgcn_mfma_f32_32x32x16_bf16(k21, S.qr[2], pA1, 0, 0, 0);
      pA0 = __builtin_amdgcn_mfma_f32_32x32x16_bf16(k30, S.qr[3], pA0, 0, 0, 0); pA1 = __builtin_amdgcn_mfma_f32_32x32x16_bf16(k31, S.qr[3], pA1, 0, 0, 0); }
    NEAR(pA0, pA1, 0); DECIDE(pA0, pA1, true);
#pragma unroll
    for (int r = 0; r < 16; ++r) { pA0[r] = EX(pA0[r]); pA1[r] = EX(pA1[r]); }
    STEP_BAR();
    ROT();
#define STEP(C0, C1, P0, P1, t) do { SBAR(); \
        STREAM((t) + 2); SBAR(); \
        PHASE_A(C0, C1, P0, P1); \
        NEAR(C0, C1, (t)); DECIDE(C0, C1, false); SBAR(); \
        PHASE_B(C0, C1, v0); \
        RESC(); STEP_BAR(); ROT(); } while (0)
    int t = 1;
    for (; t + 2 < NT; t += 2) {
        STEP(pB0, pB1, pA0, pA1, t);
        STEP(pA0, pA1, pB0, pB1, t + 1);
    }
    SBAR(); STREAM(NT + 1); SBAR();
    PHASE_A(pB0, pB1, pA0, pA1);
    { const unsigned lq = (unsigned)((wid * QBLK + r32) * PITCH + hi * 8) * 2u;
#pragma unroll
      for (int d0 = 0; d0 < 4; ++d0) S.qr[d0] = bld8(R, lq + d0 * 32, nxt.qoff); }
    SBAR();
    NEAR(pB0, pB1, NT - 1); DECIDE(pB0, pB1, false); SBAR();
    PHASE_B(pB0, pB1, v0);
    RESC();
    { float sacc = 0.f;
#pragma unroll
      for (int r = 0; r < 16; ++r) { sacc += pB0[r]; sacc += pB1[r]; }
      l_reg += sacc;
      pw0 = (u32x4){pk2(pB0[0], pB0[1]), pk2(pB0[2], pB0[3]), pk2(pB0[4], pB0[5]), pk2(pB0[6], pB0[7])}; pw1 = (u32x4){pk2(pB0[8], pB0[9]), pk2(pB0[10], pB0[11]), pk2(pB0[12], pB0[13]), pk2(pB0[14], pB0[15])};
      pw2 = (u32x4){pk2(pB1[0], pB1[1]), pk2(pB1[2], pB1[3]), pk2(pB1[4], pB1[5]), pk2(pB1[6], pB1[7])}; pw3 = (u32x4){pk2(pB1[8], pB1[9]), pk2(pB1[10], pB1[11]), pk2(pB1[12], pB1[13]), pk2(pB1[14], pB1[15])};
      SBAR(); pv_tile(o, vb0 + v1, PAF(0), PAF(1), PAF(2), PAF(3)); }
    ROT(); S.ks = k0; S.vs = v1;
    { auto rr = __builtin_amdgcn_permlane32_swap(__float_as_uint(l_reg), __float_as_uint(l_reg), false, false); l_reg = __uint_as_float(rr[0]) + __uint_as_float(rr[1]); }
    int lane_e = (int)__builtin_amdgcn_mbcnt_hi(~0u, __builtin_amdgcn_mbcnt_lo(~0u, 0u)); asm volatile("" : "+v"(lane_e));
    const int r32e = lane_e & 31, hie = lane_e >> 5;
    if (hi == 0) li_l[r32] = l_reg; asm volatile("s_waitcnt lgkmcnt(0)" ::: "memory");
    float rli[16];
#pragma unroll
    for (int r = 0; r < 16; ++r) rli[r] = __builtin_amdgcn_rcpf(li_l[crow(r, hi)]);
    LAS unsigned* st = (LAS unsigned*)(lds + OFF_STASH + wid * 8192) + lane_e;
    if (cur.comp == 0) {
#pragma unroll
        for (int r = 0; r < 16; ++r) { st[(2 * r) * 64] = pk2(o[0][r] * rli[r], o[1][r] * rli[r]); st[(2 * r + 1) * 64] = pk2(o[2][r] * rli[r], o[3][r] * rli[r]); }
    } else {
        float ss[16];
#pragma unroll
        for (int r = 0; r < 16; ++r) { const unsigned u0 = st[(2 * r) * 64], u1 = st[(2 * r + 1) * 64];
            const float s2 = lam * rli[r];
            o[0][r] = bflo(u0) - s2 * o[0][r]; o[1][r] = bfhi(u0) - s2 * o[1][r]; o[2][r] = bflo(u1) - s2 * o[2][r]; o[3][r] = bfhi(u1) - s2 * o[3][r];
            ss[r] = (o[0][r] * o[0][r] + o[1][r] * o[1][r]) + (o[2][r] * o[2][r] + o[3][r] * o[3][r]); }
#pragma unroll
        for (int r = 0; r < 16; ++r) {
#pragma unroll
            for (int x = 1; x < 32; x <<= 1) ss[r] += __shfl_xor(ss[r], x);
            ss[r] = rsqrtf(ss[r] * (1.f / 128.f) + EPS) * 0.8f; }
        float gg[4];
#pragma unroll
        for (int d0 = 0; d0 < 4; ++d0) gg[d0] = gsub[d0 * 32 + r32e];
        bf16_t* Ow = cur.O + (size_t)(wid * QBLK) * DM;
#pragma unroll
        for (int r = 0; r < 16; ++r) { const int orow = crow(r, hie);
#pragma unroll
            for (int d0 = 0; d0 < 4; ++d0) { const float v = o[d0][r] * ss[r] * gg[d0]; const float vn = __shfl_xor(v, 1);
                if ((r32e & 1) == 0) *(unsigned*)(Ow + (size_t)orow * DM + d0 * 32 + r32e) = pk2(v, vn); } }
    }
    __syncthreads();
#undef RESC
#undef KBASE
#undef NEAR
#undef PIN
#undef EX
#undef MX3
#undef DECIDE
#undef KF
#undef GAPA
#undef PHASE_A
#undef TRRD
#undef VRD8
#undef VF
#undef PAF
#undef GAPB
#undef PV4
#undef LWAIT
#undef PHASE_B
#undef STEP
#undef ROT
#undef KNEXT
#undef VNEXT
#undef STREAM
#undef STEP_BAR
}
#undef DA_DMA16
#undef DA_STAGE
#undef DA_LANE_OFFS
}

constexpr int NWAVES = 8;
constexpr int N_LAUNCHES = MK_N_LAUNCHES;
constexpr int N_PHASES = 9;
static_assert(N_LAUNCHES == 1 || N_LAUNCHES == N_PHASES, "MK_N_LAUNCHES is 1 or 9");

constexpr size_t MiB = 1u << 20;
constexpr size_t WS_CTL = 0, CTL_ZERO_BYTES = 1 * MiB;
constexpr size_t WS_ETK = 1 * MiB, WS_GTK = 2 * MiB, WS_RSTDT = 3 * MiB, WS_SLOTTK = 4 * MiB, WS_TOKSLOT = 5 * MiB, WS_GATESLOT = 7 * MiB, WS_RSTDSLOT = 9 * MiB, WS_RBE = 11 * MiB;
constexpr size_t WS_WRHI = 12 * MiB, WS_WRLO = 12 * MiB + 65536, WS_KMB = 13 * MiB, WS_VMT = 14 * MiB;
constexpr size_t WS_WIN = 16 * MiB, WS_WOUT = 21 * MiB, WS_X1B = 24 * MiB, WS_X1Q = 152 * MiB;
constexpr size_t WS_BIG = 216 * MiB;
constexpr size_t WS_H = WS_BIG, WS_PROJ = WS_BIG + 128 * MiB, WS_MIX = WS_BIG + 448 * MiB;
constexpr size_t WS_ACTQ = WS_BIG, WS_Y = WS_BIG + 264 * MiB;
constexpr size_t WS_END = WS_BIG + 792 * MiB;
static_assert(WS_END <= 1024 * MiB, "d_ws map");
constexpr size_t OUT_WGU = 0, OUT_WD = 64 * MiB;
constexpr int CW_BAR = 4096, CW_COUNT = 1024, CW_CURSOR = 2048;
constexpr int RING_BYTES = 159744, LDSCTL_OFF = RING_BYTES, MISC_OFF = LDSCTL_OFF + 320, LDS_BYTES = 163840;
static_assert(dattn::LDS_BYTES <= RING_BYTES, "attention scratch");

#define XB_TMO      128
#define XB_XCNT(j)  (256  + 64 * (j))
#define XB_XSUB(j)  (1280 + 64 * (j))
#define XB_XGEN(j)  (2304 + 64 * (j))
#define XB_TOP      3328
#define XB_TOPGEN   3392
#define XCD_BAR_WORDS 3456
#define XB_SPIN_CAP (1u << 18)
__device__ __forceinline__ unsigned xb_ld(unsigned* p)              { return __hip_atomic_load(p, __ATOMIC_RELAXED, __HIP_MEMORY_SCOPE_AGENT); }
__device__ __forceinline__ unsigned xb_add(unsigned* p, unsigned v) { return __hip_atomic_fetch_add(p, v, __ATOMIC_RELAXED, __HIP_MEMORY_SCOPE_AGENT); }
__device__ __forceinline__ unsigned xb_xcc_id() { return (unsigned)__builtin_amdgcn_s_getreg((3 << 11) | 20) & 0xFu; }
#define XB_SPIN(cond, bar) do { unsigned _sp = 0; while (cond) { __builtin_amdgcn_s_sleep(1); \
    if ((++_sp & 255u) == 0u) { if (xb_ld(&(bar)[XB_TMO])) break; if (_sp > XB_SPIN_CAP) { atomicAdd(&(bar)[XB_TMO], 1u); break; } } } } while (0)
struct XcdBarrier { unsigned* bar; unsigned x; volatile LAS unsigned* st; };
__device__ __forceinline__ XcdBarrier xcd_barrier_post(unsigned* bar, volatile LAS unsigned* st) {
    XcdBarrier b; b.bar = bar; b.x = xb_xcc_id(); b.st = st;
    if (threadIdx.x == 0) (void)xb_add(&bar[XB_XCNT(b.x)], 1u);
    return b;
}
__device__ __forceinline__ void xcd_barrier_complete(unsigned* bar, unsigned x, unsigned& nloc, unsigned& nx) {
    const unsigned G = gridDim.x * gridDim.y * gridDim.z;
    unsigned sum, cnt, mine, sp = 0u;
    for (;;) {
        sum = 0u; cnt = 0u; mine = 0u;
#pragma unroll
        for (unsigned j = 0; j < 16; ++j) { const unsigned c = xb_ld(&bar[XB_XCNT(j)]); sum += c; cnt += (c > 0u) ? 1u : 0u; mine = (j == x) ? c : mine; }
        if (sum == G) break;
        __builtin_amdgcn_s_sleep(1);
        if ((++sp & 255u) == 0u) { if (xb_ld(&bar[XB_TMO])) break; if (sp > XB_SPIN_CAP) { atomicAdd(&bar[XB_TMO], 1u); break; } }
    }
    nloc = mine > 0u ? mine : 1u; nx = cnt > 0u ? cnt : 1u;
}
__device__ __forceinline__ void xcd_barrier(const XcdBarrier& b) {
    asm volatile("s_waitcnt vmcnt(0)" ::: "memory");
    __syncthreads();
    if (threadIdx.x == 0) {
        unsigned* bar = b.bar;
        __builtin_amdgcn_s_waitcnt(0);
        unsigned nloc = b.st[0], nx = b.st[1];
        if (nloc == 0u) { xcd_barrier_complete(bar, b.x, nloc, nx); b.st[0] = nloc; b.st[1] = nx; }
        const unsigned old = xb_add(&bar[XB_XSUB(b.x)], 1u);
        const unsigned gen = old / nloc;
        if (old + 1u == (gen + 1u) * nloc) {
            __builtin_amdgcn_fence(__ATOMIC_RELEASE, "agent");
            asm volatile("s_waitcnt vmcnt(0)" ::: "memory");
            const unsigned og = xb_add(&bar[XB_TOP], 1u);
            const unsigned tg = og / nx;
            if (og + 1u == (tg + 1u) * nx) xb_add(&bar[XB_TOPGEN], 1u);
            else XB_SPIN(xb_ld(&bar[XB_TOPGEN]) == tg, bar);
            __builtin_amdgcn_fence(__ATOMIC_ACQUIRE, "agent");
            xb_add(&bar[XB_XGEN(b.x)], 1u);
            asm volatile("s_waitcnt vmcnt(0)" ::: "memory");
        } else {
            XB_SPIN(xb_ld(&bar[XB_XGEN(b.x)]) == gen, bar);
            __builtin_amdgcn_fence(__ATOMIC_ACQUIRE, "agent");
            asm volatile("s_waitcnt vmcnt(0)" ::: "memory");
        }
    }
    __syncthreads();
}

struct Frame {
    LAS unsigned char* lds;
    volatile LAS unsigned* MISC;
    unsigned* ctl;
    int tid, lane, wave, vcu, G;
    float* out;
    unsigned char* ws;
};
struct Args { const float* in[19]; float* out; unsigned char* ws; int ph_lo, ph_hi; };
typedef const __attribute__((address_space(4))) Args* KArgs;
__device__ __forceinline__ KArgs kargs() { KArgs p = (KArgs)__builtin_amdgcn_kernarg_segment_ptr(); asm volatile("" : "+s"(p)); return p; }
enum { I_X = 0, I_MEM, I_RELB, I_ATTNG, I_WIN, I_CONVW, I_LAMQK, I_SUBG, I_MEMG, I_WMEMKV, I_WOUT, I_FFNG, I_RW, I_RB, I_WGU, I_BGU, I_WDN, I_BDN, I_FING };

__device__ __forceinline__ void p0_transpose_item(const float* W, int K, int N, bf16_t* WT, int k0, int n0, int drow0, const float* kgain, LAS float* scr, int lane) {
#pragma unroll 16
    for (int i = 0; i < 32; ++i) { const int kk = 2 * i + (lane >> 5); float v = W[(size_t)(k0 + kk) * N + n0 + (lane & 31)]; if (kgain) v *= kgain[k0 + kk]; scr[kk * 33 + (lane & 31)] = v; }
    LDS_WAIT(); asm volatile("" ::: "memory");
    const int c = lane & 7;
#pragma unroll
    for (int j = 0; j < 4; ++j) { const int n = (lane >> 3) + 8 * j; const LAS float* s = scr + (8 * c) * 33 + n;
        u32x4 o; o.x = pk2(s[0 * 33], s[1 * 33]); o.y = pk2(s[2 * 33], s[3 * 33]); o.z = pk2(s[4 * 33], s[5 * 33]); o.w = pk2(s[6 * 33], s[7 * 33]);
        *(u32x4*)(WT + (size_t)(drow0 + n) * K + k0 + 8 * c) = o; }
    LDS_WAIT(); asm volatile("" ::: "memory");
}
__device__ __forceinline__ void rms_row2_to_bf16(const float* xa, const float* xb, const float* g, bf16_t* oa, bf16_t* ob, int lane) {
    const f32x4* ra = (const f32x4*)xa + lane; const f32x4* rb = (const f32x4*)xb + lane; const f32x4* gr = (const f32x4*)g + lane;
    f32x4 va[4], vb[4]; float sa = 0.f, sb = 0.f;
#pragma unroll
    for (int j = 0; j < 4; ++j) { va[j] = ra[64 * j]; vb[j] = rb[64 * j]; }
#pragma unroll
    for (int j = 0; j < 4; ++j) { sa += (va[j].x * va[j].x + va[j].y * va[j].y) + (va[j].z * va[j].z + va[j].w * va[j].w); sb += (vb[j].x * vb[j].x + vb[j].y * vb[j].y) + (vb[j].z * vb[j].z + vb[j].w * vb[j].w); }
    const float rsa = rsqrtf(wave_sum(sa) * (1.f / DM) + EPS), rsb = rsqrtf(wave_sum(sb) * (1.f / DM) + EPS);
    unsigned long long* pa = (unsigned long long*)oa + lane; unsigned long long* pb = (unsigned long long*)ob + lane;
#pragma unroll
    for (int j = 0; j < 4; ++j) { const f32x4 gg = gr[64 * j];
        pa[64 * j] = (unsigned long long)pk2(va[j].x * rsa * gg.x, va[j].y * rsa * gg.y) | ((unsigned long long)pk2(va[j].z * rsa * gg.z, va[j].w * rsa * gg.w) << 32);
        pb[64 * j] = (unsigned long long)pk2(vb[j].x * rsb * gg.x, vb[j].y * rsb * gg.y) | ((unsigned long long)pk2(vb[j].z * rsb * gg.z, vb[j].w * rsb * gg.w) << 32); }
}
__device__ __forceinline__ void p0_kvm_tile(Frame& F, int tile, const float* mem, const float* mem_g, const float* w_memkv) {
    const int mt = tile >> 3, ntile = tile & 7, row0 = 64 * mt, col0 = 64 * ntile;
    const int mb = F.wave >> 1, nb0 = (F.wave & 1) * 2, ar = F.lane & 15, kq = F.lane >> 4;
    const float* arow = mem + (size_t)(row0 + mb * 16 + ar) * DM;
    f32x4 acc[2]; acc[0] = (f32x4){0.f, 0.f, 0.f, 0.f}; acc[1] = acc[0];
    float ss = 0.f;
#pragma unroll 4
    for (int k0 = 0; k0 < DM; k0 += 32) {
        const int kk = k0 + 8 * kq;
        const f32x4 a0 = *(const f32x4*)(arow + kk), a1 = *(const f32x4*)(arow + kk + 4), g0 = *(const f32x4*)(mem_g + kk), g1 = *(const f32x4*)(mem_g + kk + 4);
        ss += (a0.x * a0.x + a0.y * a0.y) + (a0.z * a0.z + a0.w * a0.w) + (a1.x * a1.x + a1.y * a1.y) + (a1.z * a1.z + a1.w * a1.w);
        const bf16x8 af = pack8(a0 * g0, a1 * g1);
#pragma unroll
        for (int nbi = 0; nbi < 2; ++nbi) { const float* wp = w_memkv + (size_t)kk * 512 + col0 + (nb0 + nbi) * 16 + ar;
            f32x4 b0, b1; b0.x = wp[0]; b0.y = wp[512]; b0.z = wp[1024]; b0.w = wp[1536]; b1.x = wp[2048]; b1.y = wp[2560]; b1.z = wp[3072]; b1.w = wp[3584];
            acc[nbi] = __builtin_amdgcn_mfma_f32_16x16x32_bf16(af, pack8(b0, b1), acc[nbi], 0, 0, 0); }
    }
    ss += __shfl_xor(ss, 16); ss += __shfl_xor(ss, 32);
    const float rstd = rsqrtf(ss * (1.f / DM) + EPS);
    float rs[4];
#pragma unroll
    for (int j = 0; j < 4; ++j) rs[j] = __shfl(rstd, kq * 4 + j);
    bf16_t* kmb = (bf16_t*)(F.ws + WS_KMB); bf16_t* vmt = (bf16_t*)(F.ws + WS_VMT);
#pragma unroll
    for (int nbi = 0; nbi < 2; ++nbi) {
        const int gc = col0 + (nb0 + nbi) * 16 + ar, gr0 = row0 + mb * 16 + kq * 4;
        if (ntile < 4) {
#pragma unroll
            for (int j = 0; j < 4; ++j) kmb[(size_t)(gr0 + j) * 256 + gc] = (bf16_t)(pk2(acc[nbi][j] * rs[j], 0.f) & 0xffffu);
        } else {
            const int d = gc - 256, hm = d >> 6, dd = d & 63, b = gr0 >> 8, m = gr0 & 255;
            u32x2 w; w.x = pk2(acc[nbi][0] * rs[0], acc[nbi][1] * rs[1]); w.y = pk2(acc[nbi][2] * rs[2], acc[nbi][3] * rs[3]);
            *(u32x2*)(vmt + ((size_t)((b * 4 + hm) * 64 + dd)) * 256 + m) = w;
        }
    }
}
__device__ __forceinline__ void p0_transpose_item_fp8(const float* W, int K, int N, unsigned char* WT, int k0, int n0, int drow0, const float* kgain, float scale, LAS float* scr, int lane) {
#pragma unroll 16
    for (int i = 0; i < 32; ++i) { const int kk = 2 * i + (lane >> 5); float v = W[(size_t)(k0 + kk) * N + n0 + (lane & 31)] * scale; if (kgain) v *= kgain[k0 + kk]; scr[kk * 33 + (lane & 31)] = v; }
    LDS_WAIT(); asm volatile("" ::: "memory");
    const int c = lane & 7;
#pragma unroll
    for (int j = 0; j < 4; ++j) { const int n = (lane >> 3) + 8 * j; const LAS float* s = scr + (8 * c) * 33 + n;
        u32x2 o; o.x = pg8::pk4_fp8(s[0 * 33], s[1 * 33], s[2 * 33], s[3 * 33]); o.y = pg8::pk4_fp8(s[4 * 33], s[5 * 33], s[6 * 33], s[7 * 33]);
        *(u32x2*)(WT + (size_t)(drow0 + n) * K + k0 + 8 * c) = o; }
    LDS_WAIT(); asm volatile("" ::: "memory");
}
__device__ __forceinline__ void p0_prologue(Frame& F) {
    KArgs A = kargs();
    { const float* mem = A->in[I_MEM]; const float* mem_g = A->in[I_MEMG]; const float* w_memkv = A->in[I_WMEMKV];
      for (int tile = blockIdx.x; tile < 256; tile += F.G) p0_kvm_tile(F, tile, mem, mem_g, w_memkv); }
    const float* w_in = A->in[I_WIN]; const float* w_out = A->in[I_WOUT]; const float* w_gu = A->in[I_WGU]; const float* w_dn = A->in[I_WDN]; const float* ffn_g = A->in[I_FFNG];
    LAS float* scr = (LAS float*)(F.lds + F.wave * 16384);
    const int gw = F.vcu * NWAVES + F.wave, NGW = F.G * NWAVES;
    bf16_t* Win_t = (bf16_t*)(F.ws + WS_WIN); bf16_t* Wout_t = (bf16_t*)(F.ws + WS_WOUT);
    unsigned char* Wgu_q = (unsigned char*)F.out + OUT_WGU; unsigned char* Wd_q = (unsigned char*)F.out + OUT_WD;
    constexpr int I_IN = 16 * 80, I_OUT = 16 * 32, I_GU1 = 16 * 64, I_D1 = 16 * 32;
    constexpr int I_GU = NEXP * I_GU1, I_D = NEXP * I_D1, NITEMS = I_IN + I_OUT + I_GU + I_D;
    for (int it = gw; it < NITEMS; it += NGW) {
        int r = it;
        if (r < I_IN) { const int kb = r / 80, nb = r % 80; p0_transpose_item(w_in, DM, INW, Win_t, 64 * kb, 32 * nb, 32 * nb, nullptr, scr, F.lane); continue; } r -= I_IN;
        if (r < I_OUT) { const int kb = r / 32, nb = r % 32; p0_transpose_item(w_out, DM, DM, Wout_t, 64 * kb, 32 * nb, 32 * nb, nullptr, scr, F.lane); continue; } r -= I_OUT;
        if (r < I_GU) { const int e = r / I_GU1, q = r % I_GU1, kb = q / 64, nb = q % 64, n0 = 32 * nb;
            const int jj = n0 & 1023, drow0 = (jj >> 7) * 256 + (n0 >= 1024 ? 128 : 0) + (jj & 127);
            p0_transpose_item_fp8(w_gu + (size_t)e * DM * 2048, DM, 2048, Wgu_q + (size_t)e * 2048 * DM, 64 * kb, n0, drow0, ffn_g, 64.f, scr, F.lane); continue; } r -= I_GU;
        { const int e = r / I_D1, q = r % I_D1, kb = q / 32, nb = q % 32;
            p0_transpose_item_fp8(w_dn + (size_t)e * DEXP * DM, DEXP, DM, Wd_q + (size_t)e * DM * DEXP, 64 * kb, 32 * nb, 32 * nb, nullptr, 64.f, scr, F.lane); }
    }
    bf16_t* H = (bf16_t*)(F.ws + WS_H);
    { const float* x = A->in[I_X]; const float* attn_g = A->in[I_ATTNG];
      for (int m = gw; m < T; m += 2 * NGW) { const int m2 = (m + NGW < T) ? m + NGW : m;
          rms_row2_to_bf16(x + (size_t)m * DM, x + (size_t)m2 * DM, attn_g, H + (size_t)m * DM, H + (size_t)m2 * DM, F.lane); } }
    const float* router_w = A->in[I_RW];
    bf16_t* wrh = (bf16_t*)(F.ws + WS_WRHI); bf16_t* wrl = (bf16_t*)(F.ws + WS_WRLO);
    for (int i = (F.vcu * NWAVES + F.wave) * 64 + F.lane; i < NEXP * DM; i += NGW * 64) { const int e = i >> 10, k = i & 1023;
        const float v = ffn_g[k] * router_w[(size_t)k * NEXP + e]; const unsigned hb = pk2(v, 0.f) & 0xffffu; const float hf = __uint_as_float(hb << 16);
        wrh[i] = (bf16_t)hb; wrl[i] = (bf16_t)(pk2(v - hf, 0.f) & 0xffffu); }
}

__device__ __forceinline__ void p2_conv_block(Frame& F, int blk, int tid_, const float* conv_w) {
    const bf16_t* proj = (const bf16_t*)(F.ws + WS_PROJ); bf16_t* mix = (bf16_t*)(F.ws + WS_MIX);
    const int cg = tid_ & 31, tc = tid_ >> 5;
    const int c0 = cg * 8, t0 = blk * 256 + tc * 16, s0 = t0 & (SEQ - 1);
    float w0[8], w1[8], w2[8];
#pragma unroll
    for (int i = 0; i < 8; ++i) { w0[i] = conv_w[c0 + i]; w1[i] = conv_w[256 + c0 + i]; w2[i] = conv_w[512 + c0 + i]; }
    float p2[8], p1[8];
#pragma unroll
    for (int i = 0; i < 8; ++i) { p2[i] = 0.f; p1[i] = 0.f; }
    if (s0 >= 2) {
        const u32x4 ua = *(const u32x4*)(proj + (size_t)(t0 - 2) * INW + COL_U + c0), ca = *(const u32x4*)(proj + (size_t)(t0 - 2) * INW + COL_GC + c0);
        const u32x4 ub = *(const u32x4*)(proj + (size_t)(t0 - 1) * INW + COL_U + c0), cb = *(const u32x4*)(proj + (size_t)(t0 - 1) * INW + COL_GC + c0);
#pragma unroll
        for (int i = 0; i < 4; ++i) { p2[2 * i] = bflo(ua[i]) * bflo(ca[i]); p2[2 * i + 1] = bfhi(ua[i]) * bfhi(ca[i]); p1[2 * i] = bflo(ub[i]) * bflo(cb[i]); p1[2 * i + 1] = bfhi(ub[i]) * bfhi(cb[i]); }
    }
    for (int tt = 0; tt < 16; ++tt) {
        const size_t ro = (size_t)(t0 + tt) * INW;
        const u32x4 uu = *(const u32x4*)(proj + ro + COL_U + c0), cc = *(const u32x4*)(proj + ro + COL_GC + c0), bb = *(const u32x4*)(proj + ro + COL_GB + c0);
        float cur[8], y[8];
#pragma unroll
        for (int i = 0; i < 4; ++i) { cur[2 * i] = bflo(uu[i]) * bflo(cc[i]); cur[2 * i + 1] = bfhi(uu[i]) * bfhi(cc[i]); }
#pragma unroll
        for (int i = 0; i < 4; ++i) { y[2 * i] = bflo(bb[i]) * (w0[2 * i] * p2[2 * i] + w1[2 * i] * p1[2 * i] + w2[2 * i] * cur[2 * i]);
                                       y[2 * i + 1] = bfhi(bb[i]) * (w0[2 * i + 1] * p2[2 * i + 1] + w1[2 * i + 1] * p1[2 * i + 1] + w2[2 * i + 1] * cur[2 * i + 1]); }
        u32x4 o; o.x = pk2(y[0], y[1]); o.y = pk2(y[2], y[3]); o.z = pk2(y[4], y[5]); o.w = pk2(y[6], y[7]);
        *(u32x4*)(mix + (size_t)(t0 + tt) * DM + c0) = o;
#pragma unroll
        for (int i = 0; i < 8; ++i) { p2[i] = p1[i]; p1[i] = cur[i]; }
    }
}
__device__ __forceinline__ void p2_mem_block(Frame& F, int blk, int lane_) {
    const bf16_t* proj = (const bf16_t*)(F.ws + WS_PROJ); bf16_t* mix = (bf16_t*)(F.ws + WS_MIX);
    const bf16_t* kmb = (const bf16_t*)(F.ws + WS_KMB); const bf16_t* vmt = (const bf16_t*)(F.ws + WS_VMT);
    const int r32 = lane_ & 31, hi = lane_ >> 5, b = blk >> 5, tw = blk * 256 + F.wave * 32;
    for (int hm = 0; hm < 4; ++hm) {
        bf16x8 qr[4];
#pragma unroll
        for (int d0 = 0; d0 < 4; ++d0) qr[d0] = *(const bf16x8*)(proj + (size_t)(tw + r32) * INW + COL_QM + hm * 64 + d0 * 16 + hi * 8);
        float mx = -__builtin_inff();
#pragma unroll 1
        for (int kb = 0; kb < 8; ++kb) { f32x16 p = f32x16{};
#pragma unroll
            for (int d0 = 0; d0 < 4; ++d0) { const bf16x8 kf = *(const bf16x8*)(kmb + (size_t)(b * 256 + kb * 32 + r32) * 256 + hm * 64 + d0 * 16 + hi * 8);
                p = __builtin_amdgcn_mfma_f32_32x32x16_bf16(kf, qr[d0], p, 0, 0, 0); }
#pragma unroll
            for (int r = 0; r < 16; ++r) mx = fmaxf(mx, p[r]); }
        mx = fmaxf(mx, __shfl_xor(mx, 32));
        float sum = 0.f;
        f32x16 o[2]; o[0] = f32x16{}; o[1] = f32x16{};
#pragma unroll 1
        for (int kb = 0; kb < 8; ++kb) { f32x16 p = f32x16{};
#pragma unroll
            for (int d0 = 0; d0 < 4; ++d0) { const bf16x8 kf = *(const bf16x8*)(kmb + (size_t)(b * 256 + kb * 32 + r32) * 256 + hm * 64 + d0 * 16 + hi * 8);
                p = __builtin_amdgcn_mfma_f32_32x32x16_bf16(kf, qr[d0], p, 0, 0, 0); }
#pragma unroll
            for (int r = 0; r < 16; ++r) { p[r] = __builtin_amdgcn_exp2f(p[r] - mx); sum += p[r]; }
            bf16x8 pa0, pa1;
#define PK4(P, B_, OUT) do { unsigned a0 = pk2(P[B_+0], P[B_+1]), a1 = pk2(P[B_+2], P[B_+3]); unsigned b0 = pk2(P[B_+4], P[B_+5]), b1 = pk2(P[B_+6], P[B_+7]); \
        auto r0 = __builtin_amdgcn_permlane32_swap(a0, b0, false, false); auto r1 = __builtin_amdgcn_permlane32_swap(a1, b1, false, false); \
        u32x4 w = {r0[0], r1[0], r0[1], r1[1]}; OUT = __builtin_bit_cast(bf16x8, w); } while (0)
            PK4(p, 0, pa0); PK4(p, 8, pa1);
#undef PK4
#pragma unroll
            for (int d0 = 0; d0 < 2; ++d0) { const bf16_t* vp = vmt + ((size_t)((b * 4 + hm) * 64 + d0 * 32 + r32)) * 256 + kb * 32 + hi * 8;
                o[d0] = __builtin_amdgcn_mfma_f32_32x32x16_bf16(pa0, *(const bf16x8*)(vp), o[d0], 0, 0, 0);
                o[d0] = __builtin_amdgcn_mfma_f32_32x32x16_bf16(pa1, *(const bf16x8*)(vp + 16), o[d0], 0, 0, 0); }
        }
        sum += __shfl_xor(sum, 32);
        const float linv = __builtin_amdgcn_rcpf(sum);
#pragma unroll
        for (int r = 0; r < 16; ++r) { const int orow = crow(r, hi); const float li = __shfl(linv, orow);
#pragma unroll
            for (int d0 = 0; d0 < 2; ++d0) { const float v = o[d0][r] * li; const float vn = __shfl_xor(v, 1);
                if ((r32 & 1) == 0) *(unsigned*)(mix + (size_t)(tw + orow) * DM + 768 + hm * 64 + d0 * 32 + r32) = pk2(v, vn); } }
    }
}
__device__ __forceinline__ dattn::Ref da_ref(Frame& F, int n) {
    const int pid = F.vcu + (n >> 2) * F.G, sub = n & 3, blk = sub >> 1, comp = sub & 1, bh = pid >> 4, s = pid & 15, qb = blk ? 31 - s : s, b = bh >> 2, h = bh & 3;
    bf16_t* mix = (bf16_t*)(F.ws + WS_MIX);
    dattn::Ref r;
    r.qoff = (unsigned)(((size_t)(b * SEQ + qb * 256) * INW + COL_Q + h * 128 + comp * 64) * 2);
    r.koff = (unsigned)(((size_t)(b * SEQ) * INW + COL_K + h * 128 + comp * 64) * 2);
    r.voff = (unsigned)(((size_t)(b * SEQ) * INW + COL_V + h * 128) * 2);
    r.O = mix + (size_t)(b * SEQ + qb * 256) * DM + 256 + h * 128;
    r.P0 = qb * 256; r.comp = comp; r.h = h;
    return r;
}
__device__ __forceinline__ void p2_mixers(Frame& F) {
    KArgs A = kargs();
    const float* rel_bias = A->in[I_RELB]; const float* lam_qk = A->in[I_LAMQK]; const float* subln_g = A->in[I_SUBG];
    if (F.tid < 512) { const int h = F.tid >> 7, n = F.tid & 127; int bk;
        if (n < 16) bk = n; else { bk = 16; const int thr[15] = {19, 21, 24, 27, 31, 35, 40, 46, 52, 59, 67, 77, 87, 99, 113};
#pragma unroll
            for (int i = 0; i < 15; ++i) bk += (n >= thr[i]) ? 1 : 0; }
        ((LAS float*)(F.lds + dattn::OFF_TB))[h * 128 + n] = (rel_bias[bk * 4 + h] - rel_bias[31 * 4 + h]) * LOG2E; }
    float d1 = 0.f, d2 = 0.f;
    for (int i = 0; i < 64; ++i) { d1 += lam_qk[i] * lam_qk[64 + i]; d2 += lam_qk[128 + i] * lam_qk[192 + i]; }
    const float lam = __expf(d1) - __expf(d2) + 0.2f;
    __syncthreads();
    const int npairs = F.vcu < 512 ? (512 - F.vcu + F.G - 1) / F.G : 0, total1 = 4 * npairs, total = ((PROBE_REP >> 2) & 1) ? 2 * total1 : total1;
#if PROBE_CLK
    const unsigned long long pc0_ = __builtin_readcyclecounter(), pr0_ = __builtin_amdgcn_s_memrealtime();
#endif
    if (total > 0) {
        dattn::Seam S; dattn::Ref cur = da_ref(F, 0);
        const dattn::rsrc_t R = __builtin_amdgcn_make_buffer_rsrc((void*)(F.ws + WS_PROJ), 0, (int)((size_t)T * INW * 2), 0x00020000);
        const char* projb = (const char*)(F.ws + WS_PROJ);
        dattn::prime(cur, F.lds, S, R, projb);
        for (int n = 0; n < total; ++n) {
            const dattn::Ref nxt = (n + 1 < total) ? da_ref(F, (n + 1) % total1) : cur;
            dattn::block(cur, nxt, F.lds, S, lam, subln_g, R, projb);
            cur = nxt;
        }
    }
#if PROBE_CLK
    if (blockIdx.x == 0 && F.tid == 0) { const unsigned long long dc_ = __builtin_readcyclecounter() - pc0_, dr_ = __builtin_amdgcn_s_memrealtime() - pr0_;
        F.ctl[600] = (unsigned)dc_; F.ctl[601] = (unsigned)(dc_ >> 32); F.ctl[602] = (unsigned)dr_; }
#endif
    int lane2 = (int)__builtin_amdgcn_mbcnt_hi(~0u, __builtin_amdgcn_mbcnt_lo(~0u, 0u)); asm volatile("" : "+v"(lane2));
    const int tid2 = F.wave * 64 + lane2;
    const float* conv_w = kargs()->in[I_CONVW];
    for (int blk = blockIdx.x; blk < T / 256; blk += F.G) { p2_conv_block(F, blk, tid2, conv_w); p2_mem_block(F, blk, lane2); }
}

__device__ __forceinline__ void p4_router(Frame& F) {
    const float* router_b = kargs()->in[I_RB];
    const bf16_t* x1b = (const bf16_t*)(F.ws + WS_X1B); const bf16_t* wrh = (const bf16_t*)(F.ws + WS_WRHI); const bf16_t* wrl = (const bf16_t*)(F.ws + WS_WRLO);
    int* e_tk = (int*)(F.ws + WS_ETK); float* g_tk = (float*)(F.ws + WS_GTK); float* rstd_t = (float*)(F.ws + WS_RSTDT);
    LAS float* lg = (LAS float*)F.lds + F.wave * (32 * 33); LAS unsigned* hist = (LAS unsigned*)(F.lds + 8 * 32 * 33 * 4);
    const int r32 = F.lane & 31, hi = F.lane >> 5;
    for (int blk = blockIdx.x; blk < T / 256; blk += F.G) {
        if (F.tid < 32) hist[F.tid] = 0u;
        __syncthreads();
        const int t0 = blk * 256 + F.wave * 32;
        const bf16_t* xr = x1b + (size_t)(t0 + r32) * DM + hi * 8; const bf16_t* wh = wrh + (size_t)r32 * DM + hi * 8; const bf16_t* wl = wrl + (size_t)r32 * DM + hi * 8;
        f32x16 acc = f32x16{}; float ss = 0.f;
#pragma unroll 4
        for (int k0 = 0; k0 < DM; k0 += 16) {
            const u32x4 xw = *(const u32x4*)(xr + k0); const bf16x8 ah = *(const bf16x8*)(wh + k0), al = *(const bf16x8*)(wl + k0);
#pragma unroll
            for (int i = 0; i < 4; ++i) { const float a = bflo(xw[i]), b = bfhi(xw[i]); ss += a * a + b * b; }
            const bf16x8 xb = __builtin_bit_cast(bf16x8, xw);
            acc = __builtin_amdgcn_mfma_f32_32x32x16_bf16(ah, xb, acc, 0, 0, 0);
            acc = __builtin_amdgcn_mfma_f32_32x32x16_bf16(al, xb, acc, 0, 0, 0);
        }
        ss += __shfl_xor(ss, 32);
        const float rstd = rsqrtf(ss * (1.f / DM) + EPS);
#pragma unroll
        for (int r = 0; r < 16; ++r) { const int e = crow(r, hi); lg[r32 * 33 + e] = acc[r] * rstd + router_b[e]; }
        LDS_WAIT(); asm volatile("" ::: "memory");
        if (F.lane < 32) {
            LAS float* row = lg + F.lane * 33; float tv[4]; int ti[4];
#pragma unroll
            for (int p = 0; p < 4; ++p) { float best = -__builtin_inff(); int bi = 0;
                for (int e = 0; e < NEXP; ++e) { const float v = row[e]; if (v > best) { best = v; bi = e; } }
                tv[p] = best; ti[p] = bi; row[bi] = -__builtin_inff(); LDS_WAIT(); asm volatile("" ::: "memory"); }
            const float w1 = __expf(tv[1] - tv[0]), w2 = __expf(tv[2] - tv[0]), w3 = __expf(tv[3] - tv[0]); const float inv = 1.f / (1.f + w1 + w2 + w3);
            const int t = t0 + F.lane;
            *(int4*)(e_tk + (size_t)t * 4) = make_int4(ti[0], ti[1], ti[2], ti[3]);
            *(float4*)(g_tk + (size_t)t * 4) = make_float4(inv, w1 * inv, w2 * inv, w3 * inv);
            rstd_t[t] = rstd;
#pragma unroll
            for (int p = 0; p < 4; ++p) __hip_atomic_fetch_add(&hist[ti[p]], 1u, __ATOMIC_RELAXED, __HIP_MEMORY_SCOPE_WORKGROUP);
        }
        __syncthreads();
        if (F.tid < 32) __hip_atomic_fetch_add(F.ctl + CW_COUNT + F.tid, hist[F.tid], RLX_AGENT);
        __syncthreads();
    }
}
__device__ __forceinline__ void p5_place(Frame& F) {
    const int* e_tk = (const int*)(F.ws + WS_ETK); const float* g_tk = (const float*)(F.ws + WS_GTK); const float* rstd_t = (const float*)(F.ws + WS_RSTDT);
    int* slot_tk = (int*)(F.ws + WS_SLOTTK); int* tok_slot = (int*)(F.ws + WS_TOKSLOT); float* gate_slot = (float*)(F.ws + WS_GATESLOT); float* rstd_slot = (float*)(F.ws + WS_RSTDSLOT);
    int* rb_e = (int*)(F.ws + WS_RBE);
    LAS int* L = (LAS int*)F.lds;
    if (F.tid < 32) { const int c = (int)__hip_atomic_load(F.ctl + CW_COUNT + F.tid, RLX_AGENT); L[F.tid] = c; L[32 + F.tid] = (c + 255) & ~255; }
    __syncthreads();
    if (F.tid < 32) { int s = 0; for (int e = 0; e < F.tid; ++e) s += L[32 + e]; L[64 + F.tid] = s; }
    __syncthreads();
    for (int blk = blockIdx.x; blk < T / 256; blk += F.G) {
        if (F.tid < 32) { L[96 + F.tid] = 0; L[128 + F.tid] = 0; }
        __syncthreads();
        int ee[2];
#pragma unroll
        for (int j = 0; j < 2; ++j) { const int i = F.tid + 512 * j; ee[j] = e_tk[(size_t)blk * 1024 + i]; __hip_atomic_fetch_add(&L[96 + ee[j]], 1, __ATOMIC_RELAXED, __HIP_MEMORY_SCOPE_WORKGROUP); }
        __syncthreads();
        if (F.tid < 32) L[160 + F.tid] = L[64 + F.tid] + (int)__hip_atomic_fetch_add(F.ctl + CW_CURSOR + F.tid, (unsigned)L[96 + F.tid], RLX_AGENT);
        __syncthreads();
#pragma unroll
        for (int j = 0; j < 2; ++j) { const int i = F.tid + 512 * j; const int r = __hip_atomic_fetch_add(&L[128 + ee[j]], 1, __ATOMIC_RELAXED, __HIP_MEMORY_SCOPE_WORKGROUP); const int pos = L[160 + ee[j]] + r;
            const int t = blk * 256 + (i >> 2);
            tok_slot[pos] = t; gate_slot[pos] = g_tk[(size_t)blk * 1024 + i]; rstd_slot[pos] = rstd_t[t]; slot_tk[(size_t)blk * 1024 + i] = pos; }
        __syncthreads();
    }
    for (int e = blockIdx.x; e < NEXP; e += F.G)
        for (int i = L[e] + F.tid; i < L[32 + e]; i += NWAVES * 64) { const int pos = L[64 + e] + i; tok_slot[pos] = 0; gate_slot[pos] = 0.f; rstd_slot[pos] = 0.f; }
    if (blockIdx.x == 0) {
        const int nrb = (L[64 + 31] + L[32 + 31]) >> 8;
        for (int rb = F.tid; rb < NRB_MAX; rb += NWAVES * 64) { int e = 31; for (int q = 0; q < 32; ++q) { if (rb * 256 >= L[64 + q] && rb * 256 < L[64 + q] + L[32 + q]) e = q; } rb_e[rb] = e; }
        if (F.tid == 0) rb_e[NRB_MAX] = nrb;
    }
}
__device__ __forceinline__ void p9_final(Frame& F) {
    const bf16_t* x1b = (const bf16_t*)(F.ws + WS_X1B); const int* slot_tk = (const int*)(F.ws + WS_SLOTTK);
    const bf16_t* Y = (const bf16_t*)(F.ws + WS_Y);
    const int gw = F.vcu * NWAVES + F.wave, NGW = F.G * NWAVES;
    const float* final_g = kargs()->in[I_FING];
    for (int t = gw; t < T; t += NGW) {
        const int4 sl = *(const int4*)(slot_tk + (size_t)t * 4);
        const int s4[4] = {sl.x, sl.y, sl.z, sl.w};
        float v[2][8]; float ss = 0.f;
#pragma unroll
        for (int j = 0; j < 2; ++j) { const int c = 8 * F.lane + 512 * j;
            const u32x4 a = *(const u32x4*)(x1b + (size_t)t * DM + c);
#pragma unroll
            for (int i = 0; i < 4; ++i) { v[j][2 * i] = bflo(a[i]); v[j][2 * i + 1] = bfhi(a[i]); }
#pragma unroll
            for (int k = 0; k < 4; ++k) { const int s = s4[k]; const bf16_t* yp = Y + (size_t)s * DM + c;
                const u32x4 y = *(const u32x4*)yp;
#pragma unroll
                for (int i = 0; i < 4; ++i) { v[j][2 * i] += bflo(y[i]); v[j][2 * i + 1] += bfhi(y[i]); } }
#pragma unroll
            for (int i = 0; i < 8; ++i) ss += v[j][i] * v[j][i]; }
        const float rstd = rsqrtf(wave_sum(ss) * (1.f / DM) + EPS);
#pragma unroll
        for (int j = 0; j < 2; ++j) { const int c = 8 * F.lane + 512 * j;
            const f32x4 g0 = *(const f32x4*)(final_g + c), g1 = *(const f32x4*)(final_g + c + 4);
            f32x4 o0, o1; o0.x = v[j][0] * rstd * g0.x; o0.y = v[j][1] * rstd * g0.y; o0.z = v[j][2] * rstd * g0.z; o0.w = v[j][3] * rstd * g0.w;
            o1.x = v[j][4] * rstd * g1.x; o1.y = v[j][5] * rstd * g1.y; o1.z = v[j][6] * rstd * g1.z; o1.w = v[j][7] * rstd * g1.w;
            *(f32x4*)(F.out + (size_t)t * DM + c) = o0; *(f32x4*)(F.out + (size_t)t * DM + c + 4) = o1; }
    }
}

__global__ void __launch_bounds__(NWAVES * 64, 2) hymba_fwd(Args args) {
    extern __shared__ __attribute__((aligned(16))) unsigned char lds[];
    Frame F;
    F.lds = (LAS unsigned char*)lds;
    F.MISC = (volatile LAS unsigned*)(F.lds + MISC_OFF);
    F.tid = threadIdx.x; F.lane = F.tid & 63; F.wave = __builtin_amdgcn_readfirstlane(F.tid >> 6);
    F.G = gridDim.x; { const int bx = blockIdx.x; F.vcu = (F.G % 8 == 0) ? (bx % 8) * (F.G / 8) + bx / 8 : bx; }
    F.ws = args.ws; F.ctl = (unsigned*)(args.ws + WS_CTL); F.out = args.out;
    for (int u = F.tid; u < (LDS_BYTES - LDSCTL_OFF) / 4; u += NWAVES * 64) ((LAS unsigned*)(F.lds + LDSCTL_OFF))[u] = 0u;
    __syncthreads();
    XcdBarrier bar; bar.bar = F.ctl + CW_BAR; bar.x = 0; bar.st = nullptr;
    if (N_LAUNCHES == 1) bar = xcd_barrier_post(F.ctl + CW_BAR, F.MISC + 8);
#define GRID_BAR() do { if (N_LAUNCHES == 1) xcd_barrier(bar); } while (0)
    const int lo = args.ph_lo, hi = args.ph_hi;
#ifndef PH_MASK
#define PH_MASK 0x1ff
#endif
#define IN(k) (((PH_MASK >> (k)) & 1) && lo <= (k) && (k) < hi)
#define BOTH(k) (IN(k) && IN((k) + 1))
    bf16_t* const H = (bf16_t*)(F.ws + WS_H); bf16_t* const PROJ = (bf16_t*)(F.ws + WS_PROJ); bf16_t* const MIX = (bf16_t*)(F.ws + WS_MIX); bf16_t* const X1B = (bf16_t*)(F.ws + WS_X1B);
    bf16_t* const Win_t = (bf16_t*)(F.ws + WS_WIN); bf16_t* const Wout_t = (bf16_t*)(F.ws + WS_WOUT);
    const unsigned char* const Wgu_q = (const unsigned char*)F.out + OUT_WGU; const unsigned char* const Wd_q = (const unsigned char*)F.out + OUT_WD;
    unsigned char* const X1Q = F.ws + WS_X1Q; unsigned char* const ACTQ = F.ws + WS_ACTQ; bf16_t* const Yp = (bf16_t*)(F.ws + WS_Y);
    const int* const tok_slot = (const int*)(F.ws + WS_TOKSLOT); const float* const gate_slot = (const float*)(F.ws + WS_GATESLOT); const float* const rstd_slot = (const float*)(F.ws + WS_RSTDSLOT);
    const int* const rb_e = (const int*)(F.ws + WS_RBE);

#define REP(k) for (int rep_ = 0; rep_ < (((PROBE_REP >> (k)) & 1) ? 2 : 1); ++rep_)
    if (IN(0)) { REP(0) p0_prologue(F); if (BOTH(0)) GRID_BAR(); }
    if (IN(1)) {
        REP(1) {
        pg8::Gemm g{H, Win_t, DM, 0, nullptr}; pg8::StaticOrder S; S.init(T, INW, F.G, (int)blockIdx.x);
        pg8::EpiProj E{PROJ};
        pg8::gemm_phase<pg8::EpiProj, pg8::StaticOrder, true>(F.lds, g, S, E); }
        if (BOTH(1)) GRID_BAR();
    }
    if (IN(2)) { p2_mixers(F); if (BOTH(2)) GRID_BAR(); }
    if (IN(3)) {
        pg8::Gemm g{MIX, Wout_t, DM, 0, nullptr}; pg8::StaticOrder S; S.init(T, DM, F.G, (int)blockIdx.x);
        pg8::EpiX1 E{kargs()->in[I_X], X1B, X1Q};
        pg8::gemm_phase<pg8::EpiX1, pg8::StaticOrder, true>(F.lds, g, S, E);
        if (BOTH(3)) GRID_BAR();
    }
    if (IN(4)) { p4_router(F); if (BOTH(4)) GRID_BAR(); }
    if (IN(5)) { p5_place(F); if (BOTH(5)) GRID_BAR(); }
    if (IN(6)) {
        const int nrb = rb_e[NRB_MAX];
        REP(6) {
        pg8::Gemm g{(const bf16_t*)X1Q, (const bf16_t*)Wgu_q, DM / 2, (long)2048 * DM / 2, tok_slot}; pg8::GroupOrder S{nrb, 0, 8, F.G, (int)blockIdx.x, rb_e};
        pg8::EpiGU E{ACTQ, kargs()->in[I_BGU], rstd_slot};
        pg8::gemm_phase<pg8::EpiGU, pg8::GroupOrder, true, true, (PROBE_KREP == 2 ? 0x78787878 : 0x79797979), 0x7f7f7f7f, PROBE_KREP>(F.lds, g, S, E); }
        if (BOTH(6)) GRID_BAR();
    }
    if (IN(7)) {
        const int nrb = rb_e[NRB_MAX];
        REP(7) {
        pg8::Gemm g{(const bf16_t*)ACTQ, (const bf16_t*)Wd_q, DEXP / 2, (long)DM * DEXP / 2, nullptr}; pg8::GroupOrder S{nrb, 0, 4, F.G, (int)blockIdx.x, rb_e};
        pg8::EpiDown E{Yp, kargs()->in[I_BDN], gate_slot};
        pg8::gemm_phase<pg8::EpiDown, pg8::GroupOrder, true, true, 0x79797979, 0x7d7d7d7d>(F.lds, g, S, E); }
        if (BOTH(7)) GRID_BAR();
    }
    if (IN(8)) { REP(8) p9_final(F); }
#if PROBE_CLK
    if (IN(8) && blockIdx.x == 0 && F.tid == 0) { const unsigned long long dc_ = ((unsigned long long)F.ctl[601] << 32) | F.ctl[600]; const unsigned long long dr_ = F.ctl[602];
        const unsigned long long mhz_ = dr_ ? dc_ * 100ull / dr_ : 0ull; const unsigned long long t0_ = __builtin_amdgcn_s_memrealtime();
        while (__builtin_amdgcn_s_memrealtime() - t0_ < mhz_ * 100ull) __builtin_amdgcn_s_sleep(8); }
#endif
#undef IN
#undef BOTH
#undef GRID_BAR
}

extern "C" void kernel_launch(void* const* d_in, const int* in_sizes, int n_in, void* d_out, int out_size, void* d_ws, size_t ws_size, hipStream_t stream) {
    static int grid = 0;
    if (grid == 0) {
        if (n_in != 19 || out_size != T * DM || ws_size < WS_END) { fprintf(stderr, "kernel_launch: unexpected shapes (n_in %d out %d ws %zu)\n", n_in, out_size, ws_size); grid = -1; return; }
        int dev = 0, cus = 0;
        if (hipGetDevice(&dev) != hipSuccess || hipDeviceGetAttribute(&cus, hipDeviceAttributeMultiprocessorCount, dev) != hipSuccess) { grid = -1; return; }
        if (hipFuncSetAttribute((const void*)hymba_fwd, hipFuncAttributeMaxDynamicSharedMemorySize, LDS_BYTES) != hipSuccess) { fprintf(stderr, "kernel_launch: hipFuncSetAttribute failed\n"); grid = -1; return; }
        int per_cu = 0;
        if (hipOccupancyMaxActiveBlocksPerMultiprocessor(&per_cu, (const void*)hymba_fwd, NWAVES * 64, LDS_BYTES) != hipSuccess || per_cu < 1) fprintf(stderr, "kernel_launch: occupancy query reports %d\n", per_cu);
        (void)hipGetLastError();
        grid = cus;
    }
    if (grid < 0) return;
    if (hipMemsetAsync((char*)d_ws + WS_CTL, 0, CTL_ZERO_BYTES, stream) != hipSuccess) return;
    Args a{};
    for (int i = 0; i < 19; ++i) a.in[i] = (const float*)d_in[i];
    a.out = (float*)d_out; a.ws = (unsigned char*)d_ws;
    for (int li = 0; li < N_LAUNCHES; ++li) {
        a.ph_lo = (N_LAUNCHES == 1) ? 0 : li; a.ph_hi = (N_LAUNCHES == 1) ? N_PHASES : li + 1;
        hipLaunchKernelGGL(hymba_fwd, dim3(grid), dim3(NWAVES * 64), LDS_BYTES, stream, a);
    }
}
```

```cpp
#include <hip/hip_runtime.h>
#include <hip/hip_bf16.h>
#include <cstdio>
#include <cstdint>

#ifndef PROBE_REP
#define PROBE_REP 0
#endif
#ifndef PROBE_P0
#define PROBE_P0 0
#endif
#ifndef PROBE_SEG
#define PROBE_SEG 0
#endif
#ifndef PROBE_CLK
#define PROBE_CLK 0
#endif
#ifndef PROBE_KREP
#define PROBE_KREP 1
#endif
#ifndef PROBE_EPI
#define PROBE_EPI 0
#endif
#ifndef MK_N_LAUNCHES
#define MK_N_LAUNCHES 1
#endif

constexpr int BATCH = 8, SEQ = 8192, DM = 1024, T = BATCH * SEQ, INW = 2560, MEML = 256, NEXP = 32, TOPK = 4, DEXP = 1024;
constexpr int COL_U = 0, COL_GB = 256, COL_GC = 512, COL_Q = 768, COL_K = 1280, COL_V = 1792, COL_QM = 2304;
constexpr float EPS = 1e-5f;
constexpr float C2 = 0.125f * 1.4426950408889634f;
constexpr float LOG2E = 1.4426950408889634f;
constexpr int NRB_MAX = 1056;

#define GAS __attribute__((address_space(1)))
#define LAS __attribute__((address_space(3)))
typedef unsigned short bf16_t;
typedef short bf16x8 __attribute__((ext_vector_type(8)));
typedef short s16x4 __attribute__((ext_vector_type(4)));
typedef float f32x4 __attribute__((ext_vector_type(4)));
typedef float f32x16 __attribute__((ext_vector_type(16)));
typedef unsigned u32x4 __attribute__((ext_vector_type(4)));
typedef unsigned u32x2 __attribute__((ext_vector_type(2)));
typedef float f32x2_t __attribute__((ext_vector_type(2)));
typedef __bf16 bf16x2_t __attribute__((ext_vector_type(2)));
typedef GAS unsigned gu32;
#define RLX_AGENT __ATOMIC_RELAXED, __HIP_MEMORY_SCOPE_AGENT
#define LDS_WAIT() asm volatile("s_waitcnt lgkmcnt(0)" ::: "memory")
#define VM_WAIT() asm volatile("s_waitcnt vmcnt(0)" ::: "memory")
#define SBAR() __builtin_amdgcn_sched_barrier(0)

__device__ __forceinline__ unsigned pk2(float lo, float hi) { f32x2_t v = {lo, hi}; bf16x2_t b = __builtin_convertvector(v, bf16x2_t); return __builtin_bit_cast(unsigned, b); }
__device__ __forceinline__ float bflo(unsigned u) { return __uint_as_float(u << 16); }
__device__ __forceinline__ float bfhi(unsigned u) { return __uint_as_float(u & 0xffff0000u); }
__device__ __forceinline__ bf16x8 pack8(f32x4 a, f32x4 b) { u32x4 w = {pk2(a[0], a[1]), pk2(a[2], a[3]), pk2(b[0], b[1]), pk2(b[2], b[3])}; return __builtin_bit_cast(bf16x8, w); }
__device__ __forceinline__ int crow(int r, int hi) { return (r & 3) + 8 * (r >> 2) + 4 * hi; }
__device__ __forceinline__ float wave_sum(float v) {
#pragma unroll
    for (int o = 1; o < 64; o <<= 1) v += __shfl_xor(v, o);
    return v;
}

namespace pg8 {
constexpr int BM = 256, BK = 64, HALF = 128, HTB = HALF * BK * 2  , STAGE_BYTES = 8 * HTB, NXCD = 8, WGM = 8;
__host__ __device__ __forceinline__ int lds_byte(int r, int c) { const int st = (r >> 4) * 2 + (c >> 5), rr = r & 15, cc = c & 31, ob = rr * 64 + cc * 2; return st * 1024 + (ob ^ (((ob >> 9) & 1) << 5)); }
__host__ __device__ __forceinline__ void stage_rc(int b, int& R, int& C) { const int st = b / 1024, sb = b % 1024, swz = sb ^ (((sb >> 9) & 1) << 5); R = (st >> 1) * 16 + swz / 64; C = (st & 1) * 32 + (swz % 64) / 2; }
__host__ __device__ __forceinline__ int perm32(int rho) { const int n = rho >> 4, i = rho & 15; return 8 * (i >> 2) + 4 * n + (i & 3); }

struct Unit { int pm, pn, e; };
struct Gemm { const bf16_t* A; const bf16_t* Bt; int K; long bstride; const int* rowmap; };

struct StaticOrder {
    int nM, nN, nwg, G, c;
    __device__ void init(int M, int N, int G_, int c_) { nM = M / BM; nN = N / BM; nwg = nM * nN; G = G_; c = c_; }
    __device__ bool next(int i, Unit& u) const {
        const long L = (long)i * G + c; if (L >= nwg) return false;
        int wgid = (int)L; { const int q = nwg / NXCD, r = nwg % NXCD, xcd = wgid % NXCD, off = wgid / NXCD; wgid = (xcd < r ? xcd * (q + 1) : r * (q + 1) + (xcd - r) * q) + off; }
        const int nig = WGM * nN, gid = wgid / nig, fm = gid * WGM, gsz = (nM - fm) < WGM ? (nM - fm) : WGM;
        u.pm = fm + ((wgid % nig) % gsz); u.pn = (wgid % nig) / gsz; u.e = 0; return true;
    }
};
struct GroupOrder {
    int nrb, rb0, npn, G, c; const int* rb_e;
    __device__ bool next(int i, Unit& u) const {
        int rbl, pn;
        if ((G & 7) == 0 && ((G >> 3) % npn) == 0) { const int x = c & 7, j = c >> 3, rpx = (G >> 3) / npn; rbl = i * (G / npn) + x * rpx + j / npn; pn = j % npn; }
        else { const long L = (long)i * G + c; rbl = (int)(L / npn); pn = (int)(L % npn); }
        if (rbl >= nrb) return false;
        u.pm = rb0 + rbl; u.pn = pn; u.e = rb_e[u.pm]; return true;
    }
};

typedef int v4i_t __attribute__((ext_vector_type(4)));
typedef int v8i_t __attribute__((ext_vector_type(8)));
template <class Epi, class Sched, bool ALIGN_EPI, bool FP8 = false, int SCW = 0x7f7f7f7f, int SCA = 0x7f7f7f7f, int KREP = 1>
__device__ __forceinline__ void gemm_phase(LAS unsigned char* lds, const Gemm g, const Sched& S, const Epi& E) {
    const int tid = threadIdx.x, wid = __builtin_amdgcn_readfirstlane(tid >> 6), lane = tid & 63, wr = wid >> 2, wc = wid & 3, fr = lane & 15, fq = lane >> 4;
    const int K = g.K; int nt = K / BK; asm volatile("" : "+s"(nt));
    int Rr[2], Cc[2]; unsigned voffB[2];
#pragma unroll
    for (int i = 0; i < 2; ++i) { int R, C; stage_rc(tid * 16 + i * 8192, R, C); const int Rb = Epi::PERM ? ((R & ~31) + perm32(R & 31)) : R;
        Rr[i] = R; Cc[i] = C; voffB[i] = (unsigned)(Rb * K + C) * 2u; }
    const size_t kstep = (size_t)(BK * 2);
    const size_t hstep = (size_t)HALF * K * 2;
    const size_t tstep = 2 * hstep;
    const unsigned ldsw = (unsigned)wid * 1024u;
    const int aoff = lds_byte(wr * 64 + fr, fq * 8), boff = lds_byte(wc * 32 + fr, fq * 8);
#define PG8_SA(b, h) (((b) * 2 + (h)) * HTB)
#define PG8_SB(b, h) ((4 + (b) * 2 + (h)) * HTB)
#define PG8_STAGE(bufoff, gbase, voff) do { _Pragma("unroll") for (int _i = 0; _i < 2; ++_i) \
        __builtin_amdgcn_global_load_lds((const unsigned*)((const char*)(gbase) + (voff)[_i]), (LAS unsigned*)(lds + (bufoff) + ldsw + _i * 8192), 16, 0, 0); } while (0)
#define PG8_STAGE_A(bufoff, kptr, offs, h) do { _Pragma("unroll") for (int _i = 0; _i < 2; ++_i) \
        __builtin_amdgcn_global_load_lds((const unsigned*)((const char*)(kptr) + (offs)[h][_i]), (LAS unsigned*)(lds + (bufoff) + ldsw + _i * 8192), 16, 0, 0); } while (0)
#define PG8_AOFF(dst, u) do { _Pragma("unroll") for (int _h = 0; _h < 2; ++_h) _Pragma("unroll") for (int _i = 0; _i < 2; ++_i) { const int _row = (u).pm * BM + _h * HALF + Rr[_i]; \
        const int _src = g.rowmap ? g.rowmap[_row] : _row; dst[_h][_i] = (unsigned)(_src * K + Cc[_i]) * 2u; } } while (0)
#define PG8_LDA(dst, b, h) do { _Pragma("unroll") for (int m = 0; m < 4; ++m) _Pragma("unroll") for (int k = 0; k < 2; ++k) dst[m][k] = *(const LAS bf16x8*)(lds + PG8_SA(b, h) + aoff + m * 2048 + k * 1024); } while (0)
#define PG8_LDB(dst, b, h) do { _Pragma("unroll") for (int n = 0; n < 2; ++n) _Pragma("unroll") for (int k = 0; k < 2; ++k) dst[n][k] = *(const LAS bf16x8*)(lds + PG8_SB(b, h) + boff + n * 2048 + k * 1024); } while (0)
#define PG8_CAT(x, y) __builtin_shufflevector(__builtin_bit_cast(v4i_t, x), __builtin_bit_cast(v4i_t, y), 0, 1, 2, 3, 4, 5, 6, 7)
#define PG8_MMA(ai, bj, At, Bt) do { __builtin_amdgcn_s_setprio(1); _Pragma("unroll") for (int m = 0; m < 4; ++m) _Pragma("unroll") for (int n = 0; n < 2; ++n) { \
        if constexpr (FP8) { acc[ai][bj][m][n] = __builtin_amdgcn_mfma_scale_f32_16x16x128_f8f6f4(PG8_CAT(Bt[n][0], Bt[n][1]), PG8_CAT(At[m][0], At[m][1]), acc[ai][bj][m][n], 0, 0, 0, SCW, 0, SCA); } \
        else { _Pragma("unroll") for (int k = 0; k < 2; ++k) acc[ai][bj][m][n] = __builtin_amdgcn_mfma_f32_16x16x32_bf16(Bt[n][k], At[m][k], acc[ai][bj][m][n], 0, 0, 0); } } \
        __builtin_amdgcn_s_setprio(0); } while (0)
#define PG8_WAIT_V(n) asm volatile("s_waitcnt vmcnt(" #n ")" ::: "memory")
#define PG8_WAIT_L(n) asm volatile("s_waitcnt lgkmcnt(" #n ")" ::: "memory")
#define PG8_BAR __builtin_amdgcn_s_barrier()
#define PG8_SCHED __builtin_amdgcn_sched_barrier(0)
    Unit cur, nxt; int ui = 0;
    if (!S.next(0, cur)) return;
    f32x4 acc[2][2][4][2];
#pragma unroll
    for (int a = 0; a < 2; ++a)
#pragma unroll
        for (int b = 0; b < 2; ++b)
#pragma unroll
            for (int m = 0; m < 4; ++m)
#pragma unroll
                for (int n = 0; n < 2; ++n) acc[a][b][m][n] = (f32x4){0.f, 0.f, 0.f, 0.f};
    bf16x8 At[4][2], B0[2][2], B1[2][2];
    unsigned aoc[2][2], aon[2][2];
    PG8_AOFF(aoc, cur);
    const char* Ab = (const char*)g.A;
    const char* cB = (const char*)g.Bt + ((size_t)cur.e * (size_t)g.bstride) * 2 + (size_t)cur.pn * tstep;
    PG8_STAGE(PG8_SB(0, 0), cB, voffB); PG8_STAGE(PG8_SB(0, 1), cB + hstep, voffB); PG8_STAGE_A(PG8_SA(0, 0), Ab, aoc, 0); PG8_STAGE_A(PG8_SA(0, 1), Ab, aoc, 1);
    if (wr == 1) PG8_BAR;
    PG8_WAIT_V(2); PG8_BAR;
    PG8_STAGE(PG8_SB(1, 0), cB + kstep, voffB); PG8_STAGE_A(PG8_SA(1, 0), Ab + kstep, aoc, 0); PG8_STAGE(PG8_SB(1, 1), cB + hstep + kstep, voffB);
    PG8_WAIT_V(6); PG8_BAR;
    for (;;) {
        const bool has_next = S.next(ui + 1, nxt);
        if (has_next) { PG8_AOFF(aon, nxt); }
        else {
#pragma unroll
            for (int h = 0; h < 2; ++h)
#pragma unroll
                for (int i = 0; i < 2; ++i) aon[h][i] = aoc[h][i];
        }
        const char* nB = has_next ? (const char*)g.Bt + ((size_t)nxt.e * (size_t)g.bstride) * 2 + (size_t)nxt.pn * tstep : cB;
#pragma nounroll
        for (int t = 0; t < nt * KREP; t += 2) {
            const bool last = (t == nt * KREP - 2);
            const char* a1 = Ab + (size_t)((t + 1) & (nt - 1)) * kstep;
            const char* a2 = last ? Ab : Ab + (size_t)((t + 2) & (nt - 1)) * kstep; const char* b2 = last ? nB : cB + (size_t)((t + 2) & (nt - 1)) * kstep;
            const char* a3 = a2 + kstep; const char* b3 = b2 + kstep;
            PG8_LDB(B0, 0, 0); PG8_LDB(B1, 0, 1); PG8_SCHED; PG8_LDA(At, 0, 0); PG8_STAGE_A(PG8_SA(1, 1), a1, aoc, 1);
            if (last) {
#pragma unroll
                for (int h = 0; h < 2; ++h)
#pragma unroll
                    for (int i = 0; i < 2; ++i) aoc[h][i] = aon[h][i]; }
            PG8_WAIT_V(8); PG8_WAIT_L(0); PG8_BAR; PG8_MMA(0, 0, At, B0); PG8_MMA(0, 1, At, B1); PG8_BAR; PG8_SCHED;
            PG8_LDA(At, 0, 1); PG8_STAGE(PG8_SB(0, 0), b2, voffB); PG8_STAGE(PG8_SB(0, 1), b2 + hstep, voffB); PG8_STAGE_A(PG8_SA(0, 0), a2, aoc, 0);
            PG8_WAIT_V(8); PG8_WAIT_L(0); PG8_BAR; PG8_MMA(1, 0, At, B0); PG8_MMA(1, 1, At, B1); PG8_BAR; PG8_SCHED;
            PG8_LDB(B0, 1, 0); PG8_LDB(B1, 1, 1); PG8_SCHED; PG8_LDA(At, 1, 0); PG8_STAGE_A(PG8_SA(0, 1), a2, aoc, 1);
            PG8_WAIT_V(8); PG8_WAIT_L(0); PG8_BAR; PG8_MMA(0, 0, At, B0); PG8_MMA(0, 1, At, B1); PG8_BAR; PG8_SCHED;
            PG8_LDA(At, 1, 1); PG8_STAGE(PG8_SB(1, 0), b3, voffB); PG8_STAGE(PG8_SB(1, 1), b3 + hstep, voffB); PG8_STAGE_A(PG8_SA(1, 0), a3, aoc, 0);
            PG8_WAIT_V(8); PG8_WAIT_L(0); PG8_BAR; PG8_MMA(1, 0, At, B0); PG8_MMA(1, 1, At, B1); PG8_BAR; PG8_SCHED;
        }
        if constexpr (ALIGN_EPI) { if (wr == 0) PG8_BAR; }
        E(acc, cur, wr, wc, fr, fq);
        if constexpr (FP8 && PROBE_EPI != 0) { asm volatile("" ::: "memory"); E(acc, cur, wr, wc, fr, fq); }
        if (!has_next) break;
#pragma unroll
        for (int a = 0; a < 2; ++a)
#pragma unroll
            for (int b = 0; b < 2; ++b)
#pragma unroll
                for (int m = 0; m < 4; ++m)
#pragma unroll
                    for (int n = 0; n < 2; ++n) acc[a][b][m][n] = (f32x4){0.f, 0.f, 0.f, 0.f};
        cur = nxt; cB = nB; ++ui;
        if constexpr (ALIGN_EPI) { if (wr == 1) PG8_BAR; }
    }
    PG8_WAIT_V(0);
    if constexpr (!ALIGN_EPI) { if (wr == 0) PG8_BAR; }
    PG8_BAR;
#undef PG8_SA
#undef PG8_SB
#undef PG8_STAGE
#undef PG8_STAGE_A
#undef PG8_AOFF
#undef PG8_LDA
#undef PG8_LDB
#undef PG8_MMA
#undef PG8_CAT
#undef PG8_WAIT_V
#undef PG8_WAIT_L
#undef PG8_BAR
#undef PG8_SCHED
}

struct EpiProj {
    static constexpr bool PERM = true;
    bf16_t* O;
    __device__ __forceinline__ void operator()(const f32x4 (&acc)[2][2][4][2], const Unit& u, int wr, int wc, int fr, int fq) const {
        const int row0 = u.pm * BM + wr * 64 + fr, col0 = u.pn * BM + wc * 32 + 8 * fq;
        const float sc = (u.pn == 3 || u.pn == 4 || u.pn == 9) ? C2 : 1.f;
#pragma unroll
        for (int ai = 0; ai < 2; ++ai)
#pragma unroll
            for (int m = 0; m < 4; ++m) { bf16_t* rowp = O + (size_t)(row0 + ai * HALF + m * 16) * INW + col0;
#pragma unroll
                for (int bj = 0; bj < 2; ++bj) { const f32x4 v0 = acc[ai][bj][m][0] * sc, v1 = acc[ai][bj][m][1] * sc;
                    u32x4 w; w.x = pk2(v0[0], v0[1]); w.y = pk2(v0[2], v0[3]); w.z = pk2(v1[0], v1[1]); w.w = pk2(v1[2], v1[3]);
                    *(u32x4*)(rowp + bj * HALF) = w; } }
    }
};
__device__ __forceinline__ unsigned pk4_fp8(float a, float b, float c, float d) { int w = 0; w = __builtin_amdgcn_cvt_pk_fp8_f32(a, b, w, false); w = __builtin_amdgcn_cvt_pk_fp8_f32(c, d, w, true); return (unsigned)w; }
struct EpiX1 {
    static constexpr bool PERM = true;
    const float* X; bf16_t* O; unsigned char* Q8;
    __device__ __forceinline__ void operator()(const f32x4 (&acc)[2][2][4][2], const Unit& u, int wr, int wc, int fr, int fq) const {
        const int row0 = u.pm * BM + wr * 64 + fr, col0 = u.pn * BM + wc * 32 + 8 * fq;
#pragma unroll
        for (int ai = 0; ai < 2; ++ai)
#pragma unroll
            for (int m = 0; m < 4; ++m) { const size_t off = (size_t)(row0 + ai * HALF + m * 16) * DM + col0;
#pragma unroll
                for (int bj = 0; bj < 2; ++bj) { const f32x4 x0 = *(const f32x4*)(X + off + bj * HALF), x1 = *(const f32x4*)(X + off + bj * HALF + 4);
                    const f32x4 v0 = acc[ai][bj][m][0] + x0, v1 = acc[ai][bj][m][1] + x1;
                    u32x4 w; w.x = pk2(v0[0], v0[1]); w.y = pk2(v0[2], v0[3]); w.z = pk2(v1[0], v1[1]); w.w = pk2(v1[2], v1[3]);
                    *(u32x4*)(O + off + bj * HALF) = w;
                    u32x2 q; q.x = pk4_fp8(v0[0], v0[1], v0[2], v0[3]); q.y = pk4_fp8(v1[0], v1[1], v1[2], v1[3]);
                    *(u32x2*)(Q8 + off + bj * HALF) = q; } }
    }
};
struct EpiGU {
    static constexpr bool PERM = true;
    unsigned char* ACT; const float* bias; const float* rstd;
    __device__ __forceinline__ void operator()(const f32x4 (&acc)[2][2][4][2], const Unit& u, int wr, int wc, int fr, int fq) const {
        const int row0 = u.pm * BM + wr * 64 + fr, j0 = u.pn * HALF + wc * 32 + 8 * fq;
        const float* bp = bias + (size_t)u.e * 2048 + j0;
        const f32x4 bg0 = *(const f32x4*)(bp), bg1 = *(const f32x4*)(bp + 4), bu0 = *(const f32x4*)(bp + 1024), bu1 = *(const f32x4*)(bp + 1028);
#pragma unroll
        for (int ai = 0; ai < 2; ++ai)
#pragma unroll
            for (int m = 0; m < 4; ++m) { const int row = row0 + ai * HALF + m * 16; const float rs = rstd[row];
                f32x4 g0 = acc[ai][0][m][0] * rs + bg0, g1 = acc[ai][0][m][1] * rs + bg1, u0 = acc[ai][1][m][0] * rs + bu0, u1 = acc[ai][1][m][1] * rs + bu1;
                float o[8];
#pragma unroll
                for (int i = 0; i < 4; ++i) {
                    { const float gg = fminf(g0[i], 7.f), uu = __builtin_amdgcn_fmed3f(u0[i], -7.f, 7.f); const float s4 = gg * __builtin_amdgcn_rcpf(fmaf(__builtin_amdgcn_exp2f(-1.702f * LOG2E * gg), 0.25f, 0.25f)); o[i] = fmaf(uu, s4, s4); }
                    { const float gg = fminf(g1[i], 7.f), uu = __builtin_amdgcn_fmed3f(u1[i], -7.f, 7.f); const float s4 = gg * __builtin_amdgcn_rcpf(fmaf(__builtin_amdgcn_exp2f(-1.702f * LOG2E * gg), 0.25f, 0.25f)); o[4 + i] = fmaf(uu, s4, s4); }
                }
                u32x2 w; w.x = pk4_fp8(o[0], o[1], o[2], o[3]); w.y = pk4_fp8(o[4], o[5], o[6], o[7]);
                *(u32x2*)(ACT + (size_t)row * DEXP + j0) = w; }
    }
};
struct EpiDown {
    static constexpr bool PERM = true;
    bf16_t* Y; const float* bias; const float* gate;
    __device__ __forceinline__ void operator()(const f32x4 (&acc)[2][2][4][2], const Unit& u, int wr, int wc, int fr, int fq) const {
        const int row0 = u.pm * BM + wr * 64 + fr, col0 = u.pn * BM + wc * 32 + 8 * fq;
        const float* bp = bias + (size_t)u.e * DM + col0;
        f32x4 bv[2][2];
#pragma unroll
        for (int bj = 0; bj < 2; ++bj) { bv[bj][0] = *(const f32x4*)(bp + bj * HALF); bv[bj][1] = *(const f32x4*)(bp + bj * HALF + 4); }
#pragma unroll
        for (int ai = 0; ai < 2; ++ai)
#pragma unroll
            for (int m = 0; m < 4; ++m) { const int row = row0 + ai * HALF + m * 16; const float gs = gate[row];
#pragma unroll
                for (int bj = 0; bj < 2; ++bj) { const f32x4 v0 = (acc[ai][bj][m][0] + bv[bj][0]) * gs, v1 = (acc[ai][bj][m][1] + bv[bj][1]) * gs;
                    u32x4 w; w.x = pk2(v0[0], v0[1]); w.y = pk2(v0[2], v0[3]); w.z = pk2(v1[0], v1[1]); w.w = pk2(v1[2], v1[3]);
                    *(u32x4*)(Y + (size_t)row * DM + col0 + bj * HALF) = w; } }
    }
};
}

namespace dattn {
constexpr int NW = 8, QBLK = 32, KVBLK = 64, QB = 256, PITCH = INW;
constexpr int SHM_V = KVBLK * 128 * 2, SHM_K = KVBLK * 64 * 2;
constexpr int NVS = 4, NKS = 3;
constexpr int OFF_V = 0, OFF_K = NVS * SHM_V, OFF_WS = OFF_K + NKS * SHM_K, OFF_STASH = OFF_WS + NW * 64 * 4, OFF_TB = OFF_STASH + NW * 8192, LDS_BYTES = OFF_TB + 4 * 128 * 4;
constexpr float THR = 8.f;
__device__ __forceinline__ int v_st(int k, int c) { const int kk = k;     return ((kk >> 3) * 4 + (c >> 5)) * 512 + ((kk & 7) * 32 + (c & 31)) * 2; }
__device__ __forceinline__ int v_rd_base(int lane) { return ((lane & 3) << 3) | (((lane >> 2) & 3) << 6) | (((lane >> 4) & 1) << 5) | (((lane >> 5) & 1) << 8); }
constexpr int v_rd_off(int d0, int ks, int half) { return d0 * 512 + ks * 4096 + half * 2048; }

struct Ref { unsigned qoff, koff, voff; bf16_t* O; int P0, comp, h; };
typedef __amdgpu_buffer_rsrc_t rsrc_t;
__device__ __forceinline__ bf16x8 bld8(rsrc_t r, unsigned voff, unsigned soff) { return __builtin_bit_cast(bf16x8, __builtin_amdgcn_raw_buffer_load_b128(r, (int)voff, (int)soff, 0)); }
struct Seam { bf16x8 qr[4]; int ks, vs;
#if PROBE_SEG
    unsigned long long acc, tot;
#endif
};

__device__ __forceinline__ bf16x8 ld8(const bf16_t* p) { return *reinterpret_cast<const bf16x8*>(p); }

__device__ __forceinline__ void bias_mask(f32x16& p0, f32x16& p1, int sdq  , const LAS float* tb) {
    const float NEG = -__builtin_inff();
    int lane_ = (int)__builtin_amdgcn_mbcnt_hi(~0u, __builtin_amdgcn_mbcnt_lo(~0u, 0u));
    int dq = sdq + (lane_ & 31) - 4 * (lane_ >> 5);
    asm volatile("" : "+v"(dq));
#pragma unroll
    for (int r = 0; r < 16; ++r) {
        const int c = (r & 3) + 8 * (r >> 2);
        const int d0 = dq - c, d1 = dq - c - 32;
        const int i0 = d0 < 0 ? 0 : (d0 > 127 ? 127 : d0), i1 = d1 < 0 ? 0 : (d1 > 127 ? 127 : d1);
        const float b0 = tb[i0], b1 = tb[i1];
        p0[r] = d0 < 0 ? NEG : p0[r] + b0;
        p1[r] = d1 < 0 ? NEG : p1[r] + b1;
    }
}
__device__ __forceinline__ void partialSM(f32x16& p0, f32x16& p1, float& m_reg, float& alpha) {
    float pmax = p0[0];
#pragma unroll
    for (int r = 1; r < 16; ++r) pmax = fmaxf(pmax, p0[r]);
#pragma unroll
    for (int r = 0; r < 16; ++r) pmax = fmaxf(pmax, p1[r]);
    { auto rr = __builtin_amdgcn_permlane32_swap(__float_as_uint(pmax), __float_as_uint(pmax), false, false);
      pmax = fmaxf(__uint_as_float(rr[0]), __uint_as_float(rr[1])); }
    float mn;
    if (__builtin_expect(__all((pmax - m_reg) <= THR), 1)) { mn = m_reg; alpha = 1.f; }
    else { mn = fmaxf(m_reg, pmax); alpha = __builtin_amdgcn_exp2f(m_reg - mn); m_reg = mn; }
#pragma unroll
    for (int r = 0; r < 16; ++r) p0[r] = p0[r] - mn;
#pragma unroll
    for (int r = 0; r < 16; ++r) p1[r] = p1[r] - mn;
#pragma unroll
    for (int r = 0; r < 16; ++r) p0[r] = __builtin_amdgcn_exp2f(p0[r]);
}
__device__ __forceinline__ void finishSM(f32x16& p0, f32x16& p1, float alpha, float& l_reg, bf16x8& pa0, bf16x8& pa1, bf16x8& pa2, bf16x8& pa3) {
#pragma unroll
    for (int r = 0; r < 16; ++r) p1[r] = __builtin_amdgcn_exp2f(p1[r]);
    float ps = 0;
#pragma unroll
    for (int r = 0; r < 16; ++r) ps += p0[r];
#pragma unroll
    for (int r = 0; r < 16; ++r) ps += p1[r];
    { auto rr = __builtin_amdgcn_permlane32_swap(__float_as_uint(ps), __float_as_uint(ps), false, false);
      ps = __uint_as_float(rr[0]) + __uint_as_float(rr[1]); }
    l_reg = l_reg * alpha + ps;
#define PK4(P, B_, OUT) do { unsigned a0 = pk2(P[B_+0], P[B_+1]), a1 = pk2(P[B_+2], P[B_+3]);                          \
        unsigned b0 = pk2(P[B_+4], P[B_+5]), b1 = pk2(P[B_+6], P[B_+7]);                                             \
        auto r0 = __builtin_amdgcn_permlane32_swap(a0, b0, false, false); auto r1 = __builtin_amdgcn_permlane32_swap(a1, b1, false, false); \
        u32x4 w = {r0[0], r1[0], r0[1], r1[1]}; OUT = __builtin_bit_cast(bf16x8, w); } while (0)
    PK4(p0, 0, pa0); PK4(p0, 8, pa1); PK4(p1, 0, pa2); PK4(p1, 8, pa3);
#undef PK4
}
template <int KB>
__device__ __forceinline__ void qkt(f32x16& p0, f32x16& p1, const LAS unsigned char* K_lds, int r32, int hi, const bf16x8* qr) {
    p0 = f32x16{}; p1 = f32x16{};
    const int s = (r32 >> 1) & 7;
#pragma unroll
    for (int d0 = 0; d0 < 4; ++d0) {
        const LAS unsigned char* a = K_lds + KB * SHM_K + r32 * 128 + (((2 * d0 + hi) ^ s) << 4);
        const bf16x8 b0 = *(const LAS bf16x8*)(a);
        const bf16x8 b1 = *(const LAS bf16x8*)(a + 32 * 128);
        p0 = __builtin_amdgcn_mfma_f32_32x32x16_bf16(b0, qr[d0], p0, 0, 0, 0);
        p1 = __builtin_amdgcn_mfma_f32_32x32x16_bf16(b1, qr[d0], p1, 0, 0, 0); }
}
__device__ __forceinline__ void pv_tile(f32x16* o, int vb0, bf16x8 pa0, bf16x8 pa1, bf16x8 pa2, bf16x8 pa3) {
#define TRRD(dst, off) asm volatile("ds_read_b64_tr_b16 %0, %1 offset:%2" : "=&v"(dst) : "v"(vb0), "i"(off) : "memory")
#define PV_D0(d0) do { s16x4 l0, l1, l2, l3, h0, h1, h2, h3; constexpr int b_ = v_rd_off(d0, 0, 0); \
        TRRD(l0, b_); TRRD(h0, b_ + 2048); TRRD(l1, b_ + 4096); TRRD(h1, b_ + 6144); TRRD(l2, b_ + 8192); TRRD(h2, b_ + 10240); TRRD(l3, b_ + 12288); TRRD(h3, b_ + 14336); \
        asm volatile("s_waitcnt lgkmcnt(0)" ::: "memory"); SBAR();   \
        o[d0] = __builtin_amdgcn_mfma_f32_32x32x16_bf16(pa0, (bf16x8){l0[0], l0[1], l0[2], l0[3], h0[0], h0[1], h0[2], h0[3]}, o[d0], 0, 0, 0);   \
        o[d0] = __builtin_amdgcn_mfma_f32_32x32x16_bf16(pa1, (bf16x8){l1[0], l1[1], l1[2], l1[3], h1[0], h1[1], h1[2], h1[3]}, o[d0], 0, 0, 0);   \
        o[d0] = __builtin_amdgcn_mfma_f32_32x32x16_bf16(pa2, (bf16x8){l2[0], l2[1], l2[2], l2[3], h2[0], h2[1], h2[2], h2[3]}, o[d0], 0, 0, 0);   \
        o[d0] = __builtin_amdgcn_mfma_f32_32x32x16_bf16(pa3, (bf16x8){l3[0], l3[1], l3[2], l3[3], h3[0], h3[1], h3[2], h3[3]}, o[d0], 0, 0, 0); } while (0)
    PV_D0(0); PV_D0(1); PV_D0(2); PV_D0(3);
#undef PV_D0
#undef TRRD
}

#define DA_DMA16(gp, ldsp) __builtin_amdgcn_global_load_lds((const unsigned*)(gp), (LAS unsigned*)(ldsp), 16, 0, 0)
#define DA_STAGE(koff_, voff_, k0, ksoff, vsoff) do { const size_t tb_ = (size_t)(k0) * (PITCH * 2); \
        DA_DMA16(projb + (koff_) + tb_ + lk, K_lds + (ksoff) + wid * 1024); \
        DA_DMA16(projb + (voff_) + tb_ + lv, V_lds + (vsoff) + wid * 2048); \
        DA_DMA16(projb + (voff_) + tb_ + lv + 128, V_lds + (vsoff) + wid * 2048 + 1024); } while (0)
#define DA_LANE_OFFS() const int krow_ = 8 * wid + (lane >> 3); \
        const unsigned lk = (unsigned)(krow_ * PITCH) * 2u + (unsigned)(((lane & 7) ^ ((krow_ >> 1) & 7)) << 4); \
        const unsigned lv = (unsigned)((8 * wid + ((lane & 31) >> 2)) * PITCH) * 2u + (unsigned)(((lane >> 5) * 32 + (lane & 3) * 8) * 2)

__device__ __forceinline__ void prime(const Ref& cur, LAS unsigned char* lds, Seam& S, rsrc_t R, const char* projb) {
    const int tid = threadIdx.x, wid = __builtin_amdgcn_readfirstlane(tid >> 6), lane = tid & 63, r32 = lane & 31, hi = lane >> 5;
    DA_LANE_OFFS();
    const unsigned lq = (unsigned)((wid * QBLK + r32) * PITCH + hi * 8) * 2u;
    LAS unsigned char* K_lds = lds + OFF_K; LAS unsigned char* V_lds = lds + OFF_V;
#pragma unroll
    for (int d0 = 0; d0 < 4; ++d0) S.qr[d0] = bld8(R, lq + d0 * 32, cur.qoff);
    S.ks = 0; S.vs = 0;
    DA_STAGE(cur.koff, cur.voff, 0, 0, 0); DA_STAGE(cur.koff, cur.voff, KVBLK, SHM_K, SHM_V);
    __syncthreads();
}
__device__ __forceinline__ void block(const Ref& cur, const Ref& nxt, LAS unsigned char* lds, Seam& S, float lam, const float* gsub, rsrc_t R, const char* projb) {
    const int tid = threadIdx.x, wid = __builtin_amdgcn_readfirstlane(tid >> 6), lane = tid & 63, r32 = lane & 31, hi = lane >> 5;
    const int NT = (cur.P0 + QB) / KVBLK;
    const int qlo = cur.P0 + wid * QBLK;
    LAS unsigned char* V_lds = lds + OFF_V; LAS unsigned char* K_lds = lds + OFF_K;
    LAS float* ws = (LAS float*)(lds + OFF_WS) + wid * 64; LAS float* li_l = ws; LAS float* al_l = ws + 32;
    const LAS float* tbh = (const LAS float*)(lds + OFF_TB) + cur.h * 128;
    float mhat = 0.f, l_reg = 0.f, rmx = 0.f; f32x16 o[4] = {}; f32x16 negm = f32x16{};
    bool resc = false;
    const int vb0 = (int)(unsigned)(uintptr_t)V_lds + v_rd_base(lane);
    DA_LANE_OFFS();
    const unsigned Kh = cur.koff, Vh = cur.voff;
#define KNEXT(x) (((x) == (NKS - 1) * SHM_K) ? 0 : (x) + SHM_K)
#define VNEXT(x) (((x) == (NVS - 1) * SHM_V) ? 0 : (x) + SHM_V)
    int k0 = S.ks, k1 = KNEXT(k0), k2 = KNEXT(k1);
    int v1 = S.vs, v2 = VNEXT(v1), v3 = VNEXT(v2), v0 = VNEXT(v3);
#define ROT() do { const int kn_ = k0; k0 = k1; k1 = k2; k2 = kn_; const int vn_ = v0; v0 = v1; v1 = v2; v2 = v3; v3 = vn_; } while (0)
#define STREAM(j) do { const bool in_ = (j) < NT; const unsigned ko_ = in_ ? Kh : nxt.koff, vo_ = in_ ? Vh : nxt.voff; const int tj_ = in_ ? (j) : (j) - NT; DA_STAGE(ko_, vo_, KBASE(tj_), k2, v3); } while (0)
#define STEP_BAR() asm volatile("s_waitcnt vmcnt(3) lgkmcnt(0)\n\ts_barrier" ::: "memory")
    const int ksw = (r32 >> 1) & 7;
    const LAS unsigned char* kbase = K_lds + r32 * 128;
#define KBASE(t) ((t) * KVBLK)
#define NEAR(P0_, P1_, t) do { const int kb_ = KBASE(t); if (kb_ >= qlo - 175) bias_mask(P0_, P1_, qlo - kb_, tbh); } while (0)
#define RESC() do { if (resc) { asm volatile("s_waitcnt lgkmcnt(0)" ::: "memory");              \
                     _Pragma("unroll") for (int d_ = 0; d_ < 4; ++d_) _Pragma("unroll") for (int r = 0; r < 16; ++r) o[d_][r] *= al_l[crow(r, hi)]; } } while (0)
#define PIN(x) asm volatile("" : "+v"(x))
#define EX(v) __builtin_amdgcn_exp2f(v)
#define MX3(a, b, c) __builtin_fmaxf(__builtin_fmaxf((a), (b)), (c))
#define DECIDE(C0, C1, FIRST) do { \
        float a_ = MX3(C0[0], C0[1], C1[0]), b_ = MX3(C0[2], C0[3], C1[1]); a_ = MX3(a_, C1[2], C1[3]); \
        _Pragma("unroll") for (int r = 4; r < 16; r += 4) { a_ = MX3(a_, C0[r], C0[r + 1]); b_ = MX3(b_, C0[r + 2], C0[r + 3]); a_ = MX3(a_, C1[r], C1[r + 1]); b_ = MX3(b_, C1[r + 2], C1[r + 3]); } \
        float rm_ = __builtin_fmaxf(a_, b_); { auto rr_ = __builtin_amdgcn_permlane32_swap(__float_as_uint(rm_), __float_as_uint(rm_), false, false); rm_ = __builtin_fmaxf(__uint_as_float(rr_[0]), __uint_as_float(rr_[1])); } \
        resc = false; \
        if ((FIRST) || __builtin_expect(__any(rm_ > THR), 0)) { const float dl_ = (FIRST) ? rm_ : __builtin_fmaxf(rm_, 0.f); mhat += dl_; \
            _Pragma("unroll") for (int r = 0; r < 16; ++r) { C0[r] -= dl_; C1[r] -= dl_; } \
            _Pragma("unroll") for (int r = 0; r < 16; ++r) negm[r] = -mhat; \
            asm volatile("" : "+v"(negm)); \
            if (!(FIRST)) { const float f_ = EX(-dl_); l_reg *= f_; if (hi == 0) al_l[r32] = f_; resc = true; } } } while (0)
#define DECIDE2(C0, C1) do { float rm_ = rmx; { auto rr_ = __builtin_amdgcn_permlane32_swap(__float_as_uint(rm_), __float_as_uint(rm_), false, false); rm_ = __builtin_fmaxf(__uint_as_float(rr_[0]), __uint_as_float(rr_[1])); } \
        resc = false; \
        if (__builtin_expect(__any(rm_ > THR), 0)) { const float dl_ = __builtin_fmaxf(rm_, 0.f); mhat += dl_; const float f_ = EX(-dl_); \
            _Pragma("unroll") for (int r = 0; r < 16; ++r) { C0[r] *= f_; C1[r] *= f_; } \
            _Pragma("unroll") for (int r = 0; r < 16; ++r) negm[r] = -mhat; \
            asm volatile("" : "+v"(negm)); \
            l_reg *= f_; if (hi == 0) al_l[r32] = f_; resc = true; } } while (0)
#define KF(d0, hf) (*(const LAS bf16x8*)(kbase + k0 + (((2 * (d0) + hi) ^ ksw) << 4) + (hf) * 4096))
#define GAPA(MF, P, B, W) do { MF; sacc += P[B]; sacc += P[B + 1]; sacc += P[B + 2]; sacc += P[B + 3]; PIN(sacc); W[((B) >> 1) & 3] = pk2(P[B], P[B + 1]); W[(((B) >> 1) & 3) + 1] = pk2(P[B + 2], P[B + 3]); PIN(W); SBAR(); } while (0)
#define PHASE_A(C0, C1, P0, P1) do { \
        const bf16x8 k00 = KF(0, 0), k01 = KF(0, 1), k10 = KF(1, 0), k11 = KF(1, 1), k20 = KF(2, 0), k21 = KF(2, 1), k30 = KF(3, 0), k31 = KF(3, 1); \
        float sacc = 0.f; SBAR(); \
        GAPA(C0 = __builtin_amdgcn_mfma_f32_32x32x16_bf16(k00, S.qr[0], negm, 0, 0, 0), P0, 0, pw0); \
        GAPA(C1 = __builtin_amdgcn_mfma_f32_32x32x16_bf16(k01, S.qr[0], negm, 0, 0, 0), P0, 4, pw0); \
        GAPA(C0 = __builtin_amdgcn_mfma_f32_32x32x16_bf16(k10, S.qr[1], C0, 0, 0, 0), P0, 8, pw1); \
        GAPA(C1 = __builtin_amdgcn_mfma_f32_32x32x16_bf16(k11, S.qr[1], C1, 0, 0, 0), P0, 12, pw1); \
        GAPA(C0 = __builtin_amdgcn_mfma_f32_32x32x16_bf16(k20, S.qr[2], C0, 0, 0, 0), P1, 0, pw2); \
        GAPA(C1 = __builtin_amdgcn_mfma_f32_32x32x16_bf16(k21, S.qr[2], C1, 0, 0, 0), P1, 4, pw2); \
        GAPA(C0 = __builtin_amdgcn_mfma_f32_32x32x16_bf16(k30, S.qr[3], C0, 0, 0, 0), P1, 8, pw3); \
        GAPA(C1 = __builtin_amdgcn_mfma_f32_32x32x16_bf16(k31, S.qr[3], C1, 0, 0, 0), P1, 12, pw3); \
        l_reg += sacc; } while (0)
#define TRRD(dst, off) asm volatile("ds_read_b64_tr_b16 %0, %1 offset:%2" : "=&v"(dst) : "v"(vbr), "i"(off) : "memory")
#define VRD8(L0, H0, L1, H1, L2, H2, L3, H3, VBv, d0) do { constexpr int b_ = v_rd_off(d0, 0, 0); \
        TRRD(L0, b_); TRRD(H0, b_ + 2048); TRRD(L1, b_ + 4096); TRRD(H1, b_ + 6144); TRRD(L2, b_ + 8192); TRRD(H2, b_ + 10240); TRRD(L3, b_ + 12288); TRRD(H3, b_ + 14336); } while (0)
#define VF(L, H) (bf16x8){L[0], L[1], L[2], L[3], H[0], H[1], H[2], H[3]}
#define PAF(k) __builtin_bit_cast(bf16x8, pw##k)
#define GAPB(MF, X, B) do { MF; rmx = MX3(rmx, X[B], X[(B) + 1]); X[B] = EX(X[B]); X[(B) + 1] = EX(X[(B) + 1]); PIN(X); PIN(rmx); SBAR(); } while (0)
#define PV4(d0, L0, H0, L1, H1, L2, H2, L3, H3, X, B) do { \
        GAPB(o[d0] = __builtin_amdgcn_mfma_f32_32x32x16_bf16(PAF(0), VF(L0, H0), o[d0], 0, 0, 0), X, (B)); \
        GAPB(o[d0] = __builtin_amdgcn_mfma_f32_32x32x16_bf16(PAF(1), VF(L1, H1), o[d0], 0, 0, 0), X, (B) + 2); \
        GAPB(o[d0] = __builtin_amdgcn_mfma_f32_32x32x16_bf16(PAF(2), VF(L2, H2), o[d0], 0, 0, 0), X, (B) + 4); \
        GAPB(o[d0] = __builtin_amdgcn_mfma_f32_32x32x16_bf16(PAF(3), VF(L3, H3), o[d0], 0, 0, 0), X, (B) + 6); } while (0)
#define LWAIT(n) do { asm volatile("s_waitcnt lgkmcnt(" #n ")" ::: "memory"); SBAR(); } while (0)
#define PHASE_B(C0, C1, VBv) do { s16x4 a0, a1, a2, a3, a4, a5, a6, a7, b0, b1, b2, b3, b4, b5, b6, b7; const int vbr = vb0 + (VBv); rmx = -__builtin_inff(); \
        asm volatile("s_waitcnt lgkmcnt(0)" ::: "memory"); SBAR(); \
        VRD8(a0, a1, a2, a3, a4, a5, a6, a7, VBv, 0); VRD8(b0, b1, b2, b3, b4, b5, b6, b7, VBv, 1); LWAIT(8); \
        PV4(0, a0, a1, a2, a3, a4, a5, a6, a7, C0, 0); \
        VRD8(a0, a1, a2, a3, a4, a5, a6, a7, VBv, 2); LWAIT(8); \
        PV4(1, b0, b1, b2, b3, b4, b5, b6, b7, C0, 8); \
        VRD8(b0, b1, b2, b3, b4, b5, b6, b7, VBv, 3); LWAIT(8); \
        PV4(2, a0, a1, a2, a3, a4, a5, a6, a7, C1, 0); \
        LWAIT(0); \
        PV4(3, b0, b1, b2, b3, b4, b5, b6, b7, C1, 8); } while (0)
    f32x16 pA0, pA1, pB0, pB1; u32x4 pw0, pw1, pw2, pw3;
#if PROBE_SEG
    unsigned long long pst_ = __builtin_readcyclecounter();
#define STAMP(k) do { const unsigned long long n_ = __builtin_readcyclecounter(); if ((k) == PROBE_SEG) S.acc += n_ - pst_; S.tot += n_ - pst_; pst_ = n_; } while (0)
#else
#define STAMP(k) do { } while (0)
#endif
    STREAM(2);
    SBAR();
    {
      const bf16x8 k00 = KF(0, 0), k01 = KF(0, 1), k10 = KF(1, 0), k11 = KF(1, 1), k20 = KF(2, 0), k21 = KF(2, 1), k30 = KF(3, 0), k31 = KF(3, 1);
      pA0 = __builtin_amdgcn_mfma_f32_32x32x16_bf16(k00, S.qr[0], negm, 0, 0, 0); pA1 = __builtin_amdgcn_mfma_f32_32x32x16_bf16(k01, S.qr[0], negm, 0, 0, 0);
      pA0 = __builtin_amdgcn_mfma_f32_32x32x16_bf16(k10, S.qr[1], pA0, 0, 0, 0); pA1 = __builtin_amdgcn_mfma_f32_32x32x16_bf16(k11, S.qr[1], pA1, 0, 0, 0);
      pA0 = __builtin_amdgcn_mfma_f32_32x32x16_bf16(k20, S.qr[2], pA0, 0, 0, 0); pA1 = __builtin_amdgcn_mfma_f32_32x32x16_bf16(k21, S.qr[2], pA1, 0, 0, 0);
      pA0 = __builtin_amdgcn_mfma_f32_32x32x16_bf16(k30, S.qr[3], pA0, 0, 0, 0); pA1 = __builtin_amdgcn_mfma_f32_32x32x16_bf16(k31, S.qr[3], pA1, 0, 0, 0); }
    NEAR(pA0, pA1, 0); DECIDE(pA0, pA1, true);
#pragma unroll
    for (int r = 0; r < 16; ++r) { pA0[r] = EX(pA0[r]); pA1[r] = EX(pA1[r]); }
    STEP_BAR();
    ROT();
#define STEP(C0, C1, P0, P1, t) do { SBAR(); STAMP(5); \
        STREAM((t) + 2); SBAR(); \
        PHASE_A(C0, C1, P0, P1); SBAR(); STAMP(1); \
        NEAR(C0, C1, (t)); SBAR(); STAMP(2); \
        PHASE_B(C0, C1, v0); DECIDE2(C0, C1); SBAR(); STAMP(3); \
        RESC(); STEP_BAR(); STAMP(4); ROT(); } while (0)
    int t = 1;
    for (; t + 2 < NT; t += 2) {
        STEP(pB0, pB1, pA0, pA1, t);
        STEP(pA0, pA1, pB0, pB1, t + 1);
    }
    SBAR(); STREAM(NT + 1); SBAR();
    PHASE_A(pB0, pB1, pA0, pA1);
    { const unsigned lq = (unsigned)((wid * QBLK + r32) * PITCH + hi * 8) * 2u;
#pragma unroll
      for (int d0 = 0; d0 < 4; ++d0) S.qr[d0] = bld8(R, lq + d0 * 32, nxt.qoff); }
    SBAR();
    NEAR(pB0, pB1, NT - 1); SBAR();
    PHASE_B(pB0, pB1, v0); DECIDE2(pB0, pB1);
    RESC();
    { float sacc = 0.f;
#pragma unroll
      for (int r = 0; r < 16; ++r) { sacc += pB0[r]; sacc += pB1[r]; }
      l_reg += sacc;
      pw0 = (u32x4){pk2(pB0[0], pB0[1]), pk2(pB0[2], pB0[3]), pk2(pB0[4], pB0[5]), pk2(pB0[6], pB0[7])}; pw1 = (u32x4){pk2(pB0[8], pB0[9]), pk2(pB0[10], pB0[11]), pk2(pB0[12], pB0[13]), pk2(pB0[14], pB0[15])};
      pw2 = (u32x4){pk2(pB1[0], pB1[1]), pk2(pB1[2], pB1[3]), pk2(pB1[4], pB1[5]), pk2(pB1[6], pB1[7])}; pw3 = (u32x4){pk2(pB1[8], pB1[9]), pk2(pB1[10], pB1[11]), pk2(pB1[12], pB1[13]), pk2(pB1[14], pB1[15])};
      SBAR(); pv_tile(o, vb0 + v1, PAF(0), PAF(1), PAF(2), PAF(3)); }
    ROT(); S.ks = k0; S.vs = v1;
    { auto rr = __builtin_amdgcn_permlane32_swap(__float_as_uint(l_reg), __float_as_uint(l_reg), false, false); l_reg = __uint_as_float(rr[0]) + __uint_as_float(rr[1]); }
    int lane_e = (int)__builtin_amdgcn_mbcnt_hi(~0u, __builtin_amdgcn_mbcnt_lo(~0u, 0u)); asm volatile("" : "+v"(lane_e));
    const int r32e = lane_e & 31, hie = lane_e >> 5;
    if (hi == 0) li_l[r32] = l_reg; asm volatile("s_waitcnt lgkmcnt(0)" ::: "memory");
    float rli[16];
#pragma unroll
    for (int r = 0; r < 16; ++r) rli[r] = __builtin_amdgcn_rcpf(li_l[crow(r, hi)]);
    LAS unsigned* st = (LAS unsigned*)(lds + OFF_STASH + wid * 8192) + lane_e;
    if (cur.comp == 0) {
#pragma unroll
        for (int r = 0; r < 16; ++r) { st[(2 * r) * 64] = pk2(o[0][r] * rli[r], o[1][r] * rli[r]); st[(2 * r + 1) * 64] = pk2(o[2][r] * rli[r], o[3][r] * rli[r]); }
    } else {
        float ss[16];
#pragma unroll
        for (int r = 0; r < 16; ++r) { const unsigned u0 = st[(2 * r) * 64], u1 = st[(2 * r + 1) * 64];
            const float s2 = lam * rli[r];
            o[0][r] = bflo(u0) - s2 * o[0][r]; o[1][r] = bfhi(u0) - s2 * o[1][r]; o[2][r] = bflo(u1) - s2 * o[2][r]; o[3][r] = bfhi(u1) - s2 * o[3][r];
            ss[r] = (o[0][r] * o[0][r] + o[1][r] * o[1][r]) + (o[2][r] * o[2][r] + o[3][r] * o[3][r]); }
#pragma unroll
        for (int r = 0; r < 16; ++r) {
#pragma unroll
            for (int x = 1; x < 32; x <<= 1) ss[r] += __shfl_xor(ss[r], x);
            ss[r] = rsqrtf(ss[r] * (1.f / 128.f) + EPS) * 0.8f; }
        float gg[4];
#pragma unroll
        for (int d0 = 0; d0 < 4; ++d0) gg[d0] = gsub[d0 * 32 + r32e];
        bf16_t* Ow = cur.O + (size_t)(wid * QBLK) * DM;
#pragma unroll
        for (int r = 0; r < 16; ++r) { const int orow = crow(r, hie);
#pragma unroll
            for (int d0 = 0; d0 < 4; ++d0) { const float v = o[d0][r] * ss[r] * gg[d0]; const float vn = __shfl_xor(v, 1);
                if ((r32e & 1) == 0) *(unsigned*)(Ow + (size_t)orow * DM + d0 * 32 + r32e) = pk2(v, vn); } }
    }
    __syncthreads();
#undef RESC
#undef KBASE
#undef NEAR
#undef PIN
#undef EX
#undef MX3
#undef DECIDE
#undef DECIDE2
#undef KF
#undef GAPA
#undef PHASE_A
#undef TRRD
#undef VRD8
#undef VF
#undef PAF
#undef GAPB
#undef PV4
#undef LWAIT
#undef PHASE_B
#undef STEP
#undef STAMP
#undef ROT
#undef KNEXT
#undef VNEXT
#undef STREAM
#undef STEP_BAR
}
#undef DA_DMA16
#undef DA_STAGE
#undef DA_LANE_OFFS
}

constexpr int NWAVES = 8;
constexpr int N_LAUNCHES = MK_N_LAUNCHES;
constexpr int N_PHASES = 9;
static_assert(N_LAUNCHES == 1 || N_LAUNCHES == N_PHASES, "MK_N_LAUNCHES is 1 or 9");

constexpr size_t MiB = 1u << 20;
constexpr size_t WS_CTL = 0, CTL_ZERO_BYTES = 1 * MiB;
constexpr size_t WS_ETK = 1 * MiB, WS_GTK = 2 * MiB, WS_RSTDT = 3 * MiB, WS_SLOTTK = 4 * MiB, WS_TOKSLOT = 5 * MiB, WS_GATESLOT = 7 * MiB, WS_RSTDSLOT = 9 * MiB, WS_RBE = 11 * MiB;
constexpr size_t WS_WRHI = 12 * MiB, WS_WRLO = 12 * MiB + 65536, WS_KMB = 13 * MiB, WS_VMT = 14 * MiB;
constexpr size_t WS_WIN = 16 * MiB, WS_WOUT = 21 * MiB, WS_X1B = 24 * MiB, WS_X1Q = 152 * MiB;
constexpr size_t WS_BIG = 216 * MiB;
constexpr size_t WS_H = WS_BIG, WS_PROJ = WS_BIG + 128 * MiB, WS_MIX = WS_BIG + 448 * MiB;
constexpr size_t WS_ACTQ = WS_BIG, WS_Y = WS_BIG + 264 * MiB;
constexpr size_t WS_END = WS_BIG + 792 * MiB;
static_assert(WS_END <= 1024 * MiB, "d_ws map");
constexpr size_t OUT_WGU = 0, OUT_WD = 64 * MiB;
constexpr int CW_BAR = 4096, CW_COUNT = 1024, CW_CURSOR = 2048;
constexpr int RING_BYTES = 159744, LDSCTL_OFF = RING_BYTES, MISC_OFF = LDSCTL_OFF + 320, LDS_BYTES = 163840;
static_assert(dattn::LDS_BYTES <= RING_BYTES, "attention scratch");

#define XB_TMO      128
#define XB_XCNT(j)  (256  + 64 * (j))
#define XB_XSUB(j)  (1280 + 64 * (j))
#define XB_XGEN(j)  (2304 + 64 * (j))
#define XB_TOP      3328
#define XB_TOPGEN   3392
#define XCD_BAR_WORDS 3456
#define XB_SPIN_CAP (1u << 18)
__device__ __forceinline__ unsigned xb_ld(unsigned* p)              { return __hip_atomic_load(p, __ATOMIC_RELAXED, __HIP_MEMORY_SCOPE_AGENT); }
__device__ __forceinline__ unsigned xb_add(unsigned* p, unsigned v) { return __hip_atomic_fetch_add(p, v, __ATOMIC_RELAXED, __HIP_MEMORY_SCOPE_AGENT); }
__device__ __forceinline__ unsigned xb_xcc_id() { return (unsigned)__builtin_amdgcn_s_getreg((3 << 11) | 20) & 0xFu; }
#define XB_SPIN(cond, bar) do { unsigned _sp = 0; while (cond) { __builtin_amdgcn_s_sleep(1); \
    if ((++_sp & 255u) == 0u) { if (xb_ld(&(bar)[XB_TMO])) break; if (_sp > XB_SPIN_CAP) { atomicAdd(&(bar)[XB_TMO], 1u); break; } } } } while (0)
struct XcdBarrier { unsigned* bar; unsigned x; volatile LAS unsigned* st; };
__device__ __forceinline__ XcdBarrier xcd_barrier_post(unsigned* bar, volatile LAS unsigned* st) {
    XcdBarrier b; b.bar = bar; b.x = xb_xcc_id(); b.st = st;
    if (threadIdx.x == 0) (void)xb_add(&bar[XB_XCNT(b.x)], 1u);
    return b;
}
__device__ __forceinline__ void xcd_barrier_complete(unsigned* bar, unsigned x, unsigned& nloc, unsigned& nx) {
    const unsigned G = gridDim.x * gridDim.y * gridDim.z;
    unsigned sum, cnt, mine, sp = 0u;
    for (;;) {
        sum = 0u; cnt = 0u; mine = 0u;
#pragma unroll
        for (unsigned j = 0; j < 16; ++j) { const unsigned c = xb_ld(&bar[XB_XCNT(j)]); sum += c; cnt += (c > 0u) ? 1u : 0u; mine = (j == x) ? c : mine; }
        if (sum == G) break;
        __builtin_amdgcn_s_sleep(1);
        if ((++sp & 255u) == 0u) { if (xb_ld(&bar[XB_TMO])) break; if (sp > XB_SPIN_CAP) { atomicAdd(&bar[XB_TMO], 1u); break; } }
    }
    nloc = mine > 0u ? mine : 1u; nx = cnt > 0u ? cnt : 1u;
}
__device__ __forceinline__ void xcd_barrier(const XcdBarrier& b) {
    asm volatile("s_waitcnt vmcnt(0)" ::: "memory");
    __syncthreads();
    if (threadIdx.x == 0) {
        unsigned* bar = b.bar;
        __builtin_amdgcn_s_waitcnt(0);
        unsigned nloc = b.st[0], nx = b.st[1];
        if (nloc == 0u) { xcd_barrier_complete(bar, b.x, nloc, nx); b.st[0] = nloc; b.st[1] = nx; }
        const unsigned old = xb_add(&bar[XB_XSUB(b.x)], 1u);
        const unsigned gen = old / nloc;
        if (old + 1u == (gen + 1u) * nloc) {
            __builtin_amdgcn_fence(__ATOMIC_RELEASE, "agent");
            asm volatile("s_waitcnt vmcnt(0)" ::: "memory");
            const unsigned og = xb_add(&bar[XB_TOP], 1u);
            const unsigned tg = og / nx;
            if (og + 1u == (tg + 1u) * nx) xb_add(&bar[XB_TOPGEN], 1u);
            else XB_SPIN(xb_ld(&bar[XB_TOPGEN]) == tg, bar);
            __builtin_amdgcn_fence(__ATOMIC_ACQUIRE, "agent");
            xb_add(&bar[XB_XGEN(b.x)], 1u);
            asm volatile("s_waitcnt vmcnt(0)" ::: "memory");
        } else {
            XB_SPIN(xb_ld(&bar[XB_XGEN(b.x)]) == gen, bar);
            __builtin_amdgcn_fence(__ATOMIC_ACQUIRE, "agent");
            asm volatile("s_waitcnt vmcnt(0)" ::: "memory");
        }
    }
    __syncthreads();
}

struct Frame {
    LAS unsigned char* lds;
    volatile LAS unsigned* MISC;
    unsigned* ctl;
    int tid, lane, wave, vcu, G;
    float* out;
    unsigned char* ws;
};
struct Args { const float* in[19]; float* out; unsigned char* ws; int ph_lo, ph_hi; };
typedef const __attribute__((address_space(4))) Args* KArgs;
__device__ __forceinline__ KArgs kargs() { KArgs p = (KArgs)__builtin_amdgcn_kernarg_segment_ptr(); asm volatile("" : "+s"(p)); return p; }
enum { I_X = 0, I_MEM, I_RELB, I_ATTNG, I_WIN, I_CONVW, I_LAMQK, I_SUBG, I_MEMG, I_WMEMKV, I_WOUT, I_FFNG, I_RW, I_RB, I_WGU, I_BGU, I_WDN, I_BDN, I_FING };

template <bool GAIN, bool F8>
__device__ __forceinline__ void p0_transpose_item(const float* W, int K, int N, void* WTv, int k0, int n0, int drow0, const float* kgain, float scale, LAS float* scr, int lane) {
    float v[32];
    const float* wp = W + (size_t)(k0 + (lane >> 5)) * N + n0 + (lane & 31);
#pragma unroll
    for (int i = 0; i < 32; ++i) v[i] = wp[(size_t)(2 * i) * N];
    const int c = lane & 7;
    f32x4 g0 = {scale, scale, scale, scale}, g1 = g0;
    if constexpr (GAIN) { g0 = *(const f32x4*)(kgain + k0 + 8 * c) * scale; g1 = *(const f32x4*)(kgain + k0 + 8 * c + 4) * scale; }
#pragma unroll
    for (int i = 0; i < 32; ++i) scr[(2 * i + (lane >> 5)) * 33 + (lane & 31)] = v[i];
    LDS_WAIT(); asm volatile("" ::: "memory");
#pragma unroll
    for (int j = 0; j < 4; ++j) { const int n = (lane >> 3) + 8 * j; const LAS float* s = scr + (8 * c) * 33 + n;
        const float e0 = s[0 * 33] * g0[0], e1 = s[1 * 33] * g0[1], e2 = s[2 * 33] * g0[2], e3 = s[3 * 33] * g0[3], e4 = s[4 * 33] * g1[0], e5 = s[5 * 33] * g1[1], e6 = s[6 * 33] * g1[2], e7 = s[7 * 33] * g1[3];
        if constexpr (F8) { u32x2 o; o.x = pg8::pk4_fp8(e0, e1, e2, e3); o.y = pg8::pk4_fp8(e4, e5, e6, e7);
            *(u32x2*)((unsigned char*)WTv + (size_t)(drow0 + n) * K + k0 + 8 * c) = o; }
        else { u32x4 o; o.x = pk2(e0, e1); o.y = pk2(e2, e3); o.z = pk2(e4, e5); o.w = pk2(e6, e7);
            *(u32x4*)((bf16_t*)WTv + (size_t)(drow0 + n) * K + k0 + 8 * c) = o; } }
    LDS_WAIT(); asm volatile("" ::: "memory");
}
__device__ __forceinline__ void rms_row2_to_bf16(const float* xa, const float* xb, const float* g, bf16_t* oa, bf16_t* ob, int lane) {
    const f32x4* ra = (const f32x4*)xa + lane; const f32x4* rb = (const f32x4*)xb + lane; const f32x4* gr = (const f32x4*)g + lane;
    f32x4 va[4], vb[4]; float sa = 0.f, sb = 0.f;
#pragma unroll
    for (int j = 0; j < 4; ++j) { va[j] = ra[64 * j]; vb[j] = rb[64 * j]; }
#pragma unroll
    for (int j = 0; j < 4; ++j) { sa += (va[j].x * va[j].x + va[j].y * va[j].y) + (va[j].z * va[j].z + va[j].w * va[j].w); sb += (vb[j].x * vb[j].x + vb[j].y * vb[j].y) + (vb[j].z * vb[j].z + vb[j].w * vb[j].w); }
    const float rsa = rsqrtf(wave_sum(sa) * (1.f / DM) + EPS), rsb = rsqrtf(wave_sum(sb) * (1.f / DM) + EPS);
    unsigned long long* pa = (unsigned long long*)oa + lane; unsigned long long* pb = (unsigned long long*)ob + lane;
#pragma unroll
    for (int j = 0; j < 4; ++j) { const f32x4 gg = gr[64 * j];
        pa[64 * j] = (unsigned long long)pk2(va[j].x * rsa * gg.x, va[j].y * rsa * gg.y) | ((unsigned long long)pk2(va[j].z * rsa * gg.z, va[j].w * rsa * gg.w) << 32);
        pb[64 * j] = (unsigned long long)pk2(vb[j].x * rsb * gg.x, vb[j].y * rsb * gg.y) | ((unsigned long long)pk2(vb[j].z * rsb * gg.z, vb[j].w * rsb * gg.w) << 32); }
}
__device__ __forceinline__ void p0_kvm_tile(Frame& F, int tile, const float* mem, const float* mem_g, const float* w_memkv) {
    const int mt = tile >> 3, ntile = tile & 7, row0 = 64 * mt, col0 = 64 * ntile;
    const int mb = F.wave >> 1, nb0 = (F.wave & 1) * 2, ar = F.lane & 15, kq = F.lane >> 4;
    const float* arow = mem + (size_t)(row0 + mb * 16 + ar) * DM;
    f32x4 acc[2]; acc[0] = (f32x4){0.f, 0.f, 0.f, 0.f}; acc[1] = acc[0];
    float ss = 0.f;
    const float* wq = w_memkv + col0 + nb0 * 16 + ar;
#define KVM_LOAD(A0, A1, G0, G1, BV, k0_) do { const int kk_ = (k0_) + 8 * kq; A0 = *(const f32x4*)(arow + kk_); A1 = *(const f32x4*)(arow + kk_ + 4); G0 = *(const f32x4*)(mem_g + kk_); G1 = *(const f32x4*)(mem_g + kk_ + 4); \
        _Pragma("unroll") for (int nbi = 0; nbi < 2; ++nbi) _Pragma("unroll") for (int j = 0; j < 8; ++j) BV[nbi][j] = wq[(size_t)(kk_ + j) * 512 + nbi * 16]; } while (0)
#define KVM_MATH(A0, A1, G0, G1, BV) do { ss += (A0.x * A0.x + A0.y * A0.y) + (A0.z * A0.z + A0.w * A0.w) + (A1.x * A1.x + A1.y * A1.y) + (A1.z * A1.z + A1.w * A1.w); \
        const bf16x8 af = pack8(A0 * G0, A1 * G1); \
        _Pragma("unroll") for (int nbi = 0; nbi < 2; ++nbi) { const f32x4 b0 = {BV[nbi][0], BV[nbi][1], BV[nbi][2], BV[nbi][3]}, b1 = {BV[nbi][4], BV[nbi][5], BV[nbi][6], BV[nbi][7]}; \
            acc[nbi] = __builtin_amdgcn_mfma_f32_16x16x32_bf16(af, pack8(b0, b1), acc[nbi], 0, 0, 0); } } while (0)
    f32x4 xa0, xa1, xg0, xg1, ya0, ya1, yg0, yg1; float xb[2][8], yb[2][8];
    KVM_LOAD(xa0, xa1, xg0, xg1, xb, 0);
    for (int k0 = 0; k0 < DM; k0 += 64) {
        KVM_LOAD(ya0, ya1, yg0, yg1, yb, k0 + 32);
        KVM_MATH(xa0, xa1, xg0, xg1, xb);
        if (k0 + 64 < DM) KVM_LOAD(xa0, xa1, xg0, xg1, xb, k0 + 64);
        KVM_MATH(ya0, ya1, yg0, yg1, yb);
    }
#undef KVM_LOAD
#undef KVM_MATH
    ss += __shfl_xor(ss, 16); ss += __shfl_xor(ss, 32);
    const float rstd = rsqrtf(ss * (1.f / DM) + EPS);
    float rs[4];
#pragma unroll
    for (int j = 0; j < 4; ++j) rs[j] = __shfl(rstd, kq * 4 + j);
    bf16_t* kmb = (bf16_t*)(F.ws + WS_KMB); bf16_t* vmt = (bf16_t*)(F.ws + WS_VMT);
#pragma unroll
    for (int nbi = 0; nbi < 2; ++nbi) {
        const int gc = col0 + (nb0 + nbi) * 16 + ar, gr0 = row0 + mb * 16 + kq * 4;
        if (ntile < 4) {
#pragma unroll
            for (int j = 0; j < 4; ++j) kmb[(size_t)(gr0 + j) * 256 + gc] = (bf16_t)(pk2(acc[nbi][j] * rs[j], 0.f) & 0xffffu);
        } else {
            const int d = gc - 256, hm = d >> 6, dd = d & 63, b = gr0 >> 8, m = gr0 & 255;
            u32x2 w; w.x = pk2(acc[nbi][0] * rs[0], acc[nbi][1] * rs[1]); w.y = pk2(acc[nbi][2] * rs[2], acc[nbi][3] * rs[3]);
            *(u32x2*)(vmt + ((size_t)((b * 4 + hm) * 64 + dd)) * 256 + m) = w;
        }
    }
}
__device__ __forceinline__ void p0_prologue(Frame& F) {
    KArgs A = kargs();
    { const float* mem = A->in[I_MEM]; const float* mem_g = A->in[I_MEMG]; const float* w_memkv = A->in[I_WMEMKV];
      for (int rep2_ = 0; rep2_ < ((PROBE_P0 & 4) ? 2 : 1); ++rep2_)
      for (int tile = blockIdx.x; tile < 256; tile += F.G) p0_kvm_tile(F, tile, mem, mem_g, w_memkv); }
    const float* w_in = A->in[I_WIN]; const float* w_out = A->in[I_WOUT]; const float* w_gu = A->in[I_WGU]; const float* w_dn = A->in[I_WDN]; const float* ffn_g = A->in[I_FFNG];
    LAS float* scr = (LAS float*)(F.lds + F.wave * 16384);
    const int gw = F.vcu * NWAVES + F.wave, NGW = F.G * NWAVES;
    bf16_t* Win_t = (bf16_t*)(F.ws + WS_WIN); bf16_t* Wout_t = (bf16_t*)(F.ws + WS_WOUT);
    unsigned char* Wgu_q = (unsigned char*)F.out + OUT_WGU; unsigned char* Wd_q = (unsigned char*)F.out + OUT_WD;
    constexpr int I_IN = 16 * 80, I_OUT = 16 * 32, I_GU1 = 16 * 64, I_D1 = 16 * 32;
    constexpr int I_GU = NEXP * I_GU1, I_D = NEXP * I_D1, NITEMS = I_IN + I_OUT + I_GU + I_D;
    for (int rep0_ = 0; rep0_ < ((PROBE_P0 & 1) ? 2 : 1); ++rep0_)
    for (int it = gw; it < NITEMS; it += NGW) {
        int r = it;
        if (r < I_IN) { const int kb = r / 80, nb = r % 80; p0_transpose_item<false, false>(w_in, DM, INW, Win_t, 64 * kb, 32 * nb, 32 * nb, nullptr, 1.f, scr, F.lane); continue; } r -= I_IN;
        if (r < I_OUT) { const int kb = r / 32, nb = r % 32; p0_transpose_item<false, false>(w_out, DM, DM, Wout_t, 64 * kb, 32 * nb, 32 * nb, nullptr, 1.f, scr, F.lane); continue; } r -= I_OUT;
        if (r < I_GU) { const int e = r / I_GU1, q = r % I_GU1, kb = q / 64, nb = q % 64, n0 = 32 * nb;
            const int jj = n0 & 1023, drow0 = (jj >> 7) * 256 + (n0 >= 1024 ? 128 : 0) + (jj & 127);
            p0_transpose_item<true, true>(w_gu + (size_t)e * DM * 2048, DM, 2048, Wgu_q + (size_t)e * 2048 * DM, 64 * kb, n0, drow0, ffn_g, 64.f, scr, F.lane); continue; } r -= I_GU;
        { const int e = r / I_D1, q = r % I_D1, kb = q / 32, nb = q % 32;
            p0_transpose_item<false, true>(w_dn + (size_t)e * DEXP * DM, DEXP, DM, Wd_q + (size_t)e * DM * DEXP, 64 * kb, 32 * nb, 32 * nb, nullptr, 64.f, scr, F.lane); }
    }
    bf16_t* H = (bf16_t*)(F.ws + WS_H);
    { const float* x = A->in[I_X]; const float* attn_g = A->in[I_ATTNG];
      for (int rep1_ = 0; rep1_ < ((PROBE_P0 & 2) ? 2 : 1); ++rep1_)
      for (int m = gw; m < T; m += 2 * NGW) { const int m2 = (m + NGW < T) ? m + NGW : m;
          rms_row2_to_bf16(x + (size_t)m * DM, x + (size_t)m2 * DM, attn_g, H + (size_t)m * DM, H + (size_t)m2 * DM, F.lane); } }
    const float* router_w = A->in[I_RW];
    bf16_t* wrh = (bf16_t*)(F.ws + WS_WRHI); bf16_t* wrl = (bf16_t*)(F.ws + WS_WRLO);
    for (int i = (F.vcu * NWAVES + F.wave) * 64 + F.lane; i < NEXP * DM; i += NGW * 64) { const int e = i >> 10, k = i & 1023;
        const float v = ffn_g[k] * router_w[(size_t)k * NEXP + e]; const unsigned hb = pk2(v, 0.f) & 0xffffu; const float hf = __uint_as_float(hb << 16);
        wrh[i] = (bf16_t)hb; wrl[i] = (bf16_t)(pk2(v - hf, 0.f) & 0xffffu); }
}

__device__ __forceinline__ void p2_conv_block(Frame& F, int blk, int tid_, const float* conv_w) {
    const bf16_t* proj = (const bf16_t*)(F.ws + WS_PROJ); bf16_t* mix = (bf16_t*)(F.ws + WS_MIX);
    const int cg = tid_ & 31, tc = tid_ >> 5;
    const int c0 = cg * 8, t0 = blk * 256 + tc * 16, s0 = t0 & (SEQ - 1);
    float w0[8], w1[8], w2[8];
#pragma unroll
    for (int i = 0; i < 8; ++i) { w0[i] = conv_w[c0 + i]; w1[i] = conv_w[256 + c0 + i]; w2[i] = conv_w[512 + c0 + i]; }
    float p2[8], p1[8];
#pragma unroll
    for (int i = 0; i < 8; ++i) { p2[i] = 0.f; p1[i] = 0.f; }
    if (s0 >= 2) {
        const u32x4 ua = *(const u32x4*)(proj + (size_t)(t0 - 2) * INW + COL_U + c0), ca = *(const u32x4*)(proj + (size_t)(t0 - 2) * INW + COL_GC + c0);
        const u32x4 ub = *(const u32x4*)(proj + (size_t)(t0 - 1) * INW + COL_U + c0), cb = *(const u32x4*)(proj + (size_t)(t0 - 1) * INW + COL_GC + c0);
#pragma unroll
        for (int i = 0; i < 4; ++i) { p2[2 * i] = bflo(ua[i]) * bflo(ca[i]); p2[2 * i + 1] = bfhi(ua[i]) * bfhi(ca[i]); p1[2 * i] = bflo(ub[i]) * bflo(cb[i]); p1[2 * i + 1] = bfhi(ub[i]) * bfhi(cb[i]); }
    }
    for (int tt = 0; tt < 16; ++tt) {
        const size_t ro = (size_t)(t0 + tt) * INW;
        const u32x4 uu = *(const u32x4*)(proj + ro + COL_U + c0), cc = *(const u32x4*)(proj + ro + COL_GC + c0), bb = *(const u32x4*)(proj + ro + COL_GB + c0);
        float cur[8], y[8];
#pragma unroll
        for (int i = 0; i < 4; ++i) { cur[2 * i] = bflo(uu[i]) * bflo(cc[i]); cur[2 * i + 1] = bfhi(uu[i]) * bfhi(cc[i]); }
#pragma unroll
        for (int i = 0; i < 4; ++i) { y[2 * i] = bflo(bb[i]) * (w0[2 * i] * p2[2 * i] + w1[2 * i] * p1[2 * i] + w2[2 * i] * cur[2 * i]);
                                       y[2 * i + 1] = bfhi(bb[i]) * (w0[2 * i + 1] * p2[2 * i + 1] + w1[2 * i + 1] * p1[2 * i + 1] + w2[2 * i + 1] * cur[2 * i + 1]); }
        u32x4 o; o.x = pk2(y[0], y[1]); o.y = pk2(y[2], y[3]); o.z = pk2(y[4], y[5]); o.w = pk2(y[6], y[7]);
        *(u32x4*)(mix + (size_t)(t0 + tt) * DM + c0) = o;
#pragma unroll
        for (int i = 0; i < 8; ++i) { p2[i] = p1[i]; p1[i] = cur[i]; }
    }
}
__device__ __forceinline__ void p2_mem_block(Frame& F, int blk, int lane_) {
    const bf16_t* proj = (const bf16_t*)(F.ws + WS_PROJ); bf16_t* mix = (bf16_t*)(F.ws + WS_MIX);
    const bf16_t* kmb = (const bf16_t*)(F.ws + WS_KMB); const bf16_t* vmt = (const bf16_t*)(F.ws + WS_VMT);
    const int r32 = lane_ & 31, hi = lane_ >> 5, b = blk >> 5, tw = blk * 256 + F.wave * 32;
    for (int hm = 0; hm < 4; ++hm) {
        bf16x8 qr[4];
#pragma unroll
        for (int d0 = 0; d0 < 4; ++d0) qr[d0] = *(const bf16x8*)(proj + (size_t)(tw + r32) * INW + COL_QM + hm * 64 + d0 * 16 + hi * 8);
        float mx = -__builtin_inff();
#pragma unroll 1
        for (int kb = 0; kb < 8; ++kb) { f32x16 p = f32x16{};
#pragma unroll
            for (int d0 = 0; d0 < 4; ++d0) { const bf16x8 kf = *(const bf16x8*)(kmb + (size_t)(b * 256 + kb * 32 + r32) * 256 + hm * 64 + d0 * 16 + hi * 8);
                p = __builtin_amdgcn_mfma_f32_32x32x16_bf16(kf, qr[d0], p, 0, 0, 0); }
#pragma unroll
            for (int r = 0; r < 16; ++r) mx = fmaxf(mx, p[r]); }
        mx = fmaxf(mx, __shfl_xor(mx, 32));
        float sum = 0.f;
        f32x16 o[2]; o[0] = f32x16{}; o[1] = f32x16{};
#pragma unroll 1
        for (int kb = 0; kb < 8; ++kb) { f32x16 p = f32x16{};
#pragma unroll
            for (int d0 = 0; d0 < 4; ++d0) { const bf16x8 kf = *(const bf16x8*)(kmb + (size_t)(b * 256 + kb * 32 + r32) * 256 + hm * 64 + d0 * 16 + hi * 8);
                p = __builtin_amdgcn_mfma_f32_32x32x16_bf16(kf, qr[d0], p, 0, 0, 0); }
#pragma unroll
            for (int r = 0; r < 16; ++r) { p[r] = __builtin_amdgcn_exp2f(p[r] - mx); sum += p[r]; }
            bf16x8 pa0, pa1;
#define PK4(P, B_, OUT) do { unsigned a0 = pk2(P[B_+0], P[B_+1]), a1 = pk2(P[B_+2], P[B_+3]); unsigned b0 = pk2(P[B_+4], P[B_+5]), b1 = pk2(P[B_+6], P[B_+7]); \
        auto r0 = __builtin_amdgcn_permlane32_swap(a0, b0, false, false); auto r1 = __builtin_amdgcn_permlane32_swap(a1, b1, false, false); \
        u32x4 w = {r0[0], r1[0], r0[1], r1[1]}; OUT = __builtin_bit_cast(bf16x8, w); } while (0)
            PK4(p, 0, pa0); PK4(p, 8, pa1);
#undef PK4
#pragma unroll
            for (int d0 = 0; d0 < 2; ++d0) { const bf16_t* vp = vmt + ((size_t)((b * 4 + hm) * 64 + d0 * 32 + r32)) * 256 + kb * 32 + hi * 8;
                o[d0] = __builtin_amdgcn_mfma_f32_32x32x16_bf16(pa0, *(const bf16x8*)(vp), o[d0], 0, 0, 0);
                o[d0] = __builtin_amdgcn_mfma_f32_32x32x16_bf16(pa1, *(const bf16x8*)(vp + 16), o[d0], 0, 0, 0); }
        }
        sum += __shfl_xor(sum, 32);
        const float linv = __builtin_amdgcn_rcpf(sum);
#pragma unroll
        for (int r = 0; r < 16; ++r) { const int orow = crow(r, hi); const float li = __shfl(linv, orow);
#pragma unroll
            for (int d0 = 0; d0 < 2; ++d0) { const float v = o[d0][r] * li; const float vn = __shfl_xor(v, 1);
                if ((r32 & 1) == 0) *(unsigned*)(mix + (size_t)(tw + orow) * DM + 768 + hm * 64 + d0 * 32 + r32) = pk2(v, vn); } }
    }
}
__device__ __forceinline__ dattn::Ref da_ref(Frame& F, int n) {
    const int pid = F.vcu + (n >> 2) * F.G, sub = n & 3, blk = sub >> 1, comp = sub & 1, bh = pid >> 4, s = pid & 15, qb = blk ? 31 - s : s, b = bh >> 2, h = bh & 3;
    bf16_t* mix = (bf16_t*)(F.ws + WS_MIX);
    dattn::Ref r;
    r.qoff = (unsigned)(((size_t)(b * SEQ + qb * 256) * INW + COL_Q + h * 128 + comp * 64) * 2);
    r.koff = (unsigned)(((size_t)(b * SEQ) * INW + COL_K + h * 128 + comp * 64) * 2);
    r.voff = (unsigned)(((size_t)(b * SEQ) * INW + COL_V + h * 128) * 2);
    r.O = mix + (size_t)(b * SEQ + qb * 256) * DM + 256 + h * 128;
    r.P0 = qb * 256; r.comp = comp; r.h = h;
    return r;
}
__device__ __forceinline__ void p2_mixers(Frame& F) {
    KArgs A = kargs();
    const float* rel_bias = A->in[I_RELB]; const float* lam_qk = A->in[I_LAMQK]; const float* subln_g = A->in[I_SUBG];
    if (F.tid < 512) { const int h = F.tid >> 7, n = F.tid & 127; int bk;
        if (n < 16) bk = n; else { bk = 16; const int thr[15] = {19, 21, 24, 27, 31, 35, 40, 46, 52, 59, 67, 77, 87, 99, 113};
#pragma unroll
            for (int i = 0; i < 15; ++i) bk += (n >= thr[i]) ? 1 : 0; }
        ((LAS float*)(F.lds + dattn::OFF_TB))[h * 128 + n] = (rel_bias[bk * 4 + h] - rel_bias[31 * 4 + h]) * LOG2E; }
    float d1 = 0.f, d2 = 0.f;
    for (int i = 0; i < 64; ++i) { d1 += lam_qk[i] * lam_qk[64 + i]; d2 += lam_qk[128 + i] * lam_qk[192 + i]; }
    const float lam = __expf(d1) - __expf(d2) + 0.2f;
    __syncthreads();
    const int npairs = F.vcu < 512 ? (512 - F.vcu + F.G - 1) / F.G : 0, total1 = 4 * npairs, total = ((PROBE_REP >> 2) & 1) ? 2 * total1 : total1;
#if PROBE_CLK
    const unsigned long long pc0_ = __builtin_readcyclecounter(), pr0_ = __builtin_amdgcn_s_memrealtime();
#endif
    if (total > 0) {
        dattn::Seam S; dattn::Ref cur = da_ref(F, 0);
#if PROBE_SEG
        S.acc = 0; S.tot = 0;
#endif
        const dattn::rsrc_t R = __builtin_amdgcn_make_buffer_rsrc((void*)(F.ws + WS_PROJ), 0, (int)((size_t)T * INW * 2), 0x00020000);
        const char* projb = (const char*)(F.ws + WS_PROJ);
        dattn::prime(cur, F.lds, S, R, projb);
        for (int n = 0; n < total; ++n) {
            const dattn::Ref nxt = (n + 1 < total) ? da_ref(F, (n + 1) % total1) : cur;
            dattn::block(cur, nxt, F.lds, S, lam, subln_g, R, projb);
            cur = nxt;
        }
#if PROBE_SEG
        if (blockIdx.x == 0 && F.tid == 0) { F.ctl[604] = (unsigned)(S.acc >> 4); F.ctl[605] = (unsigned)(S.tot >> 4); }
#endif
    }
#if PROBE_CLK
    if (blockIdx.x == 0 && F.tid == 0) { const unsigned long long dc_ = __builtin_readcyclecounter() - pc0_, dr_ = __builtin_amdgcn_s_memrealtime() - pr0_;
        F.ctl[600] = (unsigned)dc_; F.ctl[601] = (unsigned)(dc_ >> 32); F.ctl[602] = (unsigned)dr_; }
#endif
    int lane2 = (int)__builtin_amdgcn_mbcnt_hi(~0u, __builtin_amdgcn_mbcnt_lo(~0u, 0u)); asm volatile("" : "+v"(lane2));
    const int tid2 = F.wave * 64 + lane2;
    const float* conv_w = kargs()->in[I_CONVW];
    for (int blk = blockIdx.x; blk < T / 256; blk += F.G) { p2_conv_block(F, blk, tid2, conv_w); p2_mem_block(F, blk, lane2); }
}

__device__ __forceinline__ void p4_router(Frame& F) {
    const float* router_b = kargs()->in[I_RB];
    const bf16_t* x1b = (const bf16_t*)(F.ws + WS_X1B); const bf16_t* wrh = (const bf16_t*)(F.ws + WS_WRHI); const bf16_t* wrl = (const bf16_t*)(F.ws + WS_WRLO);
    int* e_tk = (int*)(F.ws + WS_ETK); float* g_tk = (float*)(F.ws + WS_GTK); float* rstd_t = (float*)(F.ws + WS_RSTDT);
    LAS float* lg = (LAS float*)F.lds + F.wave * (32 * 33); LAS unsigned* hist = (LAS unsigned*)(F.lds + 8 * 32 * 33 * 4);
    const int r32 = F.lane & 31, hi = F.lane >> 5;
    for (int blk = blockIdx.x; blk < T / 256; blk += F.G) {
        if (F.tid < 32) hist[F.tid] = 0u;
        __syncthreads();
        const int t0 = blk * 256 + F.wave * 32;
        const bf16_t* xr = x1b + (size_t)(t0 + r32) * DM + hi * 8; const bf16_t* wh = wrh + (size_t)r32 * DM + hi * 8; const bf16_t* wl = wrl + (size_t)r32 * DM + hi * 8;
        f32x16 acc = f32x16{}; float ss = 0.f;
#pragma unroll 4
        for (int k0 = 0; k0 < DM; k0 += 16) {
            const u32x4 xw = *(const u32x4*)(xr + k0); const bf16x8 ah = *(const bf16x8*)(wh + k0), al = *(const bf16x8*)(wl + k0);
#pragma unroll
            for (int i = 0; i < 4; ++i) { const float a = bflo(xw[i]), b = bfhi(xw[i]); ss += a * a + b * b; }
            const bf16x8 xb = __builtin_bit_cast(bf16x8, xw);
            acc = __builtin_amdgcn_mfma_f32_32x32x16_bf16(ah, xb, acc, 0, 0, 0);
            acc = __builtin_amdgcn_mfma_f32_32x32x16_bf16(al, xb, acc, 0, 0, 0);
        }
        ss += __shfl_xor(ss, 32);
        const float rstd = rsqrtf(ss * (1.f / DM) + EPS);
#pragma unroll
        for (int r = 0; r < 16; ++r) { const int e = crow(r, hi); lg[r32 * 33 + e] = acc[r] * rstd + router_b[e]; }
        LDS_WAIT(); asm volatile("" ::: "memory");
        if (F.lane < 32) {
            LAS float* row = lg + F.lane * 33; float tv[4]; int ti[4];
#pragma unroll
            for (int p = 0; p < 4; ++p) { float best = -__builtin_inff(); int bi = 0;
                for (int e = 0; e < NEXP; ++e) { const float v = row[e]; if (v > best) { best = v; bi = e; } }
                tv[p] = best; ti[p] = bi; row[bi] = -__builtin_inff(); LDS_WAIT(); asm volatile("" ::: "memory"); }
            const float w1 = __expf(tv[1] - tv[0]), w2 = __expf(tv[2] - tv[0]), w3 = __expf(tv[3] - tv[0]); const float inv = 1.f / (1.f + w1 + w2 + w3);
            const int t = t0 + F.lane;
            *(int4*)(e_tk + (size_t)t * 4) = make_int4(ti[0], ti[1], ti[2], ti[3]);
            *(float4*)(g_tk + (size_t)t * 4) = make_float4(inv, w1 * inv, w2 * inv, w3 * inv);
            rstd_t[t] = rstd;
#pragma unroll
            for (int p = 0; p < 4; ++p) __hip_atomic_fetch_add(&hist[ti[p]], 1u, __ATOMIC_RELAXED, __HIP_MEMORY_SCOPE_WORKGROUP);
        }
        __syncthreads();
        if (F.tid < 32) __hip_atomic_fetch_add(F.ctl + CW_COUNT + F.tid, hist[F.tid], RLX_AGENT);
        __syncthreads();
    }
}
__device__ __forceinline__ void p5_place(Frame& F) {
    const int* e_tk = (const int*)(F.ws + WS_ETK); const float* g_tk = (const float*)(F.ws + WS_GTK); const float* rstd_t = (const float*)(F.ws + WS_RSTDT);
    int* slot_tk = (int*)(F.ws + WS_SLOTTK); int* tok_slot = (int*)(F.ws + WS_TOKSLOT); float* gate_slot = (float*)(F.ws + WS_GATESLOT); float* rstd_slot = (float*)(F.ws + WS_RSTDSLOT);
    int* rb_e = (int*)(F.ws + WS_RBE);
    LAS int* L = (LAS int*)F.lds;
    if (F.tid < 32) { const int c = (int)__hip_atomic_load(F.ctl + CW_COUNT + F.tid, RLX_AGENT); L[F.tid] = c; L[32 + F.tid] = (c + 255) & ~255; }
    __syncthreads();
    if (F.tid < 32) { int s = 0; for (int e = 0; e < F.tid; ++e) s += L[32 + e]; L[64 + F.tid] = s; }
    __syncthreads();
    for (int blk = blockIdx.x; blk < T / 256; blk += F.G) {
        if (F.tid < 32) { L[96 + F.tid] = 0; L[128 + F.tid] = 0; }
        __syncthreads();
        int ee[2];
#pragma unroll
        for (int j = 0; j < 2; ++j) { const int i = F.tid + 512 * j; ee[j] = e_tk[(size_t)blk * 1024 + i]; __hip_atomic_fetch_add(&L[96 + ee[j]], 1, __ATOMIC_RELAXED, __HIP_MEMORY_SCOPE_WORKGROUP); }
        __syncthreads();
        if (F.tid < 32) L[160 + F.tid] = L[64 + F.tid] + (int)__hip_atomic_fetch_add(F.ctl + CW_CURSOR + F.tid, (unsigned)L[96 + F.tid], RLX_AGENT);
        __syncthreads();
#pragma unroll
        for (int j = 0; j < 2; ++j) { const int i = F.tid + 512 * j; const int r = __hip_atomic_fetch_add(&L[128 + ee[j]], 1, __ATOMIC_RELAXED, __HIP_MEMORY_SCOPE_WORKGROUP); const int pos = L[160 + ee[j]] + r;
            const int t = blk * 256 + (i >> 2);
            tok_slot[pos] = t; gate_slot[pos] = g_tk[(size_t)blk * 1024 + i]; rstd_slot[pos] = rstd_t[t]; slot_tk[(size_t)blk * 1024 + i] = pos; }
        __syncthreads();
    }
    for (int e = blockIdx.x; e < NEXP; e += F.G)
        for (int i = L[e] + F.tid; i < L[32 + e]; i += NWAVES * 64) { const int pos = L[64 + e] + i; tok_slot[pos] = 0; gate_slot[pos] = 0.f; rstd_slot[pos] = 0.f; }
    if (blockIdx.x == 0) {
        const int nrb = (L[64 + 31] + L[32 + 31]) >> 8;
        for (int rb = F.tid; rb < NRB_MAX; rb += NWAVES * 64) { int e = 31; for (int q = 0; q < 32; ++q) { if (rb * 256 >= L[64 + q] && rb * 256 < L[64 + q] + L[32 + q]) e = q; } rb_e[rb] = e; }
        if (F.tid == 0) rb_e[NRB_MAX] = nrb;
    }
}
__device__ __forceinline__ void p9_final(Frame& F) {
    const bf16_t* x1b = (const bf16_t*)(F.ws + WS_X1B); const int* slot_tk = (const int*)(F.ws + WS_SLOTTK);
    const bf16_t* Y = (const bf16_t*)(F.ws + WS_Y);
    const int gw = F.vcu * NWAVES + F.wave, NGW = F.G * NWAVES;
    const float* final_g = kargs()->in[I_FING];
    for (int t = gw; t < T; t += NGW) {
        const int4 sl = *(const int4*)(slot_tk + (size_t)t * 4);
        const int s4[4] = {sl.x, sl.y, sl.z, sl.w};
        float v[2][8]; float ss = 0.f;
#pragma unroll
        for (int j = 0; j < 2; ++j) { const int c = 8 * F.lane + 512 * j;
            const u32x4 a = *(const u32x4*)(x1b + (size_t)t * DM + c);
#pragma unroll
            for (int i = 0; i < 4; ++i) { v[j][2 * i] = bflo(a[i]); v[j][2 * i + 1] = bfhi(a[i]); }
#pragma unroll
            for (int k = 0; k < 4; ++k) { const int s = s4[k]; const bf16_t* yp = Y + (size_t)s * DM + c;
                const u32x4 y = *(const u32x4*)yp;
#pragma unroll
                for (int i = 0; i < 4; ++i) { v[j][2 * i] += bflo(y[i]); v[j][2 * i + 1] += bfhi(y[i]); } }
#pragma unroll
            for (int i = 0; i < 8; ++i) ss += v[j][i] * v[j][i]; }
        const float rstd = rsqrtf(wave_sum(ss) * (1.f / DM) + EPS);
#pragma unroll
        for (int j = 0; j < 2; ++j) { const int c = 8 * F.lane + 512 * j;
            const f32x4 g0 = *(const f32x4*)(final_g + c), g1 = *(const f32x4*)(final_g + c + 4);
            f32x4 o0, o1; o0.x = v[j][0] * rstd * g0.x; o0.y = v[j][1] * rstd * g0.y; o0.z = v[j][2] * rstd * g0.z; o0.w = v[j][3] * rstd * g0.w;
            o1.x = v[j][4] * rstd * g1.x; o1.y = v[j][5] * rstd * g1.y; o1.z = v[j][6] * rstd * g1.z; o1.w = v[j][7] * rstd * g1.w;
            *(f32x4*)(F.out + (size_t)t * DM + c) = o0; *(f32x4*)(F.out + (size_t)t * DM + c + 4) = o1; }
    }
}

__global__ void __launch_bounds__(NWAVES * 64, 2) hymba_fwd(Args args) {
    extern __shared__ __attribute__((aligned(16))) unsigned char lds[];
    Frame F;
    F.lds = (LAS unsigned char*)lds;
    F.MISC = (volatile LAS unsigned*)(F.lds + MISC_OFF);
    F.tid = threadIdx.x; F.lane = F.tid & 63; F.wave = __builtin_amdgcn_readfirstlane(F.tid >> 6);
    F.G = gridDim.x; { const int bx = blockIdx.x; F.vcu = (F.G % 8 == 0) ? (bx % 8) * (F.G / 8) + bx / 8 : bx; }
    F.ws = args.ws; F.ctl = (unsigned*)(args.ws + WS_CTL); F.out = args.out;
    for (int u = F.tid; u < (LDS_BYTES - LDSCTL_OFF) / 4; u += NWAVES * 64) ((LAS unsigned*)(F.lds + LDSCTL_OFF))[u] = 0u;
    __syncthreads();
    XcdBarrier bar; bar.bar = F.ctl + CW_BAR; bar.x = 0; bar.st = nullptr;
    if (N_LAUNCHES == 1) bar = xcd_barrier_post(F.ctl + CW_BAR, F.MISC + 8);
#define GRID_BAR() do { if (N_LAUNCHES == 1) xcd_barrier(bar); } while (0)
    const int lo = args.ph_lo, hi = args.ph_hi;
#ifndef PH_MASK
#define PH_MASK 0x1ff
#endif
#define IN(k) (((PH_MASK >> (k)) & 1) && lo <= (k) && (k) < hi)
#define BOTH(k) (IN(k) && IN((k) + 1))
    bf16_t* const H = (bf16_t*)(F.ws + WS_H); bf16_t* const PROJ = (bf16_t*)(F.ws + WS_PROJ); bf16_t* const MIX = (bf16_t*)(F.ws + WS_MIX); bf16_t* const X1B = (bf16_t*)(F.ws + WS_X1B);
    bf16_t* const Win_t = (bf16_t*)(F.ws + WS_WIN); bf16_t* const Wout_t = (bf16_t*)(F.ws + WS_WOUT);
    const unsigned char* const Wgu_q = (const unsigned char*)F.out + OUT_WGU; const unsigned char* const Wd_q = (const unsigned char*)F.out + OUT_WD;
    unsigned char* const X1Q = F.ws + WS_X1Q; unsigned char* const ACTQ = F.ws + WS_ACTQ; bf16_t* const Yp = (bf16_t*)(F.ws + WS_Y);
    const int* const tok_slot = (const int*)(F.ws + WS_TOKSLOT); const float* const gate_slot = (const float*)(F.ws + WS_GATESLOT); const float* const rstd_slot = (const float*)(F.ws + WS_RSTDSLOT);
    const int* const rb_e = (const int*)(F.ws + WS_RBE);

#define REP(k) for (int rep_ = 0; rep_ < (((PROBE_REP >> (k)) & 1) ? 2 : 1); ++rep_)
    if (IN(0)) { REP(0) p0_prologue(F); if (BOTH(0)) GRID_BAR(); }
    if (IN(1)) {
        REP(1) {
        pg8::Gemm g{H, Win_t, DM, 0, nullptr}; pg8::StaticOrder S; S.init(T, INW, F.G, (int)blockIdx.x);
        pg8::EpiProj E{PROJ};
        pg8::gemm_phase<pg8::EpiProj, pg8::StaticOrder, true>(F.lds, g, S, E); }
        if (BOTH(1)) GRID_BAR();
    }
    if (IN(2)) { p2_mixers(F); if (BOTH(2)) GRID_BAR(); }
    if (IN(3)) {
        pg8::Gemm g{MIX, Wout_t, DM, 0, nullptr}; pg8::StaticOrder S; S.init(T, DM, F.G, (int)blockIdx.x);
        pg8::EpiX1 E{kargs()->in[I_X], X1B, X1Q};
        pg8::gemm_phase<pg8::EpiX1, pg8::StaticOrder, true>(F.lds, g, S, E);
        if (BOTH(3)) GRID_BAR();
    }
    if (IN(4)) { p4_router(F); if (BOTH(4)) GRID_BAR(); }
    if (IN(5)) { p5_place(F); if (BOTH(5)) GRID_BAR(); }
    if (IN(6)) {
        const int nrb = rb_e[NRB_MAX];
        REP(6) {
        pg8::Gemm g{(const bf16_t*)X1Q, (const bf16_t*)Wgu_q, DM / 2, (long)2048 * DM / 2, tok_slot}; pg8::GroupOrder S{nrb, 0, 8, F.G, (int)blockIdx.x, rb_e};
        pg8::EpiGU E{ACTQ, kargs()->in[I_BGU], rstd_slot};
        pg8::gemm_phase<pg8::EpiGU, pg8::GroupOrder, true, true, (PROBE_KREP == 2 ? 0x78787878 : 0x79797979), 0x7f7f7f7f, PROBE_KREP>(F.lds, g, S, E); }
        if (BOTH(6)) GRID_BAR();
    }
    if (IN(7)) {
        const int nrb = rb_e[NRB_MAX];
        REP(7) {
        pg8::Gemm g{(const bf16_t*)ACTQ, (const bf16_t*)Wd_q, DEXP / 2, (long)DM * DEXP / 2, nullptr}; pg8::GroupOrder S{nrb, 0, 4, F.G, (int)blockIdx.x, rb_e};
        pg8::EpiDown E{Yp, kargs()->in[I_BDN], gate_slot};
        pg8::gemm_phase<pg8::EpiDown, pg8::GroupOrder, true, true, 0x79797979, 0x7d7d7d7d>(F.lds, g, S, E); }
        if (BOTH(7)) GRID_BAR();
    }
    if (IN(8)) { REP(8) p9_final(F); }
#if PROBE_SEG
    if (IN(8) && blockIdx.x == 0 && F.tid == 0) { const unsigned long long a_ = F.ctl[604], t_ = F.ctl[605]; const unsigned long long us_ = t_ ? a_ * 2000ull / t_ : 0ull; const unsigned long long t0_ = __builtin_amdgcn_s_memrealtime();
        while (__builtin_amdgcn_s_memrealtime() - t0_ < us_ * 100ull) __builtin_amdgcn_s_sleep(8); }
#endif
#if PROBE_CLK
    if (IN(8) && blockIdx.x == 0 && F.tid == 0) { const unsigned long long dc_ = ((unsigned long long)F.ctl[601] << 32) | F.ctl[600]; const unsigned long long dr_ = F.ctl[602];
        const unsigned long long mhz_ = dr_ ? dc_ * 100ull / dr_ : 0ull; const unsigned long long t0_ = __builtin_amdgcn_s_memrealtime();
        while (__builtin_amdgcn_s_memrealtime() - t0_ < mhz_ * 100ull) __builtin_amdgcn_s_sleep(8); }
#endif
#undef IN
#undef BOTH
#undef GRID_BAR
}

extern "C" void kernel_launch(void* const* d_in, const int* in_sizes, int n_in, void* d_out, int out_size, void* d_ws, size_t ws_size, hipStream_t stream) {
    static int grid = 0;
    if (grid == 0) {
        if (n_in != 19 || out_size != T * DM || ws_size < WS_END) { fprintf(stderr, "kernel_launch: unexpected shapes (n_in %d out %d ws %zu)\n", n_in, out_size, ws_size); grid = -1; return; }
        int dev = 0, cus = 0;
        if (hipGetDevice(&dev) != hipSuccess || hipDeviceGetAttribute(&cus, hipDeviceAttributeMultiprocessorCount, dev) != hipSuccess) { grid = -1; return; }
        if (hipFuncSetAttribute((const void*)hymba_fwd, hipFuncAttributeMaxDynamicSharedMemorySize, LDS_BYTES) != hipSuccess) { fprintf(stderr, "kernel_launch: hipFuncSetAttribute failed\n"); grid = -1; return; }
        int per_cu = 0;
        if (hipOccupancyMaxActiveBlocksPerMultiprocessor(&per_cu, (const void*)hymba_fwd, NWAVES * 64, LDS_BYTES) != hipSuccess || per_cu < 1) fprintf(stderr, "kernel_launch: occupancy query reports %d\n", per_cu);
        (void)hipGetLastError();
        grid = cus;
    }
    if (grid < 0) return;
    if (hipMemsetAsync((char*)d_ws + WS_CTL, 0, CTL_ZERO_BYTES, stream) != hipSuccess) return;
    Args a{};
    for (int i = 0; i < 19; ++i) a.in[i] = (const float*)d_in[i];
    a.out = (float*)d_out; a.ws = (unsigned char*)d_ws;
    for (int li = 0; li < N_LAUNCHES; ++li) {
        a.ph_lo = (N_LAUNCHES == 1) ? 0 : li; a.ph_hi = (N_LAUNCHES == 1) ? N_PHASES : li + 1;
        hipLaunchKernelGGL(hymba_fwd, dim3(grid), dim3(NWAVES * 64), LDS_BYTES, stream, a);
    }
}
```

```cpp
#include <hip/hip_runtime.h>
#include <hip/hip_bf16.h>
#include <cstdio>
#include <cstdint>

#ifndef PROBE_REP
#define PROBE_REP 0
#endif
#ifndef PROBE_X
#define PROBE_X 0
#endif
#ifndef PROBE_P0
#define PROBE_P0 0
#endif
#ifndef PROBE_SEG
#define PROBE_SEG 0
#endif
#ifndef PROBE_CLK
#define PROBE_CLK 0
#endif
#ifndef PROBE_KREP
#define PROBE_KREP 1
#endif
#ifndef PROBE_EPI
#define PROBE_EPI 0
#endif
#ifndef MK_N_LAUNCHES
#define MK_N_LAUNCHES 1
#endif

constexpr int BATCH = 8, SEQ = 8192, DM = 1024, T = BATCH * SEQ, INW = 2560, MEML = 256, NEXP = 32, TOPK = 4, DEXP = 1024;
constexpr int COL_U = 0, COL_GB = 256, COL_GC = 512, COL_Q = 768, COL_K = 1280, COL_V = 1792, COL_QM = 2304;
constexpr float EPS = 1e-5f;
constexpr float C2 = 0.125f * 1.4426950408889634f;
constexpr float LOG2E = 1.4426950408889634f;
constexpr int NRB_MAX = 1056;

#define GAS __attribute__((address_space(1)))
#define LAS __attribute__((address_space(3)))
typedef unsigned short bf16_t;
typedef short bf16x8 __attribute__((ext_vector_type(8)));
typedef short s16x4 __attribute__((ext_vector_type(4)));
typedef float f32x4 __attribute__((ext_vector_type(4)));
typedef float f32x16 __attribute__((ext_vector_type(16)));
typedef unsigned u32x4 __attribute__((ext_vector_type(4)));
typedef unsigned u32x2 __attribute__((ext_vector_type(2)));
typedef float f32x2_t __attribute__((ext_vector_type(2)));
typedef __bf16 bf16x2_t __attribute__((ext_vector_type(2)));
typedef GAS unsigned gu32;
#define RLX_AGENT __ATOMIC_RELAXED, __HIP_MEMORY_SCOPE_AGENT
#define LDS_WAIT() asm volatile("s_waitcnt lgkmcnt(0)" ::: "memory")
#define VM_WAIT() asm volatile("s_waitcnt vmcnt(0)" ::: "memory")
#define SBAR() __builtin_amdgcn_sched_barrier(0)

__device__ __forceinline__ unsigned pk2(float lo, float hi) { f32x2_t v = {lo, hi}; bf16x2_t b = __builtin_convertvector(v, bf16x2_t); return __builtin_bit_cast(unsigned, b); }
__device__ __forceinline__ float bflo(unsigned u) { return __uint_as_float(u << 16); }
__device__ __forceinline__ float bfhi(unsigned u) { return __uint_as_float(u & 0xffff0000u); }
__device__ __forceinline__ bf16x8 pack8(f32x4 a, f32x4 b) { u32x4 w = {pk2(a[0], a[1]), pk2(a[2], a[3]), pk2(b[0], b[1]), pk2(b[2], b[3])}; return __builtin_bit_cast(bf16x8, w); }
__device__ __forceinline__ int crow(int r, int hi) { return (r & 3) + 8 * (r >> 2) + 4 * hi; }
__device__ __forceinline__ float wave_sum(float v) {
#pragma unroll
    for (int o = 1; o < 64; o <<= 1) v += __shfl_xor(v, o);
    return v;
}

namespace pg8 {
constexpr int BM = 256, BK = 64, HALF = 128, HTB = HALF * BK * 2  , STAGE_BYTES = 8 * HTB, NXCD = 8, WGM = 8;
__host__ __device__ __forceinline__ int lds_byte(int r, int c) { const int st = (r >> 4) * 2 + (c >> 5), rr = r & 15, cc = c & 31, ob = rr * 64 + cc * 2; return st * 1024 + (ob ^ (((ob >> 9) & 1) << 5)); }
__host__ __device__ __forceinline__ void stage_rc(int b, int& R, int& C) { const int st = b / 1024, sb = b % 1024, swz = sb ^ (((sb >> 9) & 1) << 5); R = (st >> 1) * 16 + swz / 64; C = (st & 1) * 32 + (swz % 64) / 2; }
__host__ __device__ __forceinline__ int perm32(int rho) { const int n = rho >> 4, i = rho & 15; return 8 * (i >> 2) + 4 * n + (i & 3); }

struct Unit { int pm, pn, e; };
struct Gemm { const bf16_t* A; const bf16_t* Bt; int K; long bstride; const int* rowmap; };

struct StaticOrder {
    int nM, nN, nwg, G, c;
    __device__ void init(int M, int N, int G_, int c_) { nM = M / BM; nN = N / BM; nwg = nM * nN; G = G_; c = c_; }
    __device__ bool next(int i, Unit& u) const {
        const long L = (long)i * G + c; if (L >= nwg) return false;
        int wgid = (int)L; { const int q = nwg / NXCD, r = nwg % NXCD, xcd = wgid % NXCD, off = wgid / NXCD; wgid = (xcd < r ? xcd * (q + 1) : r * (q + 1) + (xcd - r) * q) + off; }
        const int nig = WGM * nN, gid = wgid / nig, fm = gid * WGM, gsz = (nM - fm) < WGM ? (nM - fm) : WGM;
        u.pm = fm + ((wgid % nig) % gsz); u.pn = (wgid % nig) / gsz; u.e = 0; return true;
    }
};
struct GroupOrder {
    int nrb, rb0, npn, G, c; const int* rb_e;
    __device__ bool next(int i, Unit& u) const {
        int rbl, pn;
        if ((G & 7) == 0 && ((G >> 3) % npn) == 0) { const int x = c & 7, j = c >> 3, rpx = (G >> 3) / npn; rbl = i * (G / npn) + x * rpx + j / npn; pn = j % npn; }
        else { const long L = (long)i * G + c; rbl = (int)(L / npn); pn = (int)(L % npn); }
        if (rbl >= nrb) return false;
        u.pm = rb0 + rbl; u.pn = pn; u.e = rb_e[u.pm]; return true;
    }
};

typedef int v4i_t __attribute__((ext_vector_type(4)));
typedef int v8i_t __attribute__((ext_vector_type(8)));
template <class Epi, class Sched, bool ALIGN_EPI, bool FP8 = false, int SCW = 0x7f7f7f7f, int SCA = 0x7f7f7f7f, int KREP = 1>
__device__ __forceinline__ void gemm_phase(LAS unsigned char* lds, const Gemm g, const Sched& S, const Epi& E) {
    const int tid = threadIdx.x, wid = __builtin_amdgcn_readfirstlane(tid >> 6), lane = tid & 63, wr = wid >> 2, wc = wid & 3, fr = lane & 15, fq = lane >> 4;
    const int K = g.K; int nt = K / BK; asm volatile("" : "+s"(nt));
    int Rr[2], Cc[2]; unsigned voffB[2];
#pragma unroll
    for (int i = 0; i < 2; ++i) { int R, C; stage_rc(tid * 16 + i * 8192, R, C); const int Rb = Epi::PERM ? ((R & ~31) + perm32(R & 31)) : R;
        Rr[i] = R; Cc[i] = C; voffB[i] = (unsigned)(Rb * K + C) * 2u; }
    const size_t kstep = (size_t)(BK * 2);
    const size_t hstep = (size_t)HALF * K * 2;
    const size_t tstep = 2 * hstep;
    const unsigned ldsw = (unsigned)wid * 1024u;
    const int aoff = lds_byte(wr * 64 + fr, fq * 8), boff = lds_byte(wc * 32 + fr, fq * 8);
#define PG8_SA(b, h) (((b) * 2 + (h)) * HTB)
#define PG8_SB(b, h) ((4 + (b) * 2 + (h)) * HTB)
#define PG8_STAGE(bufoff, gbase, voff) do { _Pragma("unroll") for (int _i = 0; _i < 2; ++_i) \
        __builtin_amdgcn_global_load_lds((const unsigned*)((const char*)(gbase) + (voff)[_i]), (LAS unsigned*)(lds + (bufoff) + ldsw + _i * 8192), 16, 0, 0); } while (0)
#define PG8_STAGE_A(bufoff, kptr, offs, h) do { _Pragma("unroll") for (int _i = 0; _i < 2; ++_i) \
        __builtin_amdgcn_global_load_lds((const unsigned*)((const char*)(kptr) + (offs)[h][_i]), (LAS unsigned*)(lds + (bufoff) + ldsw + _i * 8192), 16, 0, 0); } while (0)
#define PG8_AOFF(dst, u) do { _Pragma("unroll") for (int _h = 0; _h < 2; ++_h) _Pragma("unroll") for (int _i = 0; _i < 2; ++_i) { const int _row = (u).pm * BM + _h * HALF + Rr[_i]; \
        const int _src = g.rowmap ? g.rowmap[_row] : _row; dst[_h][_i] = (unsigned)(_src * K + Cc[_i]) * 2u; } } while (0)
#define PG8_LDA(dst, b, h) do { _Pragma("unroll") for (int m = 0; m < 4; ++m) _Pragma("unroll") for (int k = 0; k < 2; ++k) dst[m][k] = *(const LAS bf16x8*)(lds + PG8_SA(b, h) + aoff + m * 2048 + k * 1024); } while (0)
#define PG8_LDB(dst, b, h) do { _Pragma("unroll") for (int n = 0; n < 2; ++n) _Pragma("unroll") for (int k = 0; k < 2; ++k) dst[n][k] = *(const LAS bf16x8*)(lds + PG8_SB(b, h) + boff + n * 2048 + k * 1024); } while (0)
#define PG8_CAT(x, y) __builtin_shufflevector(__builtin_bit_cast(v4i_t, x), __builtin_bit_cast(v4i_t, y), 0, 1, 2, 3, 4, 5, 6, 7)
#define PG8_MMA(ai, bj, At, Bt) do { __builtin_amdgcn_s_setprio(1); _Pragma("unroll") for (int m = 0; m < 4; ++m) _Pragma("unroll") for (int n = 0; n < 2; ++n) { \
        if constexpr (FP8) { acc[ai][bj][m][n] = __builtin_amdgcn_mfma_scale_f32_16x16x128_f8f6f4(PG8_CAT(Bt[n][0], Bt[n][1]), PG8_CAT(At[m][0], At[m][1]), acc[ai][bj][m][n], 0, 0, 0, SCW, 0, SCA); } \
        else { _Pragma("unroll") for (int k = 0; k < 2; ++k) acc[ai][bj][m][n] = __builtin_amdgcn_mfma_f32_16x16x32_bf16(Bt[n][k], At[m][k], acc[ai][bj][m][n], 0, 0, 0); } } \
        __builtin_amdgcn_s_setprio(0); } while (0)
#define PG8_WAIT_V(n) asm volatile("s_waitcnt vmcnt(" #n ")" ::: "memory")
#define PG8_WAIT_L(n) asm volatile("s_waitcnt lgkmcnt(" #n ")" ::: "memory")
#define PG8_BAR __builtin_amdgcn_s_barrier()
#define PG8_SCHED __builtin_amdgcn_sched_barrier(0)
    Unit cur, nxt; int ui = 0;
    if (!S.next(0, cur)) return;
    f32x4 acc[2][2][4][2];
#pragma unroll
    for (int a = 0; a < 2; ++a)
#pragma unroll
        for (int b = 0; b < 2; ++b)
#pragma unroll
            for (int m = 0; m < 4; ++m)
#pragma unroll
                for (int n = 0; n < 2; ++n) acc[a][b][m][n] = (f32x4){0.f, 0.f, 0.f, 0.f};
    bf16x8 At[4][2], B0[2][2], B1[2][2];
    unsigned aoc[2][2], aon[2][2];
    PG8_AOFF(aoc, cur);
    const char* Ab = (const char*)g.A;
    const char* cB = (const char*)g.Bt + ((size_t)cur.e * (size_t)g.bstride) * 2 + (size_t)cur.pn * tstep;
    PG8_STAGE(PG8_SB(0, 0), cB, voffB); PG8_STAGE(PG8_SB(0, 1), cB + hstep, voffB); PG8_STAGE_A(PG8_SA(0, 0), Ab, aoc, 0); PG8_STAGE_A(PG8_SA(0, 1), Ab, aoc, 1);
    if (wr == 1) PG8_BAR;
    PG8_WAIT_V(2); PG8_BAR;
    PG8_STAGE(PG8_SB(1, 0), cB + kstep, voffB); PG8_STAGE_A(PG8_SA(1, 0), Ab + kstep, aoc, 0); PG8_STAGE(PG8_SB(1, 1), cB + hstep + kstep, voffB);
    PG8_WAIT_V(6); PG8_BAR;
    for (;;) {
        const bool has_next = S.next(ui + 1, nxt);
        if (has_next) { PG8_AOFF(aon, nxt); }
        else {
#pragma unroll
            for (int h = 0; h < 2; ++h)
#pragma unroll
                for (int i = 0; i < 2; ++i) aon[h][i] = aoc[h][i];
        }
        const char* nB = has_next ? (const char*)g.Bt + ((size_t)nxt.e * (size_t)g.bstride) * 2 + (size_t)nxt.pn * tstep : cB;
#pragma nounroll
        for (int t = 0; t < nt * KREP; t += 2) {
            const bool last = (t == nt * KREP - 2);
            const char* a1 = Ab + (size_t)((t + 1) & (nt - 1)) * kstep;
            const char* a2 = last ? Ab : Ab + (size_t)((t + 2) & (nt - 1)) * kstep; const char* b2 = last ? nB : cB + (size_t)((t + 2) & (nt - 1)) * kstep;
            const char* a3 = a2 + kstep; const char* b3 = b2 + kstep;
            PG8_LDB(B0, 0, 0); PG8_LDB(B1, 0, 1); PG8_SCHED; PG8_LDA(At, 0, 0); PG8_STAGE_A(PG8_SA(1, 1), a1, aoc, 1);
            if (last) {
#pragma unroll
                for (int h = 0; h < 2; ++h)
#pragma unroll
                    for (int i = 0; i < 2; ++i) aoc[h][i] = aon[h][i]; }
            PG8_WAIT_V(8); PG8_WAIT_L(0); PG8_BAR; PG8_MMA(0, 0, At, B0); PG8_MMA(0, 1, At, B1); PG8_BAR; PG8_SCHED;
            PG8_LDA(At, 0, 1); PG8_STAGE(PG8_SB(0, 0), b2, voffB); PG8_STAGE(PG8_SB(0, 1), b2 + hstep, voffB); PG8_STAGE_A(PG8_SA(0, 0), a2, aoc, 0);
            PG8_WAIT_V(8); PG8_WAIT_L(0); PG8_BAR; PG8_MMA(1, 0, At, B0); PG8_MMA(1, 1, At, B1); PG8_BAR; PG8_SCHED;
            PG8_LDB(B0, 1, 0); PG8_LDB(B1, 1, 1); PG8_SCHED; PG8_LDA(At, 1, 0); PG8_STAGE_A(PG8_SA(0, 1), a2, aoc, 1);
            PG8_WAIT_V(8); PG8_WAIT_L(0); PG8_BAR; PG8_MMA(0, 0, At, B0); PG8_MMA(0, 1, At, B1); PG8_BAR; PG8_SCHED;
            PG8_LDA(At, 1, 1); PG8_STAGE(PG8_SB(1, 0), b3, voffB); PG8_STAGE(PG8_SB(1, 1), b3 + hstep, voffB); PG8_STAGE_A(PG8_SA(1, 0), a3, aoc, 0);
            PG8_WAIT_V(8); PG8_WAIT_L(0); PG8_BAR; PG8_MMA(1, 0, At, B0); PG8_MMA(1, 1, At, B1); PG8_BAR; PG8_SCHED;
        }
        if constexpr (ALIGN_EPI) { if (wr == 0) PG8_BAR; }
        E(acc, cur, wr, wc, fr, fq);
        if constexpr (FP8 && PROBE_EPI != 0) { asm volatile("" ::: "memory"); E(acc, cur, wr, wc, fr, fq); }
        if (!has_next) break;
#pragma unroll
        for (int a = 0; a < 2; ++a)
#pragma unroll
            for (int b = 0; b < 2; ++b)
#pragma unroll
                for (int m = 0; m < 4; ++m)
#pragma unroll
                    for (int n = 0; n < 2; ++n) acc[a][b][m][n] = (f32x4){0.f, 0.f, 0.f, 0.f};
        cur = nxt; cB = nB; ++ui;
        if constexpr (ALIGN_EPI) { if (wr == 1) PG8_BAR; }
    }
    PG8_WAIT_V(0);
    if constexpr (!ALIGN_EPI) { if (wr == 0) PG8_BAR; }
    PG8_BAR;
#undef PG8_SA
#undef PG8_SB
#undef PG8_STAGE
#undef PG8_STAGE_A
#undef PG8_AOFF
#undef PG8_LDA
#undef PG8_LDB
#undef PG8_MMA
#undef PG8_CAT
#undef PG8_WAIT_V
#undef PG8_WAIT_L
#undef PG8_BAR
#undef PG8_SCHED
}

struct EpiProj {
    static constexpr bool PERM = true;
    bf16_t* O;
    __device__ __forceinline__ void operator()(const f32x4 (&acc)[2][2][4][2], const Unit& u, int wr, int wc, int fr, int fq) const {
        const int row0 = u.pm * BM + wr * 64 + fr, col0 = u.pn * BM + wc * 32 + 8 * fq;
        const float sc = (u.pn == 3 || u.pn == 4 || u.pn == 9) ? C2 : 1.f;
#pragma unroll
        for (int ai = 0; ai < 2; ++ai)
#pragma unroll
            for (int m = 0; m < 4; ++m) { bf16_t* rowp = O + (size_t)(row0 + ai * HALF + m * 16) * INW + col0;
#pragma unroll
                for (int bj = 0; bj < 2; ++bj) { const f32x4 v0 = acc[ai][bj][m][0] * sc, v1 = acc[ai][bj][m][1] * sc;
                    u32x4 w; w.x = pk2(v0[0], v0[1]); w.y = pk2(v0[2], v0[3]); w.z = pk2(v1[0], v1[1]); w.w = pk2(v1[2], v1[3]);
                    *(u32x4*)(rowp + bj * HALF) = w; } }
    }
};
__device__ __forceinline__ unsigned pk4_fp8(float a, float b, float c, float d) { int w = 0; w = __builtin_amdgcn_cvt_pk_fp8_f32(a, b, w, false); w = __builtin_amdgcn_cvt_pk_fp8_f32(c, d, w, true); return (unsigned)w; }
struct EpiX1 {
    static constexpr bool PERM = true;
    const float* X; bf16_t* O; unsigned char* Q8;
    __device__ __forceinline__ void operator()(const f32x4 (&acc)[2][2][4][2], const Unit& u, int wr, int wc, int fr, int fq) const {
        const int row0 = u.pm * BM + wr * 64 + fr, col0 = u.pn * BM + wc * 32 + 8 * fq;
#pragma unroll
        for (int ai = 0; ai < 2; ++ai)
#pragma unroll
            for (int m = 0; m < 4; ++m) { const size_t off = (size_t)(row0 + ai * HALF + m * 16) * DM + col0;
#pragma unroll
                for (int bj = 0; bj < 2; ++bj) { const f32x4 x0 = *(const f32x4*)(X + off + bj * HALF), x1 = *(const f32x4*)(X + off + bj * HALF + 4);
                    const f32x4 v0 = acc[ai][bj][m][0] + x0, v1 = acc[ai][bj][m][1] + x1;
                    u32x4 w; w.x = pk2(v0[0], v0[1]); w.y = pk2(v0[2], v0[3]); w.z = pk2(v1[0], v1[1]); w.w = pk2(v1[2], v1[3]);
                    *(u32x4*)(O + off + bj * HALF) = w;
                    u32x2 q; q.x = pk4_fp8(v0[0], v0[1], v0[2], v0[3]); q.y = pk4_fp8(v1[0], v1[1], v1[2], v1[3]);
                    *(u32x2*)(Q8 + off + bj * HALF) = q; } }
    }
};
struct EpiGU {
    static constexpr bool PERM = true;
    unsigned char* ACT; const float* bias; const float* rstd;
    __device__ __forceinline__ void operator()(const f32x4 (&acc)[2][2][4][2], const Unit& u, int wr, int wc, int fr, int fq) const {
        const int row0 = u.pm * BM + wr * 64 + fr, j0 = u.pn * HALF + wc * 32 + 8 * fq;
        const float* bp = bias + (size_t)u.e * 2048 + j0;
        const f32x4 bg0 = *(const f32x4*)(bp), bg1 = *(const f32x4*)(bp + 4), bu0 = *(const f32x4*)(bp + 1024), bu1 = *(const f32x4*)(bp + 1028);
#pragma unroll
        for (int ai = 0; ai < 2; ++ai)
#pragma unroll
            for (int m = 0; m < 4; ++m) { const int row = row0 + ai * HALF + m * 16; const float rs = rstd[row];
                f32x4 g0 = acc[ai][0][m][0] * rs + bg0, g1 = acc[ai][0][m][1] * rs + bg1, u0 = acc[ai][1][m][0] * rs + bu0, u1 = acc[ai][1][m][1] * rs + bu1;
                float o[8];
#pragma unroll
                for (int i = 0; i < 4; ++i) {
                    { const float gg = fminf(g0[i], 7.f), uu = __builtin_amdgcn_fmed3f(u0[i], -7.f, 7.f); const float s4 = gg * __builtin_amdgcn_rcpf(fmaf(__builtin_amdgcn_exp2f(-1.702f * LOG2E * gg), 0.25f, 0.25f)); o[i] = fmaf(uu, s4, s4); }
                    { const float gg = fminf(g1[i], 7.f), uu = __builtin_amdgcn_fmed3f(u1[i], -7.f, 7.f); const float s4 = gg * __builtin_amdgcn_rcpf(fmaf(__builtin_amdgcn_exp2f(-1.702f * LOG2E * gg), 0.25f, 0.25f)); o[4 + i] = fmaf(uu, s4, s4); }
                }
                u32x2 w; w.x = pk4_fp8(o[0], o[1], o[2], o[3]); w.y = pk4_fp8(o[4], o[5], o[6], o[7]);
                *(u32x2*)(ACT + (size_t)row * DEXP + j0) = w; }
    }
};
struct EpiDown {
    static constexpr bool PERM = true;
    bf16_t* Y; const float* bias; const float* gate;
    __device__ __forceinline__ void operator()(const f32x4 (&acc)[2][2][4][2], const Unit& u, int wr, int wc, int fr, int fq) const {
        const int row0 = u.pm * BM + wr * 64 + fr, col0 = u.pn * BM + wc * 32 + 8 * fq;
        const float* bp = bias + (size_t)u.e * DM + col0;
        f32x4 bv[2][2];
#pragma unroll
        for (int bj = 0; bj < 2; ++bj) { bv[bj][0] = *(const f32x4*)(bp + bj * HALF); bv[bj][1] = *(const f32x4*)(bp + bj * HALF + 4); }
#pragma unroll
        for (int ai = 0; ai < 2; ++ai)
#pragma unroll
            for (int m = 0; m < 4; ++m) { const int row = row0 + ai * HALF + m * 16; const float gs = gate[row];
#pragma unroll
                for (int bj = 0; bj < 2; ++bj) { const f32x4 v0 = (acc[ai][bj][m][0] + bv[bj][0]) * gs, v1 = (acc[ai][bj][m][1] + bv[bj][1]) * gs;
                    u32x4 w; w.x = pk2(v0[0], v0[1]); w.y = pk2(v0[2], v0[3]); w.z = pk2(v1[0], v1[1]); w.w = pk2(v1[2], v1[3]);
                    *(u32x4*)(Y + (size_t)row * DM + col0 + bj * HALF) = w; } }
    }
};
}

namespace dattn {
constexpr int NW = 8, QBLK = 32, KVBLK = 64, QB = 256, PITCH = INW;
constexpr int SHM_V = KVBLK * 128 * 2, SHM_K = KVBLK * 64 * 2;
constexpr int NVS = 4, NKS = 3;
constexpr int OFF_V = 0, OFF_K = NVS * SHM_V, OFF_WS = OFF_K + NKS * SHM_K, OFF_STASH = OFF_WS + NW * 64 * 4, OFF_TB = OFF_STASH + NW * 8192, LDS_BYTES = OFF_TB + 4 * 128 * 4;
constexpr float THR = 8.f;
__device__ __forceinline__ int v_st(int k, int c) { const int kk = k;     return ((kk >> 3) * 4 + (c >> 5)) * 512 + ((kk & 7) * 32 + (c & 31)) * 2; }
__device__ __forceinline__ int v_rd_base(int lane) { return ((lane & 3) << 3) | (((lane >> 2) & 3) << 6) | (((lane >> 4) & 1) << 5) | (((lane >> 5) & 1) << 8); }
constexpr int v_rd_off(int d0, int ks, int half) { return d0 * 512 + ks * 4096 + half * 2048; }

struct Ref { unsigned qoff, koff, voff; bf16_t* O; int P0, comp, h; };
typedef __amdgpu_buffer_rsrc_t rsrc_t;
__device__ __forceinline__ bf16x8 bld8(rsrc_t r, unsigned voff, unsigned soff) { return __builtin_bit_cast(bf16x8, __builtin_amdgcn_raw_buffer_load_b128(r, (int)voff, (int)soff, 0)); }
struct Seam { bf16x8 qr[4]; int ks, vs;
#if PROBE_SEG
    unsigned long long acc, tot;
#endif
};

__device__ __forceinline__ bf16x8 ld8(const bf16_t* p) { return *reinterpret_cast<const bf16x8*>(p); }

__device__ __forceinline__ void bias_mask(f32x16& p0, f32x16& p1, int sdq  , const LAS float* tb) {
    const float NEG = -__builtin_inff();
    int lane_ = (int)__builtin_amdgcn_mbcnt_hi(~0u, __builtin_amdgcn_mbcnt_lo(~0u, 0u));
    int dq = sdq + (lane_ & 31) - 4 * (lane_ >> 5);
    asm volatile("" : "+v"(dq));
#pragma unroll
    for (int r = 0; r < 16; ++r) {
        const int c = (r & 3) + 8 * (r >> 2);
        const int d0 = dq - c, d1 = dq - c - 32;
        const int i0 = d0 < 0 ? 0 : (d0 > 127 ? 127 : d0), i1 = d1 < 0 ? 0 : (d1 > 127 ? 127 : d1);
        const float b0 = tb[i0], b1 = tb[i1];
        p0[r] = d0 < 0 ? NEG : p0[r] + b0;
        p1[r] = d1 < 0 ? NEG : p1[r] + b1;
    }
}
__device__ __forceinline__ void partialSM(f32x16& p0, f32x16& p1, float& m_reg, float& alpha) {
    float pmax = p0[0];
#pragma unroll
    for (int r = 1; r < 16; ++r) pmax = fmaxf(pmax, p0[r]);
#pragma unroll
    for (int r = 0; r < 16; ++r) pmax = fmaxf(pmax, p1[r]);
    { auto rr = __builtin_amdgcn_permlane32_swap(__float_as_uint(pmax), __float_as_uint(pmax), false, false);
      pmax = fmaxf(__uint_as_float(rr[0]), __uint_as_float(rr[1])); }
    float mn;
    if (__builtin_expect(__all((pmax - m_reg) <= THR), 1)) { mn = m_reg; alpha = 1.f; }
    else { mn = fmaxf(m_reg, pmax); alpha = __builtin_amdgcn_exp2f(m_reg - mn); m_reg = mn; }
#pragma unroll
    for (int r = 0; r < 16; ++r) p0[r] = p0[r] - mn;
#pragma unroll
    for (int r = 0; r < 16; ++r) p1[r] = p1[r] - mn;
#pragma unroll
    for (int r = 0; r < 16; ++r) p0[r] = __builtin_amdgcn_exp2f(p0[r]);
}
__device__ __forceinline__ void finishSM(f32x16& p0, f32x16& p1, float alpha, float& l_reg, bf16x8& pa0, bf16x8& pa1, bf16x8& pa2, bf16x8& pa3) {
#pragma unroll
    for (int r = 0; r < 16; ++r) p1[r] = __builtin_amdgcn_exp2f(p1[r]);
    float ps = 0;
#pragma unroll
    for (int r = 0; r < 16; ++r) ps += p0[r];
#pragma unroll
    for (int r = 0; r < 16; ++r) ps += p1[r];
    { auto rr = __builtin_amdgcn_permlane32_swap(__float_as_uint(ps), __float_as_uint(ps), false, false);
      ps = __uint_as_float(rr[0]) + __uint_as_float(rr[1]); }
    l_reg = l_reg * alpha + ps;
#define PK4(P, B_, OUT) do { unsigned a0 = pk2(P[B_+0], P[B_+1]), a1 = pk2(P[B_+2], P[B_+3]);                          \
        unsigned b0 = pk2(P[B_+4], P[B_+5]), b1 = pk2(P[B_+6], P[B_+7]);                                             \
        auto r0 = __builtin_amdgcn_permlane32_swap(a0, b0, false, false); auto r1 = __builtin_amdgcn_permlane32_swap(a1, b1, false, false); \
        u32x4 w = {r0[0], r1[0], r0[1], r1[1]}; OUT = __builtin_bit_cast(bf16x8, w); } while (0)
    PK4(p0, 0, pa0); PK4(p0, 8, pa1); PK4(p1, 0, pa2); PK4(p1, 8, pa3);
#undef PK4
}
template <int KB>
__device__ __forceinline__ void qkt(f32x16& p0, f32x16& p1, const LAS unsigned char* K_lds, int r32, int hi, const bf16x8* qr) {
    p0 = f32x16{}; p1 = f32x16{};
    const int s = (r32 >> 1) & 7;
#pragma unroll
    for (int d0 = 0; d0 < 4; ++d0) {
        const LAS unsigned char* a = K_lds + KB * SHM_K + r32 * 128 + (((2 * d0 + hi) ^ s) << 4);
        const bf16x8 b0 = *(const LAS bf16x8*)(a);
        const bf16x8 b1 = *(const LAS bf16x8*)(a + 32 * 128);
        p0 = __builtin_amdgcn_mfma_f32_32x32x16_bf16(b0, qr[d0], p0, 0, 0, 0);
        p1 = __builtin_amdgcn_mfma_f32_32x32x16_bf16(b1, qr[d0], p1, 0, 0, 0); }
}
__device__ __forceinline__ void pv_tile(f32x16* o, int vb0, bf16x8 pa0, bf16x8 pa1, bf16x8 pa2, bf16x8 pa3) {
#define TRRD(dst, off) asm volatile("ds_read_b64_tr_b16 %0, %1 offset:%2" : "=&v"(dst) : "v"(vb0), "i"(off) : "memory")
#define PV_D0(d0) do { s16x4 l0, l1, l2, l3, h0, h1, h2, h3; constexpr int b_ = v_rd_off(d0, 0, 0); \
        TRRD(l0, b_); TRRD(h0, b_ + 2048); TRRD(l1, b_ + 4096); TRRD(h1, b_ + 6144); TRRD(l2, b_ + 8192); TRRD(h2, b_ + 10240); TRRD(l3, b_ + 12288); TRRD(h3, b_ + 14336); \
        asm volatile("s_waitcnt lgkmcnt(0)" ::: "memory"); SBAR();   \
        o[d0] = __builtin_amdgcn_mfma_f32_32x32x16_bf16(pa0, (bf16x8){l0[0], l0[1], l0[2], l0[3], h0[0], h0[1], h0[2], h0[3]}, o[d0], 0, 0, 0);   \
        o[d0] = __builtin_amdgcn_mfma_f32_32x32x16_bf16(pa1, (bf16x8){l1[0], l1[1], l1[2], l1[3], h1[0], h1[1], h1[2], h1[3]}, o[d0], 0, 0, 0);   \
        o[d0] = __builtin_amdgcn_mfma_f32_32x32x16_bf16(pa2, (bf16x8){l2[0], l2[1], l2[2], l2[3], h2[0], h2[1], h2[2], h2[3]}, o[d0], 0, 0, 0);   \
        o[d0] = __builtin_amdgcn_mfma_f32_32x32x16_bf16(pa3, (bf16x8){l3[0], l3[1], l3[2], l3[3], h3[0], h3[1], h3[2], h3[3]}, o[d0], 0, 0, 0); } while (0)
    PV_D0(0); PV_D0(1); PV_D0(2); PV_D0(3);
#undef PV_D0
#undef TRRD
}

#define DA_DMA16(gp, ldsp) __builtin_amdgcn_global_load_lds((const unsigned*)(gp), (LAS unsigned*)(ldsp), 16, 0, 0)
#define DA_STAGE(koff_, voff_, k0, ksoff, vsoff) do { const size_t tb_ = (size_t)(k0) * (PITCH * 2); \
        DA_DMA16(projb + (koff_) + tb_ + lk, K_lds + (ksoff) + wid * 1024); \
        DA_DMA16(projb + (voff_) + tb_ + lv, V_lds + (vsoff) + wid * 2048); \
        DA_DMA16(projb + (voff_) + tb_ + lv + 128, V_lds + (vsoff) + wid * 2048 + 1024); } while (0)
#define DA_LANE_OFFS() const int krow_ = 8 * wid + (lane >> 3); \
        const unsigned lk = (unsigned)(krow_ * PITCH) * 2u + (unsigned)(((lane & 7) ^ ((krow_ >> 1) & 7)) << 4); \
        const unsigned lv = (unsigned)((8 * wid + ((lane & 31) >> 2)) * PITCH) * 2u + (unsigned)(((lane >> 5) * 32 + (lane & 3) * 8) * 2)

__device__ __forceinline__ void prime(const Ref& cur, LAS unsigned char* lds, Seam& S, rsrc_t R, const char* projb) {
    const int tid = threadIdx.x, wid = __builtin_amdgcn_readfirstlane(tid >> 6), lane = tid & 63, r32 = lane & 31, hi = lane >> 5;
    DA_LANE_OFFS();
    const unsigned lq = (unsigned)((wid * QBLK + r32) * PITCH + hi * 8) * 2u;
    LAS unsigned char* K_lds = lds + OFF_K; LAS unsigned char* V_lds = lds + OFF_V;
#pragma unroll
    for (int d0 = 0; d0 < 4; ++d0) S.qr[d0] = bld8(R, lq + d0 * 32, cur.qoff);
    S.ks = 0; S.vs = 0;
    DA_STAGE(cur.koff, cur.voff, 0, 0, 0); DA_STAGE(cur.koff, cur.voff, KVBLK, SHM_K, SHM_V);
    __syncthreads();
}
__device__ __forceinline__ void block(const Ref& cur, const Ref& nxt, LAS unsigned char* lds, Seam& S, float lam, const float* gsub, rsrc_t R, const char* projb) {
    const int tid = threadIdx.x, wid = __builtin_amdgcn_readfirstlane(tid >> 6), lane = tid & 63, r32 = lane & 31, hi = lane >> 5;
    const int NT = (cur.P0 + QB) / KVBLK;
    const int qlo = cur.P0 + wid * QBLK;
    LAS unsigned char* V_lds = lds + OFF_V; LAS unsigned char* K_lds = lds + OFF_K;
    LAS float* ws = (LAS float*)(lds + OFF_WS) + wid * 64; LAS float* li_l = ws; LAS float* al_l = ws + 32;
    const LAS float* tbh = (const LAS float*)(lds + OFF_TB) + cur.h * 128;
    float mhat = 0.f, l_reg = 0.f, rmx = 0.f; f32x16 o[4] = {}; f32x16 negm = f32x16{};
    bool resc = false;
    const int vb0 = (int)(unsigned)(uintptr_t)V_lds + v_rd_base(lane);
    DA_LANE_OFFS();
    const unsigned Kh = cur.koff, Vh = cur.voff;
#define KNEXT(x) (((x) == (NKS - 1) * SHM_K) ? 0 : (x) + SHM_K)
#define VNEXT(x) (((x) == (NVS - 1) * SHM_V) ? 0 : (x) + SHM_V)
    int k0 = S.ks, k1 = KNEXT(k0), k2 = KNEXT(k1);
    int v1 = S.vs, v2 = VNEXT(v1), v3 = VNEXT(v2), v0 = VNEXT(v3);
#define ROT() do { const int kn_ = k0; k0 = k1; k1 = k2; k2 = kn_; const int vn_ = v0; v0 = v1; v1 = v2; v2 = v3; v3 = vn_; } while (0)
#define STREAM(j) do { const bool in_ = (j) < NT; const unsigned ko_ = in_ ? Kh : nxt.koff, vo_ = in_ ? Vh : nxt.voff; const int tj_ = in_ ? (j) : (j) - NT; DA_STAGE(ko_, vo_, KBASE(tj_), k2, v3); } while (0)
#define STEP_BAR() asm volatile("s_waitcnt vmcnt(3) lgkmcnt(0)\n\ts_barrier" ::: "memory")
    const int ksw = (r32 >> 1) & 7;
    const LAS unsigned char* kbase = K_lds + r32 * 128;
#define KBASE(t) ((t) * KVBLK)
#define NEAR(P0_, P1_, t) do { const int kb_ = KBASE(t); if (kb_ >= qlo - 175) bias_mask(P0_, P1_, qlo - kb_, tbh); } while (0)
#define RESC() do { if (resc) { asm volatile("s_waitcnt lgkmcnt(0)" ::: "memory");              \
                     _Pragma("unroll") for (int d_ = 0; d_ < 4; ++d_) _Pragma("unroll") for (int r = 0; r < 16; ++r) o[d_][r] *= al_l[crow(r, hi)]; } } while (0)
#define PIN(x) asm volatile("" : "+v"(x))
#define EX(v) __builtin_amdgcn_exp2f(v)
#define MX3(a, b, c) __builtin_fmaxf(__builtin_fmaxf((a), (b)), (c))
#define DECIDE(C0, C1, FIRST) do { \
        float a_ = MX3(C0[0], C0[1], C1[0]), b_ = MX3(C0[2], C0[3], C1[1]); a_ = MX3(a_, C1[2], C1[3]); \
        _Pragma("unroll") for (int r = 4; r < 16; r += 4) { a_ = MX3(a_, C0[r], C0[r + 1]); b_ = MX3(b_, C0[r + 2], C0[r + 3]); a_ = MX3(a_, C1[r], C1[r + 1]); b_ = MX3(b_, C1[r + 2], C1[r + 3]); } \
        float rm_ = __builtin_fmaxf(a_, b_); { auto rr_ = __builtin_amdgcn_permlane32_swap(__float_as_uint(rm_), __float_as_uint(rm_), false, false); rm_ = __builtin_fmaxf(__uint_as_float(rr_[0]), __uint_as_float(rr_[1])); } \
        resc = false; \
        if ((FIRST) || __builtin_expect(__any(rm_ > THR), 0)) { const float dl_ = (FIRST) ? rm_ : __builtin_fmaxf(rm_, 0.f); mhat += dl_; \
            _Pragma("unroll") for (int r = 0; r < 16; ++r) { C0[r] -= dl_; C1[r] -= dl_; } \
            _Pragma("unroll") for (int r = 0; r < 16; ++r) negm[r] = -mhat; \
            asm volatile("" : "+v"(negm)); \
            if (!(FIRST)) { const float f_ = EX(-dl_); l_reg *= f_; if (hi == 0) al_l[r32] = f_; resc = true; } } } while (0)
#define DECIDE2(C0, C1) do { float rm_ = rmx; { auto rr_ = __builtin_amdgcn_permlane32_swap(__float_as_uint(rm_), __float_as_uint(rm_), false, false); rm_ = __builtin_fmaxf(__uint_as_float(rr_[0]), __uint_as_float(rr_[1])); } \
        resc = false; \
        if (__builtin_expect(__any(rm_ > THR), 0)) { const float dl_ = __builtin_fmaxf(rm_, 0.f); mhat += dl_; const float f_ = EX(-dl_); \
            _Pragma("unroll") for (int r = 0; r < 16; ++r) { C0[r] *= f_; C1[r] *= f_; } \
            _Pragma("unroll") for (int r = 0; r < 16; ++r) negm[r] = -mhat; \
            asm volatile("" : "+v"(negm)); \
            l_reg *= f_; if (hi == 0) al_l[r32] = f_; resc = true; } } while (0)
#define KF(d0, hf) (*(const LAS bf16x8*)(kbase + k0 + (((2 * (d0) + hi) ^ ksw) << 4) + (hf) * 4096))
#define GAPA(MF, P, B, W) do { MF; sacc += P[B]; sacc += P[B + 1]; sacc += P[B + 2]; sacc += P[B + 3]; PIN(sacc); W[((B) >> 1) & 3] = pk2(P[B], P[B + 1]); W[(((B) >> 1) & 3) + 1] = pk2(P[B + 2], P[B + 3]); PIN(W); SBAR(); } while (0)
#define PHASE_A(C0, C1, P0, P1) do { \
        const bf16x8 k00 = KF(0, 0), k01 = KF(0, 1), k10 = KF(1, 0), k11 = KF(1, 1), k20 = KF(2, 0), k21 = KF(2, 1), k30 = KF(3, 0), k31 = KF(3, 1); \
        float sacc = 0.f; SBAR(); \
        GAPA(C0 = __builtin_amdgcn_mfma_f32_32x32x16_bf16(k00, S.qr[0], negm, 0, 0, 0), P0, 0, pw0); \
        GAPA(C1 = __builtin_amdgcn_mfma_f32_32x32x16_bf16(k01, S.qr[0], negm, 0, 0, 0), P0, 4, pw0); \
        GAPA(C0 = __builtin_amdgcn_mfma_f32_32x32x16_bf16(k10, S.qr[1], C0, 0, 0, 0), P0, 8, pw1); \
        GAPA(C1 = __builtin_amdgcn_mfma_f32_32x32x16_bf16(k11, S.qr[1], C1, 0, 0, 0), P0, 12, pw1); \
        GAPA(C0 = __builtin_amdgcn_mfma_f32_32x32x16_bf16(k20, S.qr[2], C0, 0, 0, 0), P1, 0, pw2); \
        GAPA(C1 = __builtin_amdgcn_mfma_f32_32x32x16_bf16(k21, S.qr[2], C1, 0, 0, 0), P1, 4, pw2); \
        GAPA(C0 = __builtin_amdgcn_mfma_f32_32x32x16_bf16(k30, S.qr[3], C0, 0, 0, 0), P1, 8, pw3); \
        GAPA(C1 = __builtin_amdgcn_mfma_f32_32x32x16_bf16(k31, S.qr[3], C1, 0, 0, 0), P1, 12, pw3); \
        l_reg += sacc; } while (0)
#define TRRD(dst, off) asm volatile("ds_read_b64_tr_b16 %0, %1 offset:%2" : "=&v"(dst) : "v"(vbr), "i"(off) : "memory")
#define VRD8(L0, H0, L1, H1, L2, H2, L3, H3, VBv, d0) do { constexpr int b_ = v_rd_off(d0, 0, 0); \
        TRRD(L0, b_); TRRD(H0, b_ + 2048); TRRD(L1, b_ + 4096); TRRD(H1, b_ + 6144); TRRD(L2, b_ + 8192); TRRD(H2, b_ + 10240); TRRD(L3, b_ + 12288); TRRD(H3, b_ + 14336); } while (0)
#define VF(L, H) (bf16x8){L[0], L[1], L[2], L[3], H[0], H[1], H[2], H[3]}
#define PAF(k) __builtin_bit_cast(bf16x8, pw##k)
#define GAPB(MF, X, B) do { MF; rmx = MX3(rmx, X[B], X[(B) + 1]); X[B] = EX(X[B]); X[(B) + 1] = EX(X[(B) + 1]); PIN(X); PIN(rmx); SBAR(); } while (0)
#define PV4(d0, L0, H0, L1, H1, L2, H2, L3, H3, X, B) do { \
        GAPB(o[d0] = __builtin_amdgcn_mfma_f32_32x32x16_bf16(PAF(0), VF(L0, H0), o[d0], 0, 0, 0), X, (B)); \
        GAPB(o[d0] = __builtin_amdgcn_mfma_f32_32x32x16_bf16(PAF(1), VF(L1, H1), o[d0], 0, 0, 0), X, (B) + 2); \
        GAPB(o[d0] = __builtin_amdgcn_mfma_f32_32x32x16_bf16(PAF(2), VF(L2, H2), o[d0], 0, 0, 0), X, (B) + 4); \
        GAPB(o[d0] = __builtin_amdgcn_mfma_f32_32x32x16_bf16(PAF(3), VF(L3, H3), o[d0], 0, 0, 0), X, (B) + 6); } while (0)
#define LWAIT(n) do { asm volatile("s_waitcnt lgkmcnt(" #n ")" ::: "memory"); SBAR(); } while (0)
#define PHASE_B(C0, C1, VBv) do { s16x4 a0, a1, a2, a3, a4, a5, a6, a7, b0, b1, b2, b3, b4, b5, b6, b7; const int vbr = vb0 + (VBv); rmx = -__builtin_inff(); \
        asm volatile("s_waitcnt lgkmcnt(0)" ::: "memory"); SBAR(); \
        VRD8(a0, a1, a2, a3, a4, a5, a6, a7, VBv, 0); VRD8(b0, b1, b2, b3, b4, b5, b6, b7, VBv, 1); LWAIT(8); \
        PV4(0, a0, a1, a2, a3, a4, a5, a6, a7, C0, 0); \
        VRD8(a0, a1, a2, a3, a4, a5, a6, a7, VBv, 2); LWAIT(8); \
        PV4(1, b0, b1, b2, b3, b4, b5, b6, b7, C0, 8); \
        VRD8(b0, b1, b2, b3, b4, b5, b6, b7, VBv, 3); LWAIT(8); \
        PV4(2, a0, a1, a2, a3, a4, a5, a6, a7, C1, 0); \
        LWAIT(0); \
        PV4(3, b0, b1, b2, b3, b4, b5, b6, b7, C1, 8); } while (0)
    f32x16 pA0, pA1, pB0, pB1; u32x4 pw0, pw1, pw2, pw3;
#if PROBE_SEG
    unsigned long long pst_ = __builtin_readcyclecounter();
#define STAMP(k) do { const unsigned long long n_ = __builtin_readcyclecounter(); if ((k) == PROBE_SEG) S.acc += n_ - pst_; S.tot += n_ - pst_; pst_ = n_; } while (0)
#else
#define STAMP(k) do { } while (0)
#endif
    STREAM(2);
    SBAR();
    {
      const bf16x8 k00 = KF(0, 0), k01 = KF(0, 1), k10 = KF(1, 0), k11 = KF(1, 1), k20 = KF(2, 0), k21 = KF(2, 1), k30 = KF(3, 0), k31 = KF(3, 1);
      pA0 = __builtin_amdgcn_mfma_f32_32x32x16_bf16(k00, S.qr[0], negm, 0, 0, 0); pA1 = __builtin_amdgcn_mfma_f32_32x32x16_bf16(k01, S.qr[0], negm, 0, 0, 0);
      pA0 = __builtin_amdgcn_mfma_f32_32x32x16_bf16(k10, S.qr[1], pA0, 0, 0, 0); pA1 = __builtin_amdgcn_mfma_f32_32x32x16_bf16(k11, S.qr[1], pA1, 0, 0, 0);
      pA0 = __builtin_amdgcn_mfma_f32_32x32x16_bf16(k20, S.qr[2], pA0, 0, 0, 0); pA1 = __builtin_amdgcn_mfma_f32_32x32x16_bf16(k21, S.qr[2], pA1, 0, 0, 0);
      pA0 = __builtin_amdgcn_mfma_f32_32x32x16_bf16(k30, S.qr[3], pA0, 0, 0, 0); pA1 = __builtin_amdgcn_mfma_f32_32x32x16_bf16(k31, S.qr[3], pA1, 0, 0, 0); }
    NEAR(pA0, pA1, 0); DECIDE(pA0, pA1, true);
#pragma unroll
    for (int r = 0; r < 16; ++r) { pA0[r] = EX(pA0[r]); pA1[r] = EX(pA1[r]); }
    STEP_BAR();
    ROT();
#define STEP(C0, C1, P0, P1, t) do { SBAR(); STAMP(5); \
        STREAM((t) + 2); SBAR(); \
        PHASE_A(C0, C1, P0, P1); SBAR(); STAMP(1); \
        NEAR(C0, C1, (t)); SBAR(); STAMP(2); \
        PHASE_B(C0, C1, v0); DECIDE2(C0, C1); SBAR(); STAMP(3); \
        RESC(); STEP_BAR(); STAMP(4); ROT(); } while (0)
    int t = 1;
    for (; t + 2 < NT; t += 2) {
        STEP(pB0, pB1, pA0, pA1, t);
        STEP(pA0, pA1, pB0, pB1, t + 1);
    }
    SBAR(); STREAM(NT + 1); SBAR();
    PHASE_A(pB0, pB1, pA0, pA1);
    { const unsigned lq = (unsigned)((wid * QBLK + r32) * PITCH + hi * 8) * 2u;
#pragma unroll
      for (int d0 = 0; d0 < 4; ++d0) S.qr[d0] = bld8(R, lq + d0 * 32, nxt.qoff); }
    SBAR();
    NEAR(pB0, pB1, NT - 1); SBAR();
    PHASE_B(pB0, pB1, v0); DECIDE2(pB0, pB1);
    RESC();
    { float sacc = 0.f;
#pragma unroll
      for (int r = 0; r < 16; ++r) { sacc += pB0[r]; sacc += pB1[r]; }
      l_reg += sacc;
      pw0 = (u32x4){pk2(pB0[0], pB0[1]), pk2(pB0[2], pB0[3]), pk2(pB0[4], pB0[5]), pk2(pB0[6], pB0[7])}; pw1 = (u32x4){pk2(pB0[8], pB0[9]), pk2(pB0[10], pB0[11]), pk2(pB0[12], pB0[13]), pk2(pB0[14], pB0[15])};
      pw2 = (u32x4){pk2(pB1[0], pB1[1]), pk2(pB1[2], pB1[3]), pk2(pB1[4], pB1[5]), pk2(pB1[6], pB1[7])}; pw3 = (u32x4){pk2(pB1[8], pB1[9]), pk2(pB1[10], pB1[11]), pk2(pB1[12], pB1[13]), pk2(pB1[14], pB1[15])};
      SBAR(); pv_tile(o, vb0 + v1, PAF(0), PAF(1), PAF(2), PAF(3)); }
    ROT(); S.ks = k0; S.vs = v1;
    { auto rr = __builtin_amdgcn_permlane32_swap(__float_as_uint(l_reg), __float_as_uint(l_reg), false, false); l_reg = __uint_as_float(rr[0]) + __uint_as_float(rr[1]); }
    int lane_e = (int)__builtin_amdgcn_mbcnt_hi(~0u, __builtin_amdgcn_mbcnt_lo(~0u, 0u)); asm volatile("" : "+v"(lane_e));
    const int r32e = lane_e & 31, hie = lane_e >> 5;
    if (hi == 0) li_l[r32] = l_reg; asm volatile("s_waitcnt lgkmcnt(0)" ::: "memory");
    float rli[16];
#pragma unroll
    for (int r = 0; r < 16; ++r) rli[r] = __builtin_amdgcn_rcpf(li_l[crow(r, hi)]);
    LAS unsigned* st = (LAS unsigned*)(lds + OFF_STASH + wid * 8192) + lane_e;
    if (cur.comp == 0) {
#pragma unroll
        for (int r = 0; r < 16; ++r) { st[(2 * r) * 64] = pk2(o[0][r] * rli[r], o[1][r] * rli[r]); st[(2 * r + 1) * 64] = pk2(o[2][r] * rli[r], o[3][r] * rli[r]); }
    } else {
        float ss[16];
#pragma unroll
        for (int r = 0; r < 16; ++r) { const unsigned u0 = st[(2 * r) * 64], u1 = st[(2 * r + 1) * 64];
            const float s2 = lam * rli[r];
            o[0][r] = bflo(u0) - s2 * o[0][r]; o[1][r] = bfhi(u0) - s2 * o[1][r]; o[2][r] = bflo(u1) - s2 * o[2][r]; o[3][r] = bfhi(u1) - s2 * o[3][r];
            ss[r] = (o[0][r] * o[0][r] + o[1][r] * o[1][r]) + (o[2][r] * o[2][r] + o[3][r] * o[3][r]); }
#pragma unroll
        for (int r = 0; r < 16; ++r) {
#pragma unroll
            for (int x = 1; x < 32; x <<= 1) ss[r] += __shfl_xor(ss[r], x);
            ss[r] = rsqrtf(ss[r] * (1.f / 128.f) + EPS) * 0.8f; }
        float gg[4];
#pragma unroll
        for (int d0 = 0; d0 < 4; ++d0) gg[d0] = gsub[d0 * 32 + r32e];
        bf16_t* Ow = cur.O + (size_t)(wid * QBLK) * DM;
#pragma unroll
        for (int r = 0; r < 16; ++r) { const int orow = crow(r, hie);
#pragma unroll
            for (int d0 = 0; d0 < 4; ++d0) { const float v = o[d0][r] * ss[r] * gg[d0]; const float vn = __shfl_xor(v, 1);
                if ((r32e & 1) == 0) *(unsigned*)(Ow + (size_t)orow * DM + d0 * 32 + r32e) = pk2(v, vn); } }
    }
    __syncthreads();
#undef RESC
#undef KBASE
#undef NEAR
#undef PIN
#undef EX
#undef MX3
#undef DECIDE
#undef DECIDE2
#undef KF
#undef GAPA
#undef PHASE_A
#undef TRRD
#undef VRD8
#undef VF
#undef PAF
#undef GAPB
#undef PV4
#undef LWAIT
#undef PHASE_B
#undef STEP
#undef STAMP
#undef ROT
#undef KNEXT
#undef VNEXT
#undef STREAM
#undef STEP_BAR
}
#undef DA_DMA16
#undef DA_STAGE
#undef DA_LANE_OFFS
}

constexpr int NWAVES = 8;
constexpr int N_LAUNCHES = MK_N_LAUNCHES;
constexpr int N_PHASES = 9;
static_assert(N_LAUNCHES == 1 || N_LAUNCHES == N_PHASES, "MK_N_LAUNCHES is 1 or 9");

constexpr size_t MiB = 1u << 20;
constexpr size_t WS_CTL = 0, CTL_ZERO_BYTES = 1 * MiB;
constexpr size_t WS_ETK = 1 * MiB, WS_GTK = 2 * MiB, WS_RSTDT = 3 * MiB, WS_SLOTTK = 4 * MiB, WS_TOKSLOT = 5 * MiB, WS_GATESLOT = 7 * MiB, WS_RSTDSLOT = 9 * MiB, WS_RBE = 11 * MiB;
constexpr size_t WS_WRHI = 12 * MiB, WS_WRLO = 12 * MiB + 65536, WS_KMB = 13 * MiB, WS_VMT = 14 * MiB;
constexpr size_t WS_WIN = 16 * MiB, WS_WOUT = 21 * MiB, WS_X1B = 24 * MiB, WS_X1Q = 152 * MiB;
constexpr size_t WS_BIG = 216 * MiB;
constexpr size_t WS_H = WS_BIG, WS_PROJ = WS_BIG + 128 * MiB, WS_MIX = WS_BIG + 448 * MiB;
constexpr size_t WS_ACTQ = WS_BIG, WS_Y = WS_BIG + 264 * MiB;
constexpr size_t WS_END = WS_BIG + 792 * MiB;
static_assert(WS_END <= 1024 * MiB, "d_ws map");
constexpr size_t OUT_WGU = 0, OUT_WD = 64 * MiB;
constexpr int CW_BAR = 4096, CW_COUNT = 1024, CW_CURSOR = 2048;
constexpr int RING_BYTES = 159744, LDSCTL_OFF = RING_BYTES, MISC_OFF = LDSCTL_OFF + 320, LDS_BYTES = 163840;
static_assert(dattn::LDS_BYTES <= RING_BYTES, "attention scratch");

#define XB_TMO      128
#define XB_XCNT(j)  (256  + 64 * (j))
#define XB_XSUB(j)  (1280 + 64 * (j))
#define XB_XGEN(j)  (2304 + 64 * (j))
#define XB_TOP      3328
#define XB_TOPGEN   3392
#define XCD_BAR_WORDS 3456
#define XB_SPIN_CAP (1u << 18)
__device__ __forceinline__ unsigned xb_ld(unsigned* p)              { return __hip_atomic_load(p, __ATOMIC_RELAXED, __HIP_MEMORY_SCOPE_AGENT); }
__device__ __forceinline__ unsigned xb_add(unsigned* p, unsigned v) { return __hip_atomic_fetch_add(p, v, __ATOMIC_RELAXED, __HIP_MEMORY_SCOPE_AGENT); }
__device__ __forceinline__ unsigned xb_xcc_id() { return (unsigned)__builtin_amdgcn_s_getreg((3 << 11) | 20) & 0xFu; }
#define XB_SPIN(cond, bar) do { unsigned _sp = 0; while (cond) { __builtin_amdgcn_s_sleep(1); \
    if ((++_sp & 255u) == 0u) { if (xb_ld(&(bar)[XB_TMO])) break; if (_sp > XB_SPIN_CAP) { atomicAdd(&(bar)[XB_TMO], 1u); break; } } } } while (0)
struct XcdBarrier { unsigned* bar; unsigned x; volatile LAS unsigned* st; };
__device__ __forceinline__ XcdBarrier xcd_barrier_post(unsigned* bar, volatile LAS unsigned* st) {
    XcdBarrier b; b.bar = bar; b.x = xb_xcc_id(); b.st = st;
    if (threadIdx.x == 0) (void)xb_add(&bar[XB_XCNT(b.x)], 1u);
    return b;
}
__device__ __forceinline__ void xcd_barrier_complete(unsigned* bar, unsigned x, unsigned& nloc, unsigned& nx) {
    const unsigned G = gridDim.x * gridDim.y * gridDim.z;
    unsigned sum, cnt, mine, sp = 0u;
    for (;;) {
        sum = 0u; cnt = 0u; mine = 0u;
#pragma unroll
        for (unsigned j = 0; j < 16; ++j) { const unsigned c = xb_ld(&bar[XB_XCNT(j)]); sum += c; cnt += (c > 0u) ? 1u : 0u; mine = (j == x) ? c : mine; }
        if (sum == G) break;
        __builtin_amdgcn_s_sleep(1);
        if ((++sp & 255u) == 0u) { if (xb_ld(&bar[XB_TMO])) break; if (sp > XB_SPIN_CAP) { atomicAdd(&bar[XB_TMO], 1u); break; } }
    }
    nloc = mine > 0u ? mine : 1u; nx = cnt > 0u ? cnt : 1u;
}
__device__ __forceinline__ void xcd_barrier(const XcdBarrier& b) {
    asm volatile("s_waitcnt vmcnt(0)" ::: "memory");
    __syncthreads();
    if (threadIdx.x == 0) {
        unsigned* bar = b.bar;
        __builtin_amdgcn_s_waitcnt(0);
        unsigned nloc = b.st[0], nx = b.st[1];
        if (nloc == 0u) { xcd_barrier_complete(bar, b.x, nloc, nx); b.st[0] = nloc; b.st[1] = nx; }
        const unsigned old = xb_add(&bar[XB_XSUB(b.x)], 1u);
        const unsigned gen = old / nloc;
        if (old + 1u == (gen + 1u) * nloc) {
            __builtin_amdgcn_fence(__ATOMIC_RELEASE, "agent");
            asm volatile("s_waitcnt vmcnt(0)" ::: "memory");
            const unsigned og = xb_add(&bar[XB_TOP], 1u);
            const unsigned tg = og / nx;
            if (og + 1u == (tg + 1u) * nx) xb_add(&bar[XB_TOPGEN], 1u);
            else XB_SPIN(xb_ld(&bar[XB_TOPGEN]) == tg, bar);
            __builtin_amdgcn_fence(__ATOMIC_ACQUIRE, "agent");
            xb_add(&bar[XB_XGEN(b.x)], 1u);
            asm volatile("s_waitcnt vmcnt(0)" ::: "memory");
        } else {
            XB_SPIN(xb_ld(&bar[XB_XGEN(b.x)]) == gen, bar);
            __builtin_amdgcn_fence(__ATOMIC_ACQUIRE, "agent");
            asm volatile("s_waitcnt vmcnt(0)" ::: "memory");
        }
    }
    __syncthreads();
}

struct Frame {
    LAS unsigned char* lds;
    volatile LAS unsigned* MISC;
    unsigned* ctl;
    int tid, lane, wave, vcu, G;
    float* out;
    unsigned char* ws;
};
struct Args { const float* in[19]; float* out; unsigned char* ws; int ph_lo, ph_hi; };
typedef const __attribute__((address_space(4))) Args* KArgs;
__device__ __forceinline__ KArgs kargs() { KArgs p = (KArgs)__builtin_amdgcn_kernarg_segment_ptr(); asm volatile("" : "+s"(p)); return p; }
enum { I_X = 0, I_MEM, I_RELB, I_ATTNG, I_WIN, I_CONVW, I_LAMQK, I_SUBG, I_MEMG, I_WMEMKV, I_WOUT, I_FFNG, I_RW, I_RB, I_WGU, I_BGU, I_WDN, I_BDN, I_FING };

template <bool GAIN, bool F8>
__device__ __forceinline__ void p0_transpose_item(const float* W, int K, int N, void* WTv, int k0, int n0, int drow0, const float* kgain, float scale, LAS float* scr, int lane) {
    float v[32];
    const float* wp = W + (size_t)(k0 + (lane >> 5)) * N + n0 + (lane & 31);
#pragma unroll
    for (int i = 0; i < 32; ++i) v[i] = wp[(size_t)(2 * i) * N];
    const int c = lane & 7;
    f32x4 g0 = {scale, scale, scale, scale}, g1 = g0;
    if constexpr (GAIN) { g0 = *(const f32x4*)(kgain + k0 + 8 * c) * scale; g1 = *(const f32x4*)(kgain + k0 + 8 * c + 4) * scale; }
#pragma unroll
    for (int i = 0; i < 32; ++i) scr[(2 * i + (lane >> 5)) * 33 + (lane & 31)] = v[i];
    LDS_WAIT(); asm volatile("" ::: "memory");
#pragma unroll
    for (int j = 0; j < 4; ++j) { const int n = (lane >> 3) + 8 * j; const LAS float* s = scr + (8 * c) * 33 + n;
        const float e0 = s[0 * 33] * g0[0], e1 = s[1 * 33] * g0[1], e2 = s[2 * 33] * g0[2], e3 = s[3 * 33] * g0[3], e4 = s[4 * 33] * g1[0], e5 = s[5 * 33] * g1[1], e6 = s[6 * 33] * g1[2], e7 = s[7 * 33] * g1[3];
        if constexpr (F8) { u32x2 o; o.x = pg8::pk4_fp8(e0, e1, e2, e3); o.y = pg8::pk4_fp8(e4, e5, e6, e7);
            *(u32x2*)((unsigned char*)WTv + (size_t)(drow0 + n) * K + k0 + 8 * c) = o; }
        else { u32x4 o; o.x = pk2(e0, e1); o.y = pk2(e2, e3); o.z = pk2(e4, e5); o.w = pk2(e6, e7);
            *(u32x4*)((bf16_t*)WTv + (size_t)(drow0 + n) * K + k0 + 8 * c) = o; } }
    LDS_WAIT(); asm volatile("" ::: "memory");
}
__device__ __forceinline__ void rms_row2_to_bf16(const float* xa, const float* xb, const float* g, bf16_t* oa, bf16_t* ob, int lane) {
    const f32x4* ra = (const f32x4*)xa + lane; const f32x4* rb = (const f32x4*)xb + lane; const f32x4* gr = (const f32x4*)g + lane;
    f32x4 va[4], vb[4]; float sa = 0.f, sb = 0.f;
#pragma unroll
    for (int j = 0; j < 4; ++j) { va[j] = ra[64 * j]; vb[j] = rb[64 * j]; }
#pragma unroll
    for (int j = 0; j < 4; ++j) { sa += (va[j].x * va[j].x + va[j].y * va[j].y) + (va[j].z * va[j].z + va[j].w * va[j].w); sb += (vb[j].x * vb[j].x + vb[j].y * vb[j].y) + (vb[j].z * vb[j].z + vb[j].w * vb[j].w); }
    const float rsa = rsqrtf(wave_sum(sa) * (1.f / DM) + EPS), rsb = rsqrtf(wave_sum(sb) * (1.f / DM) + EPS);
    unsigned long long* pa = (unsigned long long*)oa + lane; unsigned long long* pb = (unsigned long long*)ob + lane;
#pragma unroll
    for (int j = 0; j < 4; ++j) { const f32x4 gg = gr[64 * j];
        pa[64 * j] = (unsigned long long)pk2(va[j].x * rsa * gg.x, va[j].y * rsa * gg.y) | ((unsigned long long)pk2(va[j].z * rsa * gg.z, va[j].w * rsa * gg.w) << 32);
        pb[64 * j] = (unsigned long long)pk2(vb[j].x * rsb * gg.x, vb[j].y * rsb * gg.y) | ((unsigned long long)pk2(vb[j].z * rsb * gg.z, vb[j].w * rsb * gg.w) << 32); }
}
__device__ __forceinline__ void p0_kvm_tile(Frame& F, int tile, const float* mem, const float* mem_g, const float* w_memkv) {
    const int mt = tile >> 3, ntile = tile & 7, row0 = 64 * mt, col0 = 64 * ntile;
    const int mb = F.wave >> 1, nb0 = (F.wave & 1) * 2, ar = F.lane & 15, kq = F.lane >> 4;
    const float* arow = mem + (size_t)(row0 + mb * 16 + ar) * DM;
    f32x4 acc[2]; acc[0] = (f32x4){0.f, 0.f, 0.f, 0.f}; acc[1] = acc[0];
    float ss = 0.f;
    const float* wq = w_memkv + col0 + nb0 * 16 + ar;
#define KVM_LOAD(A0, A1, G0, G1, BV, k0_) do { const int kk_ = (k0_) + 8 * kq; A0 = *(const f32x4*)(arow + kk_); A1 = *(const f32x4*)(arow + kk_ + 4); G0 = *(const f32x4*)(mem_g + kk_); G1 = *(const f32x4*)(mem_g + kk_ + 4); \
        _Pragma("unroll") for (int nbi = 0; nbi < 2; ++nbi) _Pragma("unroll") for (int j = 0; j < 8; ++j) BV[nbi][j] = wq[(size_t)(kk_ + j) * 512 + nbi * 16]; } while (0)
#define KVM_MATH(A0, A1, G0, G1, BV) do { ss += (A0.x * A0.x + A0.y * A0.y) + (A0.z * A0.z + A0.w * A0.w) + (A1.x * A1.x + A1.y * A1.y) + (A1.z * A1.z + A1.w * A1.w); \
        const bf16x8 af = pack8(A0 * G0, A1 * G1); \
        _Pragma("unroll") for (int nbi = 0; nbi < 2; ++nbi) { const f32x4 b0 = {BV[nbi][0], BV[nbi][1], BV[nbi][2], BV[nbi][3]}, b1 = {BV[nbi][4], BV[nbi][5], BV[nbi][6], BV[nbi][7]}; \
            acc[nbi] = __builtin_amdgcn_mfma_f32_16x16x32_bf16(af, pack8(b0, b1), acc[nbi], 0, 0, 0); } } while (0)
    f32x4 xa0, xa1, xg0, xg1, ya0, ya1, yg0, yg1; float xb[2][8], yb[2][8];
    KVM_LOAD(xa0, xa1, xg0, xg1, xb, 0);
    for (int k0 = 0; k0 < DM; k0 += 64) {
        KVM_LOAD(ya0, ya1, yg0, yg1, yb, k0 + 32);
        KVM_MATH(xa0, xa1, xg0, xg1, xb);
        if (k0 + 64 < DM) KVM_LOAD(xa0, xa1, xg0, xg1, xb, k0 + 64);
        KVM_MATH(ya0, ya1, yg0, yg1, yb);
    }
#undef KVM_LOAD
#undef KVM_MATH
    ss += __shfl_xor(ss, 16); ss += __shfl_xor(ss, 32);
    const float rstd = rsqrtf(ss * (1.f / DM) + EPS);
    float rs[4];
#pragma unroll
    for (int j = 0; j < 4; ++j) rs[j] = __shfl(rstd, kq * 4 + j);
    bf16_t* kmb = (bf16_t*)(F.ws + WS_KMB); bf16_t* vmt = (bf16_t*)(F.ws + WS_VMT);
#pragma unroll
    for (int nbi = 0; nbi < 2; ++nbi) {
        const int gc = col0 + (nb0 + nbi) * 16 + ar, gr0 = row0 + mb * 16 + kq * 4;
        if (ntile < 4) {
#pragma unroll
            for (int j = 0; j < 4; ++j) kmb[(size_t)(gr0 + j) * 256 + gc] = (bf16_t)(pk2(acc[nbi][j] * rs[j], 0.f) & 0xffffu);
        } else {
            const int d = gc - 256, hm = d >> 6, dd = d & 63, b = gr0 >> 8, m = gr0 & 255;
            u32x2 w; w.x = pk2(acc[nbi][0] * rs[0], acc[nbi][1] * rs[1]); w.y = pk2(acc[nbi][2] * rs[2], acc[nbi][3] * rs[3]);
            *(u32x2*)(vmt + ((size_t)((b * 4 + hm) * 64 + dd)) * 256 + m) = w;
        }
    }
}
__device__ __forceinline__ void p0_prologue(Frame& F) {
    KArgs A = kargs();
    { const float* mem = A->in[I_MEM]; const float* mem_g = A->in[I_MEMG]; const float* w_memkv = A->in[I_WMEMKV];
      for (int rep2_ = 0; rep2_ < ((PROBE_P0 & 4) ? 2 : 1); ++rep2_)
      for (int tile = blockIdx.x; tile < 256; tile += F.G) p0_kvm_tile(F, tile, mem, mem_g, w_memkv); }
    const float* w_in = A->in[I_WIN]; const float* w_out = A->in[I_WOUT]; const float* w_gu = A->in[I_WGU]; const float* w_dn = A->in[I_WDN]; const float* ffn_g = A->in[I_FFNG];
    LAS float* scr = (LAS float*)(F.lds + F.wave * 16384);
    const int gw = F.vcu * NWAVES + F.wave, NGW = F.G * NWAVES;
    bf16_t* Win_t = (bf16_t*)(F.ws + WS_WIN); bf16_t* Wout_t = (bf16_t*)(F.ws + WS_WOUT);
    unsigned char* Wgu_q = (unsigned char*)F.out + OUT_WGU; unsigned char* Wd_q = (unsigned char*)F.out + OUT_WD;
    constexpr int I_IN = 16 * 80, I_OUT = 16 * 32, I_GU1 = 16 * 64, I_D1 = 16 * 32;
    constexpr int I_GU = NEXP * I_GU1, I_D = NEXP * I_D1, NITEMS = I_IN + I_OUT + I_GU + I_D;
    for (int rep0_ = 0; rep0_ < ((PROBE_P0 & 1) ? 2 : 1); ++rep0_)
    for (int it = gw; it < NITEMS; it += NGW) {
        int r = it;
        if (r < I_IN) { const int kb = r / 80, nb = r % 80; p0_transpose_item<false, false>(w_in, DM, INW, Win_t, 64 * kb, 32 * nb, 32 * nb, nullptr, 1.f, scr, F.lane); continue; } r -= I_IN;
        if (r < I_OUT) { const int kb = r / 32, nb = r % 32; p0_transpose_item<false, false>(w_out, DM, DM, Wout_t, 64 * kb, 32 * nb, 32 * nb, nullptr, 1.f, scr, F.lane); continue; } r -= I_OUT;
        if (r < I_GU) { const int e = r / I_GU1, q = r % I_GU1, kb = q / 64, nb = q % 64, n0 = 32 * nb;
            const int jj = n0 & 1023, drow0 = (jj >> 7) * 256 + (n0 >= 1024 ? 128 : 0) + (jj & 127);
            p0_transpose_item<true, true>(w_gu + (size_t)e * DM * 2048, DM, 2048, Wgu_q + (size_t)e * 2048 * DM, 64 * kb, n0, drow0, ffn_g, 64.f, scr, F.lane); continue; } r -= I_GU;
        { const int e = r / I_D1, q = r % I_D1, kb = q / 32, nb = q % 32;
            p0_transpose_item<false, true>(w_dn + (size_t)e * DEXP * DM, DEXP, DM, Wd_q + (size_t)e * DM * DEXP, 64 * kb, 32 * nb, 32 * nb, nullptr, 64.f, scr, F.lane); }
    }
    bf16_t* H = (bf16_t*)(F.ws + WS_H);
    { const float* x = A->in[I_X]; const float* attn_g = A->in[I_ATTNG];
      for (int rep1_ = 0; rep1_ < ((PROBE_P0 & 2) ? 2 : 1); ++rep1_)
      for (int m = gw; m < T; m += 2 * NGW) { const int m2 = (m + NGW < T) ? m + NGW : m;
          rms_row2_to_bf16(x + (size_t)m * DM, x + (size_t)m2 * DM, attn_g, H + (size_t)m * DM, H + (size_t)m2 * DM, F.lane); } }
    const float* router_w = A->in[I_RW];
    bf16_t* wrh = (bf16_t*)(F.ws + WS_WRHI); bf16_t* wrl = (bf16_t*)(F.ws + WS_WRLO);
    for (int i = (F.vcu * NWAVES + F.wave) * 64 + F.lane; i < NEXP * DM; i += NGW * 64) { const int e = i >> 10, k = i & 1023;
        const float v = ffn_g[k] * router_w[(size_t)k * NEXP + e]; const unsigned hb = pk2(v, 0.f) & 0xffffu; const float hf = __uint_as_float(hb << 16);
        wrh[i] = (bf16_t)hb; wrl[i] = (bf16_t)(pk2(v - hf, 0.f) & 0xffffu); }
}

__device__ __forceinline__ void p2_conv_block(Frame& F, int blk, int tid_, const float* conv_w) {
    const bf16_t* proj = (const bf16_t*)(F.ws + WS_PROJ); bf16_t* mix = (bf16_t*)(F.ws + WS_MIX);
    const int cg = tid_ & 31, tc = tid_ >> 5;
    const int c0 = cg * 8, t0 = blk * 256 + tc * 16, s0 = t0 & (SEQ - 1);
    float w0[8], w1[8], w2[8];
#pragma unroll
    for (int i = 0; i < 8; ++i) { w0[i] = conv_w[c0 + i]; w1[i] = conv_w[256 + c0 + i]; w2[i] = conv_w[512 + c0 + i]; }
    float p2[8], p1[8];
#pragma unroll
    for (int i = 0; i < 8; ++i) { p2[i] = 0.f; p1[i] = 0.f; }
    if (s0 >= 2) {
        const u32x4 ua = *(const u32x4*)(proj + (size_t)(t0 - 2) * INW + COL_U + c0), ca = *(const u32x4*)(proj + (size_t)(t0 - 2) * INW + COL_GC + c0);
        const u32x4 ub = *(const u32x4*)(proj + (size_t)(t0 - 1) * INW + COL_U + c0), cb = *(const u32x4*)(proj + (size_t)(t0 - 1) * INW + COL_GC + c0);
#pragma unroll
        for (int i = 0; i < 4; ++i) { p2[2 * i] = bflo(ua[i]) * bflo(ca[i]); p2[2 * i + 1] = bfhi(ua[i]) * bfhi(ca[i]); p1[2 * i] = bflo(ub[i]) * bflo(cb[i]); p1[2 * i + 1] = bfhi(ub[i]) * bfhi(cb[i]); }
    }
    for (int tb = 0; tb < 16; tb += 4) {
        u32x4 uu[4], cc[4], bb[4];
#pragma unroll
        for (int q = 0; q < 4; ++q) { const size_t ro = (size_t)(t0 + tb + q) * INW;
            uu[q] = *(const u32x4*)(proj + ro + COL_U + c0); cc[q] = *(const u32x4*)(proj + ro + COL_GC + c0); bb[q] = *(const u32x4*)(proj + ro + COL_GB + c0); }
#pragma unroll
        for (int q = 0; q < 4; ++q) {
            float cur[8], y[8];
#pragma unroll
            for (int i = 0; i < 4; ++i) { cur[2 * i] = bflo(uu[q][i]) * bflo(cc[q][i]); cur[2 * i + 1] = bfhi(uu[q][i]) * bfhi(cc[q][i]); }
#pragma unroll
            for (int i = 0; i < 4; ++i) { y[2 * i] = bflo(bb[q][i]) * (w0[2 * i] * p2[2 * i] + w1[2 * i] * p1[2 * i] + w2[2 * i] * cur[2 * i]);
                                           y[2 * i + 1] = bfhi(bb[q][i]) * (w0[2 * i + 1] * p2[2 * i + 1] + w1[2 * i + 1] * p1[2 * i + 1] + w2[2 * i + 1] * cur[2 * i + 1]); }
            u32x4 o; o.x = pk2(y[0], y[1]); o.y = pk2(y[2], y[3]); o.z = pk2(y[4], y[5]); o.w = pk2(y[6], y[7]);
            *(u32x4*)(mix + (size_t)(t0 + tb + q) * DM + c0) = o;
#pragma unroll
            for (int i = 0; i < 8; ++i) { p2[i] = p1[i]; p1[i] = cur[i]; }
        }
    }
}
__device__ __forceinline__ void p2_mem_block(Frame& F, int blk, int lane_) {
    const bf16_t* proj = (const bf16_t*)(F.ws + WS_PROJ); bf16_t* mix = (bf16_t*)(F.ws + WS_MIX);
    const bf16_t* kmb = (const bf16_t*)(F.ws + WS_KMB); const bf16_t* vmt = (const bf16_t*)(F.ws + WS_VMT);
    const int r32 = lane_ & 31, hi = lane_ >> 5, b = blk >> 5, tw = blk * 256 + F.wave * 32, tid_ = F.wave * 64 + lane_;
    LAS unsigned char* Kl = F.lds; LAS unsigned char* Vl = F.lds + 32768;
    const int ksw = (r32 >> 1) & 7;
    for (int hm = 0; hm < 4; ++hm) {
        bf16x8 qr[4];
#pragma unroll
        for (int d0 = 0; d0 < 4; ++d0) qr[d0] = *(const bf16x8*)(proj + (size_t)(tw + r32) * INW + COL_QM + hm * 64 + d0 * 16 + hi * 8);
        { u32x4 kv[4], vv[4];
#pragma unroll
          for (int i = 0; i < 4; ++i) { const int idx = tid_ + 512 * i;
              kv[i] = *(const u32x4*)(kmb + (size_t)(b * 256 + (idx >> 3)) * 256 + hm * 64 + (idx & 7) * 8);
              vv[i] = *(const u32x4*)(vmt + ((size_t)((b * 4 + hm) * 64 + (idx >> 5))) * 256 + (idx & 31) * 8); }
          __syncthreads();
#pragma unroll
          for (int i = 0; i < 4; ++i) { const int idx = tid_ + 512 * i; const int kr = idx >> 3, kc = idx & 7, vd = idx >> 5, vc = idx & 31;
              *(LAS u32x4*)(Kl + kr * 128 + ((kc ^ ((kr >> 1) & 7)) << 4)) = kv[i];
              *(LAS u32x4*)(Vl + vd * 512 + ((vc ^ (vd & 31)) << 4)) = vv[i]; }
          __syncthreads(); }
        float mx = -__builtin_inff();
#pragma unroll 2
        for (int kb = 0; kb < 8; ++kb) { f32x16 p = f32x16{};
#pragma unroll
            for (int d0 = 0; d0 < 4; ++d0) { const bf16x8 kf = *(const LAS bf16x8*)(Kl + (kb * 32 + r32) * 128 + (((2 * d0 + hi) ^ ksw) << 4));
                p = __builtin_amdgcn_mfma_f32_32x32x16_bf16(kf, qr[d0], p, 0, 0, 0); }
#pragma unroll
            for (int r = 0; r < 16; ++r) mx = fmaxf(mx, p[r]); }
        mx = fmaxf(mx, __shfl_xor(mx, 32));
        float sum = 0.f;
        f32x16 o[2]; o[0] = f32x16{}; o[1] = f32x16{};
#pragma unroll 2
        for (int kb = 0; kb < 8; ++kb) { f32x16 p = f32x16{};
#pragma unroll
            for (int d0 = 0; d0 < 4; ++d0) { const bf16x8 kf = *(const LAS bf16x8*)(Kl + (kb * 32 + r32) * 128 + (((2 * d0 + hi) ^ ksw) << 4));
                p = __builtin_amdgcn_mfma_f32_32x32x16_bf16(kf, qr[d0], p, 0, 0, 0); }
#pragma unroll
            for (int r = 0; r < 16; ++r) { p[r] = __builtin_amdgcn_exp2f(p[r] - mx); sum += p[r]; }
            bf16x8 pa0, pa1;
#define PK4(P, B_, OUT) do { unsigned a0 = pk2(P[B_+0], P[B_+1]), a1 = pk2(P[B_+2], P[B_+3]); unsigned b0 = pk2(P[B_+4], P[B_+5]), b1 = pk2(P[B_+6], P[B_+7]); \
        auto r0 = __builtin_amdgcn_permlane32_swap(a0, b0, false, false); auto r1 = __builtin_amdgcn_permlane32_swap(a1, b1, false, false); \
        u32x4 w = {r0[0], r1[0], r0[1], r1[1]}; OUT = __builtin_bit_cast(bf16x8, w); } while (0)
            PK4(p, 0, pa0); PK4(p, 8, pa1);
#undef PK4
#pragma unroll
            for (int d0 = 0; d0 < 2; ++d0) { const LAS unsigned char* vrow = Vl + (d0 * 32 + r32) * 512;
                const bf16x8 v0 = *(const LAS bf16x8*)(vrow + (((kb * 4 + hi) ^ r32) << 4)), v1 = *(const LAS bf16x8*)(vrow + (((kb * 4 + 2 + hi) ^ r32) << 4));
                o[d0] = __builtin_amdgcn_mfma_f32_32x32x16_bf16(pa0, v0, o[d0], 0, 0, 0);
                o[d0] = __builtin_amdgcn_mfma_f32_32x32x16_bf16(pa1, v1, o[d0], 0, 0, 0); }
        }
        sum += __shfl_xor(sum, 32);
        const float linv = __builtin_amdgcn_rcpf(sum);
#pragma unroll
        for (int r = 0; r < 16; ++r) { const int orow = crow(r, hi); const float li = __shfl(linv, orow);
#pragma unroll
            for (int d0 = 0; d0 < 2; ++d0) { const float v = o[d0][r] * li; const float vn = __shfl_xor(v, 1);
                if ((r32 & 1) == 0) *(unsigned*)(mix + (size_t)(tw + orow) * DM + 768 + hm * 64 + d0 * 32 + r32) = pk2(v, vn); } }
    }
    __syncthreads();
}
__device__ __forceinline__ dattn::Ref da_ref(Frame& F, int n) {
    const int pid = F.vcu + (n >> 2) * F.G, sub = n & 3, blk = sub >> 1, comp = sub & 1, bh = pid >> 4, s = pid & 15, qb = blk ? 31 - s : s, b = bh >> 2, h = bh & 3;
    bf16_t* mix = (bf16_t*)(F.ws + WS_MIX);
    dattn::Ref r;
    r.qoff = (unsigned)(((size_t)(b * SEQ + qb * 256) * INW + COL_Q + h * 128 + comp * 64) * 2);
    r.koff = (unsigned)(((size_t)(b * SEQ) * INW + COL_K + h * 128 + comp * 64) * 2);
    r.voff = (unsigned)(((size_t)(b * SEQ) * INW + COL_V + h * 128) * 2);
    r.O = mix + (size_t)(b * SEQ + qb * 256) * DM + 256 + h * 128;
    r.P0 = qb * 256; r.comp = comp; r.h = h;
    return r;
}
__device__ __forceinline__ void p2_mixers(Frame& F) {
    KArgs A = kargs();
    const float* rel_bias = A->in[I_RELB]; const float* lam_qk = A->in[I_LAMQK]; const float* subln_g = A->in[I_SUBG];
    if (F.tid < 512) { const int h = F.tid >> 7, n = F.tid & 127; int bk;
        if (n < 16) bk = n; else { bk = 16; const int thr[15] = {19, 21, 24, 27, 31, 35, 40, 46, 52, 59, 67, 77, 87, 99, 113};
#pragma unroll
            for (int i = 0; i < 15; ++i) bk += (n >= thr[i]) ? 1 : 0; }
        ((LAS float*)(F.lds + dattn::OFF_TB))[h * 128 + n] = (rel_bias[bk * 4 + h] - rel_bias[31 * 4 + h]) * LOG2E; }
    float d1 = 0.f, d2 = 0.f;
    for (int i = 0; i < 64; ++i) { d1 += lam_qk[i] * lam_qk[64 + i]; d2 += lam_qk[128 + i] * lam_qk[192 + i]; }
    const float lam = __expf(d1) - __expf(d2) + 0.2f;
    __syncthreads();
    const int npairs = F.vcu < 512 ? (512 - F.vcu + F.G - 1) / F.G : 0, total1 = 4 * npairs, total = ((PROBE_REP >> 2) & 1) ? 2 * total1 : total1;
#if PROBE_CLK
    const unsigned long long pc0_ = __builtin_readcyclecounter(), pr0_ = __builtin_amdgcn_s_memrealtime();
#endif
    if (total > 0) {
        dattn::Seam S; dattn::Ref cur = da_ref(F, 0);
#if PROBE_SEG
        S.acc = 0; S.tot = 0;
#endif
        const dattn::rsrc_t R = __builtin_amdgcn_make_buffer_rsrc((void*)(F.ws + WS_PROJ), 0, (int)((size_t)T * INW * 2), 0x00020000);
        const char* projb = (const char*)(F.ws + WS_PROJ);
        dattn::prime(cur, F.lds, S, R, projb);
        for (int n = 0; n < total; ++n) {
            const dattn::Ref nxt = (n + 1 < total) ? da_ref(F, (n + 1) % total1) : cur;
            dattn::block(cur, nxt, F.lds, S, lam, subln_g, R, projb);
            cur = nxt;
        }
#if PROBE_SEG
        if (blockIdx.x == 0 && F.tid == 0) { F.ctl[604] = (unsigned)(S.acc >> 4); F.ctl[605] = (unsigned)(S.tot >> 4); }
#endif
    }
#if PROBE_CLK
    if (blockIdx.x == 0 && F.tid == 0) { const unsigned long long dc_ = __builtin_readcyclecounter() - pc0_, dr_ = __builtin_amdgcn_s_memrealtime() - pr0_;
        F.ctl[600] = (unsigned)dc_; F.ctl[601] = (unsigned)(dc_ >> 32); F.ctl[602] = (unsigned)dr_; }
#endif
    int lane2 = (int)__builtin_amdgcn_mbcnt_hi(~0u, __builtin_amdgcn_mbcnt_lo(~0u, 0u)); asm volatile("" : "+v"(lane2));
    const int tid2 = F.wave * 64 + lane2;
    const float* conv_w = kargs()->in[I_CONVW];
    for (int repx_ = 0; repx_ < ((PROBE_X & 1) ? 2 : 1); ++repx_)
    for (int blk = blockIdx.x; blk < T / 256; blk += F.G) { p2_conv_block(F, blk, tid2, conv_w); p2_mem_block(F, blk, lane2); }
}

__device__ __forceinline__ void p4_router(Frame& F, bool dry = false) {
    const float* router_b = kargs()->in[I_RB];
    const bf16_t* x1b = (const bf16_t*)(F.ws + WS_X1B); const bf16_t* wrh = (const bf16_t*)(F.ws + WS_WRHI); const bf16_t* wrl = (const bf16_t*)(F.ws + WS_WRLO);
    int* e_tk = (int*)(F.ws + WS_ETK); float* g_tk = (float*)(F.ws + WS_GTK); float* rstd_t = (float*)(F.ws + WS_RSTDT);
    LAS float* lg = (LAS float*)F.lds + F.wave * (32 * 33); LAS unsigned* hist = (LAS unsigned*)(F.lds + 8 * 32 * 33 * 4);
    const int r32 = F.lane & 31, hi = F.lane >> 5;
    for (int blk = blockIdx.x; blk < T / 256; blk += F.G) {
        if (F.tid < 32) hist[F.tid] = 0u;
        __syncthreads();
        const int t0 = blk * 256 + F.wave * 32;
        const bf16_t* xr = x1b + (size_t)(t0 + r32) * DM + hi * 8; const bf16_t* wh = wrh + (size_t)r32 * DM + hi * 8; const bf16_t* wl = wrl + (size_t)r32 * DM + hi * 8;
        f32x16 acc = f32x16{}; float ss = 0.f;
#pragma unroll 1
        for (int kq = 0; kq < DM; kq += 256) {
            u32x4 xw[16];
#pragma unroll
            for (int s_ = 0; s_ < 16; ++s_) xw[s_] = *(const u32x4*)(xr + kq + s_ * 16);
            SBAR();
#pragma unroll
            for (int sb = 0; sb < 16; sb += 4) { bf16x8 ah[4], al[4];
#pragma unroll
                for (int s_ = 0; s_ < 4; ++s_) { ah[s_] = *(const bf16x8*)(wh + kq + (sb + s_) * 16); al[s_] = *(const bf16x8*)(wl + kq + (sb + s_) * 16); }
#pragma unroll
                for (int s_ = 0; s_ < 4; ++s_) { const u32x4 xv = xw[sb + s_];
#pragma unroll
                    for (int i = 0; i < 4; ++i) { const float a = bflo(xv[i]), b2 = bfhi(xv[i]); ss += a * a + b2 * b2; }
                    const bf16x8 xb = __builtin_bit_cast(bf16x8, xv);
                    acc = __builtin_amdgcn_mfma_f32_32x32x16_bf16(ah[s_], xb, acc, 0, 0, 0);
                    acc = __builtin_amdgcn_mfma_f32_32x32x16_bf16(al[s_], xb, acc, 0, 0, 0); } }
        }
        ss += __shfl_xor(ss, 32);
        const float rstd = rsqrtf(ss * (1.f / DM) + EPS);
#pragma unroll
        for (int r = 0; r < 16; ++r) { const int e = crow(r, hi); lg[r32 * 33 + e] = acc[r] * rstd + router_b[e]; }
        LDS_WAIT(); asm volatile("" ::: "memory");
        if (F.lane < 32) {
            LAS float* row = lg + F.lane * 33; float tv[4]; int ti[4];
#pragma unroll
            for (int p = 0; p < 4; ++p) { float best = -__builtin_inff(); int bi = 0;
                for (int e = 0; e < NEXP; ++e) { const float v = row[e]; if (v > best) { best = v; bi = e; } }
                tv[p] = best; ti[p] = bi; row[bi] = -__builtin_inff(); LDS_WAIT(); asm volatile("" ::: "memory"); }
            const float w1 = __expf(tv[1] - tv[0]), w2 = __expf(tv[2] - tv[0]), w3 = __expf(tv[3] - tv[0]); const float inv = 1.f / (1.f + w1 + w2 + w3);
            const int t = t0 + F.lane;
            if (!dry) {
            *(int4*)(e_tk + (size_t)t * 4) = make_int4(ti[0], ti[1], ti[2], ti[3]);
            *(float4*)(g_tk + (size_t)t * 4) = make_float4(inv, w1 * inv, w2 * inv, w3 * inv);
            rstd_t[t] = rstd;
#pragma unroll
            for (int p = 0; p < 4; ++p) __hip_atomic_fetch_add(&hist[ti[p]], 1u, __ATOMIC_RELAXED, __HIP_MEMORY_SCOPE_WORKGROUP);
            }
        }
        __syncthreads();
        if (F.tid < 32) __hip_atomic_fetch_add(F.ctl + CW_COUNT + F.tid, hist[F.tid], RLX_AGENT);
        __syncthreads();
    }
}
__device__ __forceinline__ void p5_place(Frame& F) {
    const int* e_tk = (const int*)(F.ws + WS_ETK); const float* g_tk = (const float*)(F.ws + WS_GTK); const float* rstd_t = (const float*)(F.ws + WS_RSTDT);
    int* slot_tk = (int*)(F.ws + WS_SLOTTK); int* tok_slot = (int*)(F.ws + WS_TOKSLOT); float* gate_slot = (float*)(F.ws + WS_GATESLOT); float* rstd_slot = (float*)(F.ws + WS_RSTDSLOT);
    int* rb_e = (int*)(F.ws + WS_RBE);
    LAS int* L = (LAS int*)F.lds;
    if (F.tid < 32) { const int c = (int)__hip_atomic_load(F.ctl + CW_COUNT + F.tid, RLX_AGENT); L[F.tid] = c; L[32 + F.tid] = (c + 255) & ~255; }
    __syncthreads();
    if (F.tid < 32) { int s = 0; for (int e = 0; e < F.tid; ++e) s += L[32 + e]; L[64 + F.tid] = s; }
    __syncthreads();
    for (int blk = blockIdx.x; blk < T / 256; blk += F.G) {
        if (F.tid < 32) { L[96 + F.tid] = 0; L[128 + F.tid] = 0; }
        __syncthreads();
        int ee[2];
#pragma unroll
        for (int j = 0; j < 2; ++j) { const int i = F.tid + 512 * j; ee[j] = e_tk[(size_t)blk * 1024 + i]; __hip_atomic_fetch_add(&L[96 + ee[j]], 1, __ATOMIC_RELAXED, __HIP_MEMORY_SCOPE_WORKGROUP); }
        __syncthreads();
        if (F.tid < 32) L[160 + F.tid] = L[64 + F.tid] + (int)__hip_atomic_fetch_add(F.ctl + CW_CURSOR + F.tid, (unsigned)L[96 + F.tid], RLX_AGENT);
        __syncthreads();
#pragma unroll
        for (int j = 0; j < 2; ++j) { const int i = F.tid + 512 * j; const int r = __hip_atomic_fetch_add(&L[128 + ee[j]], 1, __ATOMIC_RELAXED, __HIP_MEMORY_SCOPE_WORKGROUP); const int pos = L[160 + ee[j]] + r;
            const int t = blk * 256 + (i >> 2);
            tok_slot[pos] = t; gate_slot[pos] = g_tk[(size_t)blk * 1024 + i]; rstd_slot[pos] = rstd_t[t]; slot_tk[(size_t)blk * 1024 + i] = pos; }
        __syncthreads();
    }
    for (int e = blockIdx.x; e < NEXP; e += F.G)
        for (int i = L[e] + F.tid; i < L[32 + e]; i += NWAVES * 64) { const int pos = L[64 + e] + i; tok_slot[pos] = 0; gate_slot[pos] = 0.f; rstd_slot[pos] = 0.f; }
    if (blockIdx.x == 0) {
        const int nrb = (L[64 + 31] + L[32 + 31]) >> 8;
        for (int rb = F.tid; rb < NRB_MAX; rb += NWAVES * 64) { int e = 31; for (int q = 0; q < 32; ++q) { if (rb * 256 >= L[64 + q] && rb * 256 < L[64 + q] + L[32 + q]) e = q; } rb_e[rb] = e; }
        if (F.tid == 0) rb_e[NRB_MAX] = nrb;
    }
}
__device__ __forceinline__ void p9_final(Frame& F) {
    const bf16_t* x1b = (const bf16_t*)(F.ws + WS_X1B); const int* slot_tk = (const int*)(F.ws + WS_SLOTTK);
    const bf16_t* Y = (const bf16_t*)(F.ws + WS_Y);
    const int gw = F.vcu * NWAVES + F.wave, NGW = F.G * NWAVES;
    const float* final_g = kargs()->in[I_FING];
    f32x4 gg[2][2];
#pragma unroll
    for (int j = 0; j < 2; ++j) { gg[j][0] = *(const f32x4*)(final_g + 8 * F.lane + 512 * j); gg[j][1] = *(const f32x4*)(final_g + 8 * F.lane + 512 * j + 4); }
    int4 slA = make_int4(0, 0, 0, 0), slB = slA;
    if (gw < T) { slA = *(const int4*)(slot_tk + (size_t)gw * 4); const int tb0 = (gw + NGW < T) ? gw + NGW : gw; slB = *(const int4*)(slot_tk + (size_t)tb0 * 4); }
    for (int t = gw; t < T; t += 2 * NGW) {
        const int tA = t, tB = (t + NGW < T) ? t + NGW : t;
        const int tnA = (t + 2 * NGW < T) ? t + 2 * NGW : tA, tnB = (t + 3 * NGW < T) ? t + 3 * NGW : tnA;
        const int4 nA = *(const int4*)(slot_tk + (size_t)tnA * 4), nB = *(const int4*)(slot_tk + (size_t)tnB * 4);
        const int sA[4] = {slA.x, slA.y, slA.z, slA.w}, sB[4] = {slB.x, slB.y, slB.z, slB.w};
        u32x4 xa[2], xb[2], ya[2][4], yb[2][4];
#pragma unroll
        for (int j = 0; j < 2; ++j) { const int c = 8 * F.lane + 512 * j;
            xa[j] = *(const u32x4*)(x1b + (size_t)tA * DM + c); xb[j] = *(const u32x4*)(x1b + (size_t)tB * DM + c);
#pragma unroll
            for (int k = 0; k < 4; ++k) { ya[j][k] = *(const u32x4*)(Y + (size_t)sA[k] * DM + c); yb[j][k] = *(const u32x4*)(Y + (size_t)sB[k] * DM + c); } }
        float va[2][8], vb[2][8]; float ssa = 0.f, ssb = 0.f;
#pragma unroll
        for (int j = 0; j < 2; ++j) {
#pragma unroll
            for (int i = 0; i < 4; ++i) { va[j][2 * i] = bflo(xa[j][i]); va[j][2 * i + 1] = bfhi(xa[j][i]); vb[j][2 * i] = bflo(xb[j][i]); vb[j][2 * i + 1] = bfhi(xb[j][i]); }
#pragma unroll
            for (int k = 0; k < 4; ++k)
#pragma unroll
                for (int i = 0; i < 4; ++i) { va[j][2 * i] += bflo(ya[j][k][i]); va[j][2 * i + 1] += bfhi(ya[j][k][i]); vb[j][2 * i] += bflo(yb[j][k][i]); vb[j][2 * i + 1] += bfhi(yb[j][k][i]); }
#pragma unroll
            for (int i = 0; i < 8; ++i) { ssa += va[j][i] * va[j][i]; ssb += vb[j][i] * vb[j][i]; } }
        const float ra = rsqrtf(wave_sum(ssa) * (1.f / DM) + EPS), rb = rsqrtf(wave_sum(ssb) * (1.f / DM) + EPS);
#pragma unroll
        for (int j = 0; j < 2; ++j) { const int c = 8 * F.lane + 512 * j;
            f32x4 o0, o1;
            o0.x = va[j][0] * ra * gg[j][0].x; o0.y = va[j][1] * ra * gg[j][0].y; o0.z = va[j][2] * ra * gg[j][0].z; o0.w = va[j][3] * ra * gg[j][0].w;
            o1.x = va[j][4] * ra * gg[j][1].x; o1.y = va[j][5] * ra * gg[j][1].y; o1.z = va[j][6] * ra * gg[j][1].z; o1.w = va[j][7] * ra * gg[j][1].w;
            *(f32x4*)(F.out + (size_t)tA * DM + c) = o0; *(f32x4*)(F.out + (size_t)tA * DM + c + 4) = o1;
            o0.x = vb[j][0] * rb * gg[j][0].x; o0.y = vb[j][1] * rb * gg[j][0].y; o0.z = vb[j][2] * rb * gg[j][0].z; o0.w = vb[j][3] * rb * gg[j][0].w;
            o1.x = vb[j][4] * rb * gg[j][1].x; o1.y = vb[j][5] * rb * gg[j][1].y; o1.z = vb[j][6] * rb * gg[j][1].z; o1.w = vb[j][7] * rb * gg[j][1].w;
            *(f32x4*)(F.out + (size_t)tB * DM + c) = o0; *(f32x4*)(F.out + (size_t)tB * DM + c + 4) = o1; }
        slA = nA; slB = nB;
    }
}

__global__ void __launch_bounds__(NWAVES * 64, 2) hymba_fwd(Args args) {
    extern __shared__ __attribute__((aligned(16))) unsigned char lds[];
    Frame F;
    F.lds = (LAS unsigned char*)lds;
    F.MISC = (volatile LAS unsigned*)(F.lds + MISC_OFF);
    F.tid = threadIdx.x; F.lane = F.tid & 63; F.wave = __builtin_amdgcn_readfirstlane(F.tid >> 6);
    F.G = gridDim.x; { const int bx = blockIdx.x; F.vcu = (F.G % 8 == 0) ? (bx % 8) * (F.G / 8) + bx / 8 : bx; }
    F.ws = args.ws; F.ctl = (unsigned*)(args.ws + WS_CTL); F.out = args.out;
    for (int u = F.tid; u < (LDS_BYTES - LDSCTL_OFF) / 4; u += NWAVES * 64) ((LAS unsigned*)(F.lds + LDSCTL_OFF))[u] = 0u;
    __syncthreads();
    XcdBarrier bar; bar.bar = F.ctl + CW_BAR; bar.x = 0; bar.st = nullptr;
    if (N_LAUNCHES == 1) bar = xcd_barrier_post(F.ctl + CW_BAR, F.MISC + 8);
#define GRID_BAR() do { if (N_LAUNCHES == 1) xcd_barrier(bar); } while (0)
    const int lo = args.ph_lo, hi = args.ph_hi;
#ifndef PH_MASK
#define PH_MASK 0x1ff
#endif
#define IN(k) (((PH_MASK >> (k)) & 1) && lo <= (k) && (k) < hi)
#define BOTH(k) (IN(k) && IN((k) + 1))
    bf16_t* const H = (bf16_t*)(F.ws + WS_H); bf16_t* const PROJ = (bf16_t*)(F.ws + WS_PROJ); bf16_t* const MIX = (bf16_t*)(F.ws + WS_MIX); bf16_t* const X1B = (bf16_t*)(F.ws + WS_X1B);
    bf16_t* const Win_t = (bf16_t*)(F.ws + WS_WIN); bf16_t* const Wout_t = (bf16_t*)(F.ws + WS_WOUT);
    const unsigned char* const Wgu_q = (const unsigned char*)F.out + OUT_WGU; const unsigned char* const Wd_q = (const unsigned char*)F.out + OUT_WD;
    unsigned char* const X1Q = F.ws + WS_X1Q; unsigned char* const ACTQ = F.ws + WS_ACTQ; bf16_t* const Yp = (bf16_t*)(F.ws + WS_Y);
    const int* const tok_slot = (const int*)(F.ws + WS_TOKSLOT); const float* const gate_slot = (const float*)(F.ws + WS_GATESLOT); const float* const rstd_slot = (const float*)(F.ws + WS_RSTDSLOT);
    const int* const rb_e = (const int*)(F.ws + WS_RBE);

#define REP(k) for (int rep_ = 0; rep_ < (((PROBE_REP >> (k)) & 1) ? 2 : 1); ++rep_)
    if (IN(0)) { REP(0) p0_prologue(F); if (BOTH(0)) GRID_BAR(); }
    if (IN(1)) {
        REP(1) {
        pg8::Gemm g{H, Win_t, DM, 0, nullptr}; pg8::StaticOrder S; S.init(T, INW, F.G, (int)blockIdx.x);
        pg8::EpiProj E{PROJ};
        pg8::gemm_phase<pg8::EpiProj, pg8::StaticOrder, true>(F.lds, g, S, E); }
        if (BOTH(1)) GRID_BAR();
    }
    if (IN(2)) { p2_mixers(F); if (BOTH(2)) GRID_BAR(); }
    if (IN(3)) {
        pg8::Gemm g{MIX, Wout_t, DM, 0, nullptr}; pg8::StaticOrder S; S.init(T, DM, F.G, (int)blockIdx.x);
        pg8::EpiX1 E{kargs()->in[I_X], X1B, X1Q};
        pg8::gemm_phase<pg8::EpiX1, pg8::StaticOrder, true>(F.lds, g, S, E);
        if (BOTH(3)) GRID_BAR();
    }
    if (IN(4)) { if (PROBE_X & 2) p4_router(F, true); p4_router(F); if (BOTH(4)) GRID_BAR(); }
    if (IN(5)) { p5_place(F); if (BOTH(5)) GRID_BAR(); }
    if (IN(6)) {
        const int nrb = rb_e[NRB_MAX];
        REP(6) {
        pg8::Gemm g{(const bf16_t*)X1Q, (const bf16_t*)Wgu_q, DM / 2, (long)2048 * DM / 2, tok_slot}; pg8::GroupOrder S{nrb, 0, 8, F.G, (int)blockIdx.x, rb_e};
        pg8::EpiGU E{ACTQ, kargs()->in[I_BGU], rstd_slot};
        pg8::gemm_phase<pg8::EpiGU, pg8::GroupOrder, true, true, (PROBE_KREP == 2 ? 0x78787878 : 0x79797979), 0x7f7f7f7f, PROBE_KREP>(F.lds, g, S, E); }
        if (BOTH(6)) GRID_BAR();
    }
    if (IN(7)) {
        const int nrb = rb_e[NRB_MAX];
        REP(7) {
        pg8::Gemm g{(const bf16_t*)ACTQ, (const bf16_t*)Wd_q, DEXP / 2, (long)DM * DEXP / 2, nullptr}; pg8::GroupOrder S{nrb, 0, 4, F.G, (int)blockIdx.x, rb_e};
        pg8::EpiDown E{Yp, kargs()->in[I_BDN], gate_slot};
        pg8::gemm_phase<pg8::EpiDown, pg8::GroupOrder, true, true, 0x79797979, 0x7d7d7d7d>(F.lds, g, S, E); }
        if (BOTH(7)) GRID_BAR();
    }
    if (IN(8)) { REP(8) p9_final(F); }
#if PROBE_SEG
    if (IN(8) && blockIdx.x == 0 && F.tid == 0) { const unsigned long long a_ = F.ctl[604], t_ = F.ctl[605]; const unsigned long long us_ = t_ ? a_ * 2000ull / t_ : 0ull; const unsigned long long t0_ = __builtin_amdgcn_s_memrealtime();
        while (__builtin_amdgcn_s_memrealtime() - t0_ < us_ * 100ull) __builtin_amdgcn_s_sleep(8); }
#endif
#if PROBE_CLK
    if (IN(8) && blockIdx.x == 0 && F.tid == 0) { const unsigned long long dc_ = ((unsigned long long)F.ctl[601] << 32) | F.ctl[600]; const unsigned long long dr_ = F.ctl[602];
        const unsigned long long mhz_ = dr_ ? dc_ * 100ull / dr_ : 0ull; const unsigned long long t0_ = __builtin_amdgcn_s_memrealtime();
        while (__builtin_amdgcn_s_memrealtime() - t0_ < mhz_ * 100ull) __builtin_amdgcn_s_sleep(8); }
#endif
#undef IN
#undef BOTH
#undef GRID_BAR
}

extern "C" void kernel_launch(void* const* d_in, const int* in_sizes, int n_in, void* d_out, int out_size, void* d_ws, size_t ws_size, hipStream_t stream) {
    static int grid = 0;
    if (grid == 0) {
        if (n_in != 19 || out_size != T * DM || ws_size < WS_END) { fprintf(stderr, "kernel_launch: unexpected shapes (n_in %d out %d ws %zu)\n", n_in, out_size, ws_size); grid = -1; return; }
        int dev = 0, cus = 0;
        if (hipGetDevice(&dev) != hipSuccess || hipDeviceGetAttribute(&cus, hipDeviceAttributeMultiprocessorCount, dev) != hipSuccess) { grid = -1; return; }
        if (hipFuncSetAttribute((const void*)hymba_fwd, hipFuncAttributeMaxDynamicSharedMemorySize, LDS_BYTES) != hipSuccess) { fprintf(stderr, "kernel_launch: hipFuncSetAttribute failed\n"); grid = -1; return; }
        int per_cu = 0;
        if (hipOccupancyMaxActiveBlocksPerMultiprocessor(&per_cu, (const void*)hymba_fwd, NWAVES * 64, LDS_BYTES) != hipSuccess || per_cu < 1) fprintf(stderr, "kernel_launch: occupancy query reports %d\n", per_cu);
        (void)hipGetLastError();
        grid = cus;
    }
    if (grid < 0) return;
    if (hipMemsetAsync((char*)d_ws + WS_CTL, 0, CTL_ZERO_BYTES, stream) != hipSuccess) return;
    Args a{};
    for (int i = 0; i < 19; ++i) a.in[i] = (const float*)d_in[i];
    a.out = (float*)d_out; a.ws = (unsigned char*)d_ws;
    for (int li = 0; li < N_LAUNCHES; ++li) {
        a.ph_lo = (N_LAUNCHES == 1) ? 0 : li; a.ph_hi = (N_LAUNCHES == 1) ? N_PHASES : li + 1;
        hipLaunchKernelGGL(hymba_fwd, dim3(grid), dim3(NWAVES * 64), LDS_BYTES, stream, a);
    }
}
```

```cpp
#include <hip/hip_runtime.h>
#include <hip/hip_bf16.h>
#include <cstdio>
#include <cstdint>

#ifndef PROBE_REP
#define PROBE_REP 0
#endif
#ifndef PROBE_X
#define PROBE_X 0
#endif
#ifndef PROBE_P0
#define PROBE_P0 0
#endif
#ifndef PROBE_SEG
#define PROBE_SEG 0
#endif
#ifndef PROBE_CLK
#define PROBE_CLK 0
#endif
#ifndef PROBE_KREP
#define PROBE_KREP 1
#endif
#ifndef PROBE_EPI
#define PROBE_EPI 0
#endif
#ifndef MK_N_LAUNCHES
#define MK_N_LAUNCHES 1
#endif

constexpr int BATCH = 8, SEQ = 8192, DM = 1024, T = BATCH * SEQ, INW = 2560, MEML = 256, NEXP = 32, TOPK = 4, DEXP = 1024;
constexpr int COL_U = 0, COL_GB = 256, COL_GC = 512, COL_Q = 768, COL_K = 1280, COL_V = 1792, COL_QM = 2304;
constexpr float EPS = 1e-5f;
constexpr float C2 = 0.125f * 1.4426950408889634f;
constexpr float LOG2E = 1.4426950408889634f;
constexpr int NRB_MAX = 1056;

#define GAS __attribute__((address_space(1)))
#define LAS __attribute__((address_space(3)))
typedef unsigned short bf16_t;
typedef short bf16x8 __attribute__((ext_vector_type(8)));
typedef short s16x4 __attribute__((ext_vector_type(4)));
typedef float f32x4 __attribute__((ext_vector_type(4)));
typedef float f32x16 __attribute__((ext_vector_type(16)));
typedef unsigned u32x4 __attribute__((ext_vector_type(4)));
typedef unsigned u32x2 __attribute__((ext_vector_type(2)));
typedef float f32x2_t __attribute__((ext_vector_type(2)));
typedef __bf16 bf16x2_t __attribute__((ext_vector_type(2)));
typedef GAS unsigned gu32;
#define RLX_AGENT __ATOMIC_RELAXED, __HIP_MEMORY_SCOPE_AGENT
#define LDS_WAIT() asm volatile("s_waitcnt lgkmcnt(0)" ::: "memory")
#define VM_WAIT() asm volatile("s_waitcnt vmcnt(0)" ::: "memory")
#define SBAR() __builtin_amdgcn_sched_barrier(0)

__device__ __forceinline__ unsigned pk2(float lo, float hi) { f32x2_t v = {lo, hi}; bf16x2_t b = __builtin_convertvector(v, bf16x2_t); return __builtin_bit_cast(unsigned, b); }
__device__ __forceinline__ float bflo(unsigned u) { return __uint_as_float(u << 16); }
__device__ __forceinline__ float bfhi(unsigned u) { return __uint_as_float(u & 0xffff0000u); }
__device__ __forceinline__ bf16x8 pack8(f32x4 a, f32x4 b) { u32x4 w = {pk2(a[0], a[1]), pk2(a[2], a[3]), pk2(b[0], b[1]), pk2(b[2], b[3])}; return __builtin_bit_cast(bf16x8, w); }
__device__ __forceinline__ int crow(int r, int hi) { return (r & 3) + 8 * (r >> 2) + 4 * hi; }
__device__ __forceinline__ float wave_sum(float v) {
#pragma unroll
    for (int o = 1; o < 64; o <<= 1) v += __shfl_xor(v, o);
    return v;
}

namespace pg8 {
constexpr int BM = 256, BK = 64, HALF = 128, HTB = HALF * BK * 2  , STAGE_BYTES = 8 * HTB, NXCD = 8, WGM = 8;
__host__ __device__ __forceinline__ int lds_byte(int r, int c) { const int st = (r >> 4) * 2 + (c >> 5), rr = r & 15, cc = c & 31, ob = rr * 64 + cc * 2; return st * 1024 + (ob ^ (((ob >> 9) & 1) << 5)); }
__host__ __device__ __forceinline__ void stage_rc(int b, int& R, int& C) { const int st = b / 1024, sb = b % 1024, swz = sb ^ (((sb >> 9) & 1) << 5); R = (st >> 1) * 16 + swz / 64; C = (st & 1) * 32 + (swz % 64) / 2; }
__host__ __device__ __forceinline__ int perm32(int rho) { const int n = rho >> 4, i = rho & 15; return 8 * (i >> 2) + 4 * n + (i & 3); }

struct Unit { int pm, pn, e; };
struct Gemm { const bf16_t* A; const bf16_t* Bt; int K; long bstride; const int* rowmap; };

struct StaticOrder {
    int nM, nN, nwg, G, c;
    __device__ void init(int M, int N, int G_, int c_) { nM = M / BM; nN = N / BM; nwg = nM * nN; G = G_; c = c_; }
    __device__ bool next(int i, Unit& u) const {
        const long L = (long)i * G + c; if (L >= nwg) return false;
        int wgid = (int)L; { const int q = nwg / NXCD, r = nwg % NXCD, xcd = wgid % NXCD, off = wgid / NXCD; wgid = (xcd < r ? xcd * (q + 1) : r * (q + 1) + (xcd - r) * q) + off; }
        const int nig = WGM * nN, gid = wgid / nig, fm = gid * WGM, gsz = (nM - fm) < WGM ? (nM - fm) : WGM;
        u.pm = fm + ((wgid % nig) % gsz); u.pn = (wgid % nig) / gsz; u.e = 0; return true;
    }
};
struct GroupOrder {
    int nrb, rb0, npn, G, c; const int* rb_e;
    __device__ bool next(int i, Unit& u) const {
        int rbl, pn;
        if ((G & 7) == 0 && ((G >> 3) % npn) == 0) { const int x = c & 7, j = c >> 3, rpx = (G >> 3) / npn; rbl = i * (G / npn) + x * rpx + j / npn; pn = j % npn; }
        else { const long L = (long)i * G + c; rbl = (int)(L / npn); pn = (int)(L % npn); }
        if (rbl >= nrb) return false;
        u.pm = rb0 + rbl; u.pn = pn; u.e = rb_e[u.pm]; return true;
    }
};

typedef int v4i_t __attribute__((ext_vector_type(4)));
typedef int v8i_t __attribute__((ext_vector_type(8)));
template <class Epi, class Sched, bool ALIGN_EPI, bool FP8 = false, int SCW = 0x7f7f7f7f, int SCA = 0x7f7f7f7f, int KREP = 1>
__device__ __forceinline__ void gemm_phase(LAS unsigned char* lds, const Gemm g, const Sched& S, const Epi& E) {
    const int tid = threadIdx.x, wid = __builtin_amdgcn_readfirstlane(tid >> 6), lane = tid & 63, wr = wid >> 2, wc = wid & 3, fr = lane & 15, fq = lane >> 4;
    const int K = g.K; int nt = K / BK; asm volatile("" : "+s"(nt));
    int Rr[2], Cc[2]; unsigned voffB[2];
#pragma unroll
    for (int i = 0; i < 2; ++i) { int R, C; stage_rc(tid * 16 + i * 8192, R, C); const int Rb = Epi::PERM ? ((R & ~31) + perm32(R & 31)) : R;
        Rr[i] = R; Cc[i] = C; voffB[i] = (unsigned)(Rb * K + C) * 2u; }
    const size_t kstep = (size_t)(BK * 2);
    const size_t hstep = (size_t)HALF * K * 2;
    const size_t tstep = 2 * hstep;
    const unsigned ldsw = (unsigned)wid * 1024u;
    const int aoff = lds_byte(wr * 64 + fr, fq * 8), boff = lds_byte(wc * 32 + fr, fq * 8);
#define PG8_SA(b, h) (((b) * 2 + (h)) * HTB)
#define PG8_SB(b, h) ((4 + (b) * 2 + (h)) * HTB)
#define PG8_STAGE(bufoff, gbase, voff) do { _Pragma("unroll") for (int _i = 0; _i < 2; ++_i) \
        __builtin_amdgcn_global_load_lds((const unsigned*)((const char*)(gbase) + (voff)[_i]), (LAS unsigned*)(lds + (bufoff) + ldsw + _i * 8192), 16, 0, 0); } while (0)
#define PG8_STAGE_A(bufoff, kptr, offs, h) do { _Pragma("unroll") for (int _i = 0; _i < 2; ++_i) \
        __builtin_amdgcn_global_load_lds((const unsigned*)((const char*)(kptr) + (offs)[h][_i]), (LAS unsigned*)(lds + (bufoff) + ldsw + _i * 8192), 16, 0, 0); } while (0)
#define PG8_AOFF(dst, u) do { _Pragma("unroll") for (int _h = 0; _h < 2; ++_h) _Pragma("unroll") for (int _i = 0; _i < 2; ++_i) { const int _row = (u).pm * BM + _h * HALF + Rr[_i]; \
        const int _src = g.rowmap ? g.rowmap[_row] : _row; dst[_h][_i] = (unsigned)(_src * K + Cc[_i]) * 2u; } } while (0)
#define PG8_LDA(dst, b, h) do { _Pragma("unroll") for (int m = 0; m < 4; ++m) _Pragma("unroll") for (int k = 0; k < 2; ++k) dst[m][k] = *(const LAS bf16x8*)(lds + PG8_SA(b, h) + aoff + m * 2048 + k * 1024); } while (0)
#define PG8_LDB(dst, b, h) do { _Pragma("unroll") for (int n = 0; n < 2; ++n) _Pragma("unroll") for (int k = 0; k < 2; ++k) dst[n][k] = *(const LAS bf16x8*)(lds + PG8_SB(b, h) + boff + n * 2048 + k * 1024); } while (0)
#define PG8_CAT(x, y) __builtin_shufflevector(__builtin_bit_cast(v4i_t, x), __builtin_bit_cast(v4i_t, y), 0, 1, 2, 3, 4, 5, 6, 7)
#define PG8_MMA(ai, bj, At, Bt) do { __builtin_amdgcn_s_setprio(1); _Pragma("unroll") for (int m = 0; m < 4; ++m) _Pragma("unroll") for (int n = 0; n < 2; ++n) { \
        if constexpr (FP8) { acc[ai][bj][m][n] = __builtin_amdgcn_mfma_scale_f32_16x16x128_f8f6f4(PG8_CAT(Bt[n][0], Bt[n][1]), PG8_CAT(At[m][0], At[m][1]), acc[ai][bj][m][n], 0, 0, 0, SCW, 0, SCA); } \
        else { _Pragma("unroll") for (int k = 0; k < 2; ++k) acc[ai][bj][m][n] = __builtin_amdgcn_mfma_f32_16x16x32_bf16(Bt[n][k], At[m][k], acc[ai][bj][m][n], 0, 0, 0); } } \
        __builtin_amdgcn_s_setprio(0); } while (0)
#define PG8_WAIT_V(n) asm volatile("s_waitcnt vmcnt(" #n ")" ::: "memory")
#define PG8_WAIT_L(n) asm volatile("s_waitcnt lgkmcnt(" #n ")" ::: "memory")
#define PG8_BAR __builtin_amdgcn_s_barrier()
#define PG8_SCHED __builtin_amdgcn_sched_barrier(0)
    Unit cur, nxt; int ui = 0;
    if (!S.next(0, cur)) return;
    f32x4 acc[2][2][4][2];
#pragma unroll
    for (int a = 0; a < 2; ++a)
#pragma unroll
        for (int b = 0; b < 2; ++b)
#pragma unroll
            for (int m = 0; m < 4; ++m)
#pragma unroll
                for (int n = 0; n < 2; ++n) acc[a][b][m][n] = (f32x4){0.f, 0.f, 0.f, 0.f};
    bf16x8 At[4][2], B0[2][2], B1[2][2];
    unsigned aoc[2][2], aon[2][2];
    PG8_AOFF(aoc, cur);
    const char* Ab = (const char*)g.A;
    const char* cB = (const char*)g.Bt + ((size_t)cur.e * (size_t)g.bstride) * 2 + (size_t)cur.pn * tstep;
    PG8_STAGE(PG8_SB(0, 0), cB, voffB); PG8_STAGE(PG8_SB(0, 1), cB + hstep, voffB); PG8_STAGE_A(PG8_SA(0, 0), Ab, aoc, 0); PG8_STAGE_A(PG8_SA(0, 1), Ab, aoc, 1);
    if (wr == 1) PG8_BAR;
    PG8_WAIT_V(2); PG8_BAR;
    PG8_STAGE(PG8_SB(1, 0), cB + kstep, voffB); PG8_STAGE_A(PG8_SA(1, 0), Ab + kstep, aoc, 0); PG8_STAGE(PG8_SB(1, 1), cB + hstep + kstep, voffB);
    PG8_WAIT_V(6); PG8_BAR;
    for (;;) {
        const bool has_next = S.next(ui + 1, nxt);
        if (has_next) { PG8_AOFF(aon, nxt); }
        else {
#pragma unroll
            for (int h = 0; h < 2; ++h)
#pragma unroll
                for (int i = 0; i < 2; ++i) aon[h][i] = aoc[h][i];
        }
        const char* nB = has_next ? (const char*)g.Bt + ((size_t)nxt.e * (size_t)g.bstride) * 2 + (size_t)nxt.pn * tstep : cB;
#pragma nounroll
        for (int t = 0; t < nt * KREP; t += 2) {
            const bool last = (t == nt * KREP - 2);
            const char* a1 = Ab + (size_t)((t + 1) & (nt - 1)) * kstep;
            const char* a2 = last ? Ab : Ab + (size_t)((t + 2) & (nt - 1)) * kstep; const char* b2 = last ? nB : cB + (size_t)((t + 2) & (nt - 1)) * kstep;
            const char* a3 = a2 + kstep; const char* b3 = b2 + kstep;
            PG8_LDB(B0, 0, 0); PG8_LDB(B1, 0, 1); PG8_SCHED; PG8_LDA(At, 0, 0); PG8_STAGE_A(PG8_SA(1, 1), a1, aoc, 1);
            if (last) {
#pragma unroll
                for (int h = 0; h < 2; ++h)
#pragma unroll
                    for (int i = 0; i < 2; ++i) aoc[h][i] = aon[h][i]; }
            PG8_WAIT_V(8); PG8_WAIT_L(0); PG8_BAR; PG8_MMA(0, 0, At, B0); PG8_MMA(0, 1, At, B1); PG8_BAR; PG8_SCHED;
            PG8_LDA(At, 0, 1); PG8_STAGE(PG8_SB(0, 0), b2, voffB); PG8_STAGE(PG8_SB(0, 1), b2 + hstep, voffB); PG8_STAGE_A(PG8_SA(0, 0), a2, aoc, 0);
            PG8_WAIT_V(8); PG8_WAIT_L(0); PG8_BAR; PG8_MMA(1, 0, At, B0); PG8_MMA(1, 1, At, B1); PG8_BAR; PG8_SCHED;
            PG8_LDB(B0, 1, 0); PG8_LDB(B1, 1, 1); PG8_SCHED; PG8_LDA(At, 1, 0); PG8_STAGE_A(PG8_SA(0, 1), a2, aoc, 1);
            PG8_WAIT_V(8); PG8_WAIT_L(0); PG8_BAR; PG8_MMA(0, 0, At, B0); PG8_MMA(0, 1, At, B1); PG8_BAR; PG8_SCHED;
            PG8_LDA(At, 1, 1); PG8_STAGE(PG8_SB(1, 0), b3, voffB); PG8_STAGE(PG8_SB(1, 1), b3 + hstep, voffB); PG8_STAGE_A(PG8_SA(1, 0), a3, aoc, 0);
            PG8_WAIT_V(8); PG8_WAIT_L(0); PG8_BAR; PG8_MMA(1, 0, At, B0); PG8_MMA(1, 1, At, B1); PG8_BAR; PG8_SCHED;
        }
        if constexpr (ALIGN_EPI) { if (wr == 0) PG8_BAR; }
        E(acc, cur, wr, wc, fr, fq);
        if constexpr (FP8 && PROBE_EPI != 0) { asm volatile("" ::: "memory"); E(acc, cur, wr, wc, fr, fq); }
        if (!has_next) break;
#pragma unroll
        for (int a = 0; a < 2; ++a)
#pragma unroll
            for (int b = 0; b < 2; ++b)
#pragma unroll
                for (int m = 0; m < 4; ++m)
#pragma unroll
                    for (int n = 0; n < 2; ++n) acc[a][b][m][n] = (f32x4){0.f, 0.f, 0.f, 0.f};
        cur = nxt; cB = nB; ++ui;
        if constexpr (ALIGN_EPI) { if (wr == 1) PG8_BAR; }
    }
    PG8_WAIT_V(0);
    if constexpr (!ALIGN_EPI) { if (wr == 0) PG8_BAR; }
    PG8_BAR;
#undef PG8_SA
#undef PG8_SB
#undef PG8_STAGE
#undef PG8_STAGE_A
#undef PG8_AOFF
#undef PG8_LDA
#undef PG8_LDB
#undef PG8_MMA
#undef PG8_CAT
#undef PG8_WAIT_V
#undef PG8_WAIT_L
#undef PG8_BAR
#undef PG8_SCHED
}

struct EpiProj {
    static constexpr bool PERM = true;
    bf16_t* O;
    __device__ __forceinline__ void operator()(const f32x4 (&acc)[2][2][4][2], const Unit& u, int wr, int wc, int fr, int fq) const {
        const int row0 = u.pm * BM + wr * 64 + fr, col0 = u.pn * BM + wc * 32 + 8 * fq;
        const float sc = (u.pn == 3 || u.pn == 4 || u.pn == 9) ? C2 : 1.f;
#pragma unroll
        for (int ai = 0; ai < 2; ++ai)
#pragma unroll
            for (int m = 0; m < 4; ++m) { bf16_t* rowp = O + (size_t)(row0 + ai * HALF + m * 16) * INW + col0;
#pragma unroll
                for (int bj = 0; bj < 2; ++bj) { const f32x4 v0 = acc[ai][bj][m][0] * sc, v1 = acc[ai][bj][m][1] * sc;
                    u32x4 w; w.x = pk2(v0[0], v0[1]); w.y = pk2(v0[2], v0[3]); w.z = pk2(v1[0], v1[1]); w.w = pk2(v1[2], v1[3]);
                    *(u32x4*)(rowp + bj * HALF) = w; } }
    }
};
__device__ __forceinline__ unsigned pk4_fp8(float a, float b, float c, float d) { int w = 0; w = __builtin_amdgcn_cvt_pk_fp8_f32(a, b, w, false); w = __builtin_amdgcn_cvt_pk_fp8_f32(c, d, w, true); return (unsigned)w; }
struct EpiX1 {
    static constexpr bool PERM = true;
    const float* X; bf16_t* O; unsigned char* Q8;
    __device__ __forceinline__ void operator()(const f32x4 (&acc)[2][2][4][2], const Unit& u, int wr, int wc, int fr, int fq) const {
        const int row0 = u.pm * BM + wr * 64 + fr, col0 = u.pn * BM + wc * 32 + 8 * fq;
#pragma unroll
        for (int ai = 0; ai < 2; ++ai)
#pragma unroll
            for (int m = 0; m < 4; ++m) { const size_t off = (size_t)(row0 + ai * HALF + m * 16) * DM + col0;
#pragma unroll
                for (int bj = 0; bj < 2; ++bj) { const f32x4 x0 = *(const f32x4*)(X + off + bj * HALF), x1 = *(const f32x4*)(X + off + bj * HALF + 4);
                    const f32x4 v0 = acc[ai][bj][m][0] + x0, v1 = acc[ai][bj][m][1] + x1;
                    u32x4 w; w.x = pk2(v0[0], v0[1]); w.y = pk2(v0[2], v0[3]); w.z = pk2(v1[0], v1[1]); w.w = pk2(v1[2], v1[3]);
                    *(u32x4*)(O + off + bj * HALF) = w;
                    u32x2 q; q.x = pk4_fp8(v0[0], v0[1], v0[2], v0[3]); q.y = pk4_fp8(v1[0], v1[1], v1[2], v1[3]);
                    *(u32x2*)(Q8 + off + bj * HALF) = q; } }
    }
};
struct EpiGU {
    static constexpr bool PERM = true;
    unsigned char* ACT; const float* bias; const float* rstd;
    __device__ __forceinline__ void operator()(const f32x4 (&acc)[2][2][4][2], const Unit& u, int wr, int wc, int fr, int fq) const {
        const int row0 = u.pm * BM + wr * 64 + fr, j0 = u.pn * HALF + wc * 32 + 8 * fq;
        const float* bp = bias + (size_t)u.e * 2048 + j0;
        const f32x4 bg0 = *(const f32x4*)(bp), bg1 = *(const f32x4*)(bp + 4), bu0 = *(const f32x4*)(bp + 1024), bu1 = *(const f32x4*)(bp + 1028);
#pragma unroll
        for (int ai = 0; ai < 2; ++ai)
#pragma unroll
            for (int m = 0; m < 4; ++m) { const int row = row0 + ai * HALF + m * 16; const float rs = rstd[row];
                f32x4 g0 = acc[ai][0][m][0] * rs + bg0, g1 = acc[ai][0][m][1] * rs + bg1, u0 = acc[ai][1][m][0] * rs + bu0, u1 = acc[ai][1][m][1] * rs + bu1;
                float o[8];
#pragma unroll
                for (int i = 0; i < 4; ++i) {
                    { const float gg = fminf(g0[i], 7.f), uu = __builtin_amdgcn_fmed3f(u0[i], -7.f, 7.f); const float s4 = gg * __builtin_amdgcn_rcpf(fmaf(__builtin_amdgcn_exp2f(-1.702f * LOG2E * gg), 0.25f, 0.25f)); o[i] = fmaf(uu, s4, s4); }
                    { const float gg = fminf(g1[i], 7.f), uu = __builtin_amdgcn_fmed3f(u1[i], -7.f, 7.f); const float s4 = gg * __builtin_amdgcn_rcpf(fmaf(__builtin_amdgcn_exp2f(-1.702f * LOG2E * gg), 0.25f, 0.25f)); o[4 + i] = fmaf(uu, s4, s4); }
                }
                u32x2 w; w.x = pk4_fp8(o[0], o[1], o[2], o[3]); w.y = pk4_fp8(o[4], o[5], o[6], o[7]);
                *(u32x2*)(ACT + (size_t)row * DEXP + j0) = w; }
    }
};
struct EpiDown {
    static constexpr bool PERM = true;
    unsigned char* Y; const float* bias; const float* gate;
    __device__ __forceinline__ void operator()(const f32x4 (&acc)[2][2][4][2], const Unit& u, int wr, int wc, int fr, int fq) const {
        const int row0 = u.pm * BM + wr * 64 + fr, col0 = u.pn * BM + wc * 32 + 8 * fq;
        const float* bp = bias + (size_t)u.e * DM + col0;
        f32x4 bv[2][2];
#pragma unroll
        for (int bj = 0; bj < 2; ++bj) { bv[bj][0] = *(const f32x4*)(bp + bj * HALF); bv[bj][1] = *(const f32x4*)(bp + bj * HALF + 4); }
#pragma unroll
        for (int ai = 0; ai < 2; ++ai)
#pragma unroll
            for (int m = 0; m < 4; ++m) { const int row = row0 + ai * HALF + m * 16; const float gs = 8.f * gate[row];
#pragma unroll
                for (int bj = 0; bj < 2; ++bj) { const f32x4 v0 = (acc[ai][bj][m][0] + bv[bj][0]) * gs, v1 = (acc[ai][bj][m][1] + bv[bj][1]) * gs;
                    u32x2 w; w.x = pk4_fp8(v0[0], v0[1], v0[2], v0[3]); w.y = pk4_fp8(v1[0], v1[1], v1[2], v1[3]);
                    *(u32x2*)(Y + (size_t)row * DM + col0 + bj * HALF) = w; } }
    }
};
}

namespace dattn {
constexpr int NW = 8, QBLK = 32, KVBLK = 64, QB = 256, PITCH = INW;
constexpr int SHM_V = KVBLK * 128 * 2, SHM_K = KVBLK * 64 * 2;
constexpr int NVS = 4, NKS = 3;
constexpr int OFF_V = 0, OFF_K = NVS * SHM_V, OFF_WS = OFF_K + NKS * SHM_K, OFF_STASH = OFF_WS + NW * 64 * 4, OFF_TB = OFF_STASH + NW * 8192, LDS_BYTES = OFF_TB + 4 * 128 * 4;
constexpr float THR = 8.f;
__device__ __forceinline__ int v_st(int k, int c) { const int kk = k;     return ((kk >> 3) * 4 + (c >> 5)) * 512 + ((kk & 7) * 32 + (c & 31)) * 2; }
__device__ __forceinline__ int v_rd_base(int lane) { return ((lane & 3) << 3) | (((lane >> 2) & 3) << 6) | (((lane >> 4) & 1) << 5) | (((lane >> 5) & 1) << 8); }
constexpr int v_rd_off(int d0, int ks, int half) { return d0 * 512 + ks * 4096 + half * 2048; }

struct Ref { unsigned qoff, koff, voff; bf16_t* O; int P0, comp, h; };
typedef __amdgpu_buffer_rsrc_t rsrc_t;
__device__ __forceinline__ bf16x8 bld8(rsrc_t r, unsigned voff, unsigned soff) { return __builtin_bit_cast(bf16x8, __builtin_amdgcn_raw_buffer_load_b128(r, (int)voff, (int)soff, 0)); }
struct Seam { bf16x8 qr[4]; int ks, vs;
#if PROBE_SEG
    unsigned long long acc, tot;
#endif
};

__device__ __forceinline__ bf16x8 ld8(const bf16_t* p) { return *reinterpret_cast<const bf16x8*>(p); }

__device__ __forceinline__ void bias_mask(f32x16& p0, f32x16& p1, int sdq  , const LAS float* tb) {
    const float NEG = -__builtin_inff();
    int lane_ = (int)__builtin_amdgcn_mbcnt_hi(~0u, __builtin_amdgcn_mbcnt_lo(~0u, 0u));
    int dq = sdq + (lane_ & 31) - 4 * (lane_ >> 5);
    asm volatile("" : "+v"(dq));
#pragma unroll
    for (int r = 0; r < 16; ++r) {
        const int c = (r & 3) + 8 * (r >> 2);
        const int d0 = dq - c, d1 = dq - c - 32;
        const int i0 = d0 < 0 ? 0 : (d0 > 127 ? 127 : d0), i1 = d1 < 0 ? 0 : (d1 > 127 ? 127 : d1);
        const float b0 = tb[i0], b1 = tb[i1];
        p0[r] = d0 < 0 ? NEG : p0[r] + b0;
        p1[r] = d1 < 0 ? NEG : p1[r] + b1;
    }
}
__device__ __forceinline__ void partialSM(f32x16& p0, f32x16& p1, float& m_reg, float& alpha) {
    float pmax = p0[0];
#pragma unroll
    for (int r = 1; r < 16; ++r) pmax = fmaxf(pmax, p0[r]);
#pragma unroll
    for (int r = 0; r < 16; ++r) pmax = fmaxf(pmax, p1[r]);
    { auto rr = __builtin_amdgcn_permlane32_swap(__float_as_uint(pmax), __float_as_uint(pmax), false, false);
      pmax = fmaxf(__uint_as_float(rr[0]), __uint_as_float(rr[1])); }
    float mn;
    if (__builtin_expect(__all((pmax - m_reg) <= THR), 1)) { mn = m_reg; alpha = 1.f; }
    else { mn = fmaxf(m_reg, pmax); alpha = __builtin_amdgcn_exp2f(m_reg - mn); m_reg = mn; }
#pragma unroll
    for (int r = 0; r < 16; ++r) p0[r] = p0[r] - mn;
#pragma unroll
    for (int r = 0; r < 16; ++r) p1[r] = p1[r] - mn;
#pragma unroll
    for (int r = 0; r < 16; ++r) p0[r] = __builtin_amdgcn_exp2f(p0[r]);
}
__device__ __forceinline__ void finishSM(f32x16& p0, f32x16& p1, float alpha, float& l_reg, bf16x8& pa0, bf16x8& pa1, bf16x8& pa2, bf16x8& pa3) {
#pragma unroll
    for (int r = 0; r < 16; ++r) p1[r] = __builtin_amdgcn_exp2f(p1[r]);
    float ps = 0;
#pragma unroll
    for (int r = 0; r < 16; ++r) ps += p0[r];
#pragma unroll
    for (int r = 0; r < 16; ++r) ps += p1[r];
    { auto rr = __builtin_amdgcn_permlane32_swap(__float_as_uint(ps), __float_as_uint(ps), false, false);
      ps = __uint_as_float(rr[0]) + __uint_as_float(rr[1]); }
    l_reg = l_reg * alpha + ps;
#define PK4(P, B_, OUT) do { unsigned a0 = pk2(P[B_+0], P[B_+1]), a1 = pk2(P[B_+2], P[B_+3]);                          \
        unsigned b0 = pk2(P[B_+4], P[B_+5]), b1 = pk2(P[B_+6], P[B_+7]);                                             \
        auto r0 = __builtin_amdgcn_permlane32_swap(a0, b0, false, false); auto r1 = __builtin_amdgcn_permlane32_swap(a1, b1, false, false); \
        u32x4 w = {r0[0], r1[0], r0[1], r1[1]}; OUT = __builtin_bit_cast(bf16x8, w); } while (0)
    PK4(p0, 0, pa0); PK4(p0, 8, pa1); PK4(p1, 0, pa2); PK4(p1, 8, pa3);
#undef PK4
}
template <int KB>
__device__ __forceinline__ void qkt(f32x16& p0, f32x16& p1, const LAS unsigned char* K_lds, int r32, int hi, const bf16x8* qr) {
    p0 = f32x16{}; p1 = f32x16{};
    const int s = (r32 >> 1) & 7;
#pragma unroll
    for (int d0 = 0; d0 < 4; ++d0) {
        const LAS unsigned char* a = K_lds + KB * SHM_K + r32 * 128 + (((2 * d0 + hi) ^ s) << 4);
        const bf16x8 b0 = *(const LAS bf16x8*)(a);
        const bf16x8 b1 = *(const LAS bf16x8*)(a + 32 * 128);
        p0 = __builtin_amdgcn_mfma_f32_32x32x16_bf16(b0, qr[d0], p0, 0, 0, 0);
        p1 = __builtin_amdgcn_mfma_f32_32x32x16_bf16(b1, qr[d0], p1, 0, 0, 0); }
}
__device__ __forceinline__ void pv_tile(f32x16* o, int vb0, bf16x8 pa0, bf16x8 pa1, bf16x8 pa2, bf16x8 pa3) {
#define TRRD(dst, off) asm volatile("ds_read_b64_tr_b16 %0, %1 offset:%2" : "=&v"(dst) : "v"(vb0), "i"(off) : "memory")
#define PV_D0(d0) do { s16x4 l0, l1, l2, l3, h0, h1, h2, h3; constexpr int b_ = v_rd_off(d0, 0, 0); \
        TRRD(l0, b_); TRRD(h0, b_ + 2048); TRRD(l1, b_ + 4096); TRRD(h1, b_ + 6144); TRRD(l2, b_ + 8192); TRRD(h2, b_ + 10240); TRRD(l3, b_ + 12288); TRRD(h3, b_ + 14336); \
        asm volatile("s_waitcnt lgkmcnt(0)" ::: "memory"); SBAR();   \
        o[d0] = __builtin_amdgcn_mfma_f32_32x32x16_bf16(pa0, (bf16x8){l0[0], l0[1], l0[2], l0[3], h0[0], h0[1], h0[2], h0[3]}, o[d0], 0, 0, 0);   \
        o[d0] = __builtin_amdgcn_mfma_f32_32x32x16_bf16(pa1, (bf16x8){l1[0], l1[1], l1[2], l1[3], h1[0], h1[1], h1[2], h1[3]}, o[d0], 0, 0, 0);   \
        o[d0] = __builtin_amdgcn_mfma_f32_32x32x16_bf16(pa2, (bf16x8){l2[0], l2[1], l2[2], l2[3], h2[0], h2[1], h2[2], h2[3]}, o[d0], 0, 0, 0);   \
        o[d0] = __builtin_amdgcn_mfma_f32_32x32x16_bf16(pa3, (bf16x8){l3[0], l3[1], l3[2], l3[3], h3[0], h3[1], h3[2], h3[3]}, o[d0], 0, 0, 0); } while (0)
    PV_D0(0); PV_D0(1); PV_D0(2); PV_D0(3);
#undef PV_D0
#undef TRRD
}

#define DA_DMA16(gp, ldsp) __builtin_amdgcn_global_load_lds((const unsigned*)(gp), (LAS unsigned*)(ldsp), 16, 0, 0)
#define DA_STAGE(koff_, voff_, k0, ksoff, vsoff) do { const size_t tb_ = (size_t)(k0) * (PITCH * 2); \
        DA_DMA16(projb + (koff_) + tb_ + lk, K_lds + (ksoff) + wid * 1024); \
        DA_DMA16(projb + (voff_) + tb_ + lv, V_lds + (vsoff) + wid * 2048); \
        DA_DMA16(projb + (voff_) + tb_ + lv + 128, V_lds + (vsoff) + wid * 2048 + 1024); } while (0)
#define DA_LANE_OFFS() const int krow_ = 8 * wid + (lane >> 3); \
        const unsigned lk = (unsigned)(krow_ * PITCH) * 2u + (unsigned)(((lane & 7) ^ ((krow_ >> 1) & 7)) << 4); \
        const unsigned lv = (unsigned)((8 * wid + ((lane & 31) >> 2)) * PITCH) * 2u + (unsigned)(((lane >> 5) * 32 + (lane & 3) * 8) * 2)

__device__ __forceinline__ void prime(const Ref& cur, LAS unsigned char* lds, Seam& S, rsrc_t R, const char* projb) {
    const int tid = threadIdx.x, wid = __builtin_amdgcn_readfirstlane(tid >> 6), lane = tid & 63, r32 = lane & 31, hi = lane >> 5;
    DA_LANE_OFFS();
    const unsigned lq = (unsigned)((wid * QBLK + r32) * PITCH + hi * 8) * 2u;
    LAS unsigned char* K_lds = lds + OFF_K; LAS unsigned char* V_lds = lds + OFF_V;
#pragma unroll
    for (int d0 = 0; d0 < 4; ++d0) S.qr[d0] = bld8(R, lq + d0 * 32, cur.qoff);
    S.ks = 0; S.vs = 0;
    DA_STAGE(cur.koff, cur.voff, 0, 0, 0); DA_STAGE(cur.koff, cur.voff, KVBLK, SHM_K, SHM_V);
    __syncthreads();
}
__device__ __forceinline__ void block(const Ref& cur, const Ref& nxt, LAS unsigned char* lds, Seam& S, float lam, const float* gsub, rsrc_t R, const char* projb) {
    const int tid = threadIdx.x, wid = __builtin_amdgcn_readfirstlane(tid >> 6), lane = tid & 63, r32 = lane & 31, hi = lane >> 5;
    const int NT = (cur.P0 + QB) / KVBLK;
    const int qlo = cur.P0 + wid * QBLK;
    LAS unsigned char* V_lds = lds + OFF_V; LAS unsigned char* K_lds = lds + OFF_K;
    LAS float* ws = (LAS float*)(lds + OFF_WS) + wid * 64; LAS float* li_l = ws; LAS float* al_l = ws + 32;
    const LAS float* tbh = (const LAS float*)(lds + OFF_TB) + cur.h * 128;
    float mhat = 0.f, l_reg = 0.f, rmx = 0.f; f32x16 o[4] = {}; f32x16 negm = f32x16{};
    bool resc = false;
    const int vb0 = (int)(unsigned)(uintptr_t)V_lds + v_rd_base(lane);
    DA_LANE_OFFS();
    const unsigned Kh = cur.koff, Vh = cur.voff;
#define KNEXT(x) (((x) == (NKS - 1) * SHM_K) ? 0 : (x) + SHM_K)
#define VNEXT(x) (((x) == (NVS - 1) * SHM_V) ? 0 : (x) + SHM_V)
    int k0 = S.ks, k1 = KNEXT(k0), k2 = KNEXT(k1);
    int v1 = S.vs, v2 = VNEXT(v1), v3 = VNEXT(v2), v0 = VNEXT(v3);
#define ROT() do { const int kn_ = k0; k0 = k1; k1 = k2; k2 = kn_; const int vn_ = v0; v0 = v1; v1 = v2; v2 = v3; v3 = vn_; } while (0)
#define STREAM(j) do { const bool in_ = (j) < NT; const unsigned ko_ = in_ ? Kh : nxt.koff, vo_ = in_ ? Vh : nxt.voff; const int tj_ = in_ ? (j) : (j) - NT; DA_STAGE(ko_, vo_, KBASE(tj_), k2, v3); } while (0)
#define STEP_BAR() asm volatile("s_waitcnt vmcnt(3) lgkmcnt(0)\n\ts_barrier" ::: "memory")
    const int ksw = (r32 >> 1) & 7;
    const LAS unsigned char* kbase = K_lds + r32 * 128;
#define KBASE(t) ((t) * KVBLK)
#define NEAR(P0_, P1_, t) do { const int kb_ = KBASE(t); if (kb_ >= qlo - 175) bias_mask(P0_, P1_, qlo - kb_, tbh); } while (0)
#define RESC() do { if (resc) { asm volatile("s_waitcnt lgkmcnt(0)" ::: "memory");              \
                     _Pragma("unroll") for (int d_ = 0; d_ < 4; ++d_) _Pragma("unroll") for (int r = 0; r < 16; ++r) o[d_][r] *= al_l[crow(r, hi)]; } } while (0)
#define PIN(x) asm volatile("" : "+v"(x))
#define EX(v) __builtin_amdgcn_exp2f(v)
#define MX3(a, b, c) __builtin_fmaxf(__builtin_fmaxf((a), (b)), (c))
#define DECIDE(C0, C1, FIRST) do { \
        float a_ = MX3(C0[0], C0[1], C1[0]), b_ = MX3(C0[2], C0[3], C1[1]); a_ = MX3(a_, C1[2], C1[3]); \
        _Pragma("unroll") for (int r = 4; r < 16; r += 4) { a_ = MX3(a_, C0[r], C0[r + 1]); b_ = MX3(b_, C0[r + 2], C0[r + 3]); a_ = MX3(a_, C1[r], C1[r + 1]); b_ = MX3(b_, C1[r + 2], C1[r + 3]); } \
        float rm_ = __builtin_fmaxf(a_, b_); { auto rr_ = __builtin_amdgcn_permlane32_swap(__float_as_uint(rm_), __float_as_uint(rm_), false, false); rm_ = __builtin_fmaxf(__uint_as_float(rr_[0]), __uint_as_float(rr_[1])); } \
        resc = false; \
        if ((FIRST) || __builtin_expect(__any(rm_ > THR), 0)) { const float dl_ = (FIRST) ? rm_ : __builtin_fmaxf(rm_, 0.f); mhat += dl_; \
            _Pragma("unroll") for (int r = 0; r < 16; ++r) { C0[r] -= dl_; C1[r] -= dl_; } \
            _Pragma("unroll") for (int r = 0; r < 16; ++r) negm[r] = -mhat; \
            asm volatile("" : "+v"(negm)); \
            if (!(FIRST)) { const float f_ = EX(-dl_); l_reg *= f_; if (hi == 0) al_l[r32] = f_; resc = true; } } } while (0)
#define DECIDE2(C0, C1) do { float rm_ = rmx; { auto rr_ = __builtin_amdgcn_permlane32_swap(__float_as_uint(rm_), __float_as_uint(rm_), false, false); rm_ = __builtin_fmaxf(__uint_as_float(rr_[0]), __uint_as_float(rr_[1])); } \
        resc = false; \
        if (__builtin_expect(__any(rm_ > THR), 0)) { const float dl_ = __builtin_fmaxf(rm_, 0.f); mhat += dl_; const float f_ = EX(-dl_); \
            _Pragma("unroll") for (int r = 0; r < 16; ++r) { C0[r] *= f_; C1[r] *= f_; } \
            _Pragma("unroll") for (int r = 0; r < 16; ++r) negm[r] = -mhat; \
            asm volatile("" : "+v"(negm)); \
            l_reg *= f_; if (hi == 0) al_l[r32] = f_; resc = true; } } while (0)
#define KF(d0, hf) (*(const LAS bf16x8*)(kbase + k0 + (((2 * (d0) + hi) ^ ksw) << 4) + (hf) * 4096))
#define GAPA(MF, P, B, W) do { MF; sacc += P[B]; sacc += P[B + 1]; sacc += P[B + 2]; sacc += P[B + 3]; PIN(sacc); W[((B) >> 1) & 3] = pk2(P[B], P[B + 1]); W[(((B) >> 1) & 3) + 1] = pk2(P[B + 2], P[B + 3]); PIN(W); SBAR(); } while (0)
#define PHASE_A(C0, C1, P0, P1) do { \
        const bf16x8 k00 = KF(0, 0), k01 = KF(0, 1), k10 = KF(1, 0), k11 = KF(1, 1), k20 = KF(2, 0), k21 = KF(2, 1), k30 = KF(3, 0), k31 = KF(3, 1); \
        float sacc = 0.f; SBAR(); \
        GAPA(C0 = __builtin_amdgcn_mfma_f32_32x32x16_bf16(k00, S.qr[0], negm, 0, 0, 0), P0, 0, pw0); \
        GAPA(C1 = __builtin_amdgcn_mfma_f32_32x32x16_bf16(k01, S.qr[0], negm, 0, 0, 0), P0, 4, pw0); \
        GAPA(C0 = __builtin_amdgcn_mfma_f32_32x32x16_bf16(k10, S.qr[1], C0, 0, 0, 0), P0, 8, pw1); \
        GAPA(C1 = __builtin_amdgcn_mfma_f32_32x32x16_bf16(k11, S.qr[1], C1, 0, 0, 0), P0, 12, pw1); \
        GAPA(C0 = __builtin_amdgcn_mfma_f32_32x32x16_bf16(k20, S.qr[2], C0, 0, 0, 0), P1, 0, pw2); \
        GAPA(C1 = __builtin_amdgcn_mfma_f32_32x32x16_bf16(k21, S.qr[2], C1, 0, 0, 0), P1, 4, pw2); \
        GAPA(C0 = __builtin_amdgcn_mfma_f32_32x32x16_bf16(k30, S.qr[3], C0, 0, 0, 0), P1, 8, pw3); \
        GAPA(C1 = __builtin_amdgcn_mfma_f32_32x32x16_bf16(k31, S.qr[3], C1, 0, 0, 0), P1, 12, pw3); \
        l_reg += sacc; } while (0)
#define TRRD(dst, off) asm volatile("ds_read_b64_tr_b16 %0, %1 offset:%2" : "=&v"(dst) : "v"(vbr), "i"(off) : "memory")
#define VRD8(L0, H0, L1, H1, L2, H2, L3, H3, VBv, d0) do { constexpr int b_ = v_rd_off(d0, 0, 0); \
        TRRD(L0, b_); TRRD(H0, b_ + 2048); TRRD(L1, b_ + 4096); TRRD(H1, b_ + 6144); TRRD(L2, b_ + 8192); TRRD(H2, b_ + 10240); TRRD(L3, b_ + 12288); TRRD(H3, b_ + 14336); } while (0)
#define VF(L, H) (bf16x8){L[0], L[1], L[2], L[3], H[0], H[1], H[2], H[3]}
#define PAF(k) __builtin_bit_cast(bf16x8, pw##k)
#define GAPB(MF, X, B) do { MF; rmx = MX3(rmx, X[B], X[(B) + 1]); X[B] = EX(X[B]); X[(B) + 1] = EX(X[(B) + 1]); PIN(X); PIN(rmx); SBAR(); } while (0)
#define PV4(d0, L0, H0, L1, H1, L2, H2, L3, H3, X, B) do { \
        GAPB(o[d0] = __builtin_amdgcn_mfma_f32_32x32x16_bf16(PAF(0), VF(L0, H0), o[d0], 0, 0, 0), X, (B)); \
        GAPB(o[d0] = __builtin_amdgcn_mfma_f32_32x32x16_bf16(PAF(1), VF(L1, H1), o[d0], 0, 0, 0), X, (B) + 2); \
        GAPB(o[d0] = __builtin_amdgcn_mfma_f32_32x32x16_bf16(PAF(2), VF(L2, H2), o[d0], 0, 0, 0), X, (B) + 4); \
        GAPB(o[d0] = __builtin_amdgcn_mfma_f32_32x32x16_bf16(PAF(3), VF(L3, H3), o[d0], 0, 0, 0), X, (B) + 6); } while (0)
#define LWAIT(n) do { asm volatile("s_waitcnt lgkmcnt(" #n ")" ::: "memory"); SBAR(); } while (0)
#define PHASE_B(C0, C1, VBv) do { s16x4 a0, a1, a2, a3, a4, a5, a6, a7, b0, b1, b2, b3, b4, b5, b6, b7; const int vbr = vb0 + (VBv); rmx = -__builtin_inff(); \
        asm volatile("s_waitcnt lgkmcnt(0)" ::: "memory"); SBAR(); \
        VRD8(a0, a1, a2, a3, a4, a5, a6, a7, VBv, 0); VRD8(b0, b1, b2, b3, b4, b5, b6, b7, VBv, 1); LWAIT(8); \
        PV4(0, a0, a1, a2, a3, a4, a5, a6, a7, C0, 0); \
        VRD8(a0, a1, a2, a3, a4, a5, a6, a7, VBv, 2); LWAIT(8); \
        PV4(1, b0, b1, b2, b3, b4, b5, b6, b7, C0, 8); \
        VRD8(b0, b1, b2, b3, b4, b5, b6, b7, VBv, 3); LWAIT(8); \
        PV4(2, a0, a1, a2, a3, a4, a5, a6, a7, C1, 0); \
        LWAIT(0); \
        PV4(3, b0, b1, b2, b3, b4, b5, b6, b7, C1, 8); } while (0)
    f32x16 pA0, pA1, pB0, pB1; u32x4 pw0, pw1, pw2, pw3;
#if PROBE_SEG
    unsigned long long pst_ = __builtin_readcyclecounter();
#define STAMP(k) do { const unsigned long long n_ = __builtin_readcyclecounter(); if ((k) == PROBE_SEG) S.acc += n_ - pst_; S.tot += n_ - pst_; pst_ = n_; } while (0)
#else
#define STAMP(k) do { } while (0)
#endif
    STREAM(2);
    SBAR();
    {
      const bf16x8 k00 = KF(0, 0), k01 = KF(0, 1), k10 = KF(1, 0), k11 = KF(1, 1), k20 = KF(2, 0), k21 = KF(2, 1), k30 = KF(3, 0), k31 = KF(3, 1);
      pA0 = __builtin_amdgcn_mfma_f32_32x32x16_bf16(k00, S.qr[0], negm, 0, 0, 0); pA1 = __builtin_amdgcn_mfma_f32_32x32x16_bf16(k01, S.qr[0], negm, 0, 0, 0);
      pA0 = __builtin_amdgcn_mfma_f32_32x32x16_bf16(k10, S.qr[1], pA0, 0, 0, 0); pA1 = __builtin_amdgcn_mfma_f32_32x32x16_bf16(k11, S.qr[1], pA1, 0, 0, 0);
      pA0 = __builtin_amdgcn_mfma_f32_32x32x16_bf16(k20, S.qr[2], pA0, 0, 0, 0); pA1 = __builtin_amdgcn_mfma_f32_32x32x16_bf16(k21, S.qr[2], pA1, 0, 0, 0);
      pA0 = __builtin_amdgcn_mfma_f32_32x32x16_bf16(k30, S.qr[3], pA0, 0, 0, 0); pA1 = __builtin_amdgcn_mfma_f32_32x32x16_bf16(k31, S.qr[3], pA1, 0, 0, 0); }
    NEAR(pA0, pA1, 0); DECIDE(pA0, pA1, true);
#pragma unroll
    for (int r = 0; r < 16; ++r) { pA0[r] = EX(pA0[r]); pA1[r] = EX(pA1[r]); }
    STEP_BAR();
    ROT();
#define STEP(C0, C1, P0, P1, t) do { SBAR(); STAMP(5); \
        STREAM((t) + 2); SBAR(); \
        PHASE_A(C0, C1, P0, P1); SBAR(); STAMP(1); \
        NEAR(C0, C1, (t)); SBAR(); STAMP(2); \
        PHASE_B(C0, C1, v0); DECIDE2(C0, C1); SBAR(); STAMP(3); \
        RESC(); STEP_BAR(); STAMP(4); ROT(); } while (0)
    int t = 1;
    for (; t + 2 < NT; t += 2) {
        STEP(pB0, pB1, pA0, pA1, t);
        STEP(pA0, pA1, pB0, pB1, t + 1);
    }
    SBAR(); STREAM(NT + 1); SBAR();
    PHASE_A(pB0, pB1, pA0, pA1);
    { const unsigned lq = (unsigned)((wid * QBLK + r32) * PITCH + hi * 8) * 2u;
#pragma unroll
      for (int d0 = 0; d0 < 4; ++d0) S.qr[d0] = bld8(R, lq + d0 * 32, nxt.qoff); }
    SBAR();
    NEAR(pB0, pB1, NT - 1); SBAR();
    PHASE_B(pB0, pB1, v0); DECIDE2(pB0, pB1);
    RESC();
    { float sacc = 0.f;
#pragma unroll
      for (int r = 0; r < 16; ++r) { sacc += pB0[r]; sacc += pB1[r]; }
      l_reg += sacc;
      pw0 = (u32x4){pk2(pB0[0], pB0[1]), pk2(pB0[2], pB0[3]), pk2(pB0[4], pB0[5]), pk2(pB0[6], pB0[7])}; pw1 = (u32x4){pk2(pB0[8], pB0[9]), pk2(pB0[10], pB0[11]), pk2(pB0[12], pB0[13]), pk2(pB0[14], pB0[15])};
      pw2 = (u32x4){pk2(pB1[0], pB1[1]), pk2(pB1[2], pB1[3]), pk2(pB1[4], pB1[5]), pk2(pB1[6], pB1[7])}; pw3 = (u32x4){pk2(pB1[8], pB1[9]), pk2(pB1[10], pB1[11]), pk2(pB1[12], pB1[13]), pk2(pB1[14], pB1[15])};
      SBAR(); pv_tile(o, vb0 + v1, PAF(0), PAF(1), PAF(2), PAF(3)); }
    ROT(); S.ks = k0; S.vs = v1;
    { auto rr = __builtin_amdgcn_permlane32_swap(__float_as_uint(l_reg), __float_as_uint(l_reg), false, false); l_reg = __uint_as_float(rr[0]) + __uint_as_float(rr[1]); }
    int lane_e = (int)__builtin_amdgcn_mbcnt_hi(~0u, __builtin_amdgcn_mbcnt_lo(~0u, 0u)); asm volatile("" : "+v"(lane_e));
    const int r32e = lane_e & 31, hie = lane_e >> 5;
    if (hi == 0) li_l[r32] = l_reg; asm volatile("s_waitcnt lgkmcnt(0)" ::: "memory");
    float rli[16];
#pragma unroll
    for (int r = 0; r < 16; ++r) rli[r] = __builtin_amdgcn_rcpf(li_l[crow(r, hi)]);
    LAS unsigned* st = (LAS unsigned*)(lds + OFF_STASH + wid * 8192) + lane_e;
    if (cur.comp == 0) {
#pragma unroll
        for (int r = 0; r < 16; ++r) { st[(2 * r) * 64] = pk2(o[0][r] * rli[r], o[1][r] * rli[r]); st[(2 * r + 1) * 64] = pk2(o[2][r] * rli[r], o[3][r] * rli[r]); }
    } else {
        float ss[16];
#pragma unroll
        for (int r = 0; r < 16; ++r) { const unsigned u0 = st[(2 * r) * 64], u1 = st[(2 * r + 1) * 64];
            const float s2 = lam * rli[r];
            o[0][r] = bflo(u0) - s2 * o[0][r]; o[1][r] = bfhi(u0) - s2 * o[1][r]; o[2][r] = bflo(u1) - s2 * o[2][r]; o[3][r] = bfhi(u1) - s2 * o[3][r];
            ss[r] = (o[0][r] * o[0][r] + o[1][r] * o[1][r]) + (o[2][r] * o[2][r] + o[3][r] * o[3][r]); }
#pragma unroll
        for (int r = 0; r < 16; ++r) {
#pragma unroll
            for (int x = 1; x < 32; x <<= 1) ss[r] += __shfl_xor(ss[r], x);
            ss[r] = rsqrtf(ss[r] * (1.f / 128.f) + EPS) * 0.8f; }
        float gg[4];
#pragma unroll
        for (int d0 = 0; d0 < 4; ++d0) gg[d0] = gsub[d0 * 32 + r32e];
        bf16_t* Ow = cur.O + (size_t)(wid * QBLK) * DM;
#pragma unroll
        for (int r = 0; r < 16; ++r) { const int orow = crow(r, hie);
#pragma unroll
            for (int d0 = 0; d0 < 4; ++d0) { const float v = o[d0][r] * ss[r] * gg[d0]; const float vn = __shfl_xor(v, 1);
                if ((r32e & 1) == 0) *(unsigned*)(Ow + (size_t)orow * DM + d0 * 32 + r32e) = pk2(v, vn); } }
    }
    __syncthreads();
#undef RESC
#undef KBASE
#undef NEAR
#undef PIN
#undef EX
#undef MX3
#undef DECIDE
#undef DECIDE2
#undef KF
#undef GAPA
#undef PHASE_A
#undef TRRD
#undef VRD8
#undef VF
#undef PAF
#undef GAPB
#undef PV4
#undef LWAIT
#undef PHASE_B
#undef STEP
#undef STAMP
#undef ROT
#undef KNEXT
#undef VNEXT
#undef STREAM
#undef STEP_BAR
}
#undef DA_DMA16
#undef DA_STAGE
#undef DA_LANE_OFFS
}

constexpr int NWAVES = 8;
constexpr int N_LAUNCHES = MK_N_LAUNCHES;
constexpr int N_PHASES = 9;
static_assert(N_LAUNCHES == 1 || N_LAUNCHES == N_PHASES, "MK_N_LAUNCHES is 1 or 9");

constexpr size_t MiB = 1u << 20;
constexpr size_t WS_CTL = 0, CTL_ZERO_BYTES = 1 * MiB;
constexpr size_t WS_ETK = 1 * MiB, WS_GTK = 2 * MiB, WS_RSTDT = 3 * MiB, WS_SLOTTK = 4 * MiB, WS_TOKSLOT = 5 * MiB, WS_GATESLOT = 7 * MiB, WS_RSTDSLOT = 9 * MiB, WS_RBE = 11 * MiB;
constexpr size_t WS_WRHI = 12 * MiB, WS_WRLO = 12 * MiB + 65536, WS_KMB = 13 * MiB, WS_VMT = 14 * MiB;
constexpr size_t WS_WIN = 16 * MiB, WS_WOUT = 21 * MiB, WS_X1B = 24 * MiB, WS_X1Q = 152 * MiB;
constexpr size_t WS_BIG = 216 * MiB;
constexpr size_t WS_H = WS_BIG, WS_PROJ = WS_BIG + 128 * MiB, WS_MIX = WS_BIG + 448 * MiB;
constexpr size_t WS_ACTQ = WS_BIG, WS_Y = WS_BIG + 264 * MiB;
constexpr size_t WS_END = WS_BIG + 792 * MiB;
static_assert(WS_END <= 1024 * MiB, "d_ws map");
constexpr size_t OUT_WGU = 0, OUT_WD = 64 * MiB;
constexpr int CW_BAR = 4096, CW_COUNT = 1024, CW_CURSOR = 2048;
constexpr int RING_BYTES = 159744, LDSCTL_OFF = RING_BYTES, MISC_OFF = LDSCTL_OFF + 320, LDS_BYTES = 163840;
static_assert(dattn::LDS_BYTES <= RING_BYTES, "attention scratch");

#define XB_TMO      128
#define XB_XCNT(j)  (256  + 64 * (j))
#define XB_XSUB(j)  (1280 + 64 * (j))
#define XB_XGEN(j)  (2304 + 64 * (j))
#define XB_TOP      3328
#define XB_TOPGEN   3392
#define XCD_BAR_WORDS 3456
#define XB_SPIN_CAP (1u << 18)
__device__ __forceinline__ unsigned xb_ld(unsigned* p)              { return __hip_atomic_load(p, __ATOMIC_RELAXED, __HIP_MEMORY_SCOPE_AGENT); }
__device__ __forceinline__ unsigned xb_add(unsigned* p, unsigned v) { return __hip_atomic_fetch_add(p, v, __ATOMIC_RELAXED, __HIP_MEMORY_SCOPE_AGENT); }
__device__ __forceinline__ unsigned xb_xcc_id() { return (unsigned)__builtin_amdgcn_s_getreg((3 << 11) | 20) & 0xFu; }
#define XB_SPIN(cond, bar) do { unsigned _sp = 0; while (cond) { __builtin_amdgcn_s_sleep(1); \
    if ((++_sp & 255u) == 0u) { if (xb_ld(&(bar)[XB_TMO])) break; if (_sp > XB_SPIN_CAP) { atomicAdd(&(bar)[XB_TMO], 1u); break; } } } } while (0)
struct XcdBarrier { unsigned* bar; unsigned x; volatile LAS unsigned* st; };
__device__ __forceinline__ XcdBarrier xcd_barrier_post(unsigned* bar, volatile LAS unsigned* st) {
    XcdBarrier b; b.bar = bar; b.x = xb_xcc_id(); b.st = st;
    if (threadIdx.x == 0) (void)xb_add(&bar[XB_XCNT(b.x)], 1u);
    return b;
}
__device__ __forceinline__ void xcd_barrier_complete(unsigned* bar, unsigned x, unsigned& nloc, unsigned& nx) {
    const unsigned G = gridDim.x * gridDim.y * gridDim.z;
    unsigned sum, cnt, mine, sp = 0u;
    for (;;) {
        sum = 0u; cnt = 0u; mine = 0u;
#pragma unroll
        for (unsigned j = 0; j < 16; ++j) { const unsigned c = xb_ld(&bar[XB_XCNT(j)]); sum += c; cnt += (c > 0u) ? 1u : 0u; mine = (j == x) ? c : mine; }
        if (sum == G) break;
        __builtin_amdgcn_s_sleep(1);
        if ((++sp & 255u) == 0u) { if (xb_ld(&bar[XB_TMO])) break; if (sp > XB_SPIN_CAP) { atomicAdd(&bar[XB_TMO], 1u); break; } }
    }
    nloc = mine > 0u ? mine : 1u; nx = cnt > 0u ? cnt : 1u;
}
__device__ __forceinline__ void xcd_barrier(const XcdBarrier& b) {
    asm volatile("s_waitcnt vmcnt(0)" ::: "memory");
    __syncthreads();
    if (threadIdx.x == 0) {
        unsigned* bar = b.bar;
        __builtin_amdgcn_s_waitcnt(0);
        unsigned nloc = b.st[0], nx = b.st[1];
        if (nloc == 0u) { xcd_barrier_complete(bar, b.x, nloc, nx); b.st[0] = nloc; b.st[1] = nx; }
        const unsigned old = xb_add(&bar[XB_XSUB(b.x)], 1u);
        const unsigned gen = old / nloc;
        if (old + 1u == (gen + 1u) * nloc) {
            __builtin_amdgcn_fence(__ATOMIC_RELEASE, "agent");
            asm volatile("s_waitcnt vmcnt(0)" ::: "memory");
            const unsigned og = xb_add(&bar[XB_TOP], 1u);
            const unsigned tg = og / nx;
            if (og + 1u == (tg + 1u) * nx) xb_add(&bar[XB_TOPGEN], 1u);
            else XB_SPIN(xb_ld(&bar[XB_TOPGEN]) == tg, bar);
            __builtin_amdgcn_fence(__ATOMIC_ACQUIRE, "agent");
            xb_add(&bar[XB_XGEN(b.x)], 1u);
            asm volatile("s_waitcnt vmcnt(0)" ::: "memory");
        } else {
            XB_SPIN(xb_ld(&bar[XB_XGEN(b.x)]) == gen, bar);
            __builtin_amdgcn_fence(__ATOMIC_ACQUIRE, "agent");
            asm volatile("s_waitcnt vmcnt(0)" ::: "memory");
        }
    }
    __syncthreads();
}

struct Frame {
    LAS unsigned char* lds;
    volatile LAS unsigned* MISC;
    unsigned* ctl;
    int tid, lane, wave, vcu, G;
    float* out;
    unsigned char* ws;
};
struct Args { const float* in[19]; float* out; unsigned char* ws; int ph_lo, ph_hi; };
typedef const __attribute__((address_space(4))) Args* KArgs;
__device__ __forceinline__ KArgs kargs() { KArgs p = (KArgs)__builtin_amdgcn_kernarg_segment_ptr(); asm volatile("" : "+s"(p)); return p; }
enum { I_X = 0, I_MEM, I_RELB, I_ATTNG, I_WIN, I_CONVW, I_LAMQK, I_SUBG, I_MEMG, I_WMEMKV, I_WOUT, I_FFNG, I_RW, I_RB, I_WGU, I_BGU, I_WDN, I_BDN, I_FING };

template <bool GAIN, bool F8>
__device__ __forceinline__ void p0_transpose_item(const float* W, int K, int N, void* WTv, int k0, int n0, int drow0, const float* kgain, float scale, LAS float* scr, int lane) {
    float v[32];
    const float* wp = W + (size_t)(k0 + (lane >> 5)) * N + n0 + (lane & 31);
#pragma unroll
    for (int i = 0; i < 32; ++i) v[i] = wp[(size_t)(2 * i) * N];
    const int c = lane & 7;
    f32x4 g0 = {scale, scale, scale, scale}, g1 = g0;
    if constexpr (GAIN) { g0 = *(const f32x4*)(kgain + k0 + 8 * c) * scale; g1 = *(const f32x4*)(kgain + k0 + 8 * c + 4) * scale; }
#pragma unroll
    for (int i = 0; i < 32; ++i) scr[(2 * i + (lane >> 5)) * 33 + (lane & 31)] = v[i];
    LDS_WAIT(); asm volatile("" ::: "memory");
#pragma unroll
    for (int j = 0; j < 4; ++j) { const int n = (lane >> 3) + 8 * j; const LAS float* s = scr + (8 * c) * 33 + n;
        const float e0 = s[0 * 33] * g0[0], e1 = s[1 * 33] * g0[1], e2 = s[2 * 33] * g0[2], e3 = s[3 * 33] * g0[3], e4 = s[4 * 33] * g1[0], e5 = s[5 * 33] * g1[1], e6 = s[6 * 33] * g1[2], e7 = s[7 * 33] * g1[3];
        if constexpr (F8) { u32x2 o; o.x = pg8::pk4_fp8(e0, e1, e2, e3); o.y = pg8::pk4_fp8(e4, e5, e6, e7);
            *(u32x2*)((unsigned char*)WTv + (size_t)(drow0 + n) * K + k0 + 8 * c) = o; }
        else { u32x4 o; o.x = pk2(e0, e1); o.y = pk2(e2, e3); o.z = pk2(e4, e5); o.w = pk2(e6, e7);
            *(u32x4*)((bf16_t*)WTv + (size_t)(drow0 + n) * K + k0 + 8 * c) = o; } }
    LDS_WAIT(); asm volatile("" ::: "memory");
}
__device__ __forceinline__ void rms_row2_to_bf16(const float* xa, const float* xb, const float* g, bf16_t* oa, bf16_t* ob, int lane) {
    const f32x4* ra = (const f32x4*)xa + lane; const f32x4* rb = (const f32x4*)xb + lane; const f32x4* gr = (const f32x4*)g + lane;
    f32x4 va[4], vb[4]; float sa = 0.f, sb = 0.f;
#pragma unroll
    for (int j = 0; j < 4; ++j) { va[j] = ra[64 * j]; vb[j] = rb[64 * j]; }
#pragma unroll
    for (int j = 0; j < 4; ++j) { sa += (va[j].x * va[j].x + va[j].y * va[j].y) + (va[j].z * va[j].z + va[j].w * va[j].w); sb += (vb[j].x * vb[j].x + vb[j].y * vb[j].y) + (vb[j].z * vb[j].z + vb[j].w * vb[j].w); }
    const float rsa = rsqrtf(wave_sum(sa) * (1.f / DM) + EPS), rsb = rsqrtf(wave_sum(sb) * (1.f / DM) + EPS);
    unsigned long long* pa = (unsigned long long*)oa + lane; unsigned long long* pb = (unsigned long long*)ob + lane;
#pragma unroll
    for (int j = 0; j < 4; ++j) { const f32x4 gg = gr[64 * j];
        pa[64 * j] = (unsigned long long)pk2(va[j].x * rsa * gg.x, va[j].y * rsa * gg.y) | ((unsigned long long)pk2(va[j].z * rsa * gg.z, va[j].w * rsa * gg.w) << 32);
        pb[64 * j] = (unsigned long long)pk2(vb[j].x * rsb * gg.x, vb[j].y * rsb * gg.y) | ((unsigned long long)pk2(vb[j].z * rsb * gg.z, vb[j].w * rsb * gg.w) << 32); }
}
__device__ __forceinline__ void p0_kvm_tile(Frame& F, int tile, const float* mem, const float* mem_g, const float* w_memkv) {
    const int mt = tile >> 3, ntile = tile & 7, row0 = 64 * mt, col0 = 64 * ntile;
    const int mb = F.wave >> 1, nb0 = (F.wave & 1) * 2, ar = F.lane & 15, kq = F.lane >> 4;
    const float* arow = mem + (size_t)(row0 + mb * 16 + ar) * DM;
    f32x4 acc[2]; acc[0] = (f32x4){0.f, 0.f, 0.f, 0.f}; acc[1] = acc[0];
    float ss = 0.f;
    const float* wq = w_memkv + col0 + nb0 * 16 + ar;
#define KVM_LOAD(A0, A1, G0, G1, BV, k0_) do { const int kk_ = (k0_) + 8 * kq; A0 = *(const f32x4*)(arow + kk_); A1 = *(const f32x4*)(arow + kk_ + 4); G0 = *(const f32x4*)(mem_g + kk_); G1 = *(const f32x4*)(mem_g + kk_ + 4); \
        _Pragma("unroll") for (int nbi = 0; nbi < 2; ++nbi) _Pragma("unroll") for (int j = 0; j < 8; ++j) BV[nbi][j] = wq[(size_t)(kk_ + j) * 512 + nbi * 16]; } while (0)
#define KVM_MATH(A0, A1, G0, G1, BV) do { ss += (A0.x * A0.x + A0.y * A0.y) + (A0.z * A0.z + A0.w * A0.w) + (A1.x * A1.x + A1.y * A1.y) + (A1.z * A1.z + A1.w * A1.w); \
        const bf16x8 af = pack8(A0 * G0, A1 * G1); \
        _Pragma("unroll") for (int nbi = 0; nbi < 2; ++nbi) { const f32x4 b0 = {BV[nbi][0], BV[nbi][1], BV[nbi][2], BV[nbi][3]}, b1 = {BV[nbi][4], BV[nbi][5], BV[nbi][6], BV[nbi][7]}; \
            acc[nbi] = __builtin_amdgcn_mfma_f32_16x16x32_bf16(af, pack8(b0, b1), acc[nbi], 0, 0, 0); } } while (0)
    f32x4 ba0[4], ba1[4], bg0[4], bg1[4]; float bb[4][2][8];
#pragma unroll 1
    for (int k0 = 0; k0 < DM; k0 += 128) {
#pragma unroll
        for (int q = 0; q < 4; ++q) KVM_LOAD(ba0[q], ba1[q], bg0[q], bg1[q], bb[q], k0 + 32 * q);
#pragma unroll
        for (int q = 0; q < 4; ++q) KVM_MATH(ba0[q], ba1[q], bg0[q], bg1[q], bb[q]);
    }
#undef KVM_LOAD
#undef KVM_MATH
    ss += __shfl_xor(ss, 16); ss += __shfl_xor(ss, 32);
    const float rstd = rsqrtf(ss * (1.f / DM) + EPS);
    float rs[4];
#pragma unroll
    for (int j = 0; j < 4; ++j) rs[j] = __shfl(rstd, kq * 4 + j);
    bf16_t* kmb = (bf16_t*)(F.ws + WS_KMB); bf16_t* vmt = (bf16_t*)(F.ws + WS_VMT);
#pragma unroll
    for (int nbi = 0; nbi < 2; ++nbi) {
        const int gc = col0 + (nb0 + nbi) * 16 + ar, gr0 = row0 + mb * 16 + kq * 4;
        if (ntile < 4) {
#pragma unroll
            for (int j = 0; j < 4; ++j) kmb[(size_t)(gr0 + j) * 256 + gc] = (bf16_t)(pk2(acc[nbi][j] * rs[j], 0.f) & 0xffffu);
        } else {
            const int d = gc - 256, hm = d >> 6, dd = d & 63, b = gr0 >> 8, m = gr0 & 255;
            u32x2 w; w.x = pk2(acc[nbi][0] * rs[0], acc[nbi][1] * rs[1]); w.y = pk2(acc[nbi][2] * rs[2], acc[nbi][3] * rs[3]);
            *(u32x2*)(vmt + ((size_t)((b * 4 + hm) * 64 + dd)) * 256 + m) = w;
        }
    }
}
__device__ __forceinline__ void p0_prologue(Frame& F) {
    KArgs A = kargs();
    { const float* mem = A->in[I_MEM]; const float* mem_g = A->in[I_MEMG]; const float* w_memkv = A->in[I_WMEMKV];
      for (int rep2_ = 0; rep2_ < ((PROBE_P0 & 4) ? 2 : 1); ++rep2_)
      for (int tile = blockIdx.x; tile < 256; tile += F.G) p0_kvm_tile(F, tile, mem, mem_g, w_memkv); }
    const float* w_in = A->in[I_WIN]; const float* w_out = A->in[I_WOUT]; const float* w_gu = A->in[I_WGU]; const float* w_dn = A->in[I_WDN]; const float* ffn_g = A->in[I_FFNG];
    LAS float* scr = (LAS float*)(F.lds + F.wave * 16384);
    const int gw = F.vcu * NWAVES + F.wave, NGW = F.G * NWAVES;
    bf16_t* Win_t = (bf16_t*)(F.ws + WS_WIN); bf16_t* Wout_t = (bf16_t*)(F.ws + WS_WOUT);
    unsigned char* Wgu_q = (unsigned char*)F.out + OUT_WGU; unsigned char* Wd_q = (unsigned char*)F.out + OUT_WD;
    constexpr int I_IN = 16 * 80, I_OUT = 16 * 32, I_GU1 = 16 * 64, I_D1 = 16 * 32;
    constexpr int I_GU = NEXP * I_GU1, I_D = NEXP * I_D1, NITEMS = I_IN + I_OUT + I_GU + I_D;
    for (int rep0_ = 0; rep0_ < ((PROBE_P0 & 1) ? 2 : 1); ++rep0_)
    for (int it = gw; it < NITEMS; it += NGW) {
        int r = it;
        if (r < I_IN) { const int kb = r / 80, nb = r % 80; p0_transpose_item<false, false>(w_in, DM, INW, Win_t, 64 * kb, 32 * nb, 32 * nb, nullptr, 1.f, scr, F.lane); continue; } r -= I_IN;
        if (r < I_OUT) { const int kb = r / 32, nb = r % 32; p0_transpose_item<false, false>(w_out, DM, DM, Wout_t, 64 * kb, 32 * nb, 32 * nb, nullptr, 1.f, scr, F.lane); continue; } r -= I_OUT;
        if (r < I_GU) { const int e = r / I_GU1, q = r % I_GU1, kb = q / 64, nb = q % 64, n0 = 32 * nb;
            const int jj = n0 & 1023, drow0 = (jj >> 7) * 256 + (n0 >= 1024 ? 128 : 0) + (jj & 127);
            p0_transpose_item<true, true>(w_gu + (size_t)e * DM * 2048, DM, 2048, Wgu_q + (size_t)e * 2048 * DM, 64 * kb, n0, drow0, ffn_g, 64.f, scr, F.lane); continue; } r -= I_GU;
        { const int e = r / I_D1, q = r % I_D1, kb = q / 32, nb = q % 32;
            p0_transpose_item<false, true>(w_dn + (size_t)e * DEXP * DM, DEXP, DM, Wd_q + (size_t)e * DM * DEXP, 64 * kb, 32 * nb, 32 * nb, nullptr, 64.f, scr, F.lane); }
    }
    bf16_t* H = (bf16_t*)(F.ws + WS_H);
    { const float* x = A->in[I_X]; const float* attn_g = A->in[I_ATTNG];
      for (int rep1_ = 0; rep1_ < ((PROBE_P0 & 2) ? 2 : 1); ++rep1_)
      for (int m = gw; m < T; m += 2 * NGW) { const int m2 = (m + NGW < T) ? m + NGW : m;
          rms_row2_to_bf16(x + (size_t)m * DM, x + (size_t)m2 * DM, attn_g, H + (size_t)m * DM, H + (size_t)m2 * DM, F.lane); } }
    const float* router_w = A->in[I_RW];
    bf16_t* wrh = (bf16_t*)(F.ws + WS_WRHI); bf16_t* wrl = (bf16_t*)(F.ws + WS_WRLO);
    for (int i = (F.vcu * NWAVES + F.wave) * 64 + F.lane; i < NEXP * DM; i += NGW * 64) { const int e = i >> 10, k = i & 1023;
        const float v = ffn_g[k] * router_w[(size_t)k * NEXP + e]; const unsigned hb = pk2(v, 0.f) & 0xffffu; const float hf = __uint_as_float(hb << 16);
        wrh[i] = (bf16_t)hb; wrl[i] = (bf16_t)(pk2(v - hf, 0.f) & 0xffffu); }
}

__device__ __forceinline__ void p2_conv_block(Frame& F, int blk, int tid_, const float* conv_w) {
    const bf16_t* proj = (const bf16_t*)(F.ws + WS_PROJ); bf16_t* mix = (bf16_t*)(F.ws + WS_MIX);
    const int cg = tid_ & 31, tc = tid_ >> 5;
    const int c0 = cg * 8, t0 = blk * 256 + tc * 16, s0 = t0 & (SEQ - 1);
    float w0[8], w1[8], w2[8];
#pragma unroll
    for (int i = 0; i < 8; ++i) { w0[i] = conv_w[c0 + i]; w1[i] = conv_w[256 + c0 + i]; w2[i] = conv_w[512 + c0 + i]; }
    float p2[8], p1[8];
#pragma unroll
    for (int i = 0; i < 8; ++i) { p2[i] = 0.f; p1[i] = 0.f; }
    if (s0 >= 2) {
        const u32x4 ua = *(const u32x4*)(proj + (size_t)(t0 - 2) * INW + COL_U + c0), ca = *(const u32x4*)(proj + (size_t)(t0 - 2) * INW + COL_GC + c0);
        const u32x4 ub = *(const u32x4*)(proj + (size_t)(t0 - 1) * INW + COL_U + c0), cb = *(const u32x4*)(proj + (size_t)(t0 - 1) * INW + COL_GC + c0);
#pragma unroll
        for (int i = 0; i < 4; ++i) { p2[2 * i] = bflo(ua[i]) * bflo(ca[i]); p2[2 * i + 1] = bfhi(ua[i]) * bfhi(ca[i]); p1[2 * i] = bflo(ub[i]) * bflo(cb[i]); p1[2 * i + 1] = bfhi(ub[i]) * bfhi(cb[i]); }
    }
    for (int tb = 0; tb < 16; tb += 4) {
        u32x4 uu[4], cc[4], bb[4];
#pragma unroll
        for (int q = 0; q < 4; ++q) { const size_t ro = (size_t)(t0 + tb + q) * INW;
            uu[q] = *(const u32x4*)(proj + ro + COL_U + c0); cc[q] = *(const u32x4*)(proj + ro + COL_GC + c0); bb[q] = *(const u32x4*)(proj + ro + COL_GB + c0); }
#pragma unroll
        for (int q = 0; q < 4; ++q) {
            float cur[8], y[8];
#pragma unroll
            for (int i = 0; i < 4; ++i) { cur[2 * i] = bflo(uu[q][i]) * bflo(cc[q][i]); cur[2 * i + 1] = bfhi(uu[q][i]) * bfhi(cc[q][i]); }
#pragma unroll
            for (int i = 0; i < 4; ++i) { y[2 * i] = bflo(bb[q][i]) * (w0[2 * i] * p2[2 * i] + w1[2 * i] * p1[2 * i] + w2[2 * i] * cur[2 * i]);
                                           y[2 * i + 1] = bfhi(bb[q][i]) * (w0[2 * i + 1] * p2[2 * i + 1] + w1[2 * i + 1] * p1[2 * i + 1] + w2[2 * i + 1] * cur[2 * i + 1]); }
            u32x4 o; o.x = pk2(y[0], y[1]); o.y = pk2(y[2], y[3]); o.z = pk2(y[4], y[5]); o.w = pk2(y[6], y[7]);
            *(u32x4*)(mix + (size_t)(t0 + tb + q) * DM + c0) = o;
#pragma unroll
            for (int i = 0; i < 8; ++i) { p2[i] = p1[i]; p1[i] = cur[i]; }
        }
    }
}
__device__ __forceinline__ void p2_mem_block(Frame& F, int blk, int lane_) {
    const bf16_t* proj = (const bf16_t*)(F.ws + WS_PROJ); bf16_t* mix = (bf16_t*)(F.ws + WS_MIX);
    const bf16_t* kmb = (const bf16_t*)(F.ws + WS_KMB); const bf16_t* vmt = (const bf16_t*)(F.ws + WS_VMT);
    const int r32 = lane_ & 31, hi = lane_ >> 5, b = blk >> 5, tw = blk * 256 + F.wave * 32, tid_ = F.wave * 64 + lane_;
    LAS unsigned char* Kl = F.lds; LAS unsigned char* Vl = F.lds + 32768;
    const int ksw = (r32 >> 1) & 7;
    for (int hm = 0; hm < 4; ++hm) {
        bf16x8 qr[4];
#pragma unroll
        for (int d0 = 0; d0 < 4; ++d0) qr[d0] = *(const bf16x8*)(proj + (size_t)(tw + r32) * INW + COL_QM + hm * 64 + d0 * 16 + hi * 8);
        { u32x4 kv[4], vv[4];
#pragma unroll
          for (int i = 0; i < 4; ++i) { const int idx = tid_ + 512 * i;
              kv[i] = *(const u32x4*)(kmb + (size_t)(b * 256 + (idx >> 3)) * 256 + hm * 64 + (idx & 7) * 8);
              vv[i] = *(const u32x4*)(vmt + ((size_t)((b * 4 + hm) * 64 + (idx >> 5))) * 256 + (idx & 31) * 8); }
          __syncthreads();
#pragma unroll
          for (int i = 0; i < 4; ++i) { const int idx = tid_ + 512 * i; const int kr = idx >> 3, kc = idx & 7, vd = idx >> 5, vc = idx & 31;
              *(LAS u32x4*)(Kl + kr * 128 + ((kc ^ ((kr >> 1) & 7)) << 4)) = kv[i];
              *(LAS u32x4*)(Vl + vd * 512 + ((vc ^ (vd & 31)) << 4)) = vv[i]; }
          __syncthreads(); }
        float mx = -__builtin_inff();
#pragma unroll 2
        for (int kb = 0; kb < 8; ++kb) { f32x16 p = f32x16{};
#pragma unroll
            for (int d0 = 0; d0 < 4; ++d0) { const bf16x8 kf = *(const LAS bf16x8*)(Kl + (kb * 32 + r32) * 128 + (((2 * d0 + hi) ^ ksw) << 4));
                p = __builtin_amdgcn_mfma_f32_32x32x16_bf16(kf, qr[d0], p, 0, 0, 0); }
#pragma unroll
            for (int r = 0; r < 16; ++r) mx = fmaxf(mx, p[r]); }
        mx = fmaxf(mx, __shfl_xor(mx, 32));
        float sum = 0.f;
        f32x16 o[2]; o[0] = f32x16{}; o[1] = f32x16{};
#pragma unroll 2
        for (int kb = 0; kb < 8; ++kb) { f32x16 p = f32x16{};
#pragma unroll
            for (int d0 = 0; d0 < 4; ++d0) { const bf16x8 kf = *(const LAS bf16x8*)(Kl + (kb * 32 + r32) * 128 + (((2 * d0 + hi) ^ ksw) << 4));
                p = __builtin_amdgcn_mfma_f32_32x32x16_bf16(kf, qr[d0], p, 0, 0, 0); }
#pragma unroll
            for (int r = 0; r < 16; ++r) { p[r] = __builtin_amdgcn_exp2f(p[r] - mx); sum += p[r]; }
            bf16x8 pa0, pa1;
#define PK4(P, B_, OUT) do { unsigned a0 = pk2(P[B_+0], P[B_+1]), a1 = pk2(P[B_+2], P[B_+3]); unsigned b0 = pk2(P[B_+4], P[B_+5]), b1 = pk2(P[B_+6], P[B_+7]); \
        auto r0 = __builtin_amdgcn_permlane32_swap(a0, b0, false, false); auto r1 = __builtin_amdgcn_permlane32_swap(a1, b1, false, false); \
        u32x4 w = {r0[0], r1[0], r0[1], r1[1]}; OUT = __builtin_bit_cast(bf16x8, w); } while (0)
            PK4(p, 0, pa0); PK4(p, 8, pa1);
#undef PK4
#pragma unroll
            for (int d0 = 0; d0 < 2; ++d0) { const LAS unsigned char* vrow = Vl + (d0 * 32 + r32) * 512;
                const bf16x8 v0 = *(const LAS bf16x8*)(vrow + (((kb * 4 + hi) ^ r32) << 4)), v1 = *(const LAS bf16x8*)(vrow + (((kb * 4 + 2 + hi) ^ r32) << 4));
                o[d0] = __builtin_amdgcn_mfma_f32_32x32x16_bf16(pa0, v0, o[d0], 0, 0, 0);
                o[d0] = __builtin_amdgcn_mfma_f32_32x32x16_bf16(pa1, v1, o[d0], 0, 0, 0); }
        }
        sum += __shfl_xor(sum, 32);
        const float linv = __builtin_amdgcn_rcpf(sum);
#pragma unroll
        for (int r = 0; r < 16; ++r) { const int orow = crow(r, hi); const float li = __shfl(linv, orow);
#pragma unroll
            for (int d0 = 0; d0 < 2; ++d0) { const float v = o[d0][r] * li; const float vn = __shfl_xor(v, 1);
                if ((r32 & 1) == 0) *(unsigned*)(mix + (size_t)(tw + orow) * DM + 768 + hm * 64 + d0 * 32 + r32) = pk2(v, vn); } }
    }
    __syncthreads();
}
__device__ __forceinline__ dattn::Ref da_ref(Frame& F, int n) {
    const int pid = F.vcu + (n >> 2) * F.G, sub = n & 3, blk = sub >> 1, comp = sub & 1, bh = pid >> 4, s = pid & 15, qb = blk ? 31 - s : s, b = bh >> 2, h = bh & 3;
    bf16_t* mix = (bf16_t*)(F.ws + WS_MIX);
    dattn::Ref r;
    r.qoff = (unsigned)(((size_t)(b * SEQ + qb * 256) * INW + COL_Q + h * 128 + comp * 64) * 2);
    r.koff = (unsigned)(((size_t)(b * SEQ) * INW + COL_K + h * 128 + comp * 64) * 2);
    r.voff = (unsigned)(((size_t)(b * SEQ) * INW + COL_V + h * 128) * 2);
    r.O = mix + (size_t)(b * SEQ + qb * 256) * DM + 256 + h * 128;
    r.P0 = qb * 256; r.comp = comp; r.h = h;
    return r;
}
__device__ __forceinline__ void p2_mixers(Frame& F) {
    KArgs A = kargs();
    const float* rel_bias = A->in[I_RELB]; const float* lam_qk = A->in[I_LAMQK]; const float* subln_g = A->in[I_SUBG];
    if (F.tid < 512) { const int h = F.tid >> 7, n = F.tid & 127; int bk;
        if (n < 16) bk = n; else { bk = 16; const int thr[15] = {19, 21, 24, 27, 31, 35, 40, 46, 52, 59, 67, 77, 87, 99, 113};
#pragma unroll
            for (int i = 0; i < 15; ++i) bk += (n >= thr[i]) ? 1 : 0; }
        ((LAS float*)(F.lds + dattn::OFF_TB))[h * 128 + n] = (rel_bias[bk * 4 + h] - rel_bias[31 * 4 + h]) * LOG2E; }
    float d1 = 0.f, d2 = 0.f;
    for (int i = 0; i < 64; ++i) { d1 += lam_qk[i] * lam_qk[64 + i]; d2 += lam_qk[128 + i] * lam_qk[192 + i]; }
    const float lam = __expf(d1) - __expf(d2) + 0.2f;
    __syncthreads();
    const int npairs = F.vcu < 512 ? (512 - F.vcu + F.G - 1) / F.G : 0, total1 = 4 * npairs, total = ((PROBE_REP >> 2) & 1) ? 2 * total1 : total1;
#if PROBE_CLK
    const unsigned long long pc0_ = __builtin_readcyclecounter(), pr0_ = __builtin_amdgcn_s_memrealtime();
#endif
    if (total > 0) {
        dattn::Seam S; dattn::Ref cur = da_ref(F, 0);
#if PROBE_SEG
        S.acc = 0; S.tot = 0;
#endif
        const dattn::rsrc_t R = __builtin_amdgcn_make_buffer_rsrc((void*)(F.ws + WS_PROJ), 0, (int)((size_t)T * INW * 2), 0x00020000);
        const char* projb = (const char*)(F.ws + WS_PROJ);
        dattn::prime(cur, F.lds, S, R, projb);
        for (int n = 0; n < total; ++n) {
            const dattn::Ref nxt = (n + 1 < total) ? da_ref(F, (n + 1) % total1) : cur;
            dattn::block(cur, nxt, F.lds, S, lam, subln_g, R, projb);
            cur = nxt;
        }
#if PROBE_SEG
        if (blockIdx.x == 0 && F.tid == 0) { F.ctl[604] = (unsigned)(S.acc >> 4); F.ctl[605] = (unsigned)(S.tot >> 4); }
#endif
    }
#if PROBE_CLK
    if (blockIdx.x == 0 && F.tid == 0) { const unsigned long long dc_ = __builtin_readcyclecounter() - pc0_, dr_ = __builtin_amdgcn_s_memrealtime() - pr0_;
        F.ctl[600] = (unsigned)dc_; F.ctl[601] = (unsigned)(dc_ >> 32); F.ctl[602] = (unsigned)dr_; }
#endif
    int lane2 = (int)__builtin_amdgcn_mbcnt_hi(~0u, __builtin_amdgcn_mbcnt_lo(~0u, 0u)); asm volatile("" : "+v"(lane2));
    const int tid2 = F.wave * 64 + lane2;
    const float* conv_w = kargs()->in[I_CONVW];
    for (int repx_ = 0; repx_ < ((PROBE_X & 1) ? 2 : 1); ++repx_)
    for (int blk = blockIdx.x; blk < T / 256; blk += F.G) { p2_conv_block(F, blk, tid2, conv_w); p2_mem_block(F, blk, lane2); }
}

__device__ __forceinline__ void p4_router(Frame& F, bool dry = false) {
    const float* router_b = kargs()->in[I_RB];
    const bf16_t* x1b = (const bf16_t*)(F.ws + WS_X1B); const bf16_t* wrh = (const bf16_t*)(F.ws + WS_WRHI); const bf16_t* wrl = (const bf16_t*)(F.ws + WS_WRLO);
    int* e_tk = (int*)(F.ws + WS_ETK); float* g_tk = (float*)(F.ws + WS_GTK); float* rstd_t = (float*)(F.ws + WS_RSTDT);
    LAS float* lg = (LAS float*)F.lds + F.wave * (32 * 33); LAS unsigned* hist = (LAS unsigned*)(F.lds + 8 * 32 * 33 * 4);
    const int r32 = F.lane & 31, hi = F.lane >> 5;
    for (int blk = blockIdx.x; blk < T / 256; blk += F.G) {
        if (F.tid < 32) hist[F.tid] = 0u;
        __syncthreads();
        const int t0 = blk * 256 + F.wave * 32;
        const bf16_t* xr = x1b + (size_t)(t0 + r32) * DM + hi * 8; const bf16_t* wh = wrh + (size_t)r32 * DM + hi * 8; const bf16_t* wl = wrl + (size_t)r32 * DM + hi * 8;
        f32x16 acc = f32x16{}; float ss = 0.f;
#pragma unroll 1
        for (int kq = 0; kq < DM; kq += 256) {
            u32x4 xw[16];
#pragma unroll
            for (int s_ = 0; s_ < 16; ++s_) xw[s_] = *(const u32x4*)(xr + kq + s_ * 16);
            SBAR();
#pragma unroll
            for (int sb = 0; sb < 16; sb += 4) { bf16x8 ah[4], al[4];
#pragma unroll
                for (int s_ = 0; s_ < 4; ++s_) { ah[s_] = *(const bf16x8*)(wh + kq + (sb + s_) * 16); al[s_] = *(const bf16x8*)(wl + kq + (sb + s_) * 16); }
#pragma unroll
                for (int s_ = 0; s_ < 4; ++s_) { const u32x4 xv = xw[sb + s_];
#pragma unroll
                    for (int i = 0; i < 4; ++i) { const float a = bflo(xv[i]), b2 = bfhi(xv[i]); ss += a * a + b2 * b2; }
                    const bf16x8 xb = __builtin_bit_cast(bf16x8, xv);
                    acc = __builtin_amdgcn_mfma_f32_32x32x16_bf16(ah[s_], xb, acc, 0, 0, 0);
                    acc = __builtin_amdgcn_mfma_f32_32x32x16_bf16(al[s_], xb, acc, 0, 0, 0); } }
        }
        ss += __shfl_xor(ss, 32);
        const float rstd = rsqrtf(ss * (1.f / DM) + EPS);
#pragma unroll
        for (int r = 0; r < 16; ++r) { const int e = crow(r, hi); lg[r32 * 33 + e] = acc[r] * rstd + router_b[e]; }
        LDS_WAIT(); asm volatile("" ::: "memory");
        if (F.lane < 32) {
            LAS float* row = lg + F.lane * 33; float tv[4]; int ti[4];
#pragma unroll
            for (int p = 0; p < 4; ++p) { float best = -__builtin_inff(); int bi = 0;
                for (int e = 0; e < NEXP; ++e) { const float v = row[e]; if (v > best) { best = v; bi = e; } }
                tv[p] = best; ti[p] = bi; row[bi] = -__builtin_inff(); LDS_WAIT(); asm volatile("" ::: "memory"); }
            const float w1 = __expf(tv[1] - tv[0]), w2 = __expf(tv[2] - tv[0]), w3 = __expf(tv[3] - tv[0]); const float inv = 1.f / (1.f + w1 + w2 + w3);
            const int t = t0 + F.lane;
            if (!dry) {
            *(int4*)(e_tk + (size_t)t * 4) = make_int4(ti[0], ti[1], ti[2], ti[3]);
            *(float4*)(g_tk + (size_t)t * 4) = make_float4(inv, w1 * inv, w2 * inv, w3 * inv);
            rstd_t[t] = rstd;
#pragma unroll
            for (int p = 0; p < 4; ++p) __hip_atomic_fetch_add(&hist[ti[p]], 1u, __ATOMIC_RELAXED, __HIP_MEMORY_SCOPE_WORKGROUP);
            }
        }
        __syncthreads();
        if (F.tid < 32) __hip_atomic_fetch_add(F.ctl + CW_COUNT + F.tid, hist[F.tid], RLX_AGENT);
        __syncthreads();
    }
}
__device__ __forceinline__ void p5_place(Frame& F) {
    const int* e_tk = (const int*)(F.ws + WS_ETK); const float* g_tk = (const float*)(F.ws + WS_GTK); const float* rstd_t = (const float*)(F.ws + WS_RSTDT);
    int* slot_tk = (int*)(F.ws + WS_SLOTTK); int* tok_slot = (int*)(F.ws + WS_TOKSLOT); float* gate_slot = (float*)(F.ws + WS_GATESLOT); float* rstd_slot = (float*)(F.ws + WS_RSTDSLOT);
    int* rb_e = (int*)(F.ws + WS_RBE);
    LAS int* L = (LAS int*)F.lds;
    if (F.tid < 32) { const int c = (int)__hip_atomic_load(F.ctl + CW_COUNT + F.tid, RLX_AGENT); L[F.tid] = c; L[32 + F.tid] = (c + 255) & ~255; }
    __syncthreads();
    if (F.tid < 32) { int s = 0; for (int e = 0; e < F.tid; ++e) s += L[32 + e]; L[64 + F.tid] = s; }
    __syncthreads();
    for (int blk = blockIdx.x; blk < T / 256; blk += F.G) {
        if (F.tid < 32) { L[96 + F.tid] = 0; L[128 + F.tid] = 0; }
        __syncthreads();
        int ee[2];
#pragma unroll
        for (int j = 0; j < 2; ++j) { const int i = F.tid + 512 * j; ee[j] = e_tk[(size_t)blk * 1024 + i]; __hip_atomic_fetch_add(&L[96 + ee[j]], 1, __ATOMIC_RELAXED, __HIP_MEMORY_SCOPE_WORKGROUP); }
        __syncthreads();
        if (F.tid < 32) L[160 + F.tid] = L[64 + F.tid] + (int)__hip_atomic_fetch_add(F.ctl + CW_CURSOR + F.tid, (unsigned)L[96 + F.tid], RLX_AGENT);
        __syncthreads();
#pragma unroll
        for (int j = 0; j < 2; ++j) { const int i = F.tid + 512 * j; const int r = __hip_atomic_fetch_add(&L[128 + ee[j]], 1, __ATOMIC_RELAXED, __HIP_MEMORY_SCOPE_WORKGROUP); const int pos = L[160 + ee[j]] + r;
            const int t = blk * 256 + (i >> 2);
            tok_slot[pos] = t; gate_slot[pos] = g_tk[(size_t)blk * 1024 + i]; rstd_slot[pos] = rstd_t[t]; slot_tk[(size_t)blk * 1024 + i] = pos; }
        __syncthreads();
    }
    for (int e = blockIdx.x; e < NEXP; e += F.G)
        for (int i = L[e] + F.tid; i < L[32 + e]; i += NWAVES * 64) { const int pos = L[64 + e] + i; tok_slot[pos] = 0; gate_slot[pos] = 0.f; rstd_slot[pos] = 0.f; }
    if (blockIdx.x == 0) {
        const int nrb = (L[64 + 31] + L[32 + 31]) >> 8;
        for (int rb = F.tid; rb < NRB_MAX; rb += NWAVES * 64) { int e = 31; for (int q = 0; q < 32; ++q) { if (rb * 256 >= L[64 + q] && rb * 256 < L[64 + q] + L[32 + q]) e = q; } rb_e[rb] = e; }
        if (F.tid == 0) rb_e[NRB_MAX] = nrb;
    }
}
__device__ __forceinline__ void p9_final(Frame& F) {
    const bf16_t* x1b = (const bf16_t*)(F.ws + WS_X1B); const int* slot_tk = (const int*)(F.ws + WS_SLOTTK);
    const unsigned char* Y = F.ws + WS_Y;
    const int gw = F.vcu * NWAVES + F.wave, NGW = F.G * NWAVES;
    const float* final_g = kargs()->in[I_FING];
    f32x4 gg[2][2];
#pragma unroll
    for (int j = 0; j < 2; ++j) { gg[j][0] = *(const f32x4*)(final_g + 8 * F.lane + 512 * j); gg[j][1] = *(const f32x4*)(final_g + 8 * F.lane + 512 * j + 4); }
    int4 slA = make_int4(0, 0, 0, 0), slB = slA;
    if (gw < T) { slA = *(const int4*)(slot_tk + (size_t)gw * 4); const int tb0 = (gw + NGW < T) ? gw + NGW : gw; slB = *(const int4*)(slot_tk + (size_t)tb0 * 4); }
    for (int t = gw; t < T; t += 2 * NGW) {
        const int tA = t, tB = (t + NGW < T) ? t + NGW : t;
        const int tnA = (t + 2 * NGW < T) ? t + 2 * NGW : tA, tnB = (t + 3 * NGW < T) ? t + 3 * NGW : tnA;
        const int4 nA = *(const int4*)(slot_tk + (size_t)tnA * 4), nB = *(const int4*)(slot_tk + (size_t)tnB * 4);
        const int sA[4] = {slA.x, slA.y, slA.z, slA.w}, sB[4] = {slB.x, slB.y, slB.z, slB.w};
        u32x4 xa[2], xb[2]; u32x2 ya[2][4], yb[2][4];
#pragma unroll
        for (int j = 0; j < 2; ++j) { const int c = 8 * F.lane + 512 * j;
            xa[j] = *(const u32x4*)(x1b + (size_t)tA * DM + c); xb[j] = *(const u32x4*)(x1b + (size_t)tB * DM + c);
#pragma unroll
            for (int k = 0; k < 4; ++k) { ya[j][k] = *(const u32x2*)(Y + (size_t)sA[k] * DM + c); yb[j][k] = *(const u32x2*)(Y + (size_t)sB[k] * DM + c); } }
        float va[2][8], vb[2][8]; float ssa = 0.f, ssb = 0.f;
#pragma unroll
        for (int j = 0; j < 2; ++j) {
#pragma unroll
            for (int i = 0; i < 4; ++i) { va[j][2 * i] = bflo(xa[j][i]); va[j][2 * i + 1] = bfhi(xa[j][i]); vb[j][2 * i] = bflo(xb[j][i]); vb[j][2 * i + 1] = bfhi(xb[j][i]); }
#pragma unroll
            for (int k = 0; k < 4; ++k)
#pragma unroll
                for (int w_ = 0; w_ < 2; ++w_) { const f32x2_t a0 = __builtin_amdgcn_cvt_pk_f32_fp8((int)ya[j][k][w_], false), a1 = __builtin_amdgcn_cvt_pk_f32_fp8((int)ya[j][k][w_], true);
                    const f32x2_t b0 = __builtin_amdgcn_cvt_pk_f32_fp8((int)yb[j][k][w_], false), b1 = __builtin_amdgcn_cvt_pk_f32_fp8((int)yb[j][k][w_], true);
                    va[j][4 * w_] += 0.125f * a0[0]; va[j][4 * w_ + 1] += 0.125f * a0[1]; va[j][4 * w_ + 2] += 0.125f * a1[0]; va[j][4 * w_ + 3] += 0.125f * a1[1];
                    vb[j][4 * w_] += 0.125f * b0[0]; vb[j][4 * w_ + 1] += 0.125f * b0[1]; vb[j][4 * w_ + 2] += 0.125f * b1[0]; vb[j][4 * w_ + 3] += 0.125f * b1[1]; }
#pragma unroll
            for (int i = 0; i < 8; ++i) { ssa += va[j][i] * va[j][i]; ssb += vb[j][i] * vb[j][i]; } }
        const float ra = rsqrtf(wave_sum(ssa) * (1.f / DM) + EPS), rb = rsqrtf(wave_sum(ssb) * (1.f / DM) + EPS);
#pragma unroll
        for (int j = 0; j < 2; ++j) { const int c = 8 * F.lane + 512 * j;
            f32x4 o0, o1;
            o0.x = va[j][0] * ra * gg[j][0].x; o0.y = va[j][1] * ra * gg[j][0].y; o0.z = va[j][2] * ra * gg[j][0].z; o0.w = va[j][3] * ra * gg[j][0].w;
            o1.x = va[j][4] * ra * gg[j][1].x; o1.y = va[j][5] * ra * gg[j][1].y; o1.z = va[j][6] * ra * gg[j][1].z; o1.w = va[j][7] * ra * gg[j][1].w;
            *(f32x4*)(F.out + (size_t)tA * DM + c) = o0; *(f32x4*)(F.out + (size_t)tA * DM + c + 4) = o1;
            o0.x = vb[j][0] * rb * gg[j][0].x; o0.y = vb[j][1] * rb * gg[j][0].y; o0.z = vb[j][2] * rb * gg[j][0].z; o0.w = vb[j][3] * rb * gg[j][0].w;
            o1.x = vb[j][4] * rb * gg[j][1].x; o1.y = vb[j][5] * rb * gg[j][1].y; o1.z = vb[j][6] * rb * gg[j][1].z; o1.w = vb[j][7] * rb * gg[j][1].w;
            *(f32x4*)(F.out + (size_t)tB * DM + c) = o0; *(f32x4*)(F.out + (size_t)tB * DM + c + 4) = o1; }
        slA = nA; slB = nB;
    }
}

__global__ void __launch_bounds__(NWAVES * 64, 2) hymba_fwd(Args args) {
    extern __shared__ __attribute__((aligned(16))) unsigned char lds[];
    Frame F;
    F.lds = (LAS unsigned char*)lds;
    F.MISC = (volatile LAS unsigned*)(F.lds + MISC_OFF);
    F.tid = threadIdx.x; F.lane = F.tid & 63; F.wave = __builtin_amdgcn_readfirstlane(F.tid >> 6);
    F.G = gridDim.x; { const int bx = blockIdx.x; F.vcu = (F.G % 8 == 0) ? (bx % 8) * (F.G / 8) + bx / 8 : bx; }
    F.ws = args.ws; F.ctl = (unsigned*)(args.ws + WS_CTL); F.out = args.out;
    for (int u = F.tid; u < (LDS_BYTES - LDSCTL_OFF) / 4; u += NWAVES * 64) ((LAS unsigned*)(F.lds + LDSCTL_OFF))[u] = 0u;
    __syncthreads();
    XcdBarrier bar; bar.bar = F.ctl + CW_BAR; bar.x = 0; bar.st = nullptr;
    if (N_LAUNCHES == 1) bar = xcd_barrier_post(F.ctl + CW_BAR, F.MISC + 8);
#define GRID_BAR() do { if (N_LAUNCHES == 1) xcd_barrier(bar); } while (0)
    const int lo = args.ph_lo, hi = args.ph_hi;
#ifndef PH_MASK
#define PH_MASK 0x1ff
#endif
#define IN(k) (((PH_MASK >> (k)) & 1) && lo <= (k) && (k) < hi)
#define BOTH(k) (IN(k) && IN((k) + 1))
    bf16_t* const H = (bf16_t*)(F.ws + WS_H); bf16_t* const PROJ = (bf16_t*)(F.ws + WS_PROJ); bf16_t* const MIX = (bf16_t*)(F.ws + WS_MIX); bf16_t* const X1B = (bf16_t*)(F.ws + WS_X1B);
    bf16_t* const Win_t = (bf16_t*)(F.ws + WS_WIN); bf16_t* const Wout_t = (bf16_t*)(F.ws + WS_WOUT);
    const unsigned char* const Wgu_q = (const unsigned char*)F.out + OUT_WGU; const unsigned char* const Wd_q = (const unsigned char*)F.out + OUT_WD;
    unsigned char* const X1Q = F.ws + WS_X1Q; unsigned char* const ACTQ = F.ws + WS_ACTQ; unsigned char* const Yp = F.ws + WS_Y;
    const int* const tok_slot = (const int*)(F.ws + WS_TOKSLOT); const float* const gate_slot = (const float*)(F.ws + WS_GATESLOT); const float* const rstd_slot = (const float*)(F.ws + WS_RSTDSLOT);
    const int* const rb_e = (const int*)(F.ws + WS_RBE);

#define REP(k) for (int rep_ = 0; rep_ < (((PROBE_REP >> (k)) & 1) ? 2 : 1); ++rep_)
    if (IN(0)) { REP(0) p0_prologue(F); if (BOTH(0)) GRID_BAR(); }
    if (IN(1)) {
        REP(1) {
        pg8::Gemm g{H, Win_t, DM, 0, nullptr}; pg8::StaticOrder S; S.init(T, INW, F.G, (int)blockIdx.x);
        pg8::EpiProj E{PROJ};
        pg8::gemm_phase<pg8::EpiProj, pg8::StaticOrder, true>(F.lds, g, S, E); }
        if (BOTH(1)) GRID_BAR();
    }
    if (IN(2)) { p2_mixers(F); if (BOTH(2)) GRID_BAR(); }
    if (IN(3)) {
        pg8::Gemm g{MIX, Wout_t, DM, 0, nullptr}; pg8::StaticOrder S; S.init(T, DM, F.G, (int)blockIdx.x);
        pg8::EpiX1 E{kargs()->in[I_X], X1B, X1Q};
        pg8::gemm_phase<pg8::EpiX1, pg8::StaticOrder, true>(F.lds, g, S, E);
        if (BOTH(3)) GRID_BAR();
    }
    if (IN(4)) { if (PROBE_X & 2) p4_router(F, true); p4_router(F); if (BOTH(4)) GRID_BAR(); }
    if (IN(5)) { p5_place(F); if (BOTH(5)) GRID_BAR(); }
    if (IN(6)) {
        const int nrb = rb_e[NRB_MAX];
        REP(6) {
        pg8::Gemm g{(const bf16_t*)X1Q, (const bf16_t*)Wgu_q, DM / 2, (long)2048 * DM / 2, tok_slot}; pg8::GroupOrder S{nrb, 0, 8, F.G, (int)blockIdx.x, rb_e};
        pg8::EpiGU E{ACTQ, kargs()->in[I_BGU], rstd_slot};
        pg8::gemm_phase<pg8::EpiGU, pg8::GroupOrder, true, true, (PROBE_KREP == 2 ? 0x78787878 : 0x79797979), 0x7f7f7f7f, PROBE_KREP>(F.lds, g, S, E); }
        if (BOTH(6)) GRID_BAR();
    }
    if (IN(7)) {
        const int nrb = rb_e[NRB_MAX];
        REP(7) {
        pg8::Gemm g{(const bf16_t*)ACTQ, (const bf16_t*)Wd_q, DEXP / 2, (long)DM * DEXP / 2, nullptr}; pg8::GroupOrder S{nrb, 0, 4, F.G, (int)blockIdx.x, rb_e};
        pg8::EpiDown E{Yp, kargs()->in[I_BDN], gate_slot};
        pg8::gemm_phase<pg8::EpiDown, pg8::GroupOrder, true, true, 0x79797979, 0x7d7d7d7d>(F.lds, g, S, E); }
        if (BOTH(7)) GRID_BAR();
    }
    if (IN(8)) { REP(8) p9_final(F); }
#if PROBE_SEG
    if (IN(8) && blockIdx.x == 0 && F.tid == 0) { const unsigned long long a_ = F.ctl[604], t_ = F.ctl[605]; const unsigned long long us_ = t_ ? a_ * 2000ull / t_ : 0ull; const unsigned long long t0_ = __builtin_amdgcn_s_memrealtime();
        while (__builtin_amdgcn_s_memrealtime() - t0_ < us_ * 100ull) __builtin_amdgcn_s_sleep(8); }
#endif
#if PROBE_CLK
    if (IN(8) && blockIdx.x == 0 && F.tid == 0) { const unsigned long long dc_ = ((unsigned long long)F.ctl[601] << 32) | F.ctl[600]; const unsigned long long dr_ = F.ctl[602];
        const unsigned long long mhz_ = dr_ ? dc_ * 100ull / dr_ : 0ull; const unsigned long long t0_ = __builtin_amdgcn_s_memrealtime();
        while (__builtin_amdgcn_s_memrealtime() - t0_ < mhz_ * 100ull) __builtin_amdgcn_s_sleep(8); }
#endif
#undef IN
#undef BOTH
#undef GRID_BAR
}

extern "C" void kernel_launch(void* const* d_in, const int* in_sizes, int n_in, void* d_out, int out_size, void* d_ws, size_t ws_size, hipStream_t stream) {
    static int grid = 0;
    if (grid == 0) {
        if (n_in != 19 || out_size != T * DM || ws_size < WS_END) { fprintf(stderr, "kernel_launch: unexpected shapes (n_in %d out %d ws %zu)\n", n_in, out_size, ws_size); grid = -1; return; }
        int dev = 0, cus = 0;
        if (hipGetDevice(&dev) != hipSuccess || hipDeviceGetAttribute(&cus, hipDeviceAttributeMultiprocessorCount, dev) != hipSuccess) { grid = -1; return; }
        if (hipFuncSetAttribute((const void*)hymba_fwd, hipFuncAttributeMaxDynamicSharedMemorySize, LDS_BYTES) != hipSuccess) { fprintf(stderr, "kernel_launch: hipFuncSetAttribute failed\n"); grid = -1; return; }
        int per_cu = 0;
        if (hipOccupancyMaxActiveBlocksPerMultiprocessor(&per_cu, (const void*)hymba_fwd, NWAVES * 64, LDS_BYTES) != hipSuccess || per_cu < 1) fprintf(stderr, "kernel_launch: occupancy query reports %d\n", per_cu);
        (void)hipGetLastError();
        grid = cus;
    }
    if (grid < 0) return;
    if (hipMemsetAsync((char*)d_ws + WS_CTL, 0, CTL_ZERO_BYTES, stream) != hipSuccess) return;
    Args a{};
    for (int i = 0; i < 19; ++i) a.in[i] = (const float*)d_in[i];
    a.out = (float*)d_out; a.ws = (unsigned char*)d_ws;
    for (int li = 0; li < N_LAUNCHES; ++li) {
        a.ph_lo = (N_LAUNCHES == 1) ? 0 : li; a.ph_hi = (N_LAUNCHES == 1) ? N_PHASES : li + 1;
        hipLaunchKernelGGL(hymba_fwd, dim3(grid), dim3(NWAVES * 64), LDS_BYTES, stream, a);
    }
}
```

```cpp
#include <hip/hip_runtime.h>
#include <hip/hip_bf16.h>
#include <cstdio>
#include <cstdint>

#ifndef PROBE_REP
#define PROBE_REP 0
#endif
#ifndef PROBE_X
#define PROBE_X 0
#endif
#ifndef PROBE_P0
#define PROBE_P0 0
#endif
#ifndef PROBE_SEG
#define PROBE_SEG 0
#endif
#ifndef PROBE_CLK
#define PROBE_CLK 0
#endif
#ifndef PROBE_KREP
#define PROBE_KREP 1
#endif
#ifndef PROBE_EPI
#define PROBE_EPI 0
#endif
#ifndef MK_N_LAUNCHES
#define MK_N_LAUNCHES 1
#endif

constexpr int BATCH = 8, SEQ = 8192, DM = 1024, T = BATCH * SEQ, INW = 2560, MEML = 256, NEXP = 32, TOPK = 4, DEXP = 1024;
constexpr int COL_U = 0, COL_GB = 256, COL_GC = 512, COL_Q = 768, COL_K = 1280, COL_V = 1792, COL_QM = 2304;
constexpr float EPS = 1e-5f;
constexpr float C2 = 0.125f * 1.4426950408889634f;
constexpr float LOG2E = 1.4426950408889634f;
constexpr int NRB_MAX = 1056;

#define GAS __attribute__((address_space(1)))
#define LAS __attribute__((address_space(3)))
typedef unsigned short bf16_t;
typedef short bf16x8 __attribute__((ext_vector_type(8)));
typedef short s16x4 __attribute__((ext_vector_type(4)));
typedef float f32x4 __attribute__((ext_vector_type(4)));
typedef float f32x16 __attribute__((ext_vector_type(16)));
typedef unsigned u32x4 __attribute__((ext_vector_type(4)));
typedef unsigned u32x2 __attribute__((ext_vector_type(2)));
typedef float f32x2_t __attribute__((ext_vector_type(2)));
typedef __bf16 bf16x2_t __attribute__((ext_vector_type(2)));
typedef GAS unsigned gu32;
#define RLX_AGENT __ATOMIC_RELAXED, __HIP_MEMORY_SCOPE_AGENT
#define LDS_WAIT() asm volatile("s_waitcnt lgkmcnt(0)" ::: "memory")
#define VM_WAIT() asm volatile("s_waitcnt vmcnt(0)" ::: "memory")
#define SBAR() __builtin_amdgcn_sched_barrier(0)

__device__ __forceinline__ unsigned pk2(float lo, float hi) { f32x2_t v = {lo, hi}; bf16x2_t b = __builtin_convertvector(v, bf16x2_t); return __builtin_bit_cast(unsigned, b); }
__device__ __forceinline__ float bflo(unsigned u) { return __uint_as_float(u << 16); }
__device__ __forceinline__ float bfhi(unsigned u) { return __uint_as_float(u & 0xffff0000u); }
__device__ __forceinline__ bf16x8 pack8(f32x4 a, f32x4 b) { u32x4 w = {pk2(a[0], a[1]), pk2(a[2], a[3]), pk2(b[0], b[1]), pk2(b[2], b[3])}; return __builtin_bit_cast(bf16x8, w); }
__device__ __forceinline__ int crow(int r, int hi) { return (r & 3) + 8 * (r >> 2) + 4 * hi; }
__device__ __forceinline__ float wave_sum(float v) {
#pragma unroll
    for (int o = 1; o < 64; o <<= 1) v += __shfl_xor(v, o);
    return v;
}

namespace pg8 {
constexpr int BM = 256, BK = 64, HALF = 128, HTB = HALF * BK * 2  , STAGE_BYTES = 8 * HTB, NXCD = 8, WGM = 8;
__host__ __device__ __forceinline__ int lds_byte(int r, int c) { const int st = (r >> 4) * 2 + (c >> 5), rr = r & 15, cc = c & 31, ob = rr * 64 + cc * 2; return st * 1024 + (ob ^ (((ob >> 9) & 1) << 5)); }
__host__ __device__ __forceinline__ void stage_rc(int b, int& R, int& C) { const int st = b / 1024, sb = b % 1024, swz = sb ^ (((sb >> 9) & 1) << 5); R = (st >> 1) * 16 + swz / 64; C = (st & 1) * 32 + (swz % 64) / 2; }
__host__ __device__ __forceinline__ int perm32(int rho) { const int n = rho >> 4, i = rho & 15; return 8 * (i >> 2) + 4 * n + (i & 3); }

struct Unit { int pm, pn, e; };
struct Gemm { const bf16_t* A; const bf16_t* Bt; int K; long bstride; const int* rowmap; };

struct StaticOrder {
    int nM, nN, nwg, G, c;
    __device__ void init(int M, int N, int G_, int c_) { nM = M / BM; nN = N / BM; nwg = nM * nN; G = G_; c = c_; }
    __device__ bool next(int i, Unit& u) const {
        const long L = (long)i * G + c; if (L >= nwg) return false;
        int wgid = (int)L; { const int q = nwg / NXCD, r = nwg % NXCD, xcd = wgid % NXCD, off = wgid / NXCD; wgid = (xcd < r ? xcd * (q + 1) : r * (q + 1) + (xcd - r) * q) + off; }
        const int nig = WGM * nN, gid = wgid / nig, fm = gid * WGM, gsz = (nM - fm) < WGM ? (nM - fm) : WGM;
        u.pm = fm + ((wgid % nig) % gsz); u.pn = (wgid % nig) / gsz; u.e = 0; return true;
    }
};
struct GroupOrder {
    int nrb, rb0, npn, G, c; const int* rb_e;
    __device__ bool next(int i, Unit& u) const {
        int rbl, pn;
        if ((G & 7) == 0 && ((G >> 3) % npn) == 0) { const int x = c & 7, j = c >> 3, rpx = (G >> 3) / npn; rbl = i * (G / npn) + x * rpx + j / npn; pn = j % npn; }
        else { const long L = (long)i * G + c; rbl = (int)(L / npn); pn = (int)(L % npn); }
        if (rbl >= nrb) return false;
        u.pm = rb0 + rbl; u.pn = pn; u.e = rb_e[u.pm]; return true;
    }
};

typedef int v4i_t __attribute__((ext_vector_type(4)));
typedef int v8i_t __attribute__((ext_vector_type(8)));
template <class Epi, class Sched, bool ALIGN_EPI, bool FP8 = false, int SCW = 0x7f7f7f7f, int SCA = 0x7f7f7f7f, int KREP = 1>
__device__ __forceinline__ void gemm_phase(LAS unsigned char* lds, const Gemm g, const Sched& S, const Epi& E) {
    const int tid = threadIdx.x, wid = __builtin_amdgcn_readfirstlane(tid >> 6), lane = tid & 63, wr = wid >> 2, wc = wid & 3, fr = lane & 15, fq = lane >> 4;
    const int K = g.K; int nt = K / BK; asm volatile("" : "+s"(nt));
    int Rr[2], Cc[2]; unsigned voffB[2];
#pragma unroll
    for (int i = 0; i < 2; ++i) { int R, C; stage_rc(tid * 16 + i * 8192, R, C); const int Rb = Epi::PERM ? ((R & ~31) + perm32(R & 31)) : R;
        Rr[i] = R; Cc[i] = C; voffB[i] = (unsigned)(Rb * K + C) * 2u; }
    const size_t kstep = (size_t)(BK * 2);
    const size_t hstep = (size_t)HALF * K * 2;
    const size_t tstep = 2 * hstep;
    const unsigned ldsw = (unsigned)wid * 1024u;
    const int aoff = lds_byte(wr * 64 + fr, fq * 8), boff = lds_byte(wc * 32 + fr, fq * 8);
#define PG8_SA(b, h) (((b) * 2 + (h)) * HTB)
#define PG8_SB(b, h) ((4 + (b) * 2 + (h)) * HTB)
#define PG8_STAGE(bufoff, gbase, voff) do { _Pragma("unroll") for (int _i = 0; _i < 2; ++_i) \
        __builtin_amdgcn_global_load_lds((const unsigned*)((const char*)(gbase) + (voff)[_i]), (LAS unsigned*)(lds + (bufoff) + ldsw + _i * 8192), 16, 0, 0); } while (0)
#define PG8_STAGE_A(bufoff, kptr, offs, h) do { _Pragma("unroll") for (int _i = 0; _i < 2; ++_i) \
        __builtin_amdgcn_global_load_lds((const unsigned*)((const char*)(kptr) + (offs)[h][_i]), (LAS unsigned*)(lds + (bufoff) + ldsw + _i * 8192), 16, 0, 0); } while (0)
#define PG8_AOFF(dst, u) do { _Pragma("unroll") for (int _h = 0; _h < 2; ++_h) _Pragma("unroll") for (int _i = 0; _i < 2; ++_i) { const int _row = (u).pm * BM + _h * HALF + Rr[_i]; \
        const int _src = g.rowmap ? g.rowmap[_row] : _row; dst[_h][_i] = (unsigned)(_src * K + Cc[_i]) * 2u; } } while (0)
#define PG8_LDA(dst, b, h) do { _Pragma("unroll") for (int m = 0; m < 4; ++m) _Pragma("unroll") for (int k = 0; k < 2; ++k) dst[m][k] = *(const LAS bf16x8*)(lds + PG8_SA(b, h) + aoff + m * 2048 + k * 1024); } while (0)
#define PG8_LDB(dst, b, h) do { _Pragma("unroll") for (int n = 0; n < 2; ++n) _Pragma("unroll") for (int k = 0; k < 2; ++k) dst[n][k] = *(const LAS bf16x8*)(lds + PG8_SB(b, h) + boff + n * 2048 + k * 1024); } while (0)
#define PG8_CAT(x, y) __builtin_shufflevector(__builtin_bit_cast(v4i_t, x), __builtin_bit_cast(v4i_t, y), 0, 1, 2, 3, 4, 5, 6, 7)
#define PG8_MMA(ai, bj, At, Bt) do { __builtin_amdgcn_s_setprio(1); _Pragma("unroll") for (int m = 0; m < 4; ++m) _Pragma("unroll") for (int n = 0; n < 2; ++n) { \
        if constexpr (FP8) { acc[ai][bj][m][n] = __builtin_amdgcn_mfma_scale_f32_16x16x128_f8f6f4(PG8_CAT(Bt[n][0], Bt[n][1]), PG8_CAT(At[m][0], At[m][1]), acc[ai][bj][m][n], 0, 0, 0, SCW, 0, SCA); } \
        else { _Pragma("unroll") for (int k = 0; k < 2; ++k) acc[ai][bj][m][n] = __builtin_amdgcn_mfma_f32_16x16x32_bf16(Bt[n][k], At[m][k], acc[ai][bj][m][n], 0, 0, 0); } } \
        __builtin_amdgcn_s_setprio(0); } while (0)
#define PG8_WAIT_V(n) asm volatile("s_waitcnt vmcnt(" #n ")" ::: "memory")
#define PG8_WAIT_L(n) asm volatile("s_waitcnt lgkmcnt(" #n ")" ::: "memory")
#define PG8_BAR __builtin_amdgcn_s_barrier()
#define PG8_SCHED __builtin_amdgcn_sched_barrier(0)
    Unit cur, nxt; int ui = 0;
    if (!S.next(0, cur)) return;
    f32x4 acc[2][2][4][2];
#pragma unroll
    for (int a = 0; a < 2; ++a)
#pragma unroll
        for (int b = 0; b < 2; ++b)
#pragma unroll
            for (int m = 0; m < 4; ++m)
#pragma unroll
                for (int n = 0; n < 2; ++n) acc[a][b][m][n] = (f32x4){0.f, 0.f, 0.f, 0.f};
    bf16x8 At[4][2], B0[2][2], B1[2][2];
    unsigned aoc[2][2], aon[2][2];
    PG8_AOFF(aoc, cur);
    const char* Ab = (const char*)g.A;
    const char* cB = (const char*)g.Bt + ((size_t)cur.e * (size_t)g.bstride) * 2 + (size_t)cur.pn * tstep;
    PG8_STAGE(PG8_SB(0, 0), cB, voffB); PG8_STAGE(PG8_SB(0, 1), cB + hstep, voffB); PG8_STAGE_A(PG8_SA(0, 0), Ab, aoc, 0); PG8_STAGE_A(PG8_SA(0, 1), Ab, aoc, 1);
    if (wr == 1) PG8_BAR;
    PG8_WAIT_V(2); PG8_BAR;
    PG8_STAGE(PG8_SB(1, 0), cB + kstep, voffB); PG8_STAGE_A(PG8_SA(1, 0), Ab + kstep, aoc, 0); PG8_STAGE(PG8_SB(1, 1), cB + hstep + kstep, voffB);
    PG8_WAIT_V(6); PG8_BAR;
    for (;;) {
        const bool has_next = S.next(ui + 1, nxt);
        if (has_next) { PG8_AOFF(aon, nxt); }
        else {
#pragma unroll
            for (int h = 0; h < 2; ++h)
#pragma unroll
                for (int i = 0; i < 2; ++i) aon[h][i] = aoc[h][i];
        }
        const char* nB = has_next ? (const char*)g.Bt + ((size_t)nxt.e * (size_t)g.bstride) * 2 + (size_t)nxt.pn * tstep : cB;
#pragma nounroll
        for (int t = 0; t < nt * KREP; t += 2) {
            const bool last = (t == nt * KREP - 2);
            const char* a1 = Ab + (size_t)((t + 1) & (nt - 1)) * kstep;
            const char* a2 = last ? Ab : Ab + (size_t)((t + 2) & (nt - 1)) * kstep; const char* b2 = last ? nB : cB + (size_t)((t + 2) & (nt - 1)) * kstep;
            const char* a3 = a2 + kstep; const char* b3 = b2 + kstep;
            PG8_LDB(B0, 0, 0); PG8_LDB(B1, 0, 1); PG8_SCHED; PG8_LDA(At, 0, 0); PG8_STAGE_A(PG8_SA(1, 1), a1, aoc, 1);
            if (last) {
#pragma unroll
                for (int h = 0; h < 2; ++h)
#pragma unroll
                    for (int i = 0; i < 2; ++i) aoc[h][i] = aon[h][i]; }
            PG8_WAIT_V(8); PG8_WAIT_L(0); PG8_BAR; PG8_MMA(0, 0, At, B0); PG8_MMA(0, 1, At, B1); PG8_BAR; PG8_SCHED;
            PG8_LDA(At, 0, 1); PG8_STAGE(PG8_SB(0, 0), b2, voffB); PG8_STAGE(PG8_SB(0, 1), b2 + hstep, voffB); PG8_STAGE_A(PG8_SA(0, 0), a2, aoc, 0);
            PG8_WAIT_V(8); PG8_WAIT_L(0); PG8_BAR; PG8_MMA(1, 0, At, B0); PG8_MMA(1, 1, At, B1); PG8_BAR; PG8_SCHED;
            PG8_LDB(B0, 1, 0); PG8_LDB(B1, 1, 1); PG8_SCHED; PG8_LDA(At, 1, 0); PG8_STAGE_A(PG8_SA(0, 1), a2, aoc, 1);
            PG8_WAIT_V(8); PG8_WAIT_L(0); PG8_BAR; PG8_MMA(0, 0, At, B0); PG8_MMA(0, 1, At, B1); PG8_BAR; PG8_SCHED;
            PG8_LDA(At, 1, 1); PG8_STAGE(PG8_SB(1, 0), b3, voffB); PG8_STAGE(PG8_SB(1, 1), b3 + hstep, voffB); PG8_STAGE_A(PG8_SA(1, 0), a3, aoc, 0);
            PG8_WAIT_V(8); PG8_WAIT_L(0); PG8_BAR; PG8_MMA(1, 0, At, B0); PG8_MMA(1, 1, At, B1); PG8_BAR; PG8_SCHED;
        }
        if constexpr (ALIGN_EPI) { if (wr == 0) PG8_BAR; }
        E(acc, cur, wr, wc, fr, fq);
        if constexpr (FP8 && PROBE_EPI != 0) { asm volatile("" ::: "memory"); E(acc, cur, wr, wc, fr, fq); }
        if (!has_next) break;
#pragma unroll
        for (int a = 0; a < 2; ++a)
#pragma unroll
            for (int b = 0; b < 2; ++b)
#pragma unroll
                for (int m = 0; m < 4; ++m)
#pragma unroll
                    for (int n = 0; n < 2; ++n) acc[a][b][m][n] = (f32x4){0.f, 0.f, 0.f, 0.f};
        cur = nxt; cB = nB; ++ui;
        if constexpr (ALIGN_EPI) { if (wr == 1) PG8_BAR; }
    }
    PG8_WAIT_V(0);
    if constexpr (!ALIGN_EPI) { if (wr == 0) PG8_BAR; }
    PG8_BAR;
#undef PG8_SA
#undef PG8_SB
#undef PG8_STAGE
#undef PG8_STAGE_A
#undef PG8_AOFF
#undef PG8_LDA
#undef PG8_LDB
#undef PG8_MMA
#undef PG8_CAT
#undef PG8_WAIT_V
#undef PG8_WAIT_L
#undef PG8_BAR
#undef PG8_SCHED
}

struct EpiProj {
    static constexpr bool PERM = true;
    bf16_t* O;
    __device__ __forceinline__ void operator()(const f32x4 (&acc)[2][2][4][2], const Unit& u, int wr, int wc, int fr, int fq) const {
        const int row0 = u.pm * BM + wr * 64 + fr, col0 = u.pn * BM + wc * 32 + 8 * fq;
        const float sc = (u.pn == 3 || u.pn == 4 || u.pn == 9) ? C2 : 1.f;
#pragma unroll
        for (int ai = 0; ai < 2; ++ai)
#pragma unroll
            for (int m = 0; m < 4; ++m) { bf16_t* rowp = O + (size_t)(row0 + ai * HALF + m * 16) * INW + col0;
#pragma unroll
                for (int bj = 0; bj < 2; ++bj) { const f32x4 v0 = acc[ai][bj][m][0] * sc, v1 = acc[ai][bj][m][1] * sc;
                    u32x4 w; w.x = pk2(v0[0], v0[1]); w.y = pk2(v0[2], v0[3]); w.z = pk2(v1[0], v1[1]); w.w = pk2(v1[2], v1[3]);
                    *(u32x4*)(rowp + bj * HALF) = w; } }
    }
};
__device__ __forceinline__ unsigned pk4_fp8(float a, float b, float c, float d) { int w = 0; w = __builtin_amdgcn_cvt_pk_fp8_f32(a, b, w, false); w = __builtin_amdgcn_cvt_pk_fp8_f32(c, d, w, true); return (unsigned)w; }
struct EpiX1 {
    static constexpr bool PERM = true;
    const float* X; bf16_t* O; unsigned char* Q8;
    __device__ __forceinline__ void operator()(const f32x4 (&acc)[2][2][4][2], const Unit& u, int wr, int wc, int fr, int fq) const {
        const int row0 = u.pm * BM + wr * 64 + fr, col0 = u.pn * BM + wc * 32 + 8 * fq;
        const float* __restrict__ Xr = X; bf16_t* __restrict__ Or = O; unsigned char* __restrict__ Qr = Q8;
#pragma unroll
        for (int ai = 0; ai < 2; ++ai) {
            f32x4 xv[4][2][2];
#pragma unroll
            for (int m = 0; m < 4; ++m) { const size_t off = (size_t)(row0 + ai * HALF + m * 16) * DM + col0;
#pragma unroll
                for (int bj = 0; bj < 2; ++bj) { xv[m][bj][0] = *(const f32x4*)(Xr + off + bj * HALF); xv[m][bj][1] = *(const f32x4*)(Xr + off + bj * HALF + 4); } }
#pragma unroll
            for (int m = 0; m < 4; ++m) { const size_t off = (size_t)(row0 + ai * HALF + m * 16) * DM + col0;
#pragma unroll
                for (int bj = 0; bj < 2; ++bj) { const f32x4 v0 = acc[ai][bj][m][0] + xv[m][bj][0], v1 = acc[ai][bj][m][1] + xv[m][bj][1];
                    u32x4 w; w.x = pk2(v0[0], v0[1]); w.y = pk2(v0[2], v0[3]); w.z = pk2(v1[0], v1[1]); w.w = pk2(v1[2], v1[3]);
                    *(u32x4*)(Or + off + bj * HALF) = w;
                    u32x2 q; q.x = pk4_fp8(v0[0], v0[1], v0[2], v0[3]); q.y = pk4_fp8(v1[0], v1[1], v1[2], v1[3]);
                    *(u32x2*)(Qr + off + bj * HALF) = q; } }
        }
    }
};
struct EpiGU {
    static constexpr bool PERM = true;
    unsigned char* ACT; const float* bias; const float* rstd;
    __device__ __forceinline__ void operator()(const f32x4 (&acc)[2][2][4][2], const Unit& u, int wr, int wc, int fr, int fq) const {
        const int row0 = u.pm * BM + wr * 64 + fr, j0 = u.pn * HALF + wc * 32 + 8 * fq;
        const float* bp = bias + (size_t)u.e * 2048 + j0;
        const f32x4 bg0 = *(const f32x4*)(bp), bg1 = *(const f32x4*)(bp + 4), bu0 = *(const f32x4*)(bp + 1024), bu1 = *(const f32x4*)(bp + 1028);
        float rsv[2][4];
#pragma unroll
        for (int ai = 0; ai < 2; ++ai)
#pragma unroll
            for (int m = 0; m < 4; ++m) rsv[ai][m] = rstd[row0 + ai * HALF + m * 16];
#pragma unroll
        for (int ai = 0; ai < 2; ++ai)
#pragma unroll
            for (int m = 0; m < 4; ++m) { const int row = row0 + ai * HALF + m * 16; const float rs = rsv[ai][m];
                f32x4 g0 = acc[ai][0][m][0] * rs + bg0, g1 = acc[ai][0][m][1] * rs + bg1, u0 = acc[ai][1][m][0] * rs + bu0, u1 = acc[ai][1][m][1] * rs + bu1;
                float o[8];
#pragma unroll
                for (int i = 0; i < 4; ++i) {
                    { const float gg = fminf(g0[i], 7.f), uu = __builtin_amdgcn_fmed3f(u0[i], -7.f, 7.f); const float s4 = gg * __builtin_amdgcn_rcpf(fmaf(__builtin_amdgcn_exp2f(-1.702f * LOG2E * gg), 0.25f, 0.25f)); o[i] = fmaf(uu, s4, s4); }
                    { const float gg = fminf(g1[i], 7.f), uu = __builtin_amdgcn_fmed3f(u1[i], -7.f, 7.f); const float s4 = gg * __builtin_amdgcn_rcpf(fmaf(__builtin_amdgcn_exp2f(-1.702f * LOG2E * gg), 0.25f, 0.25f)); o[4 + i] = fmaf(uu, s4, s4); }
                }
                u32x2 w; w.x = pk4_fp8(o[0], o[1], o[2], o[3]); w.y = pk4_fp8(o[4], o[5], o[6], o[7]);
                *(u32x2*)(ACT + (size_t)row * DEXP + j0) = w; }
    }
};
struct EpiDown {
    static constexpr bool PERM = true;
    unsigned char* Y; const float* bias; const float* gate;
    __device__ __forceinline__ void operator()(const f32x4 (&acc)[2][2][4][2], const Unit& u, int wr, int wc, int fr, int fq) const {
        const int row0 = u.pm * BM + wr * 64 + fr, col0 = u.pn * BM + wc * 32 + 8 * fq;
        const float* bp = bias + (size_t)u.e * DM + col0;
        f32x4 bv[2][2];
#pragma unroll
        for (int bj = 0; bj < 2; ++bj) { bv[bj][0] = *(const f32x4*)(bp + bj * HALF); bv[bj][1] = *(const f32x4*)(bp + bj * HALF + 4); }
        float gsv[2][4];
#pragma unroll
        for (int ai = 0; ai < 2; ++ai)
#pragma unroll
            for (int m = 0; m < 4; ++m) gsv[ai][m] = 8.f * gate[row0 + ai * HALF + m * 16];
#pragma unroll
        for (int ai = 0; ai < 2; ++ai)
#pragma unroll
            for (int m = 0; m < 4; ++m) { const int row = row0 + ai * HALF + m * 16; const float gs = gsv[ai][m];
#pragma unroll
                for (int bj = 0; bj < 2; ++bj) { const f32x4 v0 = (acc[ai][bj][m][0] + bv[bj][0]) * gs, v1 = (acc[ai][bj][m][1] + bv[bj][1]) * gs;
                    u32x2 w; w.x = pk4_fp8(v0[0], v0[1], v0[2], v0[3]); w.y = pk4_fp8(v1[0], v1[1], v1[2], v1[3]);
                    *(u32x2*)(Y + (size_t)row * DM + col0 + bj * HALF) = w; } }
    }
};
}

namespace dattn {
constexpr int NW = 8, QBLK = 32, KVBLK = 64, QB = 256, PITCH = INW;
constexpr int SHM_V = KVBLK * 128 * 2, SHM_K = KVBLK * 64 * 2;
constexpr int NVS = 4, NKS = 3;
constexpr int OFF_V = 0, OFF_K = NVS * SHM_V, OFF_WS = OFF_K + NKS * SHM_K, OFF_STASH = OFF_WS + NW * 64 * 4, OFF_TB = OFF_STASH + NW * 8192, LDS_BYTES = OFF_TB + 4 * 128 * 4;
constexpr float THR = 8.f;
__device__ __forceinline__ int v_st(int k, int c) { const int kk = k;     return ((kk >> 3) * 4 + (c >> 5)) * 512 + ((kk & 7) * 32 + (c & 31)) * 2; }
__device__ __forceinline__ int v_rd_base(int lane) { return ((lane & 3) << 3) | (((lane >> 2) & 3) << 6) | (((lane >> 4) & 1) << 5) | (((lane >> 5) & 1) << 8); }
constexpr int v_rd_off(int d0, int ks, int half) { return d0 * 512 + ks * 4096 + half * 2048; }

struct Ref { unsigned qoff, koff, voff; bf16_t* O; int P0, comp, h; };
typedef __amdgpu_buffer_rsrc_t rsrc_t;
__device__ __forceinline__ bf16x8 bld8(rsrc_t r, unsigned voff, unsigned soff) { return __builtin_bit_cast(bf16x8, __builtin_amdgcn_raw_buffer_load_b128(r, (int)voff, (int)soff, 0)); }
struct Seam { bf16x8 qr[4]; int ks, vs;
#if PROBE_SEG
    unsigned long long acc, tot;
#endif
};

__device__ __forceinline__ bf16x8 ld8(const bf16_t* p) { return *reinterpret_cast<const bf16x8*>(p); }

__device__ __forceinline__ void bias_mask(f32x16& p0, f32x16& p1, int sdq  , const LAS float* tb) {
    const float NEG = -__builtin_inff();
    int lane_ = (int)__builtin_amdgcn_mbcnt_hi(~0u, __builtin_amdgcn_mbcnt_lo(~0u, 0u));
    int dq = sdq + (lane_ & 31) - 4 * (lane_ >> 5);
    asm volatile("" : "+v"(dq));
#pragma unroll
    for (int r = 0; r < 16; ++r) {
        const int c = (r & 3) + 8 * (r >> 2);
        const int d0 = dq - c, d1 = dq - c - 32;
        const int i0 = d0 < 0 ? 0 : (d0 > 127 ? 127 : d0), i1 = d1 < 0 ? 0 : (d1 > 127 ? 127 : d1);
        const float b0 = tb[i0], b1 = tb[i1];
        p0[r] = d0 < 0 ? NEG : p0[r] + b0;
        p1[r] = d1 < 0 ? NEG : p1[r] + b1;
    }
}
__device__ __forceinline__ void partialSM(f32x16& p0, f32x16& p1, float& m_reg, float& alpha) {
    float pmax = p0[0];
#pragma unroll
    for (int r = 1; r < 16; ++r) pmax = fmaxf(pmax, p0[r]);
#pragma unroll
    for (int r = 0; r < 16; ++r) pmax = fmaxf(pmax, p1[r]);
    { auto rr = __builtin_amdgcn_permlane32_swap(__float_as_uint(pmax), __float_as_uint(pmax), false, false);
      pmax = fmaxf(__uint_as_float(rr[0]), __uint_as_float(rr[1])); }
    float mn;
    if (__builtin_expect(__all((pmax - m_reg) <= THR), 1)) { mn = m_reg; alpha = 1.f; }
    else { mn = fmaxf(m_reg, pmax); alpha = __builtin_amdgcn_exp2f(m_reg - mn); m_reg = mn; }
#pragma unroll
    for (int r = 0; r < 16; ++r) p0[r] = p0[r] - mn;
#pragma unroll
    for (int r = 0; r < 16; ++r) p1[r] = p1[r] - mn;
#pragma unroll
    for (int r = 0; r < 16; ++r) p0[r] = __builtin_amdgcn_exp2f(p0[r]);
}
__device__ __forceinline__ void finishSM(f32x16& p0, f32x16& p1, float alpha, float& l_reg, bf16x8& pa0, bf16x8& pa1, bf16x8& pa2, bf16x8& pa3) {
#pragma unroll
    for (int r = 0; r < 16; ++r) p1[r] = __builtin_amdgcn_exp2f(p1[r]);
    float ps = 0;
#pragma unroll
    for (int r = 0; r < 16; ++r) ps += p0[r];
#pragma unroll
    for (int r = 0; r < 16; ++r) ps += p1[r];
    { auto rr = __builtin_amdgcn_permlane32_swap(__float_as_uint(ps), __float_as_uint(ps), false, false);
      ps = __uint_as_float(rr[0]) + __uint_as_float(rr[1]); }
    l_reg = l_reg * alpha + ps;
#define PK4(P, B_, OUT) do { unsigned a0 = pk2(P[B_+0], P[B_+1]), a1 = pk2(P[B_+2], P[B_+3]);                          \
        unsigned b0 = pk2(P[B_+4], P[B_+5]), b1 = pk2(P[B_+6], P[B_+7]);                                             \
        auto r0 = __builtin_amdgcn_permlane32_swap(a0, b0, false, false); auto r1 = __builtin_amdgcn_permlane32_swap(a1, b1, false, false); \
        u32x4 w = {r0[0], r1[0], r0[1], r1[1]}; OUT = __builtin_bit_cast(bf16x8, w); } while (0)
    PK4(p0, 0, pa0); PK4(p0, 8, pa1); PK4(p1, 0, pa2); PK4(p1, 8, pa3);
#undef PK4
}
template <int KB>
__device__ __forceinline__ void qkt(f32x16& p0, f32x16& p1, const LAS unsigned char* K_lds, int r32, int hi, const bf16x8* qr) {
    p0 = f32x16{}; p1 = f32x16{};
    const int s = (r32 >> 1) & 7;
#pragma unroll
    for (int d0 = 0; d0 < 4; ++d0) {
        const LAS unsigned char* a = K_lds + KB * SHM_K + r32 * 128 + (((2 * d0 + hi) ^ s) << 4);
        const bf16x8 b0 = *(const LAS bf16x8*)(a);
        const bf16x8 b1 = *(const LAS bf16x8*)(a + 32 * 128);
        p0 = __builtin_amdgcn_mfma_f32_32x32x16_bf16(b0, qr[d0], p0, 0, 0, 0);
        p1 = __builtin_amdgcn_mfma_f32_32x32x16_bf16(b1, qr[d0], p1, 0, 0, 0); }
}
__device__ __forceinline__ void pv_tile(f32x16* o, int vb0, bf16x8 pa0, bf16x8 pa1, bf16x8 pa2, bf16x8 pa3) {
#define TRRD(dst, off) asm volatile("ds_read_b64_tr_b16 %0, %1 offset:%2" : "=&v"(dst) : "v"(vb0), "i"(off) : "memory")
#define PV_D0(d0) do { s16x4 l0, l1, l2, l3, h0, h1, h2, h3; constexpr int b_ = v_rd_off(d0, 0, 0); \
        TRRD(l0, b_); TRRD(h0, b_ + 2048); TRRD(l1, b_ + 4096); TRRD(h1, b_ + 6144); TRRD(l2, b_ + 8192); TRRD(h2, b_ + 10240); TRRD(l3, b_ + 12288); TRRD(h3, b_ + 14336); \
        asm volatile("s_waitcnt lgkmcnt(0)" ::: "memory"); SBAR();   \
        o[d0] = __builtin_amdgcn_mfma_f32_32x32x16_bf16(pa0, (bf16x8){l0[0], l0[1], l0[2], l0[3], h0[0], h0[1], h0[2], h0[3]}, o[d0], 0, 0, 0);   \
        o[d0] = __builtin_amdgcn_mfma_f32_32x32x16_bf16(pa1, (bf16x8){l1[0], l1[1], l1[2], l1[3], h1[0], h1[1], h1[2], h1[3]}, o[d0], 0, 0, 0);   \
        o[d0] = __builtin_amdgcn_mfma_f32_32x32x16_bf16(pa2, (bf16x8){l2[0], l2[1], l2[2], l2[3], h2[0], h2[1], h2[2], h2[3]}, o[d0], 0, 0, 0);   \
        o[d0] = __builtin_amdgcn_mfma_f32_32x32x16_bf16(pa3, (bf16x8){l3[0], l3[1], l3[2], l3[3], h3[0], h3[1], h3[2], h3[3]}, o[d0], 0, 0, 0); } while (0)
    PV_D0(0); PV_D0(1); PV_D0(2); PV_D0(3);
#undef PV_D0
#undef TRRD
}

#define DA_DMA16(gp, ldsp) __builtin_amdgcn_global_load_lds((const unsigned*)(gp), (LAS unsigned*)(ldsp), 16, 0, 0)
#define DA_STAGE(koff_, voff_, k0, ksoff, vsoff) do { const size_t tb_ = (size_t)(k0) * (PITCH * 2); \
        DA_DMA16(projb + (koff_) + tb_ + lk, K_lds + (ksoff) + wid * 1024); \
        DA_DMA16(projb + (voff_) + tb_ + lv, V_lds + (vsoff) + wid * 2048); \
        DA_DMA16(projb + (voff_) + tb_ + lv + 128, V_lds + (vsoff) + wid * 2048 + 1024); } while (0)
#define DA_LANE_OFFS() const int krow_ = 8 * wid + (lane >> 3); \
        const unsigned lk = (unsigned)(krow_ * PITCH) * 2u + (unsigned)(((lane & 7) ^ ((krow_ >> 1) & 7)) << 4); \
        const unsigned lv = (unsigned)((8 * wid + ((lane & 31) >> 2)) * PITCH) * 2u + (unsigned)(((lane >> 5) * 32 + (lane & 3) * 8) * 2)

__device__ __forceinline__ void prime(const Ref& cur, LAS unsigned char* lds, Seam& S, rsrc_t R, const char* projb) {
    const int tid = threadIdx.x, wid = __builtin_amdgcn_readfirstlane(tid >> 6), lane = tid & 63, r32 = lane & 31, hi = lane >> 5;
    DA_LANE_OFFS();
    const unsigned lq = (unsigned)((wid * QBLK + r32) * PITCH + hi * 8) * 2u;
    LAS unsigned char* K_lds = lds + OFF_K; LAS unsigned char* V_lds = lds + OFF_V;
#pragma unroll
    for (int d0 = 0; d0 < 4; ++d0) S.qr[d0] = bld8(R, lq + d0 * 32, cur.qoff);
    S.ks = 0; S.vs = 0;
    DA_STAGE(cur.koff, cur.voff, 0, 0, 0); DA_STAGE(cur.koff, cur.voff, KVBLK, SHM_K, SHM_V);
    __syncthreads();
}
__device__ __forceinline__ void block(const Ref& cur, const Ref& nxt, LAS unsigned char* lds, Seam& S, float lam, const float* gsub, rsrc_t R, const char* projb) {
    const int tid = threadIdx.x, wid = __builtin_amdgcn_readfirstlane(tid >> 6), lane = tid & 63, r32 = lane & 31, hi = lane >> 5;
    const int NT = (cur.P0 + QB) / KVBLK;
    const int qlo = cur.P0 + wid * QBLK;
    LAS unsigned char* V_lds = lds + OFF_V; LAS unsigned char* K_lds = lds + OFF_K;
    LAS float* ws = (LAS float*)(lds + OFF_WS) + wid * 64; LAS float* li_l = ws; LAS float* al_l = ws + 32;
    const LAS float* tbh = (const LAS float*)(lds + OFF_TB) + cur.h * 128;
    float mhat = 0.f, l_reg = 0.f, rmx = 0.f; f32x16 o[4] = {}; f32x16 negm = f32x16{};
    bool resc = false;
    const int vb0 = (int)(unsigned)(uintptr_t)V_lds + v_rd_base(lane);
    DA_LANE_OFFS();
    const unsigned Kh = cur.koff, Vh = cur.voff;
#define KNEXT(x) (((x) == (NKS - 1) * SHM_K) ? 0 : (x) + SHM_K)
#define VNEXT(x) (((x) == (NVS - 1) * SHM_V) ? 0 : (x) + SHM_V)
    int k0 = S.ks, k1 = KNEXT(k0), k2 = KNEXT(k1);
    int v1 = S.vs, v2 = VNEXT(v1), v3 = VNEXT(v2), v0 = VNEXT(v3);
#define ROT() do { const int kn_ = k0; k0 = k1; k1 = k2; k2 = kn_; const int vn_ = v0; v0 = v1; v1 = v2; v2 = v3; v3 = vn_; } while (0)
#define STREAM(j) do { const bool in_ = (j) < NT; const unsigned ko_ = in_ ? Kh : nxt.koff, vo_ = in_ ? Vh : nxt.voff; const int tj_ = in_ ? (j) : (j) - NT; DA_STAGE(ko_, vo_, KBASE(tj_), k2, v3); } while (0)
#define STEP_BAR() asm volatile("s_waitcnt vmcnt(3) lgkmcnt(0)\n\ts_barrier" ::: "memory")
    const int ksw = (r32 >> 1) & 7;
    const LAS unsigned char* kbase = K_lds + r32 * 128;
#define KBASE(t) ((t) * KVBLK)
#define NEAR(P0_, P1_, t) do { const int kb_ = KBASE(t); if (kb_ >= qlo - 175) bias_mask(P0_, P1_, qlo - kb_, tbh); } while (0)
#define RESC() do { if (resc) { asm volatile("s_waitcnt lgkmcnt(0)" ::: "memory");              \
                     _Pragma("unroll") for (int d_ = 0; d_ < 4; ++d_) _Pragma("unroll") for (int r = 0; r < 16; ++r) o[d_][r] *= al_l[crow(r, hi)]; } } while (0)
#define PIN(x) asm volatile("" : "+v"(x))
#define EX(v) __builtin_amdgcn_exp2f(v)
#define MX3(a, b, c) __builtin_fmaxf(__builtin_fmaxf((a), (b)), (c))
#define DECIDE(C0, C1, FIRST) do { \
        float a_ = MX3(C0[0], C0[1], C1[0]), b_ = MX3(C0[2], C0[3], C1[1]); a_ = MX3(a_, C1[2], C1[3]); \
        _Pragma("unroll") for (int r = 4; r < 16; r += 4) { a_ = MX3(a_, C0[r], C0[r + 1]); b_ = MX3(b_, C0[r + 2], C0[r + 3]); a_ = MX3(a_, C1[r], C1[r + 1]); b_ = MX3(b_, C1[r + 2], C1[r + 3]); } \
        float rm_ = __builtin_fmaxf(a_, b_); { auto rr_ = __builtin_amdgcn_permlane32_swap(__float_as_uint(rm_), __float_as_uint(rm_), false, false); rm_ = __builtin_fmaxf(__uint_as_float(rr_[0]), __uint_as_float(rr_[1])); } \
        resc = false; \
        if ((FIRST) || __builtin_expect(__any(rm_ > THR), 0)) { const float dl_ = (FIRST) ? rm_ : __builtin_fmaxf(rm_, 0.f); mhat += dl_; \
            _Pragma("unroll") for (int r = 0; r < 16; ++r) { C0[r] -= dl_; C1[r] -= dl_; } \
            _Pragma("unroll") for (int r = 0; r < 16; ++r) negm[r] = -mhat; \
            asm volatile("" : "+v"(negm)); \
            if (!(FIRST)) { const float f_ = EX(-dl_); l_reg *= f_; if (hi == 0) al_l[r32] = f_; resc = true; } } } while (0)
#define DECIDE2(C0, C1) do { float rm_ = rmx; { auto rr_ = __builtin_amdgcn_permlane32_swap(__float_as_uint(rm_), __float_as_uint(rm_), false, false); rm_ = __builtin_fmaxf(__uint_as_float(rr_[0]), __uint_as_float(rr_[1])); } \
        resc = false; \
        if (__builtin_expect(__any(rm_ > THR), 0)) { const float dl_ = __builtin_fmaxf(rm_, 0.f); mhat += dl_; const float f_ = EX(-dl_); \
            _Pragma("unroll") for (int r = 0; r < 16; ++r) { C0[r] *= f_; C1[r] *= f_; } \
            _Pragma("unroll") for (int r = 0; r < 16; ++r) negm[r] = -mhat; \
            asm volatile("" : "+v"(negm)); \
            l_reg *= f_; if (hi == 0) al_l[r32] = f_; resc = true; } } while (0)
#define KF(d0, hf) (*(const LAS bf16x8*)(kbase + k0 + (((2 * (d0) + hi) ^ ksw) << 4) + (hf) * 4096))
#define GAPA(MF, P, B, W) do { MF; sacc += P[B]; sacc += P[B + 1]; sacc += P[B + 2]; sacc += P[B + 3]; PIN(sacc); W[((B) >> 1) & 3] = pk2(P[B], P[B + 1]); W[(((B) >> 1) & 3) + 1] = pk2(P[B + 2], P[B + 3]); PIN(W); SBAR(); } while (0)
#define PHASE_A(C0, C1, P0, P1) do { \
        const bf16x8 k00 = KF(0, 0), k01 = KF(0, 1), k10 = KF(1, 0), k11 = KF(1, 1), k20 = KF(2, 0), k21 = KF(2, 1), k30 = KF(3, 0), k31 = KF(3, 1); \
        float sacc = 0.f; SBAR(); \
        GAPA(C0 = __builtin_amdgcn_mfma_f32_32x32x16_bf16(k00, S.qr[0], negm, 0, 0, 0), P0, 0, pw0); \
        GAPA(C1 = __builtin_amdgcn_mfma_f32_32x32x16_bf16(k01, S.qr[0], negm, 0, 0, 0), P0, 4, pw0); \
        GAPA(C0 = __builtin_amdgcn_mfma_f32_32x32x16_bf16(k10, S.qr[1], C0, 0, 0, 0), P0, 8, pw1); \
        GAPA(C1 = __builtin_amdgcn_mfma_f32_32x32x16_bf16(k11, S.qr[1], C1, 0, 0, 0), P0, 12, pw1); \
        GAPA(C0 = __builtin_amdgcn_mfma_f32_32x32x16_bf16(k20, S.qr[2], C0, 0, 0, 0), P1, 0, pw2); \
        GAPA(C1 = __builtin_amdgcn_mfma_f32_32x32x16_bf16(k21, S.qr[2], C1, 0, 0, 0), P1, 4, pw2); \
        GAPA(C0 = __builtin_amdgcn_mfma_f32_32x32x16_bf16(k30, S.qr[3], C0, 0, 0, 0), P1, 8, pw3); \
        GAPA(C1 = __builtin_amdgcn_mfma_f32_32x32x16_bf16(k31, S.qr[3], C1, 0, 0, 0), P1, 12, pw3); \
        l_reg += sacc; } while (0)
#define TRRD(dst, off) asm volatile("ds_read_b64_tr_b16 %0, %1 offset:%2" : "=&v"(dst) : "v"(vbr), "i"(off) : "memory")
#define VRD8(L0, H0, L1, H1, L2, H2, L3, H3, VBv, d0) do { constexpr int b_ = v_rd_off(d0, 0, 0); \
        TRRD(L0, b_); TRRD(H0, b_ + 2048); TRRD(L1, b_ + 4096); TRRD(H1, b_ + 6144); TRRD(L2, b_ + 8192); TRRD(H2, b_ + 10240); TRRD(L3, b_ + 12288); TRRD(H3, b_ + 14336); } while (0)
#define VF(L, H) (bf16x8){L[0], L[1], L[2], L[3], H[0], H[1], H[2], H[3]}
#define PAF(k) __builtin_bit_cast(bf16x8, pw##k)
#define GAPB(MF, X, B) do { MF; rmx = MX3(rmx, X[B], X[(B) + 1]); X[B] = EX(X[B]); X[(B) + 1] = EX(X[(B) + 1]); PIN(X); PIN(rmx); SBAR(); } while (0)
#define PV4(d0, L0, H0, L1, H1, L2, H2, L3, H3, X, B) do { \
        GAPB(o[d0] = __builtin_amdgcn_mfma_f32_32x32x16_bf16(PAF(0), VF(L0, H0), o[d0], 0, 0, 0), X, (B)); \
        GAPB(o[d0] = __builtin_amdgcn_mfma_f32_32x32x16_bf16(PAF(1), VF(L1, H1), o[d0], 0, 0, 0), X, (B) + 2); \
        GAPB(o[d0] = __builtin_amdgcn_mfma_f32_32x32x16_bf16(PAF(2), VF(L2, H2), o[d0], 0, 0, 0), X, (B) + 4); \
        GAPB(o[d0] = __builtin_amdgcn_mfma_f32_32x32x16_bf16(PAF(3), VF(L3, H3), o[d0], 0, 0, 0), X, (B) + 6); } while (0)
#define LWAIT(n) do { asm volatile("s_waitcnt lgkmcnt(" #n ")" ::: "memory"); SBAR(); } while (0)
#define PHASE_B(C0, C1, VBv) do { s16x4 a0, a1, a2, a3, a4, a5, a6, a7, b0, b1, b2, b3, b4, b5, b6, b7; const int vbr = vb0 + (VBv); rmx = -__builtin_inff(); \
        asm volatile("s_waitcnt lgkmcnt(0)" ::: "memory"); SBAR(); \
        VRD8(a0, a1, a2, a3, a4, a5, a6, a7, VBv, 0); VRD8(b0, b1, b2, b3, b4, b5, b6, b7, VBv, 1); LWAIT(8); \
        PV4(0, a0, a1, a2, a3, a4, a5, a6, a7, C0, 0); \
        VRD8(a0, a1, a2, a3, a4, a5, a6, a7, VBv, 2); LWAIT(8); \
        PV4(1, b0, b1, b2, b3, b4, b5, b6, b7, C0, 8); \
        VRD8(b0, b1, b2, b3, b4, b5, b6, b7, VBv, 3); LWAIT(8); \
        PV4(2, a0, a1, a2, a3, a4, a5, a6, a7, C1, 0); \
        LWAIT(0); \
        PV4(3, b0, b1, b2, b3, b4, b5, b6, b7, C1, 8); } while (0)
    f32x16 pA0, pA1, pB0, pB1; u32x4 pw0, pw1, pw2, pw3;
#if PROBE_SEG
    unsigned long long pst_ = __builtin_readcyclecounter();
#define STAMP(k) do { const unsigned long long n_ = __builtin_readcyclecounter(); if ((k) == PROBE_SEG) S.acc += n_ - pst_; S.tot += n_ - pst_; pst_ = n_; } while (0)
#else
#define STAMP(k) do { } while (0)
#endif
    STREAM(2);
    SBAR();
    {
      const bf16x8 k00 = KF(0, 0), k01 = KF(0, 1), k10 = KF(1, 0), k11 = KF(1, 1), k20 = KF(2, 0), k21 = KF(2, 1), k30 = KF(3, 0), k31 = KF(3, 1);
      pA0 = __builtin_amdgcn_mfma_f32_32x32x16_bf16(k00, S.qr[0], negm, 0, 0, 0); pA1 = __builtin_amdgcn_mfma_f32_32x32x16_bf16(k01, S.qr[0], negm, 0, 0, 0);
      pA0 = __builtin_amdgcn_mfma_f32_32x32x16_bf16(k10, S.qr[1], pA0, 0, 0, 0); pA1 = __builtin_amdgcn_mfma_f32_32x32x16_bf16(k11, S.qr[1], pA1, 0, 0, 0);
      pA0 = __builtin_amdgcn_mfma_f32_32x32x16_bf16(k20, S.qr[2], pA0, 0, 0, 0); pA1 = __builtin_amdgcn_mfma_f32_32x32x16_bf16(k21, S.qr[2], pA1, 0, 0, 0);
      pA0 = __builtin_amdgcn_mfma_f32_32x32x16_bf16(k30, S.qr[3], pA0, 0, 0, 0); pA1 = __builtin_amdgcn_mfma_f32_32x32x16_bf16(k31, S.qr[3], pA1, 0, 0, 0); }
    NEAR(pA0, pA1, 0); DECIDE(pA0, pA1, true);
#pragma unroll
    for (int r = 0; r < 16; ++r) { pA0[r] = EX(pA0[r]); pA1[r] = EX(pA1[r]); }
    STEP_BAR();
    ROT();
#define STEP(C0, C1, P0, P1, t) do { SBAR(); STAMP(5); \
        STREAM((t) + 2); SBAR(); \
        PHASE_A(C0, C1, P0, P1); SBAR(); STAMP(1); \
        NEAR(C0, C1, (t)); SBAR(); STAMP(2); \
        PHASE_B(C0, C1, v0); DECIDE2(C0, C1); SBAR(); STAMP(3); \
        RESC(); STEP_BAR(); STAMP(4); ROT(); } while (0)
    int t = 1;
    for (; t + 2 < NT; t += 2) {
        STEP(pB0, pB1, pA0, pA1, t);
        STEP(pA0, pA1, pB0, pB1, t + 1);
    }
    SBAR(); STREAM(NT + 1); SBAR();
    PHASE_A(pB0, pB1, pA0, pA1);
    { const unsigned lq = (unsigned)((wid * QBLK + r32) * PITCH + hi * 8) * 2u;
#pragma unroll
      for (int d0 = 0; d0 < 4; ++d0) S.qr[d0] = bld8(R, lq + d0 * 32, nxt.qoff); }
    SBAR();
    NEAR(pB0, pB1, NT - 1); SBAR();
    PHASE_B(pB0, pB1, v0); DECIDE2(pB0, pB1);
    RESC();
    { float sacc = 0.f;
#pragma unroll
      for (int r = 0; r < 16; ++r) { sacc += pB0[r]; sacc += pB1[r]; }
      l_reg += sacc;
      pw0 = (u32x4){pk2(pB0[0], pB0[1]), pk2(pB0[2], pB0[3]), pk2(pB0[4], pB0[5]), pk2(pB0[6], pB0[7])}; pw1 = (u32x4){pk2(pB0[8], pB0[9]), pk2(pB0[10], pB0[11]), pk2(pB0[12], pB0[13]), pk2(pB0[14], pB0[15])};
      pw2 = (u32x4){pk2(pB1[0], pB1[1]), pk2(pB1[2], pB1[3]), pk2(pB1[4], pB1[5]), pk2(pB1[6], pB1[7])}; pw3 = (u32x4){pk2(pB1[8], pB1[9]), pk2(pB1[10], pB1[11]), pk2(pB1[12], pB1[13]), pk2(pB1[14], pB1[15])};
      SBAR(); pv_tile(o, vb0 + v1, PAF(0), PAF(1), PAF(2), PAF(3)); }
    ROT(); S.ks = k0; S.vs = v1;
    { auto rr = __builtin_amdgcn_permlane32_swap(__float_as_uint(l_reg), __float_as_uint(l_reg), false, false); l_reg = __uint_as_float(rr[0]) + __uint_as_float(rr[1]); }
    int lane_e = (int)__builtin_amdgcn_mbcnt_hi(~0u, __builtin_amdgcn_mbcnt_lo(~0u, 0u)); asm volatile("" : "+v"(lane_e));
    const int r32e = lane_e & 31, hie = lane_e >> 5;
    if (hi == 0) li_l[r32] = l_reg; asm volatile("s_waitcnt lgkmcnt(0)" ::: "memory");
    float rli[16];
#pragma unroll
    for (int r = 0; r < 16; ++r) rli[r] = __builtin_amdgcn_rcpf(li_l[crow(r, hi)]);
    LAS unsigned* st = (LAS unsigned*)(lds + OFF_STASH + wid * 8192) + lane_e;
    if (cur.comp == 0) {
#pragma unroll
        for (int r = 0; r < 16; ++r) { st[(2 * r) * 64] = pk2(o[0][r] * rli[r], o[1][r] * rli[r]); st[(2 * r + 1) * 64] = pk2(o[2][r] * rli[r], o[3][r] * rli[r]); }
    } else {
        float ss[16];
#pragma unroll
        for (int r = 0; r < 16; ++r) { const unsigned u0 = st[(2 * r) * 64], u1 = st[(2 * r + 1) * 64];
            const float s2 = lam * rli[r];
            o[0][r] = bflo(u0) - s2 * o[0][r]; o[1][r] = bfhi(u0) - s2 * o[1][r]; o[2][r] = bflo(u1) - s2 * o[2][r]; o[3][r] = bfhi(u1) - s2 * o[3][r];
            ss[r] = (o[0][r] * o[0][r] + o[1][r] * o[1][r]) + (o[2][r] * o[2][r] + o[3][r] * o[3][r]); }
#pragma unroll
        for (int r = 0; r < 16; ++r) {
#pragma unroll
            for (int x = 1; x < 32; x <<= 1) ss[r] += __shfl_xor(ss[r], x);
            ss[r] = rsqrtf(ss[r] * (1.f / 128.f) + EPS) * 0.8f; }
        float gg[4];
#pragma unroll
        for (int d0 = 0; d0 < 4; ++d0) gg[d0] = gsub[d0 * 32 + r32e];
        bf16_t* Ow = cur.O + (size_t)(wid * QBLK) * DM;
#pragma unroll
        for (int r = 0; r < 16; ++r) { const int orow = crow(r, hie);
#pragma unroll
            for (int d0 = 0; d0 < 4; ++d0) { const float v = o[d0][r] * ss[r] * gg[d0]; const float vn = __shfl_xor(v, 1);
                if ((r32e & 1) == 0) *(unsigned*)(Ow + (size_t)orow * DM + d0 * 32 + r32e) = pk2(v, vn); } }
    }
    __syncthreads();
#undef RESC
#undef KBASE
#undef NEAR
#undef PIN
#undef EX
#undef MX3
#undef DECIDE
#undef DECIDE2
#undef KF
#undef GAPA
#undef PHASE_A
#undef TRRD
#undef VRD8
#undef VF
#undef PAF
#undef GAPB
#undef PV4
#undef LWAIT
#undef PHASE_B
#undef STEP
#undef STAMP
#undef ROT
#undef KNEXT
#undef VNEXT
#undef STREAM
#undef STEP_BAR
}
#undef DA_DMA16
#undef DA_STAGE
#undef DA_LANE_OFFS
}

constexpr int NWAVES = 8;
constexpr int N_LAUNCHES = MK_N_LAUNCHES;
constexpr int N_PHASES = 9;
static_assert(N_LAUNCHES == 1 || N_LAUNCHES == N_PHASES, "MK_N_LAUNCHES is 1 or 9");

constexpr size_t MiB = 1u << 20;
constexpr size_t WS_CTL = 0, CTL_ZERO_BYTES = 1 * MiB;
constexpr size_t WS_ETK = 1 * MiB, WS_GTK = 2 * MiB, WS_RSTDT = 3 * MiB, WS_SLOTTK = 4 * MiB, WS_TOKSLOT = 5 * MiB, WS_GATESLOT = 7 * MiB, WS_RSTDSLOT = 9 * MiB, WS_RBE = 11 * MiB;
constexpr size_t WS_WRHI = 12 * MiB, WS_WRLO = 12 * MiB + 65536, WS_KMB = 13 * MiB, WS_VMT = 14 * MiB;
constexpr size_t WS_WIN = 16 * MiB, WS_WOUT = 21 * MiB, WS_X1B = 24 * MiB, WS_X1Q = 152 * MiB;
constexpr size_t WS_BIG = 216 * MiB;
constexpr size_t WS_H = WS_BIG, WS_PROJ = WS_BIG + 128 * MiB, WS_MIX = WS_BIG + 448 * MiB;
constexpr size_t WS_ACTQ = WS_BIG, WS_Y = WS_BIG + 264 * MiB;
constexpr size_t WS_END = WS_BIG + 792 * MiB;
static_assert(WS_END <= 1024 * MiB, "d_ws map");
constexpr size_t OUT_WGU = 0, OUT_WD = 64 * MiB;
constexpr int CW_BAR = 4096, CW_COUNT = 1024, CW_CURSOR = 2048;
constexpr int RING_BYTES = 159744, LDSCTL_OFF = RING_BYTES, MISC_OFF = LDSCTL_OFF + 320, LDS_BYTES = 163840;
static_assert(dattn::LDS_BYTES <= RING_BYTES, "attention scratch");

#define XB_TMO      128
#define XB_XCNT(j)  (256  + 64 * (j))
#define XB_XSUB(j)  (1280 + 64 * (j))
#define XB_XGEN(j)  (2304 + 64 * (j))
#define XB_TOP      3328
#define XB_TOPGEN   3392
#define XCD_BAR_WORDS 3456
#define XB_SPIN_CAP (1u << 18)
__device__ __forceinline__ unsigned xb_ld(unsigned* p)              { return __hip_atomic_load(p, __ATOMIC_RELAXED, __HIP_MEMORY_SCOPE_AGENT); }
__device__ __forceinline__ unsigned xb_add(unsigned* p, unsigned v) { return __hip_atomic_fetch_add(p, v, __ATOMIC_RELAXED, __HIP_MEMORY_SCOPE_AGENT); }
__device__ __forceinline__ unsigned xb_xcc_id() { return (unsigned)__builtin_amdgcn_s_getreg((3 << 11) | 20) & 0xFu; }
#define XB_SPIN(cond, bar) do { unsigned _sp = 0; while (cond) { __builtin_amdgcn_s_sleep(1); \
    if ((++_sp & 255u) == 0u) { if (xb_ld(&(bar)[XB_TMO])) break; if (_sp > XB_SPIN_CAP) { atomicAdd(&(bar)[XB_TMO], 1u); break; } } } } while (0)
struct XcdBarrier { unsigned* bar; unsigned x; volatile LAS unsigned* st; };
__device__ __forceinline__ XcdBarrier xcd_barrier_post(unsigned* bar, volatile LAS unsigned* st) {
    XcdBarrier b; b.bar = bar; b.x = xb_xcc_id(); b.st = st;
    if (threadIdx.x == 0) (void)xb_add(&bar[XB_XCNT(b.x)], 1u);
    return b;
}
__device__ __forceinline__ void xcd_barrier_complete(unsigned* bar, unsigned x, unsigned& nloc, unsigned& nx) {
    const unsigned G = gridDim.x * gridDim.y * gridDim.z;
    unsigned sum, cnt, mine, sp = 0u;
    for (;;) {
        sum = 0u; cnt = 0u; mine = 0u;
#pragma unroll
        for (unsigned j = 0; j < 16; ++j) { const unsigned c = xb_ld(&bar[XB_XCNT(j)]); sum += c; cnt += (c > 0u) ? 1u : 0u; mine = (j == x) ? c : mine; }
        if (sum == G) break;
        __builtin_amdgcn_s_sleep(1);
        if ((++sp & 255u) == 0u) { if (xb_ld(&bar[XB_TMO])) break; if (sp > XB_SPIN_CAP) { atomicAdd(&bar[XB_TMO], 1u); break; } }
    }
    nloc = mine > 0u ? mine : 1u; nx = cnt > 0u ? cnt : 1u;
}
__device__ __forceinline__ void xcd_barrier(const XcdBarrier& b) {
    asm volatile("s_waitcnt vmcnt(0)" ::: "memory");
    __syncthreads();
    if (threadIdx.x == 0) {
        unsigned* bar = b.bar;
        __builtin_amdgcn_s_waitcnt(0);
        unsigned nloc = b.st[0], nx = b.st[1];
        if (nloc == 0u) { xcd_barrier_complete(bar, b.x, nloc, nx); b.st[0] = nloc; b.st[1] = nx; }
        const unsigned old = xb_add(&bar[XB_XSUB(b.x)], 1u);
        const unsigned gen = old / nloc;
        if (old + 1u == (gen + 1u) * nloc) {
            __builtin_amdgcn_fence(__ATOMIC_RELEASE, "agent");
            asm volatile("s_waitcnt vmcnt(0)" ::: "memory");
            const unsigned og = xb_add(&bar[XB_TOP], 1u);
            const unsigned tg = og / nx;
            if (og + 1u == (tg + 1u) * nx) xb_add(&bar[XB_TOPGEN], 1u);
            else XB_SPIN(xb_ld(&bar[XB_TOPGEN]) == tg, bar);
            __builtin_amdgcn_fence(__ATOMIC_ACQUIRE, "agent");
            xb_add(&bar[XB_XGEN(b.x)], 1u);
            asm volatile("s_waitcnt vmcnt(0)" ::: "memory");
        } else {
            XB_SPIN(xb_ld(&bar[XB_XGEN(b.x)]) == gen, bar);
            __builtin_amdgcn_fence(__ATOMIC_ACQUIRE, "agent");
            asm volatile("s_waitcnt vmcnt(0)" ::: "memory");
        }
    }
    __syncthreads();
}

struct Frame {
    LAS unsigned char* lds;
    volatile LAS unsigned* MISC;
    unsigned* ctl;
    int tid, lane, wave, vcu, G;
    float* out;
    unsigned char* ws;
};
struct Args { const float* in[19]; float* out; unsigned char* ws; int ph_lo, ph_hi; };
typedef const __attribute__((address_space(4))) Args* KArgs;
__device__ __forceinline__ KArgs kargs() { KArgs p = (KArgs)__builtin_amdgcn_kernarg_segment_ptr(); asm volatile("" : "+s"(p)); return p; }
enum { I_X = 0, I_MEM, I_RELB, I_ATTNG, I_WIN, I_CONVW, I_LAMQK, I_SUBG, I_MEMG, I_WMEMKV, I_WOUT, I_FFNG, I_RW, I_RB, I_WGU, I_BGU, I_WDN, I_BDN, I_FING };

template <bool GAIN, bool F8>
__device__ __forceinline__ void p0_transpose_item(const float* W, int K, int N, void* WTv, int k0, int n0, int drow0, const float* kgain, float scale, LAS float* scr, int lane) {
    float v[32];
    const float* wp = W + (size_t)(k0 + (lane >> 5)) * N + n0 + (lane & 31);
#pragma unroll
    for (int i = 0; i < 32; ++i) v[i] = wp[(size_t)(2 * i) * N];
    const int c = lane & 7;
    f32x4 g0 = {scale, scale, scale, scale}, g1 = g0;
    if constexpr (GAIN) { g0 = *(const f32x4*)(kgain + k0 + 8 * c) * scale; g1 = *(const f32x4*)(kgain + k0 + 8 * c + 4) * scale; }
#pragma unroll
    for (int i = 0; i < 32; ++i) scr[(2 * i + (lane >> 5)) * 33 + (lane & 31)] = v[i];
    LDS_WAIT(); asm volatile("" ::: "memory");
#pragma unroll
    for (int j = 0; j < 4; ++j) { const int n = (lane >> 3) + 8 * j; const LAS float* s = scr + (8 * c) * 33 + n;
        const float e0 = s[0 * 33] * g0[0], e1 = s[1 * 33] * g0[1], e2 = s[2 * 33] * g0[2], e3 = s[3 * 33] * g0[3], e4 = s[4 * 33] * g1[0], e5 = s[5 * 33] * g1[1], e6 = s[6 * 33] * g1[2], e7 = s[7 * 33] * g1[3];
        if constexpr (F8) { u32x2 o; o.x = pg8::pk4_fp8(e0, e1, e2, e3); o.y = pg8::pk4_fp8(e4, e5, e6, e7);
            *(u32x2*)((unsigned char*)WTv + (size_t)(drow0 + n) * K + k0 + 8 * c) = o; }
        else { u32x4 o; o.x = pk2(e0, e1); o.y = pk2(e2, e3); o.z = pk2(e4, e5); o.w = pk2(e6, e7);
            *(u32x4*)((bf16_t*)WTv + (size_t)(drow0 + n) * K + k0 + 8 * c) = o; } }
    LDS_WAIT(); asm volatile("" ::: "memory");
}
__device__ __forceinline__ void rms_row2_to_bf16(const float* xa, const float* xb, const float* g, bf16_t* oa, bf16_t* ob, int lane) {
    const f32x4* ra = (const f32x4*)xa + lane; const f32x4* rb = (const f32x4*)xb + lane; const f32x4* gr = (const f32x4*)g + lane;
    f32x4 va[4], vb[4]; float sa = 0.f, sb = 0.f;
#pragma unroll
    for (int j = 0; j < 4; ++j) { va[j] = ra[64 * j]; vb[j] = rb[64 * j]; }
#pragma unroll
    for (int j = 0; j < 4; ++j) { sa += (va[j].x * va[j].x + va[j].y * va[j].y) + (va[j].z * va[j].z + va[j].w * va[j].w); sb += (vb[j].x * vb[j].x + vb[j].y * vb[j].y) + (vb[j].z * vb[j].z + vb[j].w * vb[j].w); }
    const float rsa = rsqrtf(wave_sum(sa) * (1.f / DM) + EPS), rsb = rsqrtf(wave_sum(sb) * (1.f / DM) + EPS);
    unsigned long long* pa = (unsigned long long*)oa + lane; unsigned long long* pb = (unsigned long long*)ob + lane;
#pragma unroll
    for (int j = 0; j < 4; ++j) { const f32x4 gg = gr[64 * j];
        pa[64 * j] = (unsigned long long)pk2(va[j].x * rsa * gg.x, va[j].y * rsa * gg.y) | ((unsigned long long)pk2(va[j].z * rsa * gg.z, va[j].w * rsa * gg.w) << 32);
        pb[64 * j] = (unsigned long long)pk2(vb[j].x * rsb * gg.x, vb[j].y * rsb * gg.y) | ((unsigned long long)pk2(vb[j].z * rsb * gg.z, vb[j].w * rsb * gg.w) << 32); }
}
__device__ __forceinline__ void p0_kvm_tile(Frame& F, int tile, const float* mem, const float* mem_g, const float* w_memkv) {
    const int mt = tile >> 3, ntile = tile & 7, row0 = 64 * mt, col0 = 64 * ntile;
    const int mb = F.wave >> 1, nb0 = (F.wave & 1) * 2, ar = F.lane & 15, kq = F.lane >> 4;
    const float* arow = mem + (size_t)(row0 + mb * 16 + ar) * DM;
    f32x4 acc[2]; acc[0] = (f32x4){0.f, 0.f, 0.f, 0.f}; acc[1] = acc[0];
    float ss = 0.f;
    const float* wq = w_memkv + col0 + nb0 * 16 + ar;
#define KVM_LOAD(A0, A1, G0, G1, BV, k0_) do { const int kk_ = (k0_) + 8 * kq; A0 = *(const f32x4*)(arow + kk_); A1 = *(const f32x4*)(arow + kk_ + 4); G0 = *(const f32x4*)(mem_g + kk_); G1 = *(const f32x4*)(mem_g + kk_ + 4); \
        _Pragma("unroll") for (int nbi = 0; nbi < 2; ++nbi) _Pragma("unroll") for (int j = 0; j < 8; ++j) BV[nbi][j] = wq[(size_t)(kk_ + j) * 512 + nbi * 16]; } while (0)
#define KVM_MATH(A0, A1, G0, G1, BV) do { ss += (A0.x * A0.x + A0.y * A0.y) + (A0.z * A0.z + A0.w * A0.w) + (A1.x * A1.x + A1.y * A1.y) + (A1.z * A1.z + A1.w * A1.w); \
        const bf16x8 af = pack8(A0 * G0, A1 * G1); \
        _Pragma("unroll") for (int nbi = 0; nbi < 2; ++nbi) { const f32x4 b0 = {BV[nbi][0], BV[nbi][1], BV[nbi][2], BV[nbi][3]}, b1 = {BV[nbi][4], BV[nbi][5], BV[nbi][6], BV[nbi][7]}; \
            acc[nbi] = __builtin_amdgcn_mfma_f32_16x16x32_bf16(af, pack8(b0, b1), acc[nbi], 0, 0, 0); } } while (0)
    f32x4 ba0[4], ba1[4], bg0[4], bg1[4]; float bb[4][2][8];
#pragma unroll 1
    for (int k0 = 0; k0 < DM; k0 += 128) {
#pragma unroll
        for (int q = 0; q < 4; ++q) KVM_LOAD(ba0[q], ba1[q], bg0[q], bg1[q], bb[q], k0 + 32 * q);
#pragma unroll
        for (int q = 0; q < 4; ++q) KVM_MATH(ba0[q], ba1[q], bg0[q], bg1[q], bb[q]);
    }
#undef KVM_LOAD
#undef KVM_MATH
    ss += __shfl_xor(ss, 16); ss += __shfl_xor(ss, 32);
    const float rstd = rsqrtf(ss * (1.f / DM) + EPS);
    float rs[4];
#pragma unroll
    for (int j = 0; j < 4; ++j) rs[j] = __shfl(rstd, kq * 4 + j);
    bf16_t* kmb = (bf16_t*)(F.ws + WS_KMB); bf16_t* vmt = (bf16_t*)(F.ws + WS_VMT);
#pragma unroll
    for (int nbi = 0; nbi < 2; ++nbi) {
        const int gc = col0 + (nb0 + nbi) * 16 + ar, gr0 = row0 + mb * 16 + kq * 4;
        if (ntile < 4) {
#pragma unroll
            for (int j = 0; j < 4; ++j) kmb[(size_t)(gr0 + j) * 256 + gc] = (bf16_t)(pk2(acc[nbi][j] * rs[j], 0.f) & 0xffffu);
        } else {
            const int d = gc - 256, hm = d >> 6, dd = d & 63, b = gr0 >> 8, m = gr0 & 255;
            u32x2 w; w.x = pk2(acc[nbi][0] * rs[0], acc[nbi][1] * rs[1]); w.y = pk2(acc[nbi][2] * rs[2], acc[nbi][3] * rs[3]);
            *(u32x2*)(vmt + ((size_t)((b * 4 + hm) * 64 + dd)) * 256 + m) = w;
        }
    }
}
struct P0Tile { const float* src; unsigned char* dst; int gain; };
template <int N, int K>
__device__ __forceinline__ void p0_tile_load(const float* src, f32x4 (&v)[8], int tid) {
#pragma unroll
    for (int i = 0; i < 8; ++i) v[i] = *(const f32x4*)(src + (size_t)((tid >> 5) + 16 * i) * N + (tid & 31) * 4);
}
__device__ __forceinline__ void p0_tile_to_lds(LAS float* tl, const f32x4 (&v)[8], int tid) {
#pragma unroll
    for (int i = 0; i < 8; ++i) { const int k = (tid >> 5) + 16 * i, c = ((tid & 31) * 4) ^ (((k >> 4) & 7) << 2); *(LAS f32x4*)(tl + k * 132 + c) = v[i]; }
}
template <int K, bool GAIN>
__device__ __forceinline__ void p0_tile_store(const LAS float* tl, unsigned char* dst, const float* kgain, float scale, int tid) {
    const int run = tid & 7;
    f32x4 g[4];
#pragma unroll
    for (int q = 0; q < 4; ++q) { g[q] = (f32x4){scale, scale, scale, scale}; if constexpr (GAIN) g[q] = *(const f32x4*)(kgain + run * 16 + 4 * q) * scale; }
#pragma unroll
    for (int p = 0; p < 2; ++p) { const int n = (tid >> 3) + 64 * p; const LAS float* s = tl + (run * 16) * 132 + (n ^ (run << 2));
        u32x4 o;
#pragma unroll
        for (int q = 0; q < 4; ++q) o[q] = pg8::pk4_fp8(s[(4 * q) * 132] * g[q][0], s[(4 * q + 1) * 132] * g[q][1], s[(4 * q + 2) * 132] * g[q][2], s[(4 * q + 3) * 132] * g[q][3]);
        *(u32x4*)(dst + (size_t)n * K + run * 16) = o; }
}
__device__ __forceinline__ void p0_prologue(Frame& F) {
    KArgs A = kargs();
    { const float* mem = A->in[I_MEM]; const float* mem_g = A->in[I_MEMG]; const float* w_memkv = A->in[I_WMEMKV];
      for (int rep2_ = 0; rep2_ < ((PROBE_P0 & 4) ? 2 : 1); ++rep2_)
      for (int tile = blockIdx.x; tile < 256; tile += F.G) p0_kvm_tile(F, tile, mem, mem_g, w_memkv); }
    const float* w_in = A->in[I_WIN]; const float* w_out = A->in[I_WOUT]; const float* w_gu = A->in[I_WGU]; const float* w_dn = A->in[I_WDN]; const float* ffn_g = A->in[I_FFNG];
    LAS float* scr = (LAS float*)(F.lds + F.wave * 16384);
    const int gw = F.vcu * NWAVES + F.wave, NGW = F.G * NWAVES;
    bf16_t* Win_t = (bf16_t*)(F.ws + WS_WIN); bf16_t* Wout_t = (bf16_t*)(F.ws + WS_WOUT);
    unsigned char* Wgu_q = (unsigned char*)F.out + OUT_WGU; unsigned char* Wd_q = (unsigned char*)F.out + OUT_WD;
    constexpr int I_IN = 16 * 80, I_OUT = 16 * 32, NITEMS = I_IN + I_OUT;
    for (int rep0_ = 0; rep0_ < ((PROBE_P0 & 1) ? 2 : 1); ++rep0_)
    for (int it = gw; it < NITEMS; it += NGW) {
        int r = it;
        if (r < I_IN) { const int kb = r / 80, nb = r % 80; p0_transpose_item<false, false>(w_in, DM, INW, Win_t, 64 * kb, 32 * nb, 32 * nb, nullptr, 1.f, scr, F.lane); continue; } r -= I_IN;
        if (r < I_OUT) { const int kb = r / 32, nb = r % 32; p0_transpose_item<false, false>(w_out, DM, DM, Wout_t, 64 * kb, 32 * nb, 32 * nb, nullptr, 1.f, scr, F.lane); continue; } r -= I_OUT;
    }
    { __syncthreads();
      LAS float* tl = (LAS float*)F.lds; const int tid = F.tid;
      constexpr int T_GU = NEXP * 8 * 16, T_DN = NEXP * 8 * 8, T_ALL = T_GU + T_DN;
#define P0_TILE(ti, SRC, DST, ISGU) do { int r_ = (ti); ISGU = r_ < T_GU; if (ISGU) { const int e = r_ >> 7, q = r_ & 127, kt = q >> 4, nt = q & 15, n0 = nt * 128, jj = n0 & 1023; \
            SRC = w_gu + (size_t)e * DM * 2048 + (size_t)(kt * 128) * 2048 + n0; DST = Wgu_q + (size_t)e * 2048 * DM + (size_t)((jj >> 7) * 256 + (n0 >= 1024 ? 128 : 0)) * DM + kt * 128; } \
          else { r_ -= T_GU; const int e = r_ >> 6, q = r_ & 63, kt = q >> 3, nt = q & 7; \
            SRC = w_dn + (size_t)e * DEXP * DM + (size_t)(kt * 128) * DM + nt * 128; DST = Wd_q + (size_t)e * DM * DEXP + (size_t)(nt * 128) * DEXP + kt * 128; } } while (0)
      f32x4 v[8]; const float* src; unsigned char* dst; bool isgu; const float* srcn; unsigned char* dstn; bool isgun;
      int ti = blockIdx.x;
      if (ti < T_ALL) { P0_TILE(ti, src, dst, isgu); if (isgu) p0_tile_load<2048, DM>(src, v, tid); else p0_tile_load<DM, DEXP>(src, v, tid); }
      for (; ti < T_ALL; ti += F.G) {
          p0_tile_to_lds(tl, v, tid);
          __syncthreads();
          const int tn = ti + F.G;
          if (tn < T_ALL) { P0_TILE(tn, srcn, dstn, isgun); if (isgun) p0_tile_load<2048, DM>(srcn, v, tid); else p0_tile_load<DM, DEXP>(srcn, v, tid); }
          if (isgu) { const int kt_ = (int)(((size_t)(dst - Wgu_q)) & (DM - 1)); p0_tile_store<DM, true>(tl, dst, ffn_g + kt_, 64.f, tid); }
          else p0_tile_store<DEXP, false>(tl, dst, nullptr, 64.f, tid);
          __syncthreads();
          src = srcn; dst = dstn; isgu = isgun;
      }
#undef P0_TILE
    }
    bf16_t* H = (bf16_t*)(F.ws + WS_H);
    { const float* x = A->in[I_X]; const float* attn_g = A->in[I_ATTNG];
      for (int rep1_ = 0; rep1_ < ((PROBE_P0 & 2) ? 2 : 1); ++rep1_)
      for (int m = gw; m < T; m += 2 * NGW) { const int m2 = (m + NGW < T) ? m + NGW : m;
          rms_row2_to_bf16(x + (size_t)m * DM, x + (size_t)m2 * DM, attn_g, H + (size_t)m * DM, H + (size_t)m2 * DM, F.lane); } }
    const float* router_w = A->in[I_RW];
    bf16_t* wrh = (bf16_t*)(F.ws + WS_WRHI); bf16_t* wrl = (bf16_t*)(F.ws + WS_WRLO);
    for (int i = (F.vcu * NWAVES + F.wave) * 64 + F.lane; i < NEXP * DM; i += NGW * 64) { const int e = i >> 10, k = i & 1023;
        const float v = ffn_g[k] * router_w[(size_t)k * NEXP + e]; const unsigned hb = pk2(v, 0.f) & 0xffffu; const float hf = __uint_as_float(hb << 16);
        wrh[i] = (bf16_t)hb; wrl[i] = (bf16_t)(pk2(v - hf, 0.f) & 0xffffu); }
}

__device__ __forceinline__ void p2_conv_block(Frame& F, int blk, int tid_, const float* conv_w) {
    const bf16_t* proj = (const bf16_t*)(F.ws + WS_PROJ); bf16_t* mix = (bf16_t*)(F.ws + WS_MIX);
    const int cg = tid_ & 31, tc = tid_ >> 5;
    const int c0 = cg * 8, t0 = blk * 256 + tc * 16, s0 = t0 & (SEQ - 1);
    float w0[8], w1[8], w2[8];
#pragma unroll
    for (int i = 0; i < 8; ++i) { w0[i] = conv_w[c0 + i]; w1[i] = conv_w[256 + c0 + i]; w2[i] = conv_w[512 + c0 + i]; }
    float p2[8], p1[8];
#pragma unroll
    for (int i = 0; i < 8; ++i) { p2[i] = 0.f; p1[i] = 0.f; }
    if (s0 >= 2) {
        const u32x4 ua = *(const u32x4*)(proj + (size_t)(t0 - 2) * INW + COL_U + c0), ca = *(const u32x4*)(proj + (size_t)(t0 - 2) * INW + COL_GC + c0);
        const u32x4 ub = *(const u32x4*)(proj + (size_t)(t0 - 1) * INW + COL_U + c0), cb = *(const u32x4*)(proj + (size_t)(t0 - 1) * INW + COL_GC + c0);
#pragma unroll
        for (int i = 0; i < 4; ++i) { p2[2 * i] = bflo(ua[i]) * bflo(ca[i]); p2[2 * i + 1] = bfhi(ua[i]) * bfhi(ca[i]); p1[2 * i] = bflo(ub[i]) * bflo(cb[i]); p1[2 * i + 1] = bfhi(ub[i]) * bfhi(cb[i]); }
    }
    for (int tb = 0; tb < 16; tb += 4) {
        u32x4 uu[4], cc[4], bb[4];
#pragma unroll
        for (int q = 0; q < 4; ++q) { const size_t ro = (size_t)(t0 + tb + q) * INW;
            uu[q] = *(const u32x4*)(proj + ro + COL_U + c0); cc[q] = *(const u32x4*)(proj + ro + COL_GC + c0); bb[q] = *(const u32x4*)(proj + ro + COL_GB + c0); }
#pragma unroll
        for (int q = 0; q < 4; ++q) {
            float cur[8], y[8];
#pragma unroll
            for (int i = 0; i < 4; ++i) { cur[2 * i] = bflo(uu[q][i]) * bflo(cc[q][i]); cur[2 * i + 1] = bfhi(uu[q][i]) * bfhi(cc[q][i]); }
#pragma unroll
            for (int i = 0; i < 4; ++i) { y[2 * i] = bflo(bb[q][i]) * (w0[2 * i] * p2[2 * i] + w1[2 * i] * p1[2 * i] + w2[2 * i] * cur[2 * i]);
                                           y[2 * i + 1] = bfhi(bb[q][i]) * (w0[2 * i + 1] * p2[2 * i + 1] + w1[2 * i + 1] * p1[2 * i + 1] + w2[2 * i + 1] * cur[2 * i + 1]); }
            u32x4 o; o.x = pk2(y[0], y[1]); o.y = pk2(y[2], y[3]); o.z = pk2(y[4], y[5]); o.w = pk2(y[6], y[7]);
            *(u32x4*)(mix + (size_t)(t0 + tb + q) * DM + c0) = o;
#pragma unroll
            for (int i = 0; i < 8; ++i) { p2[i] = p1[i]; p1[i] = cur[i]; }
        }
    }
}
__device__ __forceinline__ void p2_mem_block(Frame& F, int blk, int lane_) {
    const bf16_t* proj = (const bf16_t*)(F.ws + WS_PROJ); bf16_t* mix = (bf16_t*)(F.ws + WS_MIX);
    const bf16_t* kmb = (const bf16_t*)(F.ws + WS_KMB); const bf16_t* vmt = (const bf16_t*)(F.ws + WS_VMT);
    const int r32 = lane_ & 31, hi = lane_ >> 5, b = blk >> 5, tw = blk * 256 + F.wave * 32, tid_ = F.wave * 64 + lane_;
    LAS unsigned char* Kl = F.lds; LAS unsigned char* Vl = F.lds + 32768;
    const int ksw = (r32 >> 1) & 7;
    for (int hm = 0; hm < 4; ++hm) {
        bf16x8 qr[4];
#pragma unroll
        for (int d0 = 0; d0 < 4; ++d0) qr[d0] = *(const bf16x8*)(proj + (size_t)(tw + r32) * INW + COL_QM + hm * 64 + d0 * 16 + hi * 8);
        { u32x4 kv[4], vv[4];
#pragma unroll
          for (int i = 0; i < 4; ++i) { const int idx = tid_ + 512 * i;
              kv[i] = *(const u32x4*)(kmb + (size_t)(b * 256 + (idx >> 3)) * 256 + hm * 64 + (idx & 7) * 8);
              vv[i] = *(const u32x4*)(vmt + ((size_t)((b * 4 + hm) * 64 + (idx >> 5))) * 256 + (idx & 31) * 8); }
          __syncthreads();
#pragma unroll
          for (int i = 0; i < 4; ++i) { const int idx = tid_ + 512 * i; const int kr = idx >> 3, kc = idx & 7, vd = idx >> 5, vc = idx & 31;
              *(LAS u32x4*)(Kl + kr * 128 + ((kc ^ ((kr >> 1) & 7)) << 4)) = kv[i];
              *(LAS u32x4*)(Vl + vd * 512 + ((vc ^ (vd & 31)) << 4)) = vv[i]; }
          __syncthreads(); }
        float mx = -__builtin_inff();
#pragma unroll 2
        for (int kb = 0; kb < 8; ++kb) { f32x16 p = f32x16{};
#pragma unroll
            for (int d0 = 0; d0 < 4; ++d0) { const bf16x8 kf = *(const LAS bf16x8*)(Kl + (kb * 32 + r32) * 128 + (((2 * d0 + hi) ^ ksw) << 4));
                p = __builtin_amdgcn_mfma_f32_32x32x16_bf16(kf, qr[d0], p, 0, 0, 0); }
#pragma unroll
            for (int r = 0; r < 16; ++r) mx = fmaxf(mx, p[r]); }
        mx = fmaxf(mx, __shfl_xor(mx, 32));
        float sum = 0.f;
        f32x16 o[2]; o[0] = f32x16{}; o[1] = f32x16{};
#pragma unroll 2
        for (int kb = 0; kb < 8; ++kb) { f32x16 p = f32x16{};
#pragma unroll
            for (int d0 = 0; d0 < 4; ++d0) { const bf16x8 kf = *(const LAS bf16x8*)(Kl + (kb * 32 + r32) * 128 + (((2 * d0 + hi) ^ ksw) << 4));
                p = __builtin_amdgcn_mfma_f32_32x32x16_bf16(kf, qr[d0], p, 0, 0, 0); }
#pragma unroll
            for (int r = 0; r < 16; ++r) { p[r] = __builtin_amdgcn_exp2f(p[r] - mx); sum += p[r]; }
            bf16x8 pa0, pa1;
#define PK4(P, B_, OUT) do { unsigned a0 = pk2(P[B_+0], P[B_+1]), a1 = pk2(P[B_+2], P[B_+3]); unsigned b0 = pk2(P[B_+4], P[B_+5]), b1 = pk2(P[B_+6], P[B_+7]); \
        auto r0 = __builtin_amdgcn_permlane32_swap(a0, b0, false, false); auto r1 = __builtin_amdgcn_permlane32_swap(a1, b1, false, false); \
        u32x4 w = {r0[0], r1[0], r0[1], r1[1]}; OUT = __builtin_bit_cast(bf16x8, w); } while (0)
            PK4(p, 0, pa0); PK4(p, 8, pa1);
#undef PK4
#pragma unroll
            for (int d0 = 0; d0 < 2; ++d0) { const LAS unsigned char* vrow = Vl + (d0 * 32 + r32) * 512;
                const bf16x8 v0 = *(const LAS bf16x8*)(vrow + (((kb * 4 + hi) ^ r32) << 4)), v1 = *(const LAS bf16x8*)(vrow + (((kb * 4 + 2 + hi) ^ r32) << 4));
                o[d0] = __builtin_amdgcn_mfma_f32_32x32x16_bf16(pa0, v0, o[d0], 0, 0, 0);
                o[d0] = __builtin_amdgcn_mfma_f32_32x32x16_bf16(pa1, v1, o[d0], 0, 0, 0); }
        }
        sum += __shfl_xor(sum, 32);
        const float linv = __builtin_amdgcn_rcpf(sum);
#pragma unroll
        for (int r = 0; r < 16; ++r) { const int orow = crow(r, hi); const float li = __shfl(linv, orow);
#pragma unroll
            for (int d0 = 0; d0 < 2; ++d0) { const float v = o[d0][r] * li; const float vn = __shfl_xor(v, 1);
                if ((r32 & 1) == 0) *(unsigned*)(mix + (size_t)(tw + orow) * DM + 768 + hm * 64 + d0 * 32 + r32) = pk2(v, vn); } }
    }
    __syncthreads();
}
__device__ __forceinline__ dattn::Ref da_ref(Frame& F, int n) {
    const int pid = F.vcu + (n >> 2) * F.G, sub = n & 3, blk = sub >> 1, comp = sub & 1, bh = pid >> 4, s = pid & 15, qb = blk ? 31 - s : s, b = bh >> 2, h = bh & 3;
    bf16_t* mix = (bf16_t*)(F.ws + WS_MIX);
    dattn::Ref r;
    r.qoff = (unsigned)(((size_t)(b * SEQ + qb * 256) * INW + COL_Q + h * 128 + comp * 64) * 2);
    r.koff = (unsigned)(((size_t)(b * SEQ) * INW + COL_K + h * 128 + comp * 64) * 2);
    r.voff = (unsigned)(((size_t)(b * SEQ) * INW + COL_V + h * 128) * 2);
    r.O = mix + (size_t)(b * SEQ + qb * 256) * DM + 256 + h * 128;
    r.P0 = qb * 256; r.comp = comp; r.h = h;
    return r;
}
__device__ __forceinline__ void p2_mixers(Frame& F) {
    KArgs A = kargs();
    const float* rel_bias = A->in[I_RELB]; const float* lam_qk = A->in[I_LAMQK]; const float* subln_g = A->in[I_SUBG];
    if (F.tid < 512) { const int h = F.tid >> 7, n = F.tid & 127; int bk;
        if (n < 16) bk = n; else { bk = 16; const int thr[15] = {19, 21, 24, 27, 31, 35, 40, 46, 52, 59, 67, 77, 87, 99, 113};
#pragma unroll
            for (int i = 0; i < 15; ++i) bk += (n >= thr[i]) ? 1 : 0; }
        ((LAS float*)(F.lds + dattn::OFF_TB))[h * 128 + n] = (rel_bias[bk * 4 + h] - rel_bias[31 * 4 + h]) * LOG2E; }
    float d1 = 0.f, d2 = 0.f;
    for (int i = 0; i < 64; ++i) { d1 += lam_qk[i] * lam_qk[64 + i]; d2 += lam_qk[128 + i] * lam_qk[192 + i]; }
    const float lam = __expf(d1) - __expf(d2) + 0.2f;
    if (__builtin_amdgcn_readfirstlane(F.tid) >= 256) __builtin_amdgcn_s_setprio(1);
    __syncthreads();
    const int npairs = F.vcu < 512 ? (512 - F.vcu + F.G - 1) / F.G : 0, total1 = 4 * npairs, total = ((PROBE_REP >> 2) & 1) ? 2 * total1 : total1;
#if PROBE_CLK
    const unsigned long long pc0_ = __builtin_readcyclecounter(), pr0_ = __builtin_amdgcn_s_memrealtime();
#endif
    if (total > 0) {
        dattn::Seam S; dattn::Ref cur = da_ref(F, 0);
#if PROBE_SEG
        S.acc = 0; S.tot = 0;
#endif
        const dattn::rsrc_t R = __builtin_amdgcn_make_buffer_rsrc((void*)(F.ws + WS_PROJ), 0, (int)((size_t)T * INW * 2), 0x00020000);
        const char* projb = (const char*)(F.ws + WS_PROJ);
        dattn::prime(cur, F.lds, S, R, projb);
        for (int n = 0; n < total; ++n) {
            const dattn::Ref nxt = (n + 1 < total) ? da_ref(F, (n + 1) % total1) : cur;
            dattn::block(cur, nxt, F.lds, S, lam, subln_g, R, projb);
            cur = nxt;
        }
#if PROBE_SEG
        if (blockIdx.x == 0 && F.tid == 0) { F.ctl[604] = (unsigned)(S.acc >> 4); F.ctl[605] = (unsigned)(S.tot >> 4); }
#endif
    }
#if PROBE_CLK
    if (blockIdx.x == 0 && F.tid == 0) { const unsigned long long dc_ = __builtin_readcyclecounter() - pc0_, dr_ = __builtin_amdgcn_s_memrealtime() - pr0_;
        F.ctl[600] = (unsigned)dc_; F.ctl[601] = (unsigned)(dc_ >> 32); F.ctl[602] = (unsigned)dr_; }
#endif
    __builtin_amdgcn_s_setprio(0);
    int lane2 = (int)__builtin_amdgcn_mbcnt_hi(~0u, __builtin_amdgcn_mbcnt_lo(~0u, 0u)); asm volatile("" : "+v"(lane2));
    const int tid2 = F.wave * 64 + lane2;
    const float* conv_w = kargs()->in[I_CONVW];
    for (int repx_ = 0; repx_ < ((PROBE_X & 1) ? 2 : 1); ++repx_)
    for (int blk = blockIdx.x; blk < T / 256; blk += F.G) { p2_conv_block(F, blk, tid2, conv_w); p2_mem_block(F, blk, lane2); }
}

__device__ __forceinline__ void p4_router(Frame& F, bool dry = false) {
    const float* router_b = kargs()->in[I_RB];
    const bf16_t* x1b = (const bf16_t*)(F.ws + WS_X1B); const bf16_t* wrh = (const bf16_t*)(F.ws + WS_WRHI); const bf16_t* wrl = (const bf16_t*)(F.ws + WS_WRLO);
    int* e_tk = (int*)(F.ws + WS_ETK); float* g_tk = (float*)(F.ws + WS_GTK); float* rstd_t = (float*)(F.ws + WS_RSTDT);
    LAS float* lg = (LAS float*)F.lds + F.wave * (32 * 33); LAS unsigned* hist = (LAS unsigned*)(F.lds + 8 * 32 * 33 * 4);
    const int r32 = F.lane & 31, hi = F.lane >> 5;
    for (int blk = blockIdx.x; blk < T / 256; blk += F.G) {
        if (F.tid < 32) hist[F.tid] = 0u;
        __syncthreads();
        const int t0 = blk * 256 + F.wave * 32;
        const bf16_t* xr = x1b + (size_t)(t0 + r32) * DM + hi * 8; const bf16_t* wh = wrh + (size_t)r32 * DM + hi * 8; const bf16_t* wl = wrl + (size_t)r32 * DM + hi * 8;
        f32x16 acc = f32x16{}; float ss = 0.f;
#pragma unroll 1
        for (int kq = 0; kq < DM; kq += 256) {
            u32x4 xw[16];
#pragma unroll
            for (int s_ = 0; s_ < 16; ++s_) xw[s_] = *(const u32x4*)(xr + kq + s_ * 16);
            SBAR();
#pragma unroll
            for (int sb = 0; sb < 16; sb += 4) { bf16x8 ah[4], al[4];
#pragma unroll
                for (int s_ = 0; s_ < 4; ++s_) { ah[s_] = *(const bf16x8*)(wh + kq + (sb + s_) * 16); al[s_] = *(const bf16x8*)(wl + kq + (sb + s_) * 16); }
#pragma unroll
                for (int s_ = 0; s_ < 4; ++s_) { const u32x4 xv = xw[sb + s_];
#pragma unroll
                    for (int i = 0; i < 4; ++i) { const float a = bflo(xv[i]), b2 = bfhi(xv[i]); ss += a * a + b2 * b2; }
                    const bf16x8 xb = __builtin_bit_cast(bf16x8, xv);
                    acc = __builtin_amdgcn_mfma_f32_32x32x16_bf16(ah[s_], xb, acc, 0, 0, 0);
                    acc = __builtin_amdgcn_mfma_f32_32x32x16_bf16(al[s_], xb, acc, 0, 0, 0); } }
        }
        ss += __shfl_xor(ss, 32);
        const float rstd = rsqrtf(ss * (1.f / DM) + EPS);
#pragma unroll
        for (int r = 0; r < 16; ++r) { const int e = crow(r, hi); lg[r32 * 33 + e] = acc[r] * rstd + router_b[e]; }
        LDS_WAIT(); asm volatile("" ::: "memory");
        if (F.lane < 32) {
            LAS float* row = lg + F.lane * 33; float tv[4]; int ti[4];
#pragma unroll
            for (int p = 0; p < 4; ++p) { float best = -__builtin_inff(); int bi = 0;
                for (int e = 0; e < NEXP; ++e) { const float v = row[e]; if (v > best) { best = v; bi = e; } }
                tv[p] = best; ti[p] = bi; row[bi] = -__builtin_inff(); LDS_WAIT(); asm volatile("" ::: "memory"); }
            const float w1 = __expf(tv[1] - tv[0]), w2 = __expf(tv[2] - tv[0]), w3 = __expf(tv[3] - tv[0]); const float inv = 1.f / (1.f + w1 + w2 + w3);
            const int t = t0 + F.lane;
            if (!dry) {
            *(int4*)(e_tk + (size_t)t * 4) = make_int4(ti[0], ti[1], ti[2], ti[3]);
            *(float4*)(g_tk + (size_t)t * 4) = make_float4(inv, w1 * inv, w2 * inv, w3 * inv);
            rstd_t[t] = rstd;
#pragma unroll
            for (int p = 0; p < 4; ++p) __hip_atomic_fetch_add(&hist[ti[p]], 1u, __ATOMIC_RELAXED, __HIP_MEMORY_SCOPE_WORKGROUP);
            }
        }
        __syncthreads();
        if (F.tid < 32) __hip_atomic_fetch_add(F.ctl + CW_COUNT + F.tid, hist[F.tid], RLX_AGENT);
        __syncthreads();
    }
}
__device__ __forceinline__ void p5_place(Frame& F) {
    const int* e_tk = (const int*)(F.ws + WS_ETK); const float* g_tk = (const float*)(F.ws + WS_GTK); const float* rstd_t = (const float*)(F.ws + WS_RSTDT);
    int* slot_tk = (int*)(F.ws + WS_SLOTTK); int* tok_slot = (int*)(F.ws + WS_TOKSLOT); float* gate_slot = (float*)(F.ws + WS_GATESLOT); float* rstd_slot = (float*)(F.ws + WS_RSTDSLOT);
    int* rb_e = (int*)(F.ws + WS_RBE);
    LAS int* L = (LAS int*)F.lds;
    if (F.tid < 32) { const int c = (int)__hip_atomic_load(F.ctl + CW_COUNT + F.tid, RLX_AGENT); L[F.tid] = c; L[32 + F.tid] = (c + 255) & ~255; }
    __syncthreads();
    if (F.tid < 32) { int s = 0; for (int e = 0; e < F.tid; ++e) s += L[32 + e]; L[64 + F.tid] = s; }
    __syncthreads();
    for (int blk = blockIdx.x; blk < T / 256; blk += F.G) {
        if (F.tid < 32) { L[96 + F.tid] = 0; L[128 + F.tid] = 0; }
        __syncthreads();
        int ee[2];
#pragma unroll
        for (int j = 0; j < 2; ++j) { const int i = F.tid + 512 * j; ee[j] = e_tk[(size_t)blk * 1024 + i]; __hip_atomic_fetch_add(&L[96 + ee[j]], 1, __ATOMIC_RELAXED, __HIP_MEMORY_SCOPE_WORKGROUP); }
        __syncthreads();
        if (F.tid < 32) L[160 + F.tid] = L[64 + F.tid] + (int)__hip_atomic_fetch_add(F.ctl + CW_CURSOR + F.tid, (unsigned)L[96 + F.tid], RLX_AGENT);
        __syncthreads();
#pragma unroll
        for (int j = 0; j < 2; ++j) { const int i = F.tid + 512 * j; const int r = __hip_atomic_fetch_add(&L[128 + ee[j]], 1, __ATOMIC_RELAXED, __HIP_MEMORY_SCOPE_WORKGROUP); const int pos = L[160 + ee[j]] + r;
            const int t = blk * 256 + (i >> 2);
            tok_slot[pos] = t; gate_slot[pos] = g_tk[(size_t)blk * 1024 + i]; rstd_slot[pos] = rstd_t[t]; slot_tk[(size_t)blk * 1024 + i] = pos; }
        __syncthreads();
    }
    for (int e = blockIdx.x; e < NEXP; e += F.G)
        for (int i = L[e] + F.tid; i < L[32 + e]; i += NWAVES * 64) { const int pos = L[64 + e] + i; tok_slot[pos] = 0; gate_slot[pos] = 0.f; rstd_slot[pos] = 0.f; }
    if (blockIdx.x == 0) {
        const int nrb = (L[64 + 31] + L[32 + 31]) >> 8;
        for (int rb = F.tid; rb < NRB_MAX; rb += NWAVES * 64) { int e = 31; for (int q = 0; q < 32; ++q) { if (rb * 256 >= L[64 + q] && rb * 256 < L[64 + q] + L[32 + q]) e = q; } rb_e[rb] = e; }
        if (F.tid == 0) rb_e[NRB_MAX] = nrb;
    }
}
__device__ __forceinline__ void p9_final(Frame& F) {
    const bf16_t* x1b = (const bf16_t*)(F.ws + WS_X1B); const int* slot_tk = (const int*)(F.ws + WS_SLOTTK);
    const unsigned char* Y = F.ws + WS_Y;
    const int gw = F.vcu * NWAVES + F.wave, NGW = F.G * NWAVES;
    const float* final_g = kargs()->in[I_FING];
    f32x4 gg[2][2];
#pragma unroll
    for (int j = 0; j < 2; ++j) { gg[j][0] = *(const f32x4*)(final_g + 8 * F.lane + 512 * j); gg[j][1] = *(const f32x4*)(final_g + 8 * F.lane + 512 * j + 4); }
    int4 slA = make_int4(0, 0, 0, 0), slB = slA;
    if (gw < T) { slA = *(const int4*)(slot_tk + (size_t)gw * 4); const int tb0 = (gw + NGW < T) ? gw + NGW : gw; slB = *(const int4*)(slot_tk + (size_t)tb0 * 4); }
    for (int t = gw; t < T; t += 2 * NGW) {
        const int tA = t, tB = (t + NGW < T) ? t + NGW : t;
        const int tnA = (t + 2 * NGW < T) ? t + 2 * NGW : tA, tnB = (t + 3 * NGW < T) ? t + 3 * NGW : tnA;
        const int4 nA = *(const int4*)(slot_tk + (size_t)tnA * 4), nB = *(const int4*)(slot_tk + (size_t)tnB * 4);
        const int sA[4] = {slA.x, slA.y, slA.z, slA.w}, sB[4] = {slB.x, slB.y, slB.z, slB.w};
        u32x4 xa[2], xb[2]; u32x2 ya[2][4], yb[2][4];
#pragma unroll
        for (int j = 0; j < 2; ++j) { const int c = 8 * F.lane + 512 * j;
            xa[j] = *(const u32x4*)(x1b + (size_t)tA * DM + c); xb[j] = *(const u32x4*)(x1b + (size_t)tB * DM + c);
#pragma unroll
            for (int k = 0; k < 4; ++k) { ya[j][k] = *(const u32x2*)(Y + (size_t)sA[k] * DM + c); yb[j][k] = *(const u32x2*)(Y + (size_t)sB[k] * DM + c); } }
        float va[2][8], vb[2][8]; float ssa = 0.f, ssb = 0.f;
#pragma unroll
        for (int j = 0; j < 2; ++j) {
#pragma unroll
            for (int i = 0; i < 4; ++i) { va[j][2 * i] = bflo(xa[j][i]); va[j][2 * i + 1] = bfhi(xa[j][i]); vb[j][2 * i] = bflo(xb[j][i]); vb[j][2 * i + 1] = bfhi(xb[j][i]); }
#pragma unroll
            for (int k = 0; k < 4; ++k)
#pragma unroll
                for (int w_ = 0; w_ < 2; ++w_) { const f32x2_t a0 = __builtin_amdgcn_cvt_pk_f32_fp8((int)ya[j][k][w_], false), a1 = __builtin_amdgcn_cvt_pk_f32_fp8((int)ya[j][k][w_], true);
                    const f32x2_t b0 = __builtin_amdgcn_cvt_pk_f32_fp8((int)yb[j][k][w_], false), b1 = __builtin_amdgcn_cvt_pk_f32_fp8((int)yb[j][k][w_], true);
                    va[j][4 * w_] += 0.125f * a0[0]; va[j][4 * w_ + 1] += 0.125f * a0[1]; va[j][4 * w_ + 2] += 0.125f * a1[0]; va[j][4 * w_ + 3] += 0.125f * a1[1];
                    vb[j][4 * w_] += 0.125f * b0[0]; vb[j][4 * w_ + 1] += 0.125f * b0[1]; vb[j][4 * w_ + 2] += 0.125f * b1[0]; vb[j][4 * w_ + 3] += 0.125f * b1[1]; }
#pragma unroll
            for (int i = 0; i < 8; ++i) { ssa += va[j][i] * va[j][i]; ssb += vb[j][i] * vb[j][i]; } }
        const float ra = rsqrtf(wave_sum(ssa) * (1.f / DM) + EPS), rb = rsqrtf(wave_sum(ssb) * (1.f / DM) + EPS);
#pragma unroll
        for (int j = 0; j < 2; ++j) { const int c = 8 * F.lane + 512 * j;
            f32x4 o0, o1;
            o0.x = va[j][0] * ra * gg[j][0].x; o0.y = va[j][1] * ra * gg[j][0].y; o0.z = va[j][2] * ra * gg[j][0].z; o0.w = va[j][3] * ra * gg[j][0].w;
            o1.x = va[j][4] * ra * gg[j][1].x; o1.y = va[j][5] * ra * gg[j][1].y; o1.z = va[j][6] * ra * gg[j][1].z; o1.w = va[j][7] * ra * gg[j][1].w;
            *(f32x4*)(F.out + (size_t)tA * DM + c) = o0; *(f32x4*)(F.out + (size_t)tA * DM + c + 4) = o1;
            o0.x = vb[j][0] * rb * gg[j][0].x; o0.y = vb[j][1] * rb * gg[j][0].y; o0.z = vb[j][2] * rb * gg[j][0].z; o0.w = vb[j][3] * rb * gg[j][0].w;
            o1.x = vb[j][4] * rb * gg[j][1].x; o1.y = vb[j][5] * rb * gg[j][1].y; o1.z = vb[j][6] * rb * gg[j][1].z; o1.w = vb[j][7] * rb * gg[j][1].w;
            *(f32x4*)(F.out + (size_t)tB * DM + c) = o0; *(f32x4*)(F.out + (size_t)tB * DM + c + 4) = o1; }
        slA = nA; slB = nB;
    }
}

__global__ void __launch_bounds__(NWAVES * 64, 2) hymba_fwd(Args args) {
    extern __shared__ __attribute__((aligned(16))) unsigned char lds[];
    Frame F;
    F.lds = (LAS unsigned char*)lds;
    F.MISC = (volatile LAS unsigned*)(F.lds + MISC_OFF);
    F.tid = threadIdx.x; F.lane = F.tid & 63; F.wave = __builtin_amdgcn_readfirstlane(F.tid >> 6);
    F.G = gridDim.x; { const int bx = blockIdx.x; F.vcu = (F.G % 8 == 0) ? (bx % 8) * (F.G / 8) + bx / 8 : bx; }
    F.ws = args.ws; F.ctl = (unsigned*)(args.ws + WS_CTL); F.out = args.out;
    for (int u = F.tid; u < (LDS_BYTES - LDSCTL_OFF) / 4; u += NWAVES * 64) ((LAS unsigned*)(F.lds + LDSCTL_OFF))[u] = 0u;
    __syncthreads();
    XcdBarrier bar; bar.bar = F.ctl + CW_BAR; bar.x = 0; bar.st = nullptr;
    if (N_LAUNCHES == 1) bar = xcd_barrier_post(F.ctl + CW_BAR, F.MISC + 8);
#define GRID_BAR() do { if (N_LAUNCHES == 1) xcd_barrier(bar); } while (0)
    const int lo = args.ph_lo, hi = args.ph_hi;
#ifndef PH_MASK
#define PH_MASK 0x1ff
#endif
#define IN(k) (((PH_MASK >> (k)) & 1) && lo <= (k) && (k) < hi)
#define BOTH(k) (IN(k) && IN((k) + 1))
    bf16_t* const H = (bf16_t*)(F.ws + WS_H); bf16_t* const PROJ = (bf16_t*)(F.ws + WS_PROJ); bf16_t* const MIX = (bf16_t*)(F.ws + WS_MIX); bf16_t* const X1B = (bf16_t*)(F.ws + WS_X1B);
    bf16_t* const Win_t = (bf16_t*)(F.ws + WS_WIN); bf16_t* const Wout_t = (bf16_t*)(F.ws + WS_WOUT);
    const unsigned char* const Wgu_q = (const unsigned char*)F.out + OUT_WGU; const unsigned char* const Wd_q = (const unsigned char*)F.out + OUT_WD;
    unsigned char* const X1Q = F.ws + WS_X1Q; unsigned char* const ACTQ = F.ws + WS_ACTQ; unsigned char* const Yp = F.ws + WS_Y;
    const int* const tok_slot = (const int*)(F.ws + WS_TOKSLOT); const float* const gate_slot = (const float*)(F.ws + WS_GATESLOT); const float* const rstd_slot = (const float*)(F.ws + WS_RSTDSLOT);
    const int* const rb_e = (const int*)(F.ws + WS_RBE);

#define REP(k) for (int rep_ = 0; rep_ < (((PROBE_REP >> (k)) & 1) ? 2 : 1); ++rep_)
    if (IN(0)) { REP(0) p0_prologue(F); if (BOTH(0)) GRID_BAR(); }
    if (IN(1)) {
        REP(1) {
        pg8::Gemm g{H, Win_t, DM, 0, nullptr}; pg8::StaticOrder S; S.init(T, INW, F.G, (int)blockIdx.x);
        pg8::EpiProj E{PROJ};
        pg8::gemm_phase<pg8::EpiProj, pg8::StaticOrder, true>(F.lds, g, S, E); }
        if (BOTH(1)) GRID_BAR();
    }
    if (IN(2)) { p2_mixers(F); if (BOTH(2)) GRID_BAR(); }
    if (IN(3)) {
        pg8::Gemm g{MIX, Wout_t, DM, 0, nullptr}; pg8::StaticOrder S; S.init(T, DM, F.G, (int)blockIdx.x);
        pg8::EpiX1 E{kargs()->in[I_X], X1B, X1Q};
        pg8::gemm_phase<pg8::EpiX1, pg8::StaticOrder, true>(F.lds, g, S, E);
        if (BOTH(3)) GRID_BAR();
    }
    if (IN(4)) { if (PROBE_X & 2) p4_router(F, true); p4_router(F); if (BOTH(4)) GRID_BAR(); }
    if (IN(5)) { p5_place(F); if (BOTH(5)) GRID_BAR(); }
    if (IN(6)) {
        const int nrb = rb_e[NRB_MAX];
        REP(6) {
        pg8::Gemm g{(const bf16_t*)X1Q, (const bf16_t*)Wgu_q, DM / 2, (long)2048 * DM / 2, tok_slot}; pg8::GroupOrder S{nrb, 0, 8, F.G, (int)blockIdx.x, rb_e};
        pg8::EpiGU E{ACTQ, kargs()->in[I_BGU], rstd_slot};
        pg8::gemm_phase<pg8::EpiGU, pg8::GroupOrder, true, true, (PROBE_KREP == 2 ? 0x78787878 : 0x79797979), 0x7f7f7f7f, PROBE_KREP>(F.lds, g, S, E); }
        if (BOTH(6)) GRID_BAR();
    }
    if (IN(7)) {
        const int nrb = rb_e[NRB_MAX];
        REP(7) {
        pg8::Gemm g{(const bf16_t*)ACTQ, (const bf16_t*)Wd_q, DEXP / 2, (long)DM * DEXP / 2, nullptr}; pg8::GroupOrder S{nrb, 0, 4, F.G, (int)blockIdx.x, rb_e};
        pg8::EpiDown E{Yp, kargs()->in[I_BDN], gate_slot};
        pg8::gemm_phase<pg8::EpiDown, pg8::GroupOrder, true, true, 0x79797979, 0x7d7d7d7d>(F.lds, g, S, E); }
        if (BOTH(7)) GRID_BAR();
    }
    if (IN(8)) { REP(8) p9_final(F); }
#if PROBE_SEG
    if (IN(8) && blockIdx.x == 0 && F.tid == 0) { const unsigned long long a_ = F.ctl[604], t_ = F.ctl[605]; const unsigned long long us_ = t_ ? a_ * 2000ull / t_ : 0ull; const unsigned long long t0_ = __builtin_amdgcn_s_memrealtime();
        while (__builtin_amdgcn_s_memrealtime() - t0_ < us_ * 100ull) __builtin_amdgcn_s_sleep(8); }
#endif
#if PROBE_CLK
    if (IN(8) && blockIdx.x == 0 && F.tid == 0) { const unsigned long long dc_ = ((unsigned long long)F.ctl[601] << 32) | F.ctl[600]; const unsigned long long dr_ = F.ctl[602];
        const unsigned long long mhz_ = dr_ ? dc_ * 100ull / dr_ : 0ull; const unsigned long long t0_ = __builtin_amdgcn_s_memrealtime();
        while (__builtin_amdgcn_s_memrealtime() - t0_ < mhz_ * 100ull) __builtin_amdgcn_s_sleep(8); }
#endif
#undef IN
#undef BOTH
#undef GRID_BAR
}

extern "C" void kernel_launch(void* const* d_in, const int* in_sizes, int n_in, void* d_out, int out_size, void* d_ws, size_t ws_size, hipStream_t stream) {
    static int grid = 0;
    if (grid == 0) {
        if (n_in != 19 || out_size != T * DM || ws_size < WS_END) { fprintf(stderr, "kernel_launch: unexpected shapes (n_in %d out %d ws %zu)\n", n_in, out_size, ws_size); grid = -1; return; }
        int dev = 0, cus = 0;
        if (hipGetDevice(&dev) != hipSuccess || hipDeviceGetAttribute(&cus, hipDeviceAttributeMultiprocessorCount, dev) != hipSuccess) { grid = -1; return; }
        if (hipFuncSetAttribute((const void*)hymba_fwd, hipFuncAttributeMaxDynamicSharedMemorySize, LDS_BYTES) != hipSuccess) { fprintf(stderr, "kernel_launch: hipFuncSetAttribute failed\n"); grid = -1; return; }
        int per_cu = 0;
        if (hipOccupancyMaxActiveBlocksPerMultiprocessor(&per_cu, (const void*)hymba_fwd, NWAVES * 64, LDS_BYTES) != hipSuccess || per_cu < 1) fprintf(stderr, "kernel_launch: occupancy query reports %d\n", per_cu);
        (void)hipGetLastError();
        grid = cus;
    }
    if (grid < 0) return;
    if (hipMemsetAsync((char*)d_ws + WS_CTL, 0, CTL_ZERO_BYTES, stream) != hipSuccess) return;
    Args a{};
    for (int i = 0; i < 19; ++i) a.in[i] = (const float*)d_in[i];
    a.out = (float*)d_out; a.ws = (unsigned char*)d_ws;
    for (int li = 0; li < N_LAUNCHES; ++li) {
        a.ph_lo = (N_LAUNCHES == 1) ? 0 : li; a.ph_hi = (N_LAUNCHES == 1) ? N_PHASES : li + 1;
        hipLaunchKernelGGL(hymba_fwd, dim3(grid), dim3(NWAVES * 64), LDS_BYTES, stream, a);
    }
}
```

```cpp
#include <hip/hip_runtime.h>
#include <hip/hip_bf16.h>
#include <cstdio>
#include <cstdint>

#ifndef PROBE_REP
#define PROBE_REP 0
#endif
#ifndef PROBE_X
#define PROBE_X 0
#endif
#ifndef PROBE_P0
#define PROBE_P0 0
#endif
#ifndef PROBE_SEG
#define PROBE_SEG 0
#endif
#ifndef PROBE_CLK
#define PROBE_CLK 0
#endif
#ifndef PROBE_KREP
#define PROBE_KREP 1
#endif
#ifndef PROBE_EPI
#define PROBE_EPI 0
#endif
#ifndef MK_N_LAUNCHES
#define MK_N_LAUNCHES 1
#endif

constexpr int BATCH = 8, SEQ = 8192, DM = 1024, T = BATCH * SEQ, INW = 2560, MEML = 256, NEXP = 32, TOPK = 4, DEXP = 1024;
constexpr int COL_U = 0, COL_GB = 256, COL_GC = 512, COL_Q = 768, COL_K = 1280, COL_V = 1792, COL_QM = 2304;
constexpr float EPS = 1e-5f;
constexpr float C2 = 0.125f * 1.4426950408889634f;
constexpr float LOG2E = 1.4426950408889634f;
constexpr int NRB_MAX = 1056;

#define GAS __attribute__((address_space(1)))
#define LAS __attribute__((address_space(3)))
typedef unsigned short bf16_t;
typedef short bf16x8 __attribute__((ext_vector_type(8)));
typedef short s16x4 __attribute__((ext_vector_type(4)));
typedef float f32x4 __attribute__((ext_vector_type(4)));
typedef float f32x16 __attribute__((ext_vector_type(16)));
typedef unsigned u32x4 __attribute__((ext_vector_type(4)));
typedef unsigned u32x2 __attribute__((ext_vector_type(2)));
typedef float f32x2_t __attribute__((ext_vector_type(2)));
typedef __bf16 bf16x2_t __attribute__((ext_vector_type(2)));
typedef GAS unsigned gu32;
#define RLX_AGENT __ATOMIC_RELAXED, __HIP_MEMORY_SCOPE_AGENT
#define LDS_WAIT() asm volatile("s_waitcnt lgkmcnt(0)" ::: "memory")
#define VM_WAIT() asm volatile("s_waitcnt vmcnt(0)" ::: "memory")
#define SBAR() __builtin_amdgcn_sched_barrier(0)

__device__ __forceinline__ unsigned pk2(float lo, float hi) { f32x2_t v = {lo, hi}; bf16x2_t b = __builtin_convertvector(v, bf16x2_t); return __builtin_bit_cast(unsigned, b); }
__device__ __forceinline__ float bflo(unsigned u) { return __uint_as_float(u << 16); }
__device__ __forceinline__ float bfhi(unsigned u) { return __uint_as_float(u & 0xffff0000u); }
__device__ __forceinline__ bf16x8 pack8(f32x4 a, f32x4 b) { u32x4 w = {pk2(a[0], a[1]), pk2(a[2], a[3]), pk2(b[0], b[1]), pk2(b[2], b[3])}; return __builtin_bit_cast(bf16x8, w); }
__device__ __forceinline__ int crow(int r, int hi) { return (r & 3) + 8 * (r >> 2) + 4 * hi; }
__device__ __forceinline__ float wave_sum(float v) {
#pragma unroll
    for (int o = 1; o < 64; o <<= 1) v += __shfl_xor(v, o);
    return v;
}

namespace pg8 {
constexpr int BM = 256, BK = 64, HALF = 128, HTB = HALF * BK * 2  , STAGE_BYTES = 8 * HTB, NXCD = 8, WGM = 8;
__host__ __device__ __forceinline__ int lds_byte(int r, int c) { const int st = (r >> 4) * 2 + (c >> 5), rr = r & 15, cc = c & 31, ob = rr * 64 + cc * 2; return st * 1024 + (ob ^ (((ob >> 9) & 1) << 5)); }
__host__ __device__ __forceinline__ void stage_rc(int b, int& R, int& C) { const int st = b / 1024, sb = b % 1024, swz = sb ^ (((sb >> 9) & 1) << 5); R = (st >> 1) * 16 + swz / 64; C = (st & 1) * 32 + (swz % 64) / 2; }
__host__ __device__ __forceinline__ int perm32(int rho) { const int n = rho >> 4, i = rho & 15; return 8 * (i >> 2) + 4 * n + (i & 3); }

struct Unit { int pm, pn, e; };
struct Gemm { const bf16_t* A; const bf16_t* Bt; int K; long bstride; const int* rowmap; };

struct StaticOrder {
    int nM, nN, nwg, G, c;
    __device__ void init(int M, int N, int G_, int c_) { nM = M / BM; nN = N / BM; nwg = nM * nN; G = G_; c = c_; }
    __device__ bool next(int i, Unit& u) const {
        const long L = (long)i * G + c; if (L >= nwg) return false;
        int wgid = (int)L; { const int q = nwg / NXCD, r = nwg % NXCD, xcd = wgid % NXCD, off = wgid / NXCD; wgid = (xcd < r ? xcd * (q + 1) : r * (q + 1) + (xcd - r) * q) + off; }
        const int nig = WGM * nN, gid = wgid / nig, fm = gid * WGM, gsz = (nM - fm) < WGM ? (nM - fm) : WGM;
        u.pm = fm + ((wgid % nig) % gsz); u.pn = (wgid % nig) / gsz; u.e = 0; return true;
    }
};
struct GroupOrder {
    int nrb, rb0, npn, G, c; const int* rb_e;
    __device__ bool next(int i, Unit& u) const {
        int rbl, pn;
        if ((G & 7) == 0 && ((G >> 3) % npn) == 0) { const int x = c & 7, j = c >> 3, rpx = (G >> 3) / npn; rbl = i * (G / npn) + x * rpx + j / npn; pn = j % npn; }
        else { const long L = (long)i * G + c; rbl = (int)(L / npn); pn = (int)(L % npn); }
        if (rbl >= nrb) return false;
        u.pm = rb0 + rbl; u.pn = pn; u.e = rb_e[u.pm]; return true;
    }
};

typedef int v4i_t __attribute__((ext_vector_type(4)));
typedef int v8i_t __attribute__((ext_vector_type(8)));
template <class Epi, class Sched, bool ALIGN_EPI, bool FP8 = false, int SCW = 0x7f7f7f7f, int SCA = 0x7f7f7f7f, int KREP = 1>
__device__ __forceinline__ void gemm_phase(LAS unsigned char* lds, const Gemm g, const Sched& S, const Epi& E) {
    const int tid = threadIdx.x, wid = __builtin_amdgcn_readfirstlane(tid >> 6), lane = tid & 63, wr = wid >> 2, wc = wid & 3, fr = lane & 15, fq = lane >> 4;
    const int K = g.K; int nt = K / BK; asm volatile("" : "+s"(nt));
    int Rr[2], Cc[2]; unsigned voffB[2];
#pragma unroll
    for (int i = 0; i < 2; ++i) { int R, C; stage_rc(tid * 16 + i * 8192, R, C); const int Rb = Epi::PERM ? ((R & ~31) + perm32(R & 31)) : R;
        Rr[i] = R; Cc[i] = C; voffB[i] = (unsigned)(Rb * K + C) * 2u; }
    const size_t kstep = (size_t)(BK * 2);
    const size_t hstep = (size_t)HALF * K * 2;
    const size_t tstep = 2 * hstep;
    const unsigned ldsw = (unsigned)wid * 1024u;
    const int aoff = lds_byte(wr * 64 + fr, fq * 8), boff = lds_byte(wc * 32 + fr, fq * 8);
#define PG8_SA(b, h) (((b) * 2 + (h)) * HTB)
#define PG8_SB(b, h) ((4 + (b) * 2 + (h)) * HTB)
#define PG8_STAGE(bufoff, gbase, voff) do { _Pragma("unroll") for (int _i = 0; _i < 2; ++_i) \
        __builtin_amdgcn_global_load_lds((const unsigned*)((const char*)(gbase) + (voff)[_i]), (LAS unsigned*)(lds + (bufoff) + ldsw + _i * 8192), 16, 0, 0); } while (0)
#define PG8_STAGE_A(bufoff, kptr, offs, h) do { _Pragma("unroll") for (int _i = 0; _i < 2; ++_i) \
        __builtin_amdgcn_global_load_lds((const unsigned*)((const char*)(kptr) + (offs)[h][_i]), (LAS unsigned*)(lds + (bufoff) + ldsw + _i * 8192), 16, 0, 0); } while (0)
#define PG8_AOFF(dst, u) do { _Pragma("unroll") for (int _h = 0; _h < 2; ++_h) _Pragma("unroll") for (int _i = 0; _i < 2; ++_i) { const int _row = (u).pm * BM + _h * HALF + Rr[_i]; \
        const int _src = g.rowmap ? g.rowmap[_row] : _row; dst[_h][_i] = (unsigned)(_src * K + Cc[_i]) * 2u; } } while (0)
#define PG8_LDA(dst, b, h) do { _Pragma("unroll") for (int m = 0; m < 4; ++m) _Pragma("unroll") for (int k = 0; k < 2; ++k) dst[m][k] = *(const LAS bf16x8*)(lds + PG8_SA(b, h) + aoff + m * 2048 + k * 1024); } while (0)
#define PG8_LDB(dst, b, h) do { _Pragma("unroll") for (int n = 0; n < 2; ++n) _Pragma("unroll") for (int k = 0; k < 2; ++k) dst[n][k] = *(const LAS bf16x8*)(lds + PG8_SB(b, h) + boff + n * 2048 + k * 1024); } while (0)
#define PG8_CAT(x, y) __builtin_shufflevector(__builtin_bit_cast(v4i_t, x), __builtin_bit_cast(v4i_t, y), 0, 1, 2, 3, 4, 5, 6, 7)
#define PG8_MMA(ai, bj, At, Bt) do { __builtin_amdgcn_s_setprio(1); _Pragma("unroll") for (int m = 0; m < 4; ++m) _Pragma("unroll") for (int n = 0; n < 2; ++n) { \
        if constexpr (FP8) { acc[ai][bj][m][n] = __builtin_amdgcn_mfma_scale_f32_16x16x128_f8f6f4(PG8_CAT(Bt[n][0], Bt[n][1]), PG8_CAT(At[m][0], At[m][1]), acc[ai][bj][m][n], 0, 0, 0, SCW, 0, SCA); } \
        else { _Pragma("unroll") for (int k = 0; k < 2; ++k) acc[ai][bj][m][n] = __builtin_amdgcn_mfma_f32_16x16x32_bf16(Bt[n][k], At[m][k], acc[ai][bj][m][n], 0, 0, 0); } } \
        __builtin_amdgcn_s_setprio(0); } while (0)
#define PG8_WAIT_V(n) asm volatile("s_waitcnt vmcnt(" #n ")" ::: "memory")
#define PG8_WAIT_L(n) asm volatile("s_waitcnt lgkmcnt(" #n ")" ::: "memory")
#define PG8_BAR __builtin_amdgcn_s_barrier()
#define PG8_SCHED __builtin_amdgcn_sched_barrier(0)
    Unit cur, nxt; int ui = 0;
    if (!S.next(0, cur)) return;
    f32x4 acc[2][2][4][2];
#pragma unroll
    for (int a = 0; a < 2; ++a)
#pragma unroll
        for (int b = 0; b < 2; ++b)
#pragma unroll
            for (int m = 0; m < 4; ++m)
#pragma unroll
                for (int n = 0; n < 2; ++n) acc[a][b][m][n] = (f32x4){0.f, 0.f, 0.f, 0.f};
    bf16x8 At[4][2], B0[2][2], B1[2][2];
    unsigned aoc[2][2], aon[2][2];
    PG8_AOFF(aoc, cur);
    const char* Ab = (const char*)g.A;
    const char* cB = (const char*)g.Bt + ((size_t)cur.e * (size_t)g.bstride) * 2 + (size_t)cur.pn * tstep;
    PG8_STAGE(PG8_SB(0, 0), cB, voffB); PG8_STAGE(PG8_SB(0, 1), cB + hstep, voffB); PG8_STAGE_A(PG8_SA(0, 0), Ab, aoc, 0); PG8_STAGE_A(PG8_SA(0, 1), Ab, aoc, 1);
    if (wr == 1) PG8_BAR;
    PG8_WAIT_V(2); PG8_BAR;
    PG8_STAGE(PG8_SB(1, 0), cB + kstep, voffB); PG8_STAGE_A(PG8_SA(1, 0), Ab + kstep, aoc, 0); PG8_STAGE(PG8_SB(1, 1), cB + hstep + kstep, voffB);
    PG8_WAIT_V(6); PG8_BAR;
    for (;;) {
        const bool has_next = S.next(ui + 1, nxt);
        if (has_next) { PG8_AOFF(aon, nxt); }
        else {
#pragma unroll
            for (int h = 0; h < 2; ++h)
#pragma unroll
                for (int i = 0; i < 2; ++i) aon[h][i] = aoc[h][i];
        }
        const char* nB = has_next ? (const char*)g.Bt + ((size_t)nxt.e * (size_t)g.bstride) * 2 + (size_t)nxt.pn * tstep : cB;
#pragma nounroll
        for (int t = 0; t < nt * KREP; t += 2) {
            const bool last = (t == nt * KREP - 2);
            const char* a1 = Ab + (size_t)((t + 1) & (nt - 1)) * kstep;
            const char* a2 = last ? Ab : Ab + (size_t)((t + 2) & (nt - 1)) * kstep; const char* b2 = last ? nB : cB + (size_t)((t + 2) & (nt - 1)) * kstep;
            const char* a3 = a2 + kstep; const char* b3 = b2 + kstep;
            PG8_LDB(B0, 0, 0); PG8_LDB(B1, 0, 1); PG8_SCHED; PG8_LDA(At, 0, 0); PG8_STAGE_A(PG8_SA(1, 1), a1, aoc, 1);
            if (last) {
#pragma unroll
                for (int h = 0; h < 2; ++h)
#pragma unroll
                    for (int i = 0; i < 2; ++i) aoc[h][i] = aon[h][i]; }
            PG8_WAIT_V(8); PG8_WAIT_L(0); PG8_BAR; PG8_MMA(0, 0, At, B0); PG8_MMA(0, 1, At, B1); PG8_BAR; PG8_SCHED;
            PG8_LDA(At, 0, 1); PG8_STAGE(PG8_SB(0, 0), b2, voffB); PG8_STAGE(PG8_SB(0, 1), b2 + hstep, voffB); PG8_STAGE_A(PG8_SA(0, 0), a2, aoc, 0);
            PG8_WAIT_V(8); PG8_WAIT_L(0); PG8_BAR; PG8_MMA(1, 0, At, B0); PG8_MMA(1, 1, At, B1); PG8_BAR; PG8_SCHED;
            PG8_LDB(B0, 1, 0); PG8_LDB(B1, 1, 1); PG8_SCHED; PG8_LDA(At, 1, 0); PG8_STAGE_A(PG8_SA(0, 1), a2, aoc, 1);
            PG8_WAIT_V(8); PG8_WAIT_L(0); PG8_BAR; PG8_MMA(0, 0, At, B0); PG8_MMA(0, 1, At, B1); PG8_BAR; PG8_SCHED;
            PG8_LDA(At, 1, 1); PG8_STAGE(PG8_SB(1, 0), b3, voffB); PG8_STAGE(PG8_SB(1, 1), b3 + hstep, voffB); PG8_STAGE_A(PG8_SA(1, 0), a3, aoc, 0);
            PG8_WAIT_V(8); PG8_WAIT_L(0); PG8_BAR; PG8_MMA(1, 0, At, B0); PG8_MMA(1, 1, At, B1); PG8_BAR; PG8_SCHED;
        }
        if constexpr (ALIGN_EPI) { if (wr == 0) PG8_BAR; }
        E(acc, cur, wr, wc, fr, fq);
        if constexpr (FP8 && PROBE_EPI != 0) { asm volatile("" ::: "memory"); E(acc, cur, wr, wc, fr, fq); }
        if (!has_next) break;
#pragma unroll
        for (int a = 0; a < 2; ++a)
#pragma unroll
            for (int b = 0; b < 2; ++b)
#pragma unroll
                for (int m = 0; m < 4; ++m)
#pragma unroll
                    for (int n = 0; n < 2; ++n) acc[a][b][m][n] = (f32x4){0.f, 0.f, 0.f, 0.f};
        cur = nxt; cB = nB; ++ui;
        if constexpr (ALIGN_EPI) { if (wr == 1) PG8_BAR; }
    }
    PG8_WAIT_V(0);
    if constexpr (!ALIGN_EPI) { if (wr == 0) PG8_BAR; }
    PG8_BAR;
#undef PG8_SA
#undef PG8_SB
#undef PG8_STAGE
#undef PG8_STAGE_A
#undef PG8_AOFF
#undef PG8_LDA
#undef PG8_LDB
#undef PG8_MMA
#undef PG8_CAT
#undef PG8_WAIT_V
#undef PG8_WAIT_L
#undef PG8_BAR
#undef PG8_SCHED
}

struct EpiProj {
    static constexpr bool PERM = true;
    bf16_t* O;
    __device__ __forceinline__ void operator()(const f32x4 (&acc)[2][2][4][2], const Unit& u, int wr, int wc, int fr, int fq) const {
        const int row0 = u.pm * BM + wr * 64 + fr, col0 = u.pn * BM + wc * 32 + 8 * fq;
        const float sc = (u.pn == 3 || u.pn == 4 || u.pn == 9) ? C2 : 1.f;
#pragma unroll
        for (int ai = 0; ai < 2; ++ai)
#pragma unroll
            for (int m = 0; m < 4; ++m) { bf16_t* rowp = O + (size_t)(row0 + ai * HALF + m * 16) * INW + col0;
#pragma unroll
                for (int bj = 0; bj < 2; ++bj) { const f32x4 v0 = acc[ai][bj][m][0] * sc, v1 = acc[ai][bj][m][1] * sc;
                    u32x4 w; w.x = pk2(v0[0], v0[1]); w.y = pk2(v0[2], v0[3]); w.z = pk2(v1[0], v1[1]); w.w = pk2(v1[2], v1[3]);
                    *(u32x4*)(rowp + bj * HALF) = w; } }
    }
};
__device__ __forceinline__ unsigned pk4_fp8(float a, float b, float c, float d) { int w = 0; w = __builtin_amdgcn_cvt_pk_fp8_f32(a, b, w, false); w = __builtin_amdgcn_cvt_pk_fp8_f32(c, d, w, true); return (unsigned)w; }
struct EpiX1 {
    static constexpr bool PERM = true;
    const float* X; bf16_t* O; unsigned char* Q8;
    __device__ __forceinline__ void operator()(const f32x4 (&acc)[2][2][4][2], const Unit& u, int wr, int wc, int fr, int fq) const {
        const int row0 = u.pm * BM + wr * 64 + fr, col0 = u.pn * BM + wc * 32 + 8 * fq;
        const float* __restrict__ Xr = X; bf16_t* __restrict__ Or = O; unsigned char* __restrict__ Qr = Q8;
#pragma unroll
        for (int ai = 0; ai < 2; ++ai) {
            f32x4 xv[4][2][2];
#pragma unroll
            for (int m = 0; m < 4; ++m) { const size_t off = (size_t)(row0 + ai * HALF + m * 16) * DM + col0;
#pragma unroll
                for (int bj = 0; bj < 2; ++bj) { xv[m][bj][0] = *(const f32x4*)(Xr + off + bj * HALF); xv[m][bj][1] = *(const f32x4*)(Xr + off + bj * HALF + 4); } }
#pragma unroll
            for (int m = 0; m < 4; ++m) { const size_t off = (size_t)(row0 + ai * HALF + m * 16) * DM + col0;
#pragma unroll
                for (int bj = 0; bj < 2; ++bj) { const f32x4 v0 = acc[ai][bj][m][0] + xv[m][bj][0], v1 = acc[ai][bj][m][1] + xv[m][bj][1];
                    u32x4 w; w.x = pk2(v0[0], v0[1]); w.y = pk2(v0[2], v0[3]); w.z = pk2(v1[0], v1[1]); w.w = pk2(v1[2], v1[3]);
                    *(u32x4*)(Or + off + bj * HALF) = w;
                    u32x2 q; q.x = pk4_fp8(v0[0], v0[1], v0[2], v0[3]); q.y = pk4_fp8(v1[0], v1[1], v1[2], v1[3]);
                    *(u32x2*)(Qr + off + bj * HALF) = q; } }
        }
    }
};
struct EpiGU {
    static constexpr bool PERM = true;
    unsigned char* ACT; const float* bias; const float* rstd;
    __device__ __forceinline__ void operator()(const f32x4 (&acc)[2][2][4][2], const Unit& u, int wr, int wc, int fr, int fq) const {
        const int row0 = u.pm * BM + wr * 64 + fr, j0 = u.pn * HALF + wc * 32 + 8 * fq;
        const float* bp = bias + (size_t)u.e * 2048 + j0;
        const f32x4 bg0 = *(const f32x4*)(bp), bg1 = *(const f32x4*)(bp + 4), bu0 = *(const f32x4*)(bp + 1024), bu1 = *(const f32x4*)(bp + 1028);
        float rsv[2][4];
#pragma unroll
        for (int ai = 0; ai < 2; ++ai)
#pragma unroll
            for (int m = 0; m < 4; ++m) rsv[ai][m] = rstd[row0 + ai * HALF + m * 16];
#pragma unroll
        for (int ai = 0; ai < 2; ++ai)
#pragma unroll
            for (int m = 0; m < 4; ++m) { const int row = row0 + ai * HALF + m * 16; const float rs = rsv[ai][m];
                float o[8];
#pragma unroll
                for (int h2 = 0; h2 < 2; ++h2) { const f32x4 ga = h2 ? acc[ai][0][m][1] : acc[ai][0][m][0], ua = h2 ? acc[ai][1][m][1] : acc[ai][1][m][0], gb = h2 ? bg1 : bg0, ub = h2 ? bu1 : bu0;
#pragma unroll
                    for (int p2 = 0; p2 < 2; ++p2) { const f32x2_t gacc = {ga[2 * p2], ga[2 * p2 + 1]}, uacc = {ua[2 * p2], ua[2 * p2 + 1]}, gbv = {gb[2 * p2], gb[2 * p2 + 1]}, ubv = {ub[2 * p2], ub[2 * p2 + 1]};
                        f32x2_t gg = gacc * rs + gbv, uu = uacc * rs + ubv;
                        gg[0] = fminf(gg[0], 7.f); gg[1] = fminf(gg[1], 7.f); uu[0] = __builtin_amdgcn_fmed3f(uu[0], -7.f, 7.f); uu[1] = __builtin_amdgcn_fmed3f(uu[1], -7.f, 7.f);
                        const f32x2_t tt = gg * (-1.702f * LOG2E); f32x2_t ee; ee[0] = __builtin_amdgcn_exp2f(tt[0]); ee[1] = __builtin_amdgcn_exp2f(tt[1]);
                        const f32x2_t dd = ee * 0.25f + 0.25f; f32x2_t rr; rr[0] = __builtin_amdgcn_rcpf(dd[0]); rr[1] = __builtin_amdgcn_rcpf(dd[1]);
                        const f32x2_t s4 = gg * rr, oo = uu * s4 + s4;
                        o[4 * h2 + 2 * p2] = oo[0]; o[4 * h2 + 2 * p2 + 1] = oo[1]; } }
                u32x2 w; w.x = pk4_fp8(o[0], o[1], o[2], o[3]); w.y = pk4_fp8(o[4], o[5], o[6], o[7]);
                *(u32x2*)(ACT + (size_t)row * DEXP + j0) = w; }
    }
};
struct EpiDown {
    static constexpr bool PERM = true;
    unsigned char* Y; const float* bias; const float* gate;
    __device__ __forceinline__ void operator()(const f32x4 (&acc)[2][2][4][2], const Unit& u, int wr, int wc, int fr, int fq) const {
        const int row0 = u.pm * BM + wr * 64 + fr, col0 = u.pn * BM + wc * 32 + 8 * fq;
        const float* bp = bias + (size_t)u.e * DM + col0;
        f32x4 bv[2][2];
#pragma unroll
        for (int bj = 0; bj < 2; ++bj) { bv[bj][0] = *(const f32x4*)(bp + bj * HALF); bv[bj][1] = *(const f32x4*)(bp + bj * HALF + 4); }
        float gsv[2][4];
#pragma unroll
        for (int ai = 0; ai < 2; ++ai)
#pragma unroll
            for (int m = 0; m < 4; ++m) gsv[ai][m] = 8.f * gate[row0 + ai * HALF + m * 16];
#pragma unroll
        for (int ai = 0; ai < 2; ++ai)
#pragma unroll
            for (int m = 0; m < 4; ++m) { const int row = row0 + ai * HALF + m * 16; const float gs = gsv[ai][m];
#pragma unroll
                for (int bj = 0; bj < 2; ++bj) { const f32x4 v0 = (acc[ai][bj][m][0] + bv[bj][0]) * gs, v1 = (acc[ai][bj][m][1] + bv[bj][1]) * gs;
                    u32x2 w; w.x = pk4_fp8(v0[0], v0[1], v0[2], v0[3]); w.y = pk4_fp8(v1[0], v1[1], v1[2], v1[3]);
                    *(u32x2*)(Y + (size_t)row * DM + col0 + bj * HALF) = w; } }
    }
};
}

namespace dattn {
constexpr int NW = 8, QBLK = 32, KVBLK = 64, QB = 256, PITCH = INW;
constexpr int SHM_V = KVBLK * 128 * 2, SHM_K = KVBLK * 64 * 2;
constexpr int NVS = 4, NKS = 3;
constexpr int OFF_V = 0, OFF_K = NVS * SHM_V, OFF_WS = OFF_K + NKS * SHM_K, OFF_STASH = OFF_WS + NW * 64 * 4, OFF_TB = OFF_STASH + NW * 8192, LDS_BYTES = OFF_TB + 4 * 128 * 4;
constexpr float THR = 8.f;
__device__ __forceinline__ int v_st(int k, int c) { const int kk = k;     return ((kk >> 3) * 4 + (c >> 5)) * 512 + ((kk & 7) * 32 + (c & 31)) * 2; }
__device__ __forceinline__ int v_rd_base(int lane) { return ((lane & 3) << 3) | (((lane >> 2) & 3) << 6) | (((lane >> 4) & 1) << 5) | (((lane >> 5) & 1) << 8); }
constexpr int v_rd_off(int d0, int ks, int half) { return d0 * 512 + ks * 4096 + half * 2048; }

struct Ref { unsigned qoff, koff, voff; bf16_t* O; int P0, comp, h; };
typedef __amdgpu_buffer_rsrc_t rsrc_t;
__device__ __forceinline__ bf16x8 bld8(rsrc_t r, unsigned voff, unsigned soff) { return __builtin_bit_cast(bf16x8, __builtin_amdgcn_raw_buffer_load_b128(r, (int)voff, (int)soff, 0)); }
struct Seam { bf16x8 qr[4]; int ks, vs;
#if PROBE_SEG
    unsigned long long acc, tot;
#endif
};

__device__ __forceinline__ bf16x8 ld8(const bf16_t* p) { return *reinterpret_cast<const bf16x8*>(p); }

__device__ __forceinline__ void bias_mask(f32x16& p0, f32x16& p1, int sdq  , const LAS float* tb) {
    const float NEG = -__builtin_inff();
    int lane_ = (int)__builtin_amdgcn_mbcnt_hi(~0u, __builtin_amdgcn_mbcnt_lo(~0u, 0u));
    int dq = sdq + (lane_ & 31) - 4 * (lane_ >> 5);
    asm volatile("" : "+v"(dq));
#pragma unroll
    for (int r = 0; r < 16; ++r) {
        const int c = (r & 3) + 8 * (r >> 2);
        const int d0 = dq - c, d1 = dq - c - 32;
        const int i0 = d0 < 0 ? 0 : (d0 > 127 ? 127 : d0), i1 = d1 < 0 ? 0 : (d1 > 127 ? 127 : d1);
        const float b0 = tb[i0], b1 = tb[i1];
        p0[r] = d0 < 0 ? NEG : p0[r] + b0;
        p1[r] = d1 < 0 ? NEG : p1[r] + b1;
    }
}
__device__ __forceinline__ void partialSM(f32x16& p0, f32x16& p1, float& m_reg, float& alpha) {
    float pmax = p0[0];
#pragma unroll
    for (int r = 1; r < 16; ++r) pmax = fmaxf(pmax, p0[r]);
#pragma unroll
    for (int r = 0; r < 16; ++r) pmax = fmaxf(pmax, p1[r]);
    { auto rr = __builtin_amdgcn_permlane32_swap(__float_as_uint(pmax), __float_as_uint(pmax), false, false);
      pmax = fmaxf(__uint_as_float(rr[0]), __uint_as_float(rr[1])); }
    float mn;
    if (__builtin_expect(__all((pmax - m_reg) <= THR), 1)) { mn = m_reg; alpha = 1.f; }
    else { mn = fmaxf(m_reg, pmax); alpha = __builtin_amdgcn_exp2f(m_reg - mn); m_reg = mn; }
#pragma unroll
    for (int r = 0; r < 16; ++r) p0[r] = p0[r] - mn;
#pragma unroll
    for (int r = 0; r < 16; ++r) p1[r] = p1[r] - mn;
#pragma unroll
    for (int r = 0; r < 16; ++r) p0[r] = __builtin_amdgcn_exp2f(p0[r]);
}
__device__ __forceinline__ void finishSM(f32x16& p0, f32x16& p1, float alpha, float& l_reg, bf16x8& pa0, bf16x8& pa1, bf16x8& pa2, bf16x8& pa3) {
#pragma unroll
    for (int r = 0; r < 16; ++r) p1[r] = __builtin_amdgcn_exp2f(p1[r]);
    float ps = 0;
#pragma unroll
    for (int r = 0; r < 16; ++r) ps += p0[r];
#pragma unroll
    for (int r = 0; r < 16; ++r) ps += p1[r];
    { auto rr = __builtin_amdgcn_permlane32_swap(__float_as_uint(ps), __float_as_uint(ps), false, false);
      ps = __uint_as_float(rr[0]) + __uint_as_float(rr[1]); }
    l_reg = l_reg * alpha + ps;
#define PK4(P, B_, OUT) do { unsigned a0 = pk2(P[B_+0], P[B_+1]), a1 = pk2(P[B_+2], P[B_+3]);                          \
        unsigned b0 = pk2(P[B_+4], P[B_+5]), b1 = pk2(P[B_+6], P[B_+7]);                                             \
        auto r0 = __builtin_amdgcn_permlane32_swap(a0, b0, false, false); auto r1 = __builtin_amdgcn_permlane32_swap(a1, b1, false, false); \
        u32x4 w = {r0[0], r1[0], r0[1], r1[1]}; OUT = __builtin_bit_cast(bf16x8, w); } while (0)
    PK4(p0, 0, pa0); PK4(p0, 8, pa1); PK4(p1, 0, pa2); PK4(p1, 8, pa3);
#undef PK4
}
template <int KB>
__device__ __forceinline__ void qkt(f32x16& p0, f32x16& p1, const LAS unsigned char* K_lds, int r32, int hi, const bf16x8* qr) {
    p0 = f32x16{}; p1 = f32x16{};
    const int s = (r32 >> 1) & 7;
#pragma unroll
    for (int d0 = 0; d0 < 4; ++d0) {
        const LAS unsigned char* a = K_lds + KB * SHM_K + r32 * 128 + (((2 * d0 + hi) ^ s) << 4);
        const bf16x8 b0 = *(const LAS bf16x8*)(a);
        const bf16x8 b1 = *(const LAS bf16x8*)(a + 32 * 128);
        p0 = __builtin_amdgcn_mfma_f32_32x32x16_bf16(b0, qr[d0], p0, 0, 0, 0);
        p1 = __builtin_amdgcn_mfma_f32_32x32x16_bf16(b1, qr[d0], p1, 0, 0, 0); }
}
__device__ __forceinline__ void pv_tile(f32x16* o, int vb0, bf16x8 pa0, bf16x8 pa1, bf16x8 pa2, bf16x8 pa3) {
#define TRRD(dst, off) asm volatile("ds_read_b64_tr_b16 %0, %1 offset:%2" : "=&v"(dst) : "v"(vb0), "i"(off) : "memory")
#define PV_D0(d0) do { s16x4 l0, l1, l2, l3, h0, h1, h2, h3; constexpr int b_ = v_rd_off(d0, 0, 0); \
        TRRD(l0, b_); TRRD(h0, b_ + 2048); TRRD(l1, b_ + 4096); TRRD(h1, b_ + 6144); TRRD(l2, b_ + 8192); TRRD(h2, b_ + 10240); TRRD(l3, b_ + 12288); TRRD(h3, b_ + 14336); \
        asm volatile("s_waitcnt lgkmcnt(0)" ::: "memory"); SBAR();   \
        o[d0] = __builtin_amdgcn_mfma_f32_32x32x16_bf16(pa0, (bf16x8){l0[0], l0[1], l0[2], l0[3], h0[0], h0[1], h0[2], h0[3]}, o[d0], 0, 0, 0);   \
        o[d0] = __builtin_amdgcn_mfma_f32_32x32x16_bf16(pa1, (bf16x8){l1[0], l1[1], l1[2], l1[3], h1[0], h1[1], h1[2], h1[3]}, o[d0], 0, 0, 0);   \
        o[d0] = __builtin_amdgcn_mfma_f32_32x32x16_bf16(pa2, (bf16x8){l2[0], l2[1], l2[2], l2[3], h2[0], h2[1], h2[2], h2[3]}, o[d0], 0, 0, 0);   \
        o[d0] = __builtin_amdgcn_mfma_f32_32x32x16_bf16(pa3, (bf16x8){l3[0], l3[1], l3[2], l3[3], h3[0], h3[1], h3[2], h3[3]}, o[d0], 0, 0, 0); } while (0)
    PV_D0(0); PV_D0(1); PV_D0(2); PV_D0(3);
#undef PV_D0
#undef TRRD
}

#define DA_DMA16(gp, ldsp) __builtin_amdgcn_global_load_lds((const unsigned*)(gp), (LAS unsigned*)(ldsp), 16, 0, 0)
#define DA_STAGE(koff_, voff_, k0, ksoff, vsoff) do { const size_t tb_ = (size_t)(k0) * (PITCH * 2); \
        DA_DMA16(projb + (koff_) + tb_ + lk, K_lds + (ksoff) + wid * 1024); \
        DA_DMA16(projb + (voff_) + tb_ + lv, V_lds + (vsoff) + wid * 2048); \
        DA_DMA16(projb + (voff_) + tb_ + lv + 128, V_lds + (vsoff) + wid * 2048 + 1024); } while (0)
#define DA_LANE_OFFS() const int krow_ = 8 * wid + (lane >> 3); \
        const unsigned lk = (unsigned)(krow_ * PITCH) * 2u + (unsigned)(((lane & 7) ^ ((krow_ >> 1) & 7)) << 4); \
        const unsigned lv = (unsigned)((8 * wid + ((lane & 31) >> 2)) * PITCH) * 2u + (unsigned)(((lane >> 5) * 32 + (lane & 3) * 8) * 2)

__device__ __forceinline__ void prime(const Ref& cur, LAS unsigned char* lds, Seam& S, rsrc_t R, const char* projb) {
    const int tid = threadIdx.x, wid = __builtin_amdgcn_readfirstlane(tid >> 6), lane = tid & 63, r32 = lane & 31, hi = lane >> 5;
    DA_LANE_OFFS();
    const unsigned lq = (unsigned)((wid * QBLK + r32) * PITCH + hi * 8) * 2u;
    LAS unsigned char* K_lds = lds + OFF_K; LAS unsigned char* V_lds = lds + OFF_V;
#pragma unroll
    for (int d0 = 0; d0 < 4; ++d0) S.qr[d0] = bld8(R, lq + d0 * 32, cur.qoff);
    S.ks = 0; S.vs = 0;
    DA_STAGE(cur.koff, cur.voff, 0, 0, 0); DA_STAGE(cur.koff, cur.voff, KVBLK, SHM_K, SHM_V);
    __syncthreads();
}
__device__ __forceinline__ void block(const Ref& cur, const Ref& nxt, LAS unsigned char* lds, Seam& S, float lam, const float* gsub, rsrc_t R, const char* projb) {
    const int tid = threadIdx.x, wid = __builtin_amdgcn_readfirstlane(tid >> 6), lane = tid & 63, r32 = lane & 31, hi = lane >> 5;
    const int NT = (cur.P0 + QB) / KVBLK;
    const int qlo = cur.P0 + wid * QBLK;
    LAS unsigned char* V_lds = lds + OFF_V; LAS unsigned char* K_lds = lds + OFF_K;
    LAS float* ws = (LAS float*)(lds + OFF_WS) + wid * 64; LAS float* li_l = ws; LAS float* al_l = ws + 32;
    const LAS float* tbh = (const LAS float*)(lds + OFF_TB) + cur.h * 128;
    float mhat = 0.f, l_reg = 0.f, rmx = 0.f; f32x16 o[4] = {}; f32x16 negm = f32x16{};
    bool resc = false;
    const int vb0 = (int)(unsigned)(uintptr_t)V_lds + v_rd_base(lane);
    DA_LANE_OFFS();
    const unsigned Kh = cur.koff, Vh = cur.voff;
#define KNEXT(x) (((x) == (NKS - 1) * SHM_K) ? 0 : (x) + SHM_K)
#define VNEXT(x) (((x) == (NVS - 1) * SHM_V) ? 0 : (x) + SHM_V)
    int k0 = S.ks, k1 = KNEXT(k0), k2 = KNEXT(k1);
    int v1 = S.vs, v2 = VNEXT(v1), v3 = VNEXT(v2), v0 = VNEXT(v3);
#define ROT() do { const int kn_ = k0; k0 = k1; k1 = k2; k2 = kn_; const int vn_ = v0; v0 = v1; v1 = v2; v2 = v3; v3 = vn_; } while (0)
#define STREAM(j) do { const bool in_ = (j) < NT; const unsigned ko_ = in_ ? Kh : nxt.koff, vo_ = in_ ? Vh : nxt.voff; const int tj_ = in_ ? (j) : (j) - NT; DA_STAGE(ko_, vo_, KBASE(tj_), k2, v3); } while (0)
#define STEP_BAR() asm volatile("s_waitcnt vmcnt(3) lgkmcnt(0)\n\ts_barrier" ::: "memory")
    const int ksw = (r32 >> 1) & 7;
    const LAS unsigned char* kbase = K_lds + r32 * 128;
#define KBASE(t) ((t) * KVBLK)
#define NEAR(P0_, P1_, t) do { const int kb_ = KBASE(t); if (kb_ >= qlo - 175) bias_mask(P0_, P1_, qlo - kb_, tbh); } while (0)
#define RESC() do { if (resc) { asm volatile("s_waitcnt lgkmcnt(0)" ::: "memory");              \
                     _Pragma("unroll") for (int d_ = 0; d_ < 4; ++d_) _Pragma("unroll") for (int r = 0; r < 16; ++r) o[d_][r] *= al_l[crow(r, hi)]; } } while (0)
#define PIN(x) asm volatile("" : "+v"(x))
#define EX(v) __builtin_amdgcn_exp2f(v)
#define MX3(a, b, c) __builtin_fmaxf(__builtin_fmaxf((a), (b)), (c))
#define DECIDE(C0, C1, FIRST) do { \
        float a_ = MX3(C0[0], C0[1], C1[0]), b_ = MX3(C0[2], C0[3], C1[1]); a_ = MX3(a_, C1[2], C1[3]); \
        _Pragma("unroll") for (int r = 4; r < 16; r += 4) { a_ = MX3(a_, C0[r], C0[r + 1]); b_ = MX3(b_, C0[r + 2], C0[r + 3]); a_ = MX3(a_, C1[r], C1[r + 1]); b_ = MX3(b_, C1[r + 2], C1[r + 3]); } \
        float rm_ = __builtin_fmaxf(a_, b_); { auto rr_ = __builtin_amdgcn_permlane32_swap(__float_as_uint(rm_), __float_as_uint(rm_), false, false); rm_ = __builtin_fmaxf(__uint_as_float(rr_[0]), __uint_as_float(rr_[1])); } \
        resc = false; \
        if ((FIRST) || __builtin_expect(__any(rm_ > THR), 0)) { const float dl_ = (FIRST) ? rm_ : __builtin_fmaxf(rm_, 0.f); mhat += dl_; \
            _Pragma("unroll") for (int r = 0; r < 16; ++r) { C0[r] -= dl_; C1[r] -= dl_; } \
            _Pragma("unroll") for (int r = 0; r < 16; ++r) negm[r] = -mhat; \
            asm volatile("" : "+v"(negm)); \
            if (!(FIRST)) { const float f_ = EX(-dl_); l_reg *= f_; if (hi == 0) al_l[r32] = f_; resc = true; } } } while (0)
#define DECIDE2(C0, C1) do { float rm_ = rmx; { auto rr_ = __builtin_amdgcn_permlane32_swap(__float_as_uint(rm_), __float_as_uint(rm_), false, false); rm_ = __builtin_fmaxf(__uint_as_float(rr_[0]), __uint_as_float(rr_[1])); } \
        resc = false; \
        if (__builtin_expect(__any(rm_ > THR), 0)) { const float dl_ = __builtin_fmaxf(rm_, 0.f); mhat += dl_; const float f_ = EX(-dl_); \
            _Pragma("unroll") for (int r = 0; r < 16; ++r) { C0[r] *= f_; C1[r] *= f_; } \
            _Pragma("unroll") for (int r = 0; r < 16; ++r) negm[r] = -mhat; \
            asm volatile("" : "+v"(negm)); \
            l_reg *= f_; if (hi == 0) al_l[r32] = f_; resc = true; } } while (0)
#define KF(d0, hf) (*(const LAS bf16x8*)(kbase + k0 + (((2 * (d0) + hi) ^ ksw) << 4) + (hf) * 4096))
#define GAPA(MF, P, B, W) do { MF; sacc += P[B]; sacc += P[B + 1]; sacc += P[B + 2]; sacc += P[B + 3]; PIN(sacc); W[((B) >> 1) & 3] = pk2(P[B], P[B + 1]); W[(((B) >> 1) & 3) + 1] = pk2(P[B + 2], P[B + 3]); PIN(W); SBAR(); } while (0)
#define PHASE_A(C0, C1, P0, P1) do { \
        const bf16x8 k00 = KF(0, 0), k01 = KF(0, 1), k10 = KF(1, 0), k11 = KF(1, 1), k20 = KF(2, 0), k21 = KF(2, 1), k30 = KF(3, 0), k31 = KF(3, 1); \
        float sacc = 0.f; SBAR(); \
        GAPA(C0 = __builtin_amdgcn_mfma_f32_32x32x16_bf16(k00, S.qr[0], negm, 0, 0, 0), P0, 0, pw0); \
        GAPA(C1 = __builtin_amdgcn_mfma_f32_32x32x16_bf16(k01, S.qr[0], negm, 0, 0, 0), P0, 4, pw0); \
        GAPA(C0 = __builtin_amdgcn_mfma_f32_32x32x16_bf16(k10, S.qr[1], C0, 0, 0, 0), P0, 8, pw1); \
        GAPA(C1 = __builtin_amdgcn_mfma_f32_32x32x16_bf16(k11, S.qr[1], C1, 0, 0, 0), P0, 12, pw1); \
        GAPA(C0 = __builtin_amdgcn_mfma_f32_32x32x16_bf16(k20, S.qr[2], C0, 0, 0, 0), P1, 0, pw2); \
        GAPA(C1 = __builtin_amdgcn_mfma_f32_32x32x16_bf16(k21, S.qr[2], C1, 0, 0, 0), P1, 4, pw2); \
        GAPA(C0 = __builtin_amdgcn_mfma_f32_32x32x16_bf16(k30, S.qr[3], C0, 0, 0, 0), P1, 8, pw3); \
        GAPA(C1 = __builtin_amdgcn_mfma_f32_32x32x16_bf16(k31, S.qr[3], C1, 0, 0, 0), P1, 12, pw3); \
        l_reg += sacc; } while (0)
#define TRRD(dst, off) asm volatile("ds_read_b64_tr_b16 %0, %1 offset:%2" : "=&v"(dst) : "v"(vbr), "i"(off) : "memory")
#define VRD8(L0, H0, L1, H1, L2, H2, L3, H3, VBv, d0) do { constexpr int b_ = v_rd_off(d0, 0, 0); \
        TRRD(L0, b_); TRRD(H0, b_ + 2048); TRRD(L1, b_ + 4096); TRRD(H1, b_ + 6144); TRRD(L2, b_ + 8192); TRRD(H2, b_ + 10240); TRRD(L3, b_ + 12288); TRRD(H3, b_ + 14336); } while (0)
#define VF(L, H) (bf16x8){L[0], L[1], L[2], L[3], H[0], H[1], H[2], H[3]}
#define PAF(k) __builtin_bit_cast(bf16x8, pw##k)
#define GAPB(MF, X, B) do { MF; rmx = MX3(rmx, X[B], X[(B) + 1]); X[B] = EX(X[B]); X[(B) + 1] = EX(X[(B) + 1]); PIN(X); PIN(rmx); SBAR(); } while (0)
#define PV4(d0, L0, H0, L1, H1, L2, H2, L3, H3, X, B) do { \
        GAPB(o[d0] = __builtin_amdgcn_mfma_f32_32x32x16_bf16(PAF(0), VF(L0, H0), o[d0], 0, 0, 0), X, (B)); \
        GAPB(o[d0] = __builtin_amdgcn_mfma_f32_32x32x16_bf16(PAF(1), VF(L1, H1), o[d0], 0, 0, 0), X, (B) + 2); \
        GAPB(o[d0] = __builtin_amdgcn_mfma_f32_32x32x16_bf16(PAF(2), VF(L2, H2), o[d0], 0, 0, 0), X, (B) + 4); \
        GAPB(o[d0] = __builtin_amdgcn_mfma_f32_32x32x16_bf16(PAF(3), VF(L3, H3), o[d0], 0, 0, 0), X, (B) + 6); } while (0)
#define LWAIT(n) do { asm volatile("s_waitcnt lgkmcnt(" #n ")" ::: "memory"); SBAR(); } while (0)
#define PHASE_B(C0, C1, VBv) do { s16x4 a0, a1, a2, a3, a4, a5, a6, a7, b0, b1, b2, b3, b4, b5, b6, b7; const int vbr = vb0 + (VBv); rmx = -__builtin_inff(); \
        asm volatile("s_waitcnt lgkmcnt(0)" ::: "memory"); SBAR(); \
        VRD8(a0, a1, a2, a3, a4, a5, a6, a7, VBv, 0); VRD8(b0, b1, b2, b3, b4, b5, b6, b7, VBv, 1); LWAIT(8); \
        PV4(0, a0, a1, a2, a3, a4, a5, a6, a7, C0, 0); \
        VRD8(a0, a1, a2, a3, a4, a5, a6, a7, VBv, 2); LWAIT(8); \
        PV4(1, b0, b1, b2, b3, b4, b5, b6, b7, C0, 8); \
        VRD8(b0, b1, b2, b3, b4, b5, b6, b7, VBv, 3); LWAIT(8); \
        PV4(2, a0, a1, a2, a3, a4, a5, a6, a7, C1, 0); \
        LWAIT(0); \
        PV4(3, b0, b1, b2, b3, b4, b5, b6, b7, C1, 8); } while (0)
    f32x16 pA0, pA1, pB0, pB1; u32x4 pw0, pw1, pw2, pw3;
#if PROBE_SEG
    unsigned long long pst_ = __builtin_readcyclecounter();
#define STAMP(k) do { const unsigned long long n_ = __builtin_readcyclecounter(); if ((k) == PROBE_SEG) S.acc += n_ - pst_; S.tot += n_ - pst_; pst_ = n_; } while (0)
#else
#define STAMP(k) do { } while (0)
#endif
    STREAM(2);
    SBAR();
    {
      const bf16x8 k00 = KF(0, 0), k01 = KF(0, 1), k10 = KF(1, 0), k11 = KF(1, 1), k20 = KF(2, 0), k21 = KF(2, 1), k30 = KF(3, 0), k31 = KF(3, 1);
      pA0 = __builtin_amdgcn_mfma_f32_32x32x16_bf16(k00, S.qr[0], negm, 0, 0, 0); pA1 = __builtin_amdgcn_mfma_f32_32x32x16_bf16(k01, S.qr[0], negm, 0, 0, 0);
      pA0 = __builtin_amdgcn_mfma_f32_32x32x16_bf16(k10, S.qr[1], pA0, 0, 0, 0); pA1 = __builtin_amdgcn_mfma_f32_32x32x16_bf16(k11, S.qr[1], pA1, 0, 0, 0);
      pA0 = __builtin_amdgcn_mfma_f32_32x32x16_bf16(k20, S.qr[2], pA0, 0, 0, 0); pA1 = __builtin_amdgcn_mfma_f32_32x32x16_bf16(k21, S.qr[2], pA1, 0, 0, 0);
      pA0 = __builtin_amdgcn_mfma_f32_32x32x16_bf16(k30, S.qr[3], pA0, 0, 0, 0); pA1 = __builtin_amdgcn_mfma_f32_32x32x16_bf16(k31, S.qr[3], pA1, 0, 0, 0); }
    NEAR(pA0, pA1, 0); DECIDE(pA0, pA1, true);
#pragma unroll
    for (int r = 0; r < 16; ++r) { pA0[r] = EX(pA0[r]); pA1[r] = EX(pA1[r]); }
    STEP_BAR();
    ROT();
#define STEP(C0, C1, P0, P1, t) do { SBAR(); STAMP(5); \
        STREAM((t) + 2); SBAR(); \
        PHASE_A(C0, C1, P0, P1); SBAR(); STAMP(1); \
        NEAR(C0, C1, (t)); SBAR(); STAMP(2); \
        PHASE_B(C0, C1, v0); DECIDE2(C0, C1); SBAR(); STAMP(3); \
        RESC(); STEP_BAR(); STAMP(4); ROT(); } while (0)
    int t = 1;
    for (; t + 2 < NT; t += 2) {
        STEP(pB0, pB1, pA0, pA1, t);
        STEP(pA0, pA1, pB0, pB1, t + 1);
    }
    SBAR(); STREAM(NT + 1); SBAR();
    PHASE_A(pB0, pB1, pA0, pA1);
    { const unsigned lq = (unsigned)((wid * QBLK + r32) * PITCH + hi * 8) * 2u;
#pragma unroll
      for (int d0 = 0; d0 < 4; ++d0) S.qr[d0] = bld8(R, lq + d0 * 32, nxt.qoff); }
    SBAR();
    NEAR(pB0, pB1, NT - 1); SBAR();
    PHASE_B(pB0, pB1, v0); DECIDE2(pB0, pB1);
    RESC();
    { float sacc = 0.f;
#pragma unroll
      for (int r = 0; r < 16; ++r) { sacc += pB0[r]; sacc += pB1[r]; }
      l_reg += sacc;
      pw0 = (u32x4){pk2(pB0[0], pB0[1]), pk2(pB0[2], pB0[3]), pk2(pB0[4], pB0[5]), pk2(pB0[6], pB0[7])}; pw1 = (u32x4){pk2(pB0[8], pB0[9]), pk2(pB0[10], pB0[11]), pk2(pB0[12], pB0[13]), pk2(pB0[14], pB0[15])};
      pw2 = (u32x4){pk2(pB1[0], pB1[1]), pk2(pB1[2], pB1[3]), pk2(pB1[4], pB1[5]), pk2(pB1[6], pB1[7])}; pw3 = (u32x4){pk2(pB1[8], pB1[9]), pk2(pB1[10], pB1[11]), pk2(pB1[12], pB1[13]), pk2(pB1[14], pB1[15])};
      SBAR(); pv_tile(o, vb0 + v1, PAF(0), PAF(1), PAF(2), PAF(3)); }
    ROT(); S.ks = k0; S.vs = v1;
    { auto rr = __builtin_amdgcn_permlane32_swap(__float_as_uint(l_reg), __float_as_uint(l_reg), false, false); l_reg = __uint_as_float(rr[0]) + __uint_as_float(rr[1]); }
    int lane_e = (int)__builtin_amdgcn_mbcnt_hi(~0u, __builtin_amdgcn_mbcnt_lo(~0u, 0u)); asm volatile("" : "+v"(lane_e));
    const int r32e = lane_e & 31, hie = lane_e >> 5;
    if (hi == 0) li_l[r32] = l_reg; asm volatile("s_waitcnt lgkmcnt(0)" ::: "memory");
    float rli[16];
#pragma unroll
    for (int r = 0; r < 16; ++r) rli[r] = __builtin_amdgcn_rcpf(li_l[crow(r, hi)]);
    LAS unsigned* st = (LAS unsigned*)(lds + OFF_STASH + wid * 8192) + lane_e;
    if (cur.comp == 0) {
#pragma unroll
        for (int r = 0; r < 16; ++r) { st[(2 * r) * 64] = pk2(o[0][r] * rli[r], o[1][r] * rli[r]); st[(2 * r + 1) * 64] = pk2(o[2][r] * rli[r], o[3][r] * rli[r]); }
    } else {
        float ss[16];
#pragma unroll
        for (int r = 0; r < 16; ++r) { const unsigned u0 = st[(2 * r) * 64], u1 = st[(2 * r + 1) * 64];
            const float s2 = lam * rli[r];
            o[0][r] = bflo(u0) - s2 * o[0][r]; o[1][r] = bfhi(u0) - s2 * o[1][r]; o[2][r] = bflo(u1) - s2 * o[2][r]; o[3][r] = bfhi(u1) - s2 * o[3][r];
            ss[r] = (o[0][r] * o[0][r] + o[1][r] * o[1][r]) + (o[2][r] * o[2][r] + o[3][r] * o[3][r]); }
#pragma unroll
        for (int r = 0; r < 16; ++r) {
#pragma unroll
            for (int x = 1; x < 32; x <<= 1) ss[r] += __shfl_xor(ss[r], x);
            ss[r] = rsqrtf(ss[r] * (1.f / 128.f) + EPS) * 0.8f; }
        float gg[4];
#pragma unroll
        for (int d0 = 0; d0 < 4; ++d0) gg[d0] = gsub[d0 * 32 + r32e];
        bf16_t* Ow = cur.O + (size_t)(wid * QBLK) * DM;
#pragma unroll
        for (int r = 0; r < 16; ++r) { const int orow = crow(r, hie);
#pragma unroll
            for (int d0 = 0; d0 < 4; ++d0) { const float v = o[d0][r] * ss[r] * gg[d0]; const float vn = __shfl_xor(v, 1);
                if ((r32e & 1) == 0) *(unsigned*)(Ow + (size_t)orow * DM + d0 * 32 + r32e) = pk2(v, vn); } }
    }
    __syncthreads();
#undef RESC
#undef KBASE
#undef NEAR
#undef PIN
#undef EX
#undef MX3
#undef DECIDE
#undef DECIDE2
#undef KF
#undef GAPA
#undef PHASE_A
#undef TRRD
#undef VRD8
#undef VF
#undef PAF
#undef GAPB
#undef PV4
#undef LWAIT
#undef PHASE_B
#undef STEP
#undef STAMP
#undef ROT
#undef KNEXT
#undef VNEXT
#undef STREAM
#undef STEP_BAR
}
#undef DA_DMA16
#undef DA_STAGE
#undef DA_LANE_OFFS
}

constexpr int NWAVES = 8;
constexpr int N_LAUNCHES = MK_N_LAUNCHES;
constexpr int N_PHASES = 9;
static_assert(N_LAUNCHES == 1 || N_LAUNCHES == N_PHASES, "MK_N_LAUNCHES is 1 or 9");

constexpr size_t MiB = 1u << 20;
constexpr size_t WS_CTL = 0, CTL_ZERO_BYTES = 1 * MiB;
constexpr size_t WS_ETK = 1 * MiB, WS_GTK = 2 * MiB, WS_RSTDT = 3 * MiB, WS_SLOTTK = 4 * MiB, WS_TOKSLOT = 5 * MiB, WS_GATESLOT = 7 * MiB, WS_RSTDSLOT = 9 * MiB, WS_RBE = 11 * MiB;
constexpr size_t WS_WRHI = 12 * MiB, WS_WRLO = 12 * MiB + 65536, WS_KMB = 13 * MiB, WS_VMT = 14 * MiB;
constexpr size_t WS_WIN = 16 * MiB, WS_WOUT = 21 * MiB, WS_X1B = 24 * MiB, WS_X1Q = 152 * MiB;
constexpr size_t WS_BIG = 216 * MiB;
constexpr size_t WS_H = WS_BIG, WS_PROJ = WS_BIG + 128 * MiB, WS_MIX = WS_BIG + 448 * MiB;
constexpr size_t WS_ACTQ = WS_BIG, WS_Y = WS_BIG + 264 * MiB;
constexpr size_t WS_END = WS_BIG + 792 * MiB;
static_assert(WS_END <= 1024 * MiB, "d_ws map");
constexpr size_t OUT_WGU = 0, OUT_WD = 64 * MiB;
constexpr int CW_BAR = 4096, CW_COUNT = 1024, CW_CURSOR = 2048;
constexpr int RING_BYTES = 159744, LDSCTL_OFF = RING_BYTES, MISC_OFF = LDSCTL_OFF + 320, LDS_BYTES = 163840;
static_assert(dattn::LDS_BYTES <= RING_BYTES, "attention scratch");

#define XB_TMO      128
#define XB_XCNT(j)  (256  + 64 * (j))
#define XB_XSUB(j)  (1280 + 64 * (j))
#define XB_XGEN(j)  (2304 + 64 * (j))
#define XB_TOP      3328
#define XB_TOPGEN   3392
#define XCD_BAR_WORDS 3456
#define XB_SPIN_CAP (1u << 18)
__device__ __forceinline__ unsigned xb_ld(unsigned* p)              { return __hip_atomic_load(p, __ATOMIC_RELAXED, __HIP_MEMORY_SCOPE_AGENT); }
__device__ __forceinline__ unsigned xb_add(unsigned* p, unsigned v) { return __hip_atomic_fetch_add(p, v, __ATOMIC_RELAXED, __HIP_MEMORY_SCOPE_AGENT); }
__device__ __forceinline__ unsigned xb_xcc_id() { return (unsigned)__builtin_amdgcn_s_getreg((3 << 11) | 20) & 0xFu; }
#define XB_SPIN(cond, bar) do { unsigned _sp = 0; while (cond) { __builtin_amdgcn_s_sleep(1); \
    if ((++_sp & 255u) == 0u) { if (xb_ld(&(bar)[XB_TMO])) break; if (_sp > XB_SPIN_CAP) { atomicAdd(&(bar)[XB_TMO], 1u); break; } } } } while (0)
struct XcdBarrier { unsigned* bar; unsigned x; volatile LAS unsigned* st; };
__device__ __forceinline__ XcdBarrier xcd_barrier_post(unsigned* bar, volatile LAS unsigned* st) {
    XcdBarrier b; b.bar = bar; b.x = xb_xcc_id(); b.st = st;
    if (threadIdx.x == 0) (void)xb_add(&bar[XB_XCNT(b.x)], 1u);
    return b;
}
__device__ __forceinline__ void xcd_barrier_complete(unsigned* bar, unsigned x, unsigned& nloc, unsigned& nx) {
    const unsigned G = gridDim.x * gridDim.y * gridDim.z;
    unsigned sum, cnt, mine, sp = 0u;
    for (;;) {
        sum = 0u; cnt = 0u; mine = 0u;
#pragma unroll
        for (unsigned j = 0; j < 16; ++j) { const unsigned c = xb_ld(&bar[XB_XCNT(j)]); sum += c; cnt += (c > 0u) ? 1u : 0u; mine = (j == x) ? c : mine; }
        if (sum == G) break;
        __builtin_amdgcn_s_sleep(1);
        if ((++sp & 255u) == 0u) { if (xb_ld(&bar[XB_TMO])) break; if (sp > XB_SPIN_CAP) { atomicAdd(&bar[XB_TMO], 1u); break; } }
    }
    nloc = mine > 0u ? mine : 1u; nx = cnt > 0u ? cnt : 1u;
}
__device__ __forceinline__ void xcd_barrier(const XcdBarrier& b) {
    asm volatile("s_waitcnt vmcnt(0)" ::: "memory");
    __syncthreads();
    if (threadIdx.x == 0) {
        unsigned* bar = b.bar;
        __builtin_amdgcn_s_waitcnt(0);
        unsigned nloc = b.st[0], nx = b.st[1];
        if (nloc == 0u) { xcd_barrier_complete(bar, b.x, nloc, nx); b.st[0] = nloc; b.st[1] = nx; }
        const unsigned old = xb_add(&bar[XB_XSUB(b.x)], 1u);
        const unsigned gen = old / nloc;
        if (old + 1u == (gen + 1u) * nloc) {
            __builtin_amdgcn_fence(__ATOMIC_RELEASE, "agent");
            asm volatile("s_waitcnt vmcnt(0)" ::: "memory");
            const unsigned og = xb_add(&bar[XB_TOP], 1u);
            const unsigned tg = og / nx;
            if (og + 1u == (tg + 1u) * nx) xb_add(&bar[XB_TOPGEN], 1u);
            else XB_SPIN(xb_ld(&bar[XB_TOPGEN]) == tg, bar);
            __builtin_amdgcn_fence(__ATOMIC_ACQUIRE, "agent");
            xb_add(&bar[XB_XGEN(b.x)], 1u);
            asm volatile("s_waitcnt vmcnt(0)" ::: "memory");
        } else {
            XB_SPIN(xb_ld(&bar[XB_XGEN(b.x)]) == gen, bar);
            __builtin_amdgcn_fence(__ATOMIC_ACQUIRE, "agent");
            asm volatile("s_waitcnt vmcnt(0)" ::: "memory");
        }
    }
    __syncthreads();
}

struct Frame {
    LAS unsigned char* lds;
    volatile LAS unsigned* MISC;
    unsigned* ctl;
    int tid, lane, wave, vcu, G;
    float* out;
    unsigned char* ws;
};
struct Args { const float* in[19]; float* out; unsigned char* ws; int ph_lo, ph_hi; };
typedef const __attribute__((address_space(4))) Args* KArgs;
__device__ __forceinline__ KArgs kargs() { KArgs p = (KArgs)__builtin_amdgcn_kernarg_segment_ptr(); asm volatile("" : "+s"(p)); return p; }
enum { I_X = 0, I_MEM, I_RELB, I_ATTNG, I_WIN, I_CONVW, I_LAMQK, I_SUBG, I_MEMG, I_WMEMKV, I_WOUT, I_FFNG, I_RW, I_RB, I_WGU, I_BGU, I_WDN, I_BDN, I_FING };

template <bool GAIN, bool F8>
__device__ __forceinline__ void p0_transpose_item(const float* W, int K, int N, void* WTv, int k0, int n0, int drow0, const float* kgain, float scale, LAS float* scr, int lane) {
    float v[32];
    const float* wp = W + (size_t)(k0 + (lane >> 5)) * N + n0 + (lane & 31);
#pragma unroll
    for (int i = 0; i < 32; ++i) v[i] = wp[(size_t)(2 * i) * N];
    const int c = lane & 7;
    f32x4 g0 = {scale, scale, scale, scale}, g1 = g0;
    if constexpr (GAIN) { g0 = *(const f32x4*)(kgain + k0 + 8 * c) * scale; g1 = *(const f32x4*)(kgain + k0 + 8 * c + 4) * scale; }
#pragma unroll
    for (int i = 0; i < 32; ++i) scr[(2 * i + (lane >> 5)) * 33 + (lane & 31)] = v[i];
    LDS_WAIT(); asm volatile("" ::: "memory");
#pragma unroll
    for (int j = 0; j < 4; ++j) { const int n = (lane >> 3) + 8 * j; const LAS float* s = scr + (8 * c) * 33 + n;
        const float e0 = s[0 * 33] * g0[0], e1 = s[1 * 33] * g0[1], e2 = s[2 * 33] * g0[2], e3 = s[3 * 33] * g0[3], e4 = s[4 * 33] * g1[0], e5 = s[5 * 33] * g1[1], e6 = s[6 * 33] * g1[2], e7 = s[7 * 33] * g1[3];
        if constexpr (F8) { u32x2 o; o.x = pg8::pk4_fp8(e0, e1, e2, e3); o.y = pg8::pk4_fp8(e4, e5, e6, e7);
            *(u32x2*)((unsigned char*)WTv + (size_t)(drow0 + n) * K + k0 + 8 * c) = o; }
        else { u32x4 o; o.x = pk2(e0, e1); o.y = pk2(e2, e3); o.z = pk2(e4, e5); o.w = pk2(e6, e7);
            *(u32x4*)((bf16_t*)WTv + (size_t)(drow0 + n) * K + k0 + 8 * c) = o; } }
    LDS_WAIT(); asm volatile("" ::: "memory");
}
__device__ __forceinline__ void rms_row2_to_bf16(const float* xa, const float* xb, const float* g, bf16_t* oa, bf16_t* ob, int lane) {
    const f32x4* ra = (const f32x4*)xa + lane; const f32x4* rb = (const f32x4*)xb + lane; const f32x4* gr = (const f32x4*)g + lane;
    f32x4 va[4], vb[4]; float sa = 0.f, sb = 0.f;
#pragma unroll
    for (int j = 0; j < 4; ++j) { va[j] = ra[64 * j]; vb[j] = rb[64 * j]; }
#pragma unroll
    for (int j = 0; j < 4; ++j) { sa += (va[j].x * va[j].x + va[j].y * va[j].y) + (va[j].z * va[j].z + va[j].w * va[j].w); sb += (vb[j].x * vb[j].x + vb[j].y * vb[j].y) + (vb[j].z * vb[j].z + vb[j].w * vb[j].w); }
    const float rsa = rsqrtf(wave_sum(sa) * (1.f / DM) + EPS), rsb = rsqrtf(wave_sum(sb) * (1.f / DM) + EPS);
    unsigned long long* pa = (unsigned long long*)oa + lane; unsigned long long* pb = (unsigned long long*)ob + lane;
#pragma unroll
    for (int j = 0; j < 4; ++j) { const f32x4 gg = gr[64 * j];
        pa[64 * j] = (unsigned long long)pk2(va[j].x * rsa * gg.x, va[j].y * rsa * gg.y) | ((unsigned long long)pk2(va[j].z * rsa * gg.z, va[j].w * rsa * gg.w) << 32);
        pb[64 * j] = (unsigned long long)pk2(vb[j].x * rsb * gg.x, vb[j].y * rsb * gg.y) | ((unsigned long long)pk2(vb[j].z * rsb * gg.z, vb[j].w * rsb * gg.w) << 32); }
}
__device__ __forceinline__ void p0_kvm_tile(Frame& F, int tile, const float* mem, const float* mem_g, const float* w_memkv) {
    const int mt = tile >> 3, ntile = tile & 7, row0 = 64 * mt, col0 = 64 * ntile;
    const int mb = F.wave >> 1, nb0 = (F.wave & 1) * 2, ar = F.lane & 15, kq = F.lane >> 4;
    const float* arow = mem + (size_t)(row0 + mb * 16 + ar) * DM;
    f32x4 acc[2]; acc[0] = (f32x4){0.f, 0.f, 0.f, 0.f}; acc[1] = acc[0];
    float ss = 0.f;
    const float* wq = w_memkv + col0 + nb0 * 16 + ar;
#define KVM_LOAD(A0, A1, G0, G1, BV, k0_) do { const int kk_ = (k0_) + 8 * kq; A0 = *(const f32x4*)(arow + kk_); A1 = *(const f32x4*)(arow + kk_ + 4); G0 = *(const f32x4*)(mem_g + kk_); G1 = *(const f32x4*)(mem_g + kk_ + 4); \
        _Pragma("unroll") for (int nbi = 0; nbi < 2; ++nbi) _Pragma("unroll") for (int j = 0; j < 8; ++j) BV[nbi][j] = wq[(size_t)(kk_ + j) * 512 + nbi * 16]; } while (0)
#define KVM_MATH(A0, A1, G0, G1, BV) do { ss += (A0.x * A0.x + A0.y * A0.y) + (A0.z * A0.z + A0.w * A0.w) + (A1.x * A1.x + A1.y * A1.y) + (A1.z * A1.z + A1.w * A1.w); \
        const bf16x8 af = pack8(A0 * G0, A1 * G1); \
        _Pragma("unroll") for (int nbi = 0; nbi < 2; ++nbi) { const f32x4 b0 = {BV[nbi][0], BV[nbi][1], BV[nbi][2], BV[nbi][3]}, b1 = {BV[nbi][4], BV[nbi][5], BV[nbi][6], BV[nbi][7]}; \
            acc[nbi] = __builtin_amdgcn_mfma_f32_16x16x32_bf16(af, pack8(b0, b1), acc[nbi], 0, 0, 0); } } while (0)
    f32x4 ba0[4], ba1[4], bg0[4], bg1[4]; float bb[4][2][8];
#pragma unroll 1
    for (int k0 = 0; k0 < DM; k0 += 128) {
#pragma unroll
        for (int q = 0; q < 4; ++q) KVM_LOAD(ba0[q], ba1[q], bg0[q], bg1[q], bb[q], k0 + 32 * q);
#pragma unroll
        for (int q = 0; q < 4; ++q) KVM_MATH(ba0[q], ba1[q], bg0[q], bg1[q], bb[q]);
    }
#undef KVM_LOAD
#undef KVM_MATH
    ss += __shfl_xor(ss, 16); ss += __shfl_xor(ss, 32);
    const float rstd = rsqrtf(ss * (1.f / DM) + EPS);
    float rs[4];
#pragma unroll
    for (int j = 0; j < 4; ++j) rs[j] = __shfl(rstd, kq * 4 + j);
    bf16_t* kmb = (bf16_t*)(F.ws + WS_KMB); bf16_t* vmt = (bf16_t*)(F.ws + WS_VMT);
#pragma unroll
    for (int nbi = 0; nbi < 2; ++nbi) {
        const int gc = col0 + (nb0 + nbi) * 16 + ar, gr0 = row0 + mb * 16 + kq * 4;
        if (ntile < 4) {
#pragma unroll
            for (int j = 0; j < 4; ++j) kmb[(size_t)(gr0 + j) * 256 + gc] = (bf16_t)(pk2(acc[nbi][j] * rs[j], 0.f) & 0xffffu);
        } else {
            const int d = gc - 256, hm = d >> 6, dd = d & 63, b = gr0 >> 8, m = gr0 & 255;
            u32x2 w; w.x = pk2(acc[nbi][0] * rs[0], acc[nbi][1] * rs[1]); w.y = pk2(acc[nbi][2] * rs[2], acc[nbi][3] * rs[3]);
            *(u32x2*)(vmt + ((size_t)((b * 4 + hm) * 64 + dd)) * 256 + m) = w;
        }
    }
}
struct P0Tile { const float* src; unsigned char* dst; int gain; };
template <int N, int K>
__device__ __forceinline__ void p0_tile_load(const float* src, f32x4 (&v)[8], int tid) {
#pragma unroll
    for (int i = 0; i < 8; ++i) v[i] = *(const f32x4*)(src + (size_t)((tid >> 5) + 16 * i) * N + (tid & 31) * 4);
}
__device__ __forceinline__ void p0_tile_to_lds(LAS float* tl, const f32x4 (&v)[8], int tid) {
#pragma unroll
    for (int i = 0; i < 8; ++i) { const int k = (tid >> 5) + 16 * i, c = ((tid & 31) * 4) ^ (((k >> 4) & 7) << 2); *(LAS f32x4*)(tl + k * 132 + c) = v[i]; }
}
template <int K, bool GAIN>
__device__ __forceinline__ void p0_tile_store(const LAS float* tl, unsigned char* dst, const float* kgain, float scale, int tid) {
    const int run = tid & 7;
    f32x4 g[4];
#pragma unroll
    for (int q = 0; q < 4; ++q) { g[q] = (f32x4){scale, scale, scale, scale}; if constexpr (GAIN) g[q] = *(const f32x4*)(kgain + run * 16 + 4 * q) * scale; }
#pragma unroll
    for (int p = 0; p < 2; ++p) { const int n = (tid >> 3) + 64 * p; const LAS float* s = tl + (run * 16) * 132 + (n ^ (run << 2));
        u32x4 o;
#pragma unroll
        for (int q = 0; q < 4; ++q) o[q] = pg8::pk4_fp8(s[(4 * q) * 132] * g[q][0], s[(4 * q + 1) * 132] * g[q][1], s[(4 * q + 2) * 132] * g[q][2], s[(4 * q + 3) * 132] * g[q][3]);
        *(u32x4*)(dst + (size_t)n * K + run * 16) = o; }
}
__device__ __forceinline__ void p0_prologue(Frame& F) {
    KArgs A = kargs();
    { const float* mem = A->in[I_MEM]; const float* mem_g = A->in[I_MEMG]; const float* w_memkv = A->in[I_WMEMKV];
      for (int rep2_ = 0; rep2_ < ((PROBE_P0 & 4) ? 2 : 1); ++rep2_)
      for (int tile = blockIdx.x; tile < 256; tile += F.G) p0_kvm_tile(F, tile, mem, mem_g, w_memkv); }
    const float* w_in = A->in[I_WIN]; const float* w_out = A->in[I_WOUT]; const float* w_gu = A->in[I_WGU]; const float* w_dn = A->in[I_WDN]; const float* ffn_g = A->in[I_FFNG];
    LAS float* scr = (LAS float*)(F.lds + F.wave * 16384);
    const int gw = F.vcu * NWAVES + F.wave, NGW = F.G * NWAVES;
    bf16_t* Win_t = (bf16_t*)(F.ws + WS_WIN); bf16_t* Wout_t = (bf16_t*)(F.ws + WS_WOUT);
    unsigned char* Wgu_q = (unsigned char*)F.out + OUT_WGU; unsigned char* Wd_q = (unsigned char*)F.out + OUT_WD;
    constexpr int I_IN = 16 * 80, I_OUT = 16 * 32, NITEMS = I_IN + I_OUT;
    for (int rep0_ = 0; rep0_ < ((PROBE_P0 & 1) ? 2 : 1); ++rep0_)
    for (int it = gw; it < NITEMS; it += NGW) {
        int r = it;
        if (r < I_IN) { const int kb = r / 80, nb = r % 80; p0_transpose_item<false, false>(w_in, DM, INW, Win_t, 64 * kb, 32 * nb, 32 * nb, nullptr, 1.f, scr, F.lane); continue; } r -= I_IN;
        if (r < I_OUT) { const int kb = r / 32, nb = r % 32; p0_transpose_item<false, false>(w_out, DM, DM, Wout_t, 64 * kb, 32 * nb, 32 * nb, nullptr, 1.f, scr, F.lane); continue; } r -= I_OUT;
    }
    { __syncthreads();
      LAS float* tl = (LAS float*)F.lds; const int tid = F.tid;
      constexpr int T_GU = NEXP * 8 * 16, T_DN = NEXP * 8 * 8, T_ALL = T_GU + T_DN;
#define P0_TILE(ti, SRC, DST, ISGU) do { int r_ = (ti); ISGU = r_ < T_GU; if (ISGU) { const int e = r_ >> 7, q = r_ & 127, kt = q >> 4, nt = q & 15, n0 = nt * 128, jj = n0 & 1023; \
            SRC = w_gu + (size_t)e * DM * 2048 + (size_t)(kt * 128) * 2048 + n0; DST = Wgu_q + (size_t)e * 2048 * DM + (size_t)((jj >> 7) * 256 + (n0 >= 1024 ? 128 : 0)) * DM + kt * 128; } \
          else { r_ -= T_GU; const int e = r_ >> 6, q = r_ & 63, kt = q >> 3, nt = q & 7; \
            SRC = w_dn + (size_t)e * DEXP * DM + (size_t)(kt * 128) * DM + nt * 128; DST = Wd_q + (size_t)e * DM * DEXP + (size_t)(nt * 128) * DEXP + kt * 128; } } while (0)
      f32x4 v[8]; const float* src; unsigned char* dst; bool isgu; const float* srcn; unsigned char* dstn; bool isgun;
      int ti = blockIdx.x;
      if (ti < T_ALL) { P0_TILE(ti, src, dst, isgu); if (isgu) p0_tile_load<2048, DM>(src, v, tid); else p0_tile_load<DM, DEXP>(src, v, tid); }
      for (; ti < T_ALL; ti += F.G) {
          p0_tile_to_lds(tl, v, tid);
          __syncthreads();
          const int tn = ti + F.G;
          if (tn < T_ALL) { P0_TILE(tn, srcn, dstn, isgun); if (isgun) p0_tile_load<2048, DM>(srcn, v, tid); else p0_tile_load<DM, DEXP>(srcn, v, tid); }
          if (isgu) { const int kt_ = (int)(((size_t)(dst - Wgu_q)) & (DM - 1)); p0_tile_store<DM, true>(tl, dst, ffn_g + kt_, 64.f, tid); }
          else p0_tile_store<DEXP, false>(tl, dst, nullptr, 64.f, tid);
          __syncthreads();
          src = srcn; dst = dstn; isgu = isgun;
      }
#undef P0_TILE
    }
    bf16_t* H = (bf16_t*)(F.ws + WS_H);
    { const float* x = A->in[I_X]; const float* attn_g = A->in[I_ATTNG];
      for (int rep1_ = 0; rep1_ < ((PROBE_P0 & 2) ? 2 : 1); ++rep1_)
      for (int m = gw; m < T; m += 2 * NGW) { const int m2 = (m + NGW < T) ? m + NGW : m;
          rms_row2_to_bf16(x + (size_t)m * DM, x + (size_t)m2 * DM, attn_g, H + (size_t)m * DM, H + (size_t)m2 * DM, F.lane); } }
    const float* router_w = A->in[I_RW];
    bf16_t* wrh = (bf16_t*)(F.ws + WS_WRHI); bf16_t* wrl = (bf16_t*)(F.ws + WS_WRLO);
    for (int i = (F.vcu * NWAVES + F.wave) * 64 + F.lane; i < NEXP * DM; i += NGW * 64) { const int e = i >> 10, k = i & 1023;
        const float v = ffn_g[k] * router_w[(size_t)k * NEXP + e]; const unsigned hb = pk2(v, 0.f) & 0xffffu; const float hf = __uint_as_float(hb << 16);
        wrh[i] = (bf16_t)hb; wrl[i] = (bf16_t)(pk2(v - hf, 0.f) & 0xffffu); }
}

__device__ __forceinline__ void p2_conv_block(Frame& F, int blk, int tid_, const float* conv_w) {
    const bf16_t* proj = (const bf16_t*)(F.ws + WS_PROJ); bf16_t* mix = (bf16_t*)(F.ws + WS_MIX);
    const int cg = tid_ & 31, tc = tid_ >> 5;
    const int c0 = cg * 8, t0 = blk * 256 + tc * 16, s0 = t0 & (SEQ - 1);
    float w0[8], w1[8], w2[8];
#pragma unroll
    for (int i = 0; i < 8; ++i) { w0[i] = conv_w[c0 + i]; w1[i] = conv_w[256 + c0 + i]; w2[i] = conv_w[512 + c0 + i]; }
    float p2[8], p1[8];
#pragma unroll
    for (int i = 0; i < 8; ++i) { p2[i] = 0.f; p1[i] = 0.f; }
    if (s0 >= 2) {
        const u32x4 ua = *(const u32x4*)(proj + (size_t)(t0 - 2) * INW + COL_U + c0), ca = *(const u32x4*)(proj + (size_t)(t0 - 2) * INW + COL_GC + c0);
        const u32x4 ub = *(const u32x4*)(proj + (size_t)(t0 - 1) * INW + COL_U + c0), cb = *(const u32x4*)(proj + (size_t)(t0 - 1) * INW + COL_GC + c0);
#pragma unroll
        for (int i = 0; i < 4; ++i) { p2[2 * i] = bflo(ua[i]) * bflo(ca[i]); p2[2 * i + 1] = bfhi(ua[i]) * bfhi(ca[i]); p1[2 * i] = bflo(ub[i]) * bflo(cb[i]); p1[2 * i + 1] = bfhi(ub[i]) * bfhi(cb[i]); }
    }
    for (int tb = 0; tb < 16; tb += 4) {
        u32x4 uu[4], cc[4], bb[4];
#pragma unroll
        for (int q = 0; q < 4; ++q) { const size_t ro = (size_t)(t0 + tb + q) * INW;
            uu[q] = *(const u32x4*)(proj + ro + COL_U + c0); cc[q] = *(const u32x4*)(proj + ro + COL_GC + c0); bb[q] = *(const u32x4*)(proj + ro + COL_GB + c0); }
#pragma unroll
        for (int q = 0; q < 4; ++q) {
            float cur[8], y[8];
#pragma unroll
            for (int i = 0; i < 4; ++i) { cur[2 * i] = bflo(uu[q][i]) * bflo(cc[q][i]); cur[2 * i + 1] = bfhi(uu[q][i]) * bfhi(cc[q][i]); }
#pragma unroll
            for (int i = 0; i < 4; ++i) { y[2 * i] = bflo(bb[q][i]) * (w0[2 * i] * p2[2 * i] + w1[2 * i] * p1[2 * i] + w2[2 * i] * cur[2 * i]);
                                           y[2 * i + 1] = bfhi(bb[q][i]) * (w0[2 * i + 1] * p2[2 * i + 1] + w1[2 * i + 1] * p1[2 * i + 1] + w2[2 * i + 1] * cur[2 * i + 1]); }
            u32x4 o; o.x = pk2(y[0], y[1]); o.y = pk2(y[2], y[3]); o.z = pk2(y[4], y[5]); o.w = pk2(y[6], y[7]);
            *(u32x4*)(mix + (size_t)(t0 + tb + q) * DM + c0) = o;
#pragma unroll
            for (int i = 0; i < 8; ++i) { p2[i] = p1[i]; p1[i] = cur[i]; }
        }
    }
}
__device__ __forceinline__ void p2_mem_block(Frame& F, int blk, int lane_) {
    const bf16_t* proj = (const bf16_t*)(F.ws + WS_PROJ); bf16_t* mix = (bf16_t*)(F.ws + WS_MIX);
    const bf16_t* kmb = (const bf16_t*)(F.ws + WS_KMB); const bf16_t* vmt = (const bf16_t*)(F.ws + WS_VMT);
    const int r32 = lane_ & 31, hi = lane_ >> 5, b = blk >> 5, tw = blk * 256 + F.wave * 32, tid_ = F.wave * 64 + lane_;
    LAS unsigned char* Kl = F.lds; LAS unsigned char* Vl = F.lds + 32768;
    const int ksw = (r32 >> 1) & 7;
    u32x4 kv[4], vv[4];
#define MEM_LOAD(hm_) do { _Pragma("unroll") for (int i = 0; i < 4; ++i) { const int idx = tid_ + 512 * i; \
        kv[i] = *(const u32x4*)(kmb + (size_t)(b * 256 + (idx >> 3)) * 256 + (hm_) * 64 + (idx & 7) * 8); \
        vv[i] = *(const u32x4*)(vmt + ((size_t)((b * 4 + (hm_)) * 64 + (idx >> 5))) * 256 + (idx & 31) * 8); } } while (0)
    MEM_LOAD(0);
    for (int hm = 0; hm < 4; ++hm) {
        bf16x8 qr[4];
#pragma unroll
        for (int d0 = 0; d0 < 4; ++d0) qr[d0] = *(const bf16x8*)(proj + (size_t)(tw + r32) * INW + COL_QM + hm * 64 + d0 * 16 + hi * 8);
        __syncthreads();
#pragma unroll
        for (int i = 0; i < 4; ++i) { const int idx = tid_ + 512 * i; const int kr = idx >> 3, kc = idx & 7, vd = idx >> 5, vc = idx & 31;
            *(LAS u32x4*)(Kl + kr * 128 + ((kc ^ ((kr >> 1) & 7)) << 4)) = kv[i];
            *(LAS u32x4*)(Vl + vd * 512 + ((vc ^ (vd & 31)) << 4)) = vv[i]; }
        __syncthreads();
        if (hm < 3) MEM_LOAD(hm + 1);
        float mx = -__builtin_inff();
#pragma unroll 2
        for (int kb = 0; kb < 8; ++kb) { f32x16 p = f32x16{};
#pragma unroll
            for (int d0 = 0; d0 < 4; ++d0) { const bf16x8 kf = *(const LAS bf16x8*)(Kl + (kb * 32 + r32) * 128 + (((2 * d0 + hi) ^ ksw) << 4));
                p = __builtin_amdgcn_mfma_f32_32x32x16_bf16(kf, qr[d0], p, 0, 0, 0); }
#pragma unroll
            for (int r = 0; r < 16; ++r) mx = fmaxf(mx, p[r]); }
        mx = fmaxf(mx, __shfl_xor(mx, 32));
        float sum = 0.f;
        f32x16 o[2]; o[0] = f32x16{}; o[1] = f32x16{};
#pragma unroll 2
        for (int kb = 0; kb < 8; ++kb) { f32x16 p = f32x16{};
#pragma unroll
            for (int d0 = 0; d0 < 4; ++d0) { const bf16x8 kf = *(const LAS bf16x8*)(Kl + (kb * 32 + r32) * 128 + (((2 * d0 + hi) ^ ksw) << 4));
                p = __builtin_amdgcn_mfma_f32_32x32x16_bf16(kf, qr[d0], p, 0, 0, 0); }
#pragma unroll
            for (int r = 0; r < 16; ++r) { p[r] = __builtin_amdgcn_exp2f(p[r] - mx); sum += p[r]; }
            bf16x8 pa0, pa1;
#define PK4(P, B_, OUT) do { unsigned a0 = pk2(P[B_+0], P[B_+1]), a1 = pk2(P[B_+2], P[B_+3]); unsigned b0 = pk2(P[B_+4], P[B_+5]), b1 = pk2(P[B_+6], P[B_+7]); \
        auto r0 = __builtin_amdgcn_permlane32_swap(a0, b0, false, false); auto r1 = __builtin_amdgcn_permlane32_swap(a1, b1, false, false); \
        u32x4 w = {r0[0], r1[0], r0[1], r1[1]}; OUT = __builtin_bit_cast(bf16x8, w); } while (0)
            PK4(p, 0, pa0); PK4(p, 8, pa1);
#undef PK4
#pragma unroll
            for (int d0 = 0; d0 < 2; ++d0) { const LAS unsigned char* vrow = Vl + (d0 * 32 + r32) * 512;
                const bf16x8 v0 = *(const LAS bf16x8*)(vrow + (((kb * 4 + hi) ^ r32) << 4)), v1 = *(const LAS bf16x8*)(vrow + (((kb * 4 + 2 + hi) ^ r32) << 4));
                o[d0] = __builtin_amdgcn_mfma_f32_32x32x16_bf16(pa0, v0, o[d0], 0, 0, 0);
                o[d0] = __builtin_amdgcn_mfma_f32_32x32x16_bf16(pa1, v1, o[d0], 0, 0, 0); }
        }
        sum += __shfl_xor(sum, 32);
        const float linv = __builtin_amdgcn_rcpf(sum);
#pragma unroll
        for (int r = 0; r < 16; ++r) { const int orow = crow(r, hi); const float li = __shfl(linv, orow);
#pragma unroll
            for (int d0 = 0; d0 < 2; ++d0) { const float v = o[d0][r] * li; const float vn = __shfl_xor(v, 1);
                if ((r32 & 1) == 0) *(unsigned*)(mix + (size_t)(tw + orow) * DM + 768 + hm * 64 + d0 * 32 + r32) = pk2(v, vn); } }
    }
#undef MEM_LOAD
    __syncthreads();
}
__device__ __forceinline__ dattn::Ref da_ref(Frame& F, int n) {
    const int pid = F.vcu + (n >> 2) * F.G, sub = n & 3, blk = sub >> 1, comp = sub & 1, bh = pid >> 4, s = pid & 15, qb = blk ? 31 - s : s, b = bh >> 2, h = bh & 3;
    bf16_t* mix = (bf16_t*)(F.ws + WS_MIX);
    dattn::Ref r;
    r.qoff = (unsigned)(((size_t)(b * SEQ + qb * 256) * INW + COL_Q + h * 128 + comp * 64) * 2);
    r.koff = (unsigned)(((size_t)(b * SEQ) * INW + COL_K + h * 128 + comp * 64) * 2);
    r.voff = (unsigned)(((size_t)(b * SEQ) * INW + COL_V + h * 128) * 2);
    r.O = mix + (size_t)(b * SEQ + qb * 256) * DM + 256 + h * 128;
    r.P0 = qb * 256; r.comp = comp; r.h = h;
    return r;
}
__device__ __forceinline__ void p2_mixers(Frame& F) {
    KArgs A = kargs();
    const float* rel_bias = A->in[I_RELB]; const float* lam_qk = A->in[I_LAMQK]; const float* subln_g = A->in[I_SUBG];
    if (F.tid < 512) { const int h = F.tid >> 7, n = F.tid & 127; int bk;
        if (n < 16) bk = n; else { bk = 16; const int thr[15] = {19, 21, 24, 27, 31, 35, 40, 46, 52, 59, 67, 77, 87, 99, 113};
#pragma unroll
            for (int i = 0; i < 15; ++i) bk += (n >= thr[i]) ? 1 : 0; }
        ((LAS float*)(F.lds + dattn::OFF_TB))[h * 128 + n] = (rel_bias[bk * 4 + h] - rel_bias[31 * 4 + h]) * LOG2E; }
    float d1 = 0.f, d2 = 0.f;
    for (int i = 0; i < 64; ++i) { d1 += lam_qk[i] * lam_qk[64 + i]; d2 += lam_qk[128 + i] * lam_qk[192 + i]; }
    const float lam = __expf(d1) - __expf(d2) + 0.2f;
    if (__builtin_amdgcn_readfirstlane(F.tid) >= 256) __builtin_amdgcn_s_setprio(1);
    __syncthreads();
    const int npairs = F.vcu < 512 ? (512 - F.vcu + F.G - 1) / F.G : 0, total1 = 4 * npairs, total = ((PROBE_REP >> 2) & 1) ? 2 * total1 : total1;
#if PROBE_CLK
    const unsigned long long pc0_ = __builtin_readcyclecounter(), pr0_ = __builtin_amdgcn_s_memrealtime();
#endif
    if (total > 0) {
        dattn::Seam S; dattn::Ref cur = da_ref(F, 0);
#if PROBE_SEG
        S.acc = 0; S.tot = 0;
#endif
        const dattn::rsrc_t R = __builtin_amdgcn_make_buffer_rsrc((void*)(F.ws + WS_PROJ), 0, (int)((size_t)T * INW * 2), 0x00020000);
        const char* projb = (const char*)(F.ws + WS_PROJ);
        dattn::prime(cur, F.lds, S, R, projb);
        for (int n = 0; n < total; ++n) {
            const dattn::Ref nxt = (n + 1 < total) ? da_ref(F, (n + 1) % total1) : cur;
            dattn::block(cur, nxt, F.lds, S, lam, subln_g, R, projb);
            cur = nxt;
        }
#if PROBE_SEG
        if (blockIdx.x == 0 && F.tid == 0) { F.ctl[604] = (unsigned)(S.acc >> 4); F.ctl[605] = (unsigned)(S.tot >> 4); }
#endif
    }
#if PROBE_CLK
    if (blockIdx.x == 0 && F.tid == 0) { const unsigned long long dc_ = __builtin_readcyclecounter() - pc0_, dr_ = __builtin_amdgcn_s_memrealtime() - pr0_;
        F.ctl[600] = (unsigned)dc_; F.ctl[601] = (unsigned)(dc_ >> 32); F.ctl[602] = (unsigned)dr_; }
#endif
    __builtin_amdgcn_s_setprio(0);
    int lane2 = (int)__builtin_amdgcn_mbcnt_hi(~0u, __builtin_amdgcn_mbcnt_lo(~0u, 0u)); asm volatile("" : "+v"(lane2));
    const int tid2 = F.wave * 64 + lane2;
    const float* conv_w = kargs()->in[I_CONVW];
    for (int repx_ = 0; repx_ < ((PROBE_X & 1) ? 2 : 1); ++repx_)
    for (int blk = blockIdx.x; blk < T / 256; blk += F.G) { p2_conv_block(F, blk, tid2, conv_w); p2_mem_block(F, blk, lane2); }
}

__device__ __forceinline__ void p4_router(Frame& F, bool dry = false) {
    const float* router_b = kargs()->in[I_RB];
    const bf16_t* x1b = (const bf16_t*)(F.ws + WS_X1B); const bf16_t* wrh = (const bf16_t*)(F.ws + WS_WRHI); const bf16_t* wrl = (const bf16_t*)(F.ws + WS_WRLO);
    int* e_tk = (int*)(F.ws + WS_ETK); float* g_tk = (float*)(F.ws + WS_GTK); float* rstd_t = (float*)(F.ws + WS_RSTDT);
    LAS float* lg = (LAS float*)F.lds + F.wave * (32 * 33); LAS unsigned* hist = (LAS unsigned*)(F.lds + 8 * 32 * 33 * 4);
    const int r32 = F.lane & 31, hi = F.lane >> 5;
    for (int blk = blockIdx.x; blk < T / 256; blk += F.G) {
        if (F.tid < 32) hist[F.tid] = 0u;
        __syncthreads();
        const int t0 = blk * 256 + F.wave * 32;
        const bf16_t* xr = x1b + (size_t)(t0 + r32) * DM + hi * 8; const bf16_t* wh = wrh + (size_t)r32 * DM + hi * 8; const bf16_t* wl = wrl + (size_t)r32 * DM + hi * 8;
        f32x16 acc = f32x16{}; float ss = 0.f;
#pragma unroll 1
        for (int kq = 0; kq < DM; kq += 256) {
            u32x4 xw[16];
#pragma unroll
            for (int s_ = 0; s_ < 16; ++s_) xw[s_] = *(const u32x4*)(xr + kq + s_ * 16);
            SBAR();
#pragma unroll
            for (int sb = 0; sb < 16; sb += 4) { bf16x8 ah[4], al[4];
#pragma unroll
                for (int s_ = 0; s_ < 4; ++s_) { ah[s_] = *(const bf16x8*)(wh + kq + (sb + s_) * 16); al[s_] = *(const bf16x8*)(wl + kq + (sb + s_) * 16); }
#pragma unroll
                for (int s_ = 0; s_ < 4; ++s_) { const u32x4 xv = xw[sb + s_];
#pragma unroll
                    for (int i = 0; i < 4; ++i) { const float a = bflo(xv[i]), b2 = bfhi(xv[i]); ss += a * a + b2 * b2; }
                    const bf16x8 xb = __builtin_bit_cast(bf16x8, xv);
                    acc = __builtin_amdgcn_mfma_f32_32x32x16_bf16(ah[s_], xb, acc, 0, 0, 0);
                    acc = __builtin_amdgcn_mfma_f32_32x32x16_bf16(al[s_], xb, acc, 0, 0, 0); } }
        }
        ss += __shfl_xor(ss, 32);
        const float rstd = rsqrtf(ss * (1.f / DM) + EPS);
#pragma unroll
        for (int r = 0; r < 16; ++r) { const int e = crow(r, hi); lg[r32 * 33 + e] = acc[r] * rstd + router_b[e]; }
        LDS_WAIT(); asm volatile("" ::: "memory");
        if (F.lane < 32) {
            LAS float* row = lg + F.lane * 33; float tv[4]; int ti[4];
#pragma unroll
            for (int p = 0; p < 4; ++p) { float best = -__builtin_inff(); int bi = 0;
                for (int e = 0; e < NEXP; ++e) { const float v = row[e]; if (v > best) { best = v; bi = e; } }
                tv[p] = best; ti[p] = bi; row[bi] = -__builtin_inff(); LDS_WAIT(); asm volatile("" ::: "memory"); }
            const float w1 = __expf(tv[1] - tv[0]), w2 = __expf(tv[2] - tv[0]), w3 = __expf(tv[3] - tv[0]); const float inv = 1.f / (1.f + w1 + w2 + w3);
            const int t = t0 + F.lane;
            if (!dry) {
            *(int4*)(e_tk + (size_t)t * 4) = make_int4(ti[0], ti[1], ti[2], ti[3]);
            *(float4*)(g_tk + (size_t)t * 4) = make_float4(inv, w1 * inv, w2 * inv, w3 * inv);
            rstd_t[t] = rstd;
#pragma unroll
            for (int p = 0; p < 4; ++p) __hip_atomic_fetch_add(&hist[ti[p]], 1u, __ATOMIC_RELAXED, __HIP_MEMORY_SCOPE_WORKGROUP);
            }
        }
        __syncthreads();
        if (F.tid < 32) __hip_atomic_fetch_add(F.ctl + CW_COUNT + F.tid, hist[F.tid], RLX_AGENT);
        __syncthreads();
    }
}
__device__ __forceinline__ void p5_place(Frame& F) {
    const int* e_tk = (const int*)(F.ws + WS_ETK); const float* g_tk = (const float*)(F.ws + WS_GTK); const float* rstd_t = (const float*)(F.ws + WS_RSTDT);
    int* slot_tk = (int*)(F.ws + WS_SLOTTK); int* tok_slot = (int*)(F.ws + WS_TOKSLOT); float* gate_slot = (float*)(F.ws + WS_GATESLOT); float* rstd_slot = (float*)(F.ws + WS_RSTDSLOT);
    int* rb_e = (int*)(F.ws + WS_RBE);
    LAS int* L = (LAS int*)F.lds;
    if (F.tid < 32) { const int c = (int)__hip_atomic_load(F.ctl + CW_COUNT + F.tid, RLX_AGENT); L[F.tid] = c; L[32 + F.tid] = (c + 255) & ~255; }
    __syncthreads();
    if (F.tid < 32) { int s = 0; for (int e = 0; e < F.tid; ++e) s += L[32 + e]; L[64 + F.tid] = s; }
    __syncthreads();
    for (int blk = blockIdx.x; blk < T / 256; blk += F.G) {
        if (F.tid < 32) { L[96 + F.tid] = 0; L[128 + F.tid] = 0; }
        __syncthreads();
        int ee[2];
#pragma unroll
        for (int j = 0; j < 2; ++j) { const int i = F.tid + 512 * j; ee[j] = e_tk[(size_t)blk * 1024 + i]; __hip_atomic_fetch_add(&L[96 + ee[j]], 1, __ATOMIC_RELAXED, __HIP_MEMORY_SCOPE_WORKGROUP); }
        __syncthreads();
        if (F.tid < 32) L[160 + F.tid] = L[64 + F.tid] + (int)__hip_atomic_fetch_add(F.ctl + CW_CURSOR + F.tid, (unsigned)L[96 + F.tid], RLX_AGENT);
        __syncthreads();
#pragma unroll
        for (int j = 0; j < 2; ++j) { const int i = F.tid + 512 * j; const int r = __hip_atomic_fetch_add(&L[128 + ee[j]], 1, __ATOMIC_RELAXED, __HIP_MEMORY_SCOPE_WORKGROUP); const int pos = L[160 + ee[j]] + r;
            const int t = blk * 256 + (i >> 2);
            tok_slot[pos] = t; gate_slot[pos] = g_tk[(size_t)blk * 1024 + i]; rstd_slot[pos] = rstd_t[t]; slot_tk[(size_t)blk * 1024 + i] = pos; }
        __syncthreads();
    }
    for (int e = blockIdx.x; e < NEXP; e += F.G)
        for (int i = L[e] + F.tid; i < L[32 + e]; i += NWAVES * 64) { const int pos = L[64 + e] + i; tok_slot[pos] = 0; gate_slot[pos] = 0.f; rstd_slot[pos] = 0.f; }
    if (blockIdx.x == 0) {
        const int nrb = (L[64 + 31] + L[32 + 31]) >> 8;
        for (int rb = F.tid; rb < NRB_MAX; rb += NWAVES * 64) { int e = 31; for (int q = 0; q < 32; ++q) { if (rb * 256 >= L[64 + q] && rb * 256 < L[64 + q] + L[32 + q]) e = q; } rb_e[rb] = e; }
        if (F.tid == 0) rb_e[NRB_MAX] = nrb;
    }
}
__device__ __forceinline__ void p9_final(Frame& F) {
    const bf16_t* x1b = (const bf16_t*)(F.ws + WS_X1B); const int* slot_tk = (const int*)(F.ws + WS_SLOTTK);
    const unsigned char* Y = F.ws + WS_Y;
    const int gw = F.vcu * NWAVES + F.wave, NGW = F.G * NWAVES;
    const float* final_g = kargs()->in[I_FING];
    f32x4 gg[2][2];
#pragma unroll
    for (int j = 0; j < 2; ++j) { gg[j][0] = *(const f32x4*)(final_g + 8 * F.lane + 512 * j); gg[j][1] = *(const f32x4*)(final_g + 8 * F.lane + 512 * j + 4); }
    int4 slA = make_int4(0, 0, 0, 0), slB = slA;
    if (gw < T) { slA = *(const int4*)(slot_tk + (size_t)gw * 4); const int tb0 = (gw + NGW < T) ? gw + NGW : gw; slB = *(const int4*)(slot_tk + (size_t)tb0 * 4); }
    for (int t = gw; t < T; t += 2 * NGW) {
        const int tA = t, tB = (t + NGW < T) ? t + NGW : t;
        const int tnA = (t + 2 * NGW < T) ? t + 2 * NGW : tA, tnB = (t + 3 * NGW < T) ? t + 3 * NGW : tnA;
        const int4 nA = *(const int4*)(slot_tk + (size_t)tnA * 4), nB = *(const int4*)(slot_tk + (size_t)tnB * 4);
        const int sA[4] = {slA.x, slA.y, slA.z, slA.w}, sB[4] = {slB.x, slB.y, slB.z, slB.w};
        u32x4 xa[2], xb[2]; u32x2 ya[2][4], yb[2][4];
#pragma unroll
        for (int j = 0; j < 2; ++j) { const int c = 8 * F.lane + 512 * j;
            xa[j] = *(const u32x4*)(x1b + (size_t)tA * DM + c); xb[j] = *(const u32x4*)(x1b + (size_t)tB * DM + c);
#pragma unroll
            for (int k = 0; k < 4; ++k) { ya[j][k] = *(const u32x2*)(Y + (size_t)sA[k] * DM + c); yb[j][k] = *(const u32x2*)(Y + (size_t)sB[k] * DM + c); } }
        float va[2][8], vb[2][8]; float ssa = 0.f, ssb = 0.f;
#pragma unroll
        for (int j = 0; j < 2; ++j) {
#pragma unroll
            for (int i = 0; i < 4; ++i) { va[j][2 * i] = bflo(xa[j][i]); va[j][2 * i + 1] = bfhi(xa[j][i]); vb[j][2 * i] = bflo(xb[j][i]); vb[j][2 * i + 1] = bfhi(xb[j][i]); }
#pragma unroll
            for (int k = 0; k < 4; ++k)
#pragma unroll
                for (int w_ = 0; w_ < 2; ++w_) { const f32x2_t a0 = __builtin_amdgcn_cvt_pk_f32_fp8((int)ya[j][k][w_], false), a1 = __builtin_amdgcn_cvt_pk_f32_fp8((int)ya[j][k][w_], true);
                    const f32x2_t b0 = __builtin_amdgcn_cvt_pk_f32_fp8((int)yb[j][k][w_], false), b1 = __builtin_amdgcn_cvt_pk_f32_fp8((int)yb[j][k][w_], true);
                    va[j][4 * w_] += 0.125f * a0[0]; va[j][4 * w_ + 1] += 0.125f * a0[1]; va[j][4 * w_ + 2] += 0.125f * a1[0]; va[j][4 * w_ + 3] += 0.125f * a1[1];
                    vb[j][4 * w_] += 0.125f * b0[0]; vb[j][4 * w_ + 1] += 0.125f * b0[1]; vb[j][4 * w_ + 2] += 0.125f * b1[0]; vb[j][4 * w_ + 3] += 0.125f * b1[1]; }
#pragma unroll
            for (int i = 0; i < 8; ++i) { ssa += va[j][i] * va[j][i]; ssb += vb[j][i] * vb[j][i]; } }
        const float ra = rsqrtf(wave_sum(ssa) * (1.f / DM) + EPS), rb = rsqrtf(wave_sum(ssb) * (1.f / DM) + EPS);
#pragma unroll
        for (int j = 0; j < 2; ++j) { const int c = 8 * F.lane + 512 * j;
            f32x4 o0, o1;
            o0.x = va[j][0] * ra * gg[j][0].x; o0.y = va[j][1] * ra * gg[j][0].y; o0.z = va[j][2] * ra * gg[j][0].z; o0.w = va[j][3] * ra * gg[j][0].w;
            o1.x = va[j][4] * ra * gg[j][1].x; o1.y = va[j][5] * ra * gg[j][1].y; o1.z = va[j][6] * ra * gg[j][1].z; o1.w = va[j][7] * ra * gg[j][1].w;
            *(f32x4*)(F.out + (size_t)tA * DM + c) = o0; *(f32x4*)(F.out + (size_t)tA * DM + c + 4) = o1;
            o0.x = vb[j][0] * rb * gg[j][0].x; o0.y = vb[j][1] * rb * gg[j][0].y; o0.z = vb[j][2] * rb * gg[j][0].z; o0.w = vb[j][3] * rb * gg[j][0].w;
            o1.x = vb[j][4] * rb * gg[j][1].x; o1.y = vb[j][5] * rb * gg[j][1].y; o1.z = vb[j][6] * rb * gg[j][1].z; o1.w = vb[j][7] * rb * gg[j][1].w;
            *(f32x4*)(F.out + (size_t)tB * DM + c) = o0; *(f32x4*)(F.out + (size_t)tB * DM + c + 4) = o1; }
        slA = nA; slB = nB;
    }
}

__global__ void __launch_bounds__(NWAVES * 64, 2) hymba_fwd(Args args) {
    extern __shared__ __attribute__((aligned(16))) unsigned char lds[];
    Frame F;
    F.lds = (LAS unsigned char*)lds;
    F.MISC = (volatile LAS unsigned*)(F.lds + MISC_OFF);
    F.tid = threadIdx.x; F.lane = F.tid & 63; F.wave = __builtin_amdgcn_readfirstlane(F.tid >> 6);
    F.G = gridDim.x; { const int bx = blockIdx.x; F.vcu = (F.G % 8 == 0) ? (bx % 8) * (F.G / 8) + bx / 8 : bx; }
    F.ws = args.ws; F.ctl = (unsigned*)(args.ws + WS_CTL); F.out = args.out;
    for (int u = F.tid; u < (LDS_BYTES - LDSCTL_OFF) / 4; u += NWAVES * 64) ((LAS unsigned*)(F.lds + LDSCTL_OFF))[u] = 0u;
    __syncthreads();
    XcdBarrier bar; bar.bar = F.ctl + CW_BAR; bar.x = 0; bar.st = nullptr;
    if (N_LAUNCHES == 1) bar = xcd_barrier_post(F.ctl + CW_BAR, F.MISC + 8);
#define GRID_BAR() do { if (N_LAUNCHES == 1) xcd_barrier(bar); } while (0)
    const int lo = args.ph_lo, hi = args.ph_hi;
#ifndef PH_MASK
#define PH_MASK 0x1ff
#endif
#define IN(k) (((PH_MASK >> (k)) & 1) && lo <= (k) && (k) < hi)
#define BOTH(k) (IN(k) && IN((k) + 1))
    bf16_t* const H = (bf16_t*)(F.ws + WS_H); bf16_t* const PROJ = (bf16_t*)(F.ws + WS_PROJ); bf16_t* const MIX = (bf16_t*)(F.ws + WS_MIX); bf16_t* const X1B = (bf16_t*)(F.ws + WS_X1B);
    bf16_t* const Win_t = (bf16_t*)(F.ws + WS_WIN); bf16_t* const Wout_t = (bf16_t*)(F.ws + WS_WOUT);
    const unsigned char* const Wgu_q = (const unsigned char*)F.out + OUT_WGU; const unsigned char* const Wd_q = (const unsigned char*)F.out + OUT_WD;
    unsigned char* const X1Q = F.ws + WS_X1Q; unsigned char* const ACTQ = F.ws + WS_ACTQ; unsigned char* const Yp = F.ws + WS_Y;
    const int* const tok_slot = (const int*)(F.ws + WS_TOKSLOT); const float* const gate_slot = (const float*)(F.ws + WS_GATESLOT); const float* const rstd_slot = (const float*)(F.ws + WS_RSTDSLOT);
    const int* const rb_e = (const int*)(F.ws + WS_RBE);

#define REP(k) for (int rep_ = 0; rep_ < (((PROBE_REP >> (k)) & 1) ? 2 : 1); ++rep_)
    if (IN(0)) { REP(0) p0_prologue(F); if (BOTH(0)) GRID_BAR(); }
    if (IN(1)) {
        REP(1) {
        pg8::Gemm g{H, Win_t, DM, 0, nullptr}; pg8::StaticOrder S; S.init(T, INW, F.G, (int)blockIdx.x);
        pg8::EpiProj E{PROJ};
        pg8::gemm_phase<pg8::EpiProj, pg8::StaticOrder, true>(F.lds, g, S, E); }
        if (BOTH(1)) GRID_BAR();
    }
    if (IN(2)) { p2_mixers(F); if (BOTH(2)) GRID_BAR(); }
    if (IN(3)) {
        pg8::Gemm g{MIX, Wout_t, DM, 0, nullptr}; pg8::StaticOrder S; S.init(T, DM, F.G, (int)blockIdx.x);
        pg8::EpiX1 E{kargs()->in[I_X], X1B, X1Q};
        pg8::gemm_phase<pg8::EpiX1, pg8::StaticOrder, true>(F.lds, g, S, E);
        if (BOTH(3)) GRID_BAR();
    }
    if (IN(4)) { if (PROBE_X & 2) p4_router(F, true); p4_router(F); if (BOTH(4)) GRID_BAR(); }
    if (IN(5)) { p5_place(F); if (BOTH(5)) GRID_BAR(); }
    if (IN(6)) {
        const int nrb = rb_e[NRB_MAX];
        REP(6) {
        pg8::Gemm g{(const bf16_t*)X1Q, (const bf16_t*)Wgu_q, DM / 2, (long)2048 * DM / 2, tok_slot}; pg8::GroupOrder S{nrb, 0, 8, F.G, (int)blockIdx.x, rb_e};
        pg8::EpiGU E{ACTQ, kargs()->in[I_BGU], rstd_slot};
        pg8::gemm_phase<pg8::EpiGU, pg8::GroupOrder, true, true, (PROBE_KREP == 2 ? 0x78787878 : 0x79797979), 0x7f7f7f7f, PROBE_KREP>(F.lds, g, S, E); }
        if (BOTH(6)) GRID_BAR();
    }
    if (IN(7)) {
        const int nrb = rb_e[NRB_MAX];
        REP(7) {
        pg8::Gemm g{(const bf16_t*)ACTQ, (const bf16_t*)Wd_q, DEXP / 2, (long)DM * DEXP / 2, nullptr}; pg8::GroupOrder S{nrb, 0, 4, F.G, (int)blockIdx.x, rb_e};
        pg8::EpiDown E{Yp, kargs()->in[I_BDN], gate_slot};
        pg8::gemm_phase<pg8::EpiDown, pg8::GroupOrder, true, true, 0x79797979, 0x7d7d7d7d>(F.lds, g, S, E); }
        if (BOTH(7)) GRID_BAR();
    }
    if (IN(8)) { REP(8) p9_final(F); }
#if PROBE_SEG
    if (IN(8) && blockIdx.x == 0 && F.tid == 0) { const unsigned long long a_ = F.ctl[604], t_ = F.ctl[605]; const unsigned long long us_ = t_ ? a_ * 2000ull / t_ : 0ull; const unsigned long long t0_ = __builtin_amdgcn_s_memrealtime();
        while (__builtin_amdgcn_s_memrealtime() - t0_ < us_ * 100ull) __builtin_amdgcn_s_sleep(8); }
#endif
#if PROBE_CLK
    if (IN(8) && blockIdx.x == 0 && F.tid == 0) { const unsigned long long dc_ = ((unsigned long long)F.ctl[601] << 32) | F.ctl[600]; const unsigned long long dr_ = F.ctl[602];
        const unsigned long long mhz_ = dr_ ? dc_ * 100ull / dr_ : 0ull; const unsigned long long t0_ = __builtin_amdgcn_s_memrealtime();
        while (__builtin_amdgcn_s_memrealtime() - t0_ < mhz_ * 100ull) __builtin_amdgcn_s_sleep(8); }
#endif
#undef IN
#undef BOTH
#undef GRID_BAR
}

extern "C" void kernel_launch(void* const* d_in, const int* in_sizes, int n_in, void* d_out, int out_size, void* d_ws, size_t ws_size, hipStream_t stream) {
    static int grid = 0;
    if (grid == 0) {
        if (n_in != 19 || out_size != T * DM || ws_size < WS_END) { fprintf(stderr, "kernel_launch: unexpected shapes (n_in %d out %d ws %zu)\n", n_in, out_size, ws_size); grid = -1; return; }
        int dev = 0, cus = 0;
        if (hipGetDevice(&dev) != hipSuccess || hipDeviceGetAttribute(&cus, hipDeviceAttributeMultiprocessorCount, dev) != hipSuccess) { grid = -1; return; }
        if (hipFuncSetAttribute((const void*)hymba_fwd, hipFuncAttributeMaxDynamicSharedMemorySize, LDS_BYTES) != hipSuccess) { fprintf(stderr, "kernel_launch: hipFuncSetAttribute failed\n"); grid = -1; return; }
        int per_cu = 0;
        if (hipOccupancyMaxActiveBlocksPerMultiprocessor(&per_cu, (const void*)hymba_fwd, NWAVES * 64, LDS_BYTES) != hipSuccess || per_cu < 1) fprintf(stderr, "kernel_launch: occupancy query reports %d\n", per_cu);
        (void)hipGetLastError();
        grid = cus;
    }
    if (grid < 0) return;
    if (hipMemsetAsync((char*)d_ws + WS_CTL, 0, CTL_ZERO_BYTES, stream) != hipSuccess) return;
    Args a{};
    for (int i = 0; i < 19; ++i) a.in[i] = (const float*)d_in[i];
    a.out = (float*)d_out; a.ws = (unsigned char*)d_ws;
    for (int li = 0; li < N_LAUNCHES; ++li) {
        a.ph_lo = (N_LAUNCHES == 1) ? 0 : li; a.ph_hi = (N_LAUNCHES == 1) ? N_PHASES : li + 1;
        hipLaunchKernelGGL(hymba_fwd, dim3(grid), dim3(NWAVES * 64), LDS_BYTES, stream, a);
    }
}
```

```cpp
#include <hip/hip_runtime.h>
#include <hip/hip_bf16.h>
#include <cstdio>
#include <cstdint>

#ifndef PROBE_REP
#define PROBE_REP 0
#endif
#ifndef PROBE_X
#define PROBE_X 0
#endif
#ifndef PROBE_P0
#define PROBE_P0 0
#endif
#ifndef PROBE_SEG
#define PROBE_SEG 0
#endif
#ifndef PROBE_CLK
#define PROBE_CLK 0
#endif
#ifndef PROBE_KREP
#define PROBE_KREP 1
#endif
#ifndef PROBE_EPI
#define PROBE_EPI 0
#endif
#ifndef MK_N_LAUNCHES
#define MK_N_LAUNCHES 1
#endif

constexpr int BATCH = 8, SEQ = 8192, DM = 1024, T = BATCH * SEQ, INW = 2560, MEML = 256, NEXP = 32, TOPK = 4, DEXP = 1024;
constexpr int COL_U = 0, COL_GB = 256, COL_GC = 512, COL_Q = 768, COL_K = 1280, COL_V = 1792, COL_QM = 2304;
constexpr float EPS = 1e-5f;
constexpr float C2 = 0.125f * 1.4426950408889634f;
constexpr float LOG2E = 1.4426950408889634f;
constexpr int NRB_MAX = 1056;

#define GAS __attribute__((address_space(1)))
#define LAS __attribute__((address_space(3)))
typedef unsigned short bf16_t;
typedef short bf16x8 __attribute__((ext_vector_type(8)));
typedef short s16x4 __attribute__((ext_vector_type(4)));
typedef float f32x4 __attribute__((ext_vector_type(4)));
typedef float f32x16 __attribute__((ext_vector_type(16)));
typedef unsigned u32x4 __attribute__((ext_vector_type(4)));
typedef unsigned u32x2 __attribute__((ext_vector_type(2)));
typedef float f32x2_t __attribute__((ext_vector_type(2)));
typedef __bf16 bf16x2_t __attribute__((ext_vector_type(2)));
typedef GAS unsigned gu32;
#define RLX_AGENT __ATOMIC_RELAXED, __HIP_MEMORY_SCOPE_AGENT
#define LDS_WAIT() asm volatile("s_waitcnt lgkmcnt(0)" ::: "memory")
#define VM_WAIT() asm volatile("s_waitcnt vmcnt(0)" ::: "memory")
#define SBAR() __builtin_amdgcn_sched_barrier(0)

__device__ __forceinline__ unsigned pk2(float lo, float hi) { f32x2_t v = {lo, hi}; bf16x2_t b = __builtin_convertvector(v, bf16x2_t); return __builtin_bit_cast(unsigned, b); }
__device__ __forceinline__ float bflo(unsigned u) { return __uint_as_float(u << 16); }
__device__ __forceinline__ float bfhi(unsigned u) { return __uint_as_float(u & 0xffff0000u); }
__device__ __forceinline__ bf16x8 pack8(f32x4 a, f32x4 b) { u32x4 w = {pk2(a[0], a[1]), pk2(a[2], a[3]), pk2(b[0], b[1]), pk2(b[2], b[3])}; return __builtin_bit_cast(bf16x8, w); }
__device__ __forceinline__ int crow(int r, int hi) { return (r & 3) + 8 * (r >> 2) + 4 * hi; }
__device__ __forceinline__ float wave_sum(float v) {
#pragma unroll
    for (int o = 1; o < 64; o <<= 1) v += __shfl_xor(v, o);
    return v;
}

namespace pg8 {
constexpr int BM = 256, BK = 64, HALF = 128, HTB = HALF * BK * 2  , STAGE_BYTES = 8 * HTB, NXCD = 8, WGM = 8;
__host__ __device__ __forceinline__ int lds_byte(int r, int c) { const int st = (r >> 4) * 2 + (c >> 5), rr = r & 15, cc = c & 31, ob = rr * 64 + cc * 2; return st * 1024 + (ob ^ (((ob >> 9) & 1) << 5)); }
__host__ __device__ __forceinline__ void stage_rc(int b, int& R, int& C) { const int st = b / 1024, sb = b % 1024, swz = sb ^ (((sb >> 9) & 1) << 5); R = (st >> 1) * 16 + swz / 64; C = (st & 1) * 32 + (swz % 64) / 2; }
__host__ __device__ __forceinline__ int perm32(int rho) { const int n = rho >> 4, i = rho & 15; return 8 * (i >> 2) + 4 * n + (i & 3); }

struct Unit { int pm, pn, e; };
struct Gemm { const bf16_t* A; const bf16_t* Bt; int K; long bstride; const int* rowmap; };

struct StaticOrder {
    int nM, nN, nwg, G, c;
    __device__ void init(int M, int N, int G_, int c_) { nM = M / BM; nN = N / BM; nwg = nM * nN; G = G_; c = c_; }
    __device__ bool next(int i, Unit& u) const {
        const long L = (long)i * G + c; if (L >= nwg) return false;
        int wgid = (int)L; { const int q = nwg / NXCD, r = nwg % NXCD, xcd = wgid % NXCD, off = wgid / NXCD; wgid = (xcd < r ? xcd * (q + 1) : r * (q + 1) + (xcd - r) * q) + off; }
        const int nig = WGM * nN, gid = wgid / nig, fm = gid * WGM, gsz = (nM - fm) < WGM ? (nM - fm) : WGM;
        u.pm = fm + ((wgid % nig) % gsz); u.pn = (wgid % nig) / gsz; u.e = 0; return true;
    }
};
struct GroupOrder {
    int nrb, rb0, npn, G, c; const int* rb_e;
    __device__ bool next(int i, Unit& u) const {
        int rbl, pn;
        if ((G & 7) == 0 && ((G >> 3) % npn) == 0) { const int x = c & 7, j = c >> 3, rpx = (G >> 3) / npn; rbl = i * (G / npn) + x * rpx + j / npn; pn = j % npn; }
        else { const long L = (long)i * G + c; rbl = (int)(L / npn); pn = (int)(L % npn); }
        if (rbl >= nrb) return false;
        u.pm = rb0 + rbl; u.pn = pn; u.e = rb_e[u.pm]; return true;
    }
};

typedef int v4i_t __attribute__((ext_vector_type(4)));
typedef int v8i_t __attribute__((ext_vector_type(8)));
template <class Epi, class Sched, bool ALIGN_EPI, bool FP8 = false, int SCW = 0x7f7f7f7f, int SCA = 0x7f7f7f7f, int KREP = 1>
__device__ __forceinline__ void gemm_phase(LAS unsigned char* lds, const Gemm g, const Sched& S, const Epi& E) {
    const int tid = threadIdx.x, wid = __builtin_amdgcn_readfirstlane(tid >> 6), lane = tid & 63, wr = wid >> 2, wc = wid & 3, fr = lane & 15, fq = lane >> 4;
    const int K = g.K; int nt = K / BK; asm volatile("" : "+s"(nt));
    int Rr[2], Cc[2]; unsigned voffB[2];
#pragma unroll
    for (int i = 0; i < 2; ++i) { int R, C; stage_rc(tid * 16 + i * 8192, R, C); const int Rb = Epi::PERM ? ((R & ~31) + perm32(R & 31)) : R;
        Rr[i] = R; Cc[i] = C; voffB[i] = (unsigned)(Rb * K + C) * 2u; }
    const size_t kstep = (size_t)(BK * 2);
    const size_t hstep = (size_t)HALF * K * 2;
    const size_t tstep = 2 * hstep;
    const unsigned ldsw = (unsigned)wid * 1024u;
    const int aoff = lds_byte(wr * 64 + fr, fq * 8), boff = lds_byte(wc * 32 + fr, fq * 8);
#define PG8_SA(b, h) (((b) * 2 + (h)) * HTB)
#define PG8_SB(b, h) ((4 + (b) * 2 + (h)) * HTB)
#define PG8_STAGE(bufoff, gbase, voff) do { _Pragma("unroll") for (int _i = 0; _i < 2; ++_i) \
        __builtin_amdgcn_global_load_lds((const unsigned*)((const char*)(gbase) + (voff)[_i]), (LAS unsigned*)(lds + (bufoff) + ldsw + _i * 8192), 16, 0, 0); } while (0)
#define PG8_STAGE_A(bufoff, kptr, offs, h) do { _Pragma("unroll") for (int _i = 0; _i < 2; ++_i) \
        __builtin_amdgcn_global_load_lds((const unsigned*)((const char*)(kptr) + (offs)[h][_i]), (LAS unsigned*)(lds + (bufoff) + ldsw + _i * 8192), 16, 0, 0); } while (0)
#define PG8_AOFF(dst, u) do { _Pragma("unroll") for (int _h = 0; _h < 2; ++_h) _Pragma("unroll") for (int _i = 0; _i < 2; ++_i) { const int _row = (u).pm * BM + _h * HALF + Rr[_i]; \
        const int _src = g.rowmap ? g.rowmap[_row] : _row; dst[_h][_i] = (unsigned)(_src * K + Cc[_i]) * 2u; } } while (0)
#define PG8_LDA(dst, b, h) do { _Pragma("unroll") for (int m = 0; m < 4; ++m) _Pragma("unroll") for (int k = 0; k < 2; ++k) dst[m][k] = *(const LAS bf16x8*)(lds + PG8_SA(b, h) + aoff + m * 2048 + k * 1024); } while (0)
#define PG8_LDB(dst, b, h) do { _Pragma("unroll") for (int n = 0; n < 2; ++n) _Pragma("unroll") for (int k = 0; k < 2; ++k) dst[n][k] = *(const LAS bf16x8*)(lds + PG8_SB(b, h) + boff + n * 2048 + k * 1024); } while (0)
#define PG8_CAT(x, y) __builtin_shufflevector(__builtin_bit_cast(v4i_t, x), __builtin_bit_cast(v4i_t, y), 0, 1, 2, 3, 4, 5, 6, 7)
#define PG8_MMA(ai, bj, At, Bt) do { __builtin_amdgcn_s_setprio(1); _Pragma("unroll") for (int m = 0; m < 4; ++m) _Pragma("unroll") for (int n = 0; n < 2; ++n) { \
        if constexpr (FP8) { acc[ai][bj][m][n] = __builtin_amdgcn_mfma_scale_f32_16x16x128_f8f6f4(PG8_CAT(Bt[n][0], Bt[n][1]), PG8_CAT(At[m][0], At[m][1]), acc[ai][bj][m][n], 0, 0, 0, SCW, 0, SCA); } \
        else { _Pragma("unroll") for (int k = 0; k < 2; ++k) acc[ai][bj][m][n] = __builtin_amdgcn_mfma_f32_16x16x32_bf16(Bt[n][k], At[m][k], acc[ai][bj][m][n], 0, 0, 0); } } \
        __builtin_amdgcn_s_setprio(0); } while (0)
#define PG8_WAIT_V(n) asm volatile("s_waitcnt vmcnt(" #n ")" ::: "memory")
#define PG8_WAIT_L(n) asm volatile("s_waitcnt lgkmcnt(" #n ")" ::: "memory")
#define PG8_BAR __builtin_amdgcn_s_barrier()
#define PG8_SCHED __builtin_amdgcn_sched_barrier(0)
    Unit cur, nxt; int ui = 0;
    if (!S.next(0, cur)) return;
    f32x4 acc[2][2][4][2];
#pragma unroll
    for (int a = 0; a < 2; ++a)
#pragma unroll
        for (int b = 0; b < 2; ++b)
#pragma unroll
            for (int m = 0; m < 4; ++m)
#pragma unroll
                for (int n = 0; n < 2; ++n) acc[a][b][m][n] = (f32x4){0.f, 0.f, 0.f, 0.f};
    bf16x8 At[4][2], B0[2][2], B1[2][2];
    unsigned aoc[2][2], aon[2][2];
    PG8_AOFF(aoc, cur);
    const char* Ab = (const char*)g.A;
    const char* cB = (const char*)g.Bt + ((size_t)cur.e * (size_t)g.bstride) * 2 + (size_t)cur.pn * tstep;
    PG8_STAGE(PG8_SB(0, 0), cB, voffB); PG8_STAGE(PG8_SB(0, 1), cB + hstep, voffB); PG8_STAGE_A(PG8_SA(0, 0), Ab, aoc, 0); PG8_STAGE_A(PG8_SA(0, 1), Ab, aoc, 1);
    if (wr == 1) PG8_BAR;
    PG8_WAIT_V(2); PG8_BAR;
    PG8_STAGE(PG8_SB(1, 0), cB + kstep, voffB); PG8_STAGE_A(PG8_SA(1, 0), Ab + kstep, aoc, 0); PG8_STAGE(PG8_SB(1, 1), cB + hstep + kstep, voffB);
    PG8_WAIT_V(6); PG8_BAR;
    for (;;) {
        const bool has_next = S.next(ui + 1, nxt);
        if (has_next) { PG8_AOFF(aon, nxt); }
        else {
#pragma unroll
            for (int h = 0; h < 2; ++h)
#pragma unroll
                for (int i = 0; i < 2; ++i) aon[h][i] = aoc[h][i];
        }
        const char* nB = has_next ? (const char*)g.Bt + ((size_t)nxt.e * (size_t)g.bstride) * 2 + (size_t)nxt.pn * tstep : cB;
#pragma nounroll
        for (int t = 0; t < nt * KREP; t += 2) {
            const bool last = (t == nt * KREP - 2);
            const char* a1 = Ab + (size_t)((t + 1) & (nt - 1)) * kstep;
            const char* a2 = last ? Ab : Ab + (size_t)((t + 2) & (nt - 1)) * kstep; const char* b2 = last ? nB : cB + (size_t)((t + 2) & (nt - 1)) * kstep;
            const char* a3 = a2 + kstep; const char* b3 = b2 + kstep;
            PG8_LDB(B0, 0, 0); PG8_LDB(B1, 0, 1); PG8_SCHED; PG8_LDA(At, 0, 0); PG8_STAGE_A(PG8_SA(1, 1), a1, aoc, 1);
            if (last) {
#pragma unroll
                for (int h = 0; h < 2; ++h)
#pragma unroll
                    for (int i = 0; i < 2; ++i) aoc[h][i] = aon[h][i]; }
            PG8_WAIT_V(8); PG8_WAIT_L(0); PG8_BAR; PG8_MMA(0, 0, At, B0); PG8_MMA(0, 1, At, B1); PG8_BAR; PG8_SCHED;
            PG8_LDA(At, 0, 1); PG8_STAGE(PG8_SB(0, 0), b2, voffB); PG8_STAGE(PG8_SB(0, 1), b2 + hstep, voffB); PG8_STAGE_A(PG8_SA(0, 0), a2, aoc, 0);
            PG8_WAIT_V(8); PG8_WAIT_L(0); PG8_BAR; PG8_MMA(1, 0, At, B0); PG8_MMA(1, 1, At, B1); PG8_BAR; PG8_SCHED;
            PG8_LDB(B0, 1, 0); PG8_LDB(B1, 1, 1); PG8_SCHED; PG8_LDA(At, 1, 0); PG8_STAGE_A(PG8_SA(0, 1), a2, aoc, 1);
            PG8_WAIT_V(8); PG8_WAIT_L(0); PG8_BAR; PG8_MMA(0, 0, At, B0); PG8_MMA(0, 1, At, B1); PG8_BAR; PG8_SCHED;
            PG8_LDA(At, 1, 1); PG8_STAGE(PG8_SB(1, 0), b3, voffB); PG8_STAGE(PG8_SB(1, 1), b3 + hstep, voffB); PG8_STAGE_A(PG8_SA(1, 0), a3, aoc, 0);
            PG8_WAIT_V(8); PG8_WAIT_L(0); PG8_BAR; PG8_MMA(1, 0, At, B0); PG8_MMA(1, 1, At, B1); PG8_BAR; PG8_SCHED;
        }
        if constexpr (ALIGN_EPI) { if (wr == 0) PG8_BAR; }
        E(acc, cur, wr, wc, fr, fq);
        if constexpr (FP8 && PROBE_EPI != 0) { asm volatile("" ::: "memory"); E(acc, cur, wr, wc, fr, fq); }
        if (!has_next) break;
#pragma unroll
        for (int a = 0; a < 2; ++a)
#pragma unroll
            for (int b = 0; b < 2; ++b)
#pragma unroll
                for (int m = 0; m < 4; ++m)
#pragma unroll
                    for (int n = 0; n < 2; ++n) acc[a][b][m][n] = (f32x4){0.f, 0.f, 0.f, 0.f};
        cur = nxt; cB = nB; ++ui;
        if constexpr (ALIGN_EPI) { if (wr == 1) PG8_BAR; }
    }
    PG8_WAIT_V(0);
    if constexpr (!ALIGN_EPI) { if (wr == 0) PG8_BAR; }
    PG8_BAR;
#undef PG8_SA
#undef PG8_SB
#undef PG8_STAGE
#undef PG8_STAGE_A
#undef PG8_AOFF
#undef PG8_LDA
#undef PG8_LDB
#undef PG8_MMA
#undef PG8_CAT
#undef PG8_WAIT_V
#undef PG8_WAIT_L
#undef PG8_BAR
#undef PG8_SCHED
}

struct EpiProj {
    static constexpr bool PERM = true;
    bf16_t* O;
    __device__ __forceinline__ void operator()(const f32x4 (&acc)[2][2][4][2], const Unit& u, int wr, int wc, int fr, int fq) const {
        const int row0 = u.pm * BM + wr * 64 + fr, col0 = u.pn * BM + wc * 32 + 8 * fq;
        const float sc = (u.pn == 3 || u.pn == 4 || u.pn == 9) ? C2 : 1.f;
#pragma unroll
        for (int ai = 0; ai < 2; ++ai)
#pragma unroll
            for (int m = 0; m < 4; ++m) { bf16_t* rowp = O + (size_t)(row0 + ai * HALF + m * 16) * INW + col0;
#pragma unroll
                for (int bj = 0; bj < 2; ++bj) { const f32x4 v0 = acc[ai][bj][m][0] * sc, v1 = acc[ai][bj][m][1] * sc;
                    u32x4 w; w.x = pk2(v0[0], v0[1]); w.y = pk2(v0[2], v0[3]); w.z = pk2(v1[0], v1[1]); w.w = pk2(v1[2], v1[3]);
                    *(u32x4*)(rowp + bj * HALF) = w; } }
    }
};
__device__ __forceinline__ unsigned pk4_fp8(float a, float b, float c, float d) { int w = 0; w = __builtin_amdgcn_cvt_pk_fp8_f32(a, b, w, false); w = __builtin_amdgcn_cvt_pk_fp8_f32(c, d, w, true); return (unsigned)w; }
struct EpiX1 {
    static constexpr bool PERM = true;
    const float* X; bf16_t* O; unsigned char* Q8;
    __device__ __forceinline__ void operator()(const f32x4 (&acc)[2][2][4][2], const Unit& u, int wr, int wc, int fr, int fq) const {
        const int row0 = u.pm * BM + wr * 64 + fr, col0 = u.pn * BM + wc * 32 + 8 * fq;
        const float* __restrict__ Xr = X; bf16_t* __restrict__ Or = O; unsigned char* __restrict__ Qr = Q8;
#pragma unroll
        for (int ai = 0; ai < 2; ++ai) {
            f32x4 xv[4][2][2];
#pragma unroll
            for (int m = 0; m < 4; ++m) { const size_t off = (size_t)(row0 + ai * HALF + m * 16) * DM + col0;
#pragma unroll
                for (int bj = 0; bj < 2; ++bj) { xv[m][bj][0] = *(const f32x4*)(Xr + off + bj * HALF); xv[m][bj][1] = *(const f32x4*)(Xr + off + bj * HALF + 4); } }
#pragma unroll
            for (int m = 0; m < 4; ++m) { const size_t off = (size_t)(row0 + ai * HALF + m * 16) * DM + col0;
#pragma unroll
                for (int bj = 0; bj < 2; ++bj) { const f32x4 v0 = acc[ai][bj][m][0] + xv[m][bj][0], v1 = acc[ai][bj][m][1] + xv[m][bj][1];
                    u32x4 w; w.x = pk2(v0[0], v0[1]); w.y = pk2(v0[2], v0[3]); w.z = pk2(v1[0], v1[1]); w.w = pk2(v1[2], v1[3]);
                    *(u32x4*)(Or + off + bj * HALF) = w;
                    u32x2 q; q.x = pk4_fp8(v0[0], v0[1], v0[2], v0[3]); q.y = pk4_fp8(v1[0], v1[1], v1[2], v1[3]);
                    *(u32x2*)(Qr + off + bj * HALF) = q; } }
        }
    }
};
struct EpiGU {
    static constexpr bool PERM = true;
    unsigned char* ACT; const float* bias; const float* rstd;
    __device__ __forceinline__ void operator()(const f32x4 (&acc)[2][2][4][2], const Unit& u, int wr, int wc, int fr, int fq) const {
        const int row0 = u.pm * BM + wr * 64 + fr, j0 = u.pn * HALF + wc * 32 + 8 * fq;
        const float* bp = bias + (size_t)u.e * 2048 + j0;
        const f32x4 bg0 = *(const f32x4*)(bp), bg1 = *(const f32x4*)(bp + 4), bu0 = *(const f32x4*)(bp + 1024), bu1 = *(const f32x4*)(bp + 1028);
        float rsv[2][4];
#pragma unroll
        for (int ai = 0; ai < 2; ++ai)
#pragma unroll
            for (int m = 0; m < 4; ++m) rsv[ai][m] = rstd[row0 + ai * HALF + m * 16];
#pragma unroll
        for (int ai = 0; ai < 2; ++ai)
#pragma unroll
            for (int m = 0; m < 4; ++m) { const int row = row0 + ai * HALF + m * 16; const float rs = rsv[ai][m];
                float o[8];
#pragma unroll
                for (int h2 = 0; h2 < 2; ++h2) { const f32x4 ga = h2 ? acc[ai][0][m][1] : acc[ai][0][m][0], ua = h2 ? acc[ai][1][m][1] : acc[ai][1][m][0], gb = h2 ? bg1 : bg0, ub = h2 ? bu1 : bu0;
#pragma unroll
                    for (int p2 = 0; p2 < 2; ++p2) { const f32x2_t gacc = {ga[2 * p2], ga[2 * p2 + 1]}, uacc = {ua[2 * p2], ua[2 * p2 + 1]}, gbv = {gb[2 * p2], gb[2 * p2 + 1]}, ubv = {ub[2 * p2], ub[2 * p2 + 1]};
                        f32x2_t gg = gacc * rs + gbv, uu = uacc * rs + ubv;
                        gg[0] = fminf(gg[0], 7.f); gg[1] = fminf(gg[1], 7.f); uu[0] = __builtin_amdgcn_fmed3f(uu[0], -7.f, 7.f); uu[1] = __builtin_amdgcn_fmed3f(uu[1], -7.f, 7.f);
                        const f32x2_t tt = gg * (-1.702f * LOG2E); f32x2_t ee; ee[0] = __builtin_amdgcn_exp2f(tt[0]); ee[1] = __builtin_amdgcn_exp2f(tt[1]);
                        const f32x2_t dd = ee * 0.25f + 0.25f; f32x2_t rr; rr[0] = __builtin_amdgcn_rcpf(dd[0]); rr[1] = __builtin_amdgcn_rcpf(dd[1]);
                        const f32x2_t s4 = gg * rr, oo = uu * s4 + s4;
                        o[4 * h2 + 2 * p2] = oo[0]; o[4 * h2 + 2 * p2 + 1] = oo[1]; } }
                u32x2 w; w.x = pk4_fp8(o[0], o[1], o[2], o[3]); w.y = pk4_fp8(o[4], o[5], o[6], o[7]);
                *(u32x2*)(ACT + (size_t)row * DEXP + j0) = w; }
    }
};
struct EpiDown {
    static constexpr bool PERM = true;
    unsigned char* Y; const float* bias; const float* gate;
    __device__ __forceinline__ void operator()(const f32x4 (&acc)[2][2][4][2], const Unit& u, int wr, int wc, int fr, int fq) const {
        const int row0 = u.pm * BM + wr * 64 + fr, col0 = u.pn * BM + wc * 32 + 8 * fq;
        const float* bp = bias + (size_t)u.e * DM + col0;
        f32x4 bv[2][2];
#pragma unroll
        for (int bj = 0; bj < 2; ++bj) { bv[bj][0] = *(const f32x4*)(bp + bj * HALF); bv[bj][1] = *(const f32x4*)(bp + bj * HALF + 4); }
        float gsv[2][4];
#pragma unroll
        for (int ai = 0; ai < 2; ++ai)
#pragma unroll
            for (int m = 0; m < 4; ++m) gsv[ai][m] = 8.f * gate[row0 + ai * HALF + m * 16];
#pragma unroll
        for (int ai = 0; ai < 2; ++ai)
#pragma unroll
            for (int m = 0; m < 4; ++m) { const int row = row0 + ai * HALF + m * 16; const float gs = gsv[ai][m];
#pragma unroll
                for (int bj = 0; bj < 2; ++bj) { const f32x4 v0 = (acc[ai][bj][m][0] + bv[bj][0]) * gs, v1 = (acc[ai][bj][m][1] + bv[bj][1]) * gs;
                    u32x2 w; w.x = pk4_fp8(v0[0], v0[1], v0[2], v0[3]); w.y = pk4_fp8(v1[0], v1[1], v1[2], v1[3]);
                    *(u32x2*)(Y + (size_t)row * DM + col0 + bj * HALF) = w; } }
    }
};
}

namespace dattn {
constexpr int NW = 8, QBLK = 32, KVBLK = 64, QB = 256, PITCH = INW;
constexpr int SHM_V = KVBLK * 128 * 2, SHM_K = KVBLK * 64 * 2;
constexpr int NVS = 4, NKS = 3;
constexpr int OFF_V = 0, OFF_K = NVS * SHM_V, OFF_WS = OFF_K + NKS * SHM_K, OFF_STASH = OFF_WS + NW * 64 * 4, OFF_TB = OFF_STASH + NW * 8192, LDS_BYTES = OFF_TB + 4 * 128 * 4;
constexpr float THR = 8.f;
__device__ __forceinline__ int v_st(int k, int c) { const int kk = k;     return ((kk >> 3) * 4 + (c >> 5)) * 512 + ((kk & 7) * 32 + (c & 31)) * 2; }
__device__ __forceinline__ int v_rd_base(int lane) { return ((lane & 3) << 3) | (((lane >> 2) & 3) << 6) | (((lane >> 4) & 1) << 5) | (((lane >> 5) & 1) << 8); }
constexpr int v_rd_off(int d0, int ks, int half) { return d0 * 512 + ks * 4096 + half * 2048; }

struct Ref { unsigned qoff, koff, voff; bf16_t* O; int P0, comp, h; };
typedef __amdgpu_buffer_rsrc_t rsrc_t;
__device__ __forceinline__ bf16x8 bld8(rsrc_t r, unsigned voff, unsigned soff) { return __builtin_bit_cast(bf16x8, __builtin_amdgcn_raw_buffer_load_b128(r, (int)voff, (int)soff, 0)); }
struct Seam { bf16x8 qr[4]; int ks, vs;
#if PROBE_SEG
    unsigned long long acc, tot;
#endif
};

__device__ __forceinline__ bf16x8 ld8(const bf16_t* p) { return *reinterpret_cast<const bf16x8*>(p); }

__device__ __forceinline__ void bias_mask(f32x16& p0, f32x16& p1, int sdq  , const LAS float* tb) {
    const float NEG = -__builtin_inff();
    int lane_ = (int)__builtin_amdgcn_mbcnt_hi(~0u, __builtin_amdgcn_mbcnt_lo(~0u, 0u));
    int dq = sdq + (lane_ & 31) - 4 * (lane_ >> 5);
    asm volatile("" : "+v"(dq));
#pragma unroll
    for (int r = 0; r < 16; ++r) {
        const int c = (r & 3) + 8 * (r >> 2);
        const int d0 = dq - c, d1 = dq - c - 32;
        const int i0 = d0 < 0 ? 0 : (d0 > 127 ? 127 : d0), i1 = d1 < 0 ? 0 : (d1 > 127 ? 127 : d1);
        const float b0 = tb[i0], b1 = tb[i1];
        p0[r] = d0 < 0 ? NEG : p0[r] + b0;
        p1[r] = d1 < 0 ? NEG : p1[r] + b1;
    }
}
__device__ __forceinline__ void partialSM(f32x16& p0, f32x16& p1, float& m_reg, float& alpha) {
    float pmax = p0[0];
#pragma unroll
    for (int r = 1; r < 16; ++r) pmax = fmaxf(pmax, p0[r]);
#pragma unroll
    for (int r = 0; r < 16; ++r) pmax = fmaxf(pmax, p1[r]);
    { auto rr = __builtin_amdgcn_permlane32_swap(__float_as_uint(pmax), __float_as_uint(pmax), false, false);
      pmax = fmaxf(__uint_as_float(rr[0]), __uint_as_float(rr[1])); }
    float mn;
    if (__builtin_expect(__all((pmax - m_reg) <= THR), 1)) { mn = m_reg; alpha = 1.f; }
    else { mn = fmaxf(m_reg, pmax); alpha = __builtin_amdgcn_exp2f(m_reg - mn); m_reg = mn; }
#pragma unroll
    for (int r = 0; r < 16; ++r) p0[r] = p0[r] - mn;
#pragma unroll
    for (int r = 0; r < 16; ++r) p1[r] = p1[r] - mn;
#pragma unroll
    for (int r = 0; r < 16; ++r) p0[r] = __builtin_amdgcn_exp2f(p0[r]);
}
__device__ __forceinline__ void finishSM(f32x16& p0, f32x16& p1, float alpha, float& l_reg, bf16x8& pa0, bf16x8& pa1, bf16x8& pa2, bf16x8& pa3) {
#pragma unroll
    for (int r = 0; r < 16; ++r) p1[r] = __builtin_amdgcn_exp2f(p1[r]);
    float ps = 0;
#pragma unroll
    for (int r = 0; r < 16; ++r) ps += p0[r];
#pragma unroll
    for (int r = 0; r < 16; ++r) ps += p1[r];
    { auto rr = __builtin_amdgcn_permlane32_swap(__float_as_uint(ps), __float_as_uint(ps), false, false);
      ps = __uint_as_float(rr[0]) + __uint_as_float(rr[1]); }
    l_reg = l_reg * alpha + ps;
#define PK4(P, B_, OUT) do { unsigned a0 = pk2(P[B_+0], P[B_+1]), a1 = pk2(P[B_+2], P[B_+3]);                          \
        unsigned b0 = pk2(P[B_+4], P[B_+5]), b1 = pk2(P[B_+6], P[B_+7]);                                             \
        auto r0 = __builtin_amdgcn_permlane32_swap(a0, b0, false, false); auto r1 = __builtin_amdgcn_permlane32_swap(a1, b1, false, false); \
        u32x4 w = {r0[0], r1[0], r0[1], r1[1]}; OUT = __builtin_bit_cast(bf16x8, w); } while (0)
    PK4(p0, 0, pa0); PK4(p0, 8, pa1); PK4(p1, 0, pa2); PK4(p1, 8, pa3);
#undef PK4
}
template <int KB>
__device__ __forceinline__ void qkt(f32x16& p0, f32x16& p1, const LAS unsigned char* K_lds, int r32, int hi, const bf16x8* qr) {
    p0 = f32x16{}; p1 = f32x16{};
    const int s = (r32 >> 1) & 7;
#pragma unroll
    for (int d0 = 0; d0 < 4; ++d0) {
        const LAS unsigned char* a = K_lds + KB * SHM_K + r32 * 128 + (((2 * d0 + hi) ^ s) << 4);
        const bf16x8 b0 = *(const LAS bf16x8*)(a);
        const bf16x8 b1 = *(const LAS bf16x8*)(a + 32 * 128);
        p0 = __builtin_amdgcn_mfma_f32_32x32x16_bf16(b0, qr[d0], p0, 0, 0, 0);
        p1 = __builtin_amdgcn_mfma_f32_32x32x16_bf16(b1, qr[d0], p1, 0, 0, 0); }
}
__device__ __forceinline__ void pv_tile(f32x16* o, int vb0, bf16x8 pa0, bf16x8 pa1, bf16x8 pa2, bf16x8 pa3) {
#define TRRD(dst, off) asm volatile("ds_read_b64_tr_b16 %0, %1 offset:%2" : "=&v"(dst) : "v"(vb0), "i"(off) : "memory")
#define PV_D0(d0) do { s16x4 l0, l1, l2, l3, h0, h1, h2, h3; constexpr int b_ = v_rd_off(d0, 0, 0); \
        TRRD(l0, b_); TRRD(h0, b_ + 2048); TRRD(l1, b_ + 4096); TRRD(h1, b_ + 6144); TRRD(l2, b_ + 8192); TRRD(h2, b_ + 10240); TRRD(l3, b_ + 12288); TRRD(h3, b_ + 14336); \
        asm volatile("s_waitcnt lgkmcnt(0)" ::: "memory"); SBAR();   \
        o[d0] = __builtin_amdgcn_mfma_f32_32x32x16_bf16(pa0, (bf16x8){l0[0], l0[1], l0[2], l0[3], h0[0], h0[1], h0[2], h0[3]}, o[d0], 0, 0, 0);   \
        o[d0] = __builtin_amdgcn_mfma_f32_32x32x16_bf16(pa1, (bf16x8){l1[0], l1[1], l1[2], l1[3], h1[0], h1[1], h1[2], h1[3]}, o[d0], 0, 0, 0);   \
        o[d0] = __builtin_amdgcn_mfma_f32_32x32x16_bf16(pa2, (bf16x8){l2[0], l2[1], l2[2], l2[3], h2[0], h2[1], h2[2], h2[3]}, o[d0], 0, 0, 0);   \
        o[d0] = __builtin_amdgcn_mfma_f32_32x32x16_bf16(pa3, (bf16x8){l3[0], l3[1], l3[2], l3[3], h3[0], h3[1], h3[2], h3[3]}, o[d0], 0, 0, 0); } while (0)
    PV_D0(0); PV_D0(1); PV_D0(2); PV_D0(3);
#undef PV_D0
#undef TRRD
}

#define DA_DMA16(gp, ldsp) __builtin_amdgcn_global_load_lds((const unsigned*)(gp), (LAS unsigned*)(ldsp), 16, 0, 0)
#define DA_STAGE(koff_, voff_, k0, ksoff, vsoff) do { const size_t tb_ = (size_t)(k0) * (PITCH * 2); \
        DA_DMA16(projb + (koff_) + tb_ + lk, K_lds + (ksoff) + wid * 1024); \
        DA_DMA16(projb + (voff_) + tb_ + lv, V_lds + (vsoff) + wid * 2048); \
        DA_DMA16(projb + (voff_) + tb_ + lv + 128, V_lds + (vsoff) + wid * 2048 + 1024); } while (0)
#define DA_LANE_OFFS() const int krow_ = 8 * wid + (lane >> 3); \
        const unsigned lk = (unsigned)(krow_ * PITCH) * 2u + (unsigned)(((lane & 7) ^ ((krow_ >> 1) & 7)) << 4); \
        const unsigned lv = (unsigned)((8 * wid + ((lane & 31) >> 2)) * PITCH) * 2u + (unsigned)(((lane >> 5) * 32 + (lane & 3) * 8) * 2)

__device__ __forceinline__ void prime(const Ref& cur, LAS unsigned char* lds, Seam& S, rsrc_t R, const char* projb) {
    const int tid = threadIdx.x, wid = __builtin_amdgcn_readfirstlane(tid >> 6), lane = tid & 63, r32 = lane & 31, hi = lane >> 5;
    DA_LANE_OFFS();
    const unsigned lq = (unsigned)((wid * QBLK + r32) * PITCH + hi * 8) * 2u;
    LAS unsigned char* K_lds = lds + OFF_K; LAS unsigned char* V_lds = lds + OFF_V;
#pragma unroll
    for (int d0 = 0; d0 < 4; ++d0) S.qr[d0] = bld8(R, lq + d0 * 32, cur.qoff);
    S.ks = 0; S.vs = 0;
    DA_STAGE(cur.koff, cur.voff, 0, 0, 0); DA_STAGE(cur.koff, cur.voff, KVBLK, SHM_K, SHM_V);
    asm volatile("s_waitcnt vmcnt(0)" ::: "memory");
    __syncthreads();
}
__device__ __forceinline__ void block(const Ref& cur, const Ref& nxt, LAS unsigned char* lds, Seam& S, float lam, const float* gsub, rsrc_t R, const char* projb) {
    const int tid = threadIdx.x, wid = __builtin_amdgcn_readfirstlane(tid >> 6), lane = tid & 63, r32 = lane & 31, hi = lane >> 5;
    const int NT = (cur.P0 + QB) / KVBLK;
    const int qlo = cur.P0 + wid * QBLK;
    LAS unsigned char* V_lds = lds + OFF_V; LAS unsigned char* K_lds = lds + OFF_K;
    LAS float* ws = (LAS float*)(lds + OFF_WS) + wid * 64; LAS float* li_l = ws; LAS float* al_l = ws + 32;
    const LAS float* tbh = (const LAS float*)(lds + OFF_TB) + cur.h * 128;
    float mhat = 0.f, l_reg = 0.f, rmx = 0.f; f32x16 o[4] = {}; f32x16 negm = f32x16{};
    bool resc = false;
    const int vb0 = (int)(unsigned)(uintptr_t)V_lds + v_rd_base(lane);
    DA_LANE_OFFS();
    const unsigned Kh = cur.koff, Vh = cur.voff;
#define KNEXT(x) (((x) == (NKS - 1) * SHM_K) ? 0 : (x) + SHM_K)
#define VNEXT(x) (((x) == (NVS - 1) * SHM_V) ? 0 : (x) + SHM_V)
    int k0 = S.ks, k1 = KNEXT(k0), k2 = KNEXT(k1);
    int v1 = S.vs, v2 = VNEXT(v1), v3 = VNEXT(v2), v0 = VNEXT(v3);
#define ROT() do { const int kn_ = k0; k0 = k1; k1 = k2; k2 = kn_; const int vn_ = v0; v0 = v1; v1 = v2; v2 = v3; v3 = vn_; } while (0)
#define STREAM(j) do { const bool in_ = (j) < NT; const unsigned ko_ = in_ ? Kh : nxt.koff, vo_ = in_ ? Vh : nxt.voff; const int tj_ = in_ ? (j) : (j) - NT; DA_STAGE(ko_, vo_, KBASE(tj_), k2, v3); } while (0)
#define STEP_BAR() asm volatile("s_waitcnt vmcnt(3) lgkmcnt(0)\n\ts_barrier" ::: "memory")
    const int ksw = (r32 >> 1) & 7;
    const LAS unsigned char* kbase = K_lds + r32 * 128;
#define KBASE(t) ((t) * KVBLK)
#define NEAR(P0_, P1_, t) do { const int kb_ = KBASE(t); if (kb_ >= qlo - 175) bias_mask(P0_, P1_, qlo - kb_, tbh); } while (0)
#define RESC() do { if (resc) { asm volatile("s_waitcnt lgkmcnt(0)" ::: "memory");              \
                     _Pragma("unroll") for (int d_ = 0; d_ < 4; ++d_) _Pragma("unroll") for (int r = 0; r < 16; ++r) o[d_][r] *= al_l[crow(r, hi)]; } } while (0)
#define PIN(x) asm volatile("" : "+v"(x))
#define EX(v) __builtin_amdgcn_exp2f(v)
#define MX3(a, b, c) __builtin_fmaxf(__builtin_fmaxf((a), (b)), (c))
#define DECIDE(C0, C1, FIRST) do { \
        float a_ = MX3(C0[0], C0[1], C1[0]), b_ = MX3(C0[2], C0[3], C1[1]); a_ = MX3(a_, C1[2], C1[3]); \
        _Pragma("unroll") for (int r = 4; r < 16; r += 4) { a_ = MX3(a_, C0[r], C0[r + 1]); b_ = MX3(b_, C0[r + 2], C0[r + 3]); a_ = MX3(a_, C1[r], C1[r + 1]); b_ = MX3(b_, C1[r + 2], C1[r + 3]); } \
        float rm_ = __builtin_fmaxf(a_, b_); { auto rr_ = __builtin_amdgcn_permlane32_swap(__float_as_uint(rm_), __float_as_uint(rm_), false, false); rm_ = __builtin_fmaxf(__uint_as_float(rr_[0]), __uint_as_float(rr_[1])); } \
        resc = false; \
        if ((FIRST) || __builtin_expect(__any(rm_ > THR), 0)) { const float dl_ = (FIRST) ? rm_ : __builtin_fmaxf(rm_, 0.f); mhat += dl_; \
            _Pragma("unroll") for (int r = 0; r < 16; ++r) { C0[r] -= dl_; C1[r] -= dl_; } \
            _Pragma("unroll") for (int r = 0; r < 16; ++r) negm[r] = -mhat; \
            asm volatile("" : "+v"(negm)); \
            if (!(FIRST)) { const float f_ = EX(-dl_); l_reg *= f_; if (hi == 0) al_l[r32] = f_; resc = true; } } } while (0)
#define DECIDE2(C0, C1) do { float rm_ = rmx; { auto rr_ = __builtin_amdgcn_permlane32_swap(__float_as_uint(rm_), __float_as_uint(rm_), false, false); rm_ = __builtin_fmaxf(__uint_as_float(rr_[0]), __uint_as_float(rr_[1])); } \
        resc = false; \
        if (__builtin_expect(__any(rm_ > THR), 0)) { const float dl_ = __builtin_fmaxf(rm_, 0.f); mhat += dl_; const float f_ = EX(-dl_); \
            _Pragma("unroll") for (int r = 0; r < 16; ++r) { C0[r] *= f_; C1[r] *= f_; } \
            _Pragma("unroll") for (int r = 0; r < 16; ++r) negm[r] = -mhat; \
            asm volatile("" : "+v"(negm)); \
            l_reg *= f_; if (hi == 0) al_l[r32] = f_; resc = true; } } while (0)
#define KF(d0, hf) (*(const LAS bf16x8*)(kbase + k0 + (((2 * (d0) + hi) ^ ksw) << 4) + (hf) * 4096))
#define GAPA(MF, P, B, W) do { MF; sacc += P[B]; sacc += P[B + 1]; sacc += P[B + 2]; sacc += P[B + 3]; PIN(sacc); W[((B) >> 1) & 3] = pk2(P[B], P[B + 1]); W[(((B) >> 1) & 3) + 1] = pk2(P[B + 2], P[B + 3]); PIN(W); SBAR(); } while (0)
#define PHASE_A(C0, C1, P0, P1) do { \
        const bf16x8 k00 = KF(0, 0), k01 = KF(0, 1), k10 = KF(1, 0), k11 = KF(1, 1), k20 = KF(2, 0), k21 = KF(2, 1), k30 = KF(3, 0), k31 = KF(3, 1); \
        float sacc = 0.f; SBAR(); \
        GAPA(C0 = __builtin_amdgcn_mfma_f32_32x32x16_bf16(k00, S.qr[0], negm, 0, 0, 0), P0, 0, pw0); \
        GAPA(C1 = __builtin_amdgcn_mfma_f32_32x32x16_bf16(k01, S.qr[0], negm, 0, 0, 0), P0, 4, pw0); \
        GAPA(C0 = __builtin_amdgcn_mfma_f32_32x32x16_bf16(k10, S.qr[1], C0, 0, 0, 0), P0, 8, pw1); \
        GAPA(C1 = __builtin_amdgcn_mfma_f32_32x32x16_bf16(k11, S.qr[1], C1, 0, 0, 0), P0, 12, pw1); \
        GAPA(C0 = __builtin_amdgcn_mfma_f32_32x32x16_bf16(k20, S.qr[2], C0, 0, 0, 0), P1, 0, pw2); \
        GAPA(C1 = __builtin_amdgcn_mfma_f32_32x32x16_bf16(k21, S.qr[2], C1, 0, 0, 0), P1, 4, pw2); \
        GAPA(C0 = __builtin_amdgcn_mfma_f32_32x32x16_bf16(k30, S.qr[3], C0, 0, 0, 0), P1, 8, pw3); \
        GAPA(C1 = __builtin_amdgcn_mfma_f32_32x32x16_bf16(k31, S.qr[3], C1, 0, 0, 0), P1, 12, pw3); \
        l_reg += sacc; } while (0)
#define TRRD(dst, off) asm volatile("ds_read_b64_tr_b16 %0, %1 offset:%2" : "=&v"(dst) : "v"(vbr), "i"(off) : "memory")
#define VRD8(L0, H0, L1, H1, L2, H2, L3, H3, VBv, d0) do { constexpr int b_ = v_rd_off(d0, 0, 0); \
        TRRD(L0, b_); TRRD(H0, b_ + 2048); TRRD(L1, b_ + 4096); TRRD(H1, b_ + 6144); TRRD(L2, b_ + 8192); TRRD(H2, b_ + 10240); TRRD(L3, b_ + 12288); TRRD(H3, b_ + 14336); } while (0)
#define VF(L, H) (bf16x8){L[0], L[1], L[2], L[3], H[0], H[1], H[2], H[3]}
#define PAF(k) __builtin_bit_cast(bf16x8, pw##k)
#define GAPB(MF, X, B) do { MF; rmx = MX3(rmx, X[B], X[(B) + 1]); X[B] = EX(X[B]); X[(B) + 1] = EX(X[(B) + 1]); PIN(X); PIN(rmx); SBAR(); } while (0)
#define PV4(d0, L0, H0, L1, H1, L2, H2, L3, H3, X, B) do { \
        GAPB(o[d0] = __builtin_amdgcn_mfma_f32_32x32x16_bf16(PAF(0), VF(L0, H0), o[d0], 0, 0, 0), X, (B)); \
        GAPB(o[d0] = __builtin_amdgcn_mfma_f32_32x32x16_bf16(PAF(1), VF(L1, H1), o[d0], 0, 0, 0), X, (B) + 2); \
        GAPB(o[d0] = __builtin_amdgcn_mfma_f32_32x32x16_bf16(PAF(2), VF(L2, H2), o[d0], 0, 0, 0), X, (B) + 4); \
        GAPB(o[d0] = __builtin_amdgcn_mfma_f32_32x32x16_bf16(PAF(3), VF(L3, H3), o[d0], 0, 0, 0), X, (B) + 6); } while (0)
#define LWAIT(n) do { asm volatile("s_waitcnt lgkmcnt(" #n ")" ::: "memory"); SBAR(); } while (0)
#define PHASE_B(C0, C1, VBv) do { s16x4 a0, a1, a2, a3, a4, a5, a6, a7, b0, b1, b2, b3, b4, b5, b6, b7; const int vbr = vb0 + (VBv); rmx = -__builtin_inff(); \
        asm volatile("s_waitcnt lgkmcnt(0)" ::: "memory"); SBAR(); \
        VRD8(a0, a1, a2, a3, a4, a5, a6, a7, VBv, 0); VRD8(b0, b1, b2, b3, b4, b5, b6, b7, VBv, 1); LWAIT(8); \
        PV4(0, a0, a1, a2, a3, a4, a5, a6, a7, C0, 0); \
        VRD8(a0, a1, a2, a3, a4, a5, a6, a7, VBv, 2); LWAIT(8); \
        PV4(1, b0, b1, b2, b3, b4, b5, b6, b7, C0, 8); \
        VRD8(b0, b1, b2, b3, b4, b5, b6, b7, VBv, 3); LWAIT(8); \
        PV4(2, a0, a1, a2, a3, a4, a5, a6, a7, C1, 0); \
        LWAIT(0); \
        PV4(3, b0, b1, b2, b3, b4, b5, b6, b7, C1, 8); } while (0)
    f32x16 pA0, pA1, pB0, pB1; u32x4 pw0, pw1, pw2, pw3;
#if PROBE_SEG
    unsigned long long pst_ = __builtin_readcyclecounter();
#define STAMP(k) do { const unsigned long long n_ = __builtin_readcyclecounter(); if ((k) == PROBE_SEG) S.acc += n_ - pst_; S.tot += n_ - pst_; pst_ = n_; } while (0)
#else
#define STAMP(k) do { } while (0)
#endif
    STREAM(2);
    SBAR();
    {
      const bf16x8 k00 = KF(0, 0), k01 = KF(0, 1), k10 = KF(1, 0), k11 = KF(1, 1), k20 = KF(2, 0), k21 = KF(2, 1), k30 = KF(3, 0), k31 = KF(3, 1);
      pA0 = __builtin_amdgcn_mfma_f32_32x32x16_bf16(k00, S.qr[0], negm, 0, 0, 0); pA1 = __builtin_amdgcn_mfma_f32_32x32x16_bf16(k01, S.qr[0], negm, 0, 0, 0);
      pA0 = __builtin_amdgcn_mfma_f32_32x32x16_bf16(k10, S.qr[1], pA0, 0, 0, 0); pA1 = __builtin_amdgcn_mfma_f32_32x32x16_bf16(k11, S.qr[1], pA1, 0, 0, 0);
      pA0 = __builtin_amdgcn_mfma_f32_32x32x16_bf16(k20, S.qr[2], pA0, 0, 0, 0); pA1 = __builtin_amdgcn_mfma_f32_32x32x16_bf16(k21, S.qr[2], pA1, 0, 0, 0);
      pA0 = __builtin_amdgcn_mfma_f32_32x32x16_bf16(k30, S.qr[3], pA0, 0, 0, 0); pA1 = __builtin_amdgcn_mfma_f32_32x32x16_bf16(k31, S.qr[3], pA1, 0, 0, 0); }
    NEAR(pA0, pA1, 0); DECIDE(pA0, pA1, true);
#pragma unroll
    for (int r = 0; r < 16; ++r) { pA0[r] = EX(pA0[r]); pA1[r] = EX(pA1[r]); }
    STEP_BAR();
    ROT();
#define STEP(C0, C1, P0, P1, t) do { SBAR(); STAMP(5); \
        STREAM((t) + 2); SBAR(); \
        PHASE_A(C0, C1, P0, P1); SBAR(); STAMP(1); \
        NEAR(C0, C1, (t)); SBAR(); STAMP(2); \
        PHASE_B(C0, C1, v0); DECIDE2(C0, C1); SBAR(); STAMP(3); \
        RESC(); STEP_BAR(); STAMP(4); ROT(); } while (0)
    int t = 1;
    for (; t + 2 < NT; t += 2) {
        STEP(pB0, pB1, pA0, pA1, t);
        STEP(pA0, pA1, pB0, pB1, t + 1);
    }
    SBAR(); STREAM(NT + 1); SBAR();
    PHASE_A(pB0, pB1, pA0, pA1);
    { const unsigned lq = (unsigned)((wid * QBLK + r32) * PITCH + hi * 8) * 2u;
#pragma unroll
      for (int d0 = 0; d0 < 4; ++d0) S.qr[d0] = bld8(R, lq + d0 * 32, nxt.qoff); }
    SBAR();
    NEAR(pB0, pB1, NT - 1); SBAR();
    PHASE_B(pB0, pB1, v0); DECIDE2(pB0, pB1);
    RESC();
    { float sacc = 0.f;
#pragma unroll
      for (int r = 0; r < 16; ++r) { sacc += pB0[r]; sacc += pB1[r]; }
      l_reg += sacc;
      pw0 = (u32x4){pk2(pB0[0], pB0[1]), pk2(pB0[2], pB0[3]), pk2(pB0[4], pB0[5]), pk2(pB0[6], pB0[7])}; pw1 = (u32x4){pk2(pB0[8], pB0[9]), pk2(pB0[10], pB0[11]), pk2(pB0[12], pB0[13]), pk2(pB0[14], pB0[15])};
      pw2 = (u32x4){pk2(pB1[0], pB1[1]), pk2(pB1[2], pB1[3]), pk2(pB1[4], pB1[5]), pk2(pB1[6], pB1[7])}; pw3 = (u32x4){pk2(pB1[8], pB1[9]), pk2(pB1[10], pB1[11]), pk2(pB1[12], pB1[13]), pk2(pB1[14], pB1[15])};
      SBAR(); pv_tile(o, vb0 + v1, PAF(0), PAF(1), PAF(2), PAF(3)); }
    asm volatile("s_waitcnt vmcnt(0)" ::: "memory");
    ROT(); S.ks = k0; S.vs = v1;
    { auto rr = __builtin_amdgcn_permlane32_swap(__float_as_uint(l_reg), __float_as_uint(l_reg), false, false); l_reg = __uint_as_float(rr[0]) + __uint_as_float(rr[1]); }
    int lane_e = (int)__builtin_amdgcn_mbcnt_hi(~0u, __builtin_amdgcn_mbcnt_lo(~0u, 0u)); asm volatile("" : "+v"(lane_e));
    const int r32e = lane_e & 31, hie = lane_e >> 5;
    if (hi == 0) li_l[r32] = l_reg; asm volatile("s_waitcnt lgkmcnt(0)" ::: "memory");
    float rli[16];
#pragma unroll
    for (int r = 0; r < 16; ++r) rli[r] = __builtin_amdgcn_rcpf(li_l[crow(r, hi)]);
    LAS unsigned* st = (LAS unsigned*)(lds + OFF_STASH + wid * 8192) + lane_e;
    if (cur.comp == 0) {
#pragma unroll
        for (int r = 0; r < 16; ++r) { st[(2 * r) * 64] = pk2(o[0][r] * rli[r], o[1][r] * rli[r]); st[(2 * r + 1) * 64] = pk2(o[2][r] * rli[r], o[3][r] * rli[r]); }
    } else {
        float ss[16];
#pragma unroll
        for (int r = 0; r < 16; ++r) { const unsigned u0 = st[(2 * r) * 64], u1 = st[(2 * r + 1) * 64];
            const float s2 = lam * rli[r];
            o[0][r] = bflo(u0) - s2 * o[0][r]; o[1][r] = bfhi(u0) - s2 * o[1][r]; o[2][r] = bflo(u1) - s2 * o[2][r]; o[3][r] = bfhi(u1) - s2 * o[3][r];
            ss[r] = (o[0][r] * o[0][r] + o[1][r] * o[1][r]) + (o[2][r] * o[2][r] + o[3][r] * o[3][r]); }
#pragma unroll
        for (int r = 0; r < 16; ++r) {
#pragma unroll
            for (int x = 1; x < 32; x <<= 1) ss[r] += __shfl_xor(ss[r], x);
            ss[r] = rsqrtf(ss[r] * (1.f / 128.f) + EPS) * 0.8f; }
        float gg[4];
#pragma unroll
        for (int d0 = 0; d0 < 4; ++d0) gg[d0] = gsub[d0 * 32 + r32e];
        bf16_t* Ow = cur.O + (size_t)(wid * QBLK) * DM;
#pragma unroll
        for (int r = 0; r < 16; ++r) { const int orow = crow(r, hie);
#pragma unroll
            for (int d0 = 0; d0 < 4; ++d0) { const float v = o[d0][r] * ss[r] * gg[d0]; const float vn = __shfl_xor(v, 1);
                if ((r32e & 1) == 0) *(unsigned*)(Ow + (size_t)orow * DM + d0 * 32 + r32e) = pk2(v, vn); } }
    }
    __syncthreads();
#undef RESC
#undef KBASE
#undef NEAR
#undef PIN
#undef EX
#undef MX3
#undef DECIDE
#undef DECIDE2
#undef KF
#undef GAPA
#undef PHASE_A
#undef TRRD
#undef VRD8
#undef VF
#undef PAF
#undef GAPB
#undef PV4
#undef LWAIT
#undef PHASE_B
#undef STEP
#undef STAMP
#undef ROT
#undef KNEXT
#undef VNEXT
#undef STREAM
#undef STEP_BAR
}
#undef DA_DMA16
#undef DA_STAGE
#undef DA_LANE_OFFS
}

constexpr int NWAVES = 8;
constexpr int N_LAUNCHES = MK_N_LAUNCHES;
constexpr int N_PHASES = 9;
static_assert(N_LAUNCHES == 1 || N_LAUNCHES == N_PHASES, "MK_N_LAUNCHES is 1 or 9");

constexpr size_t MiB = 1u << 20;
constexpr size_t WS_CTL = 0, CTL_ZERO_BYTES = 1 * MiB;
constexpr size_t WS_ETK = 1 * MiB, WS_GTK = 2 * MiB, WS_RSTDT = 3 * MiB, WS_SLOTTK = 4 * MiB, WS_TOKSLOT = 5 * MiB, WS_GATESLOT = 7 * MiB, WS_RSTDSLOT = 9 * MiB, WS_RBE = 11 * MiB;
constexpr size_t WS_WRHI = 12 * MiB, WS_WRLO = 12 * MiB + 65536, WS_KMB = 13 * MiB, WS_VMT = 14 * MiB;
constexpr size_t WS_WIN = 16 * MiB, WS_WOUT = 21 * MiB, WS_X1B = 24 * MiB, WS_X1Q = 152 * MiB;
constexpr size_t WS_BIG = 216 * MiB;
constexpr size_t WS_H = WS_BIG, WS_PROJ = WS_BIG + 128 * MiB, WS_MIX = WS_BIG + 448 * MiB;
constexpr size_t WS_ACTQ = WS_BIG, WS_Y = WS_BIG + 264 * MiB;
constexpr size_t WS_WGU = 792 * MiB, WS_WD = 856 * MiB;
constexpr size_t WS_END = 888 * MiB;
static_assert(WS_MIX + (size_t)T * DM * 2 <= WS_WGU && WS_END <= 1024 * MiB, "d_ws map");
constexpr int CW_BAR = 4096, CW_COUNT = 1024, CW_CURSOR = 2048;
constexpr int RING_BYTES = 159744, LDSCTL_OFF = RING_BYTES, MISC_OFF = LDSCTL_OFF + 320, LDS_BYTES = 163840;
static_assert(dattn::LDS_BYTES <= RING_BYTES, "attention scratch");

#define XB_TMO      128
#define XB_XCNT(j)  (256  + 64 * (j))
#define XB_XSUB(j)  (1280 + 64 * (j))
#define XB_XGEN(j)  (2304 + 64 * (j))
#define XB_TOP      3328
#define XB_TOPGEN   3392
#define XCD_BAR_WORDS 3456
#define XB_SPIN_CAP (1u << 18)
__device__ __forceinline__ unsigned xb_ld(unsigned* p)              { return __hip_atomic_load(p, __ATOMIC_RELAXED, __HIP_MEMORY_SCOPE_AGENT); }
__device__ __forceinline__ unsigned xb_add(unsigned* p, unsigned v) { return __hip_atomic_fetch_add(p, v, __ATOMIC_RELAXED, __HIP_MEMORY_SCOPE_AGENT); }
__device__ __forceinline__ unsigned xb_xcc_id() { return (unsigned)__builtin_amdgcn_s_getreg((3 << 11) | 20) & 0xFu; }
#define XB_SPIN(cond, bar) do { unsigned _sp = 0; while (cond) { __builtin_amdgcn_s_sleep(1); \
    if ((++_sp & 255u) == 0u) { if (xb_ld(&(bar)[XB_TMO])) break; if (_sp > XB_SPIN_CAP) { atomicAdd(&(bar)[XB_TMO], 1u); break; } } } } while (0)
struct XcdBarrier { unsigned* bar; unsigned x; volatile LAS unsigned* st; };
__device__ __forceinline__ XcdBarrier xcd_barrier_post(unsigned* bar, volatile LAS unsigned* st) {
    XcdBarrier b; b.bar = bar; b.x = xb_xcc_id(); b.st = st;
    if (threadIdx.x == 0) (void)xb_add(&bar[XB_XCNT(b.x)], 1u);
    return b;
}
__device__ __forceinline__ void xcd_barrier_complete(unsigned* bar, unsigned x, unsigned& nloc, unsigned& nx) {
    const unsigned G = gridDim.x * gridDim.y * gridDim.z;
    unsigned sum, cnt, mine, sp = 0u;
    for (;;) {
        sum = 0u; cnt = 0u; mine = 0u;
#pragma unroll
        for (unsigned j = 0; j < 16; ++j) { const unsigned c = xb_ld(&bar[XB_XCNT(j)]); sum += c; cnt += (c > 0u) ? 1u : 0u; mine = (j == x) ? c : mine; }
        if (sum == G) break;
        __builtin_amdgcn_s_sleep(1);
        if ((++sp & 255u) == 0u) { if (xb_ld(&bar[XB_TMO])) break; if (sp > XB_SPIN_CAP) { atomicAdd(&bar[XB_TMO], 1u); break; } }
    }
    nloc = mine > 0u ? mine : 1u; nx = cnt > 0u ? cnt : 1u;
}
__device__ __forceinline__ void xcd_barrier(const XcdBarrier& b) {
    asm volatile("s_waitcnt vmcnt(0)" ::: "memory");
    __syncthreads();
    if (threadIdx.x == 0) {
        unsigned* bar = b.bar;
        __builtin_amdgcn_s_waitcnt(0);
        unsigned nloc = b.st[0], nx = b.st[1];
        if (nloc == 0u) { xcd_barrier_complete(bar, b.x, nloc, nx); b.st[0] = nloc; b.st[1] = nx; }
        const unsigned old = xb_add(&bar[XB_XSUB(b.x)], 1u);
        const unsigned gen = old / nloc;
        if (old + 1u == (gen + 1u) * nloc) {
            __builtin_amdgcn_fence(__ATOMIC_RELEASE, "agent");
            asm volatile("s_waitcnt vmcnt(0)" ::: "memory");
            const unsigned og = xb_add(&bar[XB_TOP], 1u);
            const unsigned tg = og / nx;
            if (og + 1u == (tg + 1u) * nx) xb_add(&bar[XB_TOPGEN], 1u);
            else XB_SPIN(xb_ld(&bar[XB_TOPGEN]) == tg, bar);
            __builtin_amdgcn_fence(__ATOMIC_ACQUIRE, "agent");
            xb_add(&bar[XB_XGEN(b.x)], 1u);
            asm volatile("s_waitcnt vmcnt(0)" ::: "memory");
        } else {
            XB_SPIN(xb_ld(&bar[XB_XGEN(b.x)]) == gen, bar);
            __builtin_amdgcn_fence(__ATOMIC_ACQUIRE, "agent");
            asm volatile("s_waitcnt vmcnt(0)" ::: "memory");
        }
    }
    __syncthreads();
}

struct Frame {
    LAS unsigned char* lds;
    volatile LAS unsigned* MISC;
    unsigned* ctl;
    int tid, lane, wave, vcu, G;
    float* out;
    unsigned char* ws;
};
struct Args { const float* in[19]; float* out; unsigned char* ws; int ph_lo, ph_hi; };
typedef const __attribute__((address_space(4))) Args* KArgs;
__device__ __forceinline__ KArgs kargs() { KArgs p = (KArgs)__builtin_amdgcn_kernarg_segment_ptr(); asm volatile("" : "+s"(p)); return p; }
enum { I_X = 0, I_MEM, I_RELB, I_ATTNG, I_WIN, I_CONVW, I_LAMQK, I_SUBG, I_MEMG, I_WMEMKV, I_WOUT, I_FFNG, I_RW, I_RB, I_WGU, I_BGU, I_WDN, I_BDN, I_FING };

template <bool GAIN, bool F8>
__device__ __forceinline__ void p0_transpose_item(const float* W, int K, int N, void* WTv, int k0, int n0, int drow0, const float* kgain, float scale, LAS float* scr, int lane) {
    float v[32];
    const float* wp = W + (size_t)(k0 + (lane >> 5)) * N + n0 + (lane & 31);
#pragma unroll
    for (int i = 0; i < 32; ++i) v[i] = wp[(size_t)(2 * i) * N];
    const int c = lane & 7;
    f32x4 g0 = {scale, scale, scale, scale}, g1 = g0;
    if constexpr (GAIN) { g0 = *(const f32x4*)(kgain + k0 + 8 * c) * scale; g1 = *(const f32x4*)(kgain + k0 + 8 * c + 4) * scale; }
#pragma unroll
    for (int i = 0; i < 32; ++i) scr[(2 * i + (lane >> 5)) * 33 + (lane & 31)] = v[i];
    LDS_WAIT(); asm volatile("" ::: "memory");
#pragma unroll
    for (int j = 0; j < 4; ++j) { const int n = (lane >> 3) + 8 * j; const LAS float* s = scr + (8 * c) * 33 + n;
        const float e0 = s[0 * 33] * g0[0], e1 = s[1 * 33] * g0[1], e2 = s[2 * 33] * g0[2], e3 = s[3 * 33] * g0[3], e4 = s[4 * 33] * g1[0], e5 = s[5 * 33] * g1[1], e6 = s[6 * 33] * g1[2], e7 = s[7 * 33] * g1[3];
        if constexpr (F8) { u32x2 o; o.x = pg8::pk4_fp8(e0, e1, e2, e3); o.y = pg8::pk4_fp8(e4, e5, e6, e7);
            *(u32x2*)((unsigned char*)WTv + (size_t)(drow0 + n) * K + k0 + 8 * c) = o; }
        else { u32x4 o; o.x = pk2(e0, e1); o.y = pk2(e2, e3); o.z = pk2(e4, e5); o.w = pk2(e6, e7);
            *(u32x4*)((bf16_t*)WTv + (size_t)(drow0 + n) * K + k0 + 8 * c) = o; } }
    LDS_WAIT(); asm volatile("" ::: "memory");
}
__device__ __forceinline__ void rms_row2_to_bf16(const float* xa, const float* xb, const float* g, bf16_t* oa, bf16_t* ob, int lane) {
    const f32x4* ra = (const f32x4*)xa + lane; const f32x4* rb = (const f32x4*)xb + lane; const f32x4* gr = (const f32x4*)g + lane;
    f32x4 va[4], vb[4]; float sa = 0.f, sb = 0.f;
#pragma unroll
    for (int j = 0; j < 4; ++j) { va[j] = ra[64 * j]; vb[j] = rb[64 * j]; }
#pragma unroll
    for (int j = 0; j < 4; ++j) { sa += (va[j].x * va[j].x + va[j].y * va[j].y) + (va[j].z * va[j].z + va[j].w * va[j].w); sb += (vb[j].x * vb[j].x + vb[j].y * vb[j].y) + (vb[j].z * vb[j].z + vb[j].w * vb[j].w); }
    const float rsa = rsqrtf(wave_sum(sa) * (1.f / DM) + EPS), rsb = rsqrtf(wave_sum(sb) * (1.f / DM) + EPS);
    unsigned long long* pa = (unsigned long long*)oa + lane; unsigned long long* pb = (unsigned long long*)ob + lane;
#pragma unroll
    for (int j = 0; j < 4; ++j) { const f32x4 gg = gr[64 * j];
        pa[64 * j] = (unsigned long long)pk2(va[j].x * rsa * gg.x, va[j].y * rsa * gg.y) | ((unsigned long long)pk2(va[j].z * rsa * gg.z, va[j].w * rsa * gg.w) << 32);
        pb[64 * j] = (unsigned long long)pk2(vb[j].x * rsb * gg.x, vb[j].y * rsb * gg.y) | ((unsigned long long)pk2(vb[j].z * rsb * gg.z, vb[j].w * rsb * gg.w) << 32); }
}
__device__ __forceinline__ void p0_kvm_tile(Frame& F, int tile, const float* mem, const float* mem_g, const float* w_memkv) {
    const int mt = tile >> 3, ntile = tile & 7, row0 = 64 * mt, col0 = 64 * ntile;
    const int mb = F.wave >> 1, nb0 = (F.wave & 1) * 2, ar = F.lane & 15, kq = F.lane >> 4;
    const float* arow = mem + (size_t)(row0 + mb * 16 + ar) * DM;
    f32x4 acc[2]; acc[0] = (f32x4){0.f, 0.f, 0.f, 0.f}; acc[1] = acc[0];
    float ss = 0.f;
    const float* wq = w_memkv + col0 + nb0 * 16 + ar;
#define KVM_LOAD(A0, A1, G0, G1, BV, k0_) do { const int kk_ = (k0_) + 8 * kq; A0 = *(const f32x4*)(arow + kk_); A1 = *(const f32x4*)(arow + kk_ + 4); G0 = *(const f32x4*)(mem_g + kk_); G1 = *(const f32x4*)(mem_g + kk_ + 4); \
        _Pragma("unroll") for (int nbi = 0; nbi < 2; ++nbi) _Pragma("unroll") for (int j = 0; j < 8; ++j) BV[nbi][j] = wq[(size_t)(kk_ + j) * 512 + nbi * 16]; } while (0)
#define KVM_MATH(A0, A1, G0, G1, BV) do { ss += (A0.x * A0.x + A0.y * A0.y) + (A0.z * A0.z + A0.w * A0.w) + (A1.x * A1.x + A1.y * A1.y) + (A1.z * A1.z + A1.w * A1.w); \
        const bf16x8 af = pack8(A0 * G0, A1 * G1); \
        _Pragma("unroll") for (int nbi = 0; nbi < 2; ++nbi) { const f32x4 b0 = {BV[nbi][0], BV[nbi][1], BV[nbi][2], BV[nbi][3]}, b1 = {BV[nbi][4], BV[nbi][5], BV[nbi][6], BV[nbi][7]}; \
            acc[nbi] = __builtin_amdgcn_mfma_f32_16x16x32_bf16(af, pack8(b0, b1), acc[nbi], 0, 0, 0); } } while (0)
    f32x4 ba0[4], ba1[4], bg0[4], bg1[4]; float bb[4][2][8];
#pragma unroll 1
    for (int k0 = 0; k0 < DM; k0 += 128) {
#pragma unroll
        for (int q = 0; q < 4; ++q) KVM_LOAD(ba0[q], ba1[q], bg0[q], bg1[q], bb[q], k0 + 32 * q);
#pragma unroll
        for (int q = 0; q < 4; ++q) KVM_MATH(ba0[q], ba1[q], bg0[q], bg1[q], bb[q]);
    }
#undef KVM_LOAD
#undef KVM_MATH
    ss += __shfl_xor(ss, 16); ss += __shfl_xor(ss, 32);
    const float rstd = rsqrtf(ss * (1.f / DM) + EPS);
    float rs[4];
#pragma unroll
    for (int j = 0; j < 4; ++j) rs[j] = __shfl(rstd, kq * 4 + j);
    bf16_t* kmb = (bf16_t*)(F.ws + WS_KMB); bf16_t* vmt = (bf16_t*)(F.ws + WS_VMT);
#pragma unroll
    for (int nbi = 0; nbi < 2; ++nbi) {
        const int gc = col0 + (nb0 + nbi) * 16 + ar, gr0 = row0 + mb * 16 + kq * 4;
        if (ntile < 4) {
#pragma unroll
            for (int j = 0; j < 4; ++j) kmb[(size_t)(gr0 + j) * 256 + gc] = (bf16_t)(pk2(acc[nbi][j] * rs[j], 0.f) & 0xffffu);
        } else {
            const int d = gc - 256, hm = d >> 6, dd = d & 63, b = gr0 >> 8, m = gr0 & 255;
            u32x2 w; w.x = pk2(acc[nbi][0] * rs[0], acc[nbi][1] * rs[1]); w.y = pk2(acc[nbi][2] * rs[2], acc[nbi][3] * rs[3]);
            *(u32x2*)(vmt + ((size_t)((b * 4 + hm) * 64 + dd)) * 256 + m) = w;
        }
    }
}
struct P0Tile { const float* src; unsigned char* dst; int gain; };
template <int N, int K>
__device__ __forceinline__ void p0_tile_load(const float* src, f32x4 (&v)[8], int tid) {
#pragma unroll
    for (int i = 0; i < 8; ++i) v[i] = *(const f32x4*)(src + (size_t)((tid >> 5) + 16 * i) * N + (tid & 31) * 4);
}
__device__ __forceinline__ void p0_tile_to_lds(LAS float* tl, const f32x4 (&v)[8], int tid) {
#pragma unroll
    for (int i = 0; i < 8; ++i) { const int k = (tid >> 5) + 16 * i, c = ((tid & 31) * 4) ^ (((k >> 4) & 7) << 2); *(LAS f32x4*)(tl + k * 132 + c) = v[i]; }
}
template <int K, bool GAIN>
__device__ __forceinline__ void p0_tile_store(const LAS float* tl, unsigned char* dst, const float* kgain, float scale, int tid) {
    const int run = tid & 7;
    f32x4 g[4];
#pragma unroll
    for (int q = 0; q < 4; ++q) { g[q] = (f32x4){scale, scale, scale, scale}; if constexpr (GAIN) g[q] = *(const f32x4*)(kgain + run * 16 + 4 * q) * scale; }
#pragma unroll
    for (int p = 0; p < 2; ++p) { const int n = (tid >> 3) + 64 * p; const LAS float* s = tl + (run * 16) * 132 + (n ^ (run << 2));
        u32x4 o;
#pragma unroll
        for (int q = 0; q < 4; ++q) o[q] = pg8::pk4_fp8(s[(4 * q) * 132] * g[q][0], s[(4 * q + 1) * 132] * g[q][1], s[(4 * q + 2) * 132] * g[q][2], s[(4 * q + 3) * 132] * g[q][3]);
        *(u32x4*)(dst + (size_t)n * K + run * 16) = o; }
}
__device__ __forceinline__ void p0_prologue(Frame& F) {
    KArgs A = kargs();
    { const float* mem = A->in[I_MEM]; const float* mem_g = A->in[I_MEMG]; const float* w_memkv = A->in[I_WMEMKV];
      for (int rep2_ = 0; rep2_ < ((PROBE_P0 & 4) ? 2 : 1); ++rep2_)
      for (int tile = blockIdx.x; tile < 256; tile += F.G) p0_kvm_tile(F, tile, mem, mem_g, w_memkv); }
    const float* w_in = A->in[I_WIN]; const float* w_out = A->in[I_WOUT]; const float* w_gu = A->in[I_WGU]; const float* w_dn = A->in[I_WDN]; const float* ffn_g = A->in[I_FFNG];
    LAS float* scr = (LAS float*)(F.lds + F.wave * 16384);
    const int gw = F.vcu * NWAVES + F.wave, NGW = F.G * NWAVES;
    bf16_t* Win_t = (bf16_t*)(F.ws + WS_WIN); bf16_t* Wout_t = (bf16_t*)(F.ws + WS_WOUT);
    unsigned char* Wgu_q = F.ws + WS_WGU; unsigned char* Wd_q = F.ws + WS_WD;
    constexpr int I_IN = 16 * 80, I_OUT = 16 * 32, NITEMS = I_IN + I_OUT;
    for (int rep0_ = 0; rep0_ < ((PROBE_P0 & 1) ? 2 : 1); ++rep0_)
    for (int it = gw; it < NITEMS; it += NGW) {
        int r = it;
        if (r < I_IN) { const int kb = r / 80, nb = r % 80; p0_transpose_item<false, false>(w_in, DM, INW, Win_t, 64 * kb, 32 * nb, 32 * nb, nullptr, 1.f, scr, F.lane); continue; } r -= I_IN;
        if (r < I_OUT) { const int kb = r / 32, nb = r % 32; p0_transpose_item<false, false>(w_out, DM, DM, Wout_t, 64 * kb, 32 * nb, 32 * nb, nullptr, 1.f, scr, F.lane); continue; } r -= I_OUT;
    }
    { __syncthreads();
      LAS float* tl = (LAS float*)F.lds; const int tid = F.tid;
      constexpr int T_GU = NEXP * 8 * 16, T_DN = NEXP * 8 * 8, T_ALL = T_GU + T_DN;
#define P0_TILE(ti, SRC, DST, ISGU) do { int r_ = (ti); ISGU = r_ < T_GU; if (ISGU) { const int e = r_ >> 7, q = r_ & 127, kt = q >> 4, nt = q & 15, n0 = nt * 128, jj = n0 & 1023; \
            SRC = w_gu + (size_t)e * DM * 2048 + (size_t)(kt * 128) * 2048 + n0; DST = Wgu_q + (size_t)e * 2048 * DM + (size_t)((jj >> 7) * 256 + (n0 >= 1024 ? 128 : 0)) * DM + kt * 128; } \
          else { r_ -= T_GU; const int e = r_ >> 6, q = r_ & 63, kt = q >> 3, nt = q & 7; \
            SRC = w_dn + (size_t)e * DEXP * DM + (size_t)(kt * 128) * DM + nt * 128; DST = Wd_q + (size_t)e * DM * DEXP + (size_t)(nt * 128) * DEXP + kt * 128; } } while (0)
      f32x4 v[8]; const float* src; unsigned char* dst; bool isgu; const float* srcn; unsigned char* dstn; bool isgun;
      int ti = blockIdx.x;
      if (ti < T_ALL) { P0_TILE(ti, src, dst, isgu); if (isgu) p0_tile_load<2048, DM>(src, v, tid); else p0_tile_load<DM, DEXP>(src, v, tid); }
      for (; ti < T_ALL; ti += F.G) {
          p0_tile_to_lds(tl, v, tid);
          __syncthreads();
          const int tn = ti + F.G;
          if (tn < T_ALL) { P0_TILE(tn, srcn, dstn, isgun); if (isgun) p0_tile_load<2048, DM>(srcn, v, tid); else p0_tile_load<DM, DEXP>(srcn, v, tid); }
          if (isgu) { const int kt_ = (int)(((size_t)(dst - Wgu_q)) & (DM - 1)); p0_tile_store<DM, true>(tl, dst, ffn_g + kt_, 64.f, tid); }
          else p0_tile_store<DEXP, false>(tl, dst, nullptr, 64.f, tid);
          __syncthreads();
          src = srcn; dst = dstn; isgu = isgun;
      }
#undef P0_TILE
    }
    bf16_t* H = (bf16_t*)(F.ws + WS_H);
    { const float* x = A->in[I_X]; const float* attn_g = A->in[I_ATTNG];
      for (int rep1_ = 0; rep1_ < ((PROBE_P0 & 2) ? 2 : 1); ++rep1_)
      for (int m = gw; m < T; m += 2 * NGW) { const int m2 = (m + NGW < T) ? m + NGW : m;
          rms_row2_to_bf16(x + (size_t)m * DM, x + (size_t)m2 * DM, attn_g, H + (size_t)m * DM, H + (size_t)m2 * DM, F.lane); } }
    const float* router_w = A->in[I_RW];
    bf16_t* wrh = (bf16_t*)(F.ws + WS_WRHI); bf16_t* wrl = (bf16_t*)(F.ws + WS_WRLO);
    for (int i = (F.vcu * NWAVES + F.wave) * 64 + F.lane; i < NEXP * DM; i += NGW * 64) { const int e = i >> 10, k = i & 1023;
        const float v = ffn_g[k] * router_w[(size_t)k * NEXP + e]; const unsigned hb = pk2(v, 0.f) & 0xffffu; const float hf = __uint_as_float(hb << 16);
        wrh[i] = (bf16_t)hb; wrl[i] = (bf16_t)(pk2(v - hf, 0.f) & 0xffffu); }
}

__device__ __forceinline__ void p2_conv_block(Frame& F, int blk, int tid_, const float* conv_w) {
    const bf16_t* proj = (const bf16_t*)(F.ws + WS_PROJ); bf16_t* mix = (bf16_t*)(F.ws + WS_MIX);
    const int cg = tid_ & 31, tc = tid_ >> 5;
    const int c0 = cg * 8, t0 = blk * 256 + tc * 16, s0 = t0 & (SEQ - 1);
    float w0[8], w1[8], w2[8];
#pragma unroll
    for (int i = 0; i < 8; ++i) { w0[i] = conv_w[c0 + i]; w1[i] = conv_w[256 + c0 + i]; w2[i] = conv_w[512 + c0 + i]; }
    float p2[8], p1[8];
#pragma unroll
    for (int i = 0; i < 8; ++i) { p2[i] = 0.f; p1[i] = 0.f; }
    if (s0 >= 2) {
        const u32x4 ua = *(const u32x4*)(proj + (size_t)(t0 - 2) * INW + COL_U + c0), ca = *(const u32x4*)(proj + (size_t)(t0 - 2) * INW + COL_GC + c0);
        const u32x4 ub = *(const u32x4*)(proj + (size_t)(t0 - 1) * INW + COL_U + c0), cb = *(const u32x4*)(proj + (size_t)(t0 - 1) * INW + COL_GC + c0);
#pragma unroll
        for (int i = 0; i < 4; ++i) { p2[2 * i] = bflo(ua[i]) * bflo(ca[i]); p2[2 * i + 1] = bfhi(ua[i]) * bfhi(ca[i]); p1[2 * i] = bflo(ub[i]) * bflo(cb[i]); p1[2 * i + 1] = bfhi(ub[i]) * bfhi(cb[i]); }
    }
    for (int tb = 0; tb < 16; tb += 4) {
        u32x4 uu[4], cc[4], bb[4];
#pragma unroll
        for (int q = 0; q < 4; ++q) { const size_t ro = (size_t)(t0 + tb + q) * INW;
            uu[q] = *(const u32x4*)(proj + ro + COL_U + c0); cc[q] = *(const u32x4*)(proj + ro + COL_GC + c0); bb[q] = *(const u32x4*)(proj + ro + COL_GB + c0); }
#pragma unroll
        for (int q = 0; q < 4; ++q) {
            float cur[8], y[8];
#pragma unroll
            for (int i = 0; i < 4; ++i) { cur[2 * i] = bflo(uu[q][i]) * bflo(cc[q][i]); cur[2 * i + 1] = bfhi(uu[q][i]) * bfhi(cc[q][i]); }
#pragma unroll
            for (int i = 0; i < 4; ++i) { y[2 * i] = bflo(bb[q][i]) * (w0[2 * i] * p2[2 * i] + w1[2 * i] * p1[2 * i] + w2[2 * i] * cur[2 * i]);
                                           y[2 * i + 1] = bfhi(bb[q][i]) * (w0[2 * i + 1] * p2[2 * i + 1] + w1[2 * i + 1] * p1[2 * i + 1] + w2[2 * i + 1] * cur[2 * i + 1]); }
            u32x4 o; o.x = pk2(y[0], y[1]); o.y = pk2(y[2], y[3]); o.z = pk2(y[4], y[5]); o.w = pk2(y[6], y[7]);
            *(u32x4*)(mix + (size_t)(t0 + tb + q) * DM + c0) = o;
#pragma unroll
            for (int i = 0; i < 8; ++i) { p2[i] = p1[i]; p1[i] = cur[i]; }
        }
    }
}
__device__ __forceinline__ void p2_mem_block(Frame& F, int blk, int lane_) {
    const bf16_t* proj = (const bf16_t*)(F.ws + WS_PROJ); bf16_t* mix = (bf16_t*)(F.ws + WS_MIX);
    const bf16_t* kmb = (const bf16_t*)(F.ws + WS_KMB); const bf16_t* vmt = (const bf16_t*)(F.ws + WS_VMT);
    const int r32 = lane_ & 31, hi = lane_ >> 5, b = blk >> 5, tw = blk * 256 + F.wave * 32, tid_ = F.wave * 64 + lane_;
    LAS unsigned char* Kl = F.lds; LAS unsigned char* Vl = F.lds + 32768;
    const int ksw = (r32 >> 1) & 7;
    u32x4 kv[4], vv[4];
#define MEM_LOAD(hm_) do { _Pragma("unroll") for (int i = 0; i < 4; ++i) { const int idx = tid_ + 512 * i; \
        kv[i] = *(const u32x4*)(kmb + (size_t)(b * 256 + (idx >> 3)) * 256 + (hm_) * 64 + (idx & 7) * 8); \
        vv[i] = *(const u32x4*)(vmt + ((size_t)((b * 4 + (hm_)) * 64 + (idx >> 5))) * 256 + (idx & 31) * 8); } } while (0)
    MEM_LOAD(0);
    for (int hm = 0; hm < 4; ++hm) {
        bf16x8 qr[4];
#pragma unroll
        for (int d0 = 0; d0 < 4; ++d0) qr[d0] = *(const bf16x8*)(proj + (size_t)(tw + r32) * INW + COL_QM + hm * 64 + d0 * 16 + hi * 8);
        __syncthreads();
#pragma unroll
        for (int i = 0; i < 4; ++i) { const int idx = tid_ + 512 * i; const int kr = idx >> 3, kc = idx & 7, vd = idx >> 5, vc = idx & 31;
            *(LAS u32x4*)(Kl + kr * 128 + ((kc ^ ((kr >> 1) & 7)) << 4)) = kv[i];
            *(LAS u32x4*)(Vl + vd * 512 + ((vc ^ (vd & 31)) << 4)) = vv[i]; }
        __syncthreads();
        if (hm < 3) MEM_LOAD(hm + 1);
        float mx = -__builtin_inff();
#pragma unroll 2
        for (int kb = 0; kb < 8; ++kb) { f32x16 p = f32x16{};
#pragma unroll
            for (int d0 = 0; d0 < 4; ++d0) { const bf16x8 kf = *(const LAS bf16x8*)(Kl + (kb * 32 + r32) * 128 + (((2 * d0 + hi) ^ ksw) << 4));
                p = __builtin_amdgcn_mfma_f32_32x32x16_bf16(kf, qr[d0], p, 0, 0, 0); }
#pragma unroll
            for (int r = 0; r < 16; ++r) mx = fmaxf(mx, p[r]); }
        mx = fmaxf(mx, __shfl_xor(mx, 32));
        float sum = 0.f;
        f32x16 o[2]; o[0] = f32x16{}; o[1] = f32x16{};
#pragma unroll 2
        for (int kb = 0; kb < 8; ++kb) { f32x16 p = f32x16{};
#pragma unroll
            for (int d0 = 0; d0 < 4; ++d0) { const bf16x8 kf = *(const LAS bf16x8*)(Kl + (kb * 32 + r32) * 128 + (((2 * d0 + hi) ^ ksw) << 4));
                p = __builtin_amdgcn_mfma_f32_32x32x16_bf16(kf, qr[d0], p, 0, 0, 0); }
#pragma unroll
            for (int r = 0; r < 16; ++r) { p[r] = __builtin_amdgcn_exp2f(p[r] - mx); sum += p[r]; }
            bf16x8 pa0, pa1;
#define PK4(P, B_, OUT) do { unsigned a0 = pk2(P[B_+0], P[B_+1]), a1 = pk2(P[B_+2], P[B_+3]); unsigned b0 = pk2(P[B_+4], P[B_+5]), b1 = pk2(P[B_+6], P[B_+7]); \
        auto r0 = __builtin_amdgcn_permlane32_swap(a0, b0, false, false); auto r1 = __builtin_amdgcn_permlane32_swap(a1, b1, false, false); \
        u32x4 w = {r0[0], r1[0], r0[1], r1[1]}; OUT = __builtin_bit_cast(bf16x8, w); } while (0)
            PK4(p, 0, pa0); PK4(p, 8, pa1);
#undef PK4
#pragma unroll
            for (int d0 = 0; d0 < 2; ++d0) { const LAS unsigned char* vrow = Vl + (d0 * 32 + r32) * 512;
                const bf16x8 v0 = *(const LAS bf16x8*)(vrow + (((kb * 4 + hi) ^ r32) << 4)), v1 = *(const LAS bf16x8*)(vrow + (((kb * 4 + 2 + hi) ^ r32) << 4));
                o[d0] = __builtin_amdgcn_mfma_f32_32x32x16_bf16(pa0, v0, o[d0], 0, 0, 0);
                o[d0] = __builtin_amdgcn_mfma_f32_32x32x16_bf16(pa1, v1, o[d0], 0, 0, 0); }
        }
        sum += __shfl_xor(sum, 32);
        const float linv = __builtin_amdgcn_rcpf(sum);
#pragma unroll
        for (int r = 0; r < 16; ++r) { const int orow = crow(r, hi); const float li = __shfl(linv, orow);
#pragma unroll
            for (int d0 = 0; d0 < 2; ++d0) { const float v = o[d0][r] * li; const float vn = __shfl_xor(v, 1);
                if ((r32 & 1) == 0) *(unsigned*)(mix + (size_t)(tw + orow) * DM + 768 + hm * 64 + d0 * 32 + r32) = pk2(v, vn); } }
    }
#undef MEM_LOAD
    __syncthreads();
}
__device__ __forceinline__ dattn::Ref da_ref(Frame& F, int n) {
    const int pid = F.vcu + (n >> 2) * F.G, sub = n & 3, blk = sub >> 1, comp = sub & 1, bh = pid >> 4, s = pid & 15, qb = blk ? 31 - s : s, b = bh >> 2, h = bh & 3;
    bf16_t* mix = (bf16_t*)(F.ws + WS_MIX);
    dattn::Ref r;
    r.qoff = (unsigned)(((size_t)(b * SEQ + qb * 256) * INW + COL_Q + h * 128 + comp * 64) * 2);
    r.koff = (unsigned)(((size_t)(b * SEQ) * INW + COL_K + h * 128 + comp * 64) * 2);
    r.voff = (unsigned)(((size_t)(b * SEQ) * INW + COL_V + h * 128) * 2);
    r.O = mix + (size_t)(b * SEQ + qb * 256) * DM + 256 + h * 128;
    r.P0 = qb * 256; r.comp = comp; r.h = h;
    return r;
}
__device__ __forceinline__ void p2_mixers(Frame& F) {
    KArgs A = kargs();
    const float* rel_bias = A->in[I_RELB]; const float* lam_qk = A->in[I_LAMQK]; const float* subln_g = A->in[I_SUBG];
    if (F.tid < 512) { const int h = F.tid >> 7, n = F.tid & 127; int bk;
        if (n < 16) bk = n; else { bk = 16; const int thr[15] = {19, 21, 24, 27, 31, 35, 40, 46, 52, 59, 67, 77, 87, 99, 113};
#pragma unroll
            for (int i = 0; i < 15; ++i) bk += (n >= thr[i]) ? 1 : 0; }
        ((LAS float*)(F.lds + dattn::OFF_TB))[h * 128 + n] = (rel_bias[bk * 4 + h] - rel_bias[31 * 4 + h]) * LOG2E; }
    float d1 = 0.f, d2 = 0.f;
    for (int i = 0; i < 64; ++i) { d1 += lam_qk[i] * lam_qk[64 + i]; d2 += lam_qk[128 + i] * lam_qk[192 + i]; }
    const float lam = __expf(d1) - __expf(d2) + 0.2f;
    if (__builtin_amdgcn_readfirstlane(F.tid) >= 256) __builtin_amdgcn_s_setprio(1);
    __syncthreads();
    const int npairs = F.vcu < 512 ? (512 - F.vcu + F.G - 1) / F.G : 0, total1 = 4 * npairs, total = ((PROBE_REP >> 2) & 1) ? 2 * total1 : total1;
#if PROBE_CLK
    const unsigned long long pc0_ = __builtin_readcyclecounter(), pr0_ = __builtin_amdgcn_s_memrealtime();
#endif
    if (total > 0) {
        dattn::Seam S; dattn::Ref cur = da_ref(F, 0);
#if PROBE_SEG
        S.acc = 0; S.tot = 0;
#endif
        const dattn::rsrc_t R = __builtin_amdgcn_make_buffer_rsrc((void*)(F.ws + WS_PROJ), 0, (int)((size_t)T * INW * 2), 0x00020000);
        const char* projb = (const char*)(F.ws + WS_PROJ);
        dattn::prime(cur, F.lds, S, R, projb);
        for (int n = 0; n < total; ++n) {
            const dattn::Ref nxt = (n + 1 < total) ? da_ref(F, (n + 1) % total1) : cur;
            dattn::block(cur, nxt, F.lds, S, lam, subln_g, R, projb);
            cur = nxt;
        }
#if PROBE_SEG
        if (blockIdx.x == 0 && F.tid == 0) { F.ctl[604] = (unsigned)(S.acc >> 4); F.ctl[605] = (unsigned)(S.tot >> 4); }
#endif
    }
#if PROBE_CLK
    if (blockIdx.x == 0 && F.tid == 0) { const unsigned long long dc_ = __builtin_readcyclecounter() - pc0_, dr_ = __builtin_amdgcn_s_memrealtime() - pr0_;
        F.ctl[600] = (unsigned)dc_; F.ctl[601] = (unsigned)(dc_ >> 32); F.ctl[602] = (unsigned)dr_; }
#endif
    __builtin_amdgcn_s_setprio(0);
    int lane2 = (int)__builtin_amdgcn_mbcnt_hi(~0u, __builtin_amdgcn_mbcnt_lo(~0u, 0u)); asm volatile("" : "+v"(lane2));
    const int tid2 = F.wave * 64 + lane2;
    const float* conv_w = kargs()->in[I_CONVW];
    for (int repx_ = 0; repx_ < ((PROBE_X & 1) ? 2 : 1); ++repx_)
    for (int blk = blockIdx.x; blk < T / 256; blk += F.G) { p2_conv_block(F, blk, tid2, conv_w); p2_mem_block(F, blk, lane2); }
}

__device__ __forceinline__ void p4_router(Frame& F, bool dry = false) {
    const float* router_b = kargs()->in[I_RB];
    const bf16_t* x1b = (const bf16_t*)(F.ws + WS_X1B); const bf16_t* wrh = (const bf16_t*)(F.ws + WS_WRHI); const bf16_t* wrl = (const bf16_t*)(F.ws + WS_WRLO);
    int* e_tk = (int*)(F.ws + WS_ETK); float* g_tk = (float*)(F.ws + WS_GTK); float* rstd_t = (float*)(F.ws + WS_RSTDT);
    LAS float* lg = (LAS float*)F.lds + F.wave * (32 * 33); LAS unsigned* hist = (LAS unsigned*)(F.lds + 8 * 32 * 33 * 4);
    const int r32 = F.lane & 31, hi = F.lane >> 5;
    for (int blk = blockIdx.x; blk < T / 256; blk += F.G) {
        if (F.tid < 32) hist[F.tid] = 0u;
        __syncthreads();
        const int t0 = blk * 256 + F.wave * 32;
        const bf16_t* xr = x1b + (size_t)(t0 + r32) * DM + hi * 8; const bf16_t* wh = wrh + (size_t)r32 * DM + hi * 8; const bf16_t* wl = wrl + (size_t)r32 * DM + hi * 8;
        f32x16 acc = f32x16{}; float ss = 0.f;
#pragma unroll 1
        for (int kq = 0; kq < DM; kq += 256) {
            u32x4 xw[16];
#pragma unroll
            for (int s_ = 0; s_ < 16; ++s_) xw[s_] = *(const u32x4*)(xr + kq + s_ * 16);
            SBAR();
#pragma unroll
            for (int sb = 0; sb < 16; sb += 4) { bf16x8 ah[4], al[4];
#pragma unroll
                for (int s_ = 0; s_ < 4; ++s_) { ah[s_] = *(const bf16x8*)(wh + kq + (sb + s_) * 16); al[s_] = *(const bf16x8*)(wl + kq + (sb + s_) * 16); }
#pragma unroll
                for (int s_ = 0; s_ < 4; ++s_) { const u32x4 xv = xw[sb + s_];
#pragma unroll
                    for (int i = 0; i < 4; ++i) { const float a = bflo(xv[i]), b2 = bfhi(xv[i]); ss += a * a + b2 * b2; }
                    const bf16x8 xb = __builtin_bit_cast(bf16x8, xv);
                    acc = __builtin_amdgcn_mfma_f32_32x32x16_bf16(ah[s_], xb, acc, 0, 0, 0);
                    acc = __builtin_amdgcn_mfma_f32_32x32x16_bf16(al[s_], xb, acc, 0, 0, 0); } }
        }
        ss += __shfl_xor(ss, 32);
        const float rstd = rsqrtf(ss * (1.f / DM) + EPS);
#pragma unroll
        for (int r = 0; r < 16; ++r) { const int e = crow(r, hi); lg[r32 * 33 + e] = acc[r] * rstd + router_b[e]; }
        LDS_WAIT(); asm volatile("" ::: "memory");
        if (F.lane < 32) {
            LAS float* row = lg + F.lane * 33; float tv[4]; int ti[4];
#pragma unroll
            for (int p = 0; p < 4; ++p) { float best = -__builtin_inff(); int bi = 0;
                for (int e = 0; e < NEXP; ++e) { const float v = row[e]; if (v > best) { best = v; bi = e; } }
                tv[p] = best; ti[p] = bi; row[bi] = -__builtin_inff(); LDS_WAIT(); asm volatile("" ::: "memory"); }
            const float w1 = __expf(tv[1] - tv[0]), w2 = __expf(tv[2] - tv[0]), w3 = __expf(tv[3] - tv[0]); const float inv = 1.f / (1.f + w1 + w2 + w3);
            const int t = t0 + F.lane;
            if (!dry) {
            *(int4*)(e_tk + (size_t)t * 4) = make_int4(ti[0], ti[1], ti[2], ti[3]);
            *(float4*)(g_tk + (size_t)t * 4) = make_float4(inv, w1 * inv, w2 * inv, w3 * inv);
            rstd_t[t] = rstd;
#pragma unroll
            for (int p = 0; p < 4; ++p) __hip_atomic_fetch_add(&hist[ti[p]], 1u, __ATOMIC_RELAXED, __HIP_MEMORY_SCOPE_WORKGROUP);
            }
        }
        __syncthreads();
        if (F.tid < 32) __hip_atomic_fetch_add(F.ctl + CW_COUNT + F.tid, hist[F.tid], RLX_AGENT);
        __syncthreads();
    }
}
__device__ __forceinline__ void p5_place(Frame& F) {
    const int* e_tk = (const int*)(F.ws + WS_ETK); const float* g_tk = (const float*)(F.ws + WS_GTK); const float* rstd_t = (const float*)(F.ws + WS_RSTDT);
    int* slot_tk = (int*)(F.ws + WS_SLOTTK); int* tok_slot = (int*)(F.ws + WS_TOKSLOT); float* gate_slot = (float*)(F.ws + WS_GATESLOT); float* rstd_slot = (float*)(F.ws + WS_RSTDSLOT);
    int* rb_e = (int*)(F.ws + WS_RBE);
    LAS int* L = (LAS int*)F.lds;
    if (F.tid < 32) { const int c = (int)__hip_atomic_load(F.ctl + CW_COUNT + F.tid, RLX_AGENT); L[F.tid] = c; L[32 + F.tid] = (c + 255) & ~255; }
    __syncthreads();
    if (F.tid < 32) { int s = 0; for (int e = 0; e < F.tid; ++e) s += L[32 + e]; L[64 + F.tid] = s; }
    __syncthreads();
    for (int blk = blockIdx.x; blk < T / 256; blk += F.G) {
        if (F.tid < 32) { L[96 + F.tid] = 0; L[128 + F.tid] = 0; }
        __syncthreads();
        int ee[2];
#pragma unroll
        for (int j = 0; j < 2; ++j) { const int i = F.tid + 512 * j; ee[j] = e_tk[(size_t)blk * 1024 + i]; __hip_atomic_fetch_add(&L[96 + ee[j]], 1, __ATOMIC_RELAXED, __HIP_MEMORY_SCOPE_WORKGROUP); }
        __syncthreads();
        if (F.tid < 32) L[160 + F.tid] = L[64 + F.tid] + (int)__hip_atomic_fetch_add(F.ctl + CW_CURSOR + F.tid, (unsigned)L[96 + F.tid], RLX_AGENT);
        __syncthreads();
#pragma unroll
        for (int j = 0; j < 2; ++j) { const int i = F.tid + 512 * j; const int r = __hip_atomic_fetch_add(&L[128 + ee[j]], 1, __ATOMIC_RELAXED, __HIP_MEMORY_SCOPE_WORKGROUP); const int pos = L[160 + ee[j]] + r;
            const int t = blk * 256 + (i >> 2);
            tok_slot[pos] = t; gate_slot[pos] = g_tk[(size_t)blk * 1024 + i]; rstd_slot[pos] = rstd_t[t]; slot_tk[(size_t)blk * 1024 + i] = pos; }
        __syncthreads();
    }
    for (int e = blockIdx.x; e < NEXP; e += F.G)
        for (int i = L[e] + F.tid; i < L[32 + e]; i += NWAVES * 64) { const int pos = L[64 + e] + i; tok_slot[pos] = 0; gate_slot[pos] = 0.f; rstd_slot[pos] = 0.f; }
    if (blockIdx.x == 0) {
        const int nrb = (L[64 + 31] + L[32 + 31]) >> 8;
        for (int rb = F.tid; rb < NRB_MAX; rb += NWAVES * 64) { int e = 31; for (int q = 0; q < 32; ++q) { if (rb * 256 >= L[64 + q] && rb * 256 < L[64 + q] + L[32 + q]) e = q; } rb_e[rb] = e; }
        if (F.tid == 0) rb_e[NRB_MAX] = nrb;
    }
}
__device__ __forceinline__ void p9_final(Frame& F) {
    const bf16_t* x1b = (const bf16_t*)(F.ws + WS_X1B); const int* slot_tk = (const int*)(F.ws + WS_SLOTTK);
    const unsigned char* Y = F.ws + WS_Y;
    const int gw = F.vcu * NWAVES + F.wave, NGW = F.G * NWAVES;
    const float* final_g = kargs()->in[I_FING];
    f32x4 gg[2][2];
#pragma unroll
    for (int j = 0; j < 2; ++j) { gg[j][0] = *(const f32x4*)(final_g + 8 * F.lane + 512 * j); gg[j][1] = *(const f32x4*)(final_g + 8 * F.lane + 512 * j + 4); }
    int4 slA = make_int4(0, 0, 0, 0), slB = slA;
    if (gw < T) { slA = *(const int4*)(slot_tk + (size_t)gw * 4); const int tb0 = (gw + NGW < T) ? gw + NGW : gw; slB = *(const int4*)(slot_tk + (size_t)tb0 * 4); }
    for (int t = gw; t < T; t += 2 * NGW) {
        const int tA = t, tB = (t + NGW < T) ? t + NGW : t;
        const int tnA = (t + 2 * NGW < T) ? t + 2 * NGW : tA, tnB = (t + 3 * NGW < T) ? t + 3 * NGW : tnA;
        const int4 nA = *(const int4*)(slot_tk + (size_t)tnA * 4), nB = *(const int4*)(slot_tk + (size_t)tnB * 4);
        const int sA[4] = {slA.x, slA.y, slA.z, slA.w}, sB[4] = {slB.x, slB.y, slB.z, slB.w};
        u32x4 xa[2], xb[2]; u32x2 ya[2][4], yb[2][4];
#pragma unroll
        for (int j = 0; j < 2; ++j) { const int c = 8 * F.lane + 512 * j;
            xa[j] = *(const u32x4*)(x1b + (size_t)tA * DM + c); xb[j] = *(const u32x4*)(x1b + (size_t)tB * DM + c);
#pragma unroll
            for (int k = 0; k < 4; ++k) { ya[j][k] = *(const u32x2*)(Y + (size_t)sA[k] * DM + c); yb[j][k] = *(const u32x2*)(Y + (size_t)sB[k] * DM + c); } }
        float va[2][8], vb[2][8]; float ssa = 0.f, ssb = 0.f;
#pragma unroll
        for (int j = 0; j < 2; ++j) {
#pragma unroll
            for (int i = 0; i < 4; ++i) { va[j][2 * i] = bflo(xa[j][i]); va[j][2 * i + 1] = bfhi(xa[j][i]); vb[j][2 * i] = bflo(xb[j][i]); vb[j][2 * i + 1] = bfhi(xb[j][i]); }
#pragma unroll
            for (int k = 0; k < 4; ++k)
#pragma unroll
                for (int w_ = 0; w_ < 2; ++w_) { const f32x2_t a0 = __builtin_amdgcn_cvt_pk_f32_fp8((int)ya[j][k][w_], false), a1 = __builtin_amdgcn_cvt_pk_f32_fp8((int)ya[j][k][w_], true);
                    const f32x2_t b0 = __builtin_amdgcn_cvt_pk_f32_fp8((int)yb[j][k][w_], false), b1 = __builtin_amdgcn_cvt_pk_f32_fp8((int)yb[j][k][w_], true);
                    va[j][4 * w_] += 0.125f * a0[0]; va[j][4 * w_ + 1] += 0.125f * a0[1]; va[j][4 * w_ + 2] += 0.125f * a1[0]; va[j][4 * w_ + 3] += 0.125f * a1[1];
                    vb[j][4 * w_] += 0.125f * b0[0]; vb[j][4 * w_ + 1] += 0.125f * b0[1]; vb[j][4 * w_ + 2] += 0.125f * b1[0]; vb[j][4 * w_ + 3] += 0.125f * b1[1]; }
#pragma unroll
            for (int i = 0; i < 8; ++i) { ssa += va[j][i] * va[j][i]; ssb += vb[j][i] * vb[j][i]; } }
        const float ra = rsqrtf(wave_sum(ssa) * (1.f / DM) + EPS), rb = rsqrtf(wave_sum(ssb) * (1.f / DM) + EPS);
#pragma unroll
        for (int j = 0; j < 2; ++j) { const int c = 8 * F.lane + 512 * j;
            f32x4 o0, o1;
            o0.x = va[j][0] * ra * gg[j][0].x; o0.y = va[j][1] * ra * gg[j][0].y; o0.z = va[j][2] * ra * gg[j][0].z; o0.w = va[j][3] * ra * gg[j][0].w;
            o1.x = va[j][4] * ra * gg[j][1].x; o1.y = va[j][5] * ra * gg[j][1].y; o1.z = va[j][6] * ra * gg[j][1].z; o1.w = va[j][7] * ra * gg[j][1].w;
            *(f32x4*)(F.out + (size_t)tA * DM + c) = o0; *(f32x4*)(F.out + (size_t)tA * DM + c + 4) = o1;
            o0.x = vb[j][0] * rb * gg[j][0].x; o0.y = vb[j][1] * rb * gg[j][0].y; o0.z = vb[j][2] * rb * gg[j][0].z; o0.w = vb[j][3] * rb * gg[j][0].w;
            o1.x = vb[j][4] * rb * gg[j][1].x; o1.y = vb[j][5] * rb * gg[j][1].y; o1.z = vb[j][6] * rb * gg[j][1].z; o1.w = vb[j][7] * rb * gg[j][1].w;
            *(f32x4*)(F.out + (size_t)tB * DM + c) = o0; *(f32x4*)(F.out + (size_t)tB * DM + c + 4) = o1; }
        slA = nA; slB = nB;
    }
}

__global__ void __launch_bounds__(NWAVES * 64, 2) hymba_fwd(Args args) {
    extern __shared__ __attribute__((aligned(16))) unsigned char lds[];
    Frame F;
    F.lds = (LAS unsigned char*)lds;
    F.MISC = (volatile LAS unsigned*)(F.lds + MISC_OFF);
    F.tid = threadIdx.x; F.lane = F.tid & 63; F.wave = __builtin_amdgcn_readfirstlane(F.tid >> 6);
    F.G = gridDim.x; { const int bx = blockIdx.x; F.vcu = (F.G % 8 == 0) ? (bx % 8) * (F.G / 8) + bx / 8 : bx; }
    F.ws = args.ws; F.ctl = (unsigned*)(args.ws + WS_CTL); F.out = args.out;
    for (int u = F.tid; u < (LDS_BYTES - LDSCTL_OFF) / 4; u += NWAVES * 64) ((LAS unsigned*)(F.lds + LDSCTL_OFF))[u] = 0u;
    __syncthreads();
    XcdBarrier bar; bar.bar = F.ctl + CW_BAR; bar.x = 0; bar.st = nullptr;
    if (N_LAUNCHES == 1) bar = xcd_barrier_post(F.ctl + CW_BAR, F.MISC + 8);
#define GRID_BAR() do { if (N_LAUNCHES == 1) xcd_barrier(bar); } while (0)
    const int lo = args.ph_lo, hi = args.ph_hi;
#ifndef PH_MASK
#define PH_MASK 0x1ff
#endif
#define IN(k) (((PH_MASK >> (k)) & 1) && lo <= (k) && (k) < hi)
#define BOTH(k) (IN(k) && IN((k) + 1))
    bf16_t* const H = (bf16_t*)(F.ws + WS_H); bf16_t* const PROJ = (bf16_t*)(F.ws + WS_PROJ); bf16_t* const MIX = (bf16_t*)(F.ws + WS_MIX); bf16_t* const X1B = (bf16_t*)(F.ws + WS_X1B);
    bf16_t* const Win_t = (bf16_t*)(F.ws + WS_WIN); bf16_t* const Wout_t = (bf16_t*)(F.ws + WS_WOUT);
    const unsigned char* const Wgu_q = F.ws + WS_WGU; const unsigned char* const Wd_q = F.ws + WS_WD;
    unsigned char* const X1Q = F.ws + WS_X1Q; unsigned char* const ACTQ = F.ws + WS_ACTQ; unsigned char* const Yp = F.ws + WS_Y;
    const int* const tok_slot = (const int*)(F.ws + WS_TOKSLOT); const float* const gate_slot = (const float*)(F.ws + WS_GATESLOT); const float* const rstd_slot = (const float*)(F.ws + WS_RSTDSLOT);
    const int* const rb_e = (const int*)(F.ws + WS_RBE);

#define REP(k) for (int rep_ = 0; rep_ < (((PROBE_REP >> (k)) & 1) ? 2 : 1); ++rep_)
    if (IN(0)) { REP(0) p0_prologue(F); if (BOTH(0)) GRID_BAR(); }
    if (IN(1)) {
        REP(1) {
        pg8::Gemm g{H, Win_t, DM, 0, nullptr}; pg8::StaticOrder S; S.init(T, INW, F.G, (int)blockIdx.x);
        pg8::EpiProj E{PROJ};
        pg8::gemm_phase<pg8::EpiProj, pg8::StaticOrder, true>(F.lds, g, S, E); }
        if (BOTH(1)) GRID_BAR();
    }
    if (IN(2)) { p2_mixers(F); if (BOTH(2)) GRID_BAR(); }
    if (IN(3)) {
        pg8::Gemm g{MIX, Wout_t, DM, 0, nullptr}; pg8::StaticOrder S; S.init(T, DM, F.G, (int)blockIdx.x);
        pg8::EpiX1 E{kargs()->in[I_X], X1B, X1Q};
        pg8::gemm_phase<pg8::EpiX1, pg8::StaticOrder, true>(F.lds, g, S, E);
        if (BOTH(3)) GRID_BAR();
    }
    if (IN(4)) { if (PROBE_X & 2) p4_router(F, true); p4_router(F); if (BOTH(4)) GRID_BAR(); }
    if (IN(5)) { p5_place(F); if (BOTH(5)) GRID_BAR(); }
    if (IN(6)) {
        const int nrb = rb_e[NRB_MAX];
        REP(6) {
        pg8::Gemm g{(const bf16_t*)X1Q, (const bf16_t*)Wgu_q, DM / 2, (long)2048 * DM / 2, tok_slot}; pg8::GroupOrder S{nrb, 0, 8, F.G, (int)blockIdx.x, rb_e};
        pg8::EpiGU E{ACTQ, kargs()->in[I_BGU], rstd_slot};
        pg8::gemm_phase<pg8::EpiGU, pg8::GroupOrder, true, true, (PROBE_KREP == 2 ? 0x78787878 : 0x79797979), 0x7f7f7f7f, PROBE_KREP>(F.lds, g, S, E); }
        if (BOTH(6)) GRID_BAR();
    }
    if (IN(7)) {
        const int nrb = rb_e[NRB_MAX];
        REP(7) {
        pg8::Gemm g{(const bf16_t*)ACTQ, (const bf16_t*)Wd_q, DEXP / 2, (long)DM * DEXP / 2, nullptr}; pg8::GroupOrder S{nrb, 0, 4, F.G, (int)blockIdx.x, rb_e};
        pg8::EpiDown E{Yp, kargs()->in[I_BDN], gate_slot};
        pg8::gemm_phase<pg8::EpiDown, pg8::GroupOrder, true, true, 0x79797979, 0x7d7d7d7d>(F.lds, g, S, E); }
        if (BOTH(7)) GRID_BAR();
    }
    if (IN(8)) { REP(8) p9_final(F); }
#if PROBE_SEG
    if (IN(8) && blockIdx.x == 0 && F.tid == 0) { const unsigned long long a_ = F.ctl[604], t_ = F.ctl[605]; const unsigned long long us_ = t_ ? a_ * 2000ull / t_ : 0ull; const unsigned long long t0_ = __builtin_amdgcn_s_memrealtime();
        while (__builtin_amdgcn_s_memrealtime() - t0_ < us_ * 100ull) __builtin_amdgcn_s_sleep(8); }
#endif
#if PROBE_CLK
    if (IN(8) && blockIdx.x == 0 && F.tid == 0) { const unsigned long long dc_ = ((unsigned long long)F.ctl[601] << 32) | F.ctl[600]; const unsigned long long dr_ = F.ctl[602];
        const unsigned long long mhz_ = dr_ ? dc_ * 100ull / dr_ : 0ull; const unsigned long long t0_ = __builtin_amdgcn_s_memrealtime();
        while (__builtin_amdgcn_s_memrealtime() - t0_ < mhz_ * 100ull) __builtin_amdgcn_s_sleep(8); }
#endif
#undef IN
#undef BOTH
#undef GRID_BAR
}

extern "C" void kernel_launch(void* const* d_in, const int* in_sizes, int n_in, void* d_out, int out_size, void* d_ws, size_t ws_size, hipStream_t stream) {
    static int grid = 0;
    if (grid == 0) {
        if (n_in != 19 || out_size != T * DM || ws_size < WS_END) { fprintf(stderr, "kernel_launch: unexpected shapes (n_in %d out %d ws %zu)\n", n_in, out_size, ws_size); grid = -1; return; }
        int dev = 0, cus = 0;
        if (hipGetDevice(&dev) != hipSuccess || hipDeviceGetAttribute(&cus, hipDeviceAttributeMultiprocessorCount, dev) != hipSuccess) { grid = -1; return; }
        if (hipFuncSetAttribute((const void*)hymba_fwd, hipFuncAttributeMaxDynamicSharedMemorySize, LDS_BYTES) != hipSuccess) { fprintf(stderr, "kernel_launch: hipFuncSetAttribute failed\n"); grid = -1; return; }
        int per_cu = 0;
        if (hipOccupancyMaxActiveBlocksPerMultiprocessor(&per_cu, (const void*)hymba_fwd, NWAVES * 64, LDS_BYTES) != hipSuccess || per_cu < 1) fprintf(stderr, "kernel_launch: occupancy query reports %d\n", per_cu);
        (void)hipGetLastError();
        grid = cus;
    }
    if (grid < 0) return;
    if (hipMemsetAsync((char*)d_ws + WS_CTL, 0, CTL_ZERO_BYTES, stream) != hipSuccess) return;
    Args a{};
    for (int i = 0; i < 19; ++i) a.in[i] = (const float*)d_in[i];
    a.out = (float*)d_out; a.ws = (unsigned char*)d_ws;
    for (int li = 0; li < N_LAUNCHES; ++li) {
        a.ph_lo = (N_LAUNCHES == 1) ? 0 : li; a.ph_hi = (N_LAUNCHES == 1) ? N_PHASES : li + 1;
        hipLaunchKernelGGL(hymba_fwd, dim3(grid), dim3(NWAVES * 64), LDS_BYTES, stream, a);
    }
}
```

```cpp
#include <hip/hip_runtime.h>
#include <hip/hip_bf16.h>
#include <cstdio>
#include <cstdint>

#ifndef PROBE_REP
#define PROBE_REP 0
#endif
#ifndef PROBE_X
#define PROBE_X 0
#endif
#ifndef PROBE_P0
#define PROBE_P0 0
#endif
#ifndef PROBE_SEG
#define PROBE_SEG 0
#endif
#ifndef PROBE_CLK
#define PROBE_CLK 0
#endif
#ifndef PROBE_KREP
#define PROBE_KREP 1
#endif
#ifndef PROBE_EPI
#define PROBE_EPI 0
#endif
#ifndef MK_N_LAUNCHES
#define MK_N_LAUNCHES 1
#endif

constexpr int BATCH = 8, SEQ = 8192, DM = 1024, T = BATCH * SEQ, INW = 2560, MEML = 256, NEXP = 32, TOPK = 4, DEXP = 1024;
constexpr int COL_U = 0, COL_GB = 256, COL_GC = 512, COL_Q = 768, COL_K = 1280, COL_V = 1792, COL_QM = 2304;
constexpr float EPS = 1e-5f;
constexpr float C2 = 0.125f * 1.4426950408889634f;
constexpr float LOG2E = 1.4426950408889634f;
constexpr int NRB_MAX = 1056;

#define GAS __attribute__((address_space(1)))
#define LAS __attribute__((address_space(3)))
typedef unsigned short bf16_t;
typedef short bf16x8 __attribute__((ext_vector_type(8)));
typedef short s16x4 __attribute__((ext_vector_type(4)));
typedef float f32x4 __attribute__((ext_vector_type(4)));
typedef float f32x16 __attribute__((ext_vector_type(16)));
typedef unsigned u32x4 __attribute__((ext_vector_type(4)));
typedef unsigned u32x2 __attribute__((ext_vector_type(2)));
typedef float f32x2_t __attribute__((ext_vector_type(2)));
typedef __bf16 bf16x2_t __attribute__((ext_vector_type(2)));
typedef GAS unsigned gu32;
#define RLX_AGENT __ATOMIC_RELAXED, __HIP_MEMORY_SCOPE_AGENT
#define LDS_WAIT() asm volatile("s_waitcnt lgkmcnt(0)" ::: "memory")
#define VM_WAIT() asm volatile("s_waitcnt vmcnt(0)" ::: "memory")
#define SBAR() __builtin_amdgcn_sched_barrier(0)

__device__ __forceinline__ unsigned pk2(float lo, float hi) { f32x2_t v = {lo, hi}; bf16x2_t b = __builtin_convertvector(v, bf16x2_t); return __builtin_bit_cast(unsigned, b); }
__device__ __forceinline__ float bflo(unsigned u) { return __uint_as_float(u << 16); }
__device__ __forceinline__ float bfhi(unsigned u) { return __uint_as_float(u & 0xffff0000u); }
__device__ __forceinline__ bf16x8 pack8(f32x4 a, f32x4 b) { u32x4 w = {pk2(a[0], a[1]), pk2(a[2], a[3]), pk2(b[0], b[1]), pk2(b[2], b[3])}; return __builtin_bit_cast(bf16x8, w); }
__device__ __forceinline__ int crow(int r, int hi) { return (r & 3) + 8 * (r >> 2) + 4 * hi; }
__device__ __forceinline__ float wave_sum(float v) {
#pragma unroll
    for (int o = 1; o < 64; o <<= 1) v += __shfl_xor(v, o);
    return v;
}

namespace pg8 {
constexpr int BM = 256, BK = 64, HALF = 128, HTB = HALF * BK * 2  , STAGE_BYTES = 8 * HTB, NXCD = 8, WGM = 8;
__host__ __device__ __forceinline__ int lds_byte(int r, int c) { const int st = (r >> 4) * 2 + (c >> 5), rr = r & 15, cc = c & 31, ob = rr * 64 + cc * 2; return st * 1024 + (ob ^ (((ob >> 9) & 1) << 5)); }
__host__ __device__ __forceinline__ void stage_rc(int b, int& R, int& C) { const int st = b / 1024, sb = b % 1024, swz = sb ^ (((sb >> 9) & 1) << 5); R = (st >> 1) * 16 + swz / 64; C = (st & 1) * 32 + (swz % 64) / 2; }
__host__ __device__ __forceinline__ int perm32(int rho) { const int n = rho >> 4, i = rho & 15; return 8 * (i >> 2) + 4 * n + (i & 3); }

struct Unit { int pm, pn, e; };
struct Gemm { const bf16_t* A; const bf16_t* Bt; int K; long bstride; const int* rowmap; };

struct StaticOrder {
    int nM, nN, nwg, G, c;
    __device__ void init(int M, int N, int G_, int c_) { nM = M / BM; nN = N / BM; nwg = nM * nN; G = G_; c = c_; }
    __device__ bool next(int i, Unit& u) const {
        const long L = (long)i * G + c; if (L >= nwg) return false;
        int wgid = (int)L; { const int q = nwg / NXCD, r = nwg % NXCD, xcd = wgid % NXCD, off = wgid / NXCD; wgid = (xcd < r ? xcd * (q + 1) : r * (q + 1) + (xcd - r) * q) + off; }
        const int nig = WGM * nN, gid = wgid / nig, fm = gid * WGM, gsz = (nM - fm) < WGM ? (nM - fm) : WGM;
        u.pm = fm + ((wgid % nig) % gsz); u.pn = (wgid % nig) / gsz; u.e = 0; return true;
    }
};
struct GroupOrder {
    int nrb, rb0, npn, G, c; const int* rb_e;
    __device__ bool next(int i, Unit& u) const {
        int rbl, pn;
        if ((G & 7) == 0 && ((G >> 3) % npn) == 0) { const int x = c & 7, j = c >> 3, rpx = (G >> 3) / npn; rbl = i * (G / npn) + x * rpx + j / npn; pn = j % npn; }
        else { const long L = (long)i * G + c; rbl = (int)(L / npn); pn = (int)(L % npn); }
        if (rbl >= nrb) return false;
        u.pm = rb0 + rbl; u.pn = pn; u.e = rb_e[u.pm]; return true;
    }
};

typedef int v4i_t __attribute__((ext_vector_type(4)));
typedef int v8i_t __attribute__((ext_vector_type(8)));
template <class Epi, class Sched, bool ALIGN_EPI, bool FP8 = false, int SCW = 0x7f7f7f7f, int SCA = 0x7f7f7f7f, int KREP = 1>
__device__ __forceinline__ void gemm_phase(LAS unsigned char* lds, const Gemm g, const Sched& S, const Epi& E) {
    const int tid = threadIdx.x, wid = __builtin_amdgcn_readfirstlane(tid >> 6), lane = tid & 63, wr = wid >> 2, wc = wid & 3, fr = lane & 15, fq = lane >> 4;
    const int K = g.K; int nt = K / BK; asm volatile("" : "+s"(nt));
    int Rr[2], Cc[2]; unsigned voffB[2];
#pragma unroll
    for (int i = 0; i < 2; ++i) { int R, C; stage_rc(tid * 16 + i * 8192, R, C); const int Rb = Epi::PERM ? ((R & ~31) + perm32(R & 31)) : R;
        Rr[i] = R; Cc[i] = C; voffB[i] = (unsigned)(Rb * K + C) * 2u; }
    const size_t kstep = (size_t)(BK * 2);
    const size_t hstep = (size_t)HALF * K * 2;
    const size_t tstep = 2 * hstep;
    const unsigned ldsw = (unsigned)wid * 1024u;
    const int aoff = lds_byte(wr * 64 + fr, fq * 8), boff = lds_byte(wc * 32 + fr, fq * 8);
#define PG8_SA(b, h) (((b) * 2 + (h)) * HTB)
#define PG8_SB(b, h) ((4 + (b) * 2 + (h)) * HTB)
#define PG8_STAGE(bufoff, gbase, voff) do { _Pragma("unroll") for (int _i = 0; _i < 2; ++_i) \
        __builtin_amdgcn_global_load_lds((const unsigned*)((const char*)(gbase) + (voff)[_i]), (LAS unsigned*)(lds + (bufoff) + ldsw + _i * 8192), 16, 0, 0); } while (0)
#define PG8_STAGE_A(bufoff, kptr, offs, h) do { _Pragma("unroll") for (int _i = 0; _i < 2; ++_i) \
        __builtin_amdgcn_global_load_lds((const unsigned*)((const char*)(kptr) + (offs)[h][_i]), (LAS unsigned*)(lds + (bufoff) + ldsw + _i * 8192), 16, 0, 0); } while (0)
#define PG8_AOFF(dst, u) do { _Pragma("unroll") for (int _h = 0; _h < 2; ++_h) _Pragma("unroll") for (int _i = 0; _i < 2; ++_i) { const int _row = (u).pm * BM + _h * HALF + Rr[_i]; \
        const int _src = g.rowmap ? g.rowmap[_row] : _row; dst[_h][_i] = (unsigned)(_src * K + Cc[_i]) * 2u; } } while (0)
#define PG8_LDA(dst, b, h) do { _Pragma("unroll") for (int m = 0; m < 4; ++m) _Pragma("unroll") for (int k = 0; k < 2; ++k) dst[m][k] = *(const LAS bf16x8*)(lds + PG8_SA(b, h) + aoff + m * 2048 + k * 1024); } while (0)
#define PG8_LDB(dst, b, h) do { _Pragma("unroll") for (int n = 0; n < 2; ++n) _Pragma("unroll") for (int k = 0; k < 2; ++k) dst[n][k] = *(const LAS bf16x8*)(lds + PG8_SB(b, h) + boff + n * 2048 + k * 1024); } while (0)
#define PG8_CAT(x, y) __builtin_shufflevector(__builtin_bit_cast(v4i_t, x), __builtin_bit_cast(v4i_t, y), 0, 1, 2, 3, 4, 5, 6, 7)
#define PG8_MMA(ai, bj, At, Bt) do { __builtin_amdgcn_s_setprio(1); _Pragma("unroll") for (int m = 0; m < 4; ++m) _Pragma("unroll") for (int n = 0; n < 2; ++n) { \
        if constexpr (FP8) { acc[ai][bj][m][n] = __builtin_amdgcn_mfma_scale_f32_16x16x128_f8f6f4(PG8_CAT(Bt[n][0], Bt[n][1]), PG8_CAT(At[m][0], At[m][1]), acc[ai][bj][m][n], 0, 0, 0, SCW, 0, SCA); } \
        else { _Pragma("unroll") for (int k = 0; k < 2; ++k) acc[ai][bj][m][n] = __builtin_amdgcn_mfma_f32_16x16x32_bf16(Bt[n][k], At[m][k], acc[ai][bj][m][n], 0, 0, 0); } } \
        __builtin_amdgcn_s_setprio(0); } while (0)
#define PG8_WAIT_V(n) asm volatile("s_waitcnt vmcnt(" #n ")" ::: "memory")
#define PG8_WAIT_L(n) asm volatile("s_waitcnt lgkmcnt(" #n ")" ::: "memory")
#define PG8_BAR __builtin_amdgcn_s_barrier()
#define PG8_SCHED __builtin_amdgcn_sched_barrier(0)
    Unit cur, nxt; int ui = 0;
    if (!S.next(0, cur)) return;
    f32x4 acc[2][2][4][2];
#pragma unroll
    for (int a = 0; a < 2; ++a)
#pragma unroll
        for (int b = 0; b < 2; ++b)
#pragma unroll
            for (int m = 0; m < 4; ++m)
#pragma unroll
                for (int n = 0; n < 2; ++n) acc[a][b][m][n] = (f32x4){0.f, 0.f, 0.f, 0.f};
    bf16x8 At[4][2], B0[2][2], B1[2][2];
    unsigned aoc[2][2], aon[2][2];
    PG8_AOFF(aoc, cur);
    const char* Ab = (const char*)g.A;
    const char* cB = (const char*)g.Bt + ((size_t)cur.e * (size_t)g.bstride) * 2 + (size_t)cur.pn * tstep;
    PG8_STAGE(PG8_SB(0, 0), cB, voffB); PG8_STAGE(PG8_SB(0, 1), cB + hstep, voffB); PG8_STAGE_A(PG8_SA(0, 0), Ab, aoc, 0); PG8_STAGE_A(PG8_SA(0, 1), Ab, aoc, 1);
    if (wr == 1) PG8_BAR;
    PG8_WAIT_V(2); PG8_BAR;
    PG8_STAGE(PG8_SB(1, 0), cB + kstep, voffB); PG8_STAGE_A(PG8_SA(1, 0), Ab + kstep, aoc, 0); PG8_STAGE(PG8_SB(1, 1), cB + hstep + kstep, voffB);
    PG8_WAIT_V(6); PG8_BAR;
    for (;;) {
        const bool has_next = S.next(ui + 1, nxt);
        if (has_next) { PG8_AOFF(aon, nxt); }
        else {
#pragma unroll
            for (int h = 0; h < 2; ++h)
#pragma unroll
                for (int i = 0; i < 2; ++i) aon[h][i] = aoc[h][i];
        }
        const char* nB = has_next ? (const char*)g.Bt + ((size_t)nxt.e * (size_t)g.bstride) * 2 + (size_t)nxt.pn * tstep : cB;
#pragma nounroll
        for (int t = 0; t < nt * KREP; t += 2) {
            const bool last = (t == nt * KREP - 2);
            const char* a1 = Ab + (size_t)((t + 1) & (nt - 1)) * kstep;
            const char* a2 = last ? Ab : Ab + (size_t)((t + 2) & (nt - 1)) * kstep; const char* b2 = last ? nB : cB + (size_t)((t + 2) & (nt - 1)) * kstep;
            const char* a3 = a2 + kstep; const char* b3 = b2 + kstep;
            PG8_LDB(B0, 0, 0); PG8_LDB(B1, 0, 1); PG8_SCHED; PG8_LDA(At, 0, 0); PG8_STAGE_A(PG8_SA(1, 1), a1, aoc, 1);
            if (last) {
#pragma unroll
                for (int h = 0; h < 2; ++h)
#pragma unroll
                    for (int i = 0; i < 2; ++i) aoc[h][i] = aon[h][i]; }
            PG8_WAIT_V(8); PG8_WAIT_L(0); PG8_BAR; PG8_MMA(0, 0, At, B0); PG8_MMA(0, 1, At, B1); PG8_BAR; PG8_SCHED;
            PG8_LDA(At, 0, 1); PG8_STAGE(PG8_SB(0, 0), b2, voffB); PG8_STAGE(PG8_SB(0, 1), b2 + hstep, voffB); PG8_STAGE_A(PG8_SA(0, 0), a2, aoc, 0);
            PG8_WAIT_V(8); PG8_WAIT_L(0); PG8_BAR; PG8_MMA(1, 0, At, B0); PG8_MMA(1, 1, At, B1); PG8_BAR; PG8_SCHED;
            PG8_LDB(B0, 1, 0); PG8_LDB(B1, 1, 1); PG8_SCHED; PG8_LDA(At, 1, 0); PG8_STAGE_A(PG8_SA(0, 1), a2, aoc, 1);
            PG8_WAIT_V(8); PG8_WAIT_L(0); PG8_BAR; PG8_MMA(0, 0, At, B0); PG8_MMA(0, 1, At, B1); PG8_BAR; PG8_SCHED;
            PG8_LDA(At, 1, 1); PG8_STAGE(PG8_SB(1, 0), b3, voffB); PG8_STAGE(PG8_SB(1, 1), b3 + hstep, voffB); PG8_STAGE_A(PG8_SA(1, 0), a3, aoc, 0);
            PG8_WAIT_V(8); PG8_WAIT_L(0); PG8_BAR; PG8_MMA(1, 0, At, B0); PG8_MMA(1, 1, At, B1); PG8_BAR; PG8_SCHED;
        }
        if constexpr (ALIGN_EPI) { if (wr == 0) PG8_BAR; }
        E(acc, cur, wr, wc, fr, fq);
        if constexpr (FP8 && PROBE_EPI != 0) { asm volatile("" ::: "memory"); E(acc, cur, wr, wc, fr, fq); }
        if (!has_next) break;
#pragma unroll
        for (int a = 0; a < 2; ++a)
#pragma unroll
            for (int b = 0; b < 2; ++b)
#pragma unroll
                for (int m = 0; m < 4; ++m)
#pragma unroll
                    for (int n = 0; n < 2; ++n) acc[a][b][m][n] = (f32x4){0.f, 0.f, 0.f, 0.f};
        cur = nxt; cB = nB; ++ui;
        if constexpr (ALIGN_EPI) { if (wr == 1) PG8_BAR; }
    }
    PG8_WAIT_V(0);
    if constexpr (!ALIGN_EPI) { if (wr == 0) PG8_BAR; }
    PG8_BAR;
#undef PG8_SA
#undef PG8_SB
#undef PG8_STAGE
#undef PG8_STAGE_A
#undef PG8_AOFF
#undef PG8_LDA
#undef PG8_LDB
#undef PG8_MMA
#undef PG8_CAT
#undef PG8_WAIT_V
#undef PG8_WAIT_L
#undef PG8_BAR
#undef PG8_SCHED
}

struct EpiProj {
    static constexpr bool PERM = true;
    bf16_t* O; const float* rstd;
    __device__ __forceinline__ void operator()(const f32x4 (&acc)[2][2][4][2], const Unit& u, int wr, int wc, int fr, int fq) const {
        const int row0 = u.pm * BM + wr * 64 + fr, col0 = u.pn * BM + wc * 32 + 8 * fq;
        const float sc = (u.pn == 3 || u.pn == 4 || u.pn == 9) ? C2 : 1.f;
        float rsv[2][4];
#pragma unroll
        for (int ai = 0; ai < 2; ++ai)
#pragma unroll
            for (int m = 0; m < 4; ++m) rsv[ai][m] = rstd[row0 + ai * HALF + m * 16] * sc;
#pragma unroll
        for (int ai = 0; ai < 2; ++ai)
#pragma unroll
            for (int m = 0; m < 4; ++m) { bf16_t* rowp = O + (size_t)(row0 + ai * HALF + m * 16) * INW + col0; const float rs = rsv[ai][m];
#pragma unroll
                for (int bj = 0; bj < 2; ++bj) { const f32x4 v0 = acc[ai][bj][m][0] * rs, v1 = acc[ai][bj][m][1] * rs;
                    u32x4 w; w.x = pk2(v0[0], v0[1]); w.y = pk2(v0[2], v0[3]); w.z = pk2(v1[0], v1[1]); w.w = pk2(v1[2], v1[3]);
                    *(u32x4*)(rowp + bj * HALF) = w; } }
    }
};
__device__ __forceinline__ unsigned pk4_fp8(float a, float b, float c, float d) { int w = 0; w = __builtin_amdgcn_cvt_pk_fp8_f32(a, b, w, false); w = __builtin_amdgcn_cvt_pk_fp8_f32(c, d, w, true); return (unsigned)w; }
struct EpiX1 {
    static constexpr bool PERM = true;
    const bf16_t* XB; bf16_t* O; unsigned char* Q8;
    __device__ __forceinline__ void operator()(const f32x4 (&acc)[2][2][4][2], const Unit& u, int wr, int wc, int fr, int fq) const {
        const int row0 = u.pm * BM + wr * 64 + fr, col0 = u.pn * BM + wc * 32 + 8 * fq;
        const bf16_t* __restrict__ Xr = XB; bf16_t* __restrict__ Or = O; unsigned char* __restrict__ Qr = Q8;
        u32x4 xv[2][4][2];
#pragma unroll
        for (int ai = 0; ai < 2; ++ai)
#pragma unroll
            for (int m = 0; m < 4; ++m) { const size_t off = (size_t)(row0 + ai * HALF + m * 16) * DM + col0;
#pragma unroll
                for (int bj = 0; bj < 2; ++bj) xv[ai][m][bj] = *(const u32x4*)(Xr + off + bj * HALF); }
#pragma unroll
        for (int ai = 0; ai < 2; ++ai)
#pragma unroll
            for (int m = 0; m < 4; ++m) { const size_t off = (size_t)(row0 + ai * HALF + m * 16) * DM + col0;
#pragma unroll
                for (int bj = 0; bj < 2; ++bj) { const u32x4 xw = xv[ai][m][bj];
                    const f32x4 x0 = {bflo(xw.x), bfhi(xw.x), bflo(xw.y), bfhi(xw.y)}, x1 = {bflo(xw.z), bfhi(xw.z), bflo(xw.w), bfhi(xw.w)};
                    const f32x4 v0 = acc[ai][bj][m][0] + x0, v1 = acc[ai][bj][m][1] + x1;
                    u32x4 w; w.x = pk2(v0[0], v0[1]); w.y = pk2(v0[2], v0[3]); w.z = pk2(v1[0], v1[1]); w.w = pk2(v1[2], v1[3]);
                    *(u32x4*)(Or + off + bj * HALF) = w;
                    u32x2 q; q.x = pk4_fp8(v0[0], v0[1], v0[2], v0[3]); q.y = pk4_fp8(v1[0], v1[1], v1[2], v1[3]);
                    *(u32x2*)(Qr + off + bj * HALF) = q; } }
    }
};
struct EpiGU {
    static constexpr bool PERM = true;
    unsigned char* ACT; const float* bias; const float* rstd;
    __device__ __forceinline__ void operator()(const f32x4 (&acc)[2][2][4][2], const Unit& u, int wr, int wc, int fr, int fq) const {
        const int row0 = u.pm * BM + wr * 64 + fr, j0 = u.pn * HALF + wc * 32 + 8 * fq;
        const float* bp = bias + (size_t)u.e * 2048 + j0;
        const f32x4 bg0 = *(const f32x4*)(bp), bg1 = *(const f32x4*)(bp + 4), bu0 = *(const f32x4*)(bp + 1024), bu1 = *(const f32x4*)(bp + 1028);
        float rsv[2][4];
#pragma unroll
        for (int ai = 0; ai < 2; ++ai)
#pragma unroll
            for (int m = 0; m < 4; ++m) rsv[ai][m] = rstd[row0 + ai * HALF + m * 16];
#pragma unroll
        for (int ai = 0; ai < 2; ++ai)
#pragma unroll
            for (int m = 0; m < 4; ++m) { const int row = row0 + ai * HALF + m * 16; const float rs = rsv[ai][m];
                float o[8];
#pragma unroll
                for (int h2 = 0; h2 < 2; ++h2) { const f32x4 ga = h2 ? acc[ai][0][m][1] : acc[ai][0][m][0], ua = h2 ? acc[ai][1][m][1] : acc[ai][1][m][0], gb = h2 ? bg1 : bg0, ub = h2 ? bu1 : bu0;
#pragma unroll
                    for (int p2 = 0; p2 < 2; ++p2) { const f32x2_t gacc = {ga[2 * p2], ga[2 * p2 + 1]}, uacc = {ua[2 * p2], ua[2 * p2 + 1]}, gbv = {gb[2 * p2], gb[2 * p2 + 1]}, ubv = {ub[2 * p2], ub[2 * p2 + 1]};
                        f32x2_t gg = gacc * rs + gbv, uu = uacc * rs + ubv;
                        gg[0] = fminf(gg[0], 7.f); gg[1] = fminf(gg[1], 7.f); uu[0] = __builtin_amdgcn_fmed3f(uu[0], -7.f, 7.f); uu[1] = __builtin_amdgcn_fmed3f(uu[1], -7.f, 7.f);
                        const f32x2_t tt = gg * (-1.702f * LOG2E); f32x2_t ee; ee[0] = __builtin_amdgcn_exp2f(tt[0]); ee[1] = __builtin_amdgcn_exp2f(tt[1]);
                        const f32x2_t dd = ee * 0.25f + 0.25f; f32x2_t rr; rr[0] = __builtin_amdgcn_rcpf(dd[0]); rr[1] = __builtin_amdgcn_rcpf(dd[1]);
                        const f32x2_t s4 = gg * rr, oo = uu * s4 + s4;
                        o[4 * h2 + 2 * p2] = oo[0]; o[4 * h2 + 2 * p2 + 1] = oo[1]; } }
                u32x2 w; w.x = pk4_fp8(o[0], o[1], o[2], o[3]); w.y = pk4_fp8(o[4], o[5], o[6], o[7]);
                *(u32x2*)(ACT + (size_t)row * DEXP + j0) = w; }
    }
};
struct EpiDown {
    static constexpr bool PERM = true;
    unsigned char* Y; const float* bias; const float* gate;
    __device__ __forceinline__ void operator()(const f32x4 (&acc)[2][2][4][2], const Unit& u, int wr, int wc, int fr, int fq) const {
        const int row0 = u.pm * BM + wr * 64 + fr, col0 = u.pn * BM + wc * 32 + 8 * fq;
        const float* bp = bias + (size_t)u.e * DM + col0;
        f32x4 bv[2][2];
#pragma unroll
        for (int bj = 0; bj < 2; ++bj) { bv[bj][0] = *(const f32x4*)(bp + bj * HALF); bv[bj][1] = *(const f32x4*)(bp + bj * HALF + 4); }
        float gsv[2][4];
#pragma unroll
        for (int ai = 0; ai < 2; ++ai)
#pragma unroll
            for (int m = 0; m < 4; ++m) gsv[ai][m] = 8.f * gate[row0 + ai * HALF + m * 16];
#pragma unroll
        for (int ai = 0; ai < 2; ++ai)
#pragma unroll
            for (int m = 0; m < 4; ++m) { const int row = row0 + ai * HALF + m * 16; const float gs = gsv[ai][m];
#pragma unroll
                for (int bj = 0; bj < 2; ++bj) { const f32x4 v0 = (acc[ai][bj][m][0] + bv[bj][0]) * gs, v1 = (acc[ai][bj][m][1] + bv[bj][1]) * gs;
                    u32x2 w; w.x = pk4_fp8(v0[0], v0[1], v0[2], v0[3]); w.y = pk4_fp8(v1[0], v1[1], v1[2], v1[3]);
                    *(u32x2*)(Y + (size_t)row * DM + col0 + bj * HALF) = w; } }
    }
};
}

namespace dattn {
constexpr int NW = 8, QBLK = 32, KVBLK = 64, QB = 256, PITCH = INW;
constexpr int SHM_V = KVBLK * 128 * 2, SHM_K = KVBLK * 64 * 2;
constexpr int NVS = 4, NKS = 3;
constexpr int OFF_V = 0, OFF_K = NVS * SHM_V, OFF_WS = OFF_K + NKS * SHM_K, OFF_STASH = OFF_WS + NW * 64 * 4, OFF_TB = OFF_STASH + NW * 8192, LDS_BYTES = OFF_TB + 4 * 128 * 4;
constexpr float THR = 8.f;
__device__ __forceinline__ int v_st(int k, int c) { const int kk = k;     return ((kk >> 3) * 4 + (c >> 5)) * 512 + ((kk & 7) * 32 + (c & 31)) * 2; }
__device__ __forceinline__ int v_rd_base(int lane) { return ((lane & 3) << 3) | (((lane >> 2) & 3) << 6) | (((lane >> 4) & 1) << 5) | (((lane >> 5) & 1) << 8); }
constexpr int v_rd_off(int d0, int ks, int half) { return d0 * 512 + ks * 4096 + half * 2048; }

struct Ref { unsigned qoff, koff, voff; bf16_t* O; int P0, comp, h; };
typedef __amdgpu_buffer_rsrc_t rsrc_t;
__device__ __forceinline__ bf16x8 bld8(rsrc_t r, unsigned voff, unsigned soff) { return __builtin_bit_cast(bf16x8, __builtin_amdgcn_raw_buffer_load_b128(r, (int)voff, (int)soff, 0)); }
struct Seam { bf16x8 qr[4]; int ks, vs;
#if PROBE_SEG
    unsigned long long acc, tot;
#endif
};

__device__ __forceinline__ bf16x8 ld8(const bf16_t* p) { return *reinterpret_cast<const bf16x8*>(p); }

__device__ __forceinline__ void bias_mask(f32x16& p0, f32x16& p1, int sdq  , const LAS float* tb) {
    const float NEG = -__builtin_inff();
    int lane_ = (int)__builtin_amdgcn_mbcnt_hi(~0u, __builtin_amdgcn_mbcnt_lo(~0u, 0u));
    int dq = sdq + (lane_ & 31) - 4 * (lane_ >> 5);
    asm volatile("" : "+v"(dq));
#pragma unroll
    for (int r = 0; r < 16; ++r) {
        const int c = (r & 3) + 8 * (r >> 2);
        const int d0 = dq - c, d1 = dq - c - 32;
        const int i0 = d0 < 0 ? 0 : (d0 > 127 ? 127 : d0), i1 = d1 < 0 ? 0 : (d1 > 127 ? 127 : d1);
        const float b0 = tb[i0], b1 = tb[i1];
        p0[r] = d0 < 0 ? NEG : p0[r] + b0;
        p1[r] = d1 < 0 ? NEG : p1[r] + b1;
    }
}
__device__ __forceinline__ void partialSM(f32x16& p0, f32x16& p1, float& m_reg, float& alpha) {
    float pmax = p0[0];
#pragma unroll
    for (int r = 1; r < 16; ++r) pmax = fmaxf(pmax, p0[r]);
#pragma unroll
    for (int r = 0; r < 16; ++r) pmax = fmaxf(pmax, p1[r]);
    { auto rr = __builtin_amdgcn_permlane32_swap(__float_as_uint(pmax), __float_as_uint(pmax), false, false);
      pmax = fmaxf(__uint_as_float(rr[0]), __uint_as_float(rr[1])); }
    float mn;
    if (__builtin_expect(__all((pmax - m_reg) <= THR), 1)) { mn = m_reg; alpha = 1.f; }
    else { mn = fmaxf(m_reg, pmax); alpha = __builtin_amdgcn_exp2f(m_reg - mn); m_reg = mn; }
#pragma unroll
    for (int r = 0; r < 16; ++r) p0[r] = p0[r] - mn;
#pragma unroll
    for (int r = 0; r < 16; ++r) p1[r] = p1[r] - mn;
#pragma unroll
    for (int r = 0; r < 16; ++r) p0[r] = __builtin_amdgcn_exp2f(p0[r]);
}
__device__ __forceinline__ void finishSM(f32x16& p0, f32x16& p1, float alpha, float& l_reg, bf16x8& pa0, bf16x8& pa1, bf16x8& pa2, bf16x8& pa3) {
#pragma unroll
    for (int r = 0; r < 16; ++r) p1[r] = __builtin_amdgcn_exp2f(p1[r]);
    float ps = 0;
#pragma unroll
    for (int r = 0; r < 16; ++r) ps += p0[r];
#pragma unroll
    for (int r = 0; r < 16; ++r) ps += p1[r];
    { auto rr = __builtin_amdgcn_permlane32_swap(__float_as_uint(ps), __float_as_uint(ps), false, false);
      ps = __uint_as_float(rr[0]) + __uint_as_float(rr[1]); }
    l_reg = l_reg * alpha + ps;
#define PK4(P, B_, OUT) do { unsigned a0 = pk2(P[B_+0], P[B_+1]), a1 = pk2(P[B_+2], P[B_+3]);                          \
        unsigned b0 = pk2(P[B_+4], P[B_+5]), b1 = pk2(P[B_+6], P[B_+7]);                                             \
        auto r0 = __builtin_amdgcn_permlane32_swap(a0, b0, false, false); auto r1 = __builtin_amdgcn_permlane32_swap(a1, b1, false, false); \
        u32x4 w = {r0[0], r1[0], r0[1], r1[1]}; OUT = __builtin_bit_cast(bf16x8, w); } while (0)
    PK4(p0, 0, pa0); PK4(p0, 8, pa1); PK4(p1, 0, pa2); PK4(p1, 8, pa3);
#undef PK4
}
template <int KB>
__device__ __forceinline__ void qkt(f32x16& p0, f32x16& p1, const LAS unsigned char* K_lds, int r32, int hi, const bf16x8* qr) {
    p0 = f32x16{}; p1 = f32x16{};
    const int s = (r32 >> 1) & 7;
#pragma unroll
    for (int d0 = 0; d0 < 4; ++d0) {
        const LAS unsigned char* a = K_lds + KB * SHM_K + r32 * 128 + (((2 * d0 + hi) ^ s) << 4);
        const bf16x8 b0 = *(const LAS bf16x8*)(a);
        const bf16x8 b1 = *(const LAS bf16x8*)(a + 32 * 128);
        p0 = __builtin_amdgcn_mfma_f32_32x32x16_bf16(b0, qr[d0], p0, 0, 0, 0);
        p1 = __builtin_amdgcn_mfma_f32_32x32x16_bf16(b1, qr[d0], p1, 0, 0, 0); }
}
__device__ __forceinline__ void pv_tile(f32x16* o, int vb0, bf16x8 pa0, bf16x8 pa1, bf16x8 pa2, bf16x8 pa3) {
#define TRRD(dst, off) asm volatile("ds_read_b64_tr_b16 %0, %1 offset:%2" : "=&v"(dst) : "v"(vb0), "i"(off) : "memory")
#define PV_D0(d0) do { s16x4 l0, l1, l2, l3, h0, h1, h2, h3; constexpr int b_ = v_rd_off(d0, 0, 0); \
        TRRD(l0, b_); TRRD(h0, b_ + 2048); TRRD(l1, b_ + 4096); TRRD(h1, b_ + 6144); TRRD(l2, b_ + 8192); TRRD(h2, b_ + 10240); TRRD(l3, b_ + 12288); TRRD(h3, b_ + 14336); \
        asm volatile("s_waitcnt lgkmcnt(0)" ::: "memory"); SBAR();   \
        o[d0] = __builtin_amdgcn_mfma_f32_32x32x16_bf16(pa0, (bf16x8){l0[0], l0[1], l0[2], l0[3], h0[0], h0[1], h0[2], h0[3]}, o[d0], 0, 0, 0);   \
        o[d0] = __builtin_amdgcn_mfma_f32_32x32x16_bf16(pa1, (bf16x8){l1[0], l1[1], l1[2], l1[3], h1[0], h1[1], h1[2], h1[3]}, o[d0], 0, 0, 0);   \
        o[d0] = __builtin_amdgcn_mfma_f32_32x32x16_bf16(pa2, (bf16x8){l2[0], l2[1], l2[2], l2[3], h2[0], h2[1], h2[2], h2[3]}, o[d0], 0, 0, 0);   \
        o[d0] = __builtin_amdgcn_mfma_f32_32x32x16_bf16(pa3, (bf16x8){l3[0], l3[1], l3[2], l3[3], h3[0], h3[1], h3[2], h3[3]}, o[d0], 0, 0, 0); } while (0)
    PV_D0(0); PV_D0(1); PV_D0(2); PV_D0(3);
#undef PV_D0
#undef TRRD
}

#define DA_DMA16(gp, ldsp) __builtin_amdgcn_global_load_lds((const unsigned*)(gp), (LAS unsigned*)(ldsp), 16, 0, 0)
#define DA_STAGE(koff_, voff_, k0, ksoff, vsoff) do { const size_t tb_ = (size_t)(k0) * (PITCH * 2); \
        DA_DMA16(projb + (koff_) + tb_ + lk, K_lds + (ksoff) + wid * 1024); \
        DA_DMA16(projb + (voff_) + tb_ + lv, V_lds + (vsoff) + wid * 2048); \
        DA_DMA16(projb + (voff_) + tb_ + lv + 128, V_lds + (vsoff) + wid * 2048 + 1024); } while (0)
#define DA_LANE_OFFS() const int krow_ = 8 * wid + (lane >> 3); \
        const unsigned lk = (unsigned)(krow_ * PITCH) * 2u + (unsigned)(((lane & 7) ^ ((krow_ >> 1) & 7)) << 4); \
        const unsigned lv = (unsigned)((8 * wid + ((lane & 31) >> 2)) * PITCH) * 2u + (unsigned)(((lane >> 5) * 32 + (lane & 3) * 8) * 2)

__device__ __forceinline__ void prime(const Ref& cur, LAS unsigned char* lds, Seam& S, rsrc_t R, const char* projb) {
    const int tid = threadIdx.x, wid = __builtin_amdgcn_readfirstlane(tid >> 6), lane = tid & 63, r32 = lane & 31, hi = lane >> 5;
    DA_LANE_OFFS();
    const unsigned lq = (unsigned)((wid * QBLK + r32) * PITCH + hi * 8) * 2u;
    LAS unsigned char* K_lds = lds + OFF_K; LAS unsigned char* V_lds = lds + OFF_V;
#pragma unroll
    for (int d0 = 0; d0 < 4; ++d0) S.qr[d0] = bld8(R, lq + d0 * 32, cur.qoff);
    S.ks = 0; S.vs = 0;
    DA_STAGE(cur.koff, cur.voff, 0, 0, 0); DA_STAGE(cur.koff, cur.voff, KVBLK, SHM_K, SHM_V);
    asm volatile("s_waitcnt vmcnt(0)" ::: "memory");
    __syncthreads();
}
__device__ __forceinline__ void block(const Ref& cur, const Ref& nxt, LAS unsigned char* lds, Seam& S, float lam, const float* gsub, rsrc_t R, const char* projb) {
    const int tid = threadIdx.x, wid = __builtin_amdgcn_readfirstlane(tid >> 6), lane = tid & 63, r32 = lane & 31, hi = lane >> 5;
    const int NT = (cur.P0 + QB) / KVBLK;
    const int qlo = cur.P0 + wid * QBLK;
    LAS unsigned char* V_lds = lds + OFF_V; LAS unsigned char* K_lds = lds + OFF_K;
    LAS float* ws = (LAS float*)(lds + OFF_WS) + wid * 64; LAS float* li_l = ws; LAS float* al_l = ws + 32;
    const LAS float* tbh = (const LAS float*)(lds + OFF_TB) + cur.h * 128;
    float mhat = 0.f, l_reg = 0.f, rmx = 0.f; f32x16 o[4] = {}; f32x16 negm = f32x16{};
    bool resc = false;
    const int vb0 = (int)(unsigned)(uintptr_t)V_lds + v_rd_base(lane);
    DA_LANE_OFFS();
    const unsigned Kh = cur.koff, Vh = cur.voff;
#define KNEXT(x) (((x) == (NKS - 1) * SHM_K) ? 0 : (x) + SHM_K)
#define VNEXT(x) (((x) == (NVS - 1) * SHM_V) ? 0 : (x) + SHM_V)
    int k0 = S.ks, k1 = KNEXT(k0), k2 = KNEXT(k1);
    int v1 = S.vs, v2 = VNEXT(v1), v3 = VNEXT(v2), v0 = VNEXT(v3);
#define ROT() do { const int kn_ = k0; k0 = k1; k1 = k2; k2 = kn_; const int vn_ = v0; v0 = v1; v1 = v2; v2 = v3; v3 = vn_; } while (0)
#define STREAM(j) do { const bool in_ = (j) < NT; const unsigned ko_ = in_ ? Kh : nxt.koff, vo_ = in_ ? Vh : nxt.voff; const int tj_ = in_ ? (j) : (j) - NT; DA_STAGE(ko_, vo_, KBASE(tj_), k2, v3); } while (0)
#define STEP_BAR() asm volatile("s_waitcnt vmcnt(3) lgkmcnt(0)\n\ts_barrier" ::: "memory")
    const int ksw = (r32 >> 1) & 7;
    const LAS unsigned char* kbase = K_lds + r32 * 128;
#define KBASE(t) ((t) * KVBLK)
#define NEAR(P0_, P1_, t) do { const int kb_ = KBASE(t); if (kb_ >= qlo - 175) bias_mask(P0_, P1_, qlo - kb_, tbh); } while (0)
#define RESC() do { if (resc) { asm volatile("s_waitcnt lgkmcnt(0)" ::: "memory");              \
                     _Pragma("unroll") for (int d_ = 0; d_ < 4; ++d_) _Pragma("unroll") for (int r = 0; r < 16; ++r) o[d_][r] *= al_l[crow(r, hi)]; } } while (0)
#define PIN(x) asm volatile("" : "+v"(x))
#define EX(v) __builtin_amdgcn_exp2f(v)
#define MX3(a, b, c) __builtin_fmaxf(__builtin_fmaxf((a), (b)), (c))
#define DECIDE(C0, C1, FIRST) do { \
        float a_ = MX3(C0[0], C0[1], C1[0]), b_ = MX3(C0[2], C0[3], C1[1]); a_ = MX3(a_, C1[2], C1[3]); \
        _Pragma("unroll") for (int r = 4; r < 16; r += 4) { a_ = MX3(a_, C0[r], C0[r + 1]); b_ = MX3(b_, C0[r + 2], C0[r + 3]); a_ = MX3(a_, C1[r], C1[r + 1]); b_ = MX3(b_, C1[r + 2], C1[r + 3]); } \
        float rm_ = __builtin_fmaxf(a_, b_); { auto rr_ = __builtin_amdgcn_permlane32_swap(__float_as_uint(rm_), __float_as_uint(rm_), false, false); rm_ = __builtin_fmaxf(__uint_as_float(rr_[0]), __uint_as_float(rr_[1])); } \
        resc = false; \
        if ((FIRST) || __builtin_expect(__any(rm_ > THR), 0)) { const float dl_ = (FIRST) ? rm_ : __builtin_fmaxf(rm_, 0.f); mhat += dl_; \
            _Pragma("unroll") for (int r = 0; r < 16; ++r) { C0[r] -= dl_; C1[r] -= dl_; } \
            _Pragma("unroll") for (int r = 0; r < 16; ++r) negm[r] = -mhat; \
            asm volatile("" : "+v"(negm)); \
            if (!(FIRST)) { const float f_ = EX(-dl_); l_reg *= f_; if (hi == 0) al_l[r32] = f_; resc = true; } } } while (0)
#define DECIDE2(C0, C1) do { float rm_ = rmx; { auto rr_ = __builtin_amdgcn_permlane32_swap(__float_as_uint(rm_), __float_as_uint(rm_), false, false); rm_ = __builtin_fmaxf(__uint_as_float(rr_[0]), __uint_as_float(rr_[1])); } \
        resc = false; \
        if (__builtin_expect(__any(rm_ > THR), 0)) { const float dl_ = __builtin_fmaxf(rm_, 0.f); mhat += dl_; const float f_ = EX(-dl_); \
            _Pragma("unroll") for (int r = 0; r < 16; ++r) { C0[r] *= f_; C1[r] *= f_; } \
            _Pragma("unroll") for (int r = 0; r < 16; ++r) negm[r] = -mhat; \
            asm volatile("" : "+v"(negm)); \
            l_reg *= f_; if (hi == 0) al_l[r32] = f_; resc = true; } } while (0)
#define KF(d0, hf) (*(const LAS bf16x8*)(kbase + k0 + (((2 * (d0) + hi) ^ ksw) << 4) + (hf) * 4096))
#define GAPA(MF, P, B, W) do { MF; sacc += P[B]; sacc += P[B + 1]; sacc += P[B + 2]; sacc += P[B + 3]; PIN(sacc); W[((B) >> 1) & 3] = pk2(P[B], P[B + 1]); W[(((B) >> 1) & 3) + 1] = pk2(P[B + 2], P[B + 3]); PIN(W); SBAR(); } while (0)
#define PHASE_A(C0, C1, P0, P1) do { \
        const bf16x8 k00 = KF(0, 0), k01 = KF(0, 1), k10 = KF(1, 0), k11 = KF(1, 1), k20 = KF(2, 0), k21 = KF(2, 1), k30 = KF(3, 0), k31 = KF(3, 1); \
        float sacc = 0.f; SBAR(); \
        GAPA(C0 = __builtin_amdgcn_mfma_f32_32x32x16_bf16(k00, S.qr[0], negm, 0, 0, 0), P0, 0, pw0); \
        GAPA(C1 = __builtin_amdgcn_mfma_f32_32x32x16_bf16(k01, S.qr[0], negm, 0, 0, 0), P0, 4, pw0); \
        GAPA(C0 = __builtin_amdgcn_mfma_f32_32x32x16_bf16(k10, S.qr[1], C0, 0, 0, 0), P0, 8, pw1); \
        GAPA(C1 = __builtin_amdgcn_mfma_f32_32x32x16_bf16(k11, S.qr[1], C1, 0, 0, 0), P0, 12, pw1); \
        GAPA(C0 = __builtin_amdgcn_mfma_f32_32x32x16_bf16(k20, S.qr[2], C0, 0, 0, 0), P1, 0, pw2); \
        GAPA(C1 = __builtin_amdgcn_mfma_f32_32x32x16_bf16(k21, S.qr[2], C1, 0, 0, 0), P1, 4, pw2); \
        GAPA(C0 = __builtin_amdgcn_mfma_f32_32x32x16_bf16(k30, S.qr[3], C0, 0, 0, 0), P1, 8, pw3); \
        GAPA(C1 = __builtin_amdgcn_mfma_f32_32x32x16_bf16(k31, S.qr[3], C1, 0, 0, 0), P1, 12, pw3); \
        l_reg += sacc; } while (0)
#define TRRD(dst, off) asm volatile("ds_read_b64_tr_b16 %0, %1 offset:%2" : "=&v"(dst) : "v"(vbr), "i"(off) : "memory")
#define VRD8(L0, H0, L1, H1, L2, H2, L3, H3, VBv, d0) do { constexpr int b_ = v_rd_off(d0, 0, 0); \
        TRRD(L0, b_); TRRD(H0, b_ + 2048); TRRD(L1, b_ + 4096); TRRD(H1, b_ + 6144); TRRD(L2, b_ + 8192); TRRD(H2, b_ + 10240); TRRD(L3, b_ + 12288); TRRD(H3, b_ + 14336); } while (0)
#define VF(L, H) (bf16x8){L[0], L[1], L[2], L[3], H[0], H[1], H[2], H[3]}
#define PAF(k) __builtin_bit_cast(bf16x8, pw##k)
#define GAPB(MF, X, B) do { MF; rmx = MX3(rmx, X[B], X[(B) + 1]); X[B] = EX(X[B]); X[(B) + 1] = EX(X[(B) + 1]); PIN(X); PIN(rmx); SBAR(); } while (0)
#define PV4(d0, L0, H0, L1, H1, L2, H2, L3, H3, X, B) do { \
        GAPB(o[d0] = __builtin_amdgcn_mfma_f32_32x32x16_bf16(PAF(0), VF(L0, H0), o[d0], 0, 0, 0), X, (B)); \
        GAPB(o[d0] = __builtin_amdgcn_mfma_f32_32x32x16_bf16(PAF(1), VF(L1, H1), o[d0], 0, 0, 0), X, (B) + 2); \
        GAPB(o[d0] = __builtin_amdgcn_mfma_f32_32x32x16_bf16(PAF(2), VF(L2, H2), o[d0], 0, 0, 0), X, (B) + 4); \
        GAPB(o[d0] = __builtin_amdgcn_mfma_f32_32x32x16_bf16(PAF(3), VF(L3, H3), o[d0], 0, 0, 0), X, (B) + 6); } while (0)
#define LWAIT(n) do { asm volatile("s_waitcnt lgkmcnt(" #n ")" ::: "memory"); SBAR(); } while (0)
#define PHASE_B(C0, C1, VBv) do { s16x4 a0, a1, a2, a3, a4, a5, a6, a7, b0, b1, b2, b3, b4, b5, b6, b7; const int vbr = vb0 + (VBv); rmx = -__builtin_inff(); \
        asm volatile("s_waitcnt lgkmcnt(0)" ::: "memory"); SBAR(); \
        VRD8(a0, a1, a2, a3, a4, a5, a6, a7, VBv, 0); VRD8(b0, b1, b2, b3, b4, b5, b6, b7, VBv, 1); LWAIT(8); \
        PV4(0, a0, a1, a2, a3, a4, a5, a6, a7, C0, 0); \
        VRD8(a0, a1, a2, a3, a4, a5, a6, a7, VBv, 2); LWAIT(8); \
        PV4(1, b0, b1, b2, b3, b4, b5, b6, b7, C0, 8); \
        VRD8(b0, b1, b2, b3, b4, b5, b6, b7, VBv, 3); LWAIT(8); \
        PV4(2, a0, a1, a2, a3, a4, a5, a6, a7, C1, 0); \
        LWAIT(0); \
        PV4(3, b0, b1, b2, b3, b4, b5, b6, b7, C1, 8); } while (0)
    f32x16 pA0, pA1, pB0, pB1; u32x4 pw0, pw1, pw2, pw3;
#if PROBE_SEG
    unsigned long long pst_ = __builtin_readcyclecounter();
#define STAMP(k) do { const unsigned long long n_ = __builtin_readcyclecounter(); if ((k) == PROBE_SEG) S.acc += n_ - pst_; S.tot += n_ - pst_; pst_ = n_; } while (0)
#else
#define STAMP(k) do { } while (0)
#endif
    STREAM(2);
    SBAR();
    {
      const bf16x8 k00 = KF(0, 0), k01 = KF(0, 1), k10 = KF(1, 0), k11 = KF(1, 1), k20 = KF(2, 0), k21 = KF(2, 1), k30 = KF(3, 0), k31 = KF(3, 1);
      pA0 = __builtin_amdgcn_mfma_f32_32x32x16_bf16(k00, S.qr[0], negm, 0, 0, 0); pA1 = __builtin_amdgcn_mfma_f32_32x32x16_bf16(k01, S.qr[0], negm, 0, 0, 0);
      pA0 = __builtin_amdgcn_mfma_f32_32x32x16_bf16(k10, S.qr[1], pA0, 0, 0, 0); pA1 = __builtin_amdgcn_mfma_f32_32x32x16_bf16(k11, S.qr[1], pA1, 0, 0, 0);
      pA0 = __builtin_amdgcn_mfma_f32_32x32x16_bf16(k20, S.qr[2], pA0, 0, 0, 0); pA1 = __builtin_amdgcn_mfma_f32_32x32x16_bf16(k21, S.qr[2], pA1, 0, 0, 0);
      pA0 = __builtin_amdgcn_mfma_f32_32x32x16_bf16(k30, S.qr[3], pA0, 0, 0, 0); pA1 = __builtin_amdgcn_mfma_f32_32x32x16_bf16(k31, S.qr[3], pA1, 0, 0, 0); }
    NEAR(pA0, pA1, 0); DECIDE(pA0, pA1, true);
#pragma unroll
    for (int r = 0; r < 16; ++r) { pA0[r] = EX(pA0[r]); pA1[r] = EX(pA1[r]); }
    STEP_BAR();
    ROT();
#define STEP(C0, C1, P0, P1, t) do { SBAR(); STAMP(5); \
        STREAM((t) + 2); SBAR(); \
        PHASE_A(C0, C1, P0, P1); SBAR(); STAMP(1); \
        NEAR(C0, C1, (t)); SBAR(); STAMP(2); \
        PHASE_B(C0, C1, v0); DECIDE2(C0, C1); SBAR(); STAMP(3); \
        RESC(); STEP_BAR(); STAMP(4); ROT(); } while (0)
    int t = 1;
    for (; t + 2 < NT; t += 2) {
        STEP(pB0, pB1, pA0, pA1, t);
        STEP(pA0, pA1, pB0, pB1, t + 1);
    }
    SBAR(); STREAM(NT + 1); SBAR();
    PHASE_A(pB0, pB1, pA0, pA1);
    { const unsigned lq = (unsigned)((wid * QBLK + r32) * PITCH + hi * 8) * 2u;
#pragma unroll
      for (int d0 = 0; d0 < 4; ++d0) S.qr[d0] = bld8(R, lq + d0 * 32, nxt.qoff); }
    SBAR();
    NEAR(pB0, pB1, NT - 1); SBAR();
    PHASE_B(pB0, pB1, v0); DECIDE2(pB0, pB1);
    RESC();
    { float sacc = 0.f;
#pragma unroll
      for (int r = 0; r < 16; ++r) { sacc += pB0[r]; sacc += pB1[r]; }
      l_reg += sacc;
      pw0 = (u32x4){pk2(pB0[0], pB0[1]), pk2(pB0[2], pB0[3]), pk2(pB0[4], pB0[5]), pk2(pB0[6], pB0[7])}; pw1 = (u32x4){pk2(pB0[8], pB0[9]), pk2(pB0[10], pB0[11]), pk2(pB0[12], pB0[13]), pk2(pB0[14], pB0[15])};
      pw2 = (u32x4){pk2(pB1[0], pB1[1]), pk2(pB1[2], pB1[3]), pk2(pB1[4], pB1[5]), pk2(pB1[6], pB1[7])}; pw3 = (u32x4){pk2(pB1[8], pB1[9]), pk2(pB1[10], pB1[11]), pk2(pB1[12], pB1[13]), pk2(pB1[14], pB1[15])};
      SBAR(); pv_tile(o, vb0 + v1, PAF(0), PAF(1), PAF(2), PAF(3)); }
    asm volatile("s_waitcnt vmcnt(0)" ::: "memory");
    ROT(); S.ks = k0; S.vs = v1;
    { auto rr = __builtin_amdgcn_permlane32_swap(__float_as_uint(l_reg), __float_as_uint(l_reg), false, false); l_reg = __uint_as_float(rr[0]) + __uint_as_float(rr[1]); }
    int lane_e = (int)__builtin_amdgcn_mbcnt_hi(~0u, __builtin_amdgcn_mbcnt_lo(~0u, 0u)); asm volatile("" : "+v"(lane_e));
    const int r32e = lane_e & 31, hie = lane_e >> 5;
    if (hi == 0) li_l[r32] = l_reg; asm volatile("s_waitcnt lgkmcnt(0)" ::: "memory");
    float rli[16];
#pragma unroll
    for (int r = 0; r < 16; ++r) rli[r] = __builtin_amdgcn_rcpf(li_l[crow(r, hi)]);
    LAS unsigned* st = (LAS unsigned*)(lds + OFF_STASH + wid * 8192) + lane_e;
    if (cur.comp == 0) {
#pragma unroll
        for (int r = 0; r < 16; ++r) { st[(2 * r) * 64] = pk2(o[0][r] * rli[r], o[1][r] * rli[r]); st[(2 * r + 1) * 64] = pk2(o[2][r] * rli[r], o[3][r] * rli[r]); }
    } else {
        float ss[16];
#pragma unroll
        for (int r = 0; r < 16; ++r) { const unsigned u0 = st[(2 * r) * 64], u1 = st[(2 * r + 1) * 64];
            const float s2 = lam * rli[r];
            o[0][r] = bflo(u0) - s2 * o[0][r]; o[1][r] = bfhi(u0) - s2 * o[1][r]; o[2][r] = bflo(u1) - s2 * o[2][r]; o[3][r] = bfhi(u1) - s2 * o[3][r];
            ss[r] = (o[0][r] * o[0][r] + o[1][r] * o[1][r]) + (o[2][r] * o[2][r] + o[3][r] * o[3][r]); }
#pragma unroll
        for (int r = 0; r < 16; ++r) {
#pragma unroll
            for (int x = 1; x < 32; x <<= 1) ss[r] += __shfl_xor(ss[r], x);
            ss[r] = rsqrtf(ss[r] * (1.f / 128.f) + EPS) * 0.8f; }
        float gg[4];
#pragma unroll
        for (int d0 = 0; d0 < 4; ++d0) gg[d0] = gsub[d0 * 32 + r32e];
        bf16_t* Ow = cur.O + (size_t)(wid * QBLK) * DM;
#pragma unroll
        for (int r = 0; r < 16; ++r) { const int orow = crow(r, hie);
#pragma unroll
            for (int d0 = 0; d0 < 4; ++d0) { const float v = o[d0][r] * ss[r] * gg[d0]; const float vn = __shfl_xor(v, 1);
                if ((r32e & 1) == 0) *(unsigned*)(Ow + (size_t)orow * DM + d0 * 32 + r32e) = pk2(v, vn); } }
    }
    __syncthreads();
#undef RESC
#undef KBASE
#undef NEAR
#undef PIN
#undef EX
#undef MX3
#undef DECIDE
#undef DECIDE2
#undef KF
#undef GAPA
#undef PHASE_A
#undef TRRD
#undef VRD8
#undef VF
#undef PAF
#undef GAPB
#undef PV4
#undef LWAIT
#undef PHASE_B
#undef STEP
#undef STAMP
#undef ROT
#undef KNEXT
#undef VNEXT
#undef STREAM
#undef STEP_BAR
}
#undef DA_DMA16
#undef DA_STAGE
#undef DA_LANE_OFFS
}

constexpr int NWAVES = 8;
constexpr int N_LAUNCHES = MK_N_LAUNCHES;
constexpr int N_PHASES = 9;
static_assert(N_LAUNCHES == 1 || N_LAUNCHES == N_PHASES, "MK_N_LAUNCHES is 1 or 9");

constexpr size_t MiB = 1u << 20;
constexpr size_t WS_CTL = 0, CTL_ZERO_BYTES = 1 * MiB;
constexpr size_t WS_ETK = 1 * MiB, WS_GTK = 2 * MiB, WS_RSTDT = 3 * MiB, WS_SLOTTK = 4 * MiB, WS_TOKSLOT = 5 * MiB, WS_GATESLOT = 7 * MiB, WS_RSTDSLOT = 9 * MiB, WS_RBE = 11 * MiB;
constexpr size_t WS_WRHI = 12 * MiB, WS_WRLO = 12 * MiB + 65536, WS_KMB = 13 * MiB, WS_VMT = 14 * MiB;
constexpr size_t WS_WIN = 16 * MiB, WS_WOUT = 21 * MiB, WS_X1B = 24 * MiB, WS_X1Q = 152 * MiB;
constexpr size_t WS_BIG = 216 * MiB;
constexpr size_t WS_H = WS_BIG, WS_PROJ = WS_BIG + 128 * MiB, WS_MIX = WS_BIG + 448 * MiB;
constexpr size_t WS_ACTQ = WS_BIG, WS_Y = WS_BIG + 264 * MiB;
constexpr size_t WS_WGU = 792 * MiB, WS_WD = 856 * MiB;
constexpr size_t WS_RSTDX = 888 * MiB;
constexpr size_t WS_END = 889 * MiB;
static_assert(WS_MIX + (size_t)T * DM * 2 <= WS_WGU && WS_END <= 1024 * MiB, "d_ws map");
constexpr int CW_BAR = 4096, CW_COUNT = 1024, CW_CURSOR = 2048;
constexpr int RING_BYTES = 159744, LDSCTL_OFF = RING_BYTES, MISC_OFF = LDSCTL_OFF + 320, LDS_BYTES = 163840;
static_assert(dattn::LDS_BYTES <= RING_BYTES, "attention scratch");

#define XB_TMO      128
#define XB_XCNT(j)  (256  + 64 * (j))
#define XB_XSUB(j)  (1280 + 64 * (j))
#define XB_XGEN(j)  (2304 + 64 * (j))
#define XB_TOP      3328
#define XB_TOPGEN   3392
#define XCD_BAR_WORDS 3456
#define XB_SPIN_CAP (1u << 18)
__device__ __forceinline__ unsigned xb_ld(unsigned* p)              { return __hip_atomic_load(p, __ATOMIC_RELAXED, __HIP_MEMORY_SCOPE_AGENT); }
__device__ __forceinline__ unsigned xb_add(unsigned* p, unsigned v) { return __hip_atomic_fetch_add(p, v, __ATOMIC_RELAXED, __HIP_MEMORY_SCOPE_AGENT); }
__device__ __forceinline__ unsigned xb_xcc_id() { return (unsigned)__builtin_amdgcn_s_getreg((3 << 11) | 20) & 0xFu; }
#define XB_SPIN(cond, bar) do { unsigned _sp = 0; while (cond) { __builtin_amdgcn_s_sleep(1); \
    if ((++_sp & 255u) == 0u) { if (xb_ld(&(bar)[XB_TMO])) break; if (_sp > XB_SPIN_CAP) { atomicAdd(&(bar)[XB_TMO], 1u); break; } } } } while (0)
struct XcdBarrier { unsigned* bar; unsigned x; volatile LAS unsigned* st; };
__device__ __forceinline__ XcdBarrier xcd_barrier_post(unsigned* bar, volatile LAS unsigned* st) {
    XcdBarrier b; b.bar = bar; b.x = xb_xcc_id(); b.st = st;
    if (threadIdx.x == 0) (void)xb_add(&bar[XB_XCNT(b.x)], 1u);
    return b;
}
__device__ __forceinline__ void xcd_barrier_complete(unsigned* bar, unsigned x, unsigned& nloc, unsigned& nx) {
    const unsigned G = gridDim.x * gridDim.y * gridDim.z;
    unsigned sum, cnt, mine, sp = 0u;
    for (;;) {
        sum = 0u; cnt = 0u; mine = 0u;
#pragma unroll
        for (unsigned j = 0; j < 16; ++j) { const unsigned c = xb_ld(&bar[XB_XCNT(j)]); sum += c; cnt += (c > 0u) ? 1u : 0u; mine = (j == x) ? c : mine; }
        if (sum == G) break;
        __builtin_amdgcn_s_sleep(1);
        if ((++sp & 255u) == 0u) { if (xb_ld(&bar[XB_TMO])) break; if (sp > XB_SPIN_CAP) { atomicAdd(&bar[XB_TMO], 1u); break; } }
    }
    nloc = mine > 0u ? mine : 1u; nx = cnt > 0u ? cnt : 1u;
}
__device__ __forceinline__ void xcd_barrier(const XcdBarrier& b) {
    asm volatile("s_waitcnt vmcnt(0)" ::: "memory");
    __syncthreads();
    if (threadIdx.x == 0) {
        unsigned* bar = b.bar;
        __builtin_amdgcn_s_waitcnt(0);
        unsigned nloc = b.st[0], nx = b.st[1];
        if (nloc == 0u) { xcd_barrier_complete(bar, b.x, nloc, nx); b.st[0] = nloc; b.st[1] = nx; }
        const unsigned old = xb_add(&bar[XB_XSUB(b.x)], 1u);
        const unsigned gen = old / nloc;
        if (old + 1u == (gen + 1u) * nloc) {
            __builtin_amdgcn_fence(__ATOMIC_RELEASE, "agent");
            asm volatile("s_waitcnt vmcnt(0)" ::: "memory");
            const unsigned og = xb_add(&bar[XB_TOP], 1u);
            const unsigned tg = og / nx;
            if (og + 1u == (tg + 1u) * nx) xb_add(&bar[XB_TOPGEN], 1u);
            else XB_SPIN(xb_ld(&bar[XB_TOPGEN]) == tg, bar);
            __builtin_amdgcn_fence(__ATOMIC_ACQUIRE, "agent");
            xb_add(&bar[XB_XGEN(b.x)], 1u);
            asm volatile("s_waitcnt vmcnt(0)" ::: "memory");
        } else {
            XB_SPIN(xb_ld(&bar[XB_XGEN(b.x)]) == gen, bar);
            __builtin_amdgcn_fence(__ATOMIC_ACQUIRE, "agent");
            asm volatile("s_waitcnt vmcnt(0)" ::: "memory");
        }
    }
    __syncthreads();
}

struct Frame {
    LAS unsigned char* lds;
    volatile LAS unsigned* MISC;
    unsigned* ctl;
    int tid, lane, wave, vcu, G;
    float* out;
    unsigned char* ws;
};
struct Args { const float* in[19]; float* out; unsigned char* ws; int ph_lo, ph_hi; };
typedef const __attribute__((address_space(4))) Args* KArgs;
__device__ __forceinline__ KArgs kargs() { KArgs p = (KArgs)__builtin_amdgcn_kernarg_segment_ptr(); asm volatile("" : "+s"(p)); return p; }
enum { I_X = 0, I_MEM, I_RELB, I_ATTNG, I_WIN, I_CONVW, I_LAMQK, I_SUBG, I_MEMG, I_WMEMKV, I_WOUT, I_FFNG, I_RW, I_RB, I_WGU, I_BGU, I_WDN, I_BDN, I_FING };

template <bool GAIN, bool F8>
__device__ __forceinline__ void p0_transpose_item(const float* W, int K, int N, void* WTv, int k0, int n0, int drow0, const float* kgain, float scale, LAS float* scr, int lane) {
    float v[32];
    const float* wp = W + (size_t)(k0 + (lane >> 5)) * N + n0 + (lane & 31);
#pragma unroll
    for (int i = 0; i < 32; ++i) v[i] = wp[(size_t)(2 * i) * N];
    const int c = lane & 7;
    f32x4 g0 = {scale, scale, scale, scale}, g1 = g0;
    if constexpr (GAIN) { g0 = *(const f32x4*)(kgain + k0 + 8 * c) * scale; g1 = *(const f32x4*)(kgain + k0 + 8 * c + 4) * scale; }
#pragma unroll
    for (int i = 0; i < 32; ++i) scr[(2 * i + (lane >> 5)) * 33 + (lane & 31)] = v[i];
    LDS_WAIT(); asm volatile("" ::: "memory");
#pragma unroll
    for (int j = 0; j < 4; ++j) { const int n = (lane >> 3) + 8 * j; const LAS float* s = scr + (8 * c) * 33 + n;
        const float e0 = s[0 * 33] * g0[0], e1 = s[1 * 33] * g0[1], e2 = s[2 * 33] * g0[2], e3 = s[3 * 33] * g0[3], e4 = s[4 * 33] * g1[0], e5 = s[5 * 33] * g1[1], e6 = s[6 * 33] * g1[2], e7 = s[7 * 33] * g1[3];
        if constexpr (F8) { u32x2 o; o.x = pg8::pk4_fp8(e0, e1, e2, e3); o.y = pg8::pk4_fp8(e4, e5, e6, e7);
            *(u32x2*)((unsigned char*)WTv + (size_t)(drow0 + n) * K + k0 + 8 * c) = o; }
        else { u32x4 o; o.x = pk2(e0, e1); o.y = pk2(e2, e3); o.z = pk2(e4, e5); o.w = pk2(e6, e7);
            *(u32x4*)((bf16_t*)WTv + (size_t)(drow0 + n) * K + k0 + 8 * c) = o; } }
    LDS_WAIT(); asm volatile("" ::: "memory");
}
__device__ __forceinline__ void cast_row2_bf16_rstd(const float* xa, const float* xb, bf16_t* oa, bf16_t* ob, float* ra_out, float* rb_out, int lane) {
    const f32x4* ra = (const f32x4*)xa + lane; const f32x4* rb = (const f32x4*)xb + lane;
    f32x4 va[4], vb[4]; float sa = 0.f, sb = 0.f;
#pragma unroll
    for (int j = 0; j < 4; ++j) { va[j] = ra[64 * j]; vb[j] = rb[64 * j]; }
#pragma unroll
    for (int j = 0; j < 4; ++j) { sa += (va[j].x * va[j].x + va[j].y * va[j].y) + (va[j].z * va[j].z + va[j].w * va[j].w); sb += (vb[j].x * vb[j].x + vb[j].y * vb[j].y) + (vb[j].z * vb[j].z + vb[j].w * vb[j].w); }
    unsigned long long* pa = (unsigned long long*)oa + lane; unsigned long long* pb = (unsigned long long*)ob + lane;
#pragma unroll
    for (int j = 0; j < 4; ++j) {
        pa[64 * j] = (unsigned long long)pk2(va[j].x, va[j].y) | ((unsigned long long)pk2(va[j].z, va[j].w) << 32);
        pb[64 * j] = (unsigned long long)pk2(vb[j].x, vb[j].y) | ((unsigned long long)pk2(vb[j].z, vb[j].w) << 32); }
    const float rsa = rsqrtf(wave_sum(sa) * (1.f / DM) + EPS), rsb = rsqrtf(wave_sum(sb) * (1.f / DM) + EPS);
    if (lane == 0) { *ra_out = rsa; *rb_out = rsb; }
}
__device__ __forceinline__ void p0_kvm_tile(Frame& F, int tile, const float* mem, const float* mem_g, const float* w_memkv) {
    const int mt = tile >> 3, ntile = tile & 7, row0 = 64 * mt, col0 = 64 * ntile;
    const int mb = F.wave >> 1, nb0 = (F.wave & 1) * 2, ar = F.lane & 15, kq = F.lane >> 4;
    const float* arow = mem + (size_t)(row0 + mb * 16 + ar) * DM;
    f32x4 acc[2]; acc[0] = (f32x4){0.f, 0.f, 0.f, 0.f}; acc[1] = acc[0];
    float ss = 0.f;
    const float* wq = w_memkv + col0 + nb0 * 16 + ar;
#define KVM_LOAD(A0, A1, G0, G1, BV, k0_) do { const int kk_ = (k0_) + 8 * kq; A0 = *(const f32x4*)(arow + kk_); A1 = *(const f32x4*)(arow + kk_ + 4); G0 = *(const f32x4*)(mem_g + kk_); G1 = *(const f32x4*)(mem_g + kk_ + 4); \
        _Pragma("unroll") for (int nbi = 0; nbi < 2; ++nbi) _Pragma("unroll") for (int j = 0; j < 8; ++j) BV[nbi][j] = wq[(size_t)(kk_ + j) * 512 + nbi * 16]; } while (0)
#define KVM_MATH(A0, A1, G0, G1, BV) do { ss += (A0.x * A0.x + A0.y * A0.y) + (A0.z * A0.z + A0.w * A0.w) + (A1.x * A1.x + A1.y * A1.y) + (A1.z * A1.z + A1.w * A1.w); \
        const bf16x8 af = pack8(A0 * G0, A1 * G1); \
        _Pragma("unroll") for (int nbi = 0; nbi < 2; ++nbi) { const f32x4 b0 = {BV[nbi][0], BV[nbi][1], BV[nbi][2], BV[nbi][3]}, b1 = {BV[nbi][4], BV[nbi][5], BV[nbi][6], BV[nbi][7]}; \
            acc[nbi] = __builtin_amdgcn_mfma_f32_16x16x32_bf16(af, pack8(b0, b1), acc[nbi], 0, 0, 0); } } while (0)
    f32x4 ba0[4], ba1[4], bg0[4], bg1[4]; float bb[4][2][8];
#pragma unroll 1
    for (int k0 = 0; k0 < DM; k0 += 128) {
#pragma unroll
        for (int q = 0; q < 4; ++q) KVM_LOAD(ba0[q], ba1[q], bg0[q], bg1[q], bb[q], k0 + 32 * q);
#pragma unroll
        for (int q = 0; q < 4; ++q) KVM_MATH(ba0[q], ba1[q], bg0[q], bg1[q], bb[q]);
    }
#undef KVM_LOAD
#undef KVM_MATH
    ss += __shfl_xor(ss, 16); ss += __shfl_xor(ss, 32);
    const float rstd = rsqrtf(ss * (1.f / DM) + EPS);
    float rs[4];
#pragma unroll
    for (int j = 0; j < 4; ++j) rs[j] = __shfl(rstd, kq * 4 + j);
    bf16_t* kmb = (bf16_t*)(F.ws + WS_KMB); bf16_t* vmt = (bf16_t*)(F.ws + WS_VMT);
#pragma unroll
    for (int nbi = 0; nbi < 2; ++nbi) {
        const int gc = col0 + (nb0 + nbi) * 16 + ar, gr0 = row0 + mb * 16 + kq * 4;
        if (ntile < 4) {
#pragma unroll
            for (int j = 0; j < 4; ++j) kmb[(size_t)(gr0 + j) * 256 + gc] = (bf16_t)(pk2(acc[nbi][j] * rs[j], 0.f) & 0xffffu);
        } else {
            const int d = gc - 256, hm = d >> 6, dd = d & 63, b = gr0 >> 8, m = gr0 & 255;
            u32x2 w; w.x = pk2(acc[nbi][0] * rs[0], acc[nbi][1] * rs[1]); w.y = pk2(acc[nbi][2] * rs[2], acc[nbi][3] * rs[3]);
            *(u32x2*)(vmt + ((size_t)((b * 4 + hm) * 64 + dd)) * 256 + m) = w;
        }
    }
}
struct P0Tile { const float* src; unsigned char* dst; int gain; };
template <int N, int K>
__device__ __forceinline__ void p0_tile_load(const float* src, f32x4 (&v)[8], int tid) {
#pragma unroll
    for (int i = 0; i < 8; ++i) v[i] = *(const f32x4*)(src + (size_t)((tid >> 5) + 16 * i) * N + (tid & 31) * 4);
}
__device__ __forceinline__ void p0_tile_to_lds(LAS float* tl, const f32x4 (&v)[8], int tid) {
#pragma unroll
    for (int i = 0; i < 8; ++i) { const int k = (tid >> 5) + 16 * i, c = ((tid & 31) * 4) ^ (((k >> 4) & 7) << 2); *(LAS f32x4*)(tl + k * 132 + c) = v[i]; }
}
template <int K, bool GAIN>
__device__ __forceinline__ void p0_tile_store(const LAS float* tl, unsigned char* dst, const float* kgain, float scale, int tid) {
    const int run = tid & 7;
    f32x4 g[4];
#pragma unroll
    for (int q = 0; q < 4; ++q) { g[q] = (f32x4){scale, scale, scale, scale}; if constexpr (GAIN) g[q] = *(const f32x4*)(kgain + run * 16 + 4 * q) * scale; }
#pragma unroll
    for (int p = 0; p < 2; ++p) { const int n = (tid >> 3) + 64 * p; const LAS float* s = tl + (run * 16) * 132 + (n ^ (run << 2));
        u32x4 o;
#pragma unroll
        for (int q = 0; q < 4; ++q) o[q] = pg8::pk4_fp8(s[(4 * q) * 132] * g[q][0], s[(4 * q + 1) * 132] * g[q][1], s[(4 * q + 2) * 132] * g[q][2], s[(4 * q + 3) * 132] * g[q][3]);
        *(u32x4*)(dst + (size_t)n * K + run * 16) = o; }
}
__device__ __forceinline__ void p0_prologue(Frame& F) {
    KArgs A = kargs();
    { const float* mem = A->in[I_MEM]; const float* mem_g = A->in[I_MEMG]; const float* w_memkv = A->in[I_WMEMKV];
      for (int rep2_ = 0; rep2_ < ((PROBE_P0 & 4) ? 2 : 1); ++rep2_)
      for (int tile = blockIdx.x; tile < 256; tile += F.G) p0_kvm_tile(F, tile, mem, mem_g, w_memkv); }
    const float* attn_g = A->in[I_ATTNG];
    const float* w_in = A->in[I_WIN]; const float* w_out = A->in[I_WOUT]; const float* w_gu = A->in[I_WGU]; const float* w_dn = A->in[I_WDN]; const float* ffn_g = A->in[I_FFNG];
    LAS float* scr = (LAS float*)(F.lds + F.wave * 16384);
    const int gw = F.vcu * NWAVES + F.wave, NGW = F.G * NWAVES;
    bf16_t* Win_t = (bf16_t*)(F.ws + WS_WIN); bf16_t* Wout_t = (bf16_t*)(F.ws + WS_WOUT);
    unsigned char* Wgu_q = F.ws + WS_WGU; unsigned char* Wd_q = F.ws + WS_WD;
    constexpr int I_IN = 16 * 80, I_OUT = 16 * 32, NITEMS = I_IN + I_OUT;
    for (int rep0_ = 0; rep0_ < ((PROBE_P0 & 1) ? 2 : 1); ++rep0_)
    for (int it = gw; it < NITEMS; it += NGW) {
        int r = it;
        if (r < I_IN) { const int kb = r / 80, nb = r % 80; p0_transpose_item<true, false>(w_in, DM, INW, Win_t, 64 * kb, 32 * nb, 32 * nb, attn_g, 1.f, scr, F.lane); continue; } r -= I_IN;
        if (r < I_OUT) { const int kb = r / 32, nb = r % 32; p0_transpose_item<false, false>(w_out, DM, DM, Wout_t, 64 * kb, 32 * nb, 32 * nb, nullptr, 1.f, scr, F.lane); continue; } r -= I_OUT;
    }
    { __syncthreads();
      LAS float* tl = (LAS float*)F.lds; const int tid = F.tid;
      constexpr int T_GU = NEXP * 8 * 16, T_DN = NEXP * 8 * 8, T_ALL = T_GU + T_DN;
#define P0_TILE(ti, SRC, DST, ISGU) do { int r_ = (ti); ISGU = r_ < T_GU; if (ISGU) { const int e = r_ >> 7, q = r_ & 127, kt = q >> 4, nt = q & 15, n0 = nt * 128, jj = n0 & 1023; \
            SRC = w_gu + (size_t)e * DM * 2048 + (size_t)(kt * 128) * 2048 + n0; DST = Wgu_q + (size_t)e * 2048 * DM + (size_t)((jj >> 7) * 256 + (n0 >= 1024 ? 128 : 0)) * DM + kt * 128; } \
          else { r_ -= T_GU; const int e = r_ >> 6, q = r_ & 63, kt = q >> 3, nt = q & 7; \
            SRC = w_dn + (size_t)e * DEXP * DM + (size_t)(kt * 128) * DM + nt * 128; DST = Wd_q + (size_t)e * DM * DEXP + (size_t)(nt * 128) * DEXP + kt * 128; } } while (0)
      f32x4 v[8]; const float* src; unsigned char* dst; bool isgu; const float* srcn; unsigned char* dstn; bool isgun;
      int ti = blockIdx.x;
      if (ti < T_ALL) { P0_TILE(ti, src, dst, isgu); if (isgu) p0_tile_load<2048, DM>(src, v, tid); else p0_tile_load<DM, DEXP>(src, v, tid); }
      for (; ti < T_ALL; ti += F.G) {
          p0_tile_to_lds(tl, v, tid);
          __syncthreads();
          const int tn = ti + F.G;
          if (tn < T_ALL) { P0_TILE(tn, srcn, dstn, isgun); if (isgun) p0_tile_load<2048, DM>(srcn, v, tid); else p0_tile_load<DM, DEXP>(srcn, v, tid); }
          if (isgu) { const int kt_ = (int)(((size_t)(dst - Wgu_q)) & (DM - 1)); p0_tile_store<DM, true>(tl, dst, ffn_g + kt_, 64.f, tid); }
          else p0_tile_store<DEXP, false>(tl, dst, nullptr, 64.f, tid);
          __syncthreads();
          src = srcn; dst = dstn; isgu = isgun;
      }
#undef P0_TILE
    }
    bf16_t* H = (bf16_t*)(F.ws + WS_H);
    { const float* x = A->in[I_X]; float* rstd_x = (float*)(F.ws + WS_RSTDX);
      for (int rep1_ = 0; rep1_ < ((PROBE_P0 & 2) ? 2 : 1); ++rep1_)
      for (int m = gw; m < T; m += 2 * NGW) { const int m2 = (m + NGW < T) ? m + NGW : m;
          cast_row2_bf16_rstd(x + (size_t)m * DM, x + (size_t)m2 * DM, H + (size_t)m * DM, H + (size_t)m2 * DM, rstd_x + m, rstd_x + m2, F.lane); } }
    const float* router_w = A->in[I_RW];
    bf16_t* wrh = (bf16_t*)(F.ws + WS_WRHI); bf16_t* wrl = (bf16_t*)(F.ws + WS_WRLO);
    for (int i = (F.vcu * NWAVES + F.wave) * 64 + F.lane; i < NEXP * DM; i += NGW * 64) { const int e = i >> 10, k = i & 1023;
        const float v = ffn_g[k] * router_w[(size_t)k * NEXP + e]; const unsigned hb = pk2(v, 0.f) & 0xffffu; const float hf = __uint_as_float(hb << 16);
        wrh[i] = (bf16_t)hb; wrl[i] = (bf16_t)(pk2(v - hf, 0.f) & 0xffffu); }
}

__device__ __forceinline__ void p2_conv_block(Frame& F, int blk, int tid_, const float* conv_w) {
    const bf16_t* proj = (const bf16_t*)(F.ws + WS_PROJ); bf16_t* mix = (bf16_t*)(F.ws + WS_MIX);
    const int cg = tid_ & 31, tc = tid_ >> 5;
    const int c0 = cg * 8, t0 = blk * 256 + tc * 16, s0 = t0 & (SEQ - 1);
    float w0[8], w1[8], w2[8];
#pragma unroll
    for (int i = 0; i < 8; ++i) { w0[i] = conv_w[c0 + i]; w1[i] = conv_w[256 + c0 + i]; w2[i] = conv_w[512 + c0 + i]; }
    float p2[8], p1[8];
#pragma unroll
    for (int i = 0; i < 8; ++i) { p2[i] = 0.f; p1[i] = 0.f; }
    if (s0 >= 2) {
        const u32x4 ua = *(const u32x4*)(proj + (size_t)(t0 - 2) * INW + COL_U + c0), ca = *(const u32x4*)(proj + (size_t)(t0 - 2) * INW + COL_GC + c0);
        const u32x4 ub = *(const u32x4*)(proj + (size_t)(t0 - 1) * INW + COL_U + c0), cb = *(const u32x4*)(proj + (size_t)(t0 - 1) * INW + COL_GC + c0);
#pragma unroll
        for (int i = 0; i < 4; ++i) { p2[2 * i] = bflo(ua[i]) * bflo(ca[i]); p2[2 * i + 1] = bfhi(ua[i]) * bfhi(ca[i]); p1[2 * i] = bflo(ub[i]) * bflo(cb[i]); p1[2 * i + 1] = bfhi(ub[i]) * bfhi(cb[i]); }
    }
    for (int tb = 0; tb < 16; tb += 4) {
        u32x4 uu[4], cc[4], bb[4];
#pragma unroll
        for (int q = 0; q < 4; ++q) { const size_t ro = (size_t)(t0 + tb + q) * INW;
            uu[q] = *(const u32x4*)(proj + ro + COL_U + c0); cc[q] = *(const u32x4*)(proj + ro + COL_GC + c0); bb[q] = *(const u32x4*)(proj + ro + COL_GB + c0); }
#pragma unroll
        for (int q = 0; q < 4; ++q) {
            float cur[8], y[8];
#pragma unroll
            for (int i = 0; i < 4; ++i) { cur[2 * i] = bflo(uu[q][i]) * bflo(cc[q][i]); cur[2 * i + 1] = bfhi(uu[q][i]) * bfhi(cc[q][i]); }
#pragma unroll
            for (int i = 0; i < 4; ++i) { y[2 * i] = bflo(bb[q][i]) * (w0[2 * i] * p2[2 * i] + w1[2 * i] * p1[2 * i] + w2[2 * i] * cur[2 * i]);
                                           y[2 * i + 1] = bfhi(bb[q][i]) * (w0[2 * i + 1] * p2[2 * i + 1] + w1[2 * i + 1] * p1[2 * i + 1] + w2[2 * i + 1] * cur[2 * i + 1]); }
            u32x4 o; o.x = pk2(y[0], y[1]); o.y = pk2(y[2], y[3]); o.z = pk2(y[4], y[5]); o.w = pk2(y[6], y[7]);
            *(u32x4*)(mix + (size_t)(t0 + tb + q) * DM + c0) = o;
#pragma unroll
            for (int i = 0; i < 8; ++i) { p2[i] = p1[i]; p1[i] = cur[i]; }
        }
    }
}
__device__ __forceinline__ void p2_mem_block(Frame& F, int blk, int lane_) {
    const bf16_t* proj = (const bf16_t*)(F.ws + WS_PROJ); bf16_t* mix = (bf16_t*)(F.ws + WS_MIX);
    const bf16_t* kmb = (const bf16_t*)(F.ws + WS_KMB); const bf16_t* vmt = (const bf16_t*)(F.ws + WS_VMT);
    const int r32 = lane_ & 31, hi = lane_ >> 5, b = blk >> 5, tw = blk * 256 + F.wave * 32, tid_ = F.wave * 64 + lane_;
    LAS unsigned char* Kl = F.lds; LAS unsigned char* Vl = F.lds + 32768;
    const int ksw = (r32 >> 1) & 7;
    u32x4 kv[4], vv[4];
#define MEM_LOAD(hm_) do { _Pragma("unroll") for (int i = 0; i < 4; ++i) { const int idx = tid_ + 512 * i; \
        kv[i] = *(const u32x4*)(kmb + (size_t)(b * 256 + (idx >> 3)) * 256 + (hm_) * 64 + (idx & 7) * 8); \
        vv[i] = *(const u32x4*)(vmt + ((size_t)((b * 4 + (hm_)) * 64 + (idx >> 5))) * 256 + (idx & 31) * 8); } } while (0)
    MEM_LOAD(0);
    for (int hm = 0; hm < 4; ++hm) {
        bf16x8 qr[4];
#pragma unroll
        for (int d0 = 0; d0 < 4; ++d0) qr[d0] = *(const bf16x8*)(proj + (size_t)(tw + r32) * INW + COL_QM + hm * 64 + d0 * 16 + hi * 8);
        __syncthreads();
#pragma unroll
        for (int i = 0; i < 4; ++i) { const int idx = tid_ + 512 * i; const int kr = idx >> 3, kc = idx & 7, vd = idx >> 5, vc = idx & 31;
            *(LAS u32x4*)(Kl + kr * 128 + ((kc ^ ((kr >> 1) & 7)) << 4)) = kv[i];
            *(LAS u32x4*)(Vl + vd * 512 + ((vc ^ (vd & 31)) << 4)) = vv[i]; }
        __syncthreads();
        if (hm < 3) MEM_LOAD(hm + 1);
        float mx = -__builtin_inff();
#pragma unroll 2
        for (int kb = 0; kb < 8; ++kb) { f32x16 p = f32x16{};
#pragma unroll
            for (int d0 = 0; d0 < 4; ++d0) { const bf16x8 kf = *(const LAS bf16x8*)(Kl + (kb * 32 + r32) * 128 + (((2 * d0 + hi) ^ ksw) << 4));
                p = __builtin_amdgcn_mfma_f32_32x32x16_bf16(kf, qr[d0], p, 0, 0, 0); }
#pragma unroll
            for (int r = 0; r < 16; ++r) mx = fmaxf(mx, p[r]); }
        mx = fmaxf(mx, __shfl_xor(mx, 32));
        float sum = 0.f;
        f32x16 o[2]; o[0] = f32x16{}; o[1] = f32x16{};
#pragma unroll 2
        for (int kb = 0; kb < 8; ++kb) { f32x16 p = f32x16{};
#pragma unroll
            for (int d0 = 0; d0 < 4; ++d0) { const bf16x8 kf = *(const LAS bf16x8*)(Kl + (kb * 32 + r32) * 128 + (((2 * d0 + hi) ^ ksw) << 4));
                p = __builtin_amdgcn_mfma_f32_32x32x16_bf16(kf, qr[d0], p, 0, 0, 0); }
#pragma unroll
            for (int r = 0; r < 16; ++r) { p[r] = __builtin_amdgcn_exp2f(p[r] - mx); sum += p[r]; }
            bf16x8 pa0, pa1;
#define PK4(P, B_, OUT) do { unsigned a0 = pk2(P[B_+0], P[B_+1]), a1 = pk2(P[B_+2], P[B_+3]); unsigned b0 = pk2(P[B_+4], P[B_+5]), b1 = pk2(P[B_+6], P[B_+7]); \
        auto r0 = __builtin_amdgcn_permlane32_swap(a0, b0, false, false); auto r1 = __builtin_amdgcn_permlane32_swap(a1, b1, false, false); \
        u32x4 w = {r0[0], r1[0], r0[1], r1[1]}; OUT = __builtin_bit_cast(bf16x8, w); } while (0)
            PK4(p, 0, pa0); PK4(p, 8, pa1);
#undef PK4
#pragma unroll
            for (int d0 = 0; d0 < 2; ++d0) { const LAS unsigned char* vrow = Vl + (d0 * 32 + r32) * 512;
                const bf16x8 v0 = *(const LAS bf16x8*)(vrow + (((kb * 4 + hi) ^ r32) << 4)), v1 = *(const LAS bf16x8*)(vrow + (((kb * 4 + 2 + hi) ^ r32) << 4));
                o[d0] = __builtin_amdgcn_mfma_f32_32x32x16_bf16(pa0, v0, o[d0], 0, 0, 0);
                o[d0] = __builtin_amdgcn_mfma_f32_32x32x16_bf16(pa1, v1, o[d0], 0, 0, 0); }
        }
        sum += __shfl_xor(sum, 32);
        const float linv = __builtin_amdgcn_rcpf(sum);
#pragma unroll
        for (int r = 0; r < 16; ++r) { const int orow = crow(r, hi); const float li = __shfl(linv, orow);
#pragma unroll
            for (int d0 = 0; d0 < 2; ++d0) { const float v = o[d0][r] * li; const float vn = __shfl_xor(v, 1);
                if ((r32 & 1) == 0) *(unsigned*)(mix + (size_t)(tw + orow) * DM + 768 + hm * 64 + d0 * 32 + r32) = pk2(v, vn); } }
    }
#undef MEM_LOAD
    __syncthreads();
}
__device__ __forceinline__ dattn::Ref da_ref(Frame& F, int n) {
    const int pid = F.vcu + (n >> 2) * F.G, sub = n & 3, blk = sub >> 1, comp = sub & 1, bh = pid >> 4, s = pid & 15, qb = blk ? 31 - s : s, b = bh >> 2, h = bh & 3;
    bf16_t* mix = (bf16_t*)(F.ws + WS_MIX);
    dattn::Ref r;
    r.qoff = (unsigned)(((size_t)(b * SEQ + qb * 256) * INW + COL_Q + h * 128 + comp * 64) * 2);
    r.koff = (unsigned)(((size_t)(b * SEQ) * INW + COL_K + h * 128 + comp * 64) * 2);
    r.voff = (unsigned)(((size_t)(b * SEQ) * INW + COL_V + h * 128) * 2);
    r.O = mix + (size_t)(b * SEQ + qb * 256) * DM + 256 + h * 128;
    r.P0 = qb * 256; r.comp = comp; r.h = h;
    return r;
}
__device__ __forceinline__ void p2_mixers(Frame& F) {
    KArgs A = kargs();
    const float* rel_bias = A->in[I_RELB]; const float* lam_qk = A->in[I_LAMQK]; const float* subln_g = A->in[I_SUBG];
    if (F.tid < 512) { const int h = F.tid >> 7, n = F.tid & 127; int bk;
        if (n < 16) bk = n; else { bk = 16; const int thr[15] = {19, 21, 24, 27, 31, 35, 40, 46, 52, 59, 67, 77, 87, 99, 113};
#pragma unroll
            for (int i = 0; i < 15; ++i) bk += (n >= thr[i]) ? 1 : 0; }
        ((LAS float*)(F.lds + dattn::OFF_TB))[h * 128 + n] = (rel_bias[bk * 4 + h] - rel_bias[31 * 4 + h]) * LOG2E; }
    float d1 = 0.f, d2 = 0.f;
    for (int i = 0; i < 64; ++i) { d1 += lam_qk[i] * lam_qk[64 + i]; d2 += lam_qk[128 + i] * lam_qk[192 + i]; }
    const float lam = __expf(d1) - __expf(d2) + 0.2f;
    if (__builtin_amdgcn_readfirstlane(F.tid) >= 256) __builtin_amdgcn_s_setprio(1);
    __syncthreads();
    const int npairs = F.vcu < 512 ? (512 - F.vcu + F.G - 1) / F.G : 0, total1 = 4 * npairs, total = ((PROBE_REP >> 2) & 1) ? 2 * total1 : total1;
#if PROBE_CLK
    const unsigned long long pc0_ = __builtin_readcyclecounter(), pr0_ = __builtin_amdgcn_s_memrealtime();
#endif
    if (total > 0) {
        dattn::Seam S; dattn::Ref cur = da_ref(F, 0);
#if PROBE_SEG
        S.acc = 0; S.tot = 0;
#endif
        const dattn::rsrc_t R = __builtin_amdgcn_make_buffer_rsrc((void*)(F.ws + WS_PROJ), 0, (int)((size_t)T * INW * 2), 0x00020000);
        const char* projb = (const char*)(F.ws + WS_PROJ);
        dattn::prime(cur, F.lds, S, R, projb);
        for (int n = 0; n < total; ++n) {
            const dattn::Ref nxt = (n + 1 < total) ? da_ref(F, (n + 1) % total1) : cur;
            dattn::block(cur, nxt, F.lds, S, lam, subln_g, R, projb);
            cur = nxt;
        }
#if PROBE_SEG
        if (blockIdx.x == 0 && F.tid == 0) { F.ctl[604] = (unsigned)(S.acc >> 4); F.ctl[605] = (unsigned)(S.tot >> 4); }
#endif
    }
#if PROBE_CLK
    if (blockIdx.x == 0 && F.tid == 0) { const unsigned long long dc_ = __builtin_readcyclecounter() - pc0_, dr_ = __builtin_amdgcn_s_memrealtime() - pr0_;
        F.ctl[600] = (unsigned)dc_; F.ctl[601] = (unsigned)(dc_ >> 32); F.ctl[602] = (unsigned)dr_; }
#endif
    __builtin_amdgcn_s_setprio(0);
    int lane2 = (int)__builtin_amdgcn_mbcnt_hi(~0u, __builtin_amdgcn_mbcnt_lo(~0u, 0u)); asm volatile("" : "+v"(lane2));
    const int tid2 = F.wave * 64 + lane2;
    const float* conv_w = kargs()->in[I_CONVW];
    for (int repx_ = 0; repx_ < ((PROBE_X & 1) ? 2 : 1); ++repx_)
    for (int blk = blockIdx.x; blk < T / 256; blk += F.G) { p2_conv_block(F, blk, tid2, conv_w); p2_mem_block(F, blk, lane2); }
}

__device__ __forceinline__ void p4_router(Frame& F, bool dry = false) {
    const float* router_b = kargs()->in[I_RB];
    const bf16_t* x1b = (const bf16_t*)(F.ws + WS_X1B); const bf16_t* wrh = (const bf16_t*)(F.ws + WS_WRHI); const bf16_t* wrl = (const bf16_t*)(F.ws + WS_WRLO);
    int* e_tk = (int*)(F.ws + WS_ETK); float* g_tk = (float*)(F.ws + WS_GTK); float* rstd_t = (float*)(F.ws + WS_RSTDT);
    LAS float* lg = (LAS float*)F.lds + F.wave * (32 * 33); LAS unsigned* hist = (LAS unsigned*)(F.lds + 8 * 32 * 33 * 4);
    const int r32 = F.lane & 31, hi = F.lane >> 5;
    for (int blk = blockIdx.x; blk < T / 256; blk += F.G) {
        if (F.tid < 32) hist[F.tid] = 0u;
        __syncthreads();
        const int t0 = blk * 256 + F.wave * 32;
        const bf16_t* xr = x1b + (size_t)(t0 + r32) * DM + hi * 8; const bf16_t* wh = wrh + (size_t)r32 * DM + hi * 8; const bf16_t* wl = wrl + (size_t)r32 * DM + hi * 8;
        f32x16 acc = f32x16{}; float ss = 0.f;
#pragma unroll 1
        for (int kq = 0; kq < DM; kq += 256) {
            u32x4 xw[16];
#pragma unroll
            for (int s_ = 0; s_ < 16; ++s_) xw[s_] = *(const u32x4*)(xr + kq + s_ * 16);
            SBAR();
#pragma unroll
            for (int sb = 0; sb < 16; sb += 4) { bf16x8 ah[4], al[4];
#pragma unroll
                for (int s_ = 0; s_ < 4; ++s_) { ah[s_] = *(const bf16x8*)(wh + kq + (sb + s_) * 16); al[s_] = *(const bf16x8*)(wl + kq + (sb + s_) * 16); }
#pragma unroll
                for (int s_ = 0; s_ < 4; ++s_) { const u32x4 xv = xw[sb + s_];
#pragma unroll
                    for (int i = 0; i < 4; ++i) { const float a = bflo(xv[i]), b2 = bfhi(xv[i]); ss += a * a + b2 * b2; }
                    const bf16x8 xb = __builtin_bit_cast(bf16x8, xv);
                    acc = __builtin_amdgcn_mfma_f32_32x32x16_bf16(ah[s_], xb, acc, 0, 0, 0);
                    acc = __builtin_amdgcn_mfma_f32_32x32x16_bf16(al[s_], xb, acc, 0, 0, 0); } }
        }
        ss += __shfl_xor(ss, 32);
        const float rstd = rsqrtf(ss * (1.f / DM) + EPS);
#pragma unroll
        for (int r = 0; r < 16; ++r) { const int e = crow(r, hi); lg[r32 * 33 + e] = acc[r] * rstd + router_b[e]; }
        LDS_WAIT(); asm volatile("" ::: "memory");
        if (F.lane < 32) {
            LAS float* row = lg + F.lane * 33; float tv[4]; int ti[4];
#pragma unroll
            for (int p = 0; p < 4; ++p) { float best = -__builtin_inff(); int bi = 0;
                for (int e = 0; e < NEXP; ++e) { const float v = row[e]; if (v > best) { best = v; bi = e; } }
                tv[p] = best; ti[p] = bi; row[bi] = -__builtin_inff(); LDS_WAIT(); asm volatile("" ::: "memory"); }
            const float w1 = __expf(tv[1] - tv[0]), w2 = __expf(tv[2] - tv[0]), w3 = __expf(tv[3] - tv[0]); const float inv = 1.f / (1.f + w1 + w2 + w3);
            const int t = t0 + F.lane;
            if (!dry) {
            *(int4*)(e_tk + (size_t)t * 4) = make_int4(ti[0], ti[1], ti[2], ti[3]);
            *(float4*)(g_tk + (size_t)t * 4) = make_float4(inv, w1 * inv, w2 * inv, w3 * inv);
            rstd_t[t] = rstd;
#pragma unroll
            for (int p = 0; p < 4; ++p) __hip_atomic_fetch_add(&hist[ti[p]], 1u, __ATOMIC_RELAXED, __HIP_MEMORY_SCOPE_WORKGROUP);
            }
        }
        __syncthreads();
        if (F.tid < 32) __hip_atomic_fetch_add(F.ctl + CW_COUNT + F.tid, hist[F.tid], RLX_AGENT);
        __syncthreads();
    }
}
__device__ __forceinline__ void p5_place(Frame& F) {
    const int* e_tk = (const int*)(F.ws + WS_ETK); const float* g_tk = (const float*)(F.ws + WS_GTK); const float* rstd_t = (const float*)(F.ws + WS_RSTDT);
    int* slot_tk = (int*)(F.ws + WS_SLOTTK); int* tok_slot = (int*)(F.ws + WS_TOKSLOT); float* gate_slot = (float*)(F.ws + WS_GATESLOT); float* rstd_slot = (float*)(F.ws + WS_RSTDSLOT);
    int* rb_e = (int*)(F.ws + WS_RBE);
    LAS int* L = (LAS int*)F.lds;
    if (F.tid < 32) { const int c = (int)__hip_atomic_load(F.ctl + CW_COUNT + F.tid, RLX_AGENT); L[F.tid] = c; L[32 + F.tid] = (c + 255) & ~255; }
    __syncthreads();
    if (F.tid < 32) { int s = 0; for (int e = 0; e < F.tid; ++e) s += L[32 + e]; L[64 + F.tid] = s; }
    __syncthreads();
    for (int blk = blockIdx.x; blk < T / 256; blk += F.G) {
        if (F.tid < 32) { L[96 + F.tid] = 0; L[128 + F.tid] = 0; }
        __syncthreads();
        int ee[2];
#pragma unroll
        for (int j = 0; j < 2; ++j) { const int i = F.tid + 512 * j; ee[j] = e_tk[(size_t)blk * 1024 + i]; __hip_atomic_fetch_add(&L[96 + ee[j]], 1, __ATOMIC_RELAXED, __HIP_MEMORY_SCOPE_WORKGROUP); }
        __syncthreads();
        if (F.tid < 32) L[160 + F.tid] = L[64 + F.tid] + (int)__hip_atomic_fetch_add(F.ctl + CW_CURSOR + F.tid, (unsigned)L[96 + F.tid], RLX_AGENT);
        __syncthreads();
#pragma unroll
        for (int j = 0; j < 2; ++j) { const int i = F.tid + 512 * j; const int r = __hip_atomic_fetch_add(&L[128 + ee[j]], 1, __ATOMIC_RELAXED, __HIP_MEMORY_SCOPE_WORKGROUP); const int pos = L[160 + ee[j]] + r;
            const int t = blk * 256 + (i >> 2);
            tok_slot[pos] = t; gate_slot[pos] = g_tk[(size_t)blk * 1024 + i]; rstd_slot[pos] = rstd_t[t]; slot_tk[(size_t)blk * 1024 + i] = pos; }
        __syncthreads();
    }
    for (int e = blockIdx.x; e < NEXP; e += F.G)
        for (int i = L[e] + F.tid; i < L[32 + e]; i += NWAVES * 64) { const int pos = L[64 + e] + i; tok_slot[pos] = 0; gate_slot[pos] = 0.f; rstd_slot[pos] = 0.f; }
    if (blockIdx.x == 0) {
        const int nrb = (L[64 + 31] + L[32 + 31]) >> 8;
        for (int rb = F.tid; rb < NRB_MAX; rb += NWAVES * 64) { int e = 31; for (int q = 0; q < 32; ++q) { if (rb * 256 >= L[64 + q] && rb * 256 < L[64 + q] + L[32 + q]) e = q; } rb_e[rb] = e; }
        if (F.tid == 0) rb_e[NRB_MAX] = nrb;
    }
}
__device__ __forceinline__ void p9_final(Frame& F) {
    const bf16_t* x1b = (const bf16_t*)(F.ws + WS_X1B); const int* slot_tk = (const int*)(F.ws + WS_SLOTTK);
    const unsigned char* Y = F.ws + WS_Y;
    const int gw = F.vcu * NWAVES + F.wave, NGW = F.G * NWAVES;
    const float* final_g = kargs()->in[I_FING];
    f32x4 gg[2][2];
#pragma unroll
    for (int j = 0; j < 2; ++j) { gg[j][0] = *(const f32x4*)(final_g + 8 * F.lane + 512 * j); gg[j][1] = *(const f32x4*)(final_g + 8 * F.lane + 512 * j + 4); }
    int4 slA = make_int4(0, 0, 0, 0), slB = slA;
    if (gw < T) { slA = *(const int4*)(slot_tk + (size_t)gw * 4); const int tb0 = (gw + NGW < T) ? gw + NGW : gw; slB = *(const int4*)(slot_tk + (size_t)tb0 * 4); }
    for (int t = gw; t < T; t += 2 * NGW) {
        const int tA = t, tB = (t + NGW < T) ? t + NGW : t;
        const int tnA = (t + 2 * NGW < T) ? t + 2 * NGW : tA, tnB = (t + 3 * NGW < T) ? t + 3 * NGW : tnA;
        const int4 nA = *(const int4*)(slot_tk + (size_t)tnA * 4), nB = *(const int4*)(slot_tk + (size_t)tnB * 4);
        const int sA[4] = {slA.x, slA.y, slA.z, slA.w}, sB[4] = {slB.x, slB.y, slB.z, slB.w};
        u32x4 xa[2], xb[2]; u32x2 ya[2][4], yb[2][4];
#pragma unroll
        for (int j = 0; j < 2; ++j) { const int c = 8 * F.lane + 512 * j;
            xa[j] = *(const u32x4*)(x1b + (size_t)tA * DM + c); xb[j] = *(const u32x4*)(x1b + (size_t)tB * DM + c);
#pragma unroll
            for (int k = 0; k < 4; ++k) { ya[j][k] = *(const u32x2*)(Y + (size_t)sA[k] * DM + c); yb[j][k] = *(const u32x2*)(Y + (size_t)sB[k] * DM + c); } }
        float va[2][8], vb[2][8]; float ssa = 0.f, ssb = 0.f;
#pragma unroll
        for (int j = 0; j < 2; ++j) {
#pragma unroll
            for (int i = 0; i < 4; ++i) { va[j][2 * i] = bflo(xa[j][i]); va[j][2 * i + 1] = bfhi(xa[j][i]); vb[j][2 * i] = bflo(xb[j][i]); vb[j][2 * i + 1] = bfhi(xb[j][i]); }
#pragma unroll
            for (int k = 0; k < 4; ++k)
#pragma unroll
                for (int w_ = 0; w_ < 2; ++w_) { const f32x2_t a0 = __builtin_amdgcn_cvt_pk_f32_fp8((int)ya[j][k][w_], false), a1 = __builtin_amdgcn_cvt_pk_f32_fp8((int)ya[j][k][w_], true);
                    const f32x2_t b0 = __builtin_amdgcn_cvt_pk_f32_fp8((int)yb[j][k][w_], false), b1 = __builtin_amdgcn_cvt_pk_f32_fp8((int)yb[j][k][w_], true);
                    va[j][4 * w_] += 0.125f * a0[0]; va[j][4 * w_ + 1] += 0.125f * a0[1]; va[j][4 * w_ + 2] += 0.125f * a1[0]; va[j][4 * w_ + 3] += 0.125f * a1[1];
                    vb[j][4 * w_] += 0.125f * b0[0]; vb[j][4 * w_ + 1] += 0.125f * b0[1]; vb[j][4 * w_ + 2] += 0.125f * b1[0]; vb[j][4 * w_ + 3] += 0.125f * b1[1]; }
#pragma unroll
            for (int i = 0; i < 8; ++i) { ssa += va[j][i] * va[j][i]; ssb += vb[j][i] * vb[j][i]; } }
        const float ra = rsqrtf(wave_sum(ssa) * (1.f / DM) + EPS), rb = rsqrtf(wave_sum(ssb) * (1.f / DM) + EPS);
#pragma unroll
        for (int j = 0; j < 2; ++j) { const int c = 8 * F.lane + 512 * j;
            f32x4 o0, o1;
            o0.x = va[j][0] * ra * gg[j][0].x; o0.y = va[j][1] * ra * gg[j][0].y; o0.z = va[j][2] * ra * gg[j][0].z; o0.w = va[j][3] * ra * gg[j][0].w;
            o1.x = va[j][4] * ra * gg[j][1].x; o1.y = va[j][5] * ra * gg[j][1].y; o1.z = va[j][6] * ra * gg[j][1].z; o1.w = va[j][7] * ra * gg[j][1].w;
            *(f32x4*)(F.out + (size_t)tA * DM + c) = o0; *(f32x4*)(F.out + (size_t)tA * DM + c + 4) = o1;
            o0.x = vb[j][0] * rb * gg[j][0].x; o0.y = vb[j][1] * rb * gg[j][0].y; o0.z = vb[j][2] * rb * gg[j][0].z; o0.w = vb[j][3] * rb * gg[j][0].w;
            o1.x = vb[j][4] * rb * gg[j][1].x; o1.y = vb[j][5] * rb * gg[j][1].y; o1.z = vb[j][6] * rb * gg[j][1].z; o1.w = vb[j][7] * rb * gg[j][1].w;
            *(f32x4*)(F.out + (size_t)tB * DM + c) = o0; *(f32x4*)(F.out + (size_t)tB * DM + c + 4) = o1; }
        slA = nA; slB = nB;
    }
}

__global__ void __launch_bounds__(NWAVES * 64, 2) hymba_fwd(Args args) {
    extern __shared__ __attribute__((aligned(16))) unsigned char lds[];
    Frame F;
    F.lds = (LAS unsigned char*)lds;
    F.MISC = (volatile LAS unsigned*)(F.lds + MISC_OFF);
    F.tid = threadIdx.x; F.lane = F.tid & 63; F.wave = __builtin_amdgcn_readfirstlane(F.tid >> 6);
    F.G = gridDim.x; { const int bx = blockIdx.x; F.vcu = (F.G % 8 == 0) ? (bx % 8) * (F.G / 8) + bx / 8 : bx; }
    F.ws = args.ws; F.ctl = (unsigned*)(args.ws + WS_CTL); F.out = args.out;
    for (int u = F.tid; u < (LDS_BYTES - LDSCTL_OFF) / 4; u += NWAVES * 64) ((LAS unsigned*)(F.lds + LDSCTL_OFF))[u] = 0u;
    __syncthreads();
    XcdBarrier bar; bar.bar = F.ctl + CW_BAR; bar.x = 0; bar.st = nullptr;
    if (N_LAUNCHES == 1) bar = xcd_barrier_post(F.ctl + CW_BAR, F.MISC + 8);
#define GRID_BAR() do { if (N_LAUNCHES == 1) xcd_barrier(bar); } while (0)
    const int lo = args.ph_lo, hi = args.ph_hi;
#ifndef PH_MASK
#define PH_MASK 0x1ff
#endif
#define IN(k) (((PH_MASK >> (k)) & 1) && lo <= (k) && (k) < hi)
#define BOTH(k) (IN(k) && IN((k) + 1))
    bf16_t* const H = (bf16_t*)(F.ws + WS_H); bf16_t* const PROJ = (bf16_t*)(F.ws + WS_PROJ); bf16_t* const MIX = (bf16_t*)(F.ws + WS_MIX); bf16_t* const X1B = (bf16_t*)(F.ws + WS_X1B);
    bf16_t* const Win_t = (bf16_t*)(F.ws + WS_WIN); bf16_t* const Wout_t = (bf16_t*)(F.ws + WS_WOUT);
    const unsigned char* const Wgu_q = F.ws + WS_WGU; const unsigned char* const Wd_q = F.ws + WS_WD;
    unsigned char* const X1Q = F.ws + WS_X1Q; unsigned char* const ACTQ = F.ws + WS_ACTQ; unsigned char* const Yp = F.ws + WS_Y;
    const int* const tok_slot = (const int*)(F.ws + WS_TOKSLOT); const float* const gate_slot = (const float*)(F.ws + WS_GATESLOT); const float* const rstd_slot = (const float*)(F.ws + WS_RSTDSLOT);
    const int* const rb_e = (const int*)(F.ws + WS_RBE);

#define REP(k) for (int rep_ = 0; rep_ < (((PROBE_REP >> (k)) & 1) ? 2 : 1); ++rep_)
    if (IN(0)) { REP(0) p0_prologue(F); if (BOTH(0)) GRID_BAR(); }
    if (IN(1)) {
        REP(1) {
        pg8::Gemm g{H, Win_t, DM, 0, nullptr}; pg8::StaticOrder S; S.init(T, INW, F.G, (int)blockIdx.x);
        pg8::EpiProj E{PROJ, (const float*)(F.ws + WS_RSTDX)};
        pg8::gemm_phase<pg8::EpiProj, pg8::StaticOrder, true>(F.lds, g, S, E); }
        if (BOTH(1)) GRID_BAR();
    }
    if (IN(2)) { p2_mixers(F); if (BOTH(2)) GRID_BAR(); }
    if (IN(3)) {
        pg8::Gemm g{MIX, Wout_t, DM, 0, nullptr}; pg8::StaticOrder S; S.init(T, DM, F.G, (int)blockIdx.x);
        pg8::EpiX1 E{H, X1B, X1Q};
        pg8::gemm_phase<pg8::EpiX1, pg8::StaticOrder, true>(F.lds, g, S, E);
        if (BOTH(3)) GRID_BAR();
    }
    if (IN(4)) { if (PROBE_X & 2) p4_router(F, true); p4_router(F); if (BOTH(4)) GRID_BAR(); }
    if (IN(5)) { p5_place(F); if (BOTH(5)) GRID_BAR(); }
    if (IN(6)) {
        const int nrb = rb_e[NRB_MAX];
        REP(6) {
        pg8::Gemm g{(const bf16_t*)X1Q, (const bf16_t*)Wgu_q, DM / 2, (long)2048 * DM / 2, tok_slot}; pg8::GroupOrder S{nrb, 0, 8, F.G, (int)blockIdx.x, rb_e};
        pg8::EpiGU E{ACTQ, kargs()->in[I_BGU], rstd_slot};
        pg8::gemm_phase<pg8::EpiGU, pg8::GroupOrder, true, true, (PROBE_KREP == 2 ? 0x78787878 : 0x79797979), 0x7f7f7f7f, PROBE_KREP>(F.lds, g, S, E); }
        if (BOTH(6)) GRID_BAR();
    }
    if (IN(7)) {
        const int nrb = rb_e[NRB_MAX];
        REP(7) {
        pg8::Gemm g{(const bf16_t*)ACTQ, (const bf16_t*)Wd_q, DEXP / 2, (long)DM * DEXP / 2, nullptr}; pg8::GroupOrder S{nrb, 0, 4, F.G, (int)blockIdx.x, rb_e};
        pg8::EpiDown E{Yp, kargs()->in[I_BDN], gate_slot};
        pg8::gemm_phase<pg8::EpiDown, pg8::GroupOrder, true, true, 0x79797979, 0x7d7d7d7d>(F.lds, g, S, E); }
        if (BOTH(7)) GRID_BAR();
    }
    if (IN(8)) { REP(8) p9_final(F); }
#if PROBE_SEG
    if (IN(8) && blockIdx.x == 0 && F.tid == 0) { const unsigned long long a_ = F.ctl[604], t_ = F.ctl[605]; const unsigned long long us_ = t_ ? a_ * 2000ull / t_ : 0ull; const unsigned long long t0_ = __builtin_amdgcn_s_memrealtime();
        while (__builtin_amdgcn_s_memrealtime() - t0_ < us_ * 100ull) __builtin_amdgcn_s_sleep(8); }
#endif
#if PROBE_CLK
    if (IN(8) && blockIdx.x == 0 && F.tid == 0) { const unsigned long long dc_ = ((unsigned long long)F.ctl[601] << 32) | F.ctl[600]; const unsigned long long dr_ = F.ctl[602];
        const unsigned long long mhz_ = dr_ ? dc_ * 100ull / dr_ : 0ull; const unsigned long long t0_ = __builtin_amdgcn_s_memrealtime();
        while (__builtin_amdgcn_s_memrealtime() - t0_ < mhz_ * 100ull) __builtin_amdgcn_s_sleep(8); }
#endif
#undef IN
#undef BOTH
#undef GRID_BAR
}

extern "C" void kernel_launch(void* const* d_in, const int* in_sizes, int n_in, void* d_out, int out_size, void* d_ws, size_t ws_size, hipStream_t stream) {
    static int grid = 0;
    if (grid == 0) {
        if (n_in != 19 || out_size != T * DM || ws_size < WS_END) { fprintf(stderr, "kernel_launch: unexpected shapes (n_in %d out %d ws %zu)\n", n_in, out_size, ws_size); grid = -1; return; }
        int dev = 0, cus = 0;
        if (hipGetDevice(&dev) != hipSuccess || hipDeviceGetAttribute(&cus, hipDeviceAttributeMultiprocessorCount, dev) != hipSuccess) { grid = -1; return; }
        if (hipFuncSetAttribute((const void*)hymba_fwd, hipFuncAttributeMaxDynamicSharedMemorySize, LDS_BYTES) != hipSuccess) { fprintf(stderr, "kernel_launch: hipFuncSetAttribute failed\n"); grid = -1; return; }
        int per_cu = 0;
        if (hipOccupancyMaxActiveBlocksPerMultiprocessor(&per_cu, (const void*)hymba_fwd, NWAVES * 64, LDS_BYTES) != hipSuccess || per_cu < 1) fprintf(stderr, "kernel_launch: occupancy query reports %d\n", per_cu);
        (void)hipGetLastError();
        grid = cus;
    }
    if (grid < 0) return;
    if (hipMemsetAsync((char*)d_ws + WS_CTL, 0, CTL_ZERO_BYTES, stream) != hipSuccess) return;
    Args a{};
    for (int i = 0; i < 19; ++i) a.in[i] = (const float*)d_in[i];
    a.out = (float*)d_out; a.ws = (unsigned char*)d_ws;
    for (int li = 0; li < N_LAUNCHES; ++li) {
        a.ph_lo = (N_LAUNCHES == 1) ? 0 : li; a.ph_hi = (N_LAUNCHES == 1) ? N_PHASES : li + 1;
        hipLaunchKernelGGL(hymba_fwd, dim3(grid), dim3(NWAVES * 64), LDS_BYTES, stream, a);
    }
}
```

```cpp
#include <hip/hip_runtime.h>
#include <hip/hip_bf16.h>
#include <cstdio>
#include <cstdint>

#ifndef PROBE_REP
#define PROBE_REP 0
#endif
#ifndef PROBE_X
#define PROBE_X 0
#endif
#ifndef PROBE_P0
#define PROBE_P0 0
#endif
#ifndef PROBE_SEG
#define PROBE_SEG 0
#endif
#ifndef PROBE_CLK
#define PROBE_CLK 0
#endif
#ifndef PROBE_KREP
#define PROBE_KREP 1
#endif
#ifndef PROBE_EPI
#define PROBE_EPI 0
#endif
#ifndef MK_N_LAUNCHES
#define MK_N_LAUNCHES 1
#endif

constexpr int BATCH = 8, SEQ = 8192, DM = 1024, T = BATCH * SEQ, INW = 2560, MEML = 256, NEXP = 32, TOPK = 4, DEXP = 1024;
constexpr int COL_U = 0, COL_GB = 256, COL_GC = 512, COL_Q = 768, COL_K = 1280, COL_V = 1792, COL_QM = 2304;
constexpr float EPS = 1e-5f;
constexpr float C2 = 0.125f * 1.4426950408889634f;
constexpr float LOG2E = 1.4426950408889634f;
constexpr int NRB_MAX = 1056;

#define GAS __attribute__((address_space(1)))
#define LAS __attribute__((address_space(3)))
typedef unsigned short bf16_t;
typedef short bf16x8 __attribute__((ext_vector_type(8)));
typedef short s16x4 __attribute__((ext_vector_type(4)));
typedef float f32x4 __attribute__((ext_vector_type(4)));
typedef float f32x16 __attribute__((ext_vector_type(16)));
typedef unsigned u32x4 __attribute__((ext_vector_type(4)));
typedef unsigned u32x2 __attribute__((ext_vector_type(2)));
typedef float f32x2_t __attribute__((ext_vector_type(2)));
typedef __bf16 bf16x2_t __attribute__((ext_vector_type(2)));
typedef GAS unsigned gu32;
#define RLX_AGENT __ATOMIC_RELAXED, __HIP_MEMORY_SCOPE_AGENT
#define LDS_WAIT() asm volatile("s_waitcnt lgkmcnt(0)" ::: "memory")
#define VM_WAIT() asm volatile("s_waitcnt vmcnt(0)" ::: "memory")
#define SBAR() __builtin_amdgcn_sched_barrier(0)

__device__ __forceinline__ unsigned pk2(float lo, float hi) { f32x2_t v = {lo, hi}; bf16x2_t b = __builtin_convertvector(v, bf16x2_t); return __builtin_bit_cast(unsigned, b); }
__device__ __forceinline__ float bflo(unsigned u) { return __uint_as_float(u << 16); }
__device__ __forceinline__ float bfhi(unsigned u) { return __uint_as_float(u & 0xffff0000u); }
__device__ __forceinline__ bf16x8 pack8(f32x4 a, f32x4 b) { u32x4 w = {pk2(a[0], a[1]), pk2(a[2], a[3]), pk2(b[0], b[1]), pk2(b[2], b[3])}; return __builtin_bit_cast(bf16x8, w); }
__device__ __forceinline__ int crow(int r, int hi) { return (r & 3) + 8 * (r >> 2) + 4 * hi; }
__device__ __forceinline__ float wave_sum(float v) {
#pragma unroll
    for (int o = 1; o < 64; o <<= 1) v += __shfl_xor(v, o);
    return v;
}

namespace pg8 {
constexpr int BM = 256, BK = 64, HALF = 128, HTB = HALF * BK * 2  , STAGE_BYTES = 8 * HTB, NXCD = 8, WGM = 8;
__host__ __device__ __forceinline__ int lds_byte(int r, int c) { const int st = (r >> 4) * 2 + (c >> 5), rr = r & 15, cc = c & 31, ob = rr * 64 + cc * 2; return st * 1024 + (ob ^ (((ob >> 9) & 1) << 5)); }
__host__ __device__ __forceinline__ void stage_rc(int b, int& R, int& C) { const int st = b / 1024, sb = b % 1024, swz = sb ^ (((sb >> 9) & 1) << 5); R = (st >> 1) * 16 + swz / 64; C = (st & 1) * 32 + (swz % 64) / 2; }
__host__ __device__ __forceinline__ int perm32(int rho) { const int n = rho >> 4, i = rho & 15; return 8 * (i >> 2) + 4 * n + (i & 3); }

struct Unit { int pm, pn, e; };
struct Gemm { const bf16_t* A; const bf16_t* Bt; int K; long bstride; const int* rowmap; };

struct StaticOrder {
    int nM, nN, nwg, G, c;
    __device__ void init(int M, int N, int G_, int c_) { nM = M / BM; nN = N / BM; nwg = nM * nN; G = G_; c = c_; }
    __device__ bool next(int i, Unit& u) const {
        const long L = (long)i * G + c; if (L >= nwg) return false;
        int wgid = (int)L; { const int q = nwg / NXCD, r = nwg % NXCD, xcd = wgid % NXCD, off = wgid / NXCD; wgid = (xcd < r ? xcd * (q + 1) : r * (q + 1) + (xcd - r) * q) + off; }
        const int nig = WGM * nN, gid = wgid / nig, fm = gid * WGM, gsz = (nM - fm) < WGM ? (nM - fm) : WGM;
        u.pm = fm + ((wgid % nig) % gsz); u.pn = (wgid % nig) / gsz; u.e = 0; return true;
    }
};
struct GroupOrder {
    int nrb, rb0, npn, G, c; const int* rb_e;
    __device__ bool next(int i, Unit& u) const {
        int rbl, pn;
        if ((G & 7) == 0 && ((G >> 3) % npn) == 0) { const int x = c & 7, j = c >> 3, rpx = (G >> 3) / npn; rbl = i * (G / npn) + x * rpx + j / npn; pn = j % npn; }
        else { const long L = (long)i * G + c; rbl = (int)(L / npn); pn = (int)(L % npn); }
        if (rbl >= nrb) return false;
        u.pm = rb0 + rbl; u.pn = pn; u.e = rb_e[u.pm]; return true;
    }
};

typedef int v4i_t __attribute__((ext_vector_type(4)));
typedef int v8i_t __attribute__((ext_vector_type(8)));
template <class Epi, class Sched, bool ALIGN_EPI, bool FP8 = false, int SCW = 0x7f7f7f7f, int SCA = 0x7f7f7f7f, int KREP = 1>
__device__ __forceinline__ void gemm_phase(LAS unsigned char* lds, const Gemm g, const Sched& S, const Epi& E) {
    const int tid = threadIdx.x, wid = __builtin_amdgcn_readfirstlane(tid >> 6), lane = tid & 63, wr = wid >> 2, wc = wid & 3, fr = lane & 15, fq = lane >> 4;
    const int K = g.K; int nt = K / BK; asm volatile("" : "+s"(nt));
    int Rr[2], Cc[2]; unsigned voffB[2];
#pragma unroll
    for (int i = 0; i < 2; ++i) { int R, C; stage_rc(tid * 16 + i * 8192, R, C); const int Rb = Epi::PERM ? ((R & ~31) + perm32(R & 31)) : R;
        Rr[i] = R; Cc[i] = C; voffB[i] = (unsigned)(Rb * K + C) * 2u; }
    const size_t kstep = (size_t)(BK * 2);
    const size_t hstep = (size_t)HALF * K * 2;
    const size_t tstep = 2 * hstep;
    const unsigned ldsw = (unsigned)wid * 1024u;
    const int aoff = lds_byte(wr * 64 + fr, fq * 8), boff = lds_byte(wc * 32 + fr, fq * 8);
#define PG8_SA(b, h) (((b) * 2 + (h)) * HTB)
#define PG8_SB(b, h) ((4 + (b) * 2 + (h)) * HTB)
#define PG8_STAGE(bufoff, gbase, voff) do { _Pragma("unroll") for (int _i = 0; _i < 2; ++_i) \
        __builtin_amdgcn_global_load_lds((const unsigned*)((const char*)(gbase) + (voff)[_i]), (LAS unsigned*)(lds + (bufoff) + ldsw + _i * 8192), 16, 0, 0); } while (0)
#define PG8_STAGE_A(bufoff, kptr, offs, h) do { _Pragma("unroll") for (int _i = 0; _i < 2; ++_i) \
        __builtin_amdgcn_global_load_lds((const unsigned*)((const char*)(kptr) + (offs)[h][_i]), (LAS unsigned*)(lds + (bufoff) + ldsw + _i * 8192), 16, 0, 0); } while (0)
#define PG8_AOFF(dst, u) do { _Pragma("unroll") for (int _h = 0; _h < 2; ++_h) _Pragma("unroll") for (int _i = 0; _i < 2; ++_i) { const int _row = (u).pm * BM + _h * HALF + Rr[_i]; \
        const int _src = g.rowmap ? g.rowmap[_row] : _row; dst[_h][_i] = (unsigned)(_src * K + Cc[_i]) * 2u; } } while (0)
#define PG8_LDA(dst, b, h) do { _Pragma("unroll") for (int m = 0; m < 4; ++m) _Pragma("unroll") for (int k = 0; k < 2; ++k) dst[m][k] = *(const LAS bf16x8*)(lds + PG8_SA(b, h) + aoff + m * 2048 + k * 1024); } while (0)
#define PG8_LDB(dst, b, h) do { _Pragma("unroll") for (int n = 0; n < 2; ++n) _Pragma("unroll") for (int k = 0; k < 2; ++k) dst[n][k] = *(const LAS bf16x8*)(lds + PG8_SB(b, h) + boff + n * 2048 + k * 1024); } while (0)
#define PG8_CAT(x, y) __builtin_shufflevector(__builtin_bit_cast(v4i_t, x), __builtin_bit_cast(v4i_t, y), 0, 1, 2, 3, 4, 5, 6, 7)
#define PG8_MMA(ai, bj, At, Bt) do { __builtin_amdgcn_s_setprio(1); _Pragma("unroll") for (int m = 0; m < 4; ++m) _Pragma("unroll") for (int n = 0; n < 2; ++n) { \
        if constexpr (FP8) { acc[ai][bj][m][n] = __builtin_amdgcn_mfma_scale_f32_16x16x128_f8f6f4(PG8_CAT(Bt[n][0], Bt[n][1]), PG8_CAT(At[m][0], At[m][1]), acc[ai][bj][m][n], 0, 0, 0, SCW, 0, SCA); } \
        else { _Pragma("unroll") for (int k = 0; k < 2; ++k) acc[ai][bj][m][n] = __builtin_amdgcn_mfma_f32_16x16x32_bf16(Bt[n][k], At[m][k], acc[ai][bj][m][n], 0, 0, 0); } } \
        __builtin_amdgcn_s_setprio(0); } while (0)
#define PG8_WAIT_V(n) asm volatile("s_waitcnt vmcnt(" #n ")" ::: "memory")
#define PG8_WAIT_L(n) asm volatile("s_waitcnt lgkmcnt(" #n ")" ::: "memory")
#define PG8_BAR __builtin_amdgcn_s_barrier()
#define PG8_SCHED __builtin_amdgcn_sched_barrier(0)
    Unit cur, nxt; int ui = 0;
    if (!S.next(0, cur)) return;
    f32x4 acc[2][2][4][2];
#pragma unroll
    for (int a = 0; a < 2; ++a)
#pragma unroll
        for (int b = 0; b < 2; ++b)
#pragma unroll
            for (int m = 0; m < 4; ++m)
#pragma unroll
                for (int n = 0; n < 2; ++n) acc[a][b][m][n] = (f32x4){0.f, 0.f, 0.f, 0.f};
    bf16x8 At[4][2], B0[2][2], B1[2][2];
    unsigned aoc[2][2], aon[2][2];
    PG8_AOFF(aoc, cur);
    const char* Ab = (const char*)g.A;
    const char* cB = (const char*)g.Bt + ((size_t)cur.e * (size_t)g.bstride) * 2 + (size_t)cur.pn * tstep;
    PG8_STAGE(PG8_SB(0, 0), cB, voffB); PG8_STAGE(PG8_SB(0, 1), cB + hstep, voffB); PG8_STAGE_A(PG8_SA(0, 0), Ab, aoc, 0); PG8_STAGE_A(PG8_SA(0, 1), Ab, aoc, 1);
    if (wr == 1) PG8_BAR;
    PG8_WAIT_V(2); PG8_BAR;
    PG8_STAGE(PG8_SB(1, 0), cB + kstep, voffB); PG8_STAGE_A(PG8_SA(1, 0), Ab + kstep, aoc, 0); PG8_STAGE(PG8_SB(1, 1), cB + hstep + kstep, voffB);
    PG8_WAIT_V(6); PG8_BAR;
    for (;;) {
        const bool has_next = S.next(ui + 1, nxt);
        if (has_next) { PG8_AOFF(aon, nxt); }
        else {
#pragma unroll
            for (int h = 0; h < 2; ++h)
#pragma unroll
                for (int i = 0; i < 2; ++i) aon[h][i] = aoc[h][i];
        }
        const char* nB = has_next ? (const char*)g.Bt + ((size_t)nxt.e * (size_t)g.bstride) * 2 + (size_t)nxt.pn * tstep : cB;
#pragma nounroll
        for (int t = 0; t < nt * KREP; t += 2) {
            const bool last = (t == nt * KREP - 2);
            const char* a1 = Ab + (size_t)((t + 1) & (nt - 1)) * kstep;
            const char* a2 = last ? Ab : Ab + (size_t)((t + 2) & (nt - 1)) * kstep; const char* b2 = last ? nB : cB + (size_t)((t + 2) & (nt - 1)) * kstep;
            const char* a3 = a2 + kstep; const char* b3 = b2 + kstep;
            PG8_LDB(B0, 0, 0); PG8_LDB(B1, 0, 1); PG8_SCHED; PG8_LDA(At, 0, 0); PG8_STAGE_A(PG8_SA(1, 1), a1, aoc, 1);
            if (last) {
#pragma unroll
                for (int h = 0; h < 2; ++h)
#pragma unroll
                    for (int i = 0; i < 2; ++i) aoc[h][i] = aon[h][i]; }
            PG8_WAIT_V(8); PG8_WAIT_L(0); PG8_BAR; PG8_MMA(0, 0, At, B0); PG8_MMA(0, 1, At, B1); PG8_BAR; PG8_SCHED;
            PG8_LDA(At, 0, 1); PG8_STAGE(PG8_SB(0, 0), b2, voffB); PG8_STAGE(PG8_SB(0, 1), b2 + hstep, voffB); PG8_STAGE_A(PG8_SA(0, 0), a2, aoc, 0);
            PG8_WAIT_V(8); PG8_WAIT_L(0); PG8_BAR; PG8_MMA(1, 0, At, B0); PG8_MMA(1, 1, At, B1); PG8_BAR; PG8_SCHED;
            PG8_LDB(B0, 1, 0); PG8_LDB(B1, 1, 1); PG8_SCHED; PG8_LDA(At, 1, 0); PG8_STAGE_A(PG8_SA(0, 1), a2, aoc, 1);
            PG8_WAIT_V(8); PG8_WAIT_L(0); PG8_BAR; PG8_MMA(0, 0, At, B0); PG8_MMA(0, 1, At, B1); PG8_BAR; PG8_SCHED;
            PG8_LDA(At, 1, 1); PG8_STAGE(PG8_SB(1, 0), b3, voffB); PG8_STAGE(PG8_SB(1, 1), b3 + hstep, voffB); PG8_STAGE_A(PG8_SA(1, 0), a3, aoc, 0);
            PG8_WAIT_V(8); PG8_WAIT_L(0); PG8_BAR; PG8_MMA(1, 0, At, B0); PG8_MMA(1, 1, At, B1); PG8_BAR; PG8_SCHED;
        }
        if constexpr (ALIGN_EPI) { if (wr == 0) PG8_BAR; }
        E(acc, cur, wr, wc, fr, fq);
        if constexpr (FP8 && PROBE_EPI != 0) { asm volatile("" ::: "memory"); E(acc, cur, wr, wc, fr, fq); }
        if (!has_next) break;
#pragma unroll
        for (int a = 0; a < 2; ++a)
#pragma unroll
            for (int b = 0; b < 2; ++b)
#pragma unroll
                for (int m = 0; m < 4; ++m)
#pragma unroll
                    for (int n = 0; n < 2; ++n) acc[a][b][m][n] = (f32x4){0.f, 0.f, 0.f, 0.f};
        cur = nxt; cB = nB; ++ui;
        if constexpr (ALIGN_EPI) { if (wr == 1) PG8_BAR; }
    }
    PG8_WAIT_V(0);
    if constexpr (!ALIGN_EPI) { if (wr == 0) PG8_BAR; }
    PG8_BAR;
#undef PG8_SA
#undef PG8_SB
#undef PG8_STAGE
#undef PG8_STAGE_A
#undef PG8_AOFF
#undef PG8_LDA
#undef PG8_LDB
#undef PG8_MMA
#undef PG8_CAT
#undef PG8_WAIT_V
#undef PG8_WAIT_L
#undef PG8_BAR
#undef PG8_SCHED
}

struct EpiProj {
    static constexpr bool PERM = true;
    bf16_t* O; const float* rstd;
    __device__ __forceinline__ void operator()(const f32x4 (&acc)[2][2][4][2], const Unit& u, int wr, int wc, int fr, int fq) const {
        const int row0 = u.pm * BM + wr * 64 + fr, col0 = u.pn * BM + wc * 32 + 8 * fq;
        const float sc = (u.pn == 3 || u.pn == 4 || u.pn == 9) ? C2 : 1.f;
        float rsv[2][4];
#pragma unroll
        for (int ai = 0; ai < 2; ++ai)
#pragma unroll
            for (int m = 0; m < 4; ++m) rsv[ai][m] = rstd[row0 + ai * HALF + m * 16] * sc;
#pragma unroll
        for (int ai = 0; ai < 2; ++ai)
#pragma unroll
            for (int m = 0; m < 4; ++m) { bf16_t* rowp = O + (size_t)(row0 + ai * HALF + m * 16) * INW + col0; const float rs = rsv[ai][m];
#pragma unroll
                for (int bj = 0; bj < 2; ++bj) { const f32x4 v0 = acc[ai][bj][m][0] * rs, v1 = acc[ai][bj][m][1] * rs;
                    u32x4 w; w.x = pk2(v0[0], v0[1]); w.y = pk2(v0[2], v0[3]); w.z = pk2(v1[0], v1[1]); w.w = pk2(v1[2], v1[3]);
                    *(u32x4*)(rowp + bj * HALF) = w; } }
    }
};
__device__ __forceinline__ unsigned pk4_fp8(float a, float b, float c, float d) { int w = 0; w = __builtin_amdgcn_cvt_pk_fp8_f32(a, b, w, false); w = __builtin_amdgcn_cvt_pk_fp8_f32(c, d, w, true); return (unsigned)w; }
struct EpiX1 {
    static constexpr bool PERM = true;
    const bf16_t* XB; bf16_t* O; unsigned char* Q8;
    __device__ __forceinline__ void operator()(const f32x4 (&acc)[2][2][4][2], const Unit& u, int wr, int wc, int fr, int fq) const {
        const int row0 = u.pm * BM + wr * 64 + fr, col0 = u.pn * BM + wc * 32 + 8 * fq;
        const bf16_t* __restrict__ Xr = XB; bf16_t* __restrict__ Or = O; unsigned char* __restrict__ Qr = Q8;
        u32x2 qp[2];
        u32x4 xv[2][4][2];
#pragma unroll
        for (int ai = 0; ai < 2; ++ai)
#pragma unroll
            for (int m = 0; m < 4; ++m) { const size_t off = (size_t)(row0 + ai * HALF + m * 16) * DM + col0;
#pragma unroll
                for (int bj = 0; bj < 2; ++bj) xv[ai][m][bj] = *(const u32x4*)(Xr + off + bj * HALF); }
#pragma unroll
        for (int ai = 0; ai < 2; ++ai)
#pragma unroll
            for (int m = 0; m < 4; ++m) { const size_t off = (size_t)(row0 + ai * HALF + m * 16) * DM + col0;
#pragma unroll
                for (int bj = 0; bj < 2; ++bj) { const u32x4 xw = xv[ai][m][bj];
                    const f32x4 x0 = {bflo(xw.x), bfhi(xw.x), bflo(xw.y), bfhi(xw.y)}, x1 = {bflo(xw.z), bfhi(xw.z), bflo(xw.w), bfhi(xw.w)};
                    const f32x4 v0 = acc[ai][bj][m][0] + x0, v1 = acc[ai][bj][m][1] + x1;
                    u32x4 w; w.x = pk2(v0[0], v0[1]); w.y = pk2(v0[2], v0[3]); w.z = pk2(v1[0], v1[1]); w.w = pk2(v1[2], v1[3]);
                    *(u32x4*)(Or + off + bj * HALF) = w;
                    u32x2 q; q.x = pk4_fp8(v0[0], v0[1], v0[2], v0[3]); q.y = pk4_fp8(v1[0], v1[1], v1[2], v1[3]);
                    if ((m & 1) == 0) qp[bj] = q;
                    else { const int odd = fq & 1;
                        auto rx = __builtin_amdgcn_permlane16_swap(qp[bj].x, q.x, false, false); auto ry = __builtin_amdgcn_permlane16_swap(qp[bj].y, q.y, false, false);
                        u32x4 o4; o4.x = rx[0]; o4.y = ry[0]; o4.z = rx[1]; o4.w = ry[1];
                        *(u32x4*)(Qr + (size_t)(row0 + ai * HALF + (m - 1 + odd) * 16) * DM + col0 - 8 * odd + bj * HALF) = o4; } } }
    }
};
struct EpiGU {
    static constexpr bool PERM = true;
    unsigned char* ACT; const float* bias; const float* rstd;
    __device__ __forceinline__ void operator()(const f32x4 (&acc)[2][2][4][2], const Unit& u, int wr, int wc, int fr, int fq) const {
        const int row0 = u.pm * BM + wr * 64 + fr, j0 = u.pn * HALF + wc * 32 + 8 * fq;
        const float* bp = bias + (size_t)u.e * 2048 + j0;
        const f32x4 bg0 = *(const f32x4*)(bp), bg1 = *(const f32x4*)(bp + 4), bu0 = *(const f32x4*)(bp + 1024), bu1 = *(const f32x4*)(bp + 1028);
        float rsv[2][4];
#pragma unroll
        for (int ai = 0; ai < 2; ++ai)
#pragma unroll
            for (int m = 0; m < 4; ++m) rsv[ai][m] = rstd[row0 + ai * HALF + m * 16];
#pragma unroll
        for (int ai = 0; ai < 2; ++ai) { u32x2 wp;
#pragma unroll
            for (int m = 0; m < 4; ++m) { const float rs = rsv[ai][m];
                float o[8];
#pragma unroll
                for (int h2 = 0; h2 < 2; ++h2) { const f32x4 ga = h2 ? acc[ai][0][m][1] : acc[ai][0][m][0], ua = h2 ? acc[ai][1][m][1] : acc[ai][1][m][0], gb = h2 ? bg1 : bg0, ub = h2 ? bu1 : bu0;
#pragma unroll
                    for (int p2 = 0; p2 < 2; ++p2) { const f32x2_t gacc = {ga[2 * p2], ga[2 * p2 + 1]}, uacc = {ua[2 * p2], ua[2 * p2 + 1]}, gbv = {gb[2 * p2], gb[2 * p2 + 1]}, ubv = {ub[2 * p2], ub[2 * p2 + 1]};
                        f32x2_t gg = gacc * rs + gbv, uu = uacc * rs + ubv;
                        gg[0] = fminf(gg[0], 7.f); gg[1] = fminf(gg[1], 7.f); uu[0] = __builtin_amdgcn_fmed3f(uu[0], -7.f, 7.f); uu[1] = __builtin_amdgcn_fmed3f(uu[1], -7.f, 7.f);
                        const f32x2_t tt = gg * (-1.702f * LOG2E); f32x2_t ee; ee[0] = __builtin_amdgcn_exp2f(tt[0]); ee[1] = __builtin_amdgcn_exp2f(tt[1]);
                        const f32x2_t dd = ee * 0.25f + 0.25f; f32x2_t rr; rr[0] = __builtin_amdgcn_rcpf(dd[0]); rr[1] = __builtin_amdgcn_rcpf(dd[1]);
                        const f32x2_t s4 = gg * rr, oo = uu * s4 + s4;
                        o[4 * h2 + 2 * p2] = oo[0]; o[4 * h2 + 2 * p2 + 1] = oo[1]; } }
                u32x2 w; w.x = pk4_fp8(o[0], o[1], o[2], o[3]); w.y = pk4_fp8(o[4], o[5], o[6], o[7]);
                if ((m & 1) == 0) wp = w;
                else { const int odd = fq & 1;
                    auto rx = __builtin_amdgcn_permlane16_swap(wp.x, w.x, false, false); auto ry = __builtin_amdgcn_permlane16_swap(wp.y, w.y, false, false);
                    u32x4 o4; o4.x = rx[0]; o4.y = ry[0]; o4.z = rx[1]; o4.w = ry[1];
                    *(u32x4*)(ACT + (size_t)(row0 + ai * HALF + (m - 1 + odd) * 16) * DEXP + j0 - 8 * odd) = o4; } } }
    }
};
struct EpiDown {
    static constexpr bool PERM = true;
    unsigned char* Y; const float* bias; const float* gate;
    __device__ __forceinline__ void operator()(const f32x4 (&acc)[2][2][4][2], const Unit& u, int wr, int wc, int fr, int fq) const {
        const int row0 = u.pm * BM + wr * 64 + fr, col0 = u.pn * BM + wc * 32 + 8 * fq;
        const float* bp = bias + (size_t)u.e * DM + col0;
        f32x4 bv[2][2];
#pragma unroll
        for (int bj = 0; bj < 2; ++bj) { bv[bj][0] = *(const f32x4*)(bp + bj * HALF); bv[bj][1] = *(const f32x4*)(bp + bj * HALF + 4); }
        float gsv[2][4];
#pragma unroll
        for (int ai = 0; ai < 2; ++ai)
#pragma unroll
            for (int m = 0; m < 4; ++m) gsv[ai][m] = 8.f * gate[row0 + ai * HALF + m * 16];
        const int odd = fq & 1;
#pragma unroll
        for (int ai = 0; ai < 2; ++ai)
#pragma unroll
            for (int m = 0; m < 4; m += 2) { const int row = row0 + ai * HALF + (m + odd) * 16;
#pragma unroll
                for (int bj = 0; bj < 2; ++bj) { u32x2 w[2];
#pragma unroll
                    for (int q = 0; q < 2; ++q) { const float gs = gsv[ai][m + q]; const f32x4 v0 = (acc[ai][bj][m + q][0] + bv[bj][0]) * gs, v1 = (acc[ai][bj][m + q][1] + bv[bj][1]) * gs;
                        w[q].x = pk4_fp8(v0[0], v0[1], v0[2], v0[3]); w[q].y = pk4_fp8(v1[0], v1[1], v1[2], v1[3]); }
                    { auto rx = __builtin_amdgcn_permlane16_swap(w[0].x, w[1].x, false, false); w[0].x = rx[0]; w[1].x = rx[1];
                      auto ry = __builtin_amdgcn_permlane16_swap(w[0].y, w[1].y, false, false); w[0].y = ry[0]; w[1].y = ry[1]; }
                    u32x4 o; o.x = w[0].x; o.y = w[0].y; o.z = w[1].x; o.w = w[1].y;
                    *(u32x4*)(Y + (size_t)row * DM + col0 - 8 * odd + bj * HALF) = o; } }
    }
};
}

namespace dattn {
constexpr int NW = 8, QBLK = 32, KVBLK = 64, QB = 256, PITCH = INW;
constexpr int SHM_V = KVBLK * 128 * 2, SHM_K = KVBLK * 64 * 2;
constexpr int NVS = 4, NKS = 3;
constexpr int OFF_V = 0, OFF_K = NVS * SHM_V, OFF_WS = OFF_K + NKS * SHM_K, OFF_STASH = OFF_WS + NW * 64 * 4, OFF_TB = OFF_STASH + NW * 8192, LDS_BYTES = OFF_TB + 4 * 128 * 4;
constexpr float THR = 8.f;
__device__ __forceinline__ int v_st(int k, int c) { const int kk = k;     return ((kk >> 3) * 4 + (c >> 5)) * 512 + ((kk & 7) * 32 + (c & 31)) * 2; }
__device__ __forceinline__ int v_rd_base(int lane) { return ((lane & 3) << 3) | (((lane >> 2) & 3) << 6) | (((lane >> 4) & 1) << 5) | (((lane >> 5) & 1) << 8); }
constexpr int v_rd_off(int d0, int ks, int half) { return d0 * 512 + ks * 4096 + half * 2048; }

struct Ref { unsigned qoff, koff, voff; bf16_t* O; int P0, comp, h; };
typedef __amdgpu_buffer_rsrc_t rsrc_t;
__device__ __forceinline__ bf16x8 bld8(rsrc_t r, unsigned voff, unsigned soff) { return __builtin_bit_cast(bf16x8, __builtin_amdgcn_raw_buffer_load_b128(r, (int)voff, (int)soff, 0)); }
struct Seam { bf16x8 qr[4]; int ks, vs;
#if PROBE_SEG
    unsigned long long acc, tot;
#endif
};

__device__ __forceinline__ bf16x8 ld8(const bf16_t* p) { return *reinterpret_cast<const bf16x8*>(p); }

__device__ __forceinline__ void bias_mask(f32x16& p0, f32x16& p1, int sdq  , const LAS float* tb) {
    const float NEG = -__builtin_inff();
    int lane_ = (int)__builtin_amdgcn_mbcnt_hi(~0u, __builtin_amdgcn_mbcnt_lo(~0u, 0u));
    int dq = sdq + (lane_ & 31) - 4 * (lane_ >> 5);
    asm volatile("" : "+v"(dq));
#pragma unroll
    for (int r = 0; r < 16; ++r) {
        const int c = (r & 3) + 8 * (r >> 2);
        const int d0 = dq - c, d1 = dq - c - 32;
        const int i0 = d0 < 0 ? 0 : (d0 > 127 ? 127 : d0), i1 = d1 < 0 ? 0 : (d1 > 127 ? 127 : d1);
        const float b0 = tb[i0], b1 = tb[i1];
        p0[r] = d0 < 0 ? NEG : p0[r] + b0;
        p1[r] = d1 < 0 ? NEG : p1[r] + b1;
    }
}
__device__ __forceinline__ void partialSM(f32x16& p0, f32x16& p1, float& m_reg, float& alpha) {
    float pmax = p0[0];
#pragma unroll
    for (int r = 1; r < 16; ++r) pmax = fmaxf(pmax, p0[r]);
#pragma unroll
    for (int r = 0; r < 16; ++r) pmax = fmaxf(pmax, p1[r]);
    { auto rr = __builtin_amdgcn_permlane32_swap(__float_as_uint(pmax), __float_as_uint(pmax), false, false);
      pmax = fmaxf(__uint_as_float(rr[0]), __uint_as_float(rr[1])); }
    float mn;
    if (__builtin_expect(__all((pmax - m_reg) <= THR), 1)) { mn = m_reg; alpha = 1.f; }
    else { mn = fmaxf(m_reg, pmax); alpha = __builtin_amdgcn_exp2f(m_reg - mn); m_reg = mn; }
#pragma unroll
    for (int r = 0; r < 16; ++r) p0[r] = p0[r] - mn;
#pragma unroll
    for (int r = 0; r < 16; ++r) p1[r] = p1[r] - mn;
#pragma unroll
    for (int r = 0; r < 16; ++r) p0[r] = __builtin_amdgcn_exp2f(p0[r]);
}
__device__ __forceinline__ void finishSM(f32x16& p0, f32x16& p1, float alpha, float& l_reg, bf16x8& pa0, bf16x8& pa1, bf16x8& pa2, bf16x8& pa3) {
#pragma unroll
    for (int r = 0; r < 16; ++r) p1[r] = __builtin_amdgcn_exp2f(p1[r]);
    float ps = 0;
#pragma unroll
    for (int r = 0; r < 16; ++r) ps += p0[r];
#pragma unroll
    for (int r = 0; r < 16; ++r) ps += p1[r];
    { auto rr = __builtin_amdgcn_permlane32_swap(__float_as_uint(ps), __float_as_uint(ps), false, false);
      ps = __uint_as_float(rr[0]) + __uint_as_float(rr[1]); }
    l_reg = l_reg * alpha + ps;
#define PK4(P, B_, OUT) do { unsigned a0 = pk2(P[B_+0], P[B_+1]), a1 = pk2(P[B_+2], P[B_+3]);                          \
        unsigned b0 = pk2(P[B_+4], P[B_+5]), b1 = pk2(P[B_+6], P[B_+7]);                                             \
        auto r0 = __builtin_amdgcn_permlane32_swap(a0, b0, false, false); auto r1 = __builtin_amdgcn_permlane32_swap(a1, b1, false, false); \
        u32x4 w = {r0[0], r1[0], r0[1], r1[1]}; OUT = __builtin_bit_cast(bf16x8, w); } while (0)
    PK4(p0, 0, pa0); PK4(p0, 8, pa1); PK4(p1, 0, pa2); PK4(p1, 8, pa3);
#undef PK4
}
template <int KB>
__device__ __forceinline__ void qkt(f32x16& p0, f32x16& p1, const LAS unsigned char* K_lds, int r32, int hi, const bf16x8* qr) {
    p0 = f32x16{}; p1 = f32x16{};
    const int s = (r32 >> 1) & 7;
#pragma unroll
    for (int d0 = 0; d0 < 4; ++d0) {
        const LAS unsigned char* a = K_lds + KB * SHM_K + r32 * 128 + (((2 * d0 + hi) ^ s) << 4);
        const bf16x8 b0 = *(const LAS bf16x8*)(a);
        const bf16x8 b1 = *(const LAS bf16x8*)(a + 32 * 128);
        p0 = __builtin_amdgcn_mfma_f32_32x32x16_bf16(b0, qr[d0], p0, 0, 0, 0);
        p1 = __builtin_amdgcn_mfma_f32_32x32x16_bf16(b1, qr[d0], p1, 0, 0, 0); }
}
__device__ __forceinline__ void pv_tile(f32x16* o, int vb0, bf16x8 pa0, bf16x8 pa1, bf16x8 pa2, bf16x8 pa3) {
#define TRRD(dst, off) asm volatile("ds_read_b64_tr_b16 %0, %1 offset:%2" : "=&v"(dst) : "v"(vb0), "i"(off) : "memory")
#define PV_D0(d0) do { s16x4 l0, l1, l2, l3, h0, h1, h2, h3; constexpr int b_ = v_rd_off(d0, 0, 0); \
        TRRD(l0, b_); TRRD(h0, b_ + 2048); TRRD(l1, b_ + 4096); TRRD(h1, b_ + 6144); TRRD(l2, b_ + 8192); TRRD(h2, b_ + 10240); TRRD(l3, b_ + 12288); TRRD(h3, b_ + 14336); \
        asm volatile("s_waitcnt lgkmcnt(0)" ::: "memory"); SBAR();   \
        o[d0] = __builtin_amdgcn_mfma_f32_32x32x16_bf16(pa0, (bf16x8){l0[0], l0[1], l0[2], l0[3], h0[0], h0[1], h0[2], h0[3]}, o[d0], 0, 0, 0);   \
        o[d0] = __builtin_amdgcn_mfma_f32_32x32x16_bf16(pa1, (bf16x8){l1[0], l1[1], l1[2], l1[3], h1[0], h1[1], h1[2], h1[3]}, o[d0], 0, 0, 0);   \
        o[d0] = __builtin_amdgcn_mfma_f32_32x32x16_bf16(pa2, (bf16x8){l2[0], l2[1], l2[2], l2[3], h2[0], h2[1], h2[2], h2[3]}, o[d0], 0, 0, 0);   \
        o[d0] = __builtin_amdgcn_mfma_f32_32x32x16_bf16(pa3, (bf16x8){l3[0], l3[1], l3[2], l3[3], h3[0], h3[1], h3[2], h3[3]}, o[d0], 0, 0, 0); } while (0)
    PV_D0(0); PV_D0(1); PV_D0(2); PV_D0(3);
#undef PV_D0
#undef TRRD
}

#define DA_DMA16(gp, ldsp) __builtin_amdgcn_global_load_lds((const unsigned*)(gp), (LAS unsigned*)(ldsp), 16, 0, 0)
#define DA_STAGE(koff_, voff_, k0, ksoff, vsoff) do { const size_t tb_ = (size_t)(k0) * (PITCH * 2); \
        DA_DMA16(projb + (koff_) + tb_ + lk, K_lds + (ksoff) + wid * 1024); \
        DA_DMA16(projb + (voff_) + tb_ + lv, V_lds + (vsoff) + wid * 2048); \
        DA_DMA16(projb + (voff_) + tb_ + lv + 128, V_lds + (vsoff) + wid * 2048 + 1024); } while (0)
#define DA_LANE_OFFS() const int krow_ = 8 * wid + (lane >> 3); \
        const unsigned lk = (unsigned)(krow_ * PITCH) * 2u + (unsigned)(((lane & 7) ^ ((krow_ >> 1) & 7)) << 4); \
        const unsigned lv = (unsigned)((8 * wid + ((lane & 31) >> 2)) * PITCH) * 2u + (unsigned)(((lane >> 5) * 32 + (lane & 3) * 8) * 2)

__device__ __forceinline__ void prime(const Ref& cur, LAS unsigned char* lds, Seam& S, rsrc_t R, const char* projb) {
    const int tid = threadIdx.x, wid = __builtin_amdgcn_readfirstlane(tid >> 6), lane = tid & 63, r32 = lane & 31, hi = lane >> 5;
    DA_LANE_OFFS();
    const unsigned lq = (unsigned)((wid * QBLK + r32) * PITCH + hi * 8) * 2u;
    LAS unsigned char* K_lds = lds + OFF_K; LAS unsigned char* V_lds = lds + OFF_V;
#pragma unroll
    for (int d0 = 0; d0 < 4; ++d0) S.qr[d0] = bld8(R, lq + d0 * 32, cur.qoff);
    S.ks = 0; S.vs = 0;
    DA_STAGE(cur.koff, cur.voff, 0, 0, 0); DA_STAGE(cur.koff, cur.voff, KVBLK, SHM_K, SHM_V);
    asm volatile("s_waitcnt vmcnt(0)" ::: "memory");
    __syncthreads();
}
__device__ __forceinline__ void block(const Ref& cur, const Ref& nxt, LAS unsigned char* lds, Seam& S, float lam, const float* gsub, rsrc_t R, const char* projb) {
    const int tid = threadIdx.x, wid = __builtin_amdgcn_readfirstlane(tid >> 6), lane = tid & 63, r32 = lane & 31, hi = lane >> 5;
    const int NT = (cur.P0 + QB) / KVBLK;
    const int qlo = cur.P0 + wid * QBLK;
    LAS unsigned char* V_lds = lds + OFF_V; LAS unsigned char* K_lds = lds + OFF_K;
    LAS float* ws = (LAS float*)(lds + OFF_WS) + wid * 64; LAS float* li_l = ws; LAS float* al_l = ws + 32;
    const LAS float* tbh = (const LAS float*)(lds + OFF_TB) + cur.h * 128;
    float mhat = 0.f, l_reg = 0.f, rmx = 0.f; f32x16 o[4] = {}; f32x16 negm = f32x16{};
    bool resc = false;
    const int vb0 = (int)(unsigned)(uintptr_t)V_lds + v_rd_base(lane);
    DA_LANE_OFFS();
    const unsigned Kh = cur.koff, Vh = cur.voff;
#define KNEXT(x) (((x) == (NKS - 1) * SHM_K) ? 0 : (x) + SHM_K)
#define VNEXT(x) (((x) == (NVS - 1) * SHM_V) ? 0 : (x) + SHM_V)
    int k0 = S.ks, k1 = KNEXT(k0), k2 = KNEXT(k1);
    int v1 = S.vs, v2 = VNEXT(v1), v3 = VNEXT(v2), v0 = VNEXT(v3);
#define ROT() do { const int kn_ = k0; k0 = k1; k1 = k2; k2 = kn_; const int vn_ = v0; v0 = v1; v1 = v2; v2 = v3; v3 = vn_; } while (0)
#define STREAM(j) do { const bool in_ = (j) < NT; const unsigned ko_ = in_ ? Kh : nxt.koff, vo_ = in_ ? Vh : nxt.voff; const int tj_ = in_ ? (j) : (j) - NT; DA_STAGE(ko_, vo_, KBASE(tj_), k2, v3); } while (0)
#define STEP_BAR() asm volatile("s_waitcnt vmcnt(3) lgkmcnt(0)\n\ts_barrier" ::: "memory")
    const int ksw = (r32 >> 1) & 7;
    const LAS unsigned char* kbase = K_lds + r32 * 128;
#define KBASE(t) ((t) * KVBLK)
#define NEAR(P0_, P1_, t) do { const int kb_ = KBASE(t); if (kb_ >= qlo - 175) bias_mask(P0_, P1_, qlo - kb_, tbh); } while (0)
#define RESC() do { if (resc) { asm volatile("s_waitcnt lgkmcnt(0)" ::: "memory");              \
                     _Pragma("unroll") for (int d_ = 0; d_ < 4; ++d_) _Pragma("unroll") for (int r = 0; r < 16; ++r) o[d_][r] *= al_l[crow(r, hi)]; } } while (0)
#define PIN(x) asm volatile("" : "+v"(x))
#define EX(v) __builtin_amdgcn_exp2f(v)
#define MX3(a, b, c) __builtin_fmaxf(__builtin_fmaxf((a), (b)), (c))
#define DECIDE(C0, C1, FIRST) do { \
        float a_ = MX3(C0[0], C0[1], C1[0]), b_ = MX3(C0[2], C0[3], C1[1]); a_ = MX3(a_, C1[2], C1[3]); \
        _Pragma("unroll") for (int r = 4; r < 16; r += 4) { a_ = MX3(a_, C0[r], C0[r + 1]); b_ = MX3(b_, C0[r + 2], C0[r + 3]); a_ = MX3(a_, C1[r], C1[r + 1]); b_ = MX3(b_, C1[r + 2], C1[r + 3]); } \
        float rm_ = __builtin_fmaxf(a_, b_); { auto rr_ = __builtin_amdgcn_permlane32_swap(__float_as_uint(rm_), __float_as_uint(rm_), false, false); rm_ = __builtin_fmaxf(__uint_as_float(rr_[0]), __uint_as_float(rr_[1])); } \
        resc = false; \
        if ((FIRST) || __builtin_expect(__any(rm_ > THR), 0)) { const float dl_ = (FIRST) ? rm_ : __builtin_fmaxf(rm_, 0.f); mhat += dl_; \
            _Pragma("unroll") for (int r = 0; r < 16; ++r) { C0[r] -= dl_; C1[r] -= dl_; } \
            _Pragma("unroll") for (int r = 0; r < 16; ++r) negm[r] = -mhat; \
            asm volatile("" : "+v"(negm)); \
            if (!(FIRST)) { const float f_ = EX(-dl_); l_reg *= f_; if (hi == 0) al_l[r32] = f_; resc = true; } } } while (0)
#define DECIDE2(C0, C1) do { float rm_ = rmx; { auto rr_ = __builtin_amdgcn_permlane32_swap(__float_as_uint(rm_), __float_as_uint(rm_), false, false); rm_ = __builtin_fmaxf(__uint_as_float(rr_[0]), __uint_as_float(rr_[1])); } \
        resc = false; \
        if (__builtin_expect(__any(rm_ > THR), 0)) { const float dl_ = __builtin_fmaxf(rm_, 0.f); mhat += dl_; const float f_ = EX(-dl_); \
            _Pragma("unroll") for (int r = 0; r < 16; ++r) { C0[r] *= f_; C1[r] *= f_; } \
            _Pragma("unroll") for (int r = 0; r < 16; ++r) negm[r] = -mhat; \
            asm volatile("" : "+v"(negm)); \
            l_reg *= f_; if (hi == 0) al_l[r32] = f_; resc = true; } } while (0)
#define KF(d0, hf) (*(const LAS bf16x8*)(kbase + k0 + (((2 * (d0) + hi) ^ ksw) << 4) + (hf) * 4096))
#define GAPA(MF, P, B, W) do { MF; sacc += P[B]; sacc += P[B + 1]; sacc += P[B + 2]; sacc += P[B + 3]; PIN(sacc); W[((B) >> 1) & 3] = pk2(P[B], P[B + 1]); W[(((B) >> 1) & 3) + 1] = pk2(P[B + 2], P[B + 3]); PIN(W); SBAR(); } while (0)
#define PHASE_A(C0, C1, P0, P1) do { \
        const bf16x8 k00 = KF(0, 0), k01 = KF(0, 1), k10 = KF(1, 0), k11 = KF(1, 1), k20 = KF(2, 0), k21 = KF(2, 1), k30 = KF(3, 0), k31 = KF(3, 1); \
        float sacc = 0.f; SBAR(); \
        GAPA(C0 = __builtin_amdgcn_mfma_f32_32x32x16_bf16(k00, S.qr[0], negm, 0, 0, 0), P0, 0, pw0); \
        GAPA(C1 = __builtin_amdgcn_mfma_f32_32x32x16_bf16(k01, S.qr[0], negm, 0, 0, 0), P0, 4, pw0); \
        GAPA(C0 = __builtin_amdgcn_mfma_f32_32x32x16_bf16(k10, S.qr[1], C0, 0, 0, 0), P0, 8, pw1); \
        GAPA(C1 = __builtin_amdgcn_mfma_f32_32x32x16_bf16(k11, S.qr[1], C1, 0, 0, 0), P0, 12, pw1); \
        GAPA(C0 = __builtin_amdgcn_mfma_f32_32x32x16_bf16(k20, S.qr[2], C0, 0, 0, 0), P1, 0, pw2); \
        GAPA(C1 = __builtin_amdgcn_mfma_f32_32x32x16_bf16(k21, S.qr[2], C1, 0, 0, 0), P1, 4, pw2); \
        GAPA(C0 = __builtin_amdgcn_mfma_f32_32x32x16_bf16(k30, S.qr[3], C0, 0, 0, 0), P1, 8, pw3); \
        GAPA(C1 = __builtin_amdgcn_mfma_f32_32x32x16_bf16(k31, S.qr[3], C1, 0, 0, 0), P1, 12, pw3); \
        l_reg += sacc; } while (0)
#define TRRD(dst, off) asm volatile("ds_read_b64_tr_b16 %0, %1 offset:%2" : "=&v"(dst) : "v"(vbr), "i"(off) : "memory")
#define VRD8(L0, H0, L1, H1, L2, H2, L3, H3, VBv, d0) do { constexpr int b_ = v_rd_off(d0, 0, 0); \
        TRRD(L0, b_); TRRD(H0, b_ + 2048); TRRD(L1, b_ + 4096); TRRD(H1, b_ + 6144); TRRD(L2, b_ + 8192); TRRD(H2, b_ + 10240); TRRD(L3, b_ + 12288); TRRD(H3, b_ + 14336); } while (0)
#define VF(L, H) (bf16x8){L[0], L[1], L[2], L[3], H[0], H[1], H[2], H[3]}
#define PAF(k) __builtin_bit_cast(bf16x8, pw##k)
#define GAPB(MF, X, B) do { MF; rmx = MX3(rmx, X[B], X[(B) + 1]); X[B] = EX(X[B]); X[(B) + 1] = EX(X[(B) + 1]); PIN(X); PIN(rmx); SBAR(); } while (0)
#define PV4(d0, L0, H0, L1, H1, L2, H2, L3, H3, X, B) do { \
        GAPB(o[d0] = __builtin_amdgcn_mfma_f32_32x32x16_bf16(PAF(0), VF(L0, H0), o[d0], 0, 0, 0), X, (B)); \
        GAPB(o[d0] = __builtin_amdgcn_mfma_f32_32x32x16_bf16(PAF(1), VF(L1, H1), o[d0], 0, 0, 0), X, (B) + 2); \
        GAPB(o[d0] = __builtin_amdgcn_mfma_f32_32x32x16_bf16(PAF(2), VF(L2, H2), o[d0], 0, 0, 0), X, (B) + 4); \
        GAPB(o[d0] = __builtin_amdgcn_mfma_f32_32x32x16_bf16(PAF(3), VF(L3, H3), o[d0], 0, 0, 0), X, (B) + 6); } while (0)
#define LWAIT(n) do { asm volatile("s_waitcnt lgkmcnt(" #n ")" ::: "memory"); SBAR(); } while (0)
#define PHASE_B(C0, C1, VBv) do { s16x4 a0, a1, a2, a3, a4, a5, a6, a7, b0, b1, b2, b3, b4, b5, b6, b7; const int vbr = vb0 + (VBv); rmx = -__builtin_inff(); \
        asm volatile("s_waitcnt lgkmcnt(0)" ::: "memory"); SBAR(); \
        VRD8(a0, a1, a2, a3, a4, a5, a6, a7, VBv, 0); VRD8(b0, b1, b2, b3, b4, b5, b6, b7, VBv, 1); LWAIT(8); \
        PV4(0, a0, a1, a2, a3, a4, a5, a6, a7, C0, 0); \
        VRD8(a0, a1, a2, a3, a4, a5, a6, a7, VBv, 2); LWAIT(8); \
        PV4(1, b0, b1, b2, b3, b4, b5, b6, b7, C0, 8); \
        VRD8(b0, b1, b2, b3, b4, b5, b6, b7, VBv, 3); LWAIT(8); \
        PV4(2, a0, a1, a2, a3, a4, a5, a6, a7, C1, 0); \
        LWAIT(0); \
        PV4(3, b0, b1, b2, b3, b4, b5, b6, b7, C1, 8); } while (0)
    f32x16 pA0, pA1, pB0, pB1; u32x4 pw0, pw1, pw2, pw3;
#if PROBE_SEG
    unsigned long long pst_ = __builtin_readcyclecounter();
#define STAMP(k) do { const unsigned long long n_ = __builtin_readcyclecounter(); if ((k) == PROBE_SEG) S.acc += n_ - pst_; S.tot += n_ - pst_; pst_ = n_; } while (0)
#else
#define STAMP(k) do { } while (0)
#endif
    STREAM(2);
    SBAR();
    {
      const bf16x8 k00 = KF(0, 0), k01 = KF(0, 1), k10 = KF(1, 0), k11 = KF(1, 1), k20 = KF(2, 0), k21 = KF(2, 1), k30 = KF(3, 0), k31 = KF(3, 1);
      pA0 = __builtin_amdgcn_mfma_f32_32x32x16_bf16(k00, S.qr[0], negm, 0, 0, 0); pA1 = __builtin_amdgcn_mfma_f32_32x32x16_bf16(k01, S.qr[0], negm, 0, 0, 0);
      pA0 = __builtin_amdgcn_mfma_f32_32x32x16_bf16(k10, S.qr[1], pA0, 0, 0, 0); pA1 = __builtin_amdgcn_mfma_f32_32x32x16_bf16(k11, S.qr[1], pA1, 0, 0, 0);
      pA0 = __builtin_amdgcn_mfma_f32_32x32x16_bf16(k20, S.qr[2], pA0, 0, 0, 0); pA1 = __builtin_amdgcn_mfma_f32_32x32x16_bf16(k21, S.qr[2], pA1, 0, 0, 0);
      pA0 = __builtin_amdgcn_mfma_f32_32x32x16_bf16(k30, S.qr[3], pA0, 0, 0, 0); pA1 = __builtin_amdgcn_mfma_f32_32x32x16_bf16(k31, S.qr[3], pA1, 0, 0, 0); }
    NEAR(pA0, pA1, 0); DECIDE(pA0, pA1, true);
#pragma unroll
    for (int r = 0; r < 16; ++r) { pA0[r] = EX(pA0[r]); pA1[r] = EX(pA1[r]); }
    STEP_BAR();
    ROT();
#define STEP(C0, C1, P0, P1, t) do { SBAR(); STAMP(5); \
        STREAM((t) + 2); SBAR(); \
        PHASE_A(C0, C1, P0, P1); SBAR(); STAMP(1); \
        NEAR(C0, C1, (t)); SBAR(); STAMP(2); \
        PHASE_B(C0, C1, v0); DECIDE2(C0, C1); SBAR(); STAMP(3); \
        RESC(); STEP_BAR(); STAMP(4); ROT(); } while (0)
    int t = 1;
    for (; t + 2 < NT; t += 2) {
        STEP(pB0, pB1, pA0, pA1, t);
        STEP(pA0, pA1, pB0, pB1, t + 1);
    }
    SBAR(); STREAM(NT + 1); SBAR();
    PHASE_A(pB0, pB1, pA0, pA1);
    { const unsigned lq = (unsigned)((wid * QBLK + r32) * PITCH + hi * 8) * 2u;
#pragma unroll
      for (int d0 = 0; d0 < 4; ++d0) S.qr[d0] = bld8(R, lq + d0 * 32, nxt.qoff); }
    SBAR();
    NEAR(pB0, pB1, NT - 1); SBAR();
    PHASE_B(pB0, pB1, v0); DECIDE2(pB0, pB1);
    RESC();
    { float sacc = 0.f;
#pragma unroll
      for (int r = 0; r < 16; ++r) { sacc += pB0[r]; sacc += pB1[r]; }
      l_reg += sacc;
      pw0 = (u32x4){pk2(pB0[0], pB0[1]), pk2(pB0[2], pB0[3]), pk2(pB0[4], pB0[5]), pk2(pB0[6], pB0[7])}; pw1 = (u32x4){pk2(pB0[8], pB0[9]), pk2(pB0[10], pB0[11]), pk2(pB0[12], pB0[13]), pk2(pB0[14], pB0[15])};
      pw2 = (u32x4){pk2(pB1[0], pB1[1]), pk2(pB1[2], pB1[3]), pk2(pB1[4], pB1[5]), pk2(pB1[6], pB1[7])}; pw3 = (u32x4){pk2(pB1[8], pB1[9]), pk2(pB1[10], pB1[11]), pk2(pB1[12], pB1[13]), pk2(pB1[14], pB1[15])};
      SBAR(); pv_tile(o, vb0 + v1, PAF(0), PAF(1), PAF(2), PAF(3)); }
    asm volatile("s_waitcnt vmcnt(0)" ::: "memory");
    ROT(); S.ks = k0; S.vs = v1;
    { auto rr = __builtin_amdgcn_permlane32_swap(__float_as_uint(l_reg), __float_as_uint(l_reg), false, false); l_reg = __uint_as_float(rr[0]) + __uint_as_float(rr[1]); }
    int lane_e = (int)__builtin_amdgcn_mbcnt_hi(~0u, __builtin_amdgcn_mbcnt_lo(~0u, 0u)); asm volatile("" : "+v"(lane_e));
    const int r32e = lane_e & 31, hie = lane_e >> 5;
    if (hi == 0) li_l[r32] = l_reg; asm volatile("s_waitcnt lgkmcnt(0)" ::: "memory");
    float rli[16];
#pragma unroll
    for (int r = 0; r < 16; ++r) rli[r] = __builtin_amdgcn_rcpf(li_l[crow(r, hi)]);
    LAS unsigned* st = (LAS unsigned*)(lds + OFF_STASH + wid * 8192) + lane_e;
    if (cur.comp == 0) {
#pragma unroll
        for (int r = 0; r < 16; ++r) { st[(2 * r) * 64] = pk2(o[0][r] * rli[r], o[1][r] * rli[r]); st[(2 * r + 1) * 64] = pk2(o[2][r] * rli[r], o[3][r] * rli[r]); }
    } else {
        float ss[16];
#pragma unroll
        for (int r = 0; r < 16; ++r) { const unsigned u0 = st[(2 * r) * 64], u1 = st[(2 * r + 1) * 64];
            const float s2 = lam * rli[r];
            o[0][r] = bflo(u0) - s2 * o[0][r]; o[1][r] = bfhi(u0) - s2 * o[1][r]; o[2][r] = bflo(u1) - s2 * o[2][r]; o[3][r] = bfhi(u1) - s2 * o[3][r];
            ss[r] = (o[0][r] * o[0][r] + o[1][r] * o[1][r]) + (o[2][r] * o[2][r] + o[3][r] * o[3][r]); }
#pragma unroll
        for (int r = 0; r < 16; ++r) {
#pragma unroll
            for (int x = 1; x < 32; x <<= 1) ss[r] += __shfl_xor(ss[r], x);
            ss[r] = rsqrtf(ss[r] * (1.f / 128.f) + EPS) * 0.8f; }
        float gg[4];
#pragma unroll
        for (int d0 = 0; d0 < 4; ++d0) gg[d0] = gsub[d0 * 32 + r32e];
        bf16_t* Ow = cur.O + (size_t)(wid * QBLK) * DM;
#pragma unroll
        for (int r = 0; r < 16; ++r) { const int orow = crow(r, hie);
#pragma unroll
            for (int d0 = 0; d0 < 4; ++d0) { const float v = o[d0][r] * ss[r] * gg[d0]; const float vn = __shfl_xor(v, 1);
                if ((r32e & 1) == 0) *(unsigned*)(Ow + (size_t)orow * DM + d0 * 32 + r32e) = pk2(v, vn); } }
    }
    __syncthreads();
#undef RESC
#undef KBASE
#undef NEAR
#undef PIN
#undef EX
#undef MX3
#undef DECIDE
#undef DECIDE2
#undef KF
#undef GAPA
#undef PHASE_A
#undef TRRD
#undef VRD8
#undef VF
#undef PAF
#undef GAPB
#undef PV4
#undef LWAIT
#undef PHASE_B
#undef STEP
#undef STAMP
#undef ROT
#undef KNEXT
#undef VNEXT
#undef STREAM
#undef STEP_BAR
}
#undef DA_DMA16
#undef DA_STAGE
#undef DA_LANE_OFFS
}

constexpr int NWAVES = 8;
constexpr int N_LAUNCHES = MK_N_LAUNCHES;
constexpr int N_PHASES = 9;
static_assert(N_LAUNCHES == 1 || N_LAUNCHES == N_PHASES, "MK_N_LAUNCHES is 1 or 9");

constexpr size_t MiB = 1u << 20;
constexpr size_t WS_CTL = 0, CTL_ZERO_BYTES = 1 * MiB;
constexpr size_t WS_ETK = 1 * MiB, WS_GTK = 2 * MiB, WS_RSTDT = 3 * MiB, WS_SLOTTK = 4 * MiB, WS_TOKSLOT = 5 * MiB, WS_GATESLOT = 7 * MiB, WS_RSTDSLOT = 9 * MiB, WS_RBE = 11 * MiB;
constexpr size_t WS_WRHI = 12 * MiB, WS_WRLO = 12 * MiB + 65536, WS_KMB = 13 * MiB, WS_VMT = 14 * MiB;
constexpr size_t WS_WIN = 16 * MiB, WS_WOUT = 21 * MiB, WS_X1B = 24 * MiB, WS_X1Q = 152 * MiB;
constexpr size_t WS_BIG = 216 * MiB;
constexpr size_t WS_H = WS_BIG, WS_PROJ = WS_BIG + 128 * MiB, WS_MIX = WS_BIG + 448 * MiB;
constexpr size_t WS_ACTQ = WS_BIG, WS_Y = WS_BIG + 264 * MiB;
constexpr size_t WS_WGU = 792 * MiB, WS_WD = 856 * MiB;
constexpr size_t WS_RSTDX = 888 * MiB;
constexpr size_t WS_END = 889 * MiB;
static_assert(WS_MIX + (size_t)T * DM * 2 <= WS_WGU && WS_END <= 1024 * MiB, "d_ws map");
constexpr int CW_BAR = 4096, CW_COUNT = 1024, CW_CURSOR = 2048;
constexpr int RING_BYTES = 159744, LDSCTL_OFF = RING_BYTES, MISC_OFF = LDSCTL_OFF + 320, LDS_BYTES = 163840;
static_assert(dattn::LDS_BYTES <= RING_BYTES, "attention scratch");

#define XB_TMO      128
#define XB_XCNT(j)  (256  + 64 * (j))
#define XB_XSUB(j)  (1280 + 64 * (j))
#define XB_XGEN(j)  (2304 + 64 * (j))
#define XB_TOP      3328
#define XB_TOPGEN   3392
#define XCD_BAR_WORDS 3456
#define XB_SPIN_CAP (1u << 18)
__device__ __forceinline__ unsigned xb_ld(unsigned* p)              { return __hip_atomic_load(p, __ATOMIC_RELAXED, __HIP_MEMORY_SCOPE_AGENT); }
__device__ __forceinline__ unsigned xb_add(unsigned* p, unsigned v) { return __hip_atomic_fetch_add(p, v, __ATOMIC_RELAXED, __HIP_MEMORY_SCOPE_AGENT); }
__device__ __forceinline__ unsigned xb_xcc_id() { return (unsigned)__builtin_amdgcn_s_getreg((3 << 11) | 20) & 0xFu; }
#define XB_SPIN(cond, bar) do { unsigned _sp = 0; while (cond) { __builtin_amdgcn_s_sleep(1); \
    if ((++_sp & 255u) == 0u) { if (xb_ld(&(bar)[XB_TMO])) break; if (_sp > XB_SPIN_CAP) { atomicAdd(&(bar)[XB_TMO], 1u); break; } } } } while (0)
struct XcdBarrier { unsigned* bar; unsigned x; volatile LAS unsigned* st; };
__device__ __forceinline__ XcdBarrier xcd_barrier_post(unsigned* bar, volatile LAS unsigned* st) {
    XcdBarrier b; b.bar = bar; b.x = xb_xcc_id(); b.st = st;
    if (threadIdx.x == 0) (void)xb_add(&bar[XB_XCNT(b.x)], 1u);
    return b;
}
__device__ __forceinline__ void xcd_barrier_complete(unsigned* bar, unsigned x, unsigned& nloc, unsigned& nx) {
    const unsigned G = gridDim.x * gridDim.y * gridDim.z;
    unsigned sum, cnt, mine, sp = 0u;
    for (;;) {
        sum = 0u; cnt = 0u; mine = 0u;
#pragma unroll
        for (unsigned j = 0; j < 16; ++j) { const unsigned c = xb_ld(&bar[XB_XCNT(j)]); sum += c; cnt += (c > 0u) ? 1u : 0u; mine = (j == x) ? c : mine; }
        if (sum == G) break;
        __builtin_amdgcn_s_sleep(1);
        if ((++sp & 255u) == 0u) { if (xb_ld(&bar[XB_TMO])) break; if (sp > XB_SPIN_CAP) { atomicAdd(&bar[XB_TMO], 1u); break; } }
    }
    nloc = mine > 0u ? mine : 1u; nx = cnt > 0u ? cnt : 1u;
}
__device__ __forceinline__ void xcd_barrier(const XcdBarrier& b) {
    asm volatile("s_waitcnt vmcnt(0)" ::: "memory");
    __syncthreads();
    if (threadIdx.x == 0) {
        unsigned* bar = b.bar;
        __builtin_amdgcn_s_waitcnt(0);
        unsigned nloc = b.st[0], nx = b.st[1];
        if (nloc == 0u) { xcd_barrier_complete(bar, b.x, nloc, nx); b.st[0] = nloc; b.st[1] = nx; }
        const unsigned old = xb_add(&bar[XB_XSUB(b.x)], 1u);
        const unsigned gen = old / nloc;
        if (old + 1u == (gen + 1u) * nloc) {
            __builtin_amdgcn_fence(__ATOMIC_RELEASE, "agent");
            asm volatile("s_waitcnt vmcnt(0)" ::: "memory");
            const unsigned og = xb_add(&bar[XB_TOP], 1u);
            const unsigned tg = og / nx;
            if (og + 1u == (tg + 1u) * nx) xb_add(&bar[XB_TOPGEN], 1u);
            else XB_SPIN(xb_ld(&bar[XB_TOPGEN]) == tg, bar);
            __builtin_amdgcn_fence(__ATOMIC_ACQUIRE, "agent");
            xb_add(&bar[XB_XGEN(b.x)], 1u);
            asm volatile("s_waitcnt vmcnt(0)" ::: "memory");
        } else {
            XB_SPIN(xb_ld(&bar[XB_XGEN(b.x)]) == gen, bar);
            __builtin_amdgcn_fence(__ATOMIC_ACQUIRE, "agent");
            asm volatile("s_waitcnt vmcnt(0)" ::: "memory");
        }
    }
    __syncthreads();
}

struct Frame {
    LAS unsigned char* lds;
    volatile LAS unsigned* MISC;
    unsigned* ctl;
    int tid, lane, wave, vcu, G;
    float* out;
    unsigned char* ws;
};
struct Args { const float* in[19]; float* out; unsigned char* ws; int ph_lo, ph_hi; };
typedef const __attribute__((address_space(4))) Args* KArgs;
__device__ __forceinline__ KArgs kargs() { KArgs p = (KArgs)__builtin_amdgcn_kernarg_segment_ptr(); asm volatile("" : "+s"(p)); return p; }
enum { I_X = 0, I_MEM, I_RELB, I_ATTNG, I_WIN, I_CONVW, I_LAMQK, I_SUBG, I_MEMG, I_WMEMKV, I_WOUT, I_FFNG, I_RW, I_RB, I_WGU, I_BGU, I_WDN, I_BDN, I_FING };

template <bool GAIN, bool F8>
__device__ __forceinline__ void p0_transpose_item(const float* W, int K, int N, void* WTv, int k0, int n0, int drow0, const float* kgain, float scale, LAS float* scr, int lane) {
    float v[32];
    const float* wp = W + (size_t)(k0 + (lane >> 5)) * N + n0 + (lane & 31);
#pragma unroll
    for (int i = 0; i < 32; ++i) v[i] = wp[(size_t)(2 * i) * N];
    const int c = lane & 7;
    f32x4 g0 = {scale, scale, scale, scale}, g1 = g0;
    if constexpr (GAIN) { g0 = *(const f32x4*)(kgain + k0 + 8 * c) * scale; g1 = *(const f32x4*)(kgain + k0 + 8 * c + 4) * scale; }
#pragma unroll
    for (int i = 0; i < 32; ++i) scr[(2 * i + (lane >> 5)) * 33 + (lane & 31)] = v[i];
    LDS_WAIT(); asm volatile("" ::: "memory");
#pragma unroll
    for (int j = 0; j < 4; ++j) { const int n = (lane >> 3) + 8 * j; const LAS float* s = scr + (8 * c) * 33 + n;
        const float e0 = s[0 * 33] * g0[0], e1 = s[1 * 33] * g0[1], e2 = s[2 * 33] * g0[2], e3 = s[3 * 33] * g0[3], e4 = s[4 * 33] * g1[0], e5 = s[5 * 33] * g1[1], e6 = s[6 * 33] * g1[2], e7 = s[7 * 33] * g1[3];
        if constexpr (F8) { u32x2 o; o.x = pg8::pk4_fp8(e0, e1, e2, e3); o.y = pg8::pk4_fp8(e4, e5, e6, e7);
            *(u32x2*)((unsigned char*)WTv + (size_t)(drow0 + n) * K + k0 + 8 * c) = o; }
        else { u32x4 o; o.x = pk2(e0, e1); o.y = pk2(e2, e3); o.z = pk2(e4, e5); o.w = pk2(e6, e7);
            *(u32x4*)((bf16_t*)WTv + (size_t)(drow0 + n) * K + k0 + 8 * c) = o; } }
    LDS_WAIT(); asm volatile("" ::: "memory");
}
__device__ __forceinline__ void cast_row2_bf16_rstd(const float* xa, const float* xb, bf16_t* oa, bf16_t* ob, float* ra_out, float* rb_out, int lane) {
    const f32x4* ra = (const f32x4*)xa + lane; const f32x4* rb = (const f32x4*)xb + lane;
    f32x4 va[4], vb[4]; float sa = 0.f, sb = 0.f;
#pragma unroll
    for (int j = 0; j < 4; ++j) { va[j] = ra[64 * j]; vb[j] = rb[64 * j]; }
#pragma unroll
    for (int j = 0; j < 4; ++j) { sa += (va[j].x * va[j].x + va[j].y * va[j].y) + (va[j].z * va[j].z + va[j].w * va[j].w); sb += (vb[j].x * vb[j].x + vb[j].y * vb[j].y) + (vb[j].z * vb[j].z + vb[j].w * vb[j].w); }
    unsigned long long* pa = (unsigned long long*)oa + lane; unsigned long long* pb = (unsigned long long*)ob + lane;
#pragma unroll
    for (int j = 0; j < 4; ++j) {
        pa[64 * j] = (unsigned long long)pk2(va[j].x, va[j].y) | ((unsigned long long)pk2(va[j].z, va[j].w) << 32);
        pb[64 * j] = (unsigned long long)pk2(vb[j].x, vb[j].y) | ((unsigned long long)pk2(vb[j].z, vb[j].w) << 32); }
    const float rsa = rsqrtf(wave_sum(sa) * (1.f / DM) + EPS), rsb = rsqrtf(wave_sum(sb) * (1.f / DM) + EPS);
    if (lane == 0) { *ra_out = rsa; *rb_out = rsb; }
}
__device__ __forceinline__ void p0_kvm_tile(Frame& F, int tile, const float* mem, const float* mem_g, const float* w_memkv) {
    const int mt = tile >> 3, ntile = tile & 7, row0 = 64 * mt, col0 = 64 * ntile;
    const int mb = F.wave >> 1, nb0 = (F.wave & 1) * 2, ar = F.lane & 15, kq = F.lane >> 4;
    const float* arow = mem + (size_t)(row0 + mb * 16 + ar) * DM;
    f32x4 acc[2]; acc[0] = (f32x4){0.f, 0.f, 0.f, 0.f}; acc[1] = acc[0];
    float ss = 0.f;
    const float* wq = w_memkv + col0 + nb0 * 16 + ar;
#define KVM_LOAD(A0, A1, G0, G1, BV, k0_) do { const int kk_ = (k0_) + 8 * kq; A0 = *(const f32x4*)(arow + kk_); A1 = *(const f32x4*)(arow + kk_ + 4); G0 = *(const f32x4*)(mem_g + kk_); G1 = *(const f32x4*)(mem_g + kk_ + 4); \
        _Pragma("unroll") for (int nbi = 0; nbi < 2; ++nbi) _Pragma("unroll") for (int j = 0; j < 8; ++j) BV[nbi][j] = wq[(size_t)(kk_ + j) * 512 + nbi * 16]; } while (0)
#define KVM_MATH(A0, A1, G0, G1, BV) do { ss += (A0.x * A0.x + A0.y * A0.y) + (A0.z * A0.z + A0.w * A0.w) + (A1.x * A1.x + A1.y * A1.y) + (A1.z * A1.z + A1.w * A1.w); \
        const bf16x8 af = pack8(A0 * G0, A1 * G1); \
        _Pragma("unroll") for (int nbi = 0; nbi < 2; ++nbi) { const f32x4 b0 = {BV[nbi][0], BV[nbi][1], BV[nbi][2], BV[nbi][3]}, b1 = {BV[nbi][4], BV[nbi][5], BV[nbi][6], BV[nbi][7]}; \
            acc[nbi] = __builtin_amdgcn_mfma_f32_16x16x32_bf16(af, pack8(b0, b1), acc[nbi], 0, 0, 0); } } while (0)
    f32x4 ba0[4], ba1[4], bg0[4], bg1[4]; float bb[4][2][8];
#pragma unroll 1
    for (int k0 = 0; k0 < DM; k0 += 128) {
#pragma unroll
        for (int q = 0; q < 4; ++q) KVM_LOAD(ba0[q], ba1[q], bg0[q], bg1[q], bb[q], k0 + 32 * q);
#pragma unroll
        for (int q = 0; q < 4; ++q) KVM_MATH(ba0[q], ba1[q], bg0[q], bg1[q], bb[q]);
    }
#undef KVM_LOAD
#undef KVM_MATH
    ss += __shfl_xor(ss, 16); ss += __shfl_xor(ss, 32);
    const float rstd = rsqrtf(ss * (1.f / DM) + EPS);
    float rs[4];
#pragma unroll
    for (int j = 0; j < 4; ++j) rs[j] = __shfl(rstd, kq * 4 + j);
    bf16_t* kmb = (bf16_t*)(F.ws + WS_KMB); bf16_t* vmt = (bf16_t*)(F.ws + WS_VMT);
#pragma unroll
    for (int nbi = 0; nbi < 2; ++nbi) {
        const int gc = col0 + (nb0 + nbi) * 16 + ar, gr0 = row0 + mb * 16 + kq * 4;
        if (ntile < 4) {
#pragma unroll
            for (int j = 0; j < 4; ++j) kmb[(size_t)(gr0 + j) * 256 + gc] = (bf16_t)(pk2(acc[nbi][j] * rs[j], 0.f) & 0xffffu);
        } else {
            const int d = gc - 256, hm = d >> 6, dd = d & 63, b = gr0 >> 8, m = gr0 & 255;
            u32x2 w; w.x = pk2(acc[nbi][0] * rs[0], acc[nbi][1] * rs[1]); w.y = pk2(acc[nbi][2] * rs[2], acc[nbi][3] * rs[3]);
            *(u32x2*)(vmt + ((size_t)((b * 4 + hm) * 64 + dd)) * 256 + m) = w;
        }
    }
}
struct P0Tile { const float* src; unsigned char* dst; int gain; };
template <int N, int K>
__device__ __forceinline__ void p0_tile_load(const float* src, f32x4 (&v)[8], int tid) {
#pragma unroll
    for (int i = 0; i < 8; ++i) v[i] = *(const f32x4*)(src + (size_t)((tid >> 5) + 16 * i) * N + (tid & 31) * 4);
}
__device__ __forceinline__ void p0_tile_to_lds(LAS float* tl, const f32x4 (&v)[8], int tid) {
#pragma unroll
    for (int i = 0; i < 8; ++i) { const int k = (tid >> 5) + 16 * i, c = ((tid & 31) * 4) ^ (((k >> 4) & 7) << 2); *(LAS f32x4*)(tl + k * 132 + c) = v[i]; }
}
template <int K, bool GAIN>
__device__ __forceinline__ void p0_tile_store(const LAS float* tl, unsigned char* dst, const float* kgain, float scale, int tid) {
    const int run = tid & 7;
    f32x4 g[4];
#pragma unroll
    for (int q = 0; q < 4; ++q) { g[q] = (f32x4){scale, scale, scale, scale}; if constexpr (GAIN) g[q] = *(const f32x4*)(kgain + run * 16 + 4 * q) * scale; }
#pragma unroll
    for (int p = 0; p < 2; ++p) { const int n = (tid >> 3) + 64 * p; const LAS float* s = tl + (run * 16) * 132 + (n ^ (run << 2));
        u32x4 o;
#pragma unroll
        for (int q = 0; q < 4; ++q) o[q] = pg8::pk4_fp8(s[(4 * q) * 132] * g[q][0], s[(4 * q + 1) * 132] * g[q][1], s[(4 * q + 2) * 132] * g[q][2], s[(4 * q + 3) * 132] * g[q][3]);
        *(u32x4*)(dst + (size_t)n * K + run * 16) = o; }
}
__device__ __forceinline__ void p0_prologue(Frame& F) {
    KArgs A = kargs();
    { const float* mem = A->in[I_MEM]; const float* mem_g = A->in[I_MEMG]; const float* w_memkv = A->in[I_WMEMKV];
      for (int rep2_ = 0; rep2_ < ((PROBE_P0 & 4) ? 2 : 1); ++rep2_)
      for (int tile = blockIdx.x; tile < 256; tile += F.G) p0_kvm_tile(F, tile, mem, mem_g, w_memkv); }
    const float* attn_g = A->in[I_ATTNG];
    const float* w_in = A->in[I_WIN]; const float* w_out = A->in[I_WOUT]; const float* w_gu = A->in[I_WGU]; const float* w_dn = A->in[I_WDN]; const float* ffn_g = A->in[I_FFNG];
    LAS float* scr = (LAS float*)(F.lds + F.wave * 16384);
    const int gw = F.vcu * NWAVES + F.wave, NGW = F.G * NWAVES;
    bf16_t* Win_t = (bf16_t*)(F.ws + WS_WIN); bf16_t* Wout_t = (bf16_t*)(F.ws + WS_WOUT);
    unsigned char* Wgu_q = F.ws + WS_WGU; unsigned char* Wd_q = F.ws + WS_WD;
    constexpr int I_IN = 16 * 80, I_OUT = 16 * 32, NITEMS = I_IN + I_OUT;
    for (int rep0_ = 0; rep0_ < ((PROBE_P0 & 1) ? 2 : 1); ++rep0_)
    for (int it = gw; it < NITEMS; it += NGW) {
        int r = it;
        if (r < I_IN) { const int kb = r / 80, nb = r % 80; p0_transpose_item<true, false>(w_in, DM, INW, Win_t, 64 * kb, 32 * nb, 32 * nb, attn_g, 1.f, scr, F.lane); continue; } r -= I_IN;
        if (r < I_OUT) { const int kb = r / 32, nb = r % 32; p0_transpose_item<false, false>(w_out, DM, DM, Wout_t, 64 * kb, 32 * nb, 32 * nb, nullptr, 1.f, scr, F.lane); continue; } r -= I_OUT;
    }
    { __syncthreads();
      LAS float* tl = (LAS float*)F.lds; const int tid = F.tid;
      constexpr int T_GU = NEXP * 8 * 16, T_DN = NEXP * 8 * 8, T_ALL = T_GU + T_DN;
#define P0_TILE(ti, SRC, DST, ISGU) do { int r_ = (ti); ISGU = r_ < T_GU; if (ISGU) { const int e = r_ >> 7, q = r_ & 127, kt = q >> 4, nt = q & 15, n0 = nt * 128, jj = n0 & 1023; \
            SRC = w_gu + (size_t)e * DM * 2048 + (size_t)(kt * 128) * 2048 + n0; DST = Wgu_q + (size_t)e * 2048 * DM + (size_t)((jj >> 7) * 256 + (n0 >= 1024 ? 128 : 0)) * DM + kt * 128; } \
          else { r_ -= T_GU; const int e = r_ >> 6, q = r_ & 63, kt = q >> 3, nt = q & 7; \
            SRC = w_dn + (size_t)e * DEXP * DM + (size_t)(kt * 128) * DM + nt * 128; DST = Wd_q + (size_t)e * DM * DEXP + (size_t)(nt * 128) * DEXP + kt * 128; } } while (0)
      f32x4 v[8]; const float* src; unsigned char* dst; bool isgu; const float* srcn; unsigned char* dstn; bool isgun;
      int ti = blockIdx.x;
      if (ti < T_ALL) { P0_TILE(ti, src, dst, isgu); if (isgu) p0_tile_load<2048, DM>(src, v, tid); else p0_tile_load<DM, DEXP>(src, v, tid); }
      for (; ti < T_ALL; ti += F.G) {
          p0_tile_to_lds(tl, v, tid);
          __syncthreads();
          const int tn = ti + F.G;
          if (tn < T_ALL) { P0_TILE(tn, srcn, dstn, isgun); if (isgun) p0_tile_load<2048, DM>(srcn, v, tid); else p0_tile_load<DM, DEXP>(srcn, v, tid); }
          if (isgu) { const int kt_ = (int)(((size_t)(dst - Wgu_q)) & (DM - 1)); p0_tile_store<DM, true>(tl, dst, ffn_g + kt_, 64.f, tid); }
          else p0_tile_store<DEXP, false>(tl, dst, nullptr, 64.f, tid);
          __syncthreads();
          src = srcn; dst = dstn; isgu = isgun;
      }
#undef P0_TILE
    }
    bf16_t* H = (bf16_t*)(F.ws + WS_H);
    { const float* x = A->in[I_X]; float* rstd_x = (float*)(F.ws + WS_RSTDX);
      for (int rep1_ = 0; rep1_ < ((PROBE_P0 & 2) ? 2 : 1); ++rep1_)
      for (int m = gw; m < T; m += 2 * NGW) { const int m2 = (m + NGW < T) ? m + NGW : m;
          cast_row2_bf16_rstd(x + (size_t)m * DM, x + (size_t)m2 * DM, H + (size_t)m * DM, H + (size_t)m2 * DM, rstd_x + m, rstd_x + m2, F.lane); } }
    const float* router_w = A->in[I_RW];
    bf16_t* wrh = (bf16_t*)(F.ws + WS_WRHI); bf16_t* wrl = (bf16_t*)(F.ws + WS_WRLO);
    for (int i = (F.vcu * NWAVES + F.wave) * 64 + F.lane; i < NEXP * DM; i += NGW * 64) { const int e = i >> 10, k = i & 1023;
        const float v = ffn_g[k] * router_w[(size_t)k * NEXP + e]; const unsigned hb = pk2(v, 0.f) & 0xffffu; const float hf = __uint_as_float(hb << 16);
        wrh[i] = (bf16_t)hb; wrl[i] = (bf16_t)(pk2(v - hf, 0.f) & 0xffffu); }
}

__device__ __forceinline__ void p2_conv_block(Frame& F, int blk, int tid_, const float* conv_w) {
    const bf16_t* proj = (const bf16_t*)(F.ws + WS_PROJ); bf16_t* mix = (bf16_t*)(F.ws + WS_MIX);
    const int cg = tid_ & 31, tc = tid_ >> 5;
    const int c0 = cg * 8, t0 = blk * 256 + tc * 16, s0 = t0 & (SEQ - 1);
    float w0[8], w1[8], w2[8];
#pragma unroll
    for (int i = 0; i < 8; ++i) { w0[i] = conv_w[c0 + i]; w1[i] = conv_w[256 + c0 + i]; w2[i] = conv_w[512 + c0 + i]; }
    float p2[8], p1[8];
#pragma unroll
    for (int i = 0; i < 8; ++i) { p2[i] = 0.f; p1[i] = 0.f; }
    if (s0 >= 2) {
        const u32x4 ua = *(const u32x4*)(proj + (size_t)(t0 - 2) * INW + COL_U + c0), ca = *(const u32x4*)(proj + (size_t)(t0 - 2) * INW + COL_GC + c0);
        const u32x4 ub = *(const u32x4*)(proj + (size_t)(t0 - 1) * INW + COL_U + c0), cb = *(const u32x4*)(proj + (size_t)(t0 - 1) * INW + COL_GC + c0);
#pragma unroll
        for (int i = 0; i < 4; ++i) { p2[2 * i] = bflo(ua[i]) * bflo(ca[i]); p2[2 * i + 1] = bfhi(ua[i]) * bfhi(ca[i]); p1[2 * i] = bflo(ub[i]) * bflo(cb[i]); p1[2 * i + 1] = bfhi(ub[i]) * bfhi(cb[i]); }
    }
    for (int tb = 0; tb < 16; tb += 4) {
        u32x4 uu[4], cc[4], bb[4];
#pragma unroll
        for (int q = 0; q < 4; ++q) { const size_t ro = (size_t)(t0 + tb + q) * INW;
            uu[q] = *(const u32x4*)(proj + ro + COL_U + c0); cc[q] = *(const u32x4*)(proj + ro + COL_GC + c0); bb[q] = *(const u32x4*)(proj + ro + COL_GB + c0); }
#pragma unroll
        for (int q = 0; q < 4; ++q) {
            float cur[8], y[8];
#pragma unroll
            for (int i = 0; i < 4; ++i) { cur[2 * i] = bflo(uu[q][i]) * bflo(cc[q][i]); cur[2 * i + 1] = bfhi(uu[q][i]) * bfhi(cc[q][i]); }
#pragma unroll
            for (int i = 0; i < 4; ++i) { y[2 * i] = bflo(bb[q][i]) * (w0[2 * i] * p2[2 * i] + w1[2 * i] * p1[2 * i] + w2[2 * i] * cur[2 * i]);
                                           y[2 * i + 1] = bfhi(bb[q][i]) * (w0[2 * i + 1] * p2[2 * i + 1] + w1[2 * i + 1] * p1[2 * i + 1] + w2[2 * i + 1] * cur[2 * i + 1]); }
            u32x4 o; o.x = pk2(y[0], y[1]); o.y = pk2(y[2], y[3]); o.z = pk2(y[4], y[5]); o.w = pk2(y[6], y[7]);
            *(u32x4*)(mix + (size_t)(t0 + tb + q) * DM + c0) = o;
#pragma unroll
            for (int i = 0; i < 8; ++i) { p2[i] = p1[i]; p1[i] = cur[i]; }
        }
    }
}
__device__ __forceinline__ void p2_mem_block(Frame& F, int blk, int lane_) {
    const bf16_t* proj = (const bf16_t*)(F.ws + WS_PROJ); bf16_t* mix = (bf16_t*)(F.ws + WS_MIX);
    const bf16_t* kmb = (const bf16_t*)(F.ws + WS_KMB); const bf16_t* vmt = (const bf16_t*)(F.ws + WS_VMT);
    const int r32 = lane_ & 31, hi = lane_ >> 5, b = blk >> 5, tw = blk * 256 + F.wave * 32, tid_ = F.wave * 64 + lane_;
    LAS unsigned char* Kl = F.lds; LAS unsigned char* Vl = F.lds + 32768;
    const int ksw = (r32 >> 1) & 7;
    u32x4 kv[4], vv[4];
#define MEM_LOAD(hm_) do { _Pragma("unroll") for (int i = 0; i < 4; ++i) { const int idx = tid_ + 512 * i; \
        kv[i] = *(const u32x4*)(kmb + (size_t)(b * 256 + (idx >> 3)) * 256 + (hm_) * 64 + (idx & 7) * 8); \
        vv[i] = *(const u32x4*)(vmt + ((size_t)((b * 4 + (hm_)) * 64 + (idx >> 5))) * 256 + (idx & 31) * 8); } } while (0)
    MEM_LOAD(0);
    for (int hm = 0; hm < 4; ++hm) {
        bf16x8 qr[4];
#pragma unroll
        for (int d0 = 0; d0 < 4; ++d0) qr[d0] = *(const bf16x8*)(proj + (size_t)(tw + r32) * INW + COL_QM + hm * 64 + d0 * 16 + hi * 8);
        __syncthreads();
#pragma unroll
        for (int i = 0; i < 4; ++i) { const int idx = tid_ + 512 * i; const int kr = idx >> 3, kc = idx & 7, vd = idx >> 5, vc = idx & 31;
            *(LAS u32x4*)(Kl + kr * 128 + ((kc ^ ((kr >> 1) & 7)) << 4)) = kv[i];
            *(LAS u32x4*)(Vl + vd * 512 + ((vc ^ (vd & 31)) << 4)) = vv[i]; }
        __syncthreads();
        if (hm < 3) MEM_LOAD(hm + 1);
        float mx = -__builtin_inff();
#pragma unroll 2
        for (int kb = 0; kb < 8; ++kb) { f32x16 p = f32x16{};
#pragma unroll
            for (int d0 = 0; d0 < 4; ++d0) { const bf16x8 kf = *(const LAS bf16x8*)(Kl + (kb * 32 + r32) * 128 + (((2 * d0 + hi) ^ ksw) << 4));
                p = __builtin_amdgcn_mfma_f32_32x32x16_bf16(kf, qr[d0], p, 0, 0, 0); }
#pragma unroll
            for (int r = 0; r < 16; ++r) mx = fmaxf(mx, p[r]); }
        mx = fmaxf(mx, __shfl_xor(mx, 32));
        float sum = 0.f;
        f32x16 o[2]; o[0] = f32x16{}; o[1] = f32x16{};
#pragma unroll 2
        for (int kb = 0; kb < 8; ++kb) { f32x16 p = f32x16{};
#pragma unroll
            for (int d0 = 0; d0 < 4; ++d0) { const bf16x8 kf = *(const LAS bf16x8*)(Kl + (kb * 32 + r32) * 128 + (((2 * d0 + hi) ^ ksw) << 4));
                p = __builtin_amdgcn_mfma_f32_32x32x16_bf16(kf, qr[d0], p, 0, 0, 0); }
#pragma unroll
            for (int r = 0; r < 16; ++r) { p[r] = __builtin_amdgcn_exp2f(p[r] - mx); sum += p[r]; }
            bf16x8 pa0, pa1;
#define PK4(P, B_, OUT) do { unsigned a0 = pk2(P[B_+0], P[B_+1]), a1 = pk2(P[B_+2], P[B_+3]); unsigned b0 = pk2(P[B_+4], P[B_+5]), b1 = pk2(P[B_+6], P[B_+7]); \
        auto r0 = __builtin_amdgcn_permlane32_swap(a0, b0, false, false); auto r1 = __builtin_amdgcn_permlane32_swap(a1, b1, false, false); \
        u32x4 w = {r0[0], r1[0], r0[1], r1[1]}; OUT = __builtin_bit_cast(bf16x8, w); } while (0)
            PK4(p, 0, pa0); PK4(p, 8, pa1);
#undef PK4
#pragma unroll
            for (int d0 = 0; d0 < 2; ++d0) { const LAS unsigned char* vrow = Vl + (d0 * 32 + r32) * 512;
                const bf16x8 v0 = *(const LAS bf16x8*)(vrow + (((kb * 4 + hi) ^ r32) << 4)), v1 = *(const LAS bf16x8*)(vrow + (((kb * 4 + 2 + hi) ^ r32) << 4));
                o[d0] = __builtin_amdgcn_mfma_f32_32x32x16_bf16(pa0, v0, o[d0], 0, 0, 0);
                o[d0] = __builtin_amdgcn_mfma_f32_32x32x16_bf16(pa1, v1, o[d0], 0, 0, 0); }
        }
        sum += __shfl_xor(sum, 32);
        const float linv = __builtin_amdgcn_rcpf(sum);
#pragma unroll
        for (int r = 0; r < 16; ++r) { const int orow = crow(r, hi); const float li = __shfl(linv, orow);
#pragma unroll
            for (int d0 = 0; d0 < 2; ++d0) { const float v = o[d0][r] * li; const float vn = __shfl_xor(v, 1);
                if ((r32 & 1) == 0) *(unsigned*)(mix + (size_t)(tw + orow) * DM + 768 + hm * 64 + d0 * 32 + r32) = pk2(v, vn); } }
    }
#undef MEM_LOAD
    __syncthreads();
}
__device__ __forceinline__ dattn::Ref da_ref(Frame& F, int n) {
    const int pid = F.vcu + (n >> 2) * F.G, sub = n & 3, blk = sub >> 1, comp = sub & 1, bh = pid >> 4, s = pid & 15, qb = blk ? 31 - s : s, b = bh >> 2, h = bh & 3;
    bf16_t* mix = (bf16_t*)(F.ws + WS_MIX);
    dattn::Ref r;
    r.qoff = (unsigned)(((size_t)(b * SEQ + qb * 256) * INW + COL_Q + h * 128 + comp * 64) * 2);
    r.koff = (unsigned)(((size_t)(b * SEQ) * INW + COL_K + h * 128 + comp * 64) * 2);
    r.voff = (unsigned)(((size_t)(b * SEQ) * INW + COL_V + h * 128) * 2);
    r.O = mix + (size_t)(b * SEQ + qb * 256) * DM + 256 + h * 128;
    r.P0 = qb * 256; r.comp = comp; r.h = h;
    return r;
}
__device__ __forceinline__ void p2_mixers(Frame& F) {
    KArgs A = kargs();
    const float* rel_bias = A->in[I_RELB]; const float* lam_qk = A->in[I_LAMQK]; const float* subln_g = A->in[I_SUBG];
    if (F.tid < 512) { const int h = F.tid >> 7, n = F.tid & 127; int bk;
        if (n < 16) bk = n; else { bk = 16; const int thr[15] = {19, 21, 24, 27, 31, 35, 40, 46, 52, 59, 67, 77, 87, 99, 113};
#pragma unroll
            for (int i = 0; i < 15; ++i) bk += (n >= thr[i]) ? 1 : 0; }
        ((LAS float*)(F.lds + dattn::OFF_TB))[h * 128 + n] = (rel_bias[bk * 4 + h] - rel_bias[31 * 4 + h]) * LOG2E; }
    float d1 = 0.f, d2 = 0.f;
    for (int i = 0; i < 64; ++i) { d1 += lam_qk[i] * lam_qk[64 + i]; d2 += lam_qk[128 + i] * lam_qk[192 + i]; }
    const float lam = __expf(d1) - __expf(d2) + 0.2f;
    if (__builtin_amdgcn_readfirstlane(F.tid) >= 256) __builtin_amdgcn_s_setprio(1);
    __syncthreads();
    const int npairs = F.vcu < 512 ? (512 - F.vcu + F.G - 1) / F.G : 0, total1 = 4 * npairs, total = ((PROBE_REP >> 2) & 1) ? 2 * total1 : total1;
#if PROBE_CLK
    const unsigned long long pc0_ = __builtin_readcyclecounter(), pr0_ = __builtin_amdgcn_s_memrealtime();
#endif
    if (total > 0) {
        dattn::Seam S; dattn::Ref cur = da_ref(F, 0);
#if PROBE_SEG
        S.acc = 0; S.tot = 0;
#endif
        const dattn::rsrc_t R = __builtin_amdgcn_make_buffer_rsrc((void*)(F.ws + WS_PROJ), 0, (int)((size_t)T * INW * 2), 0x00020000);
        const char* projb = (const char*)(F.ws + WS_PROJ);
        dattn::prime(cur, F.lds, S, R, projb);
        for (int n = 0; n < total; ++n) {
            const dattn::Ref nxt = (n + 1 < total) ? da_ref(F, (n + 1) % total1) : cur;
            dattn::block(cur, nxt, F.lds, S, lam, subln_g, R, projb);
            cur = nxt;
        }
#if PROBE_SEG
        if (blockIdx.x == 0 && F.tid == 0) { F.ctl[604] = (unsigned)(S.acc >> 4); F.ctl[605] = (unsigned)(S.tot >> 4); }
#endif
    }
#if PROBE_CLK
    if (blockIdx.x == 0 && F.tid == 0) { const unsigned long long dc_ = __builtin_readcyclecounter() - pc0_, dr_ = __builtin_amdgcn_s_memrealtime() - pr0_;
        F.ctl[600] = (unsigned)dc_; F.ctl[601] = (unsigned)(dc_ >> 32); F.ctl[602] = (unsigned)dr_; }
#endif
    __builtin_amdgcn_s_setprio(0);
    int lane2 = (int)__builtin_amdgcn_mbcnt_hi(~0u, __builtin_amdgcn_mbcnt_lo(~0u, 0u)); asm volatile("" : "+v"(lane2));
    const int tid2 = F.wave * 64 + lane2;
    const float* conv_w = kargs()->in[I_CONVW];
    for (int repx_ = 0; repx_ < ((PROBE_X & 1) ? 2 : 1); ++repx_)
    for (int blk = blockIdx.x; blk < T / 256; blk += F.G) { p2_conv_block(F, blk, tid2, conv_w); p2_mem_block(F, blk, lane2); }
}

__device__ __forceinline__ void p4_router(Frame& F, bool dry = false) {
    const float* router_b = kargs()->in[I_RB];
    const bf16_t* x1b = (const bf16_t*)(F.ws + WS_X1B); const bf16_t* wrh = (const bf16_t*)(F.ws + WS_WRHI); const bf16_t* wrl = (const bf16_t*)(F.ws + WS_WRLO);
    int* e_tk = (int*)(F.ws + WS_ETK); float* g_tk = (float*)(F.ws + WS_GTK); float* rstd_t = (float*)(F.ws + WS_RSTDT);
    LAS float* lg = (LAS float*)F.lds + F.wave * (32 * 33); LAS unsigned* hist = (LAS unsigned*)(F.lds + 8 * 32 * 33 * 4);
    const int r32 = F.lane & 31, hi = F.lane >> 5;
    for (int blk = blockIdx.x; blk < T / 256; blk += F.G) {
        if (F.tid < 32) hist[F.tid] = 0u;
        __syncthreads();
        const int t0 = blk * 256 + F.wave * 32;
        const bf16_t* xr = x1b + (size_t)(t0 + r32) * DM + hi * 8; const bf16_t* wh = wrh + (size_t)r32 * DM + hi * 8; const bf16_t* wl = wrl + (size_t)r32 * DM + hi * 8;
        f32x16 acc = f32x16{}; float ss = 0.f;
#pragma unroll 1
        for (int kq = 0; kq < DM; kq += 256) {
            u32x4 xw[16];
#pragma unroll
            for (int s_ = 0; s_ < 16; ++s_) xw[s_] = *(const u32x4*)(xr + kq + s_ * 16);
            SBAR();
#pragma unroll
            for (int sb = 0; sb < 16; sb += 4) { bf16x8 ah[4], al[4];
#pragma unroll
                for (int s_ = 0; s_ < 4; ++s_) { ah[s_] = *(const bf16x8*)(wh + kq + (sb + s_) * 16); al[s_] = *(const bf16x8*)(wl + kq + (sb + s_) * 16); }
#pragma unroll
                for (int s_ = 0; s_ < 4; ++s_) { const u32x4 xv = xw[sb + s_];
#pragma unroll
                    for (int i = 0; i < 4; ++i) { const float a = bflo(xv[i]), b2 = bfhi(xv[i]); ss += a * a + b2 * b2; }
                    const bf16x8 xb = __builtin_bit_cast(bf16x8, xv);
                    acc = __builtin_amdgcn_mfma_f32_32x32x16_bf16(ah[s_], xb, acc, 0, 0, 0);
                    acc = __builtin_amdgcn_mfma_f32_32x32x16_bf16(al[s_], xb, acc, 0, 0, 0); } }
        }
        ss += __shfl_xor(ss, 32);
        const float rstd = rsqrtf(ss * (1.f / DM) + EPS);
#pragma unroll
        for (int r = 0; r < 16; ++r) { const int e = crow(r, hi); lg[r32 * 33 + e] = acc[r] * rstd + router_b[e]; }
        LDS_WAIT(); asm volatile("" ::: "memory");
        if (F.lane < 32) {
            LAS float* row = lg + F.lane * 33; float tv[4]; int ti[4];
#pragma unroll
            for (int p = 0; p < 4; ++p) { float best = -__builtin_inff(); int bi = 0;
                for (int e = 0; e < NEXP; ++e) { const float v = row[e]; if (v > best) { best = v; bi = e; } }
                tv[p] = best; ti[p] = bi; row[bi] = -__builtin_inff(); LDS_WAIT(); asm volatile("" ::: "memory"); }
            const float w1 = __expf(tv[1] - tv[0]), w2 = __expf(tv[2] - tv[0]), w3 = __expf(tv[3] - tv[0]); const float inv = 1.f / (1.f + w1 + w2 + w3);
            const int t = t0 + F.lane;
            if (!dry) {
            *(int4*)(e_tk + (size_t)t * 4) = make_int4(ti[0], ti[1], ti[2], ti[3]);
            *(float4*)(g_tk + (size_t)t * 4) = make_float4(inv, w1 * inv, w2 * inv, w3 * inv);
            rstd_t[t] = rstd;
#pragma unroll
            for (int p = 0; p < 4; ++p) __hip_atomic_fetch_add(&hist[ti[p]], 1u, __ATOMIC_RELAXED, __HIP_MEMORY_SCOPE_WORKGROUP);
            }
        }
        __syncthreads();
        if (F.tid < 32) __hip_atomic_fetch_add(F.ctl + CW_COUNT + F.tid, hist[F.tid], RLX_AGENT);
        __syncthreads();
    }
}
__device__ __forceinline__ void p5_place(Frame& F) {
    const int* e_tk = (const int*)(F.ws + WS_ETK); const float* g_tk = (const float*)(F.ws + WS_GTK); const float* rstd_t = (const float*)(F.ws + WS_RSTDT);
    int* slot_tk = (int*)(F.ws + WS_SLOTTK); int* tok_slot = (int*)(F.ws + WS_TOKSLOT); float* gate_slot = (float*)(F.ws + WS_GATESLOT); float* rstd_slot = (float*)(F.ws + WS_RSTDSLOT);
    int* rb_e = (int*)(F.ws + WS_RBE);
    LAS int* L = (LAS int*)F.lds;
    if (F.tid < 32) { const int c = (int)__hip_atomic_load(F.ctl + CW_COUNT + F.tid, RLX_AGENT); L[F.tid] = c; L[32 + F.tid] = (c + 255) & ~255; }
    __syncthreads();
    if (F.tid < 32) { int s = 0; for (int e = 0; e < F.tid; ++e) s += L[32 + e]; L[64 + F.tid] = s; }
    __syncthreads();
    for (int blk = blockIdx.x; blk < T / 256; blk += F.G) {
        if (F.tid < 32) { L[96 + F.tid] = 0; L[128 + F.tid] = 0; }
        __syncthreads();
        int ee[2];
#pragma unroll
        for (int j = 0; j < 2; ++j) { const int i = F.tid + 512 * j; ee[j] = e_tk[(size_t)blk * 1024 + i]; __hip_atomic_fetch_add(&L[96 + ee[j]], 1, __ATOMIC_RELAXED, __HIP_MEMORY_SCOPE_WORKGROUP); }
        __syncthreads();
        if (F.tid < 32) L[160 + F.tid] = L[64 + F.tid] + (int)__hip_atomic_fetch_add(F.ctl + CW_CURSOR + F.tid, (unsigned)L[96 + F.tid], RLX_AGENT);
        __syncthreads();
#pragma unroll
        for (int j = 0; j < 2; ++j) { const int i = F.tid + 512 * j; const int r = __hip_atomic_fetch_add(&L[128 + ee[j]], 1, __ATOMIC_RELAXED, __HIP_MEMORY_SCOPE_WORKGROUP); const int pos = L[160 + ee[j]] + r;
            const int t = blk * 256 + (i >> 2);
            tok_slot[pos] = t; gate_slot[pos] = g_tk[(size_t)blk * 1024 + i]; rstd_slot[pos] = rstd_t[t]; slot_tk[(size_t)blk * 1024 + i] = pos; }
        __syncthreads();
    }
    for (int e = blockIdx.x; e < NEXP; e += F.G)
        for (int i = L[e] + F.tid; i < L[32 + e]; i += NWAVES * 64) { const int pos = L[64 + e] + i; tok_slot[pos] = 0; gate_slot[pos] = 0.f; rstd_slot[pos] = 0.f; }
    if (blockIdx.x == 0) {
        const int nrb = (L[64 + 31] + L[32 + 31]) >> 8;
        for (int rb = F.tid; rb < NRB_MAX; rb += NWAVES * 64) { int e = 31; for (int q = 0; q < 32; ++q) { if (rb * 256 >= L[64 + q] && rb * 256 < L[64 + q] + L[32 + q]) e = q; } rb_e[rb] = e; }
        if (F.tid == 0) rb_e[NRB_MAX] = nrb;
    }
}
__device__ __forceinline__ void p9_final(Frame& F) {
    const bf16_t* x1b = (const bf16_t*)(F.ws + WS_X1B); const int* slot_tk = (const int*)(F.ws + WS_SLOTTK);
    const unsigned char* Y = F.ws + WS_Y;
    const int gw = F.vcu * NWAVES + F.wave, NGW = F.G * NWAVES;
    const float* final_g = kargs()->in[I_FING];
    f32x4 gg[2][2];
#pragma unroll
    for (int j = 0; j < 2; ++j) { gg[j][0] = *(const f32x4*)(final_g + 8 * F.lane + 512 * j); gg[j][1] = *(const f32x4*)(final_g + 8 * F.lane + 512 * j + 4); }
    int4 slA = make_int4(0, 0, 0, 0), slB = slA;
    if (gw < T) { slA = *(const int4*)(slot_tk + (size_t)gw * 4); const int tb0 = (gw + NGW < T) ? gw + NGW : gw; slB = *(const int4*)(slot_tk + (size_t)tb0 * 4); }
    for (int t = gw; t < T; t += 2 * NGW) {
        const int tA = t, tB = (t + NGW < T) ? t + NGW : t;
        const int tnA = (t + 2 * NGW < T) ? t + 2 * NGW : tA, tnB = (t + 3 * NGW < T) ? t + 3 * NGW : tnA;
        const int4 nA = *(const int4*)(slot_tk + (size_t)tnA * 4), nB = *(const int4*)(slot_tk + (size_t)tnB * 4);
        const int sA[4] = {slA.x, slA.y, slA.z, slA.w}, sB[4] = {slB.x, slB.y, slB.z, slB.w};
        u32x4 xa[2], xb[2]; u32x2 ya[2][4], yb[2][4];
#pragma unroll
        for (int j = 0; j < 2; ++j) { const int c = 8 * F.lane + 512 * j;
            xa[j] = *(const u32x4*)(x1b + (size_t)tA * DM + c); xb[j] = *(const u32x4*)(x1b + (size_t)tB * DM + c);
#pragma unroll
            for (int k = 0; k < 4; ++k) { ya[j][k] = *(const u32x2*)(Y + (size_t)sA[k] * DM + c); yb[j][k] = *(const u32x2*)(Y + (size_t)sB[k] * DM + c); } }
        float va[2][8], vb[2][8]; float ssa = 0.f, ssb = 0.f;
#pragma unroll
        for (int j = 0; j < 2; ++j) {
#pragma unroll
            for (int i = 0; i < 4; ++i) { va[j][2 * i] = bflo(xa[j][i]); va[j][2 * i + 1] = bfhi(xa[j][i]); vb[j][2 * i] = bflo(xb[j][i]); vb[j][2 * i + 1] = bfhi(xb[j][i]); }
#pragma unroll
            for (int k = 0; k < 4; ++k)
#pragma unroll
                for (int w_ = 0; w_ < 2; ++w_) { const f32x2_t a0 = __builtin_amdgcn_cvt_pk_f32_fp8((int)ya[j][k][w_], false), a1 = __builtin_amdgcn_cvt_pk_f32_fp8((int)ya[j][k][w_], true);
                    const f32x2_t b0 = __builtin_amdgcn_cvt_pk_f32_fp8((int)yb[j][k][w_], false), b1 = __builtin_amdgcn_cvt_pk_f32_fp8((int)yb[j][k][w_], true);
                    va[j][4 * w_] += 0.125f * a0[0]; va[j][4 * w_ + 1] += 0.125f * a0[1]; va[j][4 * w_ + 2] += 0.125f * a1[0]; va[j][4 * w_ + 3] += 0.125f * a1[1];
                    vb[j][4 * w_] += 0.125f * b0[0]; vb[j][4 * w_ + 1] += 0.125f * b0[1]; vb[j][4 * w_ + 2] += 0.125f * b1[0]; vb[j][4 * w_ + 3] += 0.125f * b1[1]; }
#pragma unroll
            for (int i = 0; i < 8; ++i) { ssa += va[j][i] * va[j][i]; ssb += vb[j][i] * vb[j][i]; } }
        const float ra = rsqrtf(wave_sum(ssa) * (1.f / DM) + EPS), rb = rsqrtf(wave_sum(ssb) * (1.f / DM) + EPS);
#pragma unroll
        for (int j = 0; j < 2; ++j) { const int c = 8 * F.lane + 512 * j;
            f32x4 o0, o1;
            o0.x = va[j][0] * ra * gg[j][0].x; o0.y = va[j][1] * ra * gg[j][0].y; o0.z = va[j][2] * ra * gg[j][0].z; o0.w = va[j][3] * ra * gg[j][0].w;
            o1.x = va[j][4] * ra * gg[j][1].x; o1.y = va[j][5] * ra * gg[j][1].y; o1.z = va[j][6] * ra * gg[j][1].z; o1.w = va[j][7] * ra * gg[j][1].w;
            *(f32x4*)(F.out + (size_t)tA * DM + c) = o0; *(f32x4*)(F.out + (size_t)tA * DM + c + 4) = o1;
            o0.x = vb[j][0] * rb * gg[j][0].x; o0.y = vb[j][1] * rb * gg[j][0].y; o0.z = vb[j][2] * rb * gg[j][0].z; o0.w = vb[j][3] * rb * gg[j][0].w;
            o1.x = vb[j][4] * rb * gg[j][1].x; o1.y = vb[j][5] * rb * gg[j][1].y; o1.z = vb[j][6] * rb * gg[j][1].z; o1.w = vb[j][7] * rb * gg[j][1].w;
            *(f32x4*)(F.out + (size_t)tB * DM + c) = o0; *(f32x4*)(F.out + (size_t)tB * DM + c + 4) = o1; }
        slA = nA; slB = nB;
    }
}

__global__ void __launch_bounds__(NWAVES * 64, 2) hymba_fwd(Args args) {
    extern __shared__ __attribute__((aligned(16))) unsigned char lds[];
    Frame F;
    F.lds = (LAS unsigned char*)lds;
    F.MISC = (volatile LAS unsigned*)(F.lds + MISC_OFF);
    F.tid = threadIdx.x; F.lane = F.tid & 63; F.wave = __builtin_amdgcn_readfirstlane(F.tid >> 6);
    F.G = gridDim.x; { const int bx = blockIdx.x; F.vcu = (F.G % 8 == 0) ? (bx % 8) * (F.G / 8) + bx / 8 : bx; }
    F.ws = args.ws; F.ctl = (unsigned*)(args.ws + WS_CTL); F.out = args.out;
    for (int u = F.tid; u < (LDS_BYTES - LDSCTL_OFF) / 4; u += NWAVES * 64) ((LAS unsigned*)(F.lds + LDSCTL_OFF))[u] = 0u;
    __syncthreads();
    XcdBarrier bar; bar.bar = F.ctl + CW_BAR; bar.x = 0; bar.st = nullptr;
    if (N_LAUNCHES == 1) bar = xcd_barrier_post(F.ctl + CW_BAR, F.MISC + 8);
#define GRID_BAR() do { if (N_LAUNCHES == 1) xcd_barrier(bar); } while (0)
    const int lo = args.ph_lo, hi = args.ph_hi;
#ifndef PH_MASK
#define PH_MASK 0x1ff
#endif
#define IN(k) (((PH_MASK >> (k)) & 1) && lo <= (k) && (k) < hi)
#define BOTH(k) (IN(k) && IN((k) + 1))
    bf16_t* const H = (bf16_t*)(F.ws + WS_H); bf16_t* const PROJ = (bf16_t*)(F.ws + WS_PROJ); bf16_t* const MIX = (bf16_t*)(F.ws + WS_MIX); bf16_t* const X1B = (bf16_t*)(F.ws + WS_X1B);
    bf16_t* const Win_t = (bf16_t*)(F.ws + WS_WIN); bf16_t* const Wout_t = (bf16_t*)(F.ws + WS_WOUT);
    const unsigned char* const Wgu_q = F.ws + WS_WGU; const unsigned char* const Wd_q = F.ws + WS_WD;
    unsigned char* const X1Q = F.ws + WS_X1Q; unsigned char* const ACTQ = F.ws + WS_ACTQ; unsigned char* const Yp = F.ws + WS_Y;
    const int* const tok_slot = (const int*)(F.ws + WS_TOKSLOT); const float* const gate_slot = (const float*)(F.ws + WS_GATESLOT); const float* const rstd_slot = (const float*)(F.ws + WS_RSTDSLOT);
    const int* const rb_e = (const int*)(F.ws + WS_RBE);

#define REP(k) for (int rep_ = 0; rep_ < (((PROBE_REP >> (k)) & 1) ? 2 : 1); ++rep_)
    if (IN(0)) { REP(0) p0_prologue(F); if (BOTH(0)) GRID_BAR(); }
    if (IN(1)) {
        REP(1) {
        pg8::Gemm g{H, Win_t, DM, 0, nullptr}; pg8::StaticOrder S; S.init(T, INW, F.G, (int)blockIdx.x);
        pg8::EpiProj E{PROJ, (const float*)(F.ws + WS_RSTDX)};
        pg8::gemm_phase<pg8::EpiProj, pg8::StaticOrder, true>(F.lds, g, S, E); }
        if (BOTH(1)) GRID_BAR();
    }
    if (IN(2)) { p2_mixers(F); if (BOTH(2)) GRID_BAR(); }
    if (IN(3)) {
        pg8::Gemm g{MIX, Wout_t, DM, 0, nullptr}; pg8::StaticOrder S; S.init(T, DM, F.G, (int)blockIdx.x);
        pg8::EpiX1 E{H, X1B, X1Q};
        pg8::gemm_phase<pg8::EpiX1, pg8::StaticOrder, true>(F.lds, g, S, E);
        if (BOTH(3)) GRID_BAR();
    }
    if (IN(4)) { if (PROBE_X & 2) p4_router(F, true); p4_router(F); if (BOTH(4)) GRID_BAR(); }
    if (IN(5)) { p5_place(F); if (BOTH(5)) GRID_BAR(); }
    if (IN(6)) {
        const int nrb = rb_e[NRB_MAX];
        REP(6) {
        pg8::Gemm g{(const bf16_t*)X1Q, (const bf16_t*)Wgu_q, DM / 2, (long)2048 * DM / 2, tok_slot}; pg8::GroupOrder S{nrb, 0, 8, F.G, (int)blockIdx.x, rb_e};
        pg8::EpiGU E{ACTQ, kargs()->in[I_BGU], rstd_slot};
        pg8::gemm_phase<pg8::EpiGU, pg8::GroupOrder, true, true, (PROBE_KREP == 2 ? 0x78787878 : 0x79797979), 0x7f7f7f7f, PROBE_KREP>(F.lds, g, S, E); }
        if (BOTH(6)) GRID_BAR();
    }
    if (IN(7)) {
        const int nrb = rb_e[NRB_MAX];
        REP(7) {
        pg8::Gemm g{(const bf16_t*)ACTQ, (const bf16_t*)Wd_q, DEXP / 2, (long)DM * DEXP / 2, nullptr}; pg8::GroupOrder S{nrb, 0, 4, F.G, (int)blockIdx.x, rb_e};
        pg8::EpiDown E{Yp, kargs()->in[I_BDN], gate_slot};
        pg8::gemm_phase<pg8::EpiDown, pg8::GroupOrder, true, true, 0x79797979, 0x7d7d7d7d>(F.lds, g, S, E); }
        if (BOTH(7)) GRID_BAR();
    }
    if (IN(8)) { REP(8) p9_final(F); }
#if PROBE_SEG
    if (IN(8) && blockIdx.x == 0 && F.tid == 0) { const unsigned long long a_ = F.ctl[604], t_ = F.ctl[605]; const unsigned long long us_ = t_ ? a_ * 2000ull / t_ : 0ull; const unsigned long long t0_ = __builtin_amdgcn_s_memrealtime();
        while (__builtin_amdgcn_s_memrealtime() - t0_ < us_ * 100ull) __builtin_amdgcn_s_sleep(8); }
#endif
#if PROBE_CLK
    if (IN(8) && blockIdx.x == 0 && F.tid == 0) { const unsigned long long dc_ = ((unsigned long long)F.ctl[601] << 32) | F.ctl[600]; const unsigned long long dr_ = F.ctl[602];
        const unsigned long long mhz_ = dr_ ? dc_ * 100ull / dr_ : 0ull; const unsigned long long t0_ = __builtin_amdgcn_s_memrealtime();
        while (__builtin_amdgcn_s_memrealtime() - t0_ < mhz_ * 100ull) __builtin_amdgcn_s_sleep(8); }
#endif
#undef IN
#undef BOTH
#undef GRID_BAR
}

extern "C" void kernel_launch(void* const* d_in, const int* in_sizes, int n_in, void* d_out, int out_size, void* d_ws, size_t ws_size, hipStream_t stream) {
    static int grid = 0;
    if (grid == 0) {
        if (n_in != 19 || out_size != T * DM || ws_size < WS_END) { fprintf(stderr, "kernel_launch: unexpected shapes (n_in %d out %d ws %zu)\n", n_in, out_size, ws_size); grid = -1; return; }
        int dev = 0, cus = 0;
        if (hipGetDevice(&dev) != hipSuccess || hipDeviceGetAttribute(&cus, hipDeviceAttributeMultiprocessorCount, dev) != hipSuccess) { grid = -1; return; }
        if (hipFuncSetAttribute((const void*)hymba_fwd, hipFuncAttributeMaxDynamicSharedMemorySize, LDS_BYTES) != hipSuccess) { fprintf(stderr, "kernel_launch: hipFuncSetAttribute failed\n"); grid = -1; return; }
        int per_cu = 0;
        if (hipOccupancyMaxActiveBlocksPerMultiprocessor(&per_cu, (const void*)hymba_fwd, NWAVES * 64, LDS_BYTES) != hipSuccess || per_cu < 1) fprintf(stderr, "kernel_launch: occupancy query reports %d\n", per_cu);
        (void)hipGetLastError();
        grid = cus;
    }
    if (grid < 0) return;
    if (hipMemsetAsync((char*)d_ws + WS_CTL, 0, CTL_ZERO_BYTES, stream) != hipSuccess) return;
    Args a{};
    for (int i = 0; i < 19; ++i) a.in[i] = (const float*)d_in[i];
    a.out = (float*)d_out; a.ws = (unsigned char*)d_ws;
    for (int li = 0; li < N_LAUNCHES; ++li) {
        a.ph_lo = (N_LAUNCHES == 1) ? 0 : li; a.ph_hi = (N_LAUNCHES == 1) ? N_PHASES : li + 1;
        hipLaunchKernelGGL(hymba_fwd, dim3(grid), dim3(NWAVES * 64), LDS_BYTES, stream, a);
    }
}
```

```cpp
#include <hip/hip_runtime.h>
#include <hip/hip_bf16.h>
#include <cstdio>
#include <cstdint>

#ifndef PROBE_REP
#define PROBE_REP 0
#endif
#ifndef PROBE_X
#define PROBE_X 0
#endif
#ifndef PROBE_P0
#define PROBE_P0 0
#endif
#ifndef PROBE_SEG
#define PROBE_SEG 0
#endif
#ifndef PROBE_CLK
#define PROBE_CLK 0
#endif
#ifndef PROBE_KREP
#define PROBE_KREP 1
#endif
#ifndef PROBE_EPI
#define PROBE_EPI 0
#endif
#ifndef MK_N_LAUNCHES
#define MK_N_LAUNCHES 1
#endif

constexpr int BATCH = 8, SEQ = 8192, DM = 1024, T = BATCH * SEQ, INW = 2560, MEML = 256, NEXP = 32, TOPK = 4, DEXP = 1024;
constexpr int COL_U = 0, COL_GB = 256, COL_GC = 512, COL_Q = 768, COL_K = 1280, COL_V = 1792, COL_QM = 2304;
constexpr float EPS = 1e-5f;
constexpr float C2 = 0.125f * 1.4426950408889634f;
constexpr float LOG2E = 1.4426950408889634f;
constexpr int NRB_MAX = 1056;

#define GAS __attribute__((address_space(1)))
#define LAS __attribute__((address_space(3)))
typedef unsigned short bf16_t;
typedef short bf16x8 __attribute__((ext_vector_type(8)));
typedef short s16x4 __attribute__((ext_vector_type(4)));
typedef float f32x4 __attribute__((ext_vector_type(4)));
typedef float f32x16 __attribute__((ext_vector_type(16)));
typedef unsigned u32x4 __attribute__((ext_vector_type(4)));
typedef unsigned u32x2 __attribute__((ext_vector_type(2)));
typedef float f32x2_t __attribute__((ext_vector_type(2)));
typedef __bf16 bf16x2_t __attribute__((ext_vector_type(2)));
typedef GAS unsigned gu32;
#define RLX_AGENT __ATOMIC_RELAXED, __HIP_MEMORY_SCOPE_AGENT
#define LDS_WAIT() asm volatile("s_waitcnt lgkmcnt(0)" ::: "memory")
#define VM_WAIT() asm volatile("s_waitcnt vmcnt(0)" ::: "memory")
#define SBAR() __builtin_amdgcn_sched_barrier(0)

__device__ __forceinline__ unsigned pk2(float lo, float hi) { f32x2_t v = {lo, hi}; bf16x2_t b = __builtin_convertvector(v, bf16x2_t); return __builtin_bit_cast(unsigned, b); }
__device__ __forceinline__ float bflo(unsigned u) { return __uint_as_float(u << 16); }
__device__ __forceinline__ float bfhi(unsigned u) { return __uint_as_float(u & 0xffff0000u); }
__device__ __forceinline__ bf16x8 pack8(f32x4 a, f32x4 b) { u32x4 w = {pk2(a[0], a[1]), pk2(a[2], a[3]), pk2(b[0], b[1]), pk2(b[2], b[3])}; return __builtin_bit_cast(bf16x8, w); }
__device__ __forceinline__ int crow(int r, int hi) { return (r & 3) + 8 * (r >> 2) + 4 * hi; }
__device__ __forceinline__ float wave_sum(float v) {
#pragma unroll
    for (int o = 1; o < 64; o <<= 1) v += __shfl_xor(v, o);
    return v;
}

namespace pg8 {
constexpr int BM = 256, BK = 64, HALF = 128, HTB = HALF * BK * 2  , STAGE_BYTES = 8 * HTB, NXCD = 8, WGM = 8;
__host__ __device__ __forceinline__ int lds_byte(int r, int c) { const int st = (r >> 4) * 2 + (c >> 5), rr = r & 15, cc = c & 31, ob = rr * 64 + cc * 2; return st * 1024 + (ob ^ (((ob >> 9) & 1) << 5)); }
__host__ __device__ __forceinline__ void stage_rc(int b, int& R, int& C) { const int st = b / 1024, sb = b % 1024, swz = sb ^ (((sb >> 9) & 1) << 5); R = (st >> 1) * 16 + swz / 64; C = (st & 1) * 32 + (swz % 64) / 2; }
__host__ __device__ __forceinline__ int perm32(int rho) { const int n = rho >> 4, i = rho & 15; return 8 * (i >> 2) + 4 * n + (i & 3); }

struct Unit { int pm, pn, e; };
struct Gemm { const bf16_t* A; const bf16_t* Bt; int K; long bstride; const int* rowmap; };

struct StaticOrder {
    int nM, nN, nwg, G, c;
    __device__ void init(int M, int N, int G_, int c_) { nM = M / BM; nN = N / BM; nwg = nM * nN; G = G_; c = c_; }
    __device__ bool next(int i, Unit& u) const {
        const long L = (long)i * G + c; if (L >= nwg) return false;
        int wgid = (int)L; { const int q = nwg / NXCD, r = nwg % NXCD, xcd = wgid % NXCD, off = wgid / NXCD; wgid = (xcd < r ? xcd * (q + 1) : r * (q + 1) + (xcd - r) * q) + off; }
        const int nig = WGM * nN, gid = wgid / nig, fm = gid * WGM, gsz = (nM - fm) < WGM ? (nM - fm) : WGM;
        u.pm = fm + ((wgid % nig) % gsz); u.pn = (wgid % nig) / gsz; u.e = 0; return true;
    }
};
struct GroupOrder {
    int nrb, rb0, npn, G, c; const int* rb_e;
    __device__ bool next(int i, Unit& u) const {
        int rbl, pn;
        if ((G & 7) == 0 && ((G >> 3) % npn) == 0) { const int x = c & 7, j = c >> 3, rpx = (G >> 3) / npn; rbl = i * (G / npn) + x * rpx + j / npn; pn = j % npn; }
        else { const long L = (long)i * G + c; rbl = (int)(L / npn); pn = (int)(L % npn); }
        if (rbl >= nrb) return false;
        u.pm = rb0 + rbl; u.pn = pn; u.e = rb_e[u.pm]; return true;
    }
};

typedef int v4i_t __attribute__((ext_vector_type(4)));
typedef int v8i_t __attribute__((ext_vector_type(8)));
template <class Epi, class Sched, bool ALIGN_EPI, bool FP8 = false, int SCW = 0x7f7f7f7f, int SCA = 0x7f7f7f7f, int KREP = 1>
__device__ __forceinline__ void gemm_phase(LAS unsigned char* lds, const Gemm g, const Sched& S, const Epi& E) {
    const int tid = threadIdx.x, wid = __builtin_amdgcn_readfirstlane(tid >> 6), lane = tid & 63, wr = wid >> 2, wc = wid & 3, fr = lane & 15, fq = lane >> 4;
    const int K = g.K; int nt = K / BK; asm volatile("" : "+s"(nt));
    int Rr[2], Cc[2]; unsigned voffB[2];
#pragma unroll
    for (int i = 0; i < 2; ++i) { int R, C; stage_rc(tid * 16 + i * 8192, R, C); const int Rb = Epi::PERM ? ((R & ~31) + perm32(R & 31)) : R;
        Rr[i] = R; Cc[i] = C; voffB[i] = (unsigned)(Rb * K + C) * 2u; }
    const size_t kstep = (size_t)(BK * 2);
    const size_t hstep = (size_t)HALF * K * 2;
    const size_t tstep = 2 * hstep;
    const unsigned ldsw = (unsigned)wid * 1024u;
    const int aoff = lds_byte(wr * 64 + fr, fq * 8), boff = lds_byte(wc * 32 + fr, fq * 8);
#define PG8_SA(b, h) (((b) * 2 + (h)) * HTB)
#define PG8_SB(b, h) ((4 + (b) * 2 + (h)) * HTB)
#define PG8_STAGE(bufoff, gbase, voff) do { _Pragma("unroll") for (int _i = 0; _i < 2; ++_i) \
        __builtin_amdgcn_global_load_lds((const unsigned*)((const char*)(gbase) + (voff)[_i]), (LAS unsigned*)(lds + (bufoff) + ldsw + _i * 8192), 16, 0, 0); } while (0)
#define PG8_STAGE_A(bufoff, kptr, offs, h) do { _Pragma("unroll") for (int _i = 0; _i < 2; ++_i) \
        __builtin_amdgcn_global_load_lds((const unsigned*)((const char*)(kptr) + (offs)[h][_i]), (LAS unsigned*)(lds + (bufoff) + ldsw + _i * 8192), 16, 0, 0); } while (0)
#define PG8_AOFF(dst, u) do { _Pragma("unroll") for (int _h = 0; _h < 2; ++_h) _Pragma("unroll") for (int _i = 0; _i < 2; ++_i) { const int _row = (u).pm * BM + _h * HALF + Rr[_i]; \
        const int _src = g.rowmap ? g.rowmap[_row] : _row; dst[_h][_i] = (unsigned)(_src * K + Cc[_i]) * 2u; } } while (0)
#define PG8_LDA(dst, b, h) do { _Pragma("unroll") for (int m = 0; m < 4; ++m) _Pragma("unroll") for (int k = 0; k < 2; ++k) dst[m][k] = *(const LAS bf16x8*)(lds + PG8_SA(b, h) + aoff + m * 2048 + k * 1024); } while (0)
#define PG8_LDB(dst, b, h) do { _Pragma("unroll") for (int n = 0; n < 2; ++n) _Pragma("unroll") for (int k = 0; k < 2; ++k) dst[n][k] = *(const LAS bf16x8*)(lds + PG8_SB(b, h) + boff + n * 2048 + k * 1024); } while (0)
#define PG8_CAT(x, y) __builtin_shufflevector(__builtin_bit_cast(v4i_t, x), __builtin_bit_cast(v4i_t, y), 0, 1, 2, 3, 4, 5, 6, 7)
#define PG8_MMA(ai, bj, At, Bt) do { __builtin_amdgcn_s_setprio(1); _Pragma("unroll") for (int m = 0; m < 4; ++m) _Pragma("unroll") for (int n = 0; n < 2; ++n) { \
        if constexpr (FP8) { acc[ai][bj][m][n] = __builtin_amdgcn_mfma_scale_f32_16x16x128_f8f6f4(PG8_CAT(Bt[n][0], Bt[n][1]), PG8_CAT(At[m][0], At[m][1]), acc[ai][bj][m][n], 0, 0, 0, SCW, 0, SCA); } \
        else { _Pragma("unroll") for (int k = 0; k < 2; ++k) acc[ai][bj][m][n] = __builtin_amdgcn_mfma_f32_16x16x32_bf16(Bt[n][k], At[m][k], acc[ai][bj][m][n], 0, 0, 0); } } \
        __builtin_amdgcn_s_setprio(0); } while (0)
#define PG8_WAIT_V(n) asm volatile("s_waitcnt vmcnt(" #n ")" ::: "memory")
#define PG8_WAIT_L(n) asm volatile("s_waitcnt lgkmcnt(" #n ")" ::: "memory")
#define PG8_BAR __builtin_amdgcn_s_barrier()
#define PG8_SCHED __builtin_amdgcn_sched_barrier(0)
    Unit cur, nxt; int ui = 0;
    if (!S.next(0, cur)) return;
    f32x4 acc[2][2][4][2];
#pragma unroll
    for (int a = 0; a < 2; ++a)
#pragma unroll
        for (int b = 0; b < 2; ++b)
#pragma unroll
            for (int m = 0; m < 4; ++m)
#pragma unroll
                for (int n = 0; n < 2; ++n) acc[a][b][m][n] = (f32x4){0.f, 0.f, 0.f, 0.f};
    bf16x8 At[4][2], B0[2][2], B1[2][2];
    unsigned aoc[2][2], aon[2][2];
    PG8_AOFF(aoc, cur);
    const char* Ab = (const char*)g.A;
    const char* cB = (const char*)g.Bt + ((size_t)cur.e * (size_t)g.bstride) * 2 + (size_t)cur.pn * tstep;
    PG8_STAGE(PG8_SB(0, 0), cB, voffB); PG8_STAGE(PG8_SB(0, 1), cB + hstep, voffB); PG8_STAGE_A(PG8_SA(0, 0), Ab, aoc, 0); PG8_STAGE_A(PG8_SA(0, 1), Ab, aoc, 1);
    if (wr == 1) PG8_BAR;
    PG8_WAIT_V(2); PG8_BAR;
    PG8_STAGE(PG8_SB(1, 0), cB + kstep, voffB); PG8_STAGE_A(PG8_SA(1, 0), Ab + kstep, aoc, 0); PG8_STAGE(PG8_SB(1, 1), cB + hstep + kstep, voffB);
    PG8_WAIT_V(6); PG8_BAR;
    for (;;) {
        const bool has_next = S.next(ui + 1, nxt);
        if (has_next) { PG8_AOFF(aon, nxt); }
        else {
#pragma unroll
            for (int h = 0; h < 2; ++h)
#pragma unroll
                for (int i = 0; i < 2; ++i) aon[h][i] = aoc[h][i];
        }
        const char* nB = has_next ? (const char*)g.Bt + ((size_t)nxt.e * (size_t)g.bstride) * 2 + (size_t)nxt.pn * tstep : cB;
#pragma nounroll
        for (int t = 0; t < nt * KREP; t += 2) {
            const bool last = (t == nt * KREP - 2);
            const char* a1 = Ab + (size_t)((t + 1) & (nt - 1)) * kstep;
            const char* a2 = last ? Ab : Ab + (size_t)((t + 2) & (nt - 1)) * kstep; const char* b2 = last ? nB : cB + (size_t)((t + 2) & (nt - 1)) * kstep;
            const char* a3 = a2 + kstep; const char* b3 = b2 + kstep;
            PG8_LDB(B0, 0, 0); PG8_LDB(B1, 0, 1); PG8_SCHED; PG8_LDA(At, 0, 0); PG8_STAGE_A(PG8_SA(1, 1), a1, aoc, 1);
            if (last) {
#pragma unroll
                for (int h = 0; h < 2; ++h)
#pragma unroll
                    for (int i = 0; i < 2; ++i) aoc[h][i] = aon[h][i]; }
            PG8_WAIT_V(8); PG8_WAIT_L(0); PG8_BAR; PG8_MMA(0, 0, At, B0); PG8_MMA(0, 1, At, B1); PG8_BAR; PG8_SCHED;
            PG8_LDA(At, 0, 1); PG8_STAGE(PG8_SB(0, 0), b2, voffB); PG8_STAGE(PG8_SB(0, 1), b2 + hstep, voffB); PG8_STAGE_A(PG8_SA(0, 0), a2, aoc, 0);
            PG8_WAIT_V(8); PG8_WAIT_L(0); PG8_BAR; PG8_MMA(1, 0, At, B0); PG8_MMA(1, 1, At, B1); PG8_BAR; PG8_SCHED;
            PG8_LDB(B0, 1, 0); PG8_LDB(B1, 1, 1); PG8_SCHED; PG8_LDA(At, 1, 0); PG8_STAGE_A(PG8_SA(0, 1), a2, aoc, 1);
            PG8_WAIT_V(8); PG8_WAIT_L(0); PG8_BAR; PG8_MMA(0, 0, At, B0); PG8_MMA(0, 1, At, B1); PG8_BAR; PG8_SCHED;
            PG8_LDA(At, 1, 1); PG8_STAGE(PG8_SB(1, 0), b3, voffB); PG8_STAGE(PG8_SB(1, 1), b3 + hstep, voffB); PG8_STAGE_A(PG8_SA(1, 0), a3, aoc, 0);
            PG8_WAIT_V(8); PG8_WAIT_L(0); PG8_BAR; PG8_MMA(1, 0, At, B0); PG8_MMA(1, 1, At, B1); PG8_BAR; PG8_SCHED;
        }
        if constexpr (ALIGN_EPI) { if (wr == 0) PG8_BAR; }
        E(acc, cur, wr, wc, fr, fq);
        if constexpr (FP8 && PROBE_EPI != 0) { asm volatile("" ::: "memory"); E(acc, cur, wr, wc, fr, fq); }
        if (!has_next) break;
#pragma unroll
        for (int a = 0; a < 2; ++a)
#pragma unroll
            for (int b = 0; b < 2; ++b)
#pragma unroll
                for (int m = 0; m < 4; ++m)
#pragma unroll
                    for (int n = 0; n < 2; ++n) acc[a][b][m][n] = (f32x4){0.f, 0.f, 0.f, 0.f};
        cur = nxt; cB = nB; ++ui;
        if constexpr (ALIGN_EPI) { if (wr == 1) PG8_BAR; }
    }
    PG8_WAIT_V(0);
    if constexpr (!ALIGN_EPI) { if (wr == 0) PG8_BAR; }
    PG8_BAR;
#undef PG8_SA
#undef PG8_SB
#undef PG8_STAGE
#undef PG8_STAGE_A
#undef PG8_AOFF
#undef PG8_LDA
#undef PG8_LDB
#undef PG8_MMA
#undef PG8_CAT
#undef PG8_WAIT_V
#undef PG8_WAIT_L
#undef PG8_BAR
#undef PG8_SCHED
}

struct EpiProj {
    static constexpr bool PERM = true;
    bf16_t* O; const float* rstd;
    __device__ __forceinline__ void operator()(const f32x4 (&acc)[2][2][4][2], const Unit& u, int wr, int wc, int fr, int fq) const {
        const int row0 = u.pm * BM + wr * 64 + fr, col0 = u.pn * BM + wc * 32 + 8 * fq;
        const float sc = (u.pn == 3 || u.pn == 4 || u.pn == 9) ? C2 : 1.f;
        float rsv[2][4];
#pragma unroll
        for (int ai = 0; ai < 2; ++ai)
#pragma unroll
            for (int m = 0; m < 4; ++m) rsv[ai][m] = rstd[row0 + ai * HALF + m * 16] * sc;
#pragma unroll
        for (int ai = 0; ai < 2; ++ai)
#pragma unroll
            for (int m = 0; m < 4; ++m) { bf16_t* rowp = O + (size_t)(row0 + ai * HALF + m * 16) * INW + col0; const float rs = rsv[ai][m];
#pragma unroll
                for (int bj = 0; bj < 2; ++bj) { const f32x4 v0 = acc[ai][bj][m][0] * rs, v1 = acc[ai][bj][m][1] * rs;
                    u32x4 w; w.x = pk2(v0[0], v0[1]); w.y = pk2(v0[2], v0[3]); w.z = pk2(v1[0], v1[1]); w.w = pk2(v1[2], v1[3]);
                    *(u32x4*)(rowp + bj * HALF) = w; } }
    }
};
__device__ __forceinline__ unsigned pk4_fp8(float a, float b, float c, float d) { int w = 0; w = __builtin_amdgcn_cvt_pk_fp8_f32(a, b, w, false); w = __builtin_amdgcn_cvt_pk_fp8_f32(c, d, w, true); return (unsigned)w; }
struct EpiX1 {
    static constexpr bool PERM = true;
    const bf16_t* XB; bf16_t* O; unsigned char* Q8;
    __device__ __forceinline__ void operator()(const f32x4 (&acc)[2][2][4][2], const Unit& u, int wr, int wc, int fr, int fq) const {
        const int row0 = u.pm * BM + wr * 64 + fr, col0 = u.pn * BM + wc * 32 + 8 * fq;
        const bf16_t* __restrict__ Xr = XB; bf16_t* __restrict__ Or = O; unsigned char* __restrict__ Qr = Q8;
        u32x2 qp[2];
        u32x4 xv[2][4][2];
#pragma unroll
        for (int ai = 0; ai < 2; ++ai)
#pragma unroll
            for (int m = 0; m < 4; ++m) { const size_t off = (size_t)(row0 + ai * HALF + m * 16) * DM + col0;
#pragma unroll
                for (int bj = 0; bj < 2; ++bj) xv[ai][m][bj] = *(const u32x4*)(Xr + off + bj * HALF); }
#pragma unroll
        for (int ai = 0; ai < 2; ++ai)
#pragma unroll
            for (int m = 0; m < 4; ++m) { const size_t off = (size_t)(row0 + ai * HALF + m * 16) * DM + col0;
#pragma unroll
                for (int bj = 0; bj < 2; ++bj) { const u32x4 xw = xv[ai][m][bj];
                    const f32x4 x0 = {bflo(xw.x), bfhi(xw.x), bflo(xw.y), bfhi(xw.y)}, x1 = {bflo(xw.z), bfhi(xw.z), bflo(xw.w), bfhi(xw.w)};
                    const f32x4 v0 = acc[ai][bj][m][0] + x0, v1 = acc[ai][bj][m][1] + x1;
                    u32x4 w; w.x = pk2(v0[0], v0[1]); w.y = pk2(v0[2], v0[3]); w.z = pk2(v1[0], v1[1]); w.w = pk2(v1[2], v1[3]);
                    *(u32x4*)(Or + off + bj * HALF) = w;
                    u32x2 q; q.x = pk4_fp8(v0[0], v0[1], v0[2], v0[3]); q.y = pk4_fp8(v1[0], v1[1], v1[2], v1[3]);
                    if ((m & 1) == 0) qp[bj] = q;
                    else { const int odd = fq & 1;
                        auto rx = __builtin_amdgcn_permlane16_swap(qp[bj].x, q.x, false, false); auto ry = __builtin_amdgcn_permlane16_swap(qp[bj].y, q.y, false, false);
                        u32x4 o4; o4.x = rx[0]; o4.y = ry[0]; o4.z = rx[1]; o4.w = ry[1];
                        *(u32x4*)(Qr + (size_t)(row0 + ai * HALF + (m - 1 + odd) * 16) * DM + col0 - 8 * odd + bj * HALF) = o4; } } }
    }
};
struct EpiGU {
    static constexpr bool PERM = true;
    unsigned char* ACT; const float* bias; const float* rstd;
    __device__ __forceinline__ void operator()(const f32x4 (&acc)[2][2][4][2], const Unit& u, int wr, int wc, int fr, int fq) const {
        const int row0 = u.pm * BM + wr * 64 + fr, j0 = u.pn * HALF + wc * 32 + 8 * fq;
        const float* bp = bias + (size_t)u.e * 2048 + j0;
        const f32x4 bg0 = *(const f32x4*)(bp), bg1 = *(const f32x4*)(bp + 4), bu0 = *(const f32x4*)(bp + 1024), bu1 = *(const f32x4*)(bp + 1028);
        float rsv[2][4];
#pragma unroll
        for (int ai = 0; ai < 2; ++ai)
#pragma unroll
            for (int m = 0; m < 4; ++m) rsv[ai][m] = rstd[row0 + ai * HALF + m * 16];
#pragma unroll
        for (int ai = 0; ai < 2; ++ai) { u32x2 wp;
#pragma unroll
            for (int m = 0; m < 4; ++m) { const float rs = rsv[ai][m];
                float o[8];
#pragma unroll
                for (int h2 = 0; h2 < 2; ++h2) { const f32x4 ga = h2 ? acc[ai][0][m][1] : acc[ai][0][m][0], ua = h2 ? acc[ai][1][m][1] : acc[ai][1][m][0], gb = h2 ? bg1 : bg0, ub = h2 ? bu1 : bu0;
#pragma unroll
                    for (int p2 = 0; p2 < 2; ++p2) { const f32x2_t gacc = {ga[2 * p2], ga[2 * p2 + 1]}, uacc = {ua[2 * p2], ua[2 * p2 + 1]}, gbv = {gb[2 * p2], gb[2 * p2 + 1]}, ubv = {ub[2 * p2], ub[2 * p2 + 1]};
                        f32x2_t gg = gacc * rs + gbv, uu = uacc * rs + ubv;
                        gg[0] = fminf(gg[0], 7.f); gg[1] = fminf(gg[1], 7.f); uu[0] = __builtin_amdgcn_fmed3f(uu[0], -7.f, 7.f); uu[1] = __builtin_amdgcn_fmed3f(uu[1], -7.f, 7.f);
                        const f32x2_t tt = gg * (-1.702f * LOG2E); f32x2_t ee; ee[0] = __builtin_amdgcn_exp2f(tt[0]); ee[1] = __builtin_amdgcn_exp2f(tt[1]);
                        const f32x2_t dd = ee * 0.25f + 0.25f; f32x2_t rr; rr[0] = __builtin_amdgcn_rcpf(dd[0]); rr[1] = __builtin_amdgcn_rcpf(dd[1]);
                        const f32x2_t s4 = gg * rr, oo = uu * s4 + s4;
                        o[4 * h2 + 2 * p2] = oo[0]; o[4 * h2 + 2 * p2 + 1] = oo[1]; } }
                u32x2 w; w.x = pk4_fp8(o[0], o[1], o[2], o[3]); w.y = pk4_fp8(o[4], o[5], o[6], o[7]);
                if ((m & 1) == 0) wp = w;
                else { const int odd = fq & 1;
                    auto rx = __builtin_amdgcn_permlane16_swap(wp.x, w.x, false, false); auto ry = __builtin_amdgcn_permlane16_swap(wp.y, w.y, false, false);
                    u32x4 o4; o4.x = rx[0]; o4.y = ry[0]; o4.z = rx[1]; o4.w = ry[1];
                    *(u32x4*)(ACT + (size_t)(row0 + ai * HALF + (m - 1 + odd) * 16) * DEXP + j0 - 8 * odd) = o4; } } }
    }
};
struct EpiDown {
    static constexpr bool PERM = true;
    unsigned char* Y; const float* bias; const float* gate;
    __device__ __forceinline__ void operator()(const f32x4 (&acc)[2][2][4][2], const Unit& u, int wr, int wc, int fr, int fq) const {
        const int row0 = u.pm * BM + wr * 64 + fr, col0 = u.pn * BM + wc * 32 + 8 * fq;
        const float* bp = bias + (size_t)u.e * DM + col0;
        f32x4 bv[2][2];
#pragma unroll
        for (int bj = 0; bj < 2; ++bj) { bv[bj][0] = *(const f32x4*)(bp + bj * HALF); bv[bj][1] = *(const f32x4*)(bp + bj * HALF + 4); }
        float gsv[2][4];
#pragma unroll
        for (int ai = 0; ai < 2; ++ai)
#pragma unroll
            for (int m = 0; m < 4; ++m) gsv[ai][m] = 8.f * gate[row0 + ai * HALF + m * 16];
        const int odd = fq & 1;
#pragma unroll
        for (int ai = 0; ai < 2; ++ai)
#pragma unroll
            for (int m = 0; m < 4; m += 2) { const int row = row0 + ai * HALF + (m + odd) * 16;
#pragma unroll
                for (int bj = 0; bj < 2; ++bj) { u32x2 w[2];
#pragma unroll
                    for (int q = 0; q < 2; ++q) { const float gs = gsv[ai][m + q]; const f32x4 v0 = (acc[ai][bj][m + q][0] + bv[bj][0]) * gs, v1 = (acc[ai][bj][m + q][1] + bv[bj][1]) * gs;
                        w[q].x = pk4_fp8(v0[0], v0[1], v0[2], v0[3]); w[q].y = pk4_fp8(v1[0], v1[1], v1[2], v1[3]); }
                    { auto rx = __builtin_amdgcn_permlane16_swap(w[0].x, w[1].x, false, false); w[0].x = rx[0]; w[1].x = rx[1];
                      auto ry = __builtin_amdgcn_permlane16_swap(w[0].y, w[1].y, false, false); w[0].y = ry[0]; w[1].y = ry[1]; }
                    u32x4 o; o.x = w[0].x; o.y = w[0].y; o.z = w[1].x; o.w = w[1].y;
                    *(u32x4*)(Y + (size_t)row * DM + col0 - 8 * odd + bj * HALF) = o; } }
    }
};
}

namespace dattn {
constexpr int NW = 8, QBLK = 32, KVBLK = 64, QB = 256, PITCH = INW;
constexpr int SHM_V = KVBLK * 128 * 2, SHM_K = KVBLK * 64 * 2;
constexpr int NVS = 4, NKS = 3;
constexpr int OFF_V = 0, OFF_K = NVS * SHM_V, OFF_WS = OFF_K + NKS * SHM_K, OFF_STASH = OFF_WS + NW * 64 * 4, OFF_TB = OFF_STASH + NW * 8192, LDS_BYTES = OFF_TB + 4 * 128 * 4;
constexpr float THR = 8.f;
__device__ __forceinline__ int v_st(int k, int c) { const int kk = k;     return ((kk >> 3) * 4 + (c >> 5)) * 512 + ((kk & 7) * 32 + (c & 31)) * 2; }
__device__ __forceinline__ int v_rd_base(int lane) { return ((lane & 3) << 3) | (((lane >> 2) & 3) << 6) | (((lane >> 4) & 1) << 5) | (((lane >> 5) & 1) << 8); }
constexpr int v_rd_off(int d0, int ks, int half) { return d0 * 512 + ks * 4096 + half * 2048; }

struct Ref { unsigned qoff, koff, voff; bf16_t* O; int P0, comp, h; };
typedef __amdgpu_buffer_rsrc_t rsrc_t;
__device__ __forceinline__ bf16x8 bld8(rsrc_t r, unsigned voff, unsigned soff) { return __builtin_bit_cast(bf16x8, __builtin_amdgcn_raw_buffer_load_b128(r, (int)voff, (int)soff, 0)); }
struct Seam { bf16x8 qr[4]; int ks, vs;
#if PROBE_SEG
    unsigned long long acc, tot;
#endif
};

__device__ __forceinline__ bf16x8 ld8(const bf16_t* p) { return *reinterpret_cast<const bf16x8*>(p); }

__device__ __forceinline__ void bias_mask(f32x16& p0, f32x16& p1, int sdq  , const LAS float* tb) {
    const float NEG = -__builtin_inff();
    int lane_ = (int)__builtin_amdgcn_mbcnt_hi(~0u, __builtin_amdgcn_mbcnt_lo(~0u, 0u));
    int dq = sdq + (lane_ & 31) - 4 * (lane_ >> 5);
    asm volatile("" : "+v"(dq));
#pragma unroll
    for (int r = 0; r < 16; ++r) {
        const int c = (r & 3) + 8 * (r >> 2);
        const int d0 = dq - c, d1 = dq - c - 32;
        const int i0 = d0 < 0 ? 0 : (d0 > 127 ? 127 : d0), i1 = d1 < 0 ? 0 : (d1 > 127 ? 127 : d1);
        const float b0 = tb[i0], b1 = tb[i1];
        p0[r] = d0 < 0 ? NEG : p0[r] + b0;
        p1[r] = d1 < 0 ? NEG : p1[r] + b1;
    }
}
__device__ __forceinline__ void partialSM(f32x16& p0, f32x16& p1, float& m_reg, float& alpha) {
    float pmax = p0[0];
#pragma unroll
    for (int r = 1; r < 16; ++r) pmax = fmaxf(pmax, p0[r]);
#pragma unroll
    for (int r = 0; r < 16; ++r) pmax = fmaxf(pmax, p1[r]);
    { auto rr = __builtin_amdgcn_permlane32_swap(__float_as_uint(pmax), __float_as_uint(pmax), false, false);
      pmax = fmaxf(__uint_as_float(rr[0]), __uint_as_float(rr[1])); }
    float mn;
    if (__builtin_expect(__all((pmax - m_reg) <= THR), 1)) { mn = m_reg; alpha = 1.f; }
    else { mn = fmaxf(m_reg, pmax); alpha = __builtin_amdgcn_exp2f(m_reg - mn); m_reg = mn; }
#pragma unroll
    for (int r = 0; r < 16; ++r) p0[r] = p0[r] - mn;
#pragma unroll
    for (int r = 0; r < 16; ++r) p1[r] = p1[r] - mn;
#pragma unroll
    for (int r = 0; r < 16; ++r) p0[r] = __builtin_amdgcn_exp2f(p0[r]);
}
__device__ __forceinline__ void finishSM(f32x16& p0, f32x16& p1, float alpha, float& l_reg, bf16x8& pa0, bf16x8& pa1, bf16x8& pa2, bf16x8& pa3) {
#pragma unroll
    for (int r = 0; r < 16; ++r) p1[r] = __builtin_amdgcn_exp2f(p1[r]);
    float ps = 0;
#pragma unroll
    for (int r = 0; r < 16; ++r) ps += p0[r];
#pragma unroll
    for (int r = 0; r < 16; ++r) ps += p1[r];
    { auto rr = __builtin_amdgcn_permlane32_swap(__float_as_uint(ps), __float_as_uint(ps), false, false);
      ps = __uint_as_float(rr[0]) + __uint_as_float(rr[1]); }
    l_reg = l_reg * alpha + ps;
#define PK4(P, B_, OUT) do { unsigned a0 = pk2(P[B_+0], P[B_+1]), a1 = pk2(P[B_+2], P[B_+3]);                          \
        unsigned b0 = pk2(P[B_+4], P[B_+5]), b1 = pk2(P[B_+6], P[B_+7]);                                             \
        auto r0 = __builtin_amdgcn_permlane32_swap(a0, b0, false, false); auto r1 = __builtin_amdgcn_permlane32_swap(a1, b1, false, false); \
        u32x4 w = {r0[0], r1[0], r0[1], r1[1]}; OUT = __builtin_bit_cast(bf16x8, w); } while (0)
    PK4(p0, 0, pa0); PK4(p0, 8, pa1); PK4(p1, 0, pa2); PK4(p1, 8, pa3);
#undef PK4
}
template <int KB>
__device__ __forceinline__ void qkt(f32x16& p0, f32x16& p1, const LAS unsigned char* K_lds, int r32, int hi, const bf16x8* qr) {
    p0 = f32x16{}; p1 = f32x16{};
    const int s = (r32 >> 1) & 7;
#pragma unroll
    for (int d0 = 0; d0 < 4; ++d0) {
        const LAS unsigned char* a = K_lds + KB * SHM_K + r32 * 128 + (((2 * d0 + hi) ^ s) << 4);
        const bf16x8 b0 = *(const LAS bf16x8*)(a);
        const bf16x8 b1 = *(const LAS bf16x8*)(a + 32 * 128);
        p0 = __builtin_amdgcn_mfma_f32_32x32x16_bf16(b0, qr[d0], p0, 0, 0, 0);
        p1 = __builtin_amdgcn_mfma_f32_32x32x16_bf16(b1, qr[d0], p1, 0, 0, 0); }
}
__device__ __forceinline__ void pv_tile(f32x16* o, int vb0, bf16x8 pa0, bf16x8 pa1, bf16x8 pa2, bf16x8 pa3) {
#define TRRD(dst, off) asm volatile("ds_read_b64_tr_b16 %0, %1 offset:%2" : "=&v"(dst) : "v"(vb0), "i"(off) : "memory")
#define PV_D0(d0) do { s16x4 l0, l1, l2, l3, h0, h1, h2, h3; constexpr int b_ = v_rd_off(d0, 0, 0); \
        TRRD(l0, b_); TRRD(h0, b_ + 2048); TRRD(l1, b_ + 4096); TRRD(h1, b_ + 6144); TRRD(l2, b_ + 8192); TRRD(h2, b_ + 10240); TRRD(l3, b_ + 12288); TRRD(h3, b_ + 14336); \
        asm volatile("s_waitcnt lgkmcnt(0)" ::: "memory"); SBAR();   \
        o[d0] = __builtin_amdgcn_mfma_f32_32x32x16_bf16(pa0, (bf16x8){l0[0], l0[1], l0[2], l0[3], h0[0], h0[1], h0[2], h0[3]}, o[d0], 0, 0, 0);   \
        o[d0] = __builtin_amdgcn_mfma_f32_32x32x16_bf16(pa1, (bf16x8){l1[0], l1[1], l1[2], l1[3], h1[0], h1[1], h1[2], h1[3]}, o[d0], 0, 0, 0);   \
        o[d0] = __builtin_amdgcn_mfma_f32_32x32x16_bf16(pa2, (bf16x8){l2[0], l2[1], l2[2], l2[3], h2[0], h2[1], h2[2], h2[3]}, o[d0], 0, 0, 0);   \
        o[d0] = __builtin_amdgcn_mfma_f32_32x32x16_bf16(pa3, (bf16x8){l3[0], l3[1], l3[2], l3[3], h3[0], h3[1], h3[2], h3[3]}, o[d0], 0, 0, 0); } while (0)
    PV_D0(0); PV_D0(1); PV_D0(2); PV_D0(3);
#undef PV_D0
#undef TRRD
}

#define DA_DMA16(gp, ldsp) __builtin_amdgcn_global_load_lds((const unsigned*)(gp), (LAS unsigned*)(ldsp), 16, 0, 0)
#define DA_STAGE(koff_, voff_, k0, ksoff, vsoff) do { const size_t tb_ = (size_t)(k0) * (PITCH * 2); \
        DA_DMA16(projb + (koff_) + tb_ + lk, K_lds + (ksoff) + wid * 1024); \
        DA_DMA16(projb + (voff_) + tb_ + lv, V_lds + (vsoff) + wid * 2048); \
        DA_DMA16(projb + (voff_) + tb_ + lv + 128, V_lds + (vsoff) + wid * 2048 + 1024); } while (0)
#define DA_LANE_OFFS() const int krow_ = 8 * wid + (lane >> 3); \
        const unsigned lk = (unsigned)(krow_ * PITCH) * 2u + (unsigned)(((lane & 7) ^ ((krow_ >> 1) & 7)) << 4); \
        const unsigned lv = (unsigned)((8 * wid + ((lane & 31) >> 2)) * PITCH) * 2u + (unsigned)(((lane >> 5) * 32 + (lane & 3) * 8) * 2)

__device__ __forceinline__ void prime(const Ref& cur, LAS unsigned char* lds, Seam& S, rsrc_t R, const char* projb) {
    const int tid = threadIdx.x, wid = __builtin_amdgcn_readfirstlane(tid >> 6), lane = tid & 63, r32 = lane & 31, hi = lane >> 5;
    DA_LANE_OFFS();
    const unsigned lq = (unsigned)((wid * QBLK + r32) * PITCH + hi * 8) * 2u;
    LAS unsigned char* K_lds = lds + OFF_K; LAS unsigned char* V_lds = lds + OFF_V;
#pragma unroll
    for (int d0 = 0; d0 < 4; ++d0) S.qr[d0] = bld8(R, lq + d0 * 32, cur.qoff);
    S.ks = 0; S.vs = 0;
    DA_STAGE(cur.koff, cur.voff, 0, 0, 0); DA_STAGE(cur.koff, cur.voff, KVBLK, SHM_K, SHM_V);
    asm volatile("s_waitcnt vmcnt(0)" ::: "memory");
    __syncthreads();
}
__device__ __forceinline__ void block(const Ref& cur, const Ref& nxt, LAS unsigned char* lds, Seam& S, float lam, const float* gsub, rsrc_t R, const char* projb) {
    const int tid = threadIdx.x, wid = __builtin_amdgcn_readfirstlane(tid >> 6), lane = tid & 63, r32 = lane & 31, hi = lane >> 5;
    const int NT = (cur.P0 + QB) / KVBLK;
    const int qlo = cur.P0 + wid * QBLK;
    LAS unsigned char* V_lds = lds + OFF_V; LAS unsigned char* K_lds = lds + OFF_K;
    LAS float* ws = (LAS float*)(lds + OFF_WS) + wid * 64; LAS float* li_l = ws; LAS float* al_l = ws + 32;
    const LAS float* tbh = (const LAS float*)(lds + OFF_TB) + cur.h * 128;
    float mhat = 0.f, l_reg = 0.f, rmx = 0.f; f32x16 o[4] = {}; f32x16 negm = f32x16{};
    bool resc = false;
    const int vb0 = (int)(unsigned)(uintptr_t)V_lds + v_rd_base(lane);
    DA_LANE_OFFS();
    const unsigned Kh = cur.koff, Vh = cur.voff;
#define KNEXT(x) (((x) == (NKS - 1) * SHM_K) ? 0 : (x) + SHM_K)
#define VNEXT(x) (((x) == (NVS - 1) * SHM_V) ? 0 : (x) + SHM_V)
    int k0 = S.ks, k1 = KNEXT(k0), k2 = KNEXT(k1);
    int v1 = S.vs, v2 = VNEXT(v1), v3 = VNEXT(v2), v0 = VNEXT(v3);
#define ROT() do { const int kn_ = k0; k0 = k1; k1 = k2; k2 = kn_; const int vn_ = v0; v0 = v1; v1 = v2; v2 = v3; v3 = vn_; } while (0)
#define STREAM(j) do { const bool in_ = (j) < NT; const unsigned ko_ = in_ ? Kh : nxt.koff, vo_ = in_ ? Vh : nxt.voff; const int tj_ = in_ ? (j) : (j) - NT; DA_STAGE(ko_, vo_, KBASE(tj_), k2, v3); } while (0)
#define STEP_BAR() asm volatile("s_waitcnt vmcnt(3) lgkmcnt(0)\n\ts_barrier" ::: "memory")
    const int ksw = (r32 >> 1) & 7;
    const LAS unsigned char* kbase = K_lds + r32 * 128;
#define KBASE(t) ((t) * KVBLK)
#define NEAR(P0_, P1_, t) do { const int kb_ = KBASE(t); if (kb_ >= qlo - 175) bias_mask(P0_, P1_, qlo - kb_, tbh); } while (0)
#define RESC() do { if (resc) { asm volatile("s_waitcnt lgkmcnt(0)" ::: "memory");              \
                     _Pragma("unroll") for (int d_ = 0; d_ < 4; ++d_) _Pragma("unroll") for (int r = 0; r < 16; ++r) o[d_][r] *= al_l[crow(r, hi)]; } } while (0)
#define PIN(x) asm volatile("" : "+v"(x))
#define EX(v) __builtin_amdgcn_exp2f(v)
#define MX3(a, b, c) __builtin_fmaxf(__builtin_fmaxf((a), (b)), (c))
#define DECIDE(C0, C1, FIRST) do { \
        float a_ = MX3(C0[0], C0[1], C1[0]), b_ = MX3(C0[2], C0[3], C1[1]); a_ = MX3(a_, C1[2], C1[3]); \
        _Pragma("unroll") for (int r = 4; r < 16; r += 4) { a_ = MX3(a_, C0[r], C0[r + 1]); b_ = MX3(b_, C0[r + 2], C0[r + 3]); a_ = MX3(a_, C1[r], C1[r + 1]); b_ = MX3(b_, C1[r + 2], C1[r + 3]); } \
        float rm_ = __builtin_fmaxf(a_, b_); { auto rr_ = __builtin_amdgcn_permlane32_swap(__float_as_uint(rm_), __float_as_uint(rm_), false, false); rm_ = __builtin_fmaxf(__uint_as_float(rr_[0]), __uint_as_float(rr_[1])); } \
        resc = false; \
        if ((FIRST) || __builtin_expect(__any(rm_ > THR), 0)) { const float dl_ = (FIRST) ? rm_ : __builtin_fmaxf(rm_, 0.f); mhat += dl_; \
            _Pragma("unroll") for (int r = 0; r < 16; ++r) { C0[r] -= dl_; C1[r] -= dl_; } \
            _Pragma("unroll") for (int r = 0; r < 16; ++r) negm[r] = -mhat; \
            asm volatile("" : "+v"(negm)); \
            if (!(FIRST)) { const float f_ = EX(-dl_); l_reg *= f_; if (hi == 0) al_l[r32] = f_; resc = true; } } } while (0)
#define DECIDE2(C0, C1) do { float rm_ = rmx; { auto rr_ = __builtin_amdgcn_permlane32_swap(__float_as_uint(rm_), __float_as_uint(rm_), false, false); rm_ = __builtin_fmaxf(__uint_as_float(rr_[0]), __uint_as_float(rr_[1])); } \
        resc = false; \
        if (__builtin_expect(__any(rm_ > THR), 0)) { const float dl_ = __builtin_fmaxf(rm_, 0.f); mhat += dl_; const float f_ = EX(-dl_); \
            _Pragma("unroll") for (int r = 0; r < 16; ++r) { C0[r] *= f_; C1[r] *= f_; } \
            _Pragma("unroll") for (int r = 0; r < 16; ++r) negm[r] = -mhat; \
            asm volatile("" : "+v"(negm)); \
            l_reg *= f_; if (hi == 0) al_l[r32] = f_; resc = true; } } while (0)
#define KF(d0, hf) (*(const LAS bf16x8*)(kbase + k0 + (((2 * (d0) + hi) ^ ksw) << 4) + (hf) * 4096))
#define GAPA(MF, P, B, W) do { MF; sacc += P[B]; sacc += P[B + 1]; sacc += P[B + 2]; sacc += P[B + 3]; PIN(sacc); W[((B) >> 1) & 3] = pk2(P[B], P[B + 1]); W[(((B) >> 1) & 3) + 1] = pk2(P[B + 2], P[B + 3]); PIN(W); SBAR(); } while (0)
#define PHASE_A(C0, C1, P0, P1) do { \
        const bf16x8 k00 = KF(0, 0), k01 = KF(0, 1), k10 = KF(1, 0), k11 = KF(1, 1), k20 = KF(2, 0), k21 = KF(2, 1), k30 = KF(3, 0), k31 = KF(3, 1); \
        float sacc = 0.f; SBAR(); \
        GAPA(C0 = __builtin_amdgcn_mfma_f32_32x32x16_bf16(k00, S.qr[0], negm, 0, 0, 0), P0, 0, pw0); \
        GAPA(C1 = __builtin_amdgcn_mfma_f32_32x32x16_bf16(k01, S.qr[0], negm, 0, 0, 0), P0, 4, pw0); \
        GAPA(C0 = __builtin_amdgcn_mfma_f32_32x32x16_bf16(k10, S.qr[1], C0, 0, 0, 0), P0, 8, pw1); \
        GAPA(C1 = __builtin_amdgcn_mfma_f32_32x32x16_bf16(k11, S.qr[1], C1, 0, 0, 0), P0, 12, pw1); \
        GAPA(C0 = __builtin_amdgcn_mfma_f32_32x32x16_bf16(k20, S.qr[2], C0, 0, 0, 0), P1, 0, pw2); \
        GAPA(C1 = __builtin_amdgcn_mfma_f32_32x32x16_bf16(k21, S.qr[2], C1, 0, 0, 0), P1, 4, pw2); \
        GAPA(C0 = __builtin_amdgcn_mfma_f32_32x32x16_bf16(k30, S.qr[3], C0, 0, 0, 0), P1, 8, pw3); \
        GAPA(C1 = __builtin_amdgcn_mfma_f32_32x32x16_bf16(k31, S.qr[3], C1, 0, 0, 0), P1, 12, pw3); \
        l_reg += sacc; } while (0)
#define TRRD(dst, off) asm volatile("ds_read_b64_tr_b16 %0, %1 offset:%2" : "=&v"(dst) : "v"(vbr), "i"(off) : "memory")
#define VRD8(L0, H0, L1, H1, L2, H2, L3, H3, VBv, d0) do { constexpr int b_ = v_rd_off(d0, 0, 0); \
        TRRD(L0, b_); TRRD(H0, b_ + 2048); TRRD(L1, b_ + 4096); TRRD(H1, b_ + 6144); TRRD(L2, b_ + 8192); TRRD(H2, b_ + 10240); TRRD(L3, b_ + 12288); TRRD(H3, b_ + 14336); } while (0)
#define VF(L, H) (bf16x8){L[0], L[1], L[2], L[3], H[0], H[1], H[2], H[3]}
#define PAF(k) __builtin_bit_cast(bf16x8, pw##k)
#define GAPB(MF, X, B) do { MF; rmx = MX3(rmx, X[B], X[(B) + 1]); X[B] = EX(X[B]); X[(B) + 1] = EX(X[(B) + 1]); PIN(X); PIN(rmx); SBAR(); } while (0)
#define PV4(d0, L0, H0, L1, H1, L2, H2, L3, H3, X, B) do { \
        GAPB(o[d0] = __builtin_amdgcn_mfma_f32_32x32x16_bf16(PAF(0), VF(L0, H0), o[d0], 0, 0, 0), X, (B)); \
        GAPB(o[d0] = __builtin_amdgcn_mfma_f32_32x32x16_bf16(PAF(1), VF(L1, H1), o[d0], 0, 0, 0), X, (B) + 2); \
        GAPB(o[d0] = __builtin_amdgcn_mfma_f32_32x32x16_bf16(PAF(2), VF(L2, H2), o[d0], 0, 0, 0), X, (B) + 4); \
        GAPB(o[d0] = __builtin_amdgcn_mfma_f32_32x32x16_bf16(PAF(3), VF(L3, H3), o[d0], 0, 0, 0), X, (B) + 6); } while (0)
#define LWAIT(n) do { asm volatile("s_waitcnt lgkmcnt(" #n ")" ::: "memory"); SBAR(); } while (0)
#define PHASE_B(C0, C1, VBv) do { s16x4 a0, a1, a2, a3, a4, a5, a6, a7, b0, b1, b2, b3, b4, b5, b6, b7; const int vbr = vb0 + (VBv); rmx = -__builtin_inff(); \
        asm volatile("s_waitcnt lgkmcnt(0)" ::: "memory"); SBAR(); \
        VRD8(a0, a1, a2, a3, a4, a5, a6, a7, VBv, 0); VRD8(b0, b1, b2, b3, b4, b5, b6, b7, VBv, 1); LWAIT(8); \
        PV4(0, a0, a1, a2, a3, a4, a5, a6, a7, C0, 0); \
        VRD8(a0, a1, a2, a3, a4, a5, a6, a7, VBv, 2); LWAIT(8); \
        PV4(1, b0, b1, b2, b3, b4, b5, b6, b7, C0, 8); \
        VRD8(b0, b1, b2, b3, b4, b5, b6, b7, VBv, 3); LWAIT(8); \
        PV4(2, a0, a1, a2, a3, a4, a5, a6, a7, C1, 0); \
        LWAIT(0); \
        PV4(3, b0, b1, b2, b3, b4, b5, b6, b7, C1, 8); } while (0)
    f32x16 pA0, pA1, pB0, pB1; u32x4 pw0, pw1, pw2, pw3;
#if PROBE_SEG
    unsigned long long pst_ = __builtin_readcyclecounter();
#define STAMP(k) do { const unsigned long long n_ = __builtin_readcyclecounter(); if ((k) == PROBE_SEG) S.acc += n_ - pst_; S.tot += n_ - pst_; pst_ = n_; } while (0)
#else
#define STAMP(k) do { } while (0)
#endif
    STREAM(2);
    SBAR();
    {
      const bf16x8 k00 = KF(0, 0), k01 = KF(0, 1), k10 = KF(1, 0), k11 = KF(1, 1), k20 = KF(2, 0), k21 = KF(2, 1), k30 = KF(3, 0), k31 = KF(3, 1);
      pA0 = __builtin_amdgcn_mfma_f32_32x32x16_bf16(k00, S.qr[0], negm, 0, 0, 0); pA1 = __builtin_amdgcn_mfma_f32_32x32x16_bf16(k01, S.qr[0], negm, 0, 0, 0);
      pA0 = __builtin_amdgcn_mfma_f32_32x32x16_bf16(k10, S.qr[1], pA0, 0, 0, 0); pA1 = __builtin_amdgcn_mfma_f32_32x32x16_bf16(k11, S.qr[1], pA1, 0, 0, 0);
      pA0 = __builtin_amdgcn_mfma_f32_32x32x16_bf16(k20, S.qr[2], pA0, 0, 0, 0); pA1 = __builtin_amdgcn_mfma_f32_32x32x16_bf16(k21, S.qr[2], pA1, 0, 0, 0);
      pA0 = __builtin_amdgcn_mfma_f32_32x32x16_bf16(k30, S.qr[3], pA0, 0, 0, 0); pA1 = __builtin_amdgcn_mfma_f32_32x32x16_bf16(k31, S.qr[3], pA1, 0, 0, 0); }
    NEAR(pA0, pA1, 0); DECIDE(pA0, pA1, true);
#pragma unroll
    for (int r = 0; r < 16; ++r) { pA0[r] = EX(pA0[r]); pA1[r] = EX(pA1[r]); }
    STEP_BAR();
    ROT();
#define STEP(C0, C1, P0, P1, t) do { SBAR(); STAMP(5); \
        STREAM((t) + 2); SBAR(); \
        PHASE_A(C0, C1, P0, P1); SBAR(); STAMP(1); \
        NEAR(C0, C1, (t)); SBAR(); STAMP(2); \
        PHASE_B(C0, C1, v0); DECIDE2(C0, C1); SBAR(); STAMP(3); \
        RESC(); STEP_BAR(); STAMP(4); ROT(); } while (0)
    int t = 1;
    for (; t + 2 < NT; t += 2) {
        STEP(pB0, pB1, pA0, pA1, t);
        STEP(pA0, pA1, pB0, pB1, t + 1);
    }
    SBAR(); STREAM(NT + 1); SBAR();
    PHASE_A(pB0, pB1, pA0, pA1);
    { const unsigned lq = (unsigned)((wid * QBLK + r32) * PITCH + hi * 8) * 2u;
#pragma unroll
      for (int d0 = 0; d0 < 4; ++d0) S.qr[d0] = bld8(R, lq + d0 * 32, nxt.qoff); }
    SBAR();
    NEAR(pB0, pB1, NT - 1); SBAR();
    PHASE_B(pB0, pB1, v0); DECIDE2(pB0, pB1);
    RESC();
    { float sacc = 0.f;
#pragma unroll
      for (int r = 0; r < 16; ++r) { sacc += pB0[r]; sacc += pB1[r]; }
      l_reg += sacc;
      pw0 = (u32x4){pk2(pB0[0], pB0[1]), pk2(pB0[2], pB0[3]), pk2(pB0[4], pB0[5]), pk2(pB0[6], pB0[7])}; pw1 = (u32x4){pk2(pB0[8], pB0[9]), pk2(pB0[10], pB0[11]), pk2(pB0[12], pB0[13]), pk2(pB0[14], pB0[15])};
      pw2 = (u32x4){pk2(pB1[0], pB1[1]), pk2(pB1[2], pB1[3]), pk2(pB1[4], pB1[5]), pk2(pB1[6], pB1[7])}; pw3 = (u32x4){pk2(pB1[8], pB1[9]), pk2(pB1[10], pB1[11]), pk2(pB1[12], pB1[13]), pk2(pB1[14], pB1[15])};
      SBAR(); pv_tile(o, vb0 + v1, PAF(0), PAF(1), PAF(2), PAF(3)); }
    asm volatile("s_waitcnt vmcnt(0)" ::: "memory");
    ROT(); S.ks = k0; S.vs = v1;
    { auto rr = __builtin_amdgcn_permlane32_swap(__float_as_uint(l_reg), __float_as_uint(l_reg), false, false); l_reg = __uint_as_float(rr[0]) + __uint_as_float(rr[1]); }
    int lane_e = (int)__builtin_amdgcn_mbcnt_hi(~0u, __builtin_amdgcn_mbcnt_lo(~0u, 0u)); asm volatile("" : "+v"(lane_e));
    const int r32e = lane_e & 31, hie = lane_e >> 5;
    if (hi == 0) li_l[r32] = l_reg; asm volatile("s_waitcnt lgkmcnt(0)" ::: "memory");
    float rli[16];
#pragma unroll
    for (int r = 0; r < 16; ++r) rli[r] = __builtin_amdgcn_rcpf(li_l[crow(r, hi)]);
    LAS unsigned* st = (LAS unsigned*)(lds + OFF_STASH + wid * 8192) + lane_e;
    if (cur.comp == 0) {
#pragma unroll
        for (int r = 0; r < 16; ++r) { st[(2 * r) * 64] = pk2(o[0][r] * rli[r], o[1][r] * rli[r]); st[(2 * r + 1) * 64] = pk2(o[2][r] * rli[r], o[3][r] * rli[r]); }
    } else {
        float ss[16];
#pragma unroll
        for (int r = 0; r < 16; ++r) { const unsigned u0 = st[(2 * r) * 64], u1 = st[(2 * r + 1) * 64];
            const float s2 = lam * rli[r];
            o[0][r] = bflo(u0) - s2 * o[0][r]; o[1][r] = bfhi(u0) - s2 * o[1][r]; o[2][r] = bflo(u1) - s2 * o[2][r]; o[3][r] = bfhi(u1) - s2 * o[3][r];
            ss[r] = (o[0][r] * o[0][r] + o[1][r] * o[1][r]) + (o[2][r] * o[2][r] + o[3][r] * o[3][r]); }
#pragma unroll
        for (int r = 0; r < 16; ++r) {
#pragma unroll
            for (int x = 1; x < 32; x <<= 1) ss[r] += __shfl_xor(ss[r], x);
            ss[r] = rsqrtf(ss[r] * (1.f / 128.f) + EPS) * 0.8f; }
        float gg[4];
#pragma unroll
        for (int d0 = 0; d0 < 4; ++d0) gg[d0] = gsub[d0 * 32 + r32e];
        bf16_t* Ow = cur.O + (size_t)(wid * QBLK) * DM;
#pragma unroll
        for (int r = 0; r < 16; ++r) { const int orow = crow(r, hie);
#pragma unroll
            for (int d0 = 0; d0 < 4; ++d0) { const float v = o[d0][r] * ss[r] * gg[d0]; const float vn = __shfl_xor(v, 1);
                if ((r32e & 1) == 0) *(unsigned*)(Ow + (size_t)orow * DM + d0 * 32 + r32e) = pk2(v, vn); } }
    }
    __syncthreads();
#undef RESC
#undef KBASE
#undef NEAR
#undef PIN
#undef EX
#undef MX3
#undef DECIDE
#undef DECIDE2
#undef KF
#undef GAPA
#undef PHASE_A
#undef TRRD
#undef VRD8
#undef VF
#undef PAF
#undef GAPB
#undef PV4
#undef LWAIT
#undef PHASE_B
#undef STEP
#undef STAMP
#undef ROT
#undef KNEXT
#undef VNEXT
#undef STREAM
#undef STEP_BAR
}
#undef DA_DMA16
#undef DA_STAGE
#undef DA_LANE_OFFS
}

constexpr int NWAVES = 8;
constexpr int N_LAUNCHES = MK_N_LAUNCHES;
constexpr int N_PHASES = 9;
static_assert(N_LAUNCHES == 1 || N_LAUNCHES == N_PHASES, "MK_N_LAUNCHES is 1 or 9");

constexpr size_t MiB = 1u << 20;
constexpr size_t WS_CTL = 0, CTL_ZERO_BYTES = 1 * MiB;
constexpr size_t WS_ETK = 1 * MiB, WS_GTK = 2 * MiB, WS_RSTDT = 3 * MiB, WS_SLOTTK = 4 * MiB, WS_TOKSLOT = 5 * MiB, WS_GATESLOT = 7 * MiB, WS_RSTDSLOT = 9 * MiB, WS_RBE = 11 * MiB;
constexpr size_t WS_WRHI = 12 * MiB, WS_WRLO = 12 * MiB + 65536, WS_KMB = 13 * MiB, WS_VMT = 14 * MiB;
constexpr size_t WS_WIN = 16 * MiB, WS_WOUT = 21 * MiB, WS_X1B = 24 * MiB, WS_X1Q = 152 * MiB;
constexpr size_t WS_BIG = 216 * MiB;
constexpr size_t WS_H = WS_BIG, WS_PROJ = WS_BIG + 128 * MiB, WS_MIX = WS_BIG + 448 * MiB;
constexpr size_t WS_ACTQ = WS_BIG, WS_Y = WS_BIG + 264 * MiB;
constexpr size_t WS_WGU = 792 * MiB, WS_WD = 856 * MiB;
constexpr size_t WS_RSTDX = 888 * MiB;
constexpr size_t WS_END = 889 * MiB;
static_assert(WS_MIX + (size_t)T * DM * 2 <= WS_WGU && WS_END <= 1024 * MiB, "d_ws map");
constexpr int CW_BAR = 4096, CW_COUNT = 1024, CW_CURSOR = 2048;
constexpr int RING_BYTES = 159744, LDSCTL_OFF = RING_BYTES, MISC_OFF = LDSCTL_OFF + 320, LDS_BYTES = 163840;
static_assert(dattn::LDS_BYTES <= RING_BYTES, "attention scratch");

#define XB_TMO      128
#define XB_XCNT(j)  (256  + 64 * (j))
#define XB_XSUB(j)  (1280 + 64 * (j))
#define XB_XGEN(j)  (2304 + 64 * (j))
#define XB_TOP      3328
#define XB_TOPGEN   3392
#define XCD_BAR_WORDS 3456
#define XB_SPIN_CAP (1u << 18)
__device__ __forceinline__ unsigned xb_ld(unsigned* p)              { return __hip_atomic_load(p, __ATOMIC_RELAXED, __HIP_MEMORY_SCOPE_AGENT); }
__device__ __forceinline__ unsigned xb_add(unsigned* p, unsigned v) { return __hip_atomic_fetch_add(p, v, __ATOMIC_RELAXED, __HIP_MEMORY_SCOPE_AGENT); }
__device__ __forceinline__ unsigned xb_xcc_id() { return (unsigned)__builtin_amdgcn_s_getreg((3 << 11) | 20) & 0xFu; }
#define XB_SPIN(cond, bar) do { unsigned _sp = 0; while (cond) { __builtin_amdgcn_s_sleep(1); \
    if ((++_sp & 255u) == 0u) { if (xb_ld(&(bar)[XB_TMO])) break; if (_sp > XB_SPIN_CAP) { atomicAdd(&(bar)[XB_TMO], 1u); break; } } } } while (0)
struct XcdBarrier { unsigned* bar; unsigned x; volatile LAS unsigned* st; };
__device__ __forceinline__ XcdBarrier xcd_barrier_post(unsigned* bar, volatile LAS unsigned* st) {
    XcdBarrier b; b.bar = bar; b.x = xb_xcc_id(); b.st = st;
    if (threadIdx.x == 0) (void)xb_add(&bar[XB_XCNT(b.x)], 1u);
    return b;
}
__device__ __forceinline__ void xcd_barrier_complete(unsigned* bar, unsigned x, unsigned& nloc, unsigned& nx) {
    const unsigned G = gridDim.x * gridDim.y * gridDim.z;
    unsigned sum, cnt, mine, sp = 0u;
    for (;;) {
        sum = 0u; cnt = 0u; mine = 0u;
#pragma unroll
        for (unsigned j = 0; j < 16; ++j) { const unsigned c = xb_ld(&bar[XB_XCNT(j)]); sum += c; cnt += (c > 0u) ? 1u : 0u; mine = (j == x) ? c : mine; }
        if (sum == G) break;
        __builtin_amdgcn_s_sleep(1);
        if ((++sp & 255u) == 0u) { if (xb_ld(&bar[XB_TMO])) break; if (sp > XB_SPIN_CAP) { atomicAdd(&bar[XB_TMO], 1u); break; } }
    }
    nloc = mine > 0u ? mine : 1u; nx = cnt > 0u ? cnt : 1u;
}
__device__ __forceinline__ void xcd_barrier(const XcdBarrier& b) {
    asm volatile("s_waitcnt vmcnt(0)" ::: "memory");
    __syncthreads();
    if (threadIdx.x == 0) {
        unsigned* bar = b.bar;
        __builtin_amdgcn_s_waitcnt(0);
        unsigned nloc = b.st[0], nx = b.st[1];
        if (nloc == 0u) { xcd_barrier_complete(bar, b.x, nloc, nx); b.st[0] = nloc; b.st[1] = nx; }
        const unsigned old = xb_add(&bar[XB_XSUB(b.x)], 1u);
        const unsigned gen = old / nloc;
        if (old + 1u == (gen + 1u) * nloc) {
            __builtin_amdgcn_fence(__ATOMIC_RELEASE, "agent");
            asm volatile("s_waitcnt vmcnt(0)" ::: "memory");
            const unsigned og = xb_add(&bar[XB_TOP], 1u);
            const unsigned tg = og / nx;
            if (og + 1u == (tg + 1u) * nx) xb_add(&bar[XB_TOPGEN], 1u);
            else XB_SPIN(xb_ld(&bar[XB_TOPGEN]) == tg, bar);
            __builtin_amdgcn_fence(__ATOMIC_ACQUIRE, "agent");
            xb_add(&bar[XB_XGEN(b.x)], 1u);
            asm volatile("s_waitcnt vmcnt(0)" ::: "memory");
        } else {
            XB_SPIN(xb_ld(&bar[XB_XGEN(b.x)]) == gen, bar);
            __builtin_amdgcn_fence(__ATOMIC_ACQUIRE, "agent");
            asm volatile("s_waitcnt vmcnt(0)" ::: "memory");
        }
    }
    __syncthreads();
}

struct Frame {
    LAS unsigned char* lds;
    volatile LAS unsigned* MISC;
    unsigned* ctl;
    int tid, lane, wave, vcu, G;
    float* out;
    unsigned char* ws;
};
struct Args { const float* in[19]; float* out; unsigned char* ws; int ph_lo, ph_hi; };
typedef const __attribute__((address_space(4))) Args* KArgs;
__device__ __forceinline__ KArgs kargs() { KArgs p = (KArgs)__builtin_amdgcn_kernarg_segment_ptr(); asm volatile("" : "+s"(p)); return p; }
enum { I_X = 0, I_MEM, I_RELB, I_ATTNG, I_WIN, I_CONVW, I_LAMQK, I_SUBG, I_MEMG, I_WMEMKV, I_WOUT, I_FFNG, I_RW, I_RB, I_WGU, I_BGU, I_WDN, I_BDN, I_FING };

template <bool GAIN, bool F8>
__device__ __forceinline__ void p0_transpose_item(const float* W, int K, int N, void* WTv, int k0, int n0, int drow0, const float* kgain, float scale, LAS float* scr, int lane) {
    float v[32];
    const float* wp = W + (size_t)(k0 + (lane >> 5)) * N + n0 + (lane & 31);
#pragma unroll
    for (int i = 0; i < 32; ++i) v[i] = wp[(size_t)(2 * i) * N];
    const int c = lane & 7;
    f32x4 g0 = {scale, scale, scale, scale}, g1 = g0;
    if constexpr (GAIN) { g0 = *(const f32x4*)(kgain + k0 + 8 * c) * scale; g1 = *(const f32x4*)(kgain + k0 + 8 * c + 4) * scale; }
#pragma unroll
    for (int i = 0; i < 32; ++i) scr[(2 * i + (lane >> 5)) * 33 + (lane & 31)] = v[i];
    LDS_WAIT(); asm volatile("" ::: "memory");
#pragma unroll
    for (int j = 0; j < 4; ++j) { const int n = (lane >> 3) + 8 * j; const LAS float* s = scr + (8 * c) * 33 + n;
        const float e0 = s[0 * 33] * g0[0], e1 = s[1 * 33] * g0[1], e2 = s[2 * 33] * g0[2], e3 = s[3 * 33] * g0[3], e4 = s[4 * 33] * g1[0], e5 = s[5 * 33] * g1[1], e6 = s[6 * 33] * g1[2], e7 = s[7 * 33] * g1[3];
        if constexpr (F8) { u32x2 o; o.x = pg8::pk4_fp8(e0, e1, e2, e3); o.y = pg8::pk4_fp8(e4, e5, e6, e7);
            *(u32x2*)((unsigned char*)WTv + (size_t)(drow0 + n) * K + k0 + 8 * c) = o; }
        else { u32x4 o; o.x = pk2(e0, e1); o.y = pk2(e2, e3); o.z = pk2(e4, e5); o.w = pk2(e6, e7);
            *(u32x4*)((bf16_t*)WTv + (size_t)(drow0 + n) * K + k0 + 8 * c) = o; } }
    LDS_WAIT(); asm volatile("" ::: "memory");
}
__device__ __forceinline__ void cast_row2_bf16_rstd(const float* xa, const float* xb, bf16_t* oa, bf16_t* ob, float* ra_out, float* rb_out, int lane) {
    const f32x4* ra = (const f32x4*)xa + lane; const f32x4* rb = (const f32x4*)xb + lane;
    f32x4 va[4], vb[4]; float sa = 0.f, sb = 0.f;
#pragma unroll
    for (int j = 0; j < 4; ++j) { va[j] = ra[64 * j]; vb[j] = rb[64 * j]; }
#pragma unroll
    for (int j = 0; j < 4; ++j) { sa += (va[j].x * va[j].x + va[j].y * va[j].y) + (va[j].z * va[j].z + va[j].w * va[j].w); sb += (vb[j].x * vb[j].x + vb[j].y * vb[j].y) + (vb[j].z * vb[j].z + vb[j].w * vb[j].w); }
    unsigned long long* pa = (unsigned long long*)oa + lane; unsigned long long* pb = (unsigned long long*)ob + lane;
#pragma unroll
    for (int j = 0; j < 4; ++j) {
        pa[64 * j] = (unsigned long long)pk2(va[j].x, va[j].y) | ((unsigned long long)pk2(va[j].z, va[j].w) << 32);
        pb[64 * j] = (unsigned long long)pk2(vb[j].x, vb[j].y) | ((unsigned long long)pk2(vb[j].z, vb[j].w) << 32); }
    const float rsa = rsqrtf(wave_sum(sa) * (1.f / DM) + EPS), rsb = rsqrtf(wave_sum(sb) * (1.f / DM) + EPS);
    if (lane == 0) { *ra_out = rsa; *rb_out = rsb; }
}
__device__ __forceinline__ void p0_kvm_tile(Frame& F, int tile, const float* mem, const float* mem_g, const float* w_memkv) {
    const int mt = tile >> 3, ntile = tile & 7, row0 = 64 * mt, col0 = 64 * ntile;
    const int mb = F.wave >> 1, nb0 = (F.wave & 1) * 2, ar = F.lane & 15, kq = F.lane >> 4;
    const float* arow = mem + (size_t)(row0 + mb * 16 + ar) * DM;
    f32x4 acc[2]; acc[0] = (f32x4){0.f, 0.f, 0.f, 0.f}; acc[1] = acc[0];
    float ss = 0.f;
    const float* wq = w_memkv + col0 + nb0 * 16 + ar;
#define KVM_LOAD(A0, A1, G0, G1, BV, k0_) do { const int kk_ = (k0_) + 8 * kq; A0 = *(const f32x4*)(arow + kk_); A1 = *(const f32x4*)(arow + kk_ + 4); G0 = *(const f32x4*)(mem_g + kk_); G1 = *(const f32x4*)(mem_g + kk_ + 4); \
        _Pragma("unroll") for (int nbi = 0; nbi < 2; ++nbi) _Pragma("unroll") for (int j = 0; j < 8; ++j) BV[nbi][j] = wq[(size_t)(kk_ + j) * 512 + nbi * 16]; } while (0)
#define KVM_MATH(A0, A1, G0, G1, BV) do { ss += (A0.x * A0.x + A0.y * A0.y) + (A0.z * A0.z + A0.w * A0.w) + (A1.x * A1.x + A1.y * A1.y) + (A1.z * A1.z + A1.w * A1.w); \
        const bf16x8 af = pack8(A0 * G0, A1 * G1); \
        _Pragma("unroll") for (int nbi = 0; nbi < 2; ++nbi) { const f32x4 b0 = {BV[nbi][0], BV[nbi][1], BV[nbi][2], BV[nbi][3]}, b1 = {BV[nbi][4], BV[nbi][5], BV[nbi][6], BV[nbi][7]}; \
            acc[nbi] = __builtin_amdgcn_mfma_f32_16x16x32_bf16(af, pack8(b0, b1), acc[nbi], 0, 0, 0); } } while (0)
    f32x4 ba0[4], ba1[4], bg0[4], bg1[4]; float bb[4][2][8];
#pragma unroll 1
    for (int k0 = 0; k0 < DM; k0 += 128) {
#pragma unroll
        for (int q = 0; q < 4; ++q) KVM_LOAD(ba0[q], ba1[q], bg0[q], bg1[q], bb[q], k0 + 32 * q);
#pragma unroll
        for (int q = 0; q < 4; ++q) KVM_MATH(ba0[q], ba1[q], bg0[q], bg1[q], bb[q]);
    }
#undef KVM_LOAD
#undef KVM_MATH
    ss += __shfl_xor(ss, 16); ss += __shfl_xor(ss, 32);
    const float rstd = rsqrtf(ss * (1.f / DM) + EPS);
    float rs[4];
#pragma unroll
    for (int j = 0; j < 4; ++j) rs[j] = __shfl(rstd, kq * 4 + j);
    bf16_t* kmb = (bf16_t*)(F.ws + WS_KMB); bf16_t* vmt = (bf16_t*)(F.ws + WS_VMT);
#pragma unroll
    for (int nbi = 0; nbi < 2; ++nbi) {
        const int gc = col0 + (nb0 + nbi) * 16 + ar, gr0 = row0 + mb * 16 + kq * 4;
        if (ntile < 4) {
#pragma unroll
            for (int j = 0; j < 4; ++j) kmb[(size_t)(gr0 + j) * 256 + gc] = (bf16_t)(pk2(acc[nbi][j] * rs[j], 0.f) & 0xffffu);
        } else {
            const int d = gc - 256, hm = d >> 6, dd = d & 63, b = gr0 >> 8, m = gr0 & 255;
            u32x2 w; w.x = pk2(acc[nbi][0] * rs[0], acc[nbi][1] * rs[1]); w.y = pk2(acc[nbi][2] * rs[2], acc[nbi][3] * rs[3]);
            *(u32x2*)(vmt + ((size_t)((b * 4 + hm) * 64 + dd)) * 256 + m) = w;
        }
    }
}
struct P0Tile { const float* src; unsigned char* dst; int gain; };
template <int N, int K>
__device__ __forceinline__ void p0_tile_load(const float* src, f32x4 (&v)[8], int tid) {
#pragma unroll
    for (int i = 0; i < 8; ++i) v[i] = *(const f32x4*)(src + (size_t)((tid >> 5) + 16 * i) * N + (tid & 31) * 4);
}
__device__ __forceinline__ void p0_tile_to_lds(LAS float* tl, const f32x4 (&v)[8], int tid) {
#pragma unroll
    for (int i = 0; i < 8; ++i) { const int k = (tid >> 5) + 16 * i, c = ((tid & 31) * 4) ^ (((k >> 4) & 7) << 2); *(LAS f32x4*)(tl + k * 132 + c) = v[i]; }
}
template <int K, bool GAIN>
__device__ __forceinline__ void p0_tile_store(const LAS float* tl, unsigned char* dst, const float* kgain, float scale, int tid) {
    const int run = tid & 7;
    f32x4 g[4];
#pragma unroll
    for (int q = 0; q < 4; ++q) { g[q] = (f32x4){scale, scale, scale, scale}; if constexpr (GAIN) g[q] = *(const f32x4*)(kgain + run * 16 + 4 * q) * scale; }
#pragma unroll
    for (int p = 0; p < 2; ++p) { const int n = (tid >> 3) + 64 * p; const LAS float* s = tl + (run * 16) * 132 + (n ^ (run << 2));
        u32x4 o;
#pragma unroll
        for (int q = 0; q < 4; ++q) o[q] = pg8::pk4_fp8(s[(4 * q) * 132] * g[q][0], s[(4 * q + 1) * 132] * g[q][1], s[(4 * q + 2) * 132] * g[q][2], s[(4 * q + 3) * 132] * g[q][3]);
        *(u32x4*)(dst + (size_t)n * K + run * 16) = o; }
}
__device__ __forceinline__ void p0_prologue(Frame& F) {
    KArgs A = kargs();
    { const float* mem = A->in[I_MEM]; const float* mem_g = A->in[I_MEMG]; const float* w_memkv = A->in[I_WMEMKV];
      for (int rep2_ = 0; rep2_ < ((PROBE_P0 & 4) ? 2 : 1); ++rep2_)
      for (int tile = blockIdx.x; tile < 256; tile += F.G) p0_kvm_tile(F, tile, mem, mem_g, w_memkv); }
    const float* attn_g = A->in[I_ATTNG];
    const float* w_in = A->in[I_WIN]; const float* w_out = A->in[I_WOUT]; const float* w_gu = A->in[I_WGU]; const float* w_dn = A->in[I_WDN]; const float* ffn_g = A->in[I_FFNG];
    LAS float* scr = (LAS float*)(F.lds + F.wave * 16384);
    const int gw = F.vcu * NWAVES + F.wave, NGW = F.G * NWAVES;
    bf16_t* Win_t = (bf16_t*)(F.ws + WS_WIN); bf16_t* Wout_t = (bf16_t*)(F.ws + WS_WOUT);
    unsigned char* Wgu_q = F.ws + WS_WGU; unsigned char* Wd_q = F.ws + WS_WD;
    constexpr int I_IN = 16 * 80, I_OUT = 16 * 32, NITEMS = I_IN + I_OUT;
    for (int rep0_ = 0; rep0_ < ((PROBE_P0 & 1) ? 2 : 1); ++rep0_)
    for (int it = gw; it < NITEMS; it += NGW) {
        int r = it;
        if (r < I_IN) { const int kb = r / 80, nb = r % 80; p0_transpose_item<true, false>(w_in, DM, INW, Win_t, 64 * kb, 32 * nb, 32 * nb, attn_g, 1.f, scr, F.lane); continue; } r -= I_IN;
        if (r < I_OUT) { const int kb = r / 32, nb = r % 32; p0_transpose_item<false, false>(w_out, DM, DM, Wout_t, 64 * kb, 32 * nb, 32 * nb, nullptr, 1.f, scr, F.lane); continue; } r -= I_OUT;
    }
    { __syncthreads();
      LAS float* tl = (LAS float*)F.lds; const int tid = F.tid;
      constexpr int T_GU = NEXP * 8 * 16, T_DN = NEXP * 8 * 8, T_ALL = T_GU + T_DN;
#define P0_TILE(ti, SRC, DST, ISGU) do { int r_ = (ti); ISGU = r_ < T_GU; if (ISGU) { const int e = r_ >> 7, q = r_ & 127, kt = q >> 4, nt = q & 15, n0 = nt * 128, jj = n0 & 1023; \
            SRC = w_gu + (size_t)e * DM * 2048 + (size_t)(kt * 128) * 2048 + n0; DST = Wgu_q + (size_t)e * 2048 * DM + (size_t)((jj >> 7) * 256 + (n0 >= 1024 ? 128 : 0)) * DM + kt * 128; } \
          else { r_ -= T_GU; const int e = r_ >> 6, q = r_ & 63, kt = q >> 3, nt = q & 7; \
            SRC = w_dn + (size_t)e * DEXP * DM + (size_t)(kt * 128) * DM + nt * 128; DST = Wd_q + (size_t)e * DM * DEXP + (size_t)(nt * 128) * DEXP + kt * 128; } } while (0)
      f32x4 v[8]; const float* src; unsigned char* dst; bool isgu; const float* srcn; unsigned char* dstn; bool isgun;
      int ti = blockIdx.x;
      if (ti < T_ALL) { P0_TILE(ti, src, dst, isgu); if (isgu) p0_tile_load<2048, DM>(src, v, tid); else p0_tile_load<DM, DEXP>(src, v, tid); }
      for (; ti < T_ALL; ti += F.G) {
          p0_tile_to_lds(tl, v, tid);
          __syncthreads();
          const int tn = ti + F.G;
          if (tn < T_ALL) { P0_TILE(tn, srcn, dstn, isgun); if (isgun) p0_tile_load<2048, DM>(srcn, v, tid); else p0_tile_load<DM, DEXP>(srcn, v, tid); }
          if (isgu) { const int kt_ = (int)(((size_t)(dst - Wgu_q)) & (DM - 1)); p0_tile_store<DM, true>(tl, dst, ffn_g + kt_, 64.f, tid); }
          else p0_tile_store<DEXP, false>(tl, dst, nullptr, 64.f, tid);
          __syncthreads();
          src = srcn; dst = dstn; isgu = isgun;
      }
#undef P0_TILE
    }
    bf16_t* H = (bf16_t*)(F.ws + WS_H);
    { const float* x = A->in[I_X]; float* rstd_x = (float*)(F.ws + WS_RSTDX);
      for (int rep1_ = 0; rep1_ < ((PROBE_P0 & 2) ? 2 : 1); ++rep1_)
      for (int m = gw; m < T; m += 2 * NGW) { const int m2 = (m + NGW < T) ? m + NGW : m;
          cast_row2_bf16_rstd(x + (size_t)m * DM, x + (size_t)m2 * DM, H + (size_t)m * DM, H + (size_t)m2 * DM, rstd_x + m, rstd_x + m2, F.lane); } }
    const float* router_w = A->in[I_RW];
    bf16_t* wrh = (bf16_t*)(F.ws + WS_WRHI); bf16_t* wrl = (bf16_t*)(F.ws + WS_WRLO);
    for (int i = (F.vcu * NWAVES + F.wave) * 64 + F.lane; i < NEXP * DM; i += NGW * 64) { const int e = i >> 10, k = i & 1023;
        const float v = ffn_g[k] * router_w[(size_t)k * NEXP + e]; const unsigned hb = pk2(v, 0.f) & 0xffffu; const float hf = __uint_as_float(hb << 16);
        wrh[i] = (bf16_t)hb; wrl[i] = (bf16_t)(pk2(v - hf, 0.f) & 0xffffu); }
}

__device__ __forceinline__ void p2_conv_block(Frame& F, int blk, int tid_, const float* conv_w) {
    const bf16_t* proj = (const bf16_t*)(F.ws + WS_PROJ); bf16_t* mix = (bf16_t*)(F.ws + WS_MIX);
    const int cg = tid_ & 31, tc = tid_ >> 5;
    const int c0 = cg * 8, t0 = blk * 256 + tc * 16, s0 = t0 & (SEQ - 1);
    float w0[8], w1[8], w2[8];
#pragma unroll
    for (int i = 0; i < 8; ++i) { w0[i] = conv_w[c0 + i]; w1[i] = conv_w[256 + c0 + i]; w2[i] = conv_w[512 + c0 + i]; }
    float p2[8], p1[8];
#pragma unroll
    for (int i = 0; i < 8; ++i) { p2[i] = 0.f; p1[i] = 0.f; }
    if (s0 >= 2) {
        const u32x4 ua = *(const u32x4*)(proj + (size_t)(t0 - 2) * INW + COL_U + c0), ca = *(const u32x4*)(proj + (size_t)(t0 - 2) * INW + COL_GC + c0);
        const u32x4 ub = *(const u32x4*)(proj + (size_t)(t0 - 1) * INW + COL_U + c0), cb = *(const u32x4*)(proj + (size_t)(t0 - 1) * INW + COL_GC + c0);
#pragma unroll
        for (int i = 0; i < 4; ++i) { p2[2 * i] = bflo(ua[i]) * bflo(ca[i]); p2[2 * i + 1] = bfhi(ua[i]) * bfhi(ca[i]); p1[2 * i] = bflo(ub[i]) * bflo(cb[i]); p1[2 * i + 1] = bfhi(ub[i]) * bfhi(cb[i]); }
    }
    for (int tb = 0; tb < 16; tb += 4) {
        u32x4 uu[4], cc[4], bb[4];
#pragma unroll
        for (int q = 0; q < 4; ++q) { const size_t ro = (size_t)(t0 + tb + q) * INW;
            uu[q] = *(const u32x4*)(proj + ro + COL_U + c0); cc[q] = *(const u32x4*)(proj + ro + COL_GC + c0); bb[q] = *(const u32x4*)(proj + ro + COL_GB + c0); }
#pragma unroll
        for (int q = 0; q < 4; ++q) {
            float cur[8], y[8];
#pragma unroll
            for (int i = 0; i < 4; ++i) { cur[2 * i] = bflo(uu[q][i]) * bflo(cc[q][i]); cur[2 * i + 1] = bfhi(uu[q][i]) * bfhi(cc[q][i]); }
#pragma unroll
            for (int i = 0; i < 4; ++i) { y[2 * i] = bflo(bb[q][i]) * (w0[2 * i] * p2[2 * i] + w1[2 * i] * p1[2 * i] + w2[2 * i] * cur[2 * i]);
                                           y[2 * i + 1] = bfhi(bb[q][i]) * (w0[2 * i + 1] * p2[2 * i + 1] + w1[2 * i + 1] * p1[2 * i + 1] + w2[2 * i + 1] * cur[2 * i + 1]); }
            u32x4 o; o.x = pk2(y[0], y[1]); o.y = pk2(y[2], y[3]); o.z = pk2(y[4], y[5]); o.w = pk2(y[6], y[7]);
            *(u32x4*)(mix + (size_t)(t0 + tb + q) * DM + c0) = o;
#pragma unroll
            for (int i = 0; i < 8; ++i) { p2[i] = p1[i]; p1[i] = cur[i]; }
        }
    }
}
__device__ __forceinline__ void p2_mem_block(Frame& F, int blk, int lane_) {
    const bf16_t* proj = (const bf16_t*)(F.ws + WS_PROJ); bf16_t* mix = (bf16_t*)(F.ws + WS_MIX);
    const bf16_t* kmb = (const bf16_t*)(F.ws + WS_KMB); const bf16_t* vmt = (const bf16_t*)(F.ws + WS_VMT);
    const int r32 = lane_ & 31, hi = lane_ >> 5, b = blk >> 5, tw = blk * 256 + F.wave * 32, tid_ = F.wave * 64 + lane_;
    LAS unsigned char* Kl = F.lds; LAS unsigned char* Vl = F.lds + 32768;
    const int ksw = (r32 >> 1) & 7;
    u32x4 kv[4], vv[4];
#define MEM_LOAD(hm_) do { _Pragma("unroll") for (int i = 0; i < 4; ++i) { const int idx = tid_ + 512 * i; \
        kv[i] = *(const u32x4*)(kmb + (size_t)(b * 256 + (idx >> 3)) * 256 + (hm_) * 64 + (idx & 7) * 8); \
        vv[i] = *(const u32x4*)(vmt + ((size_t)((b * 4 + (hm_)) * 64 + (idx >> 5))) * 256 + (idx & 31) * 8); } } while (0)
    MEM_LOAD(0);
    for (int hm = 0; hm < 4; ++hm) {
        bf16x8 qr[4];
#pragma unroll
        for (int d0 = 0; d0 < 4; ++d0) qr[d0] = *(const bf16x8*)(proj + (size_t)(tw + r32) * INW + COL_QM + hm * 64 + d0 * 16 + hi * 8);
        __syncthreads();
#pragma unroll
        for (int i = 0; i < 4; ++i) { const int idx = tid_ + 512 * i; const int kr = idx >> 3, kc = idx & 7, vd = idx >> 5, vc = idx & 31;
            *(LAS u32x4*)(Kl + kr * 128 + ((kc ^ ((kr >> 1) & 7)) << 4)) = kv[i];
            *(LAS u32x4*)(Vl + vd * 512 + ((vc ^ (vd & 31)) << 4)) = vv[i]; }
        __syncthreads();
        if (hm < 3) MEM_LOAD(hm + 1);
        float mx = -__builtin_inff();
#pragma unroll 2
        for (int kb = 0; kb < 8; ++kb) { f32x16 p = f32x16{};
#pragma unroll
            for (int d0 = 0; d0 < 4; ++d0) { const bf16x8 kf = *(const LAS bf16x8*)(Kl + (kb * 32 + r32) * 128 + (((2 * d0 + hi) ^ ksw) << 4));
                p = __builtin_amdgcn_mfma_f32_32x32x16_bf16(kf, qr[d0], p, 0, 0, 0); }
#pragma unroll
            for (int r = 0; r < 16; ++r) mx = fmaxf(mx, p[r]); }
        mx = fmaxf(mx, __shfl_xor(mx, 32));
        float sum = 0.f;
        f32x16 o[2]; o[0] = f32x16{}; o[1] = f32x16{};
#pragma unroll 2
        for (int kb = 0; kb < 8; ++kb) { f32x16 p = f32x16{};
#pragma unroll
            for (int d0 = 0; d0 < 4; ++d0) { const bf16x8 kf = *(const LAS bf16x8*)(Kl + (kb * 32 + r32) * 128 + (((2 * d0 + hi) ^ ksw) << 4));
                p = __builtin_amdgcn_mfma_f32_32x32x16_bf16(kf, qr[d0], p, 0, 0, 0); }
#pragma unroll
            for (int r = 0; r < 16; ++r) { p[r] = __builtin_amdgcn_exp2f(p[r] - mx); sum += p[r]; }
            bf16x8 pa0, pa1;
#define PK4(P, B_, OUT) do { unsigned a0 = pk2(P[B_+0], P[B_+1]), a1 = pk2(P[B_+2], P[B_+3]); unsigned b0 = pk2(P[B_+4], P[B_+5]), b1 = pk2(P[B_+6], P[B_+7]); \
        auto r0 = __builtin_amdgcn_permlane32_swap(a0, b0, false, false); auto r1 = __builtin_amdgcn_permlane32_swap(a1, b1, false, false); \
        u32x4 w = {r0[0], r1[0], r0[1], r1[1]}; OUT = __builtin_bit_cast(bf16x8, w); } while (0)
            PK4(p, 0, pa0); PK4(p, 8, pa1);
#undef PK4
#pragma unroll
            for (int d0 = 0; d0 < 2; ++d0) { const LAS unsigned char* vrow = Vl + (d0 * 32 + r32) * 512;
                const bf16x8 v0 = *(const LAS bf16x8*)(vrow + (((kb * 4 + hi) ^ r32) << 4)), v1 = *(const LAS bf16x8*)(vrow + (((kb * 4 + 2 + hi) ^ r32) << 4));
                o[d0] = __builtin_amdgcn_mfma_f32_32x32x16_bf16(pa0, v0, o[d0], 0, 0, 0);
                o[d0] = __builtin_amdgcn_mfma_f32_32x32x16_bf16(pa1, v1, o[d0], 0, 0, 0); }
        }
        sum += __shfl_xor(sum, 32);
        const float linv = __builtin_amdgcn_rcpf(sum);
#pragma unroll
        for (int r = 0; r < 16; ++r) { const int orow = crow(r, hi); const float li = __shfl(linv, orow);
#pragma unroll
            for (int d0 = 0; d0 < 2; ++d0) { const float v = o[d0][r] * li; const float vn = __shfl_xor(v, 1);
                if ((r32 & 1) == 0) *(unsigned*)(mix + (size_t)(tw + orow) * DM + 768 + hm * 64 + d0 * 32 + r32) = pk2(v, vn); } }
    }
#undef MEM_LOAD
    __syncthreads();
}
__device__ __forceinline__ dattn::Ref da_ref(Frame& F, int n) {
    const int pid = F.vcu + (n >> 2) * F.G, sub = n & 3, blk = sub >> 1, comp = sub & 1, bh = pid >> 4, s = pid & 15, qb = blk ? 31 - s : s, b = bh >> 2, h = bh & 3;
    bf16_t* mix = (bf16_t*)(F.ws + WS_MIX);
    dattn::Ref r;
    r.qoff = (unsigned)(((size_t)(b * SEQ + qb * 256) * INW + COL_Q + h * 128 + comp * 64) * 2);
    r.koff = (unsigned)(((size_t)(b * SEQ) * INW + COL_K + h * 128 + comp * 64) * 2);
    r.voff = (unsigned)(((size_t)(b * SEQ) * INW + COL_V + h * 128) * 2);
    r.O = mix + (size_t)(b * SEQ + qb * 256) * DM + 256 + h * 128;
    r.P0 = qb * 256; r.comp = comp; r.h = h;
    return r;
}
__device__ __forceinline__ void p2_mixers(Frame& F) {
    KArgs A = kargs();
    const float* rel_bias = A->in[I_RELB]; const float* lam_qk = A->in[I_LAMQK]; const float* subln_g = A->in[I_SUBG];
    if (F.tid < 512) { const int h = F.tid >> 7, n = F.tid & 127; int bk;
        if (n < 16) bk = n; else { bk = 16; const int thr[15] = {19, 21, 24, 27, 31, 35, 40, 46, 52, 59, 67, 77, 87, 99, 113};
#pragma unroll
            for (int i = 0; i < 15; ++i) bk += (n >= thr[i]) ? 1 : 0; }
        ((LAS float*)(F.lds + dattn::OFF_TB))[h * 128 + n] = (rel_bias[bk * 4 + h] - rel_bias[31 * 4 + h]) * LOG2E; }
    float d1 = 0.f, d2 = 0.f;
    for (int i = 0; i < 64; ++i) { d1 += lam_qk[i] * lam_qk[64 + i]; d2 += lam_qk[128 + i] * lam_qk[192 + i]; }
    const float lam = __expf(d1) - __expf(d2) + 0.2f;
    if (__builtin_amdgcn_readfirstlane(F.tid) >= 256) __builtin_amdgcn_s_setprio(1);
    __syncthreads();
    const int npairs = F.vcu < 512 ? (512 - F.vcu + F.G - 1) / F.G : 0, total1 = 4 * npairs, total = ((PROBE_REP >> 2) & 1) ? 2 * total1 : total1;
#if PROBE_CLK
    const unsigned long long pc0_ = __builtin_readcyclecounter(), pr0_ = __builtin_amdgcn_s_memrealtime();
#endif
    if (total > 0) {
        dattn::Seam S; dattn::Ref cur = da_ref(F, 0);
#if PROBE_SEG
        S.acc = 0; S.tot = 0;
#endif
        const dattn::rsrc_t R = __builtin_amdgcn_make_buffer_rsrc((void*)(F.ws + WS_PROJ), 0, (int)((size_t)T * INW * 2), 0x00020000);
        const char* projb = (const char*)(F.ws + WS_PROJ);
        dattn::prime(cur, F.lds, S, R, projb);
        for (int n = 0; n < total; ++n) {
            const dattn::Ref nxt = (n + 1 < total) ? da_ref(F, (n + 1) % total1) : cur;
            dattn::block(cur, nxt, F.lds, S, lam, subln_g, R, projb);
            cur = nxt;
        }
#if PROBE_SEG
        if (blockIdx.x == 0 && F.tid == 0) { F.ctl[604] = (unsigned)(S.acc >> 4); F.ctl[605] = (unsigned)(S.tot >> 4); }
#endif
    }
#if PROBE_CLK
    if (blockIdx.x == 0 && F.tid == 0) { const unsigned long long dc_ = __builtin_readcyclecounter() - pc0_, dr_ = __builtin_amdgcn_s_memrealtime() - pr0_;
        F.ctl[600] = (unsigned)dc_; F.ctl[601] = (unsigned)(dc_ >> 32); F.ctl[602] = (unsigned)dr_; }
#endif
    __builtin_amdgcn_s_setprio(0);
    int lane2 = (int)__builtin_amdgcn_mbcnt_hi(~0u, __builtin_amdgcn_mbcnt_lo(~0u, 0u)); asm volatile("" : "+v"(lane2));
    const int tid2 = F.wave * 64 + lane2;
    const float* conv_w = kargs()->in[I_CONVW];
    for (int repx_ = 0; repx_ < ((PROBE_X & 1) ? 2 : 1); ++repx_)
    for (int blk = blockIdx.x; blk < T / 256; blk += F.G) { p2_conv_block(F, blk, tid2, conv_w); p2_mem_block(F, blk, lane2); }
}

__device__ __forceinline__ void p4_router(Frame& F, bool dry = false) {
    const float* router_b = kargs()->in[I_RB];
    const bf16_t* x1b = (const bf16_t*)(F.ws + WS_X1B); const bf16_t* wrh = (const bf16_t*)(F.ws + WS_WRHI); const bf16_t* wrl = (const bf16_t*)(F.ws + WS_WRLO);
    int* e_tk = (int*)(F.ws + WS_ETK); float* g_tk = (float*)(F.ws + WS_GTK); float* rstd_t = (float*)(F.ws + WS_RSTDT);
    LAS float* lg = (LAS float*)F.lds + F.wave * (32 * 33); LAS unsigned* hist = (LAS unsigned*)(F.lds + 131072);
    LAS unsigned char* imgh = F.lds; LAS unsigned char* imgl = F.lds + 65536;
    const int r32 = F.lane & 31, hi = F.lane >> 5;
    for (int blk = blockIdx.x; blk < T / 256; blk += F.G) {
        if (F.tid < 32) hist[F.tid] = 0u;
        { u32x4 wv[16];
#pragma unroll
          for (int i = 0; i < 8; ++i) { const int idx = F.tid + 512 * i; wv[i] = *(const u32x4*)(wrh + (size_t)idx * 8); wv[8 + i] = *(const u32x4*)(wrl + (size_t)idx * 8); }
#pragma unroll
          for (int i = 0; i < 8; ++i) { const int idx = F.tid + 512 * i, row = idx >> 7, c = idx & 127; const int off = row * 2048 + ((c ^ row) << 4);
              *(LAS u32x4*)(imgh + off) = wv[i]; *(LAS u32x4*)(imgl + off) = wv[8 + i]; } }
        __syncthreads();
        const int t0 = blk * 256 + F.wave * 32;
        const bf16_t* xr = x1b + (size_t)(t0 + r32) * DM + hi * 8;
        const LAS unsigned char* fh = imgh + r32 * 2048; const LAS unsigned char* fl = imgl + r32 * 2048;
        f32x16 acc = f32x16{}; float ss = 0.f;
#pragma unroll 1
        for (int kq = 0; kq < DM; kq += 256) {
            u32x4 xw[16];
#pragma unroll
            for (int s_ = 0; s_ < 16; ++s_) xw[s_] = *(const u32x4*)(xr + kq + s_ * 16);
            SBAR();
#pragma unroll
            for (int sb = 0; sb < 16; sb += 4) { bf16x8 ah[4], al[4];
#pragma unroll
                for (int s_ = 0; s_ < 4; ++s_) { const int c = ((kq >> 3) + 2 * (sb + s_) + hi) ^ r32; ah[s_] = *(const LAS bf16x8*)(fh + (c << 4)); al[s_] = *(const LAS bf16x8*)(fl + (c << 4)); }
#pragma unroll
                for (int s_ = 0; s_ < 4; ++s_) { const u32x4 xv = xw[sb + s_];
#pragma unroll
                    for (int i = 0; i < 4; ++i) { const float a = bflo(xv[i]), b2 = bfhi(xv[i]); ss += a * a + b2 * b2; }
                    const bf16x8 xb = __builtin_bit_cast(bf16x8, xv);
                    acc = __builtin_amdgcn_mfma_f32_32x32x16_bf16(ah[s_], xb, acc, 0, 0, 0);
                    acc = __builtin_amdgcn_mfma_f32_32x32x16_bf16(al[s_], xb, acc, 0, 0, 0); } }
        }
        __syncthreads();
        ss += __shfl_xor(ss, 32);
        const float rstd = rsqrtf(ss * (1.f / DM) + EPS);
#pragma unroll
        for (int r = 0; r < 16; ++r) { const int e = crow(r, hi); lg[r32 * 33 + e] = acc[r] * rstd + router_b[e]; }
        LDS_WAIT(); asm volatile("" ::: "memory");
        if (F.lane < 32) {
            LAS float* row = lg + F.lane * 33; float tv[4]; int ti[4];
#pragma unroll
            for (int p = 0; p < 4; ++p) { float best = -__builtin_inff(); int bi = 0;
                for (int e = 0; e < NEXP; ++e) { const float v = row[e]; if (v > best) { best = v; bi = e; } }
                tv[p] = best; ti[p] = bi; row[bi] = -__builtin_inff(); LDS_WAIT(); asm volatile("" ::: "memory"); }
            const float w1 = __expf(tv[1] - tv[0]), w2 = __expf(tv[2] - tv[0]), w3 = __expf(tv[3] - tv[0]); const float inv = 1.f / (1.f + w1 + w2 + w3);
            const int t = t0 + F.lane;
            if (!dry) {
            *(int4*)(e_tk + (size_t)t * 4) = make_int4(ti[0], ti[1], ti[2], ti[3]);
            *(float4*)(g_tk + (size_t)t * 4) = make_float4(inv, w1 * inv, w2 * inv, w3 * inv);
            rstd_t[t] = rstd;
#pragma unroll
            for (int p = 0; p < 4; ++p) __hip_atomic_fetch_add(&hist[ti[p]], 1u, __ATOMIC_RELAXED, __HIP_MEMORY_SCOPE_WORKGROUP);
            }
        }
        __syncthreads();
        if (F.tid < 32) __hip_atomic_fetch_add(F.ctl + CW_COUNT + F.tid, hist[F.tid], RLX_AGENT);
        __syncthreads();
    }
}
__device__ __forceinline__ void p5_place(Frame& F) {
    const int* e_tk = (const int*)(F.ws + WS_ETK); const float* g_tk = (const float*)(F.ws + WS_GTK); const float* rstd_t = (const float*)(F.ws + WS_RSTDT);
    int* slot_tk = (int*)(F.ws + WS_SLOTTK); int* tok_slot = (int*)(F.ws + WS_TOKSLOT); float* gate_slot = (float*)(F.ws + WS_GATESLOT); float* rstd_slot = (float*)(F.ws + WS_RSTDSLOT);
    int* rb_e = (int*)(F.ws + WS_RBE);
    LAS int* L = (LAS int*)F.lds;
    if (F.tid < 32) { const int c = (int)__hip_atomic_load(F.ctl + CW_COUNT + F.tid, RLX_AGENT); L[F.tid] = c; L[32 + F.tid] = (c + 255) & ~255; }
    __syncthreads();
    if (F.tid < 32) { int s = 0; for (int e = 0; e < F.tid; ++e) s += L[32 + e]; L[64 + F.tid] = s; }
    __syncthreads();
    for (int blk = blockIdx.x; blk < T / 256; blk += F.G) {
        if (F.tid < 32) { L[96 + F.tid] = 0; L[128 + F.tid] = 0; }
        __syncthreads();
        int ee[2];
#pragma unroll
        for (int j = 0; j < 2; ++j) { const int i = F.tid + 512 * j; ee[j] = e_tk[(size_t)blk * 1024 + i]; __hip_atomic_fetch_add(&L[96 + ee[j]], 1, __ATOMIC_RELAXED, __HIP_MEMORY_SCOPE_WORKGROUP); }
        __syncthreads();
        if (F.tid < 32) L[160 + F.tid] = L[64 + F.tid] + (int)__hip_atomic_fetch_add(F.ctl + CW_CURSOR + F.tid, (unsigned)L[96 + F.tid], RLX_AGENT);
        __syncthreads();
#pragma unroll
        for (int j = 0; j < 2; ++j) { const int i = F.tid + 512 * j; const int r = __hip_atomic_fetch_add(&L[128 + ee[j]], 1, __ATOMIC_RELAXED, __HIP_MEMORY_SCOPE_WORKGROUP); const int pos = L[160 + ee[j]] + r;
            const int t = blk * 256 + (i >> 2);
            tok_slot[pos] = t; gate_slot[pos] = g_tk[(size_t)blk * 1024 + i]; rstd_slot[pos] = rstd_t[t]; slot_tk[(size_t)blk * 1024 + i] = pos; }
        __syncthreads();
    }
    for (int e = blockIdx.x; e < NEXP; e += F.G)
        for (int i = L[e] + F.tid; i < L[32 + e]; i += NWAVES * 64) { const int pos = L[64 + e] + i; tok_slot[pos] = 0; gate_slot[pos] = 0.f; rstd_slot[pos] = 0.f; }
    if (blockIdx.x == 0) {
        const int nrb = (L[64 + 31] + L[32 + 31]) >> 8;
        for (int rb = F.tid; rb < NRB_MAX; rb += NWAVES * 64) { int e = 31; for (int q = 0; q < 32; ++q) { if (rb * 256 >= L[64 + q] && rb * 256 < L[64 + q] + L[32 + q]) e = q; } rb_e[rb] = e; }
        if (F.tid == 0) rb_e[NRB_MAX] = nrb;
    }
}
__device__ __forceinline__ void p9_final(Frame& F) {
    const bf16_t* x1b = (const bf16_t*)(F.ws + WS_X1B); const int* slot_tk = (const int*)(F.ws + WS_SLOTTK);
    const unsigned char* Y = F.ws + WS_Y;
    const int gw = F.vcu * NWAVES + F.wave, NGW = F.G * NWAVES;
    const float* final_g = kargs()->in[I_FING];
    f32x4 gg[2][2];
#pragma unroll
    for (int j = 0; j < 2; ++j) { gg[j][0] = *(const f32x4*)(final_g + 8 * F.lane + 512 * j); gg[j][1] = *(const f32x4*)(final_g + 8 * F.lane + 512 * j + 4); }
    int4 slA = make_int4(0, 0, 0, 0), slB = slA;
    if (gw < T) { slA = *(const int4*)(slot_tk + (size_t)gw * 4); const int tb0 = (gw + NGW < T) ? gw + NGW : gw; slB = *(const int4*)(slot_tk + (size_t)tb0 * 4); }
    for (int t = gw; t < T; t += 2 * NGW) {
        const int tA = t, tB = (t + NGW < T) ? t + NGW : t;
        const int tnA = (t + 2 * NGW < T) ? t + 2 * NGW : tA, tnB = (t + 3 * NGW < T) ? t + 3 * NGW : tnA;
        const int4 nA = *(const int4*)(slot_tk + (size_t)tnA * 4), nB = *(const int4*)(slot_tk + (size_t)tnB * 4);
        const int sA[4] = {slA.x, slA.y, slA.z, slA.w}, sB[4] = {slB.x, slB.y, slB.z, slB.w};
        u32x4 xa[2], xb[2]; u32x2 ya[2][4], yb[2][4];
#pragma unroll
        for (int j = 0; j < 2; ++j) { const int c = 8 * F.lane + 512 * j;
            xa[j] = *(const u32x4*)(x1b + (size_t)tA * DM + c); xb[j] = *(const u32x4*)(x1b + (size_t)tB * DM + c);
#pragma unroll
            for (int k = 0; k < 4; ++k) { ya[j][k] = *(const u32x2*)(Y + (size_t)sA[k] * DM + c); yb[j][k] = *(const u32x2*)(Y + (size_t)sB[k] * DM + c); } }
        float va[2][8], vb[2][8]; float ssa = 0.f, ssb = 0.f;
#pragma unroll
        for (int j = 0; j < 2; ++j) {
#pragma unroll
            for (int i = 0; i < 4; ++i) { va[j][2 * i] = bflo(xa[j][i]); va[j][2 * i + 1] = bfhi(xa[j][i]); vb[j][2 * i] = bflo(xb[j][i]); vb[j][2 * i + 1] = bfhi(xb[j][i]); }
#pragma unroll
            for (int k = 0; k < 4; ++k)
#pragma unroll
                for (int w_ = 0; w_ < 2; ++w_) { const f32x2_t a0 = __builtin_amdgcn_cvt_pk_f32_fp8((int)ya[j][k][w_], false), a1 = __builtin_amdgcn_cvt_pk_f32_fp8((int)ya[j][k][w_], true);
                    const f32x2_t b0 = __builtin_amdgcn_cvt_pk_f32_fp8((int)yb[j][k][w_], false), b1 = __builtin_amdgcn_cvt_pk_f32_fp8((int)yb[j][k][w_], true);
                    va[j][4 * w_] += 0.125f * a0[0]; va[j][4 * w_ + 1] += 0.125f * a0[1]; va[j][4 * w_ + 2] += 0.125f * a1[0]; va[j][4 * w_ + 3] += 0.125f * a1[1];
                    vb[j][4 * w_] += 0.125f * b0[0]; vb[j][4 * w_ + 1] += 0.125f * b0[1]; vb[j][4 * w_ + 2] += 0.125f * b1[0]; vb[j][4 * w_ + 3] += 0.125f * b1[1]; }
#pragma unroll
            for (int i = 0; i < 8; ++i) { ssa += va[j][i] * va[j][i]; ssb += vb[j][i] * vb[j][i]; } }
        const float ra = rsqrtf(wave_sum(ssa) * (1.f / DM) + EPS), rb = rsqrtf(wave_sum(ssb) * (1.f / DM) + EPS);
#pragma unroll
        for (int j = 0; j < 2; ++j) { const int c = 8 * F.lane + 512 * j;
            f32x4 o0, o1;
            o0.x = va[j][0] * ra * gg[j][0].x; o0.y = va[j][1] * ra * gg[j][0].y; o0.z = va[j][2] * ra * gg[j][0].z; o0.w = va[j][3] * ra * gg[j][0].w;
            o1.x = va[j][4] * ra * gg[j][1].x; o1.y = va[j][5] * ra * gg[j][1].y; o1.z = va[j][6] * ra * gg[j][1].z; o1.w = va[j][7] * ra * gg[j][1].w;
            *(f32x4*)(F.out + (size_t)tA * DM + c) = o0; *(f32x4*)(F.out + (size_t)tA * DM + c + 4) = o1;
            o0.x = vb[j][0] * rb * gg[j][0].x; o0.y = vb[j][1] * rb * gg[j][0].y; o0.z = vb[j][2] * rb * gg[j][0].z; o0.w = vb[j][3] * rb * gg[j][0].w;
            o1.x = vb[j][4] * rb * gg[j][1].x; o1.y = vb[j][5] * rb * gg[j][1].y; o1.z = vb[j][6] * rb * gg[j][1].z; o1.w = vb[j][7] * rb * gg[j][1].w;
            *(f32x4*)(F.out + (size_t)tB * DM + c) = o0; *(f32x4*)(F.out + (size_t)tB * DM + c + 4) = o1; }
        slA = nA; slB = nB;
    }
}

__global__ void __launch_bounds__(NWAVES * 64, 2) hymba_fwd(Args args) {
    extern __shared__ __attribute__((aligned(16))) unsigned char lds[];
    Frame F;
    F.lds = (LAS unsigned char*)lds;
    F.MISC = (volatile LAS unsigned*)(F.lds + MISC_OFF);
    F.tid = threadIdx.x; F.lane = F.tid & 63; F.wave = __builtin_amdgcn_readfirstlane(F.tid >> 6);
    F.G = gridDim.x; { const int bx = blockIdx.x; F.vcu = (F.G % 8 == 0) ? (bx % 8) * (F.G / 8) + bx / 8 : bx; }
    F.ws = args.ws; F.ctl = (unsigned*)(args.ws + WS_CTL); F.out = args.out;
    for (int u = F.tid; u < (LDS_BYTES - LDSCTL_OFF) / 4; u += NWAVES * 64) ((LAS unsigned*)(F.lds + LDSCTL_OFF))[u] = 0u;
    __syncthreads();
    XcdBarrier bar; bar.bar = F.ctl + CW_BAR; bar.x = 0; bar.st = nullptr;
    if (N_LAUNCHES == 1) bar = xcd_barrier_post(F.ctl + CW_BAR, F.MISC + 8);
#define GRID_BAR() do { if (N_LAUNCHES == 1) xcd_barrier(bar); } while (0)
    const int lo = args.ph_lo, hi = args.ph_hi;
#ifndef PH_MASK
#define PH_MASK 0x1ff
#endif
#define IN(k) (((PH_MASK >> (k)) & 1) && lo <= (k) && (k) < hi)
#define BOTH(k) (IN(k) && IN((k) + 1))
    bf16_t* const H = (bf16_t*)(F.ws + WS_H); bf16_t* const PROJ = (bf16_t*)(F.ws + WS_PROJ); bf16_t* const MIX = (bf16_t*)(F.ws + WS_MIX); bf16_t* const X1B = (bf16_t*)(F.ws + WS_X1B);
    bf16_t* const Win_t = (bf16_t*)(F.ws + WS_WIN); bf16_t* const Wout_t = (bf16_t*)(F.ws + WS_WOUT);
    const unsigned char* const Wgu_q = F.ws + WS_WGU; const unsigned char* const Wd_q = F.ws + WS_WD;
    unsigned char* const X1Q = F.ws + WS_X1Q; unsigned char* const ACTQ = F.ws + WS_ACTQ; unsigned char* const Yp = F.ws + WS_Y;
    const int* const tok_slot = (const int*)(F.ws + WS_TOKSLOT); const float* const gate_slot = (const float*)(F.ws + WS_GATESLOT); const float* const rstd_slot = (const float*)(F.ws + WS_RSTDSLOT);
    const int* const rb_e = (const int*)(F.ws + WS_RBE);

#define REP(k) for (int rep_ = 0; rep_ < (((PROBE_REP >> (k)) & 1) ? 2 : 1); ++rep_)
    if (IN(0)) { REP(0) p0_prologue(F); if (BOTH(0)) GRID_BAR(); }
    if (IN(1)) {
        REP(1) {
        pg8::Gemm g{H, Win_t, DM, 0, nullptr}; pg8::StaticOrder S; S.init(T, INW, F.G, (int)blockIdx.x);
        pg8::EpiProj E{PROJ, (const float*)(F.ws + WS_RSTDX)};
        pg8::gemm_phase<pg8::EpiProj, pg8::StaticOrder, true>(F.lds, g, S, E); }
        if (BOTH(1)) GRID_BAR();
    }
    if (IN(2)) { p2_mixers(F); if (BOTH(2)) GRID_BAR(); }
    if (IN(3)) {
        pg8::Gemm g{MIX, Wout_t, DM, 0, nullptr}; pg8::StaticOrder S; S.init(T, DM, F.G, (int)blockIdx.x);
        pg8::EpiX1 E{H, X1B, X1Q};
        pg8::gemm_phase<pg8::EpiX1, pg8::StaticOrder, true>(F.lds, g, S, E);
        if (BOTH(3)) GRID_BAR();
    }
    if (IN(4)) { if (PROBE_X & 2) p4_router(F, true); p4_router(F); if (BOTH(4)) GRID_BAR(); }
    if (IN(5)) { p5_place(F); if (BOTH(5)) GRID_BAR(); }
    if (IN(6)) {
        const int nrb = rb_e[NRB_MAX];
        REP(6) {
        pg8::Gemm g{(const bf16_t*)X1Q, (const bf16_t*)Wgu_q, DM / 2, (long)2048 * DM / 2, tok_slot}; pg8::GroupOrder S{nrb, 0, 8, F.G, (int)blockIdx.x, rb_e};
        pg8::EpiGU E{ACTQ, kargs()->in[I_BGU], rstd_slot};
        pg8::gemm_phase<pg8::EpiGU, pg8::GroupOrder, true, true, (PROBE_KREP == 2 ? 0x78787878 : 0x79797979), 0x7f7f7f7f, PROBE_KREP>(F.lds, g, S, E); }
        if (BOTH(6)) GRID_BAR();
    }
    if (IN(7)) {
        const int nrb = rb_e[NRB_MAX];
        REP(7) {
        pg8::Gemm g{(const bf16_t*)ACTQ, (const bf16_t*)Wd_q, DEXP / 2, (long)DM * DEXP / 2, nullptr}; pg8::GroupOrder S{nrb, 0, 4, F.G, (int)blockIdx.x, rb_e};
        pg8::EpiDown E{Yp, kargs()->in[I_BDN], gate_slot};
        pg8::gemm_phase<pg8::EpiDown, pg8::GroupOrder, true, true, 0x79797979, 0x7d7d7d7d>(F.lds, g, S, E); }
        if (BOTH(7)) GRID_BAR();
    }
    if (IN(8)) { REP(8) p9_final(F); }
#if PROBE_SEG
    if (IN(8) && blockIdx.x == 0 && F.tid == 0) { const unsigned long long a_ = F.ctl[604], t_ = F.ctl[605]; const unsigned long long us_ = t_ ? a_ * 2000ull / t_ : 0ull; const unsigned long long t0_ = __builtin_amdgcn_s_memrealtime();
        while (__builtin_amdgcn_s_memrealtime() - t0_ < us_ * 100ull) __builtin_amdgcn_s_sleep(8); }
#endif
#if PROBE_CLK
    if (IN(8) && blockIdx.x == 0 && F.tid == 0) { const unsigned long long dc_ = ((unsigned long long)F.ctl[601] << 32) | F.ctl[600]; const unsigned long long dr_ = F.ctl[602];
        const unsigned long long mhz_ = dr_ ? dc_ * 100ull / dr_ : 0ull; const unsigned long long t0_ = __builtin_amdgcn_s_memrealtime();
        while (__builtin_amdgcn_s_memrealtime() - t0_ < mhz_ * 100ull) __builtin_amdgcn_s_sleep(8); }
#endif
#undef IN
#undef BOTH
#undef GRID_BAR
}

extern "C" void kernel_launch(void* const* d_in, const int* in_sizes, int n_in, void* d_out, int out_size, void* d_ws, size_t ws_size, hipStream_t stream) {
    static int grid = 0;
    if (grid == 0) {
        if (n_in != 19 || out_size != T * DM || ws_size < WS_END) { fprintf(stderr, "kernel_launch: unexpected shapes (n_in %d out %d ws %zu)\n", n_in, out_size, ws_size); grid = -1; return; }
        int dev = 0, cus = 0;
        if (hipGetDevice(&dev) != hipSuccess || hipDeviceGetAttribute(&cus, hipDeviceAttributeMultiprocessorCount, dev) != hipSuccess) { grid = -1; return; }
        if (hipFuncSetAttribute((const void*)hymba_fwd, hipFuncAttributeMaxDynamicSharedMemorySize, LDS_BYTES) != hipSuccess) { fprintf(stderr, "kernel_launch: hipFuncSetAttribute failed\n"); grid = -1; return; }
        int per_cu = 0;
        if (hipOccupancyMaxActiveBlocksPerMultiprocessor(&per_cu, (const void*)hymba_fwd, NWAVES * 64, LDS_BYTES) != hipSuccess || per_cu < 1) fprintf(stderr, "kernel_launch: occupancy query reports %d\n", per_cu);
        (void)hipGetLastError();
        grid = cus;
    }
    if (grid < 0) return;
    if (hipMemsetAsync((char*)d_ws + WS_CTL, 0, CTL_ZERO_BYTES, stream) != hipSuccess) return;
    Args a{};
    for (int i = 0; i < 19; ++i) a.in[i] = (const float*)d_in[i];
    a.out = (float*)d_out; a.ws = (unsigned char*)d_ws;
    for (int li = 0; li < N_LAUNCHES; ++li) {
        a.ph_lo = (N_LAUNCHES == 1) ? 0 : li; a.ph_hi = (N_LAUNCHES == 1) ? N_PHASES : li + 1;
        hipLaunchKernelGGL(hymba_fwd, dim3(grid), dim3(NWAVES * 64), LDS_BYTES, stream, a);
    }
}
```
